# Optimizing an MI355X kernel written in HIP

```python
import jax, jax.numpy as jnp
from jax import lax
import numpy as np

D_MODEL = 1024
BATCH = 2
SEQ = 8192
DEPTH = 2

D_MIX = D_MODEL
N_MIXERS = 4
GROUP_WIDTH = D_MIX // N_MIXERS
N_GROUP_HEADS = 4
HEAD_DIM = GROUP_WIDTH // N_GROUP_HEADS
N_IN_SLICES = 10
D_IN = N_IN_SLICES * GROUP_WIDTH
LRU_CONV = 4
LRU_C = 8.0
HGRN_CHUNK = 64
POOL_WINDOWS = (2, 4, 8, 16)
SCONV_WIDTH = 3
D_FF = 2816
N_EXPERTS = 8
TOP_K = 2
D_FF_EXPERT = 3584
ROW_BLOCK = 128
NORM_EPS = 1e-6
HEAD_NORM_EPS = 1e-5
N_DENSE = (DEPTH + 1) // 2
N_MOE = DEPTH // 2

kernel_name = 'hybrid_lru_hgrn2_pool_sconv_moe'

F32 = jnp.float32


def rms_norm(x, g):
    xf = x.astype(F32)
    y = xf * lax.rsqrt(jnp.mean(xf * xf, axis=-1, keepdims=True) + NORM_EPS)
    return (y * g.astype(F32)).astype(x.dtype)


def causal_depthwise_conv(x, w):
    k = w.shape[0]
    return lax.conv_general_dilated(
        x, w[:, None, :].astype(x.dtype), window_strides=(1,), padding=[(k - 1, 0)],
        dimension_numbers=('NWC', 'WIO', 'NWC'), feature_group_count=x.shape[-1])


def block_diag_linear(x, w, b):
    bsz, s, c = x.shape
    xh = x.reshape(bsz, s, N_GROUP_HEADS, HEAD_DIM)
    return jnp.einsum('bshi,hij->bshj', xh, w).reshape(bsz, s, c) + b


def rg_lru(x, w_a, b_a, w_x, b_x, lam):
    r = jax.nn.sigmoid(block_diag_linear(x, w_a, b_a).astype(F32))
    i = jax.nn.sigmoid(block_diag_linear(x, w_x, b_x).astype(F32))
    log_a = -LRU_C * r * jax.nn.softplus(-lam.astype(F32))
    a = jnp.exp(log_a)
    mult = jnp.sqrt(-jnp.expm1(2.0 * log_a))
    u = mult * i * x.astype(F32)

    def combine(c1, c2):
        a1, b1 = c1
        a2, b2 = c2
        return a1 * a2, a2 * b1 + b2

    _, h = lax.associative_scan(combine, (a, u), axis=1)
    return h.astype(x.dtype)


def hgrn2(q, f_pre, v, g, lb, norm_g):
    bsz, s, c = q.shape
    n_chunks = s // HGRN_CHUNK
    z = f_pre.astype(F32)
    log_f = jnp.log(lb + (1.0 - lb) * jax.nn.sigmoid(z))
    k = (1.0 - lb) * jax.nn.sigmoid(-z)
    qf = jax.nn.silu(q.astype(F32))

    def to_chunks(t):
        return t.reshape(bsz, n_chunks, HGRN_CHUNK, N_GROUP_HEADS, HEAD_DIM).transpose(1, 0, 3, 2, 4)

    qc, kc, vc, gc = (to_chunks(t) for t in (qf, k, v.astype(F32), log_f))
    causal = jnp.tril(jnp.ones((HGRN_CHUNK, HGRN_CHUNK), dtype=bool))

    def step(state, inp):
        q_, k_, v_, g_ = inp
        G = jnp.cumsum(g_, axis=2)
        diff = G[:, :, :, None, :] - G[:, :, None, :, :]
        decay = jnp.exp(jnp.where(causal[:, :, None], diff, -jnp.inf))
        scores = jnp.einsum('bhtk,bhtsk,bhsk->bhts', q_, decay, k_)
        o = (jnp.einsum('bhts,bhsv->bhtv', scores, v_)
             + jnp.einsum('bhtk,bhkv->bhtv', q_ * jnp.exp(G), state))
        G_last = G[:, :, -1:, :]
        state = (jnp.exp(G_last[:, :, 0, :])[..., None] * state
                 + jnp.einsum('bhsk,bhsv->bhkv', k_ * jnp.exp(G_last - G), v_))
        return state, o

    s0 = jnp.zeros((bsz, N_GROUP_HEADS, HEAD_DIM, HEAD_DIM), F32)
    _, o = lax.scan(step, s0, (qc, kc, vc, gc))
    o = o.transpose(1, 0, 3, 2, 4).reshape(bsz, s, N_GROUP_HEADS, HEAD_DIM)
    o = o * lax.rsqrt(jnp.mean(o * o, axis=-1, keepdims=True) + HEAD_NORM_EPS) * norm_g.astype(F32)
    o = o * jax.nn.silu(g.astype(F32).reshape(bsz, s, N_GROUP_HEADS, HEAD_DIM))
    return o.reshape(bsz, s, c).astype(q.dtype)


def multiscale_pool(x, w_pool, scale):
    bsz, s, c = x.shape
    xf = x.astype(F32).reshape(bsz, s, len(POOL_WINDOWS), HEAD_DIM)
    cs = jnp.cumsum(xf, axis=1)
    pos = jnp.arange(1, s + 1, dtype=F32)
    outs = []
    for gi, w in enumerate(POOL_WINDOWS):
        cg = cs[:, :, gi]
        lag = jnp.pad(cg[:, :-w], ((0, 0), (w, 0), (0, 0)))
        mean = (cg - lag) / jnp.minimum(pos, float(w))[None, :, None]
        outs.append(mean - xf[:, :, gi])
    d = jnp.stack(outs, axis=2).astype(x.dtype)
    y = jnp.einsum('bsgi,gij->bsgj', d, w_pool).reshape(bsz, s, c)
    return y * scale


def hybrid_mixer(h, w_in, w_out, lru_conv_w, lru_conv_b, lru_w_a, lru_b_a, lru_w_x, lru_b_x,
                 lru_lambda, lb, hgrn_norm_g, pool_w, pool_scale, sconv_w):
    proj = h @ w_in
    a_x, a_g, q, f, v, o_g, p, sb, sc, sx = jnp.split(proj, N_IN_SLICES, axis=-1)
    a_in = causal_depthwise_conv(a_x, lru_conv_w) + lru_conv_b
    y_a = rg_lru(a_in, lru_w_a, lru_b_a, lru_w_x, lru_b_x, lru_lambda) * jax.nn.gelu(a_g)
    y_b = hgrn2(q, f, v, o_g, lb, hgrn_norm_g)
    y_c = multiscale_pool(p, pool_w, pool_scale)
    y_d = sb * causal_depthwise_conv(sc * sx, sconv_w)
    y = jnp.concatenate([y_a, y_b, y_c, y_d], axis=-1)
    return y @ w_out


def swiglu(h, w_gate, w_up, w_down):
    return (jax.nn.silu(h @ w_gate) * (h @ w_up)) @ w_down


def moe_swiglu(h, w_router, w1, w3, w2):
    bsz, s, d = h.shape
    n = bsz * s
    xf = h.reshape(n, d)
    logits = jnp.dot(xf.astype(F32), w_router.astype(F32))
    top_logit, top_e = lax.top_k(logits, TOP_K)
    gates = jax.nn.softmax(top_logit, axis=-1)
    e_flat = top_e.reshape(-1).astype(jnp.int32)
    tok_flat = jnp.arange(n * TOP_K, dtype=jnp.int32) // TOP_K
    g_flat = gates.reshape(-1)
    order = jnp.argsort(e_flat)
    e_sorted, tok_sorted, g_sorted = e_flat[order], tok_flat[order], g_flat[order]
    counts = jnp.bincount(e_flat, length=N_EXPERTS)
    start = jnp.cumsum(counts) - counts
    padded = (counts + ROW_BLOCK - 1) // ROW_BLOCK * ROW_BLOCK
    pend = jnp.cumsum(padded)
    pstart = pend - padded
    dest = pstart[e_sorted] + (jnp.arange(n * TOP_K, dtype=jnp.int32) - start[e_sorted])
    n_blocks = (n * TOP_K + ROW_BLOCK - 1) // ROW_BLOCK + N_EXPERTS
    n_rows = n_blocks * ROW_BLOCK
    row_tok = jnp.full((n_rows,), n, jnp.int32).at[dest].set(tok_sorted)
    row_gate = jnp.zeros((n_rows,), F32).at[dest].set(g_sorted)
    block_e = jnp.minimum(
        jnp.searchsorted(pend, jnp.arange(n_blocks, dtype=pend.dtype) * ROW_BLOCK, side='right'),
        N_EXPERTS - 1)
    x_rows = jnp.concatenate([xf, jnp.zeros((1, d), xf.dtype)], axis=0)[row_tok]
    x_rows = x_rows.reshape(n_blocks, ROW_BLOCK, d)

    def expert_block(args):
        xb, e = args
        return (jax.nn.silu(xb @ w1[e]) * (xb @ w3[e])) @ w2[e]

    y_rows = lax.map(expert_block, (x_rows, block_e)).reshape(n_rows, d)
    y = jax.ops.segment_sum(y_rows.astype(F32) * row_gate[:, None], row_tok, num_segments=n + 1)[:n]
    return y.reshape(bsz, s, d).astype(h.dtype)


def setup_inputs(seed: int = 0) -> dict:
    key = jax.random.key(seed)
    ks = jax.random.split(key, 32)

    def nrm(k, shape, fan_in):
        return jax.random.normal(k, shape, F32) * (fan_in ** -0.5)

    u = jax.random.uniform(ks[9], (DEPTH, GROUP_WIDTH), F32, minval=0.9, maxval=0.999)
    a0 = u ** (1.0 / LRU_C)
    lru_lambda = jnp.log(a0) - jnp.log1p(-a0)
    return {
        'x': jax.random.normal(ks[0], (BATCH, SEQ, D_MODEL), F32),
        'w_in': nrm(ks[1], (DEPTH, D_MODEL, D_IN), D_MODEL),
        'w_out': nrm(ks[2], (DEPTH, D_MIX, D_MODEL), D_MIX),
        'lru_conv_w': nrm(ks[3], (DEPTH, LRU_CONV, GROUP_WIDTH), LRU_CONV),
        'lru_conv_b': 0.01 * jax.random.normal(ks[4], (DEPTH, GROUP_WIDTH), F32),
        'lru_w_a': nrm(ks[5], (DEPTH, N_GROUP_HEADS, HEAD_DIM, HEAD_DIM), HEAD_DIM),
        'lru_b_a': 0.01 * jax.random.normal(ks[6], (DEPTH, GROUP_WIDTH), F32),
        'lru_w_x': nrm(ks[7], (DEPTH, N_GROUP_HEADS, HEAD_DIM, HEAD_DIM), HEAD_DIM),
        'lru_b_x': 0.01 * jax.random.normal(ks[8], (DEPTH, GROUP_WIDTH), F32),
        'lru_lambda': lru_lambda,
        'hgrn_lower_bounds': 0.1 * jax.random.normal(ks[10], (DEPTH, GROUP_WIDTH), F32),
        'hgrn_norm_g': 1.0 + 0.02 * jax.random.normal(ks[11], (DEPTH, HEAD_DIM), F32),
        'pool_w': nrm(ks[12], (DEPTH, len(POOL_WINDOWS), HEAD_DIM, HEAD_DIM), HEAD_DIM),
        'pool_scale': 1.0 + 0.1 * jax.random.normal(ks[13], (DEPTH, GROUP_WIDTH), F32),
        'sconv_w': nrm(ks[14], (DEPTH, SCONV_WIDTH, GROUP_WIDTH), SCONV_WIDTH),
        'norm_mix_g': 1.0 + 0.02 * jax.random.normal(ks[15], (DEPTH, D_MODEL), F32),
        'norm_ffn_g': 1.0 + 0.02 * jax.random.normal(ks[16], (DEPTH, D_MODEL), F32),
        'ffn_w_gate': nrm(ks[17], (N_DENSE, D_MODEL, D_FF), D_MODEL),
        'ffn_w_up': nrm(ks[18], (N_DENSE, D_MODEL, D_FF), D_MODEL),
        'ffn_w_down': nrm(ks[19], (N_DENSE, D_FF, D_MODEL), D_FF),
        'moe_w_router': nrm(ks[20], (N_MOE, D_MODEL, N_EXPERTS), D_MODEL),
        'moe_w1': nrm(ks[21], (N_MOE, N_EXPERTS, D_MODEL, D_FF_EXPERT), D_MODEL),
        'moe_w3': nrm(ks[22], (N_MOE, N_EXPERTS, D_MODEL, D_FF_EXPERT), D_MODEL),
        'moe_w2': nrm(ks[23], (N_MOE, N_EXPERTS, D_FF_EXPERT, D_MODEL), D_FF_EXPERT),
        'final_norm_g': 1.0 + 0.02 * jax.random.normal(ks[24], (D_MODEL,), F32),
    }


def reference(x, w_in, w_out, lru_conv_w, lru_conv_b, lru_w_a, lru_b_a, lru_w_x, lru_b_x,
              lru_lambda, hgrn_lower_bounds, hgrn_norm_g, pool_w, pool_scale, sconv_w,
              norm_mix_g, norm_ffn_g, ffn_w_gate, ffn_w_up, ffn_w_down,
              moe_w_router, moe_w1, moe_w3, moe_w2, final_norm_g):
    lb_all = jnp.cumsum(jax.nn.softmax(hgrn_lower_bounds.astype(F32), axis=0), axis=0)
    lb_all = lb_all - lb_all[0]
    h = x
    for layer in range(DEPTH):
        hn = rms_norm(h, norm_mix_g[layer])
        h = h + hybrid_mixer(hn, w_in[layer], w_out[layer], lru_conv_w[layer], lru_conv_b[layer],
                             lru_w_a[layer], lru_b_a[layer], lru_w_x[layer], lru_b_x[layer],
                             lru_lambda[layer], lb_all[layer], hgrn_norm_g[layer],
                             pool_w[layer], pool_scale[layer], sconv_w[layer])
        hn = rms_norm(h, norm_ffn_g[layer])
        if layer % 2 == 0:
            j = layer // 2
            h = h + swiglu(hn, ffn_w_gate[j], ffn_w_up[j], ffn_w_down[j])
        else:
            j = layer // 2
            h = h + moe_swiglu(hn, moe_w_router[j], moe_w1[j], moe_w3[j], moe_w2[j])
    return rms_norm(h, final_norm_g)
```

```cpp
#include <hip/hip_runtime.h>
#include <cstdint>
#include <cstdio>

typedef unsigned short bf16;
typedef short bf16x8 __attribute__((ext_vector_type(8)));
typedef float f32x4 __attribute__((ext_vector_type(4)));
typedef unsigned u32x4 __attribute__((ext_vector_type(4)));
typedef unsigned u32x2 __attribute__((ext_vector_type(2)));

constexpr int NTOK = 16384, SEQ = 8192, D = 1024, DIN = 2560, GW = 256, HD = 64, DFF = 2816, DFFE = 3584, NE = 8;
constexpr int CH = 64, NCHUNK = NTOK / CH, CPB = SEQ / CH;
constexpr int NT = 512;
constexpr int MAXTILES = NTOK * 2 / 256 + NE;
constexpr int CAPT = 68;
constexpr int NPASS = (MAXTILES + CAPT - 1) / CAPT;

constexpr size_t MiB = 1u << 20;
constexpr size_t WS_CTL = 0;
constexpr size_t WS_SMALL = 1 * MiB;
constexpr size_t WS_WIN = 5 * MiB;
constexpr size_t WS_WOUT = 15 * MiB;
constexpr size_t WS_WGU = 19 * MiB;
constexpr size_t WS_WD = 30 * MiB;
constexpr size_t WS_W13 = 36 * MiB;
constexpr size_t WS_W2 = 148 * MiB;
constexpr size_t WS_ACT = 204 * MiB;
constexpr size_t WS_HN = WS_ACT;
constexpr size_t WS_PROJ = WS_ACT + 32 * MiB;
constexpr size_t WS_Y = WS_ACT + 112 * MiB;
constexpr size_t WS_GBUF = WS_ACT + 144 * MiB;
constexpr size_t WS_HLOC = WS_ACT + 160 * MiB;
constexpr size_t WS_CUMA = WS_ACT + 176 * MiB;
constexpr size_t WS_DS = WS_ACT + 192 * MiB;
constexpr size_t WS_HID = WS_PROJ;
constexpr size_t WS_HIDE = WS_ACT + 32 * MiB;
constexpr size_t WS_OUT2 = WS_ACT + 151 * MiB;
constexpr size_t WS_END = WS_ACT + 215 * MiB;
constexpr size_t SM_TOKE = 0;
constexpr size_t SM_TOKG = 128 * 1024;
constexpr size_t SM_TOKR = 256 * 1024;
constexpr size_t SM_BCNT = 384 * 1024;
constexpr size_t SM_ROWTOK = 400 * 1024;
constexpr size_t SM_ROWDST = 544 * 1024;
constexpr size_t SM_ROWG = 688 * 1024;
constexpr size_t SM_TILEE = 832 * 1024;
constexpr size_t SM_CARA = 1024 * 1024;
constexpr size_t SM_CARH = 1280 * 1024;
constexpr size_t SM_CIN = 1536 * 1024;
constexpr size_t SM_DEC = 1792 * 1024;

struct Args {
    const float* in[25];
    float* out;
    unsigned char* ws;
    int phase, layer, pass, pad;
};

__device__ __forceinline__ float bf2f(unsigned v) { return __uint_as_float(v << 16); }
__device__ __forceinline__ unsigned f2bf(float f) { unsigned u = __float_as_uint(f); return (u + 0x7fffu + ((u >> 16) & 1u)) >> 16; }
__device__ __forceinline__ unsigned pk2(float lo, float hi) { return f2bf(lo) | (f2bf(hi) << 16); }
__device__ __forceinline__ float sigmoidf_(float x) { return 1.0f / (1.0f + __expf(-x)); }
__device__ __forceinline__ float siluf_(float x) { return x * sigmoidf_(x); }
__device__ __forceinline__ float gelu_tanh(float x) { const float u = 0.7978845608028654f * (x + 0.044715f * x * x * x); return 0.5f * x * (1.0f + tanhf(u)); }
__device__ __forceinline__ float wave_sum(float v) {
#pragma unroll
    for (int o = 1; o < 64; o <<= 1) v += __shfl_xor(v, o);
    return v;
}
#define LDS_WAIT() asm volatile("s_waitcnt lgkmcnt(0)" ::: "memory")

__device__ __forceinline__ void cvt_item(const float* W, int K, int N, bf16* WT, int mode, int item, float* scr, int lane) {
    const int nblk = N / 32, kb = item / nblk, nb = item % nblk, k0 = 64 * kb, n0 = 32 * nb;
#pragma unroll 8
    for (int i = 0; i < 32; ++i) { const int kk = 2 * i + (lane >> 5); scr[kk * 33 + (lane & 31)] = W[(size_t)(k0 + kk) * N + n0 + (lane & 31)]; }
    LDS_WAIT();
    const int c = lane & 7;
#pragma unroll
    for (int j = 0; j < 4; ++j) {
        const int n = (lane >> 3) + 8 * j; const float* s = scr + (8 * c) * 33 + n;
        u32x4 o; o.x = pk2(s[0 * 33], s[1 * 33]); o.y = pk2(s[2 * 33], s[3 * 33]); o.z = pk2(s[4 * 33], s[5 * 33]); o.w = pk2(s[6 * 33], s[7 * 33]);
        const int nn = n0 + n; const int drow = mode == 0 ? nn : ((nn >> 7) * 256 + (nn & 127) + (mode == 2 ? 128 : 0));
        *(u32x4*)(WT + (size_t)drow * K + k0 + 8 * c) = o;
    }
    LDS_WAIT();
}

__device__ __forceinline__ void rms_row_bf16(const float* xrow, const float* g, bf16* orow, int lane) {
    const f32x4* xr = (const f32x4*)xrow; const f32x4* gr = (const f32x4*)g;
    f32x4 v[4]; float s = 0.f;
#pragma unroll
    for (int j = 0; j < 4; ++j) { v[j] = xr[lane + 64 * j]; s += (v[j].x * v[j].x + v[j].y * v[j].y) + (v[j].z * v[j].z + v[j].w * v[j].w); }
    const float r = 1.0f / sqrtf(wave_sum(s) * (1.0f / D) + 1e-6f);
    u32x2* o8 = (u32x2*)orow;
#pragma unroll
    for (int j = 0; j < 4; ++j) { const f32x4 gv = gr[lane + 64 * j]; u32x2 w; w.x = pk2(v[j].x * r * gv.x, v[j].y * r * gv.y); w.y = pk2(v[j].z * r * gv.z, v[j].w * r * gv.w); o8[lane + 64 * j] = w; }
}

template <bool DUAL, class Epi>
__device__ __forceinline__ void gemm_tile(const bf16* A, int lda, const int* rowmap, int m0, const bf16* Bt, int ldb, int K, const Epi& epi, int ncol0) {
    const int tid = threadIdx.x, wid = tid >> 6, lane = tid & 63, wr = wid >> 1, wc = wid & 1, fr = lane & 15, fq = lane >> 4;
    const bf16* pa[2]; const bf16* pb[4];
#pragma unroll
    for (int i = 0; i < 2; ++i) { const int row = m0 + 32 * wr + 16 * i + fr; const int ar = rowmap ? rowmap[row] : row; pa[i] = A + (size_t)ar * lda + 8 * fq; }
#pragma unroll
    for (int j = 0; j < 4; ++j) { const int n = 64 * wc + 16 * j + fr; pb[j] = Bt + (size_t)n * ldb + 8 * fq; }
    f32x4 acc[2][4], acu[2][4];
#pragma unroll
    for (int i = 0; i < 2; ++i)
#pragma unroll
        for (int j = 0; j < 4; ++j) { acc[i][j] = (f32x4){0.f, 0.f, 0.f, 0.f}; acu[i][j] = (f32x4){0.f, 0.f, 0.f, 0.f}; }
    for (int k = 0; k < K; k += 32) {
        bf16x8 a[2], b[4], bu[4];
#pragma unroll
        for (int i = 0; i < 2; ++i) a[i] = *(const bf16x8*)(pa[i] + k);
#pragma unroll
        for (int j = 0; j < 4; ++j) { b[j] = *(const bf16x8*)(pb[j] + k); if (DUAL) bu[j] = *(const bf16x8*)(pb[j] + (size_t)128 * ldb + k); }
#pragma unroll
        for (int i = 0; i < 2; ++i)
#pragma unroll
            for (int j = 0; j < 4; ++j) {
                acc[i][j] = __builtin_amdgcn_mfma_f32_16x16x32_bf16(b[j], a[i], acc[i][j], 0, 0, 0);
                if (DUAL) acu[i][j] = __builtin_amdgcn_mfma_f32_16x16x32_bf16(bu[j], a[i], acu[i][j], 0, 0, 0);
            }
    }
#pragma unroll
    for (int i = 0; i < 2; ++i)
#pragma unroll
        for (int j = 0; j < 4; ++j) epi(m0 + 32 * wr + 16 * i + fr, ncol0 + 64 * wc + 16 * j + 4 * fq, acc[i][j], acu[i][j]);
}

struct EpiBf16 { bf16* C; int ldc; __device__ __forceinline__ void operator()(int row, int col, f32x4 v, f32x4) const {
    u32x2 w; w.x = pk2(v.x, v.y); w.y = pk2(v.z, v.w); *(u32x2*)(C + (size_t)row * ldc + col) = w; } };
struct EpiResid { const float* base; float* out; __device__ __forceinline__ void operator()(int row, int col, f32x4 v, f32x4) const {
    const f32x4 b = *(const f32x4*)(base + (size_t)row * D + col); *(f32x4*)(out + (size_t)row * D + col) = b + v; } };
struct EpiSwiglu { bf16* C; int ldc; int row_off; __device__ __forceinline__ void operator()(int row, int col, f32x4 g, f32x4 u) const {
    u32x2 w; w.x = pk2(siluf_(g.x) * u.x, siluf_(g.y) * u.y); w.y = pk2(siluf_(g.z) * u.z, siluf_(g.w) * u.w); *(u32x2*)(C + (size_t)(row - row_off) * ldc + col) = w; } };
struct EpiMoeDown { bf16* out2; const int* rowdst; const float* rowg; int row_off; __device__ __forceinline__ void operator()(int row, int col, f32x4 v, f32x4) const {
    const int gr = row + row_off; const int d = rowdst[gr]; if (d < 0) return; const float g = rowg[gr];
    u32x2 w; w.x = pk2(g * v.x, g * v.y); w.y = pk2(g * v.z, g * v.w); *(u32x2*)(out2 + (size_t)d * D + col) = w; } };

enum Phase { PH_PROLOGUE = 0, PH_INPROJ, PH_MIX1, PH_MIX2, PH_MIX3, PH_OUTPROJ, PH_NORM, PH_FFNUP, PH_FFNDOWN, PH_DISPATCH, PH_MOEUP, PH_MOEDOWN, PH_FINAL };

__global__ void __launch_bounds__(NT) fwd(Args a) {
    extern __shared__ __attribute__((aligned(16))) unsigned char lds_raw[];
    float* ldsf = (float*)lds_raw;
    const int tid = threadIdx.x, lane = tid & 63, wid = tid >> 6, G = gridDim.x, bid = blockIdx.x;
    unsigned char* ws = a.ws; unsigned char* sm = ws + WS_SMALL;
    const int L = a.layer;
    bf16* HN = (bf16*)(ws + WS_HN); bf16* PROJ = (bf16*)(ws + WS_PROJ); bf16* Y = (bf16*)(ws + WS_Y);
    float* GBUF = (float*)(ws + WS_GBUF); float* HLOC = (float*)(ws + WS_HLOC); float* CUMA = (float*)(ws + WS_CUMA); float* DS = (float*)(ws + WS_DS);
    bf16* HID = (bf16*)(ws + WS_HID); bf16* HIDE = (bf16*)(ws + WS_HIDE); bf16* OUT2 = (bf16*)(ws + WS_OUT2);
    int* TOKE = (int*)(sm + SM_TOKE); float* TOKG = (float*)(sm + SM_TOKG); int* TOKR = (int*)(sm + SM_TOKR); int* BCNT = (int*)(sm + SM_BCNT);
    int* ROWTOK = (int*)(sm + SM_ROWTOK); int* ROWDST = (int*)(sm + SM_ROWDST); float* ROWG = (float*)(sm + SM_ROWG); int* TILEE = (int*)(sm + SM_TILEE);
    float* CARA = (float*)(sm + SM_CARA); float* CARH = (float*)(sm + SM_CARH); float* CIN = (float*)(sm + SM_CIN); float* DEC = (float*)(sm + SM_DEC);
    float* hres = a.out;

    switch (a.phase) {
    case PH_PROLOGUE: {
        float* scr = ldsf + wid * (64 * 33);
        const int gw = bid * 8 + wid, NGW = G * 8;
        constexpr int I_IN = 16 * 80, I_OUT = 16 * 32, I_G = 16 * 88, I_D = 44 * 32, I_E1 = 16 * 112, I_E2 = 56 * 32;
        constexpr int T0 = 2 * I_IN, T1 = T0 + 2 * I_OUT, T2 = T1 + I_G, T3 = T2 + I_G, T4 = T3 + I_D, T5 = T4 + NE * I_E1, T6 = T5 + NE * I_E1, T7 = T6 + NE * I_E2;
        for (int it = gw; it < T7; it += NGW) {
            if (it < T0) { const int l = it / I_IN, r = it % I_IN; cvt_item(a.in[1] + (size_t)l * D * DIN, D, DIN, (bf16*)(ws + WS_WIN) + (size_t)l * DIN * D, 0, r, scr, lane); }
            else if (it < T1) { const int q = it - T0, l = q / I_OUT, r = q % I_OUT; cvt_item(a.in[2] + (size_t)l * D * D, D, D, (bf16*)(ws + WS_WOUT) + (size_t)l * D * D, 0, r, scr, lane); }
            else if (it < T2) { cvt_item(a.in[17], D, DFF, (bf16*)(ws + WS_WGU), 1, it - T1, scr, lane); }
            else if (it < T3) { cvt_item(a.in[18], D, DFF, (bf16*)(ws + WS_WGU), 2, it - T2, scr, lane); }
            else if (it < T4) { cvt_item(a.in[19], DFF, D, (bf16*)(ws + WS_WD), 0, it - T3, scr, lane); }
            else if (it < T5) { const int q = it - T4, e = q / I_E1, r = q % I_E1; cvt_item(a.in[21] + (size_t)e * D * DFFE, D, DFFE, (bf16*)(ws + WS_W13) + (size_t)e * 2 * DFFE * D, 1, r, scr, lane); }
            else if (it < T6) { const int q = it - T5, e = q / I_E1, r = q % I_E1; cvt_item(a.in[22] + (size_t)e * D * DFFE, D, DFFE, (bf16*)(ws + WS_W13) + (size_t)e * 2 * DFFE * D, 2, r, scr, lane); }
            else { const int q = it - T6, e = q / I_E2, r = q % I_E2; cvt_item(a.in[23] + (size_t)e * DFFE * D, DFFE, D, (bf16*)(ws + WS_W2) + (size_t)e * D * DFFE, 0, r, scr, lane); }
        }
        for (int m = gw; m < NTOK; m += NGW) rms_row_bf16(a.in[0] + (size_t)m * D, a.in[15], HN + (size_t)m * D, lane);
    } break;

    case PH_INPROJ: {
        const bf16* Bt = (const bf16*)(ws + WS_WIN) + (size_t)L * DIN * D; EpiBf16 E{PROJ, DIN};
        constexpr int NN = DIN / 128, NU = (NTOK / 128) * NN;
        for (int u = bid; u < NU; u += G) { const int pm = u / NN, pn = u % NN; gemm_tile<false>(HN, D, nullptr, pm * 128, Bt + (size_t)pn * 128 * D, D, D, E, pn * 128); }
    } break;

    case PH_MIX1: {
        const float* conv_w = a.in[3] + L * 4 * GW; const float* conv_b = a.in[4] + L * GW;
        const float* w_a = a.in[5] + L * 4 * HD * HD; const float* b_a = a.in[6] + L * GW; const float* w_x = a.in[7] + L * 4 * HD * HD; const float* b_x = a.in[8] + L * GW;
        const float* lam = a.in[9] + L * GW; const float* lbp = a.in[10];
        float* ain = ldsf;
        float* Gl = ldsf; float* kkl = ldsf + 4096; float* vl = ldsf + 8192;
        for (int ci = bid; ci < NCHUNK; ci += G) {
            const int b = ci / CPB, t0 = (ci % CPB) * CH, g0 = ci * CH;
            for (int idx = tid; idx < CH * GW; idx += NT) {
                const int t = idx >> 8, c = idx & 255; float acc = conv_b[c];
#pragma unroll
                for (int k = 0; k < 4; ++k) { const int tt = t0 + t - 3 + k; if (tt >= 0) acc += conv_w[k * GW + c] * bf2f(PROJ[(size_t)(b * SEQ + tt) * DIN + c]); }
                ain[idx] = acc;
            }
            __syncthreads();
            if (tid < GW) {
                const int c = tid, h = c >> 6, j = c & 63; const float sp = log1pf(__expf(-lam[c])); const float ba = b_a[c], bx = b_x[c];
                float hl = 0.f, ca = 1.f;
                for (int t = 0; t < CH; ++t) {
                    float ra = ba, rx = bx; const float* xr = ain + t * GW + h * 64;
                    for (int i = 0; i < 64; ++i) { const float xi = xr[i]; ra += xi * w_a[(h * 64 + i) * 64 + j]; rx += xi * w_x[(h * 64 + i) * 64 + j]; }
                    const float r = sigmoidf_(ra), ig = sigmoidf_(rx); const float loga = -8.0f * r * sp; const float av = __expf(loga);
                    const float mult = sqrtf(fmaxf(-expm1f(2.0f * loga), 0.f)); const float u = mult * ig * ain[t * GW + c];
                    hl = av * hl + u; ca *= av;
                    HLOC[(size_t)(g0 + t) * GW + c] = hl; CUMA[(size_t)(g0 + t) * GW + c] = ca;
                }
                CARA[ci * GW + c] = ca; CARH[ci * GW + c] = hl;
            }
            __syncthreads();
            for (int hh = 0; hh < 4; ++hh) {
                for (int idx = tid; idx < CH * HD; idx += NT) {
                    const int t = idx >> 6, k = idx & 63, c = hh * 64 + k; const size_t row = (size_t)(g0 + t) * DIN;
                    const float lb = L == 0 ? 0.f : sigmoidf_(lbp[GW + c] - lbp[c]);
                    const float zz = bf2f(PROJ[row + 768 + c]); const float sg = sigmoidf_(zz);
                    Gl[idx] = logf(lb + (1.f - lb) * sg); kkl[idx] = (1.f - lb) * (1.f - sg); vl[idx] = bf2f(PROJ[row + 1024 + c]);
                }
                __syncthreads();
                if (tid < HD) { float run = 0.f; for (int t = 0; t < CH; ++t) { run += Gl[t * 64 + tid]; Gl[t * 64 + tid] = run; } }
                __syncthreads();
                for (int idx = tid; idx < CH * HD; idx += NT) { const int t = idx >> 6, k = idx & 63; GBUF[(size_t)(g0 + t) * GW + hh * 64 + k] = Gl[idx]; }
                for (int idx = tid; idx < HD * HD; idx += NT) {
                    const int k = idx >> 6, vv = idx & 63; const float gl = Gl[63 * 64 + k]; float acc = 0.f;
                    for (int s = 0; s < CH; ++s) acc += kkl[s * 64 + k] * __expf(gl - Gl[s * 64 + k]) * vl[s * 64 + vv];
                    DS[((size_t)(ci * 4 + hh) * 64 + k) * 64 + vv] = acc;
                }
                if (tid < HD) DEC[(ci * 4 + hh) * 64 + tid] = __expf(Gl[63 * 64 + tid]);
                __syncthreads();
            }
        }
    } break;

    case PH_MIX2: {
        const int gt = bid * NT + tid, NGT = G * NT;
        for (int task = gt; task < 2 * 4 * 4096 + 2 * GW; task += NGT) {
            if (task < 2 * 4 * 4096) {
                const int b = task >> 14, hh = (task >> 12) & 3, kv = task & 4095, k = kv >> 6; float S = 0.f;
                for (int ch = 0; ch < CPB; ++ch) { const int ci = b * CPB + ch; const size_t idx = (size_t)(ci * 4 + hh) * 4096 + kv; const float d = DS[idx]; DS[idx] = S; S = DEC[(ci * 4 + hh) * 64 + k] * S + d; }
            } else {
                const int q = task - 2 * 4 * 4096, b = q >> 8, c = q & 255; float hp = 0.f;
                for (int ch = 0; ch < CPB; ++ch) { const int ci = b * CPB + ch; CIN[ci * GW + c] = hp; hp = CARA[ci * GW + c] * hp + CARH[ci * GW + c]; }
            }
        }
    } break;

    case PH_MIX3: {
        const float* lbp = a.in[10]; const float* norm_g = a.in[11] + L * HD; const float* pool_w = a.in[12] + L * 4 * HD * HD; const float* pool_s = a.in[13] + L * GW; const float* sconv_w = a.in[14] + L * 3 * GW;
        float* qf = ldsf; float* kk = ldsf + 4096; float* Gs = ldsf + 8192; float* vs = ldsf + 12288; float* sc = ldsf + 16384; float* Sp = ldsf + 20480; float* ol = ldsf + 24576; float* rsl = ldsf + 28672;
        float* dl = ldsf;
        for (int ci = bid; ci < NCHUNK; ci += G) {
            const int t0 = (ci % CPB) * CH, g0 = ci * CH;
            for (int idx = tid; idx < CH * GW; idx += NT) {
                const int t = idx >> 8, c = idx & 255; const size_t tok = g0 + t;
                const float h = HLOC[tok * GW + c] + CUMA[tok * GW + c] * CIN[ci * GW + c];
                const float ag = bf2f(PROJ[tok * DIN + 256 + c]);
                Y[tok * D + c] = (bf16)f2bf(h * gelu_tanh(ag));
            }
            for (int hh = 0; hh < 4; ++hh) {
                for (int idx = tid; idx < CH * HD; idx += NT) {
                    const int t = idx >> 6, k = idx & 63, c = hh * 64 + k; const size_t tok = g0 + t; const size_t row = tok * DIN;
                    const float lb = L == 0 ? 0.f : sigmoidf_(lbp[GW + c] - lbp[c]);
                    qf[idx] = siluf_(bf2f(PROJ[row + 512 + c]));
                    const float zz = bf2f(PROJ[row + 768 + c]); kk[idx] = (1.f - lb) * (1.f - sigmoidf_(zz));
                    Gs[idx] = GBUF[tok * GW + c]; vs[idx] = bf2f(PROJ[row + 1024 + c]);
                }
                for (int idx = tid; idx < HD * HD; idx += NT) Sp[idx] = DS[(size_t)(ci * 4 + hh) * 4096 + idx];
                __syncthreads();
                for (int idx = tid; idx < CH * CH; idx += NT) {
                    const int t = idx >> 6, s = idx & 63; float acc = 0.f;
                    if (s <= t) for (int k = 0; k < HD; ++k) acc += qf[t * 64 + k] * kk[s * 64 + k] * __expf(Gs[t * 64 + k] - Gs[s * 64 + k]);
                    sc[idx] = acc;
                }
                __syncthreads();
                for (int idx = tid; idx < CH * HD; idx += NT) {
                    const int t = idx >> 6, vv = idx & 63; float acc = 0.f;
                    for (int s = 0; s <= t; ++s) acc += sc[t * 64 + s] * vs[s * 64 + vv];
                    for (int k = 0; k < HD; ++k) acc += qf[t * 64 + k] * __expf(Gs[t * 64 + k]) * Sp[k * 64 + vv];
                    ol[idx] = acc;
                }
                __syncthreads();
                if (tid < CH) { float ms = 0.f; for (int vv = 0; vv < HD; ++vv) { const float o = ol[tid * 64 + vv]; ms += o * o; } rsl[tid] = 1.0f / sqrtf(ms * (1.0f / HD) + 1e-5f); }
                __syncthreads();
                for (int idx = tid; idx < CH * HD; idx += NT) {
                    const int t = idx >> 6, vv = idx & 63; const size_t tok = g0 + t;
                    const float og = bf2f(PROJ[tok * DIN + 1280 + hh * 64 + vv]);
                    Y[tok * D + 256 + hh * 64 + vv] = (bf16)f2bf(ol[idx] * rsl[t] * norm_g[vv] * siluf_(og));
                }
                __syncthreads();
            }
            for (int idx = tid; idx < CH * GW; idx += NT) {
                const int t = idx >> 8, c = idx & 255, gi = c >> 6, w = 2 << gi; const int tt = t0 + t; const size_t tok = g0 + t;
                const int cnt = (tt + 1 < w) ? (tt + 1) : w; float sum = 0.f;
                for (int r = 0; r < cnt; ++r) sum += bf2f(PROJ[(tok - r) * DIN + 1536 + c]);
                dl[idx] = sum / (float)cnt - bf2f(PROJ[tok * DIN + 1536 + c]);
            }
            __syncthreads();
            for (int idx = tid; idx < CH * GW; idx += NT) {
                const int t = idx >> 8, c = idx & 255, gi = c >> 6, j = c & 63; const size_t tok = g0 + t; float acc = 0.f;
                for (int i = 0; i < HD; ++i) acc += dl[t * GW + gi * 64 + i] * pool_w[(gi * 64 + i) * 64 + j];
                Y[tok * D + 512 + c] = (bf16)f2bf(acc * pool_s[c]);
            }
            for (int idx = tid; idx < CH * GW; idx += NT) {
                const int t = idx >> 8, c = idx & 255; const int tt = t0 + t; const size_t tok = g0 + t; float acc = 0.f;
#pragma unroll
                for (int k = 0; k < 3; ++k) { const int d = 2 - k; if (tt - d >= 0) { const size_t r = (tok - d) * DIN; acc += sconv_w[k * GW + c] * bf2f(PROJ[r + 2048 + c]) * bf2f(PROJ[r + 2304 + c]); } }
                Y[tok * D + 768 + c] = (bf16)f2bf(bf2f(PROJ[tok * DIN + 1792 + c]) * acc);
            }
            __syncthreads();
        }
    } break;

    case PH_OUTPROJ: {
        const bf16* Bt = (const bf16*)(ws + WS_WOUT) + (size_t)L * D * D; EpiResid E{L == 0 ? a.in[0] : hres, hres};
        constexpr int NN = D / 128, NU = (NTOK / 128) * NN;
        for (int u = bid; u < NU; u += G) { const int pm = u / NN, pn = u % NN; gemm_tile<false>(Y, D, nullptr, pm * 128, Bt + (size_t)pn * 128 * D, D, D, E, pn * 128); }
    } break;

    case PH_NORM: {
        const float* g = a.pass == 0 ? a.in[16] + L * D : a.in[15] + D;
        const bool route = (L == 1 && a.pass == 0);
        int* sel = (int*)lds_raw;
        const float* wr_ = a.in[20];
        for (int blk = bid; blk < NTOK / 64; blk += G) {
            for (int r8 = 0; r8 < 8; ++r8) {
                const int tl = wid * 8 + r8, m = blk * 64 + tl;
                const f32x4* xr = (const f32x4*)(hres + (size_t)m * D); const f32x4* gr = (const f32x4*)g;
                f32x4 v[4]; float s = 0.f;
#pragma unroll
                for (int j = 0; j < 4; ++j) { v[j] = xr[lane + 64 * j]; s += (v[j].x * v[j].x + v[j].y * v[j].y) + (v[j].z * v[j].z + v[j].w * v[j].w); }
                const float r = 1.0f / sqrtf(wave_sum(s) * (1.0f / D) + 1e-6f);
                u32x2* o8 = (u32x2*)(HN + (size_t)m * D);
                float lg[8] = {0.f, 0.f, 0.f, 0.f, 0.f, 0.f, 0.f, 0.f};
#pragma unroll
                for (int j = 0; j < 4; ++j) {
                    const f32x4 gv = gr[lane + 64 * j]; const f32x4 y = (f32x4){v[j].x * r * gv.x, v[j].y * r * gv.y, v[j].z * r * gv.z, v[j].w * r * gv.w};
                    u32x2 w; w.x = pk2(y.x, y.y); w.y = pk2(y.z, y.w); o8[lane + 64 * j] = w;
                    if (route) {
                        const int i0 = 4 * (lane + 64 * j);
#pragma unroll
                        for (int q = 0; q < 4; ++q) { const float yv = q == 0 ? y.x : q == 1 ? y.y : q == 2 ? y.z : y.w; const f32x4 w0 = *(const f32x4*)(wr_ + (size_t)(i0 + q) * 8), w1 = *(const f32x4*)(wr_ + (size_t)(i0 + q) * 8 + 4);
                            lg[0] += yv * w0.x; lg[1] += yv * w0.y; lg[2] += yv * w0.z; lg[3] += yv * w0.w; lg[4] += yv * w1.x; lg[5] += yv * w1.y; lg[6] += yv * w1.z; lg[7] += yv * w1.w; }
                    }
                }
                if (route) {
#pragma unroll
                    for (int e = 0; e < 8; ++e) lg[e] = wave_sum(lg[e]);
                    if (lane == 0) {
                        int e1 = 0; float l1 = lg[0];
#pragma unroll
                        for (int e = 1; e < 8; ++e) if (lg[e] > l1) { l1 = lg[e]; e1 = e; }
                        int e2 = -1; float l2 = -3.0e38f;
#pragma unroll
                        for (int e = 0; e < 8; ++e) if (e != e1 && lg[e] > l2) { l2 = lg[e]; e2 = e; }
                        const float g1 = 1.0f / (1.0f + __expf(l2 - l1));
                        TOKE[m * 2] = e1; TOKE[m * 2 + 1] = e2; TOKG[m * 2] = g1; TOKG[m * 2 + 1] = 1.0f - g1;
                        sel[tl * 2] = e1; sel[tl * 2 + 1] = e2;
                    }
                }
            }
            if (route) {
                __syncthreads();
                if (tid < NE) { int cnt = 0; for (int q = 0; q < 128; ++q) if (sel[q] == tid) { TOKR[blk * 128 + q] = cnt; ++cnt; } BCNT[blk * NE + tid] = cnt; }
                __syncthreads();
            }
        }
    } break;

    case PH_FFNUP: {
        const bf16* Bt = (const bf16*)(ws + WS_WGU); EpiSwiglu E{HID, DFF, 0};
        constexpr int NN = DFF / 128, NU = (NTOK / 128) * NN;
        for (int u = bid; u < NU; u += G) { const int pm = u / NN, pn = u % NN; gemm_tile<true>(HN, D, nullptr, pm * 128, Bt + (size_t)pn * 256 * D, D, D, E, pn * 128); }
    } break;

    case PH_FFNDOWN: {
        const bf16* Bt = (const bf16*)(ws + WS_WD); EpiResid E{hres, hres};
        constexpr int NN = D / 128, NU = (NTOK / 128) * NN;
        for (int u = bid; u < NU; u += G) { const int pm = u / NN, pn = u % NN; gemm_tile<false>(HID, DFF, nullptr, pm * 128, Bt + (size_t)pn * 128 * DFF, DFF, DFF, E, pn * 128); }
    } break;

    case PH_DISPATCH: {
        int* sh = (int*)lds_raw;
        for (int blk = bid; blk < NTOK / 64; blk += G) {
            if (tid < NE) { int tot = 0, base = 0; for (int b2 = 0; b2 < NTOK / 64; ++b2) { const int c = BCNT[b2 * NE + tid]; if (b2 < blk) base += c; tot += c; } sh[tid] = tot; sh[16 + tid] = base; sh[24 + tid] = (tot + 255) >> 8; }
            __syncthreads();
            if (tid == 0) { int acc = 0; for (int e = 0; e < NE; ++e) { sh[8 + e] = acc * 256; acc += sh[24 + e]; } sh[32] = acc; }
            __syncthreads();
            if (tid < 128) { const int m = blk * 64 + (tid >> 1); const int e = TOKE[blk * 128 + tid]; const int r = sh[8 + e] + sh[16 + e] + TOKR[blk * 128 + tid];
                ROWTOK[r] = m; ROWDST[r] = m * 2 + (tid & 1); ROWG[r] = TOKG[blk * 128 + tid]; }
            if (blk == 0) {
                for (int e = 0; e < NE; ++e) { const int lo = sh[8 + e] + sh[e], hi = sh[8 + e] + sh[24 + e] * 256; for (int r = lo + tid; r < hi; r += NT) { ROWTOK[r] = 0; ROWDST[r] = -1; ROWG[r] = 0.f; } }
                if (tid < MAXTILES) { int e = 0; for (int q = 0; q < NE; ++q) if (tid * 256 >= sh[8 + q]) e = q; TILEE[tid] = e; }
                if (tid == 0) TILEE[MAXTILES] = sh[32];
            }
            __syncthreads();
        }
    } break;

    case PH_MOEUP: {
        const int ntiles = TILEE[MAXTILES]; const int tlo = a.pass * CAPT; int thi = tlo + CAPT; if (thi > ntiles) thi = ntiles;
        if (thi > tlo) {
            EpiSwiglu E{HIDE, DFFE, tlo * 256};
            constexpr int NN = DFFE / 128; const int NU = (thi - tlo) * 2 * NN;
            for (int u = bid; u < NU; u += G) { const int pm = u / NN, pn = u % NN; const int m0 = tlo * 256 + pm * 128; const int e = TILEE[m0 >> 8];
                const bf16* Bt = (const bf16*)(ws + WS_W13) + (size_t)e * 2 * DFFE * D; gemm_tile<true>(HN, D, ROWTOK, m0, Bt + (size_t)pn * 256 * D, D, D, E, pn * 128); }
        }
    } break;

    case PH_MOEDOWN: {
        const int ntiles = TILEE[MAXTILES]; const int tlo = a.pass * CAPT; int thi = tlo + CAPT; if (thi > ntiles) thi = ntiles;
        if (thi > tlo) {
            EpiMoeDown E{OUT2, ROWDST, ROWG, tlo * 256};
            constexpr int NN = D / 128; const int NU = (thi - tlo) * 2 * NN;
            for (int u = bid; u < NU; u += G) { const int pm = u / NN, pn = u % NN; const int m0 = pm * 128; const int e = TILEE[(tlo * 256 + m0) >> 8];
                const bf16* Bt = (const bf16*)(ws + WS_W2) + (size_t)e * D * DFFE; gemm_tile<false>(HIDE, DFFE, nullptr, m0, Bt + (size_t)pn * 128 * DFFE, DFFE, DFFE, E, pn * 128); }
        }
    } break;

    case PH_FINAL: {
        const float* g = a.in[24]; const int gw = bid * 8 + wid, NGW = G * 8;
        for (int m = gw; m < NTOK; m += NGW) {
            f32x4* xr = (f32x4*)(hres + (size_t)m * D); const f32x4* gr = (const f32x4*)g;
            const u32x2* o0 = (const u32x2*)(OUT2 + (size_t)(2 * m) * D); const u32x2* o1 = (const u32x2*)(OUT2 + (size_t)(2 * m + 1) * D);
            f32x4 v[4]; float s = 0.f;
#pragma unroll
            for (int j = 0; j < 4; ++j) {
                v[j] = xr[lane + 64 * j]; const u32x2 p = o0[lane + 64 * j], q = o1[lane + 64 * j];
                v[j].x += bf2f(p.x & 0xffffu) + bf2f(q.x & 0xffffu); v[j].y += bf2f(p.x >> 16) + bf2f(q.x >> 16);
                v[j].z += bf2f(p.y & 0xffffu) + bf2f(q.y & 0xffffu); v[j].w += bf2f(p.y >> 16) + bf2f(q.y >> 16);
                s += (v[j].x * v[j].x + v[j].y * v[j].y) + (v[j].z * v[j].z + v[j].w * v[j].w);
            }
            const float r = 1.0f / sqrtf(wave_sum(s) * (1.0f / D) + 1e-6f);
#pragma unroll
            for (int j = 0; j < 4; ++j) { const f32x4 gv = gr[lane + 64 * j]; xr[lane + 64 * j] = (f32x4){v[j].x * r * gv.x, v[j].y * r * gv.y, v[j].z * r * gv.z, v[j].w * r * gv.w}; }
        }
    } break;
    }
}

constexpr int LDS_BYTES = 131072;

extern "C" void kernel_launch(void* const* d_in, const int* in_sizes, int n_in, void* d_out, int out_size, void* d_ws, size_t ws_size, hipStream_t stream) {
    static int ready = 0;
    if (ready == 0) {
        if (n_in != 25 || out_size != NTOK * D || ws_size < WS_END) { fprintf(stderr, "kernel_launch: unexpected shapes (n_in %d out %d ws %zu need %zu)\n", n_in, out_size, ws_size, (size_t)WS_END); ready = -1; return; }
        if (hipFuncSetAttribute((const void*)fwd, hipFuncAttributeMaxDynamicSharedMemorySize, LDS_BYTES) != hipSuccess) { fprintf(stderr, "kernel_launch: hipFuncSetAttribute failed\n"); ready = -1; return; }
        ready = 1;
    }
    if (ready < 0) return;
    Args a{};
    for (int i = 0; i < 25; ++i) a.in[i] = (const float*)d_in[i];
    a.out = (float*)d_out; a.ws = (unsigned char*)d_ws;
    auto run = [&](int phase, int layer, int pass, int grid) { a.phase = phase; a.layer = layer; a.pass = pass; hipLaunchKernelGGL(fwd, dim3(grid), dim3(NT), LDS_BYTES, stream, a); };
    run(PH_PROLOGUE, 0, 0, 256);
    for (int L = 0; L < 2; ++L) {
        run(PH_INPROJ, L, 0, 1024);
        run(PH_MIX1, L, 0, 256);
        run(PH_MIX2, L, 0, 65);
        run(PH_MIX3, L, 0, 256);
        run(PH_OUTPROJ, L, 0, 1024);
        run(PH_NORM, L, 0, 256);
        if (L == 0) { run(PH_FFNUP, 0, 0, 1024); run(PH_FFNDOWN, 0, 0, 1024); run(PH_NORM, 0, 1, 256); }
        else {
            run(PH_DISPATCH, 1, 0, 256);
            for (int p = 0; p < NPASS; ++p) { run(PH_MOEUP, 1, p, 1024); run(PH_MOEDOWN, 1, p, 1024); }
            run(PH_FINAL, 1, 0, 256);
        }
    }
}
```

```cpp
#include <hip/hip_runtime.h>
#include <cstdint>
#include <cstdio>

typedef unsigned short bf16;
typedef short bf16x8 __attribute__((ext_vector_type(8)));
typedef float f32x4 __attribute__((ext_vector_type(4)));
typedef unsigned u32x4 __attribute__((ext_vector_type(4)));
typedef unsigned u32x2 __attribute__((ext_vector_type(2)));

constexpr int NTOK = 16384, SEQ = 8192, D = 1024, DIN = 2560, GW = 256, HD = 64, DFF = 2816, DFFE = 3584, NE = 8;
constexpr int CH = 64, NCHUNK = NTOK / CH, CPB = SEQ / CH;
constexpr int NT = 512;
constexpr int MAXTILES = NTOK * 2 / 256 + NE;
constexpr int CAPT = 68;
constexpr int NPASS = (MAXTILES + CAPT - 1) / CAPT;

constexpr size_t MiB = 1u << 20;
constexpr size_t WS_CTL = 0;
constexpr size_t WS_SMALL = 1 * MiB;
constexpr size_t WS_WIN = 5 * MiB;
constexpr size_t WS_WOUT = 15 * MiB;
constexpr size_t WS_WGU = 19 * MiB;
constexpr size_t WS_WD = 30 * MiB;
constexpr size_t WS_W13 = 36 * MiB;
constexpr size_t WS_W2 = 148 * MiB;
constexpr size_t WS_ACT = 204 * MiB;
constexpr size_t WS_HN = WS_ACT;
constexpr size_t WS_PROJ = WS_ACT + 32 * MiB;
constexpr size_t WS_Y = WS_ACT + 112 * MiB;
constexpr size_t WS_GBUF = WS_ACT + 144 * MiB;
constexpr size_t WS_HLOC = WS_ACT + 160 * MiB;
constexpr size_t WS_CUMA = WS_ACT + 176 * MiB;
constexpr size_t WS_DS = WS_ACT + 192 * MiB;
constexpr size_t WS_HID = WS_PROJ;
constexpr size_t WS_HIDE = WS_ACT + 32 * MiB;
constexpr size_t WS_OUT2 = WS_ACT + 151 * MiB;
constexpr size_t WS_END = WS_ACT + 215 * MiB;
constexpr size_t SM_TOKE = 0;
constexpr size_t SM_TOKG = 128 * 1024;
constexpr size_t SM_TOKR = 256 * 1024;
constexpr size_t SM_BCNT = 384 * 1024;
constexpr size_t SM_ROWTOK = 400 * 1024;
constexpr size_t SM_ROWDST = 544 * 1024;
constexpr size_t SM_ROWG = 688 * 1024;
constexpr size_t SM_TILEE = 832 * 1024;
constexpr size_t SM_CARA = 1024 * 1024;
constexpr size_t SM_CARH = 1280 * 1024;
constexpr size_t SM_CIN = 1536 * 1024;
constexpr size_t SM_DEC = 1792 * 1024;

struct Args {
    const float* in[25];
    float* out;
    unsigned char* ws;
    int ph_lo, ph_hi, pad0, pad1;
};

__device__ __forceinline__ float bf2f(unsigned v) { return __uint_as_float(v << 16); }
__device__ __forceinline__ unsigned f2bf(float f) { unsigned u = __float_as_uint(f); return (u + 0x7fffu + ((u >> 16) & 1u)) >> 16; }
__device__ __forceinline__ unsigned pk2(float lo, float hi) { return f2bf(lo) | (f2bf(hi) << 16); }
__device__ __forceinline__ float sigmoidf_(float x) { return 1.0f / (1.0f + __expf(-x)); }
__device__ __forceinline__ float siluf_(float x) { return x * sigmoidf_(x); }
__device__ __forceinline__ float gelu_tanh(float x) { const float u = 0.7978845608028654f * (x + 0.044715f * x * x * x); return 0.5f * x * (1.0f + tanhf(u)); }
__device__ __forceinline__ float wave_sum(float v) {
#pragma unroll
    for (int o = 1; o < 64; o <<= 1) v += __shfl_xor(v, o);
    return v;
}
#define LDS_WAIT() asm volatile("s_waitcnt lgkmcnt(0)" ::: "memory")

__device__ __forceinline__ void cvt_item(const float* W, int K, int N, bf16* WT, int mode, int item, float* scr, int lane) {
    const int nblk = N / 32, kb = item / nblk, nb = item % nblk, k0 = 64 * kb, n0 = 32 * nb;
#pragma unroll 8
    for (int i = 0; i < 32; ++i) { const int kk = 2 * i + (lane >> 5); scr[kk * 33 + (lane & 31)] = W[(size_t)(k0 + kk) * N + n0 + (lane & 31)]; }
    LDS_WAIT();
    const int c = lane & 7;
#pragma unroll
    for (int j = 0; j < 4; ++j) {
        const int n = (lane >> 3) + 8 * j; const float* s = scr + (8 * c) * 33 + n;
        u32x4 o; o.x = pk2(s[0 * 33], s[1 * 33]); o.y = pk2(s[2 * 33], s[3 * 33]); o.z = pk2(s[4 * 33], s[5 * 33]); o.w = pk2(s[6 * 33], s[7 * 33]);
        const int nn = n0 + n; const int drow = mode == 0 ? nn : ((nn >> 7) * 256 + (nn & 127) + (mode == 2 ? 128 : 0));
        *(u32x4*)(WT + (size_t)drow * K + k0 + 8 * c) = o;
    }
    LDS_WAIT();
}

__device__ __forceinline__ void rms_row_bf16(const float* xrow, const float* g, bf16* orow, int lane) {
    const f32x4* xr = (const f32x4*)xrow; const f32x4* gr = (const f32x4*)g;
    f32x4 v[4]; float s = 0.f;
#pragma unroll
    for (int j = 0; j < 4; ++j) { v[j] = xr[lane + 64 * j]; s += (v[j].x * v[j].x + v[j].y * v[j].y) + (v[j].z * v[j].z + v[j].w * v[j].w); }
    const float r = 1.0f / sqrtf(wave_sum(s) * (1.0f / D) + 1e-6f);
    u32x2* o8 = (u32x2*)orow;
#pragma unroll
    for (int j = 0; j < 4; ++j) { const f32x4 gv = gr[lane + 64 * j]; u32x2 w; w.x = pk2(v[j].x * r * gv.x, v[j].y * r * gv.y); w.y = pk2(v[j].z * r * gv.z, v[j].w * r * gv.w); o8[lane + 64 * j] = w; }
}

template <bool DUAL, class Epi>
__device__ __forceinline__ void gemm_tile(const bf16* A, int lda, const int* rowmap, int m0, const bf16* Bt, int ldb, int K, const Epi& epi, int ncol0) {
    const int tid = threadIdx.x, wid = tid >> 6, lane = tid & 63, wr = wid >> 1, wc = wid & 1, fr = lane & 15, fq = lane >> 4;
    const bf16* pa[2]; const bf16* pb[4];
#pragma unroll
    for (int i = 0; i < 2; ++i) { const int row = m0 + 32 * wr + 16 * i + fr; const int ar = rowmap ? rowmap[row] : row; pa[i] = A + (size_t)ar * lda + 8 * fq; }
#pragma unroll
    for (int j = 0; j < 4; ++j) { const int n = 64 * wc + 16 * j + fr; pb[j] = Bt + (size_t)n * ldb + 8 * fq; }
    f32x4 acc[2][4], acu[2][4];
#pragma unroll
    for (int i = 0; i < 2; ++i)
#pragma unroll
        for (int j = 0; j < 4; ++j) { acc[i][j] = (f32x4){0.f, 0.f, 0.f, 0.f}; acu[i][j] = (f32x4){0.f, 0.f, 0.f, 0.f}; }
    for (int k = 0; k < K; k += 32) {
        bf16x8 a[2], b[4], bu[4];
#pragma unroll
        for (int i = 0; i < 2; ++i) a[i] = *(const bf16x8*)(pa[i] + k);
#pragma unroll
        for (int j = 0; j < 4; ++j) { b[j] = *(const bf16x8*)(pb[j] + k); if (DUAL) bu[j] = *(const bf16x8*)(pb[j] + (size_t)128 * ldb + k); }
#pragma unroll
        for (int i = 0; i < 2; ++i)
#pragma unroll
            for (int j = 0; j < 4; ++j) {
                acc[i][j] = __builtin_amdgcn_mfma_f32_16x16x32_bf16(b[j], a[i], acc[i][j], 0, 0, 0);
                if (DUAL) acu[i][j] = __builtin_amdgcn_mfma_f32_16x16x32_bf16(bu[j], a[i], acu[i][j], 0, 0, 0);
            }
    }
#pragma unroll
    for (int i = 0; i < 2; ++i)
#pragma unroll
        for (int j = 0; j < 4; ++j) epi(m0 + 32 * wr + 16 * i + fr, ncol0 + 64 * wc + 16 * j + 4 * fq, acc[i][j], acu[i][j]);
}

struct EpiBf16 { bf16* C; int ldc; __device__ __forceinline__ void operator()(int row, int col, f32x4 v, f32x4) const {
    u32x2 w; w.x = pk2(v.x, v.y); w.y = pk2(v.z, v.w); *(u32x2*)(C + (size_t)row * ldc + col) = w; } };
struct EpiResid { const float* base; float* out; __device__ __forceinline__ void operator()(int row, int col, f32x4 v, f32x4) const {
    const f32x4 b = *(const f32x4*)(base + (size_t)row * D + col); *(f32x4*)(out + (size_t)row * D + col) = b + v; } };
struct EpiSwiglu { bf16* C; int ldc; int row_off; __device__ __forceinline__ void operator()(int row, int col, f32x4 g, f32x4 u) const {
    u32x2 w; w.x = pk2(siluf_(g.x) * u.x, siluf_(g.y) * u.y); w.y = pk2(siluf_(g.z) * u.z, siluf_(g.w) * u.w); *(u32x2*)(C + (size_t)(row - row_off) * ldc + col) = w; } };
struct EpiMoeDown { bf16* out2; const int* rowdst; const float* rowg; int row_off; __device__ __forceinline__ void operator()(int row, int col, f32x4 v, f32x4) const {
    const int gr = row + row_off; const int d = rowdst[gr]; if (d < 0) return; const float g = rowg[gr];
    u32x2 w; w.x = pk2(g * v.x, g * v.y); w.y = pk2(g * v.z, g * v.w); *(u32x2*)(out2 + (size_t)d * D + col) = w; } };


#define LAS __attribute__((address_space(3)))
#define XB_TMO      128
#define XB_XCNT(j)  (256  + 64 * (j))
#define XB_XSUB(j)  (1280 + 64 * (j))
#define XB_XGEN(j)  (2304 + 64 * (j))
#define XB_TOP      3328
#define XB_TOPGEN   3392
#define XCD_BAR_WORDS 3456
#define XB_SPIN_CAP (1u << 22)
__device__ __forceinline__ unsigned xb_ld(unsigned* p)              { return __hip_atomic_load(p, __ATOMIC_RELAXED, __HIP_MEMORY_SCOPE_AGENT); }
__device__ __forceinline__ unsigned xb_add(unsigned* p, unsigned v) { return __hip_atomic_fetch_add(p, v, __ATOMIC_RELAXED, __HIP_MEMORY_SCOPE_AGENT); }
__device__ __forceinline__ unsigned xb_xcc_id() { return (unsigned)__builtin_amdgcn_s_getreg((3 << 11) | 20) & 0xFu; }
#define XB_SPIN(cond, bar) do { unsigned _sp = 0; while (cond) { __builtin_amdgcn_s_sleep(1); \
    if ((++_sp & 255u) == 0u) { if (xb_ld(&(bar)[XB_TMO])) break; if (_sp > XB_SPIN_CAP) { atomicAdd(&(bar)[XB_TMO], 1u); break; } } } } while (0)
struct XcdBarrier { unsigned* bar; unsigned x; volatile LAS unsigned* st; };
__device__ __forceinline__ XcdBarrier xcd_barrier_post(unsigned* bar, volatile LAS unsigned* st) {
    XcdBarrier b; b.bar = bar; b.x = xb_xcc_id(); b.st = st;
    if (threadIdx.x == 0) (void)xb_add(&bar[XB_XCNT(b.x)], 1u);
    return b;
}
__device__ __forceinline__ void xcd_barrier_complete(unsigned* bar, unsigned x, unsigned& nloc, unsigned& nx) {
    const unsigned G = gridDim.x * gridDim.y * gridDim.z;
    unsigned sum, cnt, mine, sp = 0u;
    for (;;) {
        sum = 0u; cnt = 0u; mine = 0u;
#pragma unroll
        for (unsigned j = 0; j < 16; ++j) { const unsigned c = xb_ld(&bar[XB_XCNT(j)]); sum += c; cnt += (c > 0u) ? 1u : 0u; mine = (j == x) ? c : mine; }
        if (sum == G) break;
        __builtin_amdgcn_s_sleep(1);
        if ((++sp & 255u) == 0u) { if (xb_ld(&bar[XB_TMO])) break; if (sp > XB_SPIN_CAP) { atomicAdd(&bar[XB_TMO], 1u); break; } }
    }
    nloc = mine > 0u ? mine : 1u; nx = cnt > 0u ? cnt : 1u;
}
__device__ __forceinline__ void xcd_barrier(const XcdBarrier& b) {
    asm volatile("s_waitcnt vmcnt(0)" ::: "memory");
    __syncthreads();
    if (threadIdx.x == 0) {
        unsigned* bar = b.bar;
        __builtin_amdgcn_s_waitcnt(0);
        unsigned nloc = b.st[0], nx = b.st[1];
        if (nloc == 0u) { xcd_barrier_complete(bar, b.x, nloc, nx); b.st[0] = nloc; b.st[1] = nx; }
        const unsigned old = xb_add(&bar[XB_XSUB(b.x)], 1u);
        const unsigned gen = old / nloc;
        if (old + 1u == (gen + 1u) * nloc) {
            __builtin_amdgcn_fence(__ATOMIC_RELEASE, "agent");
            asm volatile("s_waitcnt vmcnt(0)" ::: "memory");
            const unsigned og = xb_add(&bar[XB_TOP], 1u);
            const unsigned tg = og / nx;
            if (og + 1u == (tg + 1u) * nx) xb_add(&bar[XB_TOPGEN], 1u);
            else XB_SPIN(xb_ld(&bar[XB_TOPGEN]) == tg, bar);
            __builtin_amdgcn_fence(__ATOMIC_ACQUIRE, "agent");
            xb_add(&bar[XB_XGEN(b.x)], 1u);
            asm volatile("s_waitcnt vmcnt(0)" ::: "memory");
        } else {
            XB_SPIN(xb_ld(&bar[XB_XGEN(b.x)]) == gen, bar);
            __builtin_amdgcn_fence(__ATOMIC_ACQUIRE, "agent");
            asm volatile("s_waitcnt vmcnt(0)" ::: "memory");
        }
    }
    __syncthreads();
}
constexpr int RING_BYTES = 131072, MISC_OFF = RING_BYTES + 320, LDS_BYTES = 147456;
constexpr int CW_BAR = 4096;

enum Phase { PH_PROLOGUE = 0, PH_INPROJ, PH_MIX1, PH_MIX2, PH_MIX3, PH_OUTPROJ, PH_NORM, PH_FFNUP, PH_FFNDOWN, PH_DISPATCH, PH_MOEUP, PH_MOEDOWN, PH_FINAL };

__global__ void __launch_bounds__(NT) fwd(Args a) {
    extern __shared__ __attribute__((aligned(16))) unsigned char lds_raw[];
    float* ldsf = (float*)lds_raw;
    const int G = gridDim.x, bid = blockIdx.x;
    { const int tid0 = threadIdx.x; for (int u = tid0; u < (LDS_BYTES - RING_BYTES) / 4; u += NT) ((LAS unsigned*)((LAS unsigned char*)lds_raw + RING_BYTES))[u] = 0u; }
    __syncthreads();
    XcdBarrier bar = xcd_barrier_post((unsigned*)(a.ws + WS_CTL) + CW_BAR, (volatile LAS unsigned*)((LAS unsigned char*)lds_raw + MISC_OFF) + 8);

    for (int step = a.ph_lo; step < a.ph_hi; ++step) {
    int tid = threadIdx.x; asm volatile("" : "+v"(tid));
    const int lane = tid & 63, wid = tid >> 6;
    unsigned char* ws = a.ws; asm volatile("" : "+s"(ws)); unsigned char* sm = ws + WS_SMALL;
        bf16* HN = (bf16*)(ws + WS_HN); bf16* PROJ = (bf16*)(ws + WS_PROJ); bf16* Y = (bf16*)(ws + WS_Y);
    float* GBUF = (float*)(ws + WS_GBUF); float* HLOC = (float*)(ws + WS_HLOC); float* CUMA = (float*)(ws + WS_CUMA); float* DS = (float*)(ws + WS_DS);
    bf16* HID = (bf16*)(ws + WS_HID); bf16* HIDE = (bf16*)(ws + WS_HIDE); bf16* OUT2 = (bf16*)(ws + WS_OUT2);
    int* TOKE = (int*)(sm + SM_TOKE); float* TOKG = (float*)(sm + SM_TOKG); int* TOKR = (int*)(sm + SM_TOKR); int* BCNT = (int*)(sm + SM_BCNT);
    int* ROWTOK = (int*)(sm + SM_ROWTOK); int* ROWDST = (int*)(sm + SM_ROWDST); float* ROWG = (float*)(sm + SM_ROWG); int* TILEE = (int*)(sm + SM_TILEE);
    float* CARA = (float*)(sm + SM_CARA); float* CARH = (float*)(sm + SM_CARH); float* CIN = (float*)(sm + SM_CIN); float* DEC = (float*)(sm + SM_DEC);
    float* hres = a.out;
    int phase, L, pass = 0;
    if (step == 0) { phase = PH_PROLOGUE; L = 0; }
    else if (step < 10) { L = 0; const int s = step - 1; phase = s < 5 ? PH_INPROJ + s : s == 5 ? PH_NORM : s == 6 ? PH_FFNUP : s == 7 ? PH_FFNDOWN : PH_NORM; pass = (s == 8) ? 1 : 0; }
    else { L = 1; const int s = step - 10; phase = s < 5 ? PH_INPROJ + s : s == 5 ? PH_NORM : s == 6 ? PH_DISPATCH : s == 11 ? PH_FINAL : ((s - 7) & 1) ? PH_MOEDOWN : PH_MOEUP; pass = (s >= 7 && s < 11) ? ((s - 7) >> 1) : 0; }
    switch (phase) {
    case PH_PROLOGUE: {
        float* scr = ldsf + wid * (64 * 33);
        const int gw = bid * 8 + wid, NGW = G * 8;
        constexpr int I_IN = 16 * 80, I_OUT = 16 * 32, I_G = 16 * 88, I_D = 44 * 32, I_E1 = 16 * 112, I_E2 = 56 * 32;
        constexpr int T0 = 2 * I_IN, T1 = T0 + 2 * I_OUT, T2 = T1 + I_G, T3 = T2 + I_G, T4 = T3 + I_D, T5 = T4 + NE * I_E1, T6 = T5 + NE * I_E1, T7 = T6 + NE * I_E2;
        for (int it = gw; it < T7; it += NGW) {
            if (it < T0) { const int l = it / I_IN, r = it % I_IN; cvt_item(a.in[1] + (size_t)l * D * DIN, D, DIN, (bf16*)(ws + WS_WIN) + (size_t)l * DIN * D, 0, r, scr, lane); }
            else if (it < T1) { const int q = it - T0, l = q / I_OUT, r = q % I_OUT; cvt_item(a.in[2] + (size_t)l * D * D, D, D, (bf16*)(ws + WS_WOUT) + (size_t)l * D * D, 0, r, scr, lane); }
            else if (it < T2) { cvt_item(a.in[17], D, DFF, (bf16*)(ws + WS_WGU), 1, it - T1, scr, lane); }
            else if (it < T3) { cvt_item(a.in[18], D, DFF, (bf16*)(ws + WS_WGU), 2, it - T2, scr, lane); }
            else if (it < T4) { cvt_item(a.in[19], DFF, D, (bf16*)(ws + WS_WD), 0, it - T3, scr, lane); }
            else if (it < T5) { const int q = it - T4, e = q / I_E1, r = q % I_E1; cvt_item(a.in[21] + (size_t)e * D * DFFE, D, DFFE, (bf16*)(ws + WS_W13) + (size_t)e * 2 * DFFE * D, 1, r, scr, lane); }
            else if (it < T6) { const int q = it - T5, e = q / I_E1, r = q % I_E1; cvt_item(a.in[22] + (size_t)e * D * DFFE, D, DFFE, (bf16*)(ws + WS_W13) + (size_t)e * 2 * DFFE * D, 2, r, scr, lane); }
            else { const int q = it - T6, e = q / I_E2, r = q % I_E2; cvt_item(a.in[23] + (size_t)e * DFFE * D, DFFE, D, (bf16*)(ws + WS_W2) + (size_t)e * D * DFFE, 0, r, scr, lane); }
        }
        for (int m = gw; m < NTOK; m += NGW) rms_row_bf16(a.in[0] + (size_t)m * D, a.in[15], HN + (size_t)m * D, lane);
    } break;

    case PH_INPROJ: {
        const bf16* Bt = (const bf16*)(ws + WS_WIN) + (size_t)L * DIN * D; EpiBf16 E{PROJ, DIN};
        constexpr int NN = DIN / 128, NU = (NTOK / 128) * NN;
        for (int u = bid; u < NU; u += G) { const int pm = u / NN, pn = u % NN; gemm_tile<false>(HN, D, nullptr, pm * 128, Bt + (size_t)pn * 128 * D, D, D, E, pn * 128); }
    } break;

    case PH_MIX1: {
        const float* conv_w = a.in[3] + L * 4 * GW; const float* conv_b = a.in[4] + L * GW;
        const float* w_a = a.in[5] + L * 4 * HD * HD; const float* b_a = a.in[6] + L * GW; const float* w_x = a.in[7] + L * 4 * HD * HD; const float* b_x = a.in[8] + L * GW;
        const float* lam = a.in[9] + L * GW; const float* lbp = a.in[10];
        float* ain = ldsf;
        float* Gl = ldsf; float* kkl = ldsf + 4096; float* vl = ldsf + 8192;
        for (int ci = bid; ci < NCHUNK; ci += G) {
            const int b = ci / CPB, t0 = (ci % CPB) * CH, g0 = ci * CH;
            for (int idx = tid; idx < CH * GW; idx += NT) {
                const int t = idx >> 8, c = idx & 255; float acc = conv_b[c];
#pragma unroll
                for (int k = 0; k < 4; ++k) { const int tt = t0 + t - 3 + k; if (tt >= 0) acc += conv_w[k * GW + c] * bf2f(PROJ[(size_t)(b * SEQ + tt) * DIN + c]); }
                ain[idx] = acc;
            }
            __syncthreads();
            if (tid < GW) {
                const int c = tid, h = c >> 6, j = c & 63; const float sp = log1pf(__expf(-lam[c])); const float ba = b_a[c], bx = b_x[c];
                float hl = 0.f, ca = 1.f;
                for (int t = 0; t < CH; ++t) {
                    float ra = ba, rx = bx; const float* xr = ain + t * GW + h * 64;
                    for (int i = 0; i < 64; ++i) { const float xi = xr[i]; ra += xi * w_a[(h * 64 + i) * 64 + j]; rx += xi * w_x[(h * 64 + i) * 64 + j]; }
                    const float r = sigmoidf_(ra), ig = sigmoidf_(rx); const float loga = -8.0f * r * sp; const float av = __expf(loga);
                    const float mult = sqrtf(fmaxf(-expm1f(2.0f * loga), 0.f)); const float u = mult * ig * ain[t * GW + c];
                    hl = av * hl + u; ca *= av;
                    HLOC[(size_t)(g0 + t) * GW + c] = hl; CUMA[(size_t)(g0 + t) * GW + c] = ca;
                }
                CARA[ci * GW + c] = ca; CARH[ci * GW + c] = hl;
            }
            __syncthreads();
            for (int hh = 0; hh < 4; ++hh) {
                for (int idx = tid; idx < CH * HD; idx += NT) {
                    const int t = idx >> 6, k = idx & 63, c = hh * 64 + k; const size_t row = (size_t)(g0 + t) * DIN;
                    const float lb = L == 0 ? 0.f : sigmoidf_(lbp[GW + c] - lbp[c]);
                    const float zz = bf2f(PROJ[row + 768 + c]); const float sg = sigmoidf_(zz);
                    Gl[idx] = logf(lb + (1.f - lb) * sg); kkl[idx] = (1.f - lb) * (1.f - sg); vl[idx] = bf2f(PROJ[row + 1024 + c]);
                }
                __syncthreads();
                if (tid < HD) { float run = 0.f; for (int t = 0; t < CH; ++t) { run += Gl[t * 64 + tid]; Gl[t * 64 + tid] = run; } }
                __syncthreads();
                for (int idx = tid; idx < CH * HD; idx += NT) { const int t = idx >> 6, k = idx & 63; GBUF[(size_t)(g0 + t) * GW + hh * 64 + k] = Gl[idx]; }
                for (int idx = tid; idx < HD * HD; idx += NT) {
                    const int k = idx >> 6, vv = idx & 63; const float gl = Gl[63 * 64 + k]; float acc = 0.f;
                    for (int s = 0; s < CH; ++s) acc += kkl[s * 64 + k] * __expf(gl - Gl[s * 64 + k]) * vl[s * 64 + vv];
                    DS[((size_t)(ci * 4 + hh) * 64 + k) * 64 + vv] = acc;
                }
                if (tid < HD) DEC[(ci * 4 + hh) * 64 + tid] = __expf(Gl[63 * 64 + tid]);
                __syncthreads();
            }
        }
    } break;

    case PH_MIX2: {
        const int gt = bid * NT + tid, NGT = G * NT;
        for (int task = gt; task < 2 * 4 * 4096 + 2 * GW; task += NGT) {
            if (task < 2 * 4 * 4096) {
                const int b = task >> 14, hh = (task >> 12) & 3, kv = task & 4095, k = kv >> 6; float S = 0.f;
                for (int ch = 0; ch < CPB; ++ch) { const int ci = b * CPB + ch; const size_t idx = (size_t)(ci * 4 + hh) * 4096 + kv; const float d = DS[idx]; DS[idx] = S; S = DEC[(ci * 4 + hh) * 64 + k] * S + d; }
            } else {
                const int q = task - 2 * 4 * 4096, b = q >> 8, c = q & 255; float hp = 0.f;
                for (int ch = 0; ch < CPB; ++ch) { const int ci = b * CPB + ch; CIN[ci * GW + c] = hp; hp = CARA[ci * GW + c] * hp + CARH[ci * GW + c]; }
            }
        }
    } break;

    case PH_MIX3: {
        const float* lbp = a.in[10]; const float* norm_g = a.in[11] + L * HD; const float* pool_w = a.in[12] + L * 4 * HD * HD; const float* pool_s = a.in[13] + L * GW; const float* sconv_w = a.in[14] + L * 3 * GW;
        float* qf = ldsf; float* kk = ldsf + 4096; float* Gs = ldsf + 8192; float* vs = ldsf + 12288; float* sc = ldsf + 16384; float* Sp = ldsf + 20480; float* ol = ldsf + 24576; float* rsl = ldsf + 28672;
        float* dl = ldsf;
        for (int ci = bid; ci < NCHUNK; ci += G) {
            const int t0 = (ci % CPB) * CH, g0 = ci * CH;
            for (int idx = tid; idx < CH * GW; idx += NT) {
                const int t = idx >> 8, c = idx & 255; const size_t tok = g0 + t;
                const float h = HLOC[tok * GW + c] + CUMA[tok * GW + c] * CIN[ci * GW + c];
                const float ag = bf2f(PROJ[tok * DIN + 256 + c]);
                Y[tok * D + c] = (bf16)f2bf(h * gelu_tanh(ag));
            }
            for (int hh = 0; hh < 4; ++hh) {
                for (int idx = tid; idx < CH * HD; idx += NT) {
                    const int t = idx >> 6, k = idx & 63, c = hh * 64 + k; const size_t tok = g0 + t; const size_t row = tok * DIN;
                    const float lb = L == 0 ? 0.f : sigmoidf_(lbp[GW + c] - lbp[c]);
                    qf[idx] = siluf_(bf2f(PROJ[row + 512 + c]));
                    const float zz = bf2f(PROJ[row + 768 + c]); kk[idx] = (1.f - lb) * (1.f - sigmoidf_(zz));
                    Gs[idx] = GBUF[tok * GW + c]; vs[idx] = bf2f(PROJ[row + 1024 + c]);
                }
                for (int idx = tid; idx < HD * HD; idx += NT) Sp[idx] = DS[(size_t)(ci * 4 + hh) * 4096 + idx];
                __syncthreads();
                for (int idx = tid; idx < CH * CH; idx += NT) {
                    const int t = idx >> 6, s = idx & 63; float acc = 0.f;
                    if (s <= t) for (int k = 0; k < HD; ++k) acc += qf[t * 64 + k] * kk[s * 64 + k] * __expf(Gs[t * 64 + k] - Gs[s * 64 + k]);
                    sc[idx] = acc;
                }
                __syncthreads();
                for (int idx = tid; idx < CH * HD; idx += NT) {
                    const int t = idx >> 6, vv = idx & 63; float acc = 0.f;
                    for (int s = 0; s <= t; ++s) acc += sc[t * 64 + s] * vs[s * 64 + vv];
                    for (int k = 0; k < HD; ++k) acc += qf[t * 64 + k] * __expf(Gs[t * 64 + k]) * Sp[k * 64 + vv];
                    ol[idx] = acc;
                }
                __syncthreads();
                if (tid < CH) { float ms = 0.f; for (int vv = 0; vv < HD; ++vv) { const float o = ol[tid * 64 + vv]; ms += o * o; } rsl[tid] = 1.0f / sqrtf(ms * (1.0f / HD) + 1e-5f); }
                __syncthreads();
                for (int idx = tid; idx < CH * HD; idx += NT) {
                    const int t = idx >> 6, vv = idx & 63; const size_t tok = g0 + t;
                    const float og = bf2f(PROJ[tok * DIN + 1280 + hh * 64 + vv]);
                    Y[tok * D + 256 + hh * 64 + vv] = (bf16)f2bf(ol[idx] * rsl[t] * norm_g[vv] * siluf_(og));
                }
                __syncthreads();
            }
            for (int idx = tid; idx < CH * GW; idx += NT) {
                const int t = idx >> 8, c = idx & 255, gi = c >> 6, w = 2 << gi; const int tt = t0 + t; const size_t tok = g0 + t;
                const int cnt = (tt + 1 < w) ? (tt + 1) : w; float sum = 0.f;
                for (int r = 0; r < cnt; ++r) sum += bf2f(PROJ[(tok - r) * DIN + 1536 + c]);
                dl[idx] = sum / (float)cnt - bf2f(PROJ[tok * DIN + 1536 + c]);
            }
            __syncthreads();
            for (int idx = tid; idx < CH * GW; idx += NT) {
                const int t = idx >> 8, c = idx & 255, gi = c >> 6, j = c & 63; const size_t tok = g0 + t; float acc = 0.f;
                for (int i = 0; i < HD; ++i) acc += dl[t * GW + gi * 64 + i] * pool_w[(gi * 64 + i) * 64 + j];
                Y[tok * D + 512 + c] = (bf16)f2bf(acc * pool_s[c]);
            }
            for (int idx = tid; idx < CH * GW; idx += NT) {
                const int t = idx >> 8, c = idx & 255; const int tt = t0 + t; const size_t tok = g0 + t; float acc = 0.f;
#pragma unroll
                for (int k = 0; k < 3; ++k) { const int d = 2 - k; if (tt - d >= 0) { const size_t r = (tok - d) * DIN; acc += sconv_w[k * GW + c] * bf2f(PROJ[r + 2048 + c]) * bf2f(PROJ[r + 2304 + c]); } }
                Y[tok * D + 768 + c] = (bf16)f2bf(bf2f(PROJ[tok * DIN + 1792 + c]) * acc);
            }
            __syncthreads();
        }
    } break;

    case PH_OUTPROJ: {
        const bf16* Bt = (const bf16*)(ws + WS_WOUT) + (size_t)L * D * D; EpiResid E{L == 0 ? a.in[0] : hres, hres};
        constexpr int NN = D / 128, NU = (NTOK / 128) * NN;
        for (int u = bid; u < NU; u += G) { const int pm = u / NN, pn = u % NN; gemm_tile<false>(Y, D, nullptr, pm * 128, Bt + (size_t)pn * 128 * D, D, D, E, pn * 128); }
    } break;

    case PH_NORM: {
        const float* g = pass == 0 ? a.in[16] + L * D : a.in[15] + D;
        const bool route = (L == 1 && pass == 0);
        int* sel = (int*)lds_raw;
        const float* wr_ = a.in[20];
        for (int blk = bid; blk < NTOK / 64; blk += G) {
            for (int r8 = 0; r8 < 8; ++r8) {
                const int tl = wid * 8 + r8, m = blk * 64 + tl;
                const f32x4* xr = (const f32x4*)(hres + (size_t)m * D); const f32x4* gr = (const f32x4*)g;
                f32x4 v[4]; float s = 0.f;
#pragma unroll
                for (int j = 0; j < 4; ++j) { v[j] = xr[lane + 64 * j]; s += (v[j].x * v[j].x + v[j].y * v[j].y) + (v[j].z * v[j].z + v[j].w * v[j].w); }
                const float r = 1.0f / sqrtf(wave_sum(s) * (1.0f / D) + 1e-6f);
                u32x2* o8 = (u32x2*)(HN + (size_t)m * D);
                float lg[8] = {0.f, 0.f, 0.f, 0.f, 0.f, 0.f, 0.f, 0.f};
#pragma unroll
                for (int j = 0; j < 4; ++j) {
                    const f32x4 gv = gr[lane + 64 * j]; const f32x4 y = (f32x4){v[j].x * r * gv.x, v[j].y * r * gv.y, v[j].z * r * gv.z, v[j].w * r * gv.w};
                    u32x2 w; w.x = pk2(y.x, y.y); w.y = pk2(y.z, y.w); o8[lane + 64 * j] = w;
                    if (route) {
                        const int i0 = 4 * (lane + 64 * j);
#pragma unroll
                        for (int q = 0; q < 4; ++q) { const float yv = q == 0 ? y.x : q == 1 ? y.y : q == 2 ? y.z : y.w; const f32x4 w0 = *(const f32x4*)(wr_ + (size_t)(i0 + q) * 8), w1 = *(const f32x4*)(wr_ + (size_t)(i0 + q) * 8 + 4);
                            lg[0] += yv * w0.x; lg[1] += yv * w0.y; lg[2] += yv * w0.z; lg[3] += yv * w0.w; lg[4] += yv * w1.x; lg[5] += yv * w1.y; lg[6] += yv * w1.z; lg[7] += yv * w1.w; }
                    }
                }
                if (route) {
#pragma unroll
                    for (int e = 0; e < 8; ++e) lg[e] = wave_sum(lg[e]);
                    if (lane == 0) {
                        int e1 = 0; float l1 = lg[0];
#pragma unroll
                        for (int e = 1; e < 8; ++e) if (lg[e] > l1) { l1 = lg[e]; e1 = e; }
                        int e2 = -1; float l2 = -3.0e38f;
#pragma unroll
                        for (int e = 0; e < 8; ++e) if (e != e1 && lg[e] > l2) { l2 = lg[e]; e2 = e; }
                        const float g1 = 1.0f / (1.0f + __expf(l2 - l1));
                        TOKE[m * 2] = e1; TOKE[m * 2 + 1] = e2; TOKG[m * 2] = g1; TOKG[m * 2 + 1] = 1.0f - g1;
                        sel[tl * 2] = e1; sel[tl * 2 + 1] = e2;
                    }
                }
            }
            if (route) {
                __syncthreads();
                if (tid < NE) { int cnt = 0; for (int q = 0; q < 128; ++q) if (sel[q] == tid) { TOKR[blk * 128 + q] = cnt; ++cnt; } BCNT[blk * NE + tid] = cnt; }
                __syncthreads();
            }
        }
    } break;

    case PH_FFNUP: {
        const bf16* Bt = (const bf16*)(ws + WS_WGU); EpiSwiglu E{HID, DFF, 0};
        constexpr int NN = DFF / 128, NU = (NTOK / 128) * NN;
        for (int u = bid; u < NU; u += G) { const int pm = u / NN, pn = u % NN; gemm_tile<true>(HN, D, nullptr, pm * 128, Bt + (size_t)pn * 256 * D, D, D, E, pn * 128); }
    } break;

    case PH_FFNDOWN: {
        const bf16* Bt = (const bf16*)(ws + WS_WD); EpiResid E{hres, hres};
        constexpr int NN = D / 128, NU = (NTOK / 128) * NN;
        for (int u = bid; u < NU; u += G) { const int pm = u / NN, pn = u % NN; gemm_tile<false>(HID, DFF, nullptr, pm * 128, Bt + (size_t)pn * 128 * DFF, DFF, DFF, E, pn * 128); }
    } break;

    case PH_DISPATCH: {
        int* sh = (int*)lds_raw;
        for (int blk = bid; blk < NTOK / 64; blk += G) {
            if (tid < NE) { int tot = 0, base = 0; for (int b2 = 0; b2 < NTOK / 64; ++b2) { const int c = BCNT[b2 * NE + tid]; if (b2 < blk) base += c; tot += c; } sh[tid] = tot; sh[16 + tid] = base; sh[24 + tid] = (tot + 255) >> 8; }
            __syncthreads();
            if (tid == 0) { int acc = 0; for (int e = 0; e < NE; ++e) { sh[8 + e] = acc * 256; acc += sh[24 + e]; } sh[32] = acc; }
            __syncthreads();
            if (tid < 128) { const int m = blk * 64 + (tid >> 1); const int e = TOKE[blk * 128 + tid]; const int r = sh[8 + e] + sh[16 + e] + TOKR[blk * 128 + tid];
                ROWTOK[r] = m; ROWDST[r] = m * 2 + (tid & 1); ROWG[r] = TOKG[blk * 128 + tid]; }
            if (blk == 0) {
                for (int e = 0; e < NE; ++e) { const int lo = sh[8 + e] + sh[e], hi = sh[8 + e] + sh[24 + e] * 256; for (int r = lo + tid; r < hi; r += NT) { ROWTOK[r] = 0; ROWDST[r] = -1; ROWG[r] = 0.f; } }
                if (tid < MAXTILES) { int e = 0; for (int q = 0; q < NE; ++q) if (tid * 256 >= sh[8 + q]) e = q; TILEE[tid] = e; }
                if (tid == 0) TILEE[MAXTILES] = sh[32];
            }
            __syncthreads();
        }
    } break;

    case PH_MOEUP: {
        const int ntiles = TILEE[MAXTILES]; const int tlo = pass * CAPT; int thi = tlo + CAPT; if (thi > ntiles) thi = ntiles;
        if (thi > tlo) {
            EpiSwiglu E{HIDE, DFFE, tlo * 256};
            constexpr int NN = DFFE / 128; const int NU = (thi - tlo) * 2 * NN;
            for (int u = bid; u < NU; u += G) { const int pm = u / NN, pn = u % NN; const int m0 = tlo * 256 + pm * 128; const int e = TILEE[m0 >> 8];
                const bf16* Bt = (const bf16*)(ws + WS_W13) + (size_t)e * 2 * DFFE * D; gemm_tile<true>(HN, D, ROWTOK, m0, Bt + (size_t)pn * 256 * D, D, D, E, pn * 128); }
        }
    } break;

    case PH_MOEDOWN: {
        const int ntiles = TILEE[MAXTILES]; const int tlo = pass * CAPT; int thi = tlo + CAPT; if (thi > ntiles) thi = ntiles;
        if (thi > tlo) {
            EpiMoeDown E{OUT2, ROWDST, ROWG, tlo * 256};
            constexpr int NN = D / 128; const int NU = (thi - tlo) * 2 * NN;
            for (int u = bid; u < NU; u += G) { const int pm = u / NN, pn = u % NN; const int m0 = pm * 128; const int e = TILEE[(tlo * 256 + m0) >> 8];
                const bf16* Bt = (const bf16*)(ws + WS_W2) + (size_t)e * D * DFFE; gemm_tile<false>(HIDE, DFFE, nullptr, m0, Bt + (size_t)pn * 128 * DFFE, DFFE, DFFE, E, pn * 128); }
        }
    } break;

    case PH_FINAL: {
        const float* g = a.in[24]; const int gw = bid * 8 + wid, NGW = G * 8;
        for (int m = gw; m < NTOK; m += NGW) {
            f32x4* xr = (f32x4*)(hres + (size_t)m * D); const f32x4* gr = (const f32x4*)g;
            const u32x2* o0 = (const u32x2*)(OUT2 + (size_t)(2 * m) * D); const u32x2* o1 = (const u32x2*)(OUT2 + (size_t)(2 * m + 1) * D);
            f32x4 v[4]; float s = 0.f;
#pragma unroll
            for (int j = 0; j < 4; ++j) {
                v[j] = xr[lane + 64 * j]; const u32x2 p = o0[lane + 64 * j], q = o1[lane + 64 * j];
                v[j].x += bf2f(p.x & 0xffffu) + bf2f(q.x & 0xffffu); v[j].y += bf2f(p.x >> 16) + bf2f(q.x >> 16);
                v[j].z += bf2f(p.y & 0xffffu) + bf2f(q.y & 0xffffu); v[j].w += bf2f(p.y >> 16) + bf2f(q.y >> 16);
                s += (v[j].x * v[j].x + v[j].y * v[j].y) + (v[j].z * v[j].z + v[j].w * v[j].w);
            }
            const float r = 1.0f / sqrtf(wave_sum(s) * (1.0f / D) + 1e-6f);
#pragma unroll
            for (int j = 0; j < 4; ++j) { const f32x4 gv = gr[lane + 64 * j]; xr[lane + 64 * j] = (f32x4){v[j].x * r * gv.x, v[j].y * r * gv.y, v[j].z * r * gv.z, v[j].w * r * gv.w}; }
        }
    } break;
    }
    if (step + 1 < a.ph_hi) xcd_barrier(bar);
    }
}

constexpr int NSTEPS = 22;
#ifndef MK_PER_PHASE
#define MK_PER_PHASE 0
#endif

extern "C" void kernel_launch(void* const* d_in, const int* in_sizes, int n_in, void* d_out, int out_size, void* d_ws, size_t ws_size, hipStream_t stream) {
    static int grid = 0;
    if (grid == 0) {
        if (n_in != 25 || out_size != NTOK * D || ws_size < WS_END) { fprintf(stderr, "kernel_launch: unexpected shapes (n_in %d out %d ws %zu need %zu)\n", n_in, out_size, ws_size, (size_t)WS_END); grid = -1; return; }
        int dev = 0, cus = 0, per_cu = 0;
        if (hipGetDevice(&dev) != hipSuccess || hipDeviceGetAttribute(&cus, hipDeviceAttributeMultiprocessorCount, dev) != hipSuccess) { grid = -1; return; }
        if (hipFuncSetAttribute((const void*)fwd, hipFuncAttributeMaxDynamicSharedMemorySize, LDS_BYTES) != hipSuccess) { fprintf(stderr, "kernel_launch: hipFuncSetAttribute failed\n"); grid = -1; return; }
        if (hipOccupancyMaxActiveBlocksPerMultiprocessor(&per_cu, (const void*)fwd, NT, LDS_BYTES) != hipSuccess || per_cu < 1) { fprintf(stderr, "kernel_launch: occupancy query says %d blocks/CU\n", per_cu); (void)hipGetLastError(); grid = -1; return; }
        grid = cus;
    }
    if (grid < 0) return;
    hipMemsetAsync((char*)d_ws + WS_CTL, 0, 1 * MiB, stream);
    Args a{};
    for (int i = 0; i < 25; ++i) a.in[i] = (const float*)d_in[i];
    a.out = (float*)d_out; a.ws = (unsigned char*)d_ws;
#if MK_PER_PHASE
    for (int s = 0; s < NSTEPS; ++s) { a.ph_lo = s; a.ph_hi = s + 1; hipLaunchKernelGGL(fwd, dim3(grid), dim3(NT), LDS_BYTES, stream, a); }
#else
    a.ph_lo = 0; a.ph_hi = NSTEPS;
    hipLaunchKernelGGL(fwd, dim3(grid), dim3(NT), LDS_BYTES, stream, a);
#endif
}
```

```cpp
#include <hip/hip_runtime.h>
#include <cstdint>
#include <cstdio>

typedef unsigned short bf16;
typedef short bf16x8 __attribute__((ext_vector_type(8)));
typedef float f32x4 __attribute__((ext_vector_type(4)));
typedef unsigned u32x4 __attribute__((ext_vector_type(4)));
typedef unsigned u32x2 __attribute__((ext_vector_type(2)));

constexpr int NTOK = 16384, SEQ = 8192, D = 1024, DIN = 2560, GW = 256, HD = 64, DFF = 2816, DFFE = 3584, NE = 8;
constexpr int CH = 64, NCHUNK = NTOK / CH, CPB = SEQ / CH;
constexpr int NT = 512;
constexpr int MAXTILES = NTOK * 2 / 256 + NE;
constexpr int CAPT = 68;
constexpr int NPASS = (MAXTILES + CAPT - 1) / CAPT;

constexpr size_t MiB = 1u << 20;
constexpr size_t WS_CTL = 0;
constexpr size_t WS_SMALL = 1 * MiB;
constexpr size_t WS_WIN = 5 * MiB;
constexpr size_t WS_WOUT = 15 * MiB;
constexpr size_t WS_WGU = 19 * MiB;
constexpr size_t WS_WD = 30 * MiB;
constexpr size_t WS_W13 = 36 * MiB;
constexpr size_t WS_W2 = 148 * MiB;
constexpr size_t WS_ACT = 204 * MiB;
constexpr size_t WS_HN = WS_ACT;
constexpr size_t WS_PROJ = WS_ACT + 32 * MiB;
constexpr size_t WS_Y = WS_ACT + 112 * MiB;
constexpr size_t WS_GBUF = WS_ACT + 144 * MiB;
constexpr size_t WS_HLOC = WS_ACT + 160 * MiB;
constexpr size_t WS_CUMA = WS_ACT + 176 * MiB;
constexpr size_t WS_DS = WS_ACT + 192 * MiB;
constexpr size_t WS_HID = WS_PROJ;
constexpr size_t WS_XR = WS_ACT;
constexpr size_t WS_HIDE = WS_ACT + 68 * MiB;
constexpr size_t WS_OUT2 = WS_ACT + 187 * MiB;
constexpr size_t WS_END = WS_ACT + 251 * MiB;
constexpr size_t SM_TOKE = 0;
constexpr size_t SM_TOKG = 128 * 1024;
constexpr size_t SM_TOKR = 256 * 1024;
constexpr size_t SM_BCNT = 384 * 1024;
constexpr size_t SM_ROWTOK = 400 * 1024;
constexpr size_t SM_ROWDST = 544 * 1024;
constexpr size_t SM_ROWG = 688 * 1024;
constexpr size_t SM_TILEE = 832 * 1024;
constexpr size_t SM_CARA = 1024 * 1024;
constexpr size_t SM_CARH = 1280 * 1024;
constexpr size_t SM_CIN = 1536 * 1024;
constexpr size_t SM_DEC = 1792 * 1024;
constexpr size_t SM_RSTD = 2048 * 1024;

struct Args {
    const float* in[25];
    float* out;
    unsigned char* ws;
    int ph_lo, ph_hi, pad0, pad1;
};

__device__ __forceinline__ float bf2f(unsigned v) { return __uint_as_float(v << 16); }
__device__ __forceinline__ unsigned f2bf(float f) { unsigned u = __float_as_uint(f); return (u + 0x7fffu + ((u >> 16) & 1u)) >> 16; }
__device__ __forceinline__ unsigned pk2(float lo, float hi) { return f2bf(lo) | (f2bf(hi) << 16); }
__device__ __forceinline__ float sigmoidf_(float x) { return 1.0f / (1.0f + __expf(-x)); }
__device__ __forceinline__ float siluf_(float x) { return x * sigmoidf_(x); }
__device__ __forceinline__ float gelu_tanh(float x) { const float u = 0.7978845608028654f * (x + 0.044715f * x * x * x); return 0.5f * x * (1.0f + tanhf(u)); }
__device__ __forceinline__ float wave_sum(float v) {
#pragma unroll
    for (int o = 1; o < 64; o <<= 1) v += __shfl_xor(v, o);
    return v;
}
#define LDS_WAIT() asm volatile("s_waitcnt lgkmcnt(0)" ::: "memory")

namespace pg8 {
#define PG8_LAS __attribute__((address_space(3)))
typedef unsigned short bf16_t;
typedef short bf16x8 __attribute__((ext_vector_type(8)));
typedef float f32x4 __attribute__((ext_vector_type(4)));
typedef unsigned u32x4 __attribute__((ext_vector_type(4)));
constexpr int BM = 256, BK = 64, HALF = 128, HTB = HALF * BK * 2  , STAGE_BYTES = 8 * HTB, NXCD = 8, WGM = 8;

__host__ __device__ __forceinline__ int lds_byte(int r, int c) { const int st = (r >> 4) * 2 + (c >> 5), rr = r & 15, cc = c & 31, ob = rr * 64 + cc * 2; return st * 1024 + (ob ^ (((ob >> 9) & 1) << 5)); }
__host__ __device__ __forceinline__ void stage_rc(int b, int& R, int& C) { const int st = b / 1024, sb = b % 1024, swz = sb ^ (((sb >> 9) & 1) << 5); R = (st >> 1) * 16 + swz / 64; C = (st & 1) * 32 + (swz % 64) / 2; }
__host__ __device__ __forceinline__ int perm32(int rho) { const int n = rho >> 4, i = rho & 15; return 8 * (i >> 2) + 4 * n + (i & 3); }

struct Unit { int pm, pn, pa, pb; };
struct Gemm { const bf16_t* A; const bf16_t* Bt; int M, N, K; };

struct StaticOrder {
    int nM, nN, nwg, G, c;
    __host__ __device__ void init(int M, int N, int G_, int c_) { nM = M / BM; nN = N / BM; nwg = nM * nN; G = G_; c = c_; }
    __host__ __device__ bool next(int i, Unit& u) const {
        const long L = (long)i * G + c; if (L >= nwg) return false;
        int wgid = (int)L; { const int q = nwg / NXCD, r = nwg % NXCD, xcd = wgid % NXCD, off = wgid / NXCD; wgid = (xcd < r ? xcd * (q + 1) : r * (q + 1) + (xcd - r) * q) + off; }
        const int nig = WGM * nN, gid = wgid / nig, fm = gid * WGM, gsz = (nM - fm) < WGM ? (nM - fm) : WGM;
        u.pm = fm + ((wgid % nig) % gsz); u.pn = (wgid % nig) / gsz; u.pa = u.pm; u.pb = u.pn; return true;
    }
    __device__ __forceinline__ void a_ready(const Unit&) const {}
    __device__ __forceinline__ void done(const Unit&) const {}
};

__device__ __forceinline__ unsigned cvt_pk_bf16(float lo, float hi) { unsigned r; asm volatile("v_cvt_pk_bf16_f32 %0, %1, %2" : "=v"(r) : "v"(lo), "v"(hi)); return r; }
typedef float f32x2 __attribute__((ext_vector_type(2)));
template <class Epi, class Sched, bool ALIGN_EPI = false, bool SP2 = false>
__device__ __forceinline__ void gemm_phase(PG8_LAS unsigned char* lds, const Gemm g, const Sched& S, const Epi& E) {
    int tid = threadIdx.x; asm volatile("" : "+v"(tid));
    const int wid = __builtin_amdgcn_readfirstlane(tid >> 6), lane = tid & 63, wr = wid >> 2, wc = wid & 3, fr = lane & 15, fq = lane >> 4;
    const int K = g.K, nt = K / BK;
    unsigned voffA[2], voffB[2];
#pragma unroll
    for (int i = 0; i < 2; ++i) { int R, C; stage_rc(tid * 16 + i * 8192, R, C); const int Rb = Epi::PERM ? ((R & ~31) + perm32(R & 31)) : R;
        voffA[i] = (unsigned)(R * K + C) * 2u; voffB[i] = (unsigned)(Rb * K + C) * 2u; }
    const size_t kstep = (size_t)(BK * 2);
    const size_t hstep = (size_t)HALF * K * 2;
    const size_t tstep = 2 * hstep;
    const unsigned ldsw = (unsigned)wid * 1024u;
    const int aoff = lds_byte(wr * 64 + fr, fq * 8), boff = lds_byte(wc * 32 + fr, fq * 8);
#define PG8_SA(b, h) (((b) * 2 + (h)) * HTB)
#define PG8_SB(b, h) ((4 + (b) * 2 + (h)) * HTB)
#define PG8_STAGE(bufoff, gbase, voff) do { _Pragma("unroll") for (int _i = 0; _i < 2; ++_i) \
        __builtin_amdgcn_global_load_lds((const unsigned*)((const char*)(gbase) + (voff)[_i]), (PG8_LAS unsigned*)(lds + (bufoff) + ldsw + _i * 8192), 16, 0, 0); } while (0)
#define PG8_LDA(dst, b, h) do { _Pragma("unroll") for (int m = 0; m < 4; ++m) _Pragma("unroll") for (int k = 0; k < 2; ++k) dst[m][k] = *(const PG8_LAS bf16x8*)(lds + PG8_SA(b, h) + aoff + m * 2048 + k * 1024); } while (0)
#define PG8_LDB(dst, b, h) do { _Pragma("unroll") for (int n = 0; n < 2; ++n) _Pragma("unroll") for (int k = 0; k < 2; ++k) dst[n][k] = *(const PG8_LAS bf16x8*)(lds + PG8_SB(b, h) + boff + n * 2048 + k * 1024); } while (0)
#define PG8_MMA(ai, bj, At, Bt) do { __builtin_amdgcn_s_setprio(1); _Pragma("unroll") for (int m = 0; m < 4; ++m) _Pragma("unroll") for (int n = 0; n < 2; ++n) _Pragma("unroll") for (int k = 0; k < 2; ++k) \
        acc[ai][bj][m][n] = __builtin_amdgcn_mfma_f32_16x16x32_bf16(Bt[n][k], At[m][k], acc[ai][bj][m][n], 0, 0, 0); __builtin_amdgcn_s_setprio(0); } while (0)
#define PG8_WAIT_V(n) asm volatile("s_waitcnt vmcnt(" #n ")" ::: "memory")
#define PG8_WAIT_L(n) asm volatile("s_waitcnt lgkmcnt(" #n ")" ::: "memory")
#define PG8_BAR __builtin_amdgcn_s_barrier()
#define PG8_SCHED __builtin_amdgcn_sched_barrier(0)
    Unit cur, nxt; int ui = 0;
    if (!S.next(0, cur)) return;
    f32x4 acc[2][2][4][2];
#pragma unroll
    for (int a = 0; a < 2; ++a)
#pragma unroll
        for (int b = 0; b < 2; ++b)
#pragma unroll
            for (int m = 0; m < 4; ++m)
#pragma unroll
                for (int n = 0; n < 2; ++n) acc[a][b][m][n] = (f32x4){0.f, 0.f, 0.f, 0.f};
    bf16x8 At[4][2], B0[2][2], B1[2][2];
    const char* cA = (const char*)g.A + (size_t)cur.pa * tstep; const char* cB = (const char*)g.Bt + (size_t)cur.pb * tstep;
    S.a_ready(cur);
    if constexpr (SP2) {
        PG8_STAGE(PG8_SB(0, 0), cB, voffB); PG8_STAGE(PG8_SB(0, 1), cB + hstep, voffB); PG8_STAGE(PG8_SA(0, 0), cA, voffA); PG8_STAGE(PG8_SA(0, 1), cA + hstep, voffA);
        if (wr == 1) PG8_BAR;
        PG8_WAIT_V(2); PG8_BAR;
        PG8_STAGE(PG8_SB(1, 0), cB + kstep, voffB); PG8_STAGE(PG8_SA(1, 0), cA + kstep, voffA); PG8_STAGE(PG8_SB(1, 1), cB + hstep + kstep, voffB);
        PG8_WAIT_V(6); PG8_BAR;
    } else {
        PG8_STAGE(PG8_SB(0, 0), cB, voffB); PG8_STAGE(PG8_SA(0, 0), cA, voffA); PG8_STAGE(PG8_SB(0, 1), cB + hstep, voffB); PG8_STAGE(PG8_SA(0, 1), cA + hstep, voffA);
        if (wr == 1) PG8_BAR;
        PG8_WAIT_V(4); PG8_BAR;
        PG8_STAGE(PG8_SB(1, 0), cB + kstep, voffB); PG8_STAGE(PG8_SA(1, 0), cA + kstep, voffA); PG8_STAGE(PG8_SB(1, 1), cB + hstep + kstep, voffB);
        PG8_WAIT_V(6); PG8_BAR;
    }
    for (;;) {
        const bool has_next = S.next(ui + 1, nxt);
        const char* nA = has_next ? (const char*)g.A + (size_t)nxt.pa * tstep : cA; const char* nB = has_next ? (const char*)g.Bt + (size_t)nxt.pb * tstep : cB;
        for (int t = 0; t < nt; t += 2) {
            const bool last = (t == nt - 2);
            const char* a1 = cA + (size_t)(t + 1) * kstep;
            const char* a2 = last ? nA : cA + (size_t)(t + 2) * kstep; const char* b2 = last ? nB : cB + (size_t)(t + 2) * kstep;
            const char* a3 = a2 + kstep; const char* b3 = b2 + kstep;
            if (last && has_next) S.a_ready(nxt);
            if constexpr (SP2) {
            PG8_LDB(B0, 0, 0); PG8_LDB(B1, 0, 1); PG8_SCHED; PG8_LDA(At, 0, 0); PG8_STAGE(PG8_SA(1, 1), a1 + hstep, voffA);
            PG8_WAIT_V(8); PG8_WAIT_L(0); PG8_BAR; PG8_MMA(0, 0, At, B0); PG8_MMA(0, 1, At, B1); PG8_BAR; PG8_SCHED;
            PG8_LDA(At, 0, 1); PG8_STAGE(PG8_SB(0, 0), b2, voffB); PG8_STAGE(PG8_SB(0, 1), b2 + hstep, voffB); PG8_STAGE(PG8_SA(0, 0), a2, voffA);
            PG8_WAIT_V(8); PG8_WAIT_L(0); PG8_BAR; PG8_MMA(1, 0, At, B0); PG8_MMA(1, 1, At, B1); PG8_BAR; PG8_SCHED;
            PG8_LDB(B0, 1, 0); PG8_LDB(B1, 1, 1); PG8_SCHED; PG8_LDA(At, 1, 0); PG8_STAGE(PG8_SA(0, 1), a2 + hstep, voffA);
            PG8_WAIT_V(8); PG8_WAIT_L(0); PG8_BAR; PG8_MMA(0, 0, At, B0); PG8_MMA(0, 1, At, B1); PG8_BAR; PG8_SCHED;
            PG8_LDA(At, 1, 1); PG8_STAGE(PG8_SB(1, 0), b3, voffB); PG8_STAGE(PG8_SB(1, 1), b3 + hstep, voffB); PG8_STAGE(PG8_SA(1, 0), a3, voffA);
            PG8_WAIT_V(8); PG8_WAIT_L(0); PG8_BAR; PG8_MMA(1, 0, At, B0); PG8_MMA(1, 1, At, B1); PG8_BAR; PG8_SCHED;
            } else {
            PG8_LDB(B0, 0, 0); PG8_SCHED; PG8_LDA(At, 0, 0); PG8_STAGE(PG8_SA(1, 1), a1 + hstep, voffA);
            PG8_WAIT_L(8); PG8_BAR; PG8_WAIT_L(0); PG8_MMA(0, 0, At, B0); PG8_BAR; PG8_SCHED;
            PG8_LDB(B1, 0, 1); PG8_STAGE(PG8_SB(0, 0), b2, voffB);
            PG8_BAR; PG8_WAIT_L(0); PG8_MMA(0, 1, At, B1); PG8_BAR;
            PG8_LDA(At, 0, 1); PG8_STAGE(PG8_SA(0, 0), a2, voffA);
            PG8_BAR; PG8_WAIT_L(0); PG8_MMA(1, 0, At, B0); PG8_BAR; PG8_SCHED;
            PG8_STAGE(PG8_SB(0, 1), b2 + hstep, voffB);
            PG8_WAIT_V(6); PG8_BAR; PG8_MMA(1, 1, At, B1); PG8_BAR;
            PG8_LDB(B0, 1, 0); PG8_SCHED; PG8_LDA(At, 1, 0); PG8_STAGE(PG8_SA(0, 1), a2 + hstep, voffA);
            PG8_WAIT_L(8); PG8_BAR; PG8_WAIT_L(0); PG8_MMA(0, 0, At, B0); PG8_BAR; PG8_SCHED;
            PG8_LDB(B1, 1, 1); PG8_STAGE(PG8_SB(1, 0), b3, voffB);
            PG8_BAR; PG8_WAIT_L(0); PG8_MMA(0, 1, At, B1); PG8_BAR;
            PG8_LDA(At, 1, 1); PG8_STAGE(PG8_SA(1, 0), a3, voffA);
            PG8_BAR; PG8_WAIT_L(0); PG8_MMA(1, 0, At, B0); PG8_BAR; PG8_SCHED;
            PG8_STAGE(PG8_SB(1, 1), b3 + hstep, voffB);
            PG8_WAIT_V(6); PG8_BAR; PG8_MMA(1, 1, At, B1); PG8_BAR;
            }
        }
        if constexpr (ALIGN_EPI) { if (wr == 0) PG8_BAR; }
        if constexpr (!Epi::AFTER_DRAIN) { E(acc, cur, wr, wc, fr, fq); S.done(cur); }
        if (!has_next) break;
#pragma unroll
        for (int a = 0; a < 2; ++a)
#pragma unroll
            for (int b = 0; b < 2; ++b)
#pragma unroll
                for (int m = 0; m < 4; ++m)
#pragma unroll
                    for (int n = 0; n < 2; ++n) acc[a][b][m][n] = (f32x4){0.f, 0.f, 0.f, 0.f};
        cur = nxt; cA = nA; cB = nB; ++ui;
        if constexpr (ALIGN_EPI) { if (wr == 1) PG8_BAR; }
    }
    PG8_WAIT_V(0);
    if constexpr (!ALIGN_EPI) { if (wr == 0) PG8_BAR; }
    PG8_BAR;
    if constexpr (Epi::AFTER_DRAIN) { E.fused(acc, cur, wr, wc, fr, fq, lds, wid, lane); S.done(cur); }
#undef PG8_SA
#undef PG8_SB
#undef PG8_STAGE
#undef PG8_LDA
#undef PG8_LDB
#undef PG8_MMA
#undef PG8_WAIT_V
#undef PG8_WAIT_L
#undef PG8_BAR
#undef PG8_SCHED
}

struct EpiStoreBf16 {
    static constexpr bool PERM = true, AFTER_DRAIN = false;
    bf16_t* O; int ldc;
    __device__ __forceinline__ void operator()(const f32x4 (&acc)[2][2][4][2], const Unit& u, int wr, int wc, int fr, int fq) const {
        const int row0 = u.pm * BM + wr * 64 + fr, col0 = u.pn * BM + wc * 32 + 8 * fq;
#pragma unroll
        for (int ai = 0; ai < 2; ++ai)
#pragma unroll
            for (int m = 0; m < 4; ++m) { bf16_t* rowp = O + (size_t)(row0 + ai * HALF + m * 16) * ldc + col0;
#pragma unroll
                for (int bj = 0; bj < 2; ++bj) { const f32x4 v0 = acc[ai][bj][m][0], v1 = acc[ai][bj][m][1];
                    u32x4 w; w.x = cvt_pk_bf16(v0[0], v0[1]); w.y = cvt_pk_bf16(v0[2], v0[3]); w.z = cvt_pk_bf16(v1[0], v1[1]); w.w = cvt_pk_bf16(v1[2], v1[3]);
                    *(u32x4*)(rowp + bj * HALF) = w; } }
    }
};
struct EpiResidF32 {
    static constexpr bool PERM = false, AFTER_DRAIN = false;
    const float* base; float* out;
    __device__ __forceinline__ void operator()(const f32x4 (&acc)[2][2][4][2], const Unit& u, int wr, int wc, int fr, int fq) const {
        const int row0 = u.pm * BM + wr * 64 + fr, col0 = u.pn * BM + wc * 32 + 4 * fq;
#pragma unroll
        for (int ai = 0; ai < 2; ++ai)
#pragma unroll
            for (int m = 0; m < 4; ++m) { const size_t off = (size_t)(row0 + ai * HALF + m * 16) * 1024 + col0;
#pragma unroll
                for (int bj = 0; bj < 2; ++bj)
#pragma unroll
                    for (int n = 0; n < 2; ++n) { const f32x4 b = *(const f32x4*)(base + off + bj * HALF + n * 16); *(f32x4*)(out + off + bj * HALF + n * 16) = b + acc[ai][bj][m][n]; } }
    }
};
__device__ __forceinline__ float silu_f(float x) { return x * __builtin_amdgcn_rcpf(1.0f + __builtin_amdgcn_exp2f(-1.44269504089f * x)); }
struct EpiSwiglu {
    static constexpr bool PERM = true, AFTER_DRAIN = false;
    bf16_t* C; int ldc; int row_off;
    __device__ __forceinline__ void operator()(const f32x4 (&acc)[2][2][4][2], const Unit& u, int wr, int wc, int fr, int fq) const {
        const int row0 = u.pm * BM + wr * 64 + fr - row_off, col0 = u.pn * HALF + wc * 32 + 8 * fq;
#pragma unroll
        for (int ai = 0; ai < 2; ++ai)
#pragma unroll
            for (int m = 0; m < 4; ++m) { bf16_t* rowp = C + (size_t)(row0 + ai * HALF + m * 16) * ldc + col0;
                const f32x4 g0 = acc[ai][0][m][0], g1 = acc[ai][0][m][1], u0 = acc[ai][1][m][0], u1 = acc[ai][1][m][1];
                u32x4 w; w.x = cvt_pk_bf16(silu_f(g0[0]) * u0[0], silu_f(g0[1]) * u0[1]); w.y = cvt_pk_bf16(silu_f(g0[2]) * u0[2], silu_f(g0[3]) * u0[3]);
                w.z = cvt_pk_bf16(silu_f(g1[0]) * u1[0], silu_f(g1[1]) * u1[1]); w.w = cvt_pk_bf16(silu_f(g1[2]) * u1[2], silu_f(g1[3]) * u1[3]);
                *(u32x4*)rowp = w; }
    }
};
struct EpiMoeDown {
    static constexpr bool PERM = true, AFTER_DRAIN = false;
    bf16_t* out2; const int* rowdst; const float* rowg;
    __device__ __forceinline__ void operator()(const f32x4 (&acc)[2][2][4][2], const Unit& u, int wr, int wc, int fr, int fq) const {
        const int row0 = u.pm * BM + wr * 64 + fr, col0 = u.pn * BM + wc * 32 + 8 * fq;
#pragma unroll
        for (int ai = 0; ai < 2; ++ai)
#pragma unroll
            for (int m = 0; m < 4; ++m) { const int gr = row0 + ai * HALF + m * 16; const int d = rowdst[gr]; const float g = rowg[gr];
                if (d >= 0) { bf16_t* rowp = out2 + (size_t)d * 1024 + col0;
#pragma unroll
                    for (int bj = 0; bj < 2; ++bj) { const f32x4 v0 = acc[ai][bj][m][0] * g, v1 = acc[ai][bj][m][1] * g;
                        u32x4 w; w.x = cvt_pk_bf16(v0[0], v0[1]); w.y = cvt_pk_bf16(v0[2], v0[3]); w.z = cvt_pk_bf16(v1[0], v1[1]); w.w = cvt_pk_bf16(v1[2], v1[3]);
                        *(u32x4*)(rowp + bj * HALF) = w; } } }
    }
};
struct MoeOrder {
    StaticOrder so; int tlo, nN, a_off; const int* tilee;
    __device__ void init(int nrt, int nN_, int G, int c, int tlo_, int a_off_, const int* tilee_) { so.init(nrt * BM, nN_ * BM, G, c); tlo = tlo_; nN = nN_; a_off = a_off_; tilee = tilee_; }
    __device__ bool next(int i, Unit& u) const { if (!so.next(i, u)) return false; u.pm += tlo; u.pa = u.pm - a_off; const int e = __builtin_amdgcn_readfirstlane(__hip_atomic_load(tilee + u.pm, __ATOMIC_RELAXED, __HIP_MEMORY_SCOPE_AGENT)); u.pb = e * nN + u.pn; return true; }
    __device__ __forceinline__ void a_ready(const Unit&) const {}
    __device__ __forceinline__ void done(const Unit&) const {}
};
}

__device__ __forceinline__ void cvt_item(const float* W, int K, int N, bf16* WT, int mode, int item, float* scr, int lane) {
    const int nblk = N / 32, kb = item / nblk, nb = item % nblk, k0 = 64 * kb, n0 = 32 * nb;
#pragma unroll 8
    for (int i = 0; i < 32; ++i) { const int kk = 2 * i + (lane >> 5); scr[kk * 33 + (lane & 31)] = W[(size_t)(k0 + kk) * N + n0 + (lane & 31)]; }
    LDS_WAIT();
    const int c = lane & 7;
#pragma unroll
    for (int j = 0; j < 4; ++j) {
        const int n = (lane >> 3) + 8 * j; const float* s = scr + (8 * c) * 33 + n;
        u32x4 o; o.x = pk2(s[0 * 33], s[1 * 33]); o.y = pk2(s[2 * 33], s[3 * 33]); o.z = pk2(s[4 * 33], s[5 * 33]); o.w = pk2(s[6 * 33], s[7 * 33]);
        const int nn = n0 + n; const int drow = mode == 0 ? nn : ((nn >> 7) * 256 + (nn & 127) + (mode == 2 ? 128 : 0));
        *(u32x4*)(WT + (size_t)drow * K + k0 + 8 * c) = o;
    }
    LDS_WAIT();
}

__device__ __forceinline__ void rms_row_bf16(const float* xrow, const float* g, bf16* orow, int lane) {
    const f32x4* xr = (const f32x4*)xrow; const f32x4* gr = (const f32x4*)g;
    f32x4 v[4]; float s = 0.f;
#pragma unroll
    for (int j = 0; j < 4; ++j) { v[j] = xr[lane + 64 * j]; s += (v[j].x * v[j].x + v[j].y * v[j].y) + (v[j].z * v[j].z + v[j].w * v[j].w); }
    const float r = 1.0f / sqrtf(wave_sum(s) * (1.0f / D) + 1e-6f);
    u32x2* o8 = (u32x2*)orow;
#pragma unroll
    for (int j = 0; j < 4; ++j) { const f32x4 gv = gr[lane + 64 * j]; u32x2 w; w.x = pk2(v[j].x * r * gv.x, v[j].y * r * gv.y); w.y = pk2(v[j].z * r * gv.z, v[j].w * r * gv.w); o8[lane + 64 * j] = w; }
}

#define LAS __attribute__((address_space(3)))
#define XB_TMO      128
#define XB_XCNT(j)  (256  + 64 * (j))
#define XB_XSUB(j)  (1280 + 64 * (j))
#define XB_XGEN(j)  (2304 + 64 * (j))
#define XB_TOP      3328
#define XB_TOPGEN   3392
#define XCD_BAR_WORDS 3456
#define XB_SPIN_CAP (1u << 22)
__device__ __forceinline__ unsigned xb_ld(unsigned* p)              { return __hip_atomic_load(p, __ATOMIC_RELAXED, __HIP_MEMORY_SCOPE_AGENT); }
__device__ __forceinline__ unsigned xb_add(unsigned* p, unsigned v) { return __hip_atomic_fetch_add(p, v, __ATOMIC_RELAXED, __HIP_MEMORY_SCOPE_AGENT); }
__device__ __forceinline__ unsigned xb_xcc_id() { return (unsigned)__builtin_amdgcn_s_getreg((3 << 11) | 20) & 0xFu; }
#define XB_SPIN(cond, bar) do { unsigned _sp = 0; while (cond) { __builtin_amdgcn_s_sleep(1); \
    if ((++_sp & 255u) == 0u) { if (xb_ld(&(bar)[XB_TMO])) break; if (_sp > XB_SPIN_CAP) { atomicAdd(&(bar)[XB_TMO], 1u); break; } } } } while (0)
struct XcdBarrier { unsigned* bar; unsigned x; volatile LAS unsigned* st; };
__device__ __forceinline__ XcdBarrier xcd_barrier_post(unsigned* bar, volatile LAS unsigned* st) {
    XcdBarrier b; b.bar = bar; b.x = xb_xcc_id(); b.st = st;
    if (threadIdx.x == 0) (void)xb_add(&bar[XB_XCNT(b.x)], 1u);
    return b;
}
__device__ __forceinline__ void xcd_barrier_complete(unsigned* bar, unsigned x, unsigned& nloc, unsigned& nx) {
    const unsigned G = gridDim.x * gridDim.y * gridDim.z;
    unsigned sum, cnt, mine, sp = 0u;
    for (;;) {
        sum = 0u; cnt = 0u; mine = 0u;
#pragma unroll
        for (unsigned j = 0; j < 16; ++j) { const unsigned c = xb_ld(&bar[XB_XCNT(j)]); sum += c; cnt += (c > 0u) ? 1u : 0u; mine = (j == x) ? c : mine; }
        if (sum == G) break;
        __builtin_amdgcn_s_sleep(1);
        if ((++sp & 255u) == 0u) { if (xb_ld(&bar[XB_TMO])) break; if (sp > XB_SPIN_CAP) { atomicAdd(&bar[XB_TMO], 1u); break; } }
    }
    nloc = mine > 0u ? mine : 1u; nx = cnt > 0u ? cnt : 1u;
}
__device__ __forceinline__ void xcd_barrier(const XcdBarrier& b) {
    asm volatile("s_waitcnt vmcnt(0)" ::: "memory");
    __syncthreads();
    if (threadIdx.x == 0) {
        unsigned* bar = b.bar;
        __builtin_amdgcn_s_waitcnt(0);
        unsigned nloc = b.st[0], nx = b.st[1];
        if (nloc == 0u) { xcd_barrier_complete(bar, b.x, nloc, nx); b.st[0] = nloc; b.st[1] = nx; }
        const unsigned old = xb_add(&bar[XB_XSUB(b.x)], 1u);
        const unsigned gen = old / nloc;
        if (old + 1u == (gen + 1u) * nloc) {
            __builtin_amdgcn_fence(__ATOMIC_RELEASE, "agent");
            asm volatile("s_waitcnt vmcnt(0)" ::: "memory");
            const unsigned og = xb_add(&bar[XB_TOP], 1u);
            const unsigned tg = og / nx;
            if (og + 1u == (tg + 1u) * nx) xb_add(&bar[XB_TOPGEN], 1u);
            else XB_SPIN(xb_ld(&bar[XB_TOPGEN]) == tg, bar);
            __builtin_amdgcn_fence(__ATOMIC_ACQUIRE, "agent");
            xb_add(&bar[XB_XGEN(b.x)], 1u);
            asm volatile("s_waitcnt vmcnt(0)" ::: "memory");
        } else {
            XB_SPIN(xb_ld(&bar[XB_XGEN(b.x)]) == gen, bar);
            __builtin_amdgcn_fence(__ATOMIC_ACQUIRE, "agent");
            asm volatile("s_waitcnt vmcnt(0)" ::: "memory");
        }
    }
    __syncthreads();
}
constexpr int RING_BYTES = 131072, MISC_OFF = RING_BYTES + 320, LDS_BYTES = 147456;
constexpr int CW_BAR = 4096;

enum Phase { PH_PROLOGUE = 0, PH_INPROJ, PH_MIX1, PH_MIX2, PH_MIX3, PH_OUTPROJ, PH_NORM, PH_FFNUP, PH_FFNDOWN, PH_DISPATCH, PH_MOEUP, PH_MOEDOWN, PH_FINAL };

#define HN ((bf16*)(ws + WS_HN))
#define PROJ ((bf16*)(ws + WS_PROJ))
#define Y ((bf16*)(ws + WS_Y))
#define GBUF ((float*)(ws + WS_GBUF))
#define HLOC ((float*)(ws + WS_HLOC))
#define CUMA ((float*)(ws + WS_CUMA))
#define DS ((float*)(ws + WS_DS))
#define HID ((bf16*)(ws + WS_HID))
#define HIDE ((bf16*)(ws + WS_HIDE))
#define OUT2 ((bf16*)(ws + WS_OUT2))
#define XR ((bf16*)(ws + WS_XR))
#define SMALLP(T, off) ((T*)(ws + WS_SMALL + (off)))
#define RSTD SMALLP(float, SM_RSTD)
#define TOKE SMALLP(int, SM_TOKE)
#define TOKG SMALLP(float, SM_TOKG)
#define TOKR SMALLP(int, SM_TOKR)
#define BCNT SMALLP(int, SM_BCNT)
#define ROWDST SMALLP(int, SM_ROWDST)
#define ROWG SMALLP(float, SM_ROWG)
#define TILEE SMALLP(int, SM_TILEE)
#define CARA SMALLP(float, SM_CARA)
#define CARH SMALLP(float, SM_CARH)
#define CIN SMALLP(float, SM_CIN)
#define DEC SMALLP(float, SM_DEC)
#define PHASE_ENTER int tid = threadIdx.x; asm volatile("" : "+v"(tid)); const int lane = tid & 63, wid = tid >> 6; unsigned char* ws = a.ws; asm volatile("" : "+s"(ws)); float* hres = a.out; (void)lane; (void)wid; (void)hres;

__global__ void __launch_bounds__(NT) fwd(Args a) {
    extern __shared__ __attribute__((aligned(16))) unsigned char lds_raw[];
    float* ldsf = (float*)lds_raw;
    const int G = gridDim.x, bid = blockIdx.x;
    { const int tid0 = threadIdx.x; for (int u = tid0; u < (LDS_BYTES - RING_BYTES) / 4; u += NT) ((LAS unsigned*)((LAS unsigned char*)lds_raw + RING_BYTES))[u] = 0u; }
    __syncthreads();
    XcdBarrier bar = xcd_barrier_post((unsigned*)(a.ws + WS_CTL) + CW_BAR, (volatile LAS unsigned*)((LAS unsigned char*)lds_raw + MISC_OFF) + 8);

    for (int step = a.ph_lo; step < a.ph_hi; ++step) {
    int phase, L, pass = 0;
    if (step == 0) { phase = PH_PROLOGUE; L = 0; }
    else if (step < 10) { L = 0; const int s = step - 1; phase = s < 5 ? PH_INPROJ + s : s == 5 ? PH_NORM : s == 6 ? PH_FFNUP : s == 7 ? PH_FFNDOWN : PH_NORM; pass = (s == 8) ? 1 : 0; }
    else { L = 1; const int s = step - 10; phase = s < 5 ? PH_INPROJ + s : s == 5 ? PH_NORM : s == 6 ? PH_DISPATCH : s == 11 ? PH_FINAL : ((s - 7) & 1) ? PH_MOEDOWN : PH_MOEUP; pass = (s >= 7 && s < 11) ? ((s - 7) >> 1) : 0; }
    switch (phase) {
    case PH_PROLOGUE: {
        PHASE_ENTER
        float* scr = ldsf + wid * (64 * 33);
        const int gw = bid * 8 + wid, NGW = G * 8;
        constexpr int I_IN = 16 * 80, I_OUT = 16 * 32, I_G = 16 * 88, I_D = 44 * 32, I_E1 = 16 * 112, I_E2 = 56 * 32;
        constexpr int T0 = 2 * I_IN, T1 = T0 + 2 * I_OUT, T2 = T1 + I_G, T3 = T2 + I_G, T4 = T3 + I_D, T5 = T4 + NE * I_E1, T6 = T5 + NE * I_E1, T7 = T6 + NE * I_E2;
        for (int it = gw; it < T7; it += NGW) {
            if (it < T0) { const int l = it / I_IN, r = it % I_IN; cvt_item(a.in[1] + (size_t)l * D * DIN, D, DIN, (bf16*)(ws + WS_WIN) + (size_t)l * DIN * D, 0, r, scr, lane); }
            else if (it < T1) { const int q = it - T0, l = q / I_OUT, r = q % I_OUT; cvt_item(a.in[2] + (size_t)l * D * D, D, D, (bf16*)(ws + WS_WOUT) + (size_t)l * D * D, 0, r, scr, lane); }
            else if (it < T2) { cvt_item(a.in[17], D, DFF, (bf16*)(ws + WS_WGU), 1, it - T1, scr, lane); }
            else if (it < T3) { cvt_item(a.in[18], D, DFF, (bf16*)(ws + WS_WGU), 2, it - T2, scr, lane); }
            else if (it < T4) { cvt_item(a.in[19], DFF, D, (bf16*)(ws + WS_WD), 0, it - T3, scr, lane); }
            else if (it < T5) { const int q = it - T4, e = q / I_E1, r = q % I_E1; cvt_item(a.in[21] + (size_t)e * D * DFFE, D, DFFE, (bf16*)(ws + WS_W13) + (size_t)e * 2 * DFFE * D, 1, r, scr, lane); }
            else if (it < T6) { const int q = it - T5, e = q / I_E1, r = q % I_E1; cvt_item(a.in[22] + (size_t)e * D * DFFE, D, DFFE, (bf16*)(ws + WS_W13) + (size_t)e * 2 * DFFE * D, 2, r, scr, lane); }
            else { const int q = it - T6, e = q / I_E2, r = q % I_E2; cvt_item(a.in[23] + (size_t)e * DFFE * D, DFFE, D, (bf16*)(ws + WS_W2) + (size_t)e * D * DFFE, 0, r, scr, lane); }
        }
        for (int m = gw; m < NTOK; m += NGW) rms_row_bf16(a.in[0] + (size_t)m * D, a.in[15], HN + (size_t)m * D, lane);
    } break;

    case PH_INPROJ: {
        PHASE_ENTER
        pg8::Gemm g{HN, (const bf16*)(ws + WS_WIN) + (size_t)L * DIN * D, NTOK, DIN, D}; pg8::StaticOrder S; S.init(NTOK, DIN, G, bid);
        pg8::EpiStoreBf16 E{PROJ, DIN};
        pg8::gemm_phase<pg8::EpiStoreBf16, pg8::StaticOrder, true, true>((PG8_LAS unsigned char*)lds_raw, g, S, E);
    } break;

    case PH_MIX1: {
        PHASE_ENTER
        const float* conv_w = a.in[3] + L * 4 * GW; const float* conv_b = a.in[4] + L * GW;
        const float* w_a = a.in[5] + L * 4 * HD * HD; const float* b_a = a.in[6] + L * GW; const float* w_x = a.in[7] + L * 4 * HD * HD; const float* b_x = a.in[8] + L * GW;
        const float* lam = a.in[9] + L * GW; const float* lbp = a.in[10];
        float* ain = ldsf;
        float* Gl = ldsf; float* kkl = ldsf + 4096; float* vl = ldsf + 8192;
        for (int ci = bid; ci < NCHUNK; ci += G) {
            const int b = ci / CPB, t0 = (ci % CPB) * CH, g0 = ci * CH;
            for (int idx = tid; idx < CH * GW; idx += NT) {
                const int t = idx >> 8, c = idx & 255; float acc = conv_b[c];
#pragma unroll
                for (int k = 0; k < 4; ++k) { const int tt = t0 + t - 3 + k; if (tt >= 0) acc += conv_w[k * GW + c] * bf2f(PROJ[(size_t)(b * SEQ + tt) * DIN + c]); }
                ain[idx] = acc;
            }
            __syncthreads();
            if (tid < GW) {
                const int c = tid, h = c >> 6, j = c & 63; const float sp = log1pf(__expf(-lam[c])); const float ba = b_a[c], bx = b_x[c];
                float hl = 0.f, ca = 1.f;
                for (int t = 0; t < CH; ++t) {
                    float ra = ba, rx = bx; const float* xr = ain + t * GW + h * 64;
                    for (int i = 0; i < 64; ++i) { const float xi = xr[i]; ra += xi * w_a[(h * 64 + i) * 64 + j]; rx += xi * w_x[(h * 64 + i) * 64 + j]; }
                    const float r = sigmoidf_(ra), ig = sigmoidf_(rx); const float loga = -8.0f * r * sp; const float av = __expf(loga);
                    const float mult = sqrtf(fmaxf(-expm1f(2.0f * loga), 0.f)); const float u = mult * ig * ain[t * GW + c];
                    hl = av * hl + u; ca *= av;
                    HLOC[(size_t)(g0 + t) * GW + c] = hl; CUMA[(size_t)(g0 + t) * GW + c] = ca;
                }
                CARA[ci * GW + c] = ca; CARH[ci * GW + c] = hl;
            }
            __syncthreads();
            for (int hh = 0; hh < 4; ++hh) {
                for (int idx = tid; idx < CH * HD; idx += NT) {
                    const int t = idx >> 6, k = idx & 63, c = hh * 64 + k; const size_t row = (size_t)(g0 + t) * DIN;
                    const float lb = L == 0 ? 0.f : sigmoidf_(lbp[GW + c] - lbp[c]);
                    const float zz = bf2f(PROJ[row + 768 + c]); const float sg = sigmoidf_(zz);
                    Gl[idx] = logf(lb + (1.f - lb) * sg); kkl[idx] = (1.f - lb) * (1.f - sg); vl[idx] = bf2f(PROJ[row + 1024 + c]);
                }
                __syncthreads();
                if (tid < HD) { float run = 0.f; for (int t = 0; t < CH; ++t) { run += Gl[t * 64 + tid]; Gl[t * 64 + tid] = run; } }
                __syncthreads();
                for (int idx = tid; idx < CH * HD; idx += NT) { const int t = idx >> 6, k = idx & 63; GBUF[(size_t)(g0 + t) * GW + hh * 64 + k] = Gl[idx]; }
                for (int idx = tid; idx < HD * HD; idx += NT) {
                    const int k = idx >> 6, vv = idx & 63; const float gl = Gl[63 * 64 + k]; float acc = 0.f;
                    for (int s = 0; s < CH; ++s) acc += kkl[s * 64 + k] * __expf(gl - Gl[s * 64 + k]) * vl[s * 64 + vv];
                    DS[((size_t)(ci * 4 + hh) * 64 + k) * 64 + vv] = acc;
                }
                if (tid < HD) DEC[(ci * 4 + hh) * 64 + tid] = __expf(Gl[63 * 64 + tid]);
                __syncthreads();
            }
        }
    } break;

    case PH_MIX2: {
        PHASE_ENTER
        const int gt = bid * NT + tid, NGT = G * NT;
        for (int task = gt; task < 2 * 4 * 4096 + 2 * GW; task += NGT) {
            if (task < 2 * 4 * 4096) {
                const int b = task >> 14, hh = (task >> 12) & 3, kv = task & 4095, k = kv >> 6; float S = 0.f;
                for (int ch = 0; ch < CPB; ++ch) { const int ci = b * CPB + ch; const size_t idx = (size_t)(ci * 4 + hh) * 4096 + kv; const float d = DS[idx]; DS[idx] = S; S = DEC[(ci * 4 + hh) * 64 + k] * S + d; }
            } else {
                const int q = task - 2 * 4 * 4096, b = q >> 8, c = q & 255; float hp = 0.f;
                for (int ch = 0; ch < CPB; ++ch) { const int ci = b * CPB + ch; CIN[ci * GW + c] = hp; hp = CARA[ci * GW + c] * hp + CARH[ci * GW + c]; }
            }
        }
    } break;

    case PH_MIX3: {
        PHASE_ENTER
        const float* lbp = a.in[10]; const float* norm_g = a.in[11] + L * HD; const float* pool_w = a.in[12] + L * 4 * HD * HD; const float* pool_s = a.in[13] + L * GW; const float* sconv_w = a.in[14] + L * 3 * GW;
        float* qf = ldsf; float* kk = ldsf + 4096; float* Gs = ldsf + 8192; float* vs = ldsf + 12288; float* sc = ldsf + 16384; float* Sp = ldsf + 20480; float* ol = ldsf + 24576; float* rsl = ldsf + 28672;
        float* dl = ldsf;
        for (int ci = bid; ci < NCHUNK; ci += G) {
            const int t0 = (ci % CPB) * CH, g0 = ci * CH;
            for (int idx = tid; idx < CH * GW; idx += NT) {
                const int t = idx >> 8, c = idx & 255; const size_t tok = g0 + t;
                const float h = HLOC[tok * GW + c] + CUMA[tok * GW + c] * CIN[ci * GW + c];
                const float ag = bf2f(PROJ[tok * DIN + 256 + c]);
                Y[tok * D + c] = (bf16)f2bf(h * gelu_tanh(ag));
            }
            for (int hh = 0; hh < 4; ++hh) {
                for (int idx = tid; idx < CH * HD; idx += NT) {
                    const int t = idx >> 6, k = idx & 63, c = hh * 64 + k; const size_t tok = g0 + t; const size_t row = tok * DIN;
                    const float lb = L == 0 ? 0.f : sigmoidf_(lbp[GW + c] - lbp[c]);
                    qf[idx] = siluf_(bf2f(PROJ[row + 512 + c]));
                    const float zz = bf2f(PROJ[row + 768 + c]); kk[idx] = (1.f - lb) * (1.f - sigmoidf_(zz));
                    Gs[idx] = GBUF[tok * GW + c]; vs[idx] = bf2f(PROJ[row + 1024 + c]);
                }
                for (int idx = tid; idx < HD * HD; idx += NT) Sp[idx] = DS[(size_t)(ci * 4 + hh) * 4096 + idx];
                __syncthreads();
                for (int idx = tid; idx < CH * CH; idx += NT) {
                    const int t = idx >> 6, s = idx & 63; float acc = 0.f;
                    if (s <= t) for (int k = 0; k < HD; ++k) acc += qf[t * 64 + k] * kk[s * 64 + k] * __expf(Gs[t * 64 + k] - Gs[s * 64 + k]);
                    sc[idx] = acc;
                }
                __syncthreads();
                for (int idx = tid; idx < CH * HD; idx += NT) {
                    const int t = idx >> 6, vv = idx & 63; float acc = 0.f;
                    for (int s = 0; s <= t; ++s) acc += sc[t * 64 + s] * vs[s * 64 + vv];
                    for (int k = 0; k < HD; ++k) acc += qf[t * 64 + k] * __expf(Gs[t * 64 + k]) * Sp[k * 64 + vv];
                    ol[idx] = acc;
                }
                __syncthreads();
                if (tid < CH) { float ms = 0.f; for (int vv = 0; vv < HD; ++vv) { const float o = ol[tid * 64 + vv]; ms += o * o; } rsl[tid] = 1.0f / sqrtf(ms * (1.0f / HD) + 1e-5f); }
                __syncthreads();
                for (int idx = tid; idx < CH * HD; idx += NT) {
                    const int t = idx >> 6, vv = idx & 63; const size_t tok = g0 + t;
                    const float og = bf2f(PROJ[tok * DIN + 1280 + hh * 64 + vv]);
                    Y[tok * D + 256 + hh * 64 + vv] = (bf16)f2bf(ol[idx] * rsl[t] * norm_g[vv] * siluf_(og));
                }
                __syncthreads();
            }
            for (int idx = tid; idx < CH * GW; idx += NT) {
                const int t = idx >> 8, c = idx & 255, gi = c >> 6, w = 2 << gi; const int tt = t0 + t; const size_t tok = g0 + t;
                const int cnt = (tt + 1 < w) ? (tt + 1) : w; float sum = 0.f;
                for (int r = 0; r < cnt; ++r) sum += bf2f(PROJ[(tok - r) * DIN + 1536 + c]);
                dl[idx] = sum / (float)cnt - bf2f(PROJ[tok * DIN + 1536 + c]);
            }
            __syncthreads();
            for (int idx = tid; idx < CH * GW; idx += NT) {
                const int t = idx >> 8, c = idx & 255, gi = c >> 6, j = c & 63; const size_t tok = g0 + t; float acc = 0.f;
                for (int i = 0; i < HD; ++i) acc += dl[t * GW + gi * 64 + i] * pool_w[(gi * 64 + i) * 64 + j];
                Y[tok * D + 512 + c] = (bf16)f2bf(acc * pool_s[c]);
            }
            for (int idx = tid; idx < CH * GW; idx += NT) {
                const int t = idx >> 8, c = idx & 255; const int tt = t0 + t; const size_t tok = g0 + t; float acc = 0.f;
#pragma unroll
                for (int k = 0; k < 3; ++k) { const int d = 2 - k; if (tt - d >= 0) { const size_t r = (tok - d) * DIN; acc += sconv_w[k * GW + c] * bf2f(PROJ[r + 2048 + c]) * bf2f(PROJ[r + 2304 + c]); } }
                Y[tok * D + 768 + c] = (bf16)f2bf(bf2f(PROJ[tok * DIN + 1792 + c]) * acc);
            }
            __syncthreads();
        }
    } break;

    case PH_OUTPROJ: {
        PHASE_ENTER
        pg8::Gemm g{Y, (const bf16*)(ws + WS_WOUT) + (size_t)L * D * D, NTOK, D, D}; pg8::StaticOrder S; S.init(NTOK, D, G, bid);
        pg8::EpiResidF32 E{L == 0 ? a.in[0] : hres, hres};
        pg8::gemm_phase<pg8::EpiResidF32, pg8::StaticOrder, true, true>((PG8_LAS unsigned char*)lds_raw, g, S, E);
    } break;

    case PH_NORM: {
        PHASE_ENTER
        const float* g = pass == 0 ? a.in[16] + L * D : a.in[15] + D;
        const bool route = (L == 1 && pass == 0);
        int* sel = (int*)lds_raw;
        const float* wr_ = a.in[20];
        for (int blk = bid; blk < NTOK / 64; blk += G) {
            for (int r8 = 0; r8 < 8; ++r8) {
                const int tl = wid * 8 + r8, m = blk * 64 + tl;
                const f32x4* xr = (const f32x4*)(hres + (size_t)m * D); const f32x4* gr = (const f32x4*)g;
                f32x4 v[4]; float s = 0.f;
#pragma unroll
                for (int j = 0; j < 4; ++j) { v[j] = xr[lane + 64 * j]; s += (v[j].x * v[j].x + v[j].y * v[j].y) + (v[j].z * v[j].z + v[j].w * v[j].w); }
                const float r = 1.0f / sqrtf(wave_sum(s) * (1.0f / D) + 1e-6f);
                u32x2* o8 = (u32x2*)(HN + (size_t)m * D);
                float lg[8] = {0.f, 0.f, 0.f, 0.f, 0.f, 0.f, 0.f, 0.f};
#pragma unroll
                for (int j = 0; j < 4; ++j) {
                    const f32x4 gv = gr[lane + 64 * j]; const f32x4 y = (f32x4){v[j].x * r * gv.x, v[j].y * r * gv.y, v[j].z * r * gv.z, v[j].w * r * gv.w};
                    if (!route) { u32x2 w; w.x = pk2(y.x, y.y); w.y = pk2(y.z, y.w); o8[lane + 64 * j] = w; }
                    if (route) {
                        const int i0 = 4 * (lane + 64 * j);
#pragma unroll
                        for (int q = 0; q < 4; ++q) { const float yv = q == 0 ? y.x : q == 1 ? y.y : q == 2 ? y.z : y.w; const f32x4 w0 = *(const f32x4*)(wr_ + (size_t)(i0 + q) * 8), w1 = *(const f32x4*)(wr_ + (size_t)(i0 + q) * 8 + 4);
                            lg[0] += yv * w0.x; lg[1] += yv * w0.y; lg[2] += yv * w0.z; lg[3] += yv * w0.w; lg[4] += yv * w1.x; lg[5] += yv * w1.y; lg[6] += yv * w1.z; lg[7] += yv * w1.w; }
                    }
                }
                if (route) {
#pragma unroll
                    for (int e = 0; e < 8; ++e) lg[e] = wave_sum(lg[e]);
                    if (lane == 0) {
                        int e1 = 0; float l1 = lg[0];
#pragma unroll
                        for (int e = 1; e < 8; ++e) if (lg[e] > l1) { l1 = lg[e]; e1 = e; }
                        int e2 = -1; float l2 = -3.0e38f;
#pragma unroll
                        for (int e = 0; e < 8; ++e) if (e != e1 && lg[e] > l2) { l2 = lg[e]; e2 = e; }
                        const float g1 = 1.0f / (1.0f + __expf(l2 - l1));
                        TOKE[m * 2] = e1; TOKE[m * 2 + 1] = e2; TOKG[m * 2] = g1; TOKG[m * 2 + 1] = 1.0f - g1;
                        sel[tl * 2] = e1; sel[tl * 2 + 1] = e2; RSTD[m] = r;
                    }
                }
            }
            if (route) {
                __syncthreads();
                if (tid < NE) { int cnt = 0; for (int q = 0; q < 128; ++q) if (sel[q] == tid) { TOKR[blk * 128 + q] = cnt; ++cnt; } BCNT[blk * NE + tid] = cnt; }
                __syncthreads();
            }
        }
    } break;

    case PH_FFNUP: {
        PHASE_ENTER
        pg8::Gemm g{HN, (const bf16*)(ws + WS_WGU), NTOK, 2 * DFF, D}; pg8::StaticOrder S; S.init(NTOK, 2 * DFF, G, bid);
        pg8::EpiSwiglu E{HID, DFF, 0};
        pg8::gemm_phase<pg8::EpiSwiglu, pg8::StaticOrder, true, true>((PG8_LAS unsigned char*)lds_raw, g, S, E);
    } break;

    case PH_FFNDOWN: {
        PHASE_ENTER
        pg8::Gemm g{HID, (const bf16*)(ws + WS_WD), NTOK, D, DFF}; pg8::StaticOrder S; S.init(NTOK, D, G, bid);
        pg8::EpiResidF32 E{hres, hres};
        pg8::gemm_phase<pg8::EpiResidF32, pg8::StaticOrder, true, true>((PG8_LAS unsigned char*)lds_raw, g, S, E);
    } break;

    case PH_DISPATCH: {
        PHASE_ENTER
        int* sh = (int*)lds_raw;
        const f32x4* gr = (const f32x4*)(a.in[16] + D);
        for (int blk = bid; blk < NTOK / 64; blk += G) {
            if (tid < NE) { int tot = 0, base = 0; for (int b2 = 0; b2 < NTOK / 64; ++b2) { const int c = BCNT[b2 * NE + tid]; if (b2 < blk) base += c; tot += c; } sh[tid] = tot; sh[16 + tid] = base; sh[24 + tid] = (tot + 255) >> 8; }
            __syncthreads();
            if (tid == 0) { int acc = 0; for (int e = 0; e < NE; ++e) { sh[8 + e] = acc * 256; acc += sh[24 + e]; } sh[32] = acc; }
            __syncthreads();
            if (tid < 128) { const int m = blk * 64 + (tid >> 1); const int e = TOKE[blk * 128 + tid]; const int r = sh[8 + e] + sh[16 + e] + TOKR[blk * 128 + tid];
                ROWDST[r] = m * 2 + (tid & 1); ROWG[r] = TOKG[blk * 128 + tid]; }
            for (int r8 = 0; r8 < 8; ++r8) {
                const int m = blk * 64 + wid * 8 + r8; const int e0 = TOKE[m * 2], e1 = TOKE[m * 2 + 1];
                const int r0 = sh[8 + e0] + sh[16 + e0] + TOKR[m * 2], r1 = sh[8 + e1] + sh[16 + e1] + TOKR[m * 2 + 1];
                const float rs = RSTD[m]; const f32x4* xr = (const f32x4*)(hres + (size_t)m * D);
                u32x2* o0 = (u32x2*)(XR + (size_t)r0 * D); u32x2* o1 = (u32x2*)(XR + (size_t)r1 * D);
#pragma unroll
                for (int j = 0; j < 4; ++j) { const f32x4 v = xr[lane + 64 * j], gv = gr[lane + 64 * j]; u32x2 w; w.x = pk2(v.x * rs * gv.x, v.y * rs * gv.y); w.y = pk2(v.z * rs * gv.z, v.w * rs * gv.w); o0[lane + 64 * j] = w; o1[lane + 64 * j] = w; }
            }
            if (blk == 0) {
                for (int e = 0; e < NE; ++e) { const int lo = sh[8 + e] + sh[e], hi = sh[8 + e] + sh[24 + e] * 256; for (int r = lo + tid; r < hi; r += NT) { ROWDST[r] = -1; ROWG[r] = 0.f; } }
                if (tid < MAXTILES) { int e = 0; for (int q = 0; q < NE; ++q) if (tid * 256 >= sh[8 + q]) e = q; TILEE[tid] = e; }
                if (tid == 0) TILEE[MAXTILES] = sh[32];
            }
            __syncthreads();
        }
    } break;

    case PH_MOEUP: {
        PHASE_ENTER
        const int ntiles = __builtin_amdgcn_readfirstlane(__hip_atomic_load(TILEE + MAXTILES, __ATOMIC_RELAXED, __HIP_MEMORY_SCOPE_AGENT)); const int tlo = pass * CAPT; int thi = tlo + CAPT; if (thi > ntiles) thi = ntiles;
        if (thi > tlo) {
            pg8::Gemm g{XR, (const bf16*)(ws + WS_W13), 0, 0, D}; pg8::MoeOrder S; S.init(thi - tlo, DFFE / 128, G, bid, tlo, 0, TILEE);
            pg8::EpiSwiglu E{HIDE, DFFE, tlo * 256};
            pg8::gemm_phase<pg8::EpiSwiglu, pg8::MoeOrder, true, true>((PG8_LAS unsigned char*)lds_raw, g, S, E);
        }
    } break;

    case PH_MOEDOWN: {
        PHASE_ENTER
        const int ntiles = __builtin_amdgcn_readfirstlane(__hip_atomic_load(TILEE + MAXTILES, __ATOMIC_RELAXED, __HIP_MEMORY_SCOPE_AGENT)); const int tlo = pass * CAPT; int thi = tlo + CAPT; if (thi > ntiles) thi = ntiles;
        if (thi > tlo) {
            pg8::Gemm g{HIDE, (const bf16*)(ws + WS_W2), 0, 0, DFFE}; pg8::MoeOrder S; S.init(thi - tlo, D / 256, G, bid, tlo, tlo, TILEE);
            pg8::EpiMoeDown E{OUT2, ROWDST, ROWG};
            pg8::gemm_phase<pg8::EpiMoeDown, pg8::MoeOrder, true, true>((PG8_LAS unsigned char*)lds_raw, g, S, E);
        }
    } break;

    case PH_FINAL: {
        PHASE_ENTER
        const float* g = a.in[24]; const int gw = bid * 8 + wid, NGW = G * 8;
        for (int m = gw; m < NTOK; m += NGW) {
            f32x4* xr = (f32x4*)(hres + (size_t)m * D); const f32x4* gr = (const f32x4*)g;
            const u32x2* o0 = (const u32x2*)(OUT2 + (size_t)(2 * m) * D); const u32x2* o1 = (const u32x2*)(OUT2 + (size_t)(2 * m + 1) * D);
            f32x4 v[4]; float s = 0.f;
#pragma unroll
            for (int j = 0; j < 4; ++j) {
                v[j] = xr[lane + 64 * j]; const u32x2 p = o0[lane + 64 * j], q = o1[lane + 64 * j];
                v[j].x += bf2f(p.x & 0xffffu) + bf2f(q.x & 0xffffu); v[j].y += bf2f(p.x >> 16) + bf2f(q.x >> 16);
                v[j].z += bf2f(p.y & 0xffffu) + bf2f(q.y & 0xffffu); v[j].w += bf2f(p.y >> 16) + bf2f(q.y >> 16);
                s += (v[j].x * v[j].x + v[j].y * v[j].y) + (v[j].z * v[j].z + v[j].w * v[j].w);
            }
            const float r = 1.0f / sqrtf(wave_sum(s) * (1.0f / D) + 1e-6f);
#pragma unroll
            for (int j = 0; j < 4; ++j) { const f32x4 gv = gr[lane + 64 * j]; xr[lane + 64 * j] = (f32x4){v[j].x * r * gv.x, v[j].y * r * gv.y, v[j].z * r * gv.z, v[j].w * r * gv.w}; }
        }
    } break;
    }
    if (step + 1 < a.ph_hi) xcd_barrier(bar);
    }
}

constexpr int NSTEPS = 22;
#ifndef MK_PER_PHASE
#define MK_PER_PHASE 0
#endif

extern "C" void kernel_launch(void* const* d_in, const int* in_sizes, int n_in, void* d_out, int out_size, void* d_ws, size_t ws_size, hipStream_t stream) {
    static int grid = 0;
    if (grid == 0) {
        if (n_in != 25 || out_size != NTOK * D || ws_size < WS_END) { fprintf(stderr, "kernel_launch: unexpected shapes (n_in %d out %d ws %zu need %zu)\n", n_in, out_size, ws_size, (size_t)WS_END); grid = -1; return; }
        int dev = 0, cus = 0, per_cu = 0;
        if (hipGetDevice(&dev) != hipSuccess || hipDeviceGetAttribute(&cus, hipDeviceAttributeMultiprocessorCount, dev) != hipSuccess) { grid = -1; return; }
        if (hipFuncSetAttribute((const void*)fwd, hipFuncAttributeMaxDynamicSharedMemorySize, LDS_BYTES) != hipSuccess) { fprintf(stderr, "kernel_launch: hipFuncSetAttribute failed\n"); grid = -1; return; }
        if (hipOccupancyMaxActiveBlocksPerMultiprocessor(&per_cu, (const void*)fwd, NT, LDS_BYTES) != hipSuccess || per_cu < 1) { fprintf(stderr, "kernel_launch: occupancy query says %d blocks/CU\n", per_cu); (void)hipGetLastError(); grid = -1; return; }
        grid = cus;
    }
    if (grid < 0) return;
    hipMemsetAsync((char*)d_ws + WS_CTL, 0, 1 * MiB, stream);
    Args a{};
    for (int i = 0; i < 25; ++i) a.in[i] = (const float*)d_in[i];
    a.out = (float*)d_out; a.ws = (unsigned char*)d_ws;
#if MK_PER_PHASE
    for (int s = 0; s < NSTEPS; ++s) { a.ph_lo = s; a.ph_hi = s + 1; hipLaunchKernelGGL(fwd, dim3(grid), dim3(NT), LDS_BYTES, stream, a); }
#else
    a.ph_lo = 0; a.ph_hi = NSTEPS;
    hipLaunchKernelGGL(fwd, dim3(grid), dim3(NT), LDS_BYTES, stream, a);
#endif
}
```

```cpp
#include <hip/hip_runtime.h>
#include <cstdint>
#include <cstdio>

typedef unsigned short bf16;
typedef short bf16x8 __attribute__((ext_vector_type(8)));
typedef float f32x4 __attribute__((ext_vector_type(4)));
typedef unsigned u32x4 __attribute__((ext_vector_type(4)));
typedef unsigned u32x2 __attribute__((ext_vector_type(2)));

constexpr int NTOK = 16384, SEQ = 8192, D = 1024, DIN = 2560, GW = 256, HD = 64, DFF = 2816, DFFE = 3584, NE = 8;
constexpr int CH = 64, NCHUNK = NTOK / CH, CPB = SEQ / CH;
constexpr int NT = 512;
constexpr int MAXTILES = NTOK * 2 / 256 + NE;
constexpr int CAPT = 68;
constexpr int NPASS = (MAXTILES + CAPT - 1) / CAPT;

constexpr size_t MiB = 1u << 20;
constexpr size_t WS_CTL = 0;
constexpr size_t WS_SMALL = 1 * MiB;
constexpr size_t WS_WIN = 5 * MiB;
constexpr size_t WS_WOUT = 15 * MiB;
constexpr size_t WS_WGU = 19 * MiB;
constexpr size_t WS_WD = 30 * MiB;
constexpr size_t WS_W13 = 36 * MiB;
constexpr size_t WS_W2 = 148 * MiB;
constexpr size_t WS_ACT = 204 * MiB;
constexpr size_t WS_HN = WS_ACT;
constexpr size_t WS_PROJ = WS_ACT + 32 * MiB;
constexpr size_t WS_Y = WS_ACT + 112 * MiB;
constexpr size_t WS_GBUF = WS_ACT + 144 * MiB;
constexpr size_t WS_HLOC = WS_ACT + 160 * MiB;
constexpr size_t WS_CUMA = WS_ACT + 176 * MiB;
constexpr size_t WS_DS = WS_ACT + 192 * MiB;
constexpr size_t WS_HID = WS_PROJ;
constexpr size_t WS_XR = WS_ACT;
constexpr size_t WS_HIDE = WS_ACT + 68 * MiB;
constexpr size_t WS_OUT2 = WS_ACT + 187 * MiB;
constexpr size_t WS_END = WS_ACT + 251 * MiB;
constexpr size_t SM_TOKE = 0;
constexpr size_t SM_TOKG = 128 * 1024;
constexpr size_t SM_TOKR = 256 * 1024;
constexpr size_t SM_BCNT = 384 * 1024;
constexpr size_t SM_ROWTOK = 400 * 1024;
constexpr size_t SM_ROWDST = 544 * 1024;
constexpr size_t SM_ROWG = 688 * 1024;
constexpr size_t SM_TILEE = 832 * 1024;
constexpr size_t SM_CARA = 1024 * 1024;
constexpr size_t SM_CARH = 1280 * 1024;
constexpr size_t SM_CIN = 1536 * 1024;
constexpr size_t SM_DEC = 1792 * 1024;
constexpr size_t SM_RSTD = 2048 * 1024;
constexpr size_t SM_WTA = 2304 * 1024;
constexpr size_t SM_WTX = 2368 * 1024;
constexpr size_t SM_WTP = 2432 * 1024;

struct Args {
    const float* in[25];
    float* out;
    unsigned char* ws;
    int ph_lo, ph_hi, pad0, pad1;
};

__device__ __forceinline__ float bf2f(unsigned v) { return __uint_as_float(v << 16); }
__device__ __forceinline__ unsigned f2bf(float f) { unsigned u = __float_as_uint(f); return (u + 0x7fffu + ((u >> 16) & 1u)) >> 16; }
__device__ __forceinline__ unsigned pk2(float lo, float hi) { return f2bf(lo) | (f2bf(hi) << 16); }
__device__ __forceinline__ float sigmoidf_(float x) { return 1.0f / (1.0f + __expf(-x)); }
__device__ __forceinline__ float siluf_(float x) { return x * sigmoidf_(x); }
__device__ __forceinline__ float gelu_tanh(float x) { const float u = 0.7978845608028654f * (x + 0.044715f * x * x * x); return 0.5f * x * (1.0f + tanhf(u)); }
__device__ __forceinline__ float wave_sum(float v) {
#pragma unroll
    for (int o = 1; o < 64; o <<= 1) v += __shfl_xor(v, o);
    return v;
}
#define LDS_WAIT() asm volatile("s_waitcnt lgkmcnt(0)" ::: "memory")

namespace pg8 {
#define PG8_LAS __attribute__((address_space(3)))
typedef unsigned short bf16_t;
typedef short bf16x8 __attribute__((ext_vector_type(8)));
typedef float f32x4 __attribute__((ext_vector_type(4)));
typedef unsigned u32x4 __attribute__((ext_vector_type(4)));
constexpr int BM = 256, BK = 64, HALF = 128, HTB = HALF * BK * 2  , STAGE_BYTES = 8 * HTB, NXCD = 8, WGM = 8;

__host__ __device__ __forceinline__ int lds_byte(int r, int c) { const int st = (r >> 4) * 2 + (c >> 5), rr = r & 15, cc = c & 31, ob = rr * 64 + cc * 2; return st * 1024 + (ob ^ (((ob >> 9) & 1) << 5)); }
__host__ __device__ __forceinline__ void stage_rc(int b, int& R, int& C) { const int st = b / 1024, sb = b % 1024, swz = sb ^ (((sb >> 9) & 1) << 5); R = (st >> 1) * 16 + swz / 64; C = (st & 1) * 32 + (swz % 64) / 2; }
__host__ __device__ __forceinline__ int perm32(int rho) { const int n = rho >> 4, i = rho & 15; return 8 * (i >> 2) + 4 * n + (i & 3); }

struct Unit { int pm, pn, pa, pb; };
struct Gemm { const bf16_t* A; const bf16_t* Bt; int M, N, K; };

struct StaticOrder {
    int nM, nN, nwg, G, c;
    __host__ __device__ void init(int M, int N, int G_, int c_) { nM = M / BM; nN = N / BM; nwg = nM * nN; G = G_; c = c_; }
    __host__ __device__ bool next(int i, Unit& u) const {
        const long L = (long)i * G + c; if (L >= nwg) return false;
        int wgid = (int)L; { const int q = nwg / NXCD, r = nwg % NXCD, xcd = wgid % NXCD, off = wgid / NXCD; wgid = (xcd < r ? xcd * (q + 1) : r * (q + 1) + (xcd - r) * q) + off; }
        const int nig = WGM * nN, gid = wgid / nig, fm = gid * WGM, gsz = (nM - fm) < WGM ? (nM - fm) : WGM;
        u.pm = fm + ((wgid % nig) % gsz); u.pn = (wgid % nig) / gsz; u.pa = u.pm; u.pb = u.pn; return true;
    }
    __device__ __forceinline__ void a_ready(const Unit&) const {}
    __device__ __forceinline__ void done(const Unit&) const {}
};

__device__ __forceinline__ unsigned cvt_pk_bf16(float lo, float hi) { unsigned r; asm volatile("v_cvt_pk_bf16_f32 %0, %1, %2" : "=v"(r) : "v"(lo), "v"(hi)); return r; }
typedef float f32x2 __attribute__((ext_vector_type(2)));
template <class Epi, class Sched, bool ALIGN_EPI = false, bool SP2 = false>
__device__ __forceinline__ void gemm_phase(PG8_LAS unsigned char* lds, const Gemm g, const Sched& S, const Epi& E) {
    int tid = threadIdx.x; asm volatile("" : "+v"(tid));
    const int wid = __builtin_amdgcn_readfirstlane(tid >> 6), lane = tid & 63, wr = wid >> 2, wc = wid & 3, fr = lane & 15, fq = lane >> 4;
    const int K = g.K, nt = K / BK;
    unsigned voffA[2], voffB[2];
#pragma unroll
    for (int i = 0; i < 2; ++i) { int R, C; stage_rc(tid * 16 + i * 8192, R, C); const int Rb = Epi::PERM ? ((R & ~31) + perm32(R & 31)) : R;
        voffA[i] = (unsigned)(R * K + C) * 2u; voffB[i] = (unsigned)(Rb * K + C) * 2u; }
    const size_t kstep = (size_t)(BK * 2);
    const size_t hstep = (size_t)HALF * K * 2;
    const size_t tstep = 2 * hstep;
    const unsigned ldsw = (unsigned)wid * 1024u;
    const int aoff = lds_byte(wr * 64 + fr, fq * 8), boff = lds_byte(wc * 32 + fr, fq * 8);
#define PG8_SA(b, h) (((b) * 2 + (h)) * HTB)
#define PG8_SB(b, h) ((4 + (b) * 2 + (h)) * HTB)
#define PG8_STAGE(bufoff, gbase, voff) do { _Pragma("unroll") for (int _i = 0; _i < 2; ++_i) \
        __builtin_amdgcn_global_load_lds((const unsigned*)((const char*)(gbase) + (voff)[_i]), (PG8_LAS unsigned*)(lds + (bufoff) + ldsw + _i * 8192), 16, 0, 0); } while (0)
#define PG8_LDA(dst, b, h) do { _Pragma("unroll") for (int m = 0; m < 4; ++m) _Pragma("unroll") for (int k = 0; k < 2; ++k) dst[m][k] = *(const PG8_LAS bf16x8*)(lds + PG8_SA(b, h) + aoff + m * 2048 + k * 1024); } while (0)
#define PG8_LDB(dst, b, h) do { _Pragma("unroll") for (int n = 0; n < 2; ++n) _Pragma("unroll") for (int k = 0; k < 2; ++k) dst[n][k] = *(const PG8_LAS bf16x8*)(lds + PG8_SB(b, h) + boff + n * 2048 + k * 1024); } while (0)
#define PG8_MMA(ai, bj, At, Bt) do { __builtin_amdgcn_s_setprio(1); _Pragma("unroll") for (int m = 0; m < 4; ++m) _Pragma("unroll") for (int n = 0; n < 2; ++n) _Pragma("unroll") for (int k = 0; k < 2; ++k) \
        acc[ai][bj][m][n] = __builtin_amdgcn_mfma_f32_16x16x32_bf16(Bt[n][k], At[m][k], acc[ai][bj][m][n], 0, 0, 0); __builtin_amdgcn_s_setprio(0); } while (0)
#define PG8_WAIT_V(n) asm volatile("s_waitcnt vmcnt(" #n ")" ::: "memory")
#define PG8_WAIT_L(n) asm volatile("s_waitcnt lgkmcnt(" #n ")" ::: "memory")
#define PG8_BAR __builtin_amdgcn_s_barrier()
#define PG8_SCHED __builtin_amdgcn_sched_barrier(0)
    Unit cur, nxt; int ui = 0;
    if (!S.next(0, cur)) return;
    f32x4 acc[2][2][4][2];
#pragma unroll
    for (int a = 0; a < 2; ++a)
#pragma unroll
        for (int b = 0; b < 2; ++b)
#pragma unroll
            for (int m = 0; m < 4; ++m)
#pragma unroll
                for (int n = 0; n < 2; ++n) acc[a][b][m][n] = (f32x4){0.f, 0.f, 0.f, 0.f};
    bf16x8 At[4][2], B0[2][2], B1[2][2];
    const char* cA = (const char*)g.A + (size_t)cur.pa * tstep; const char* cB = (const char*)g.Bt + (size_t)cur.pb * tstep;
    S.a_ready(cur);
    if constexpr (SP2) {
        PG8_STAGE(PG8_SB(0, 0), cB, voffB); PG8_STAGE(PG8_SB(0, 1), cB + hstep, voffB); PG8_STAGE(PG8_SA(0, 0), cA, voffA); PG8_STAGE(PG8_SA(0, 1), cA + hstep, voffA);
        if (wr == 1) PG8_BAR;
        PG8_WAIT_V(2); PG8_BAR;
        PG8_STAGE(PG8_SB(1, 0), cB + kstep, voffB); PG8_STAGE(PG8_SA(1, 0), cA + kstep, voffA); PG8_STAGE(PG8_SB(1, 1), cB + hstep + kstep, voffB);
        PG8_WAIT_V(6); PG8_BAR;
    } else {
        PG8_STAGE(PG8_SB(0, 0), cB, voffB); PG8_STAGE(PG8_SA(0, 0), cA, voffA); PG8_STAGE(PG8_SB(0, 1), cB + hstep, voffB); PG8_STAGE(PG8_SA(0, 1), cA + hstep, voffA);
        if (wr == 1) PG8_BAR;
        PG8_WAIT_V(4); PG8_BAR;
        PG8_STAGE(PG8_SB(1, 0), cB + kstep, voffB); PG8_STAGE(PG8_SA(1, 0), cA + kstep, voffA); PG8_STAGE(PG8_SB(1, 1), cB + hstep + kstep, voffB);
        PG8_WAIT_V(6); PG8_BAR;
    }
    for (;;) {
        const bool has_next = S.next(ui + 1, nxt);
        const char* nA = has_next ? (const char*)g.A + (size_t)nxt.pa * tstep : cA; const char* nB = has_next ? (const char*)g.Bt + (size_t)nxt.pb * tstep : cB;
        for (int t = 0; t < nt; t += 2) {
            const bool last = (t == nt - 2);
            const char* a1 = cA + (size_t)(t + 1) * kstep;
            const char* a2 = last ? nA : cA + (size_t)(t + 2) * kstep; const char* b2 = last ? nB : cB + (size_t)(t + 2) * kstep;
            const char* a3 = a2 + kstep; const char* b3 = b2 + kstep;
            if (last && has_next) S.a_ready(nxt);
            if constexpr (SP2) {
            PG8_LDB(B0, 0, 0); PG8_LDB(B1, 0, 1); PG8_SCHED; PG8_LDA(At, 0, 0); PG8_STAGE(PG8_SA(1, 1), a1 + hstep, voffA);
            PG8_WAIT_V(8); PG8_WAIT_L(0); PG8_BAR; PG8_MMA(0, 0, At, B0); PG8_MMA(0, 1, At, B1); PG8_BAR; PG8_SCHED;
            PG8_LDA(At, 0, 1); PG8_STAGE(PG8_SB(0, 0), b2, voffB); PG8_STAGE(PG8_SB(0, 1), b2 + hstep, voffB); PG8_STAGE(PG8_SA(0, 0), a2, voffA);
            PG8_WAIT_V(8); PG8_WAIT_L(0); PG8_BAR; PG8_MMA(1, 0, At, B0); PG8_MMA(1, 1, At, B1); PG8_BAR; PG8_SCHED;
            PG8_LDB(B0, 1, 0); PG8_LDB(B1, 1, 1); PG8_SCHED; PG8_LDA(At, 1, 0); PG8_STAGE(PG8_SA(0, 1), a2 + hstep, voffA);
            PG8_WAIT_V(8); PG8_WAIT_L(0); PG8_BAR; PG8_MMA(0, 0, At, B0); PG8_MMA(0, 1, At, B1); PG8_BAR; PG8_SCHED;
            PG8_LDA(At, 1, 1); PG8_STAGE(PG8_SB(1, 0), b3, voffB); PG8_STAGE(PG8_SB(1, 1), b3 + hstep, voffB); PG8_STAGE(PG8_SA(1, 0), a3, voffA);
            PG8_WAIT_V(8); PG8_WAIT_L(0); PG8_BAR; PG8_MMA(1, 0, At, B0); PG8_MMA(1, 1, At, B1); PG8_BAR; PG8_SCHED;
            } else {
            PG8_LDB(B0, 0, 0); PG8_SCHED; PG8_LDA(At, 0, 0); PG8_STAGE(PG8_SA(1, 1), a1 + hstep, voffA);
            PG8_WAIT_L(8); PG8_BAR; PG8_WAIT_L(0); PG8_MMA(0, 0, At, B0); PG8_BAR; PG8_SCHED;
            PG8_LDB(B1, 0, 1); PG8_STAGE(PG8_SB(0, 0), b2, voffB);
            PG8_BAR; PG8_WAIT_L(0); PG8_MMA(0, 1, At, B1); PG8_BAR;
            PG8_LDA(At, 0, 1); PG8_STAGE(PG8_SA(0, 0), a2, voffA);
            PG8_BAR; PG8_WAIT_L(0); PG8_MMA(1, 0, At, B0); PG8_BAR; PG8_SCHED;
            PG8_STAGE(PG8_SB(0, 1), b2 + hstep, voffB);
            PG8_WAIT_V(6); PG8_BAR; PG8_MMA(1, 1, At, B1); PG8_BAR;
            PG8_LDB(B0, 1, 0); PG8_SCHED; PG8_LDA(At, 1, 0); PG8_STAGE(PG8_SA(0, 1), a2 + hstep, voffA);
            PG8_WAIT_L(8); PG8_BAR; PG8_WAIT_L(0); PG8_MMA(0, 0, At, B0); PG8_BAR; PG8_SCHED;
            PG8_LDB(B1, 1, 1); PG8_STAGE(PG8_SB(1, 0), b3, voffB);
            PG8_BAR; PG8_WAIT_L(0); PG8_MMA(0, 1, At, B1); PG8_BAR;
            PG8_LDA(At, 1, 1); PG8_STAGE(PG8_SA(1, 0), a3, voffA);
            PG8_BAR; PG8_WAIT_L(0); PG8_MMA(1, 0, At, B0); PG8_BAR; PG8_SCHED;
            PG8_STAGE(PG8_SB(1, 1), b3 + hstep, voffB);
            PG8_WAIT_V(6); PG8_BAR; PG8_MMA(1, 1, At, B1); PG8_BAR;
            }
        }
        if constexpr (ALIGN_EPI) { if (wr == 0) PG8_BAR; }
        if constexpr (!Epi::AFTER_DRAIN) { E(acc, cur, wr, wc, fr, fq); S.done(cur); }
        if (!has_next) break;
#pragma unroll
        for (int a = 0; a < 2; ++a)
#pragma unroll
            for (int b = 0; b < 2; ++b)
#pragma unroll
                for (int m = 0; m < 4; ++m)
#pragma unroll
                    for (int n = 0; n < 2; ++n) acc[a][b][m][n] = (f32x4){0.f, 0.f, 0.f, 0.f};
        cur = nxt; cA = nA; cB = nB; ++ui;
        if constexpr (ALIGN_EPI) { if (wr == 1) PG8_BAR; }
    }
    PG8_WAIT_V(0);
    if constexpr (!ALIGN_EPI) { if (wr == 0) PG8_BAR; }
    PG8_BAR;
    if constexpr (Epi::AFTER_DRAIN) { E.fused(acc, cur, wr, wc, fr, fq, lds, wid, lane); S.done(cur); }
#undef PG8_SA
#undef PG8_SB
#undef PG8_STAGE
#undef PG8_LDA
#undef PG8_LDB
#undef PG8_MMA
#undef PG8_WAIT_V
#undef PG8_WAIT_L
#undef PG8_BAR
#undef PG8_SCHED
}

struct EpiStoreBf16 {
    static constexpr bool PERM = true, AFTER_DRAIN = false;
    bf16_t* O; int ldc;
    __device__ __forceinline__ void operator()(const f32x4 (&acc)[2][2][4][2], const Unit& u, int wr, int wc, int fr, int fq) const {
        const int row0 = u.pm * BM + wr * 64 + fr, col0 = u.pn * BM + wc * 32 + 8 * fq;
#pragma unroll
        for (int ai = 0; ai < 2; ++ai)
#pragma unroll
            for (int m = 0; m < 4; ++m) { bf16_t* rowp = O + (size_t)(row0 + ai * HALF + m * 16) * ldc + col0;
#pragma unroll
                for (int bj = 0; bj < 2; ++bj) { const f32x4 v0 = acc[ai][bj][m][0], v1 = acc[ai][bj][m][1];
                    u32x4 w; w.x = cvt_pk_bf16(v0[0], v0[1]); w.y = cvt_pk_bf16(v0[2], v0[3]); w.z = cvt_pk_bf16(v1[0], v1[1]); w.w = cvt_pk_bf16(v1[2], v1[3]);
                    *(u32x4*)(rowp + bj * HALF) = w; } }
    }
};
struct EpiResidF32 {
    static constexpr bool PERM = false, AFTER_DRAIN = false;
    const float* base; float* out;
    __device__ __forceinline__ void operator()(const f32x4 (&acc)[2][2][4][2], const Unit& u, int wr, int wc, int fr, int fq) const {
        const int row0 = u.pm * BM + wr * 64 + fr, col0 = u.pn * BM + wc * 32 + 4 * fq;
#pragma unroll
        for (int ai = 0; ai < 2; ++ai)
#pragma unroll
            for (int m = 0; m < 4; ++m) { const size_t off = (size_t)(row0 + ai * HALF + m * 16) * 1024 + col0;
#pragma unroll
                for (int bj = 0; bj < 2; ++bj)
#pragma unroll
                    for (int n = 0; n < 2; ++n) { const f32x4 b = *(const f32x4*)(base + off + bj * HALF + n * 16); *(f32x4*)(out + off + bj * HALF + n * 16) = b + acc[ai][bj][m][n]; } }
    }
};
__device__ __forceinline__ float silu_f(float x) { return x * __builtin_amdgcn_rcpf(1.0f + __builtin_amdgcn_exp2f(-1.44269504089f * x)); }
struct EpiSwiglu {
    static constexpr bool PERM = true, AFTER_DRAIN = false;
    bf16_t* C; int ldc; int row_off;
    __device__ __forceinline__ void operator()(const f32x4 (&acc)[2][2][4][2], const Unit& u, int wr, int wc, int fr, int fq) const {
        const int row0 = u.pm * BM + wr * 64 + fr - row_off, col0 = u.pn * HALF + wc * 32 + 8 * fq;
#pragma unroll
        for (int ai = 0; ai < 2; ++ai)
#pragma unroll
            for (int m = 0; m < 4; ++m) { bf16_t* rowp = C + (size_t)(row0 + ai * HALF + m * 16) * ldc + col0;
                const f32x4 g0 = acc[ai][0][m][0], g1 = acc[ai][0][m][1], u0 = acc[ai][1][m][0], u1 = acc[ai][1][m][1];
                u32x4 w; w.x = cvt_pk_bf16(silu_f(g0[0]) * u0[0], silu_f(g0[1]) * u0[1]); w.y = cvt_pk_bf16(silu_f(g0[2]) * u0[2], silu_f(g0[3]) * u0[3]);
                w.z = cvt_pk_bf16(silu_f(g1[0]) * u1[0], silu_f(g1[1]) * u1[1]); w.w = cvt_pk_bf16(silu_f(g1[2]) * u1[2], silu_f(g1[3]) * u1[3]);
                *(u32x4*)rowp = w; }
    }
};
struct EpiMoeDown {
    static constexpr bool PERM = true, AFTER_DRAIN = false;
    bf16_t* out2; const int* rowdst; const float* rowg;
    __device__ __forceinline__ void operator()(const f32x4 (&acc)[2][2][4][2], const Unit& u, int wr, int wc, int fr, int fq) const {
        const int row0 = u.pm * BM + wr * 64 + fr, col0 = u.pn * BM + wc * 32 + 8 * fq;
#pragma unroll
        for (int ai = 0; ai < 2; ++ai)
#pragma unroll
            for (int m = 0; m < 4; ++m) { const int gr = row0 + ai * HALF + m * 16; const int d = rowdst[gr]; const float g = rowg[gr];
                if (d >= 0) { bf16_t* rowp = out2 + (size_t)d * 1024 + col0;
#pragma unroll
                    for (int bj = 0; bj < 2; ++bj) { const f32x4 v0 = acc[ai][bj][m][0] * g, v1 = acc[ai][bj][m][1] * g;
                        u32x4 w; w.x = cvt_pk_bf16(v0[0], v0[1]); w.y = cvt_pk_bf16(v0[2], v0[3]); w.z = cvt_pk_bf16(v1[0], v1[1]); w.w = cvt_pk_bf16(v1[2], v1[3]);
                        *(u32x4*)(rowp + bj * HALF) = w; } } }
    }
};
struct MoeOrder {
    StaticOrder so; int tlo, nN, a_off; const int* tilee;
    __device__ void init(int nrt, int nN_, int G, int c, int tlo_, int a_off_, const int* tilee_) { so.init(nrt * BM, nN_ * BM, G, c); tlo = tlo_; nN = nN_; a_off = a_off_; tilee = tilee_; }
    __device__ bool next(int i, Unit& u) const { if (!so.next(i, u)) return false; u.pm += tlo; u.pa = u.pm - a_off; const int e = __builtin_amdgcn_readfirstlane(__hip_atomic_load(tilee + u.pm, __ATOMIC_RELAXED, __HIP_MEMORY_SCOPE_AGENT)); u.pb = e * nN + u.pn; return true; }
    __device__ __forceinline__ void a_ready(const Unit&) const {}
    __device__ __forceinline__ void done(const Unit&) const {}
};
}

__device__ __forceinline__ void cvt_item(const float* W, int K, int N, bf16* WT, int mode, int item, float* scr, int lane) {
    const int nblk = N / 32, kb = item / nblk, nb = item % nblk, k0 = 64 * kb, n0 = 32 * nb;
#pragma unroll 8
    for (int i = 0; i < 32; ++i) { const int kk = 2 * i + (lane >> 5); scr[kk * 33 + (lane & 31)] = W[(size_t)(k0 + kk) * N + n0 + (lane & 31)]; }
    LDS_WAIT();
    const int c = lane & 7;
#pragma unroll
    for (int j = 0; j < 4; ++j) {
        const int n = (lane >> 3) + 8 * j; const float* s = scr + (8 * c) * 33 + n;
        u32x4 o; o.x = pk2(s[0 * 33], s[1 * 33]); o.y = pk2(s[2 * 33], s[3 * 33]); o.z = pk2(s[4 * 33], s[5 * 33]); o.w = pk2(s[6 * 33], s[7 * 33]);
        const int nn = n0 + n; const int drow = mode == 0 ? nn : ((nn >> 7) * 256 + (nn & 127) + (mode == 2 ? 128 : 0));
        *(u32x4*)(WT + (size_t)drow * K + k0 + 8 * c) = o;
    }
    LDS_WAIT();
}

__device__ __forceinline__ void rms_row_bf16(const float* xrow, const float* g, bf16* orow, int lane) {
    const f32x4* xr = (const f32x4*)xrow; const f32x4* gr = (const f32x4*)g;
    f32x4 v[4]; float s = 0.f;
#pragma unroll
    for (int j = 0; j < 4; ++j) { v[j] = xr[lane + 64 * j]; s += (v[j].x * v[j].x + v[j].y * v[j].y) + (v[j].z * v[j].z + v[j].w * v[j].w); }
    const float r = 1.0f / sqrtf(wave_sum(s) * (1.0f / D) + 1e-6f);
    u32x2* o8 = (u32x2*)orow;
#pragma unroll
    for (int j = 0; j < 4; ++j) { const f32x4 gv = gr[lane + 64 * j]; u32x2 w; w.x = pk2(v[j].x * r * gv.x, v[j].y * r * gv.y); w.y = pk2(v[j].z * r * gv.z, v[j].w * r * gv.w); o8[lane + 64 * j] = w; }
}

#define LAS __attribute__((address_space(3)))
#define XB_TMO      128
#define XB_XCNT(j)  (256  + 64 * (j))
#define XB_XSUB(j)  (1280 + 64 * (j))
#define XB_XGEN(j)  (2304 + 64 * (j))
#define XB_TOP      3328
#define XB_TOPGEN   3392
#define XCD_BAR_WORDS 3456
#define XB_SPIN_CAP (1u << 22)
__device__ __forceinline__ unsigned xb_ld(unsigned* p)              { return __hip_atomic_load(p, __ATOMIC_RELAXED, __HIP_MEMORY_SCOPE_AGENT); }
__device__ __forceinline__ unsigned xb_add(unsigned* p, unsigned v) { return __hip_atomic_fetch_add(p, v, __ATOMIC_RELAXED, __HIP_MEMORY_SCOPE_AGENT); }
__device__ __forceinline__ unsigned xb_xcc_id() { return (unsigned)__builtin_amdgcn_s_getreg((3 << 11) | 20) & 0xFu; }
#define XB_SPIN(cond, bar) do { unsigned _sp = 0; while (cond) { __builtin_amdgcn_s_sleep(1); \
    if ((++_sp & 255u) == 0u) { if (xb_ld(&(bar)[XB_TMO])) break; if (_sp > XB_SPIN_CAP) { atomicAdd(&(bar)[XB_TMO], 1u); break; } } } } while (0)
struct XcdBarrier { unsigned* bar; unsigned x; volatile LAS unsigned* st; };
__device__ __forceinline__ XcdBarrier xcd_barrier_post(unsigned* bar, volatile LAS unsigned* st) {
    XcdBarrier b; b.bar = bar; b.x = xb_xcc_id(); b.st = st;
    if (threadIdx.x == 0) (void)xb_add(&bar[XB_XCNT(b.x)], 1u);
    return b;
}
__device__ __forceinline__ void xcd_barrier_complete(unsigned* bar, unsigned x, unsigned& nloc, unsigned& nx) {
    const unsigned G = gridDim.x * gridDim.y * gridDim.z;
    unsigned sum, cnt, mine, sp = 0u;
    for (;;) {
        sum = 0u; cnt = 0u; mine = 0u;
#pragma unroll
        for (unsigned j = 0; j < 16; ++j) { const unsigned c = xb_ld(&bar[XB_XCNT(j)]); sum += c; cnt += (c > 0u) ? 1u : 0u; mine = (j == x) ? c : mine; }
        if (sum == G) break;
        __builtin_amdgcn_s_sleep(1);
        if ((++sp & 255u) == 0u) { if (xb_ld(&bar[XB_TMO])) break; if (sp > XB_SPIN_CAP) { atomicAdd(&bar[XB_TMO], 1u); break; } }
    }
    nloc = mine > 0u ? mine : 1u; nx = cnt > 0u ? cnt : 1u;
}
__device__ __forceinline__ void xcd_barrier(const XcdBarrier& b) {
    asm volatile("s_waitcnt vmcnt(0)" ::: "memory");
    __syncthreads();
    if (threadIdx.x == 0) {
        unsigned* bar = b.bar;
        __builtin_amdgcn_s_waitcnt(0);
        unsigned nloc = b.st[0], nx = b.st[1];
        if (nloc == 0u) { xcd_barrier_complete(bar, b.x, nloc, nx); b.st[0] = nloc; b.st[1] = nx; }
        const unsigned old = xb_add(&bar[XB_XSUB(b.x)], 1u);
        const unsigned gen = old / nloc;
        if (old + 1u == (gen + 1u) * nloc) {
            __builtin_amdgcn_fence(__ATOMIC_RELEASE, "agent");
            asm volatile("s_waitcnt vmcnt(0)" ::: "memory");
            const unsigned og = xb_add(&bar[XB_TOP], 1u);
            const unsigned tg = og / nx;
            if (og + 1u == (tg + 1u) * nx) xb_add(&bar[XB_TOPGEN], 1u);
            else XB_SPIN(xb_ld(&bar[XB_TOPGEN]) == tg, bar);
            __builtin_amdgcn_fence(__ATOMIC_ACQUIRE, "agent");
            xb_add(&bar[XB_XGEN(b.x)], 1u);
            asm volatile("s_waitcnt vmcnt(0)" ::: "memory");
        } else {
            XB_SPIN(xb_ld(&bar[XB_XGEN(b.x)]) == gen, bar);
            __builtin_amdgcn_fence(__ATOMIC_ACQUIRE, "agent");
            asm volatile("s_waitcnt vmcnt(0)" ::: "memory");
        }
    }
    __syncthreads();
}
constexpr int RING_BYTES = 131072, MISC_OFF = RING_BYTES + 320, LDS_BYTES = 147456;
constexpr int CW_BAR = 4096;

enum Phase { PH_PROLOGUE = 0, PH_INPROJ, PH_MIX1, PH_MIX2, PH_MIX3, PH_OUTPROJ, PH_NORM, PH_FFNUP, PH_FFNDOWN, PH_DISPATCH, PH_MOEUP, PH_MOEDOWN, PH_FINAL };


constexpr int AINB_STRIDE = 528;
__device__ __forceinline__ void lru_conv(const bf16* proj, const float* conv_w, const float* conv_b, int b, int t0, unsigned char* ainb, float* ainf, int tid) {
    for (int idx = tid; idx < CH * GW; idx += NT) {
        const int t = idx >> 8, c = idx & 255; float acc = conv_b[c];
#pragma unroll
        for (int k = 0; k < 4; ++k) { const int tt = t0 + t - 3 + k; if (tt >= 0) acc += conv_w[k * GW + c] * bf2f(proj[(size_t)(b * SEQ + tt) * DIN + c]); }
        ainf[idx] = acc; *(bf16*)(ainb + t * AINB_STRIDE + c * 2) = (bf16)f2bf(acc);
    }
}
__device__ __forceinline__ void lru_gates(const unsigned char* ainb, const float* ainf, const bf16* wta, const bf16* wtx, const float* b_a, const float* b_x, const float* lam,
                                          int h, int nt, int lane, float (&av)[4][4], float (&uv)[4][4]) {
    const int fr = lane & 15, fq = lane >> 4, c = 64 * h + 16 * nt + fr;
    bf16x8 wa[2], wx[2];
#pragma unroll
    for (int ks = 0; ks < 2; ++ks) { wa[ks] = *(const bf16x8*)(wta + (size_t)(h * 64 + 16 * nt + fr) * 64 + 32 * ks + 8 * fq); wx[ks] = *(const bf16x8*)(wtx + (size_t)(h * 64 + 16 * nt + fr) * 64 + 32 * ks + 8 * fq); }
    f32x4 aa[4], ax[4];
#pragma unroll
    for (int mt = 0; mt < 4; ++mt) { aa[mt] = (f32x4){0.f, 0.f, 0.f, 0.f}; ax[mt] = (f32x4){0.f, 0.f, 0.f, 0.f};
#pragma unroll
        for (int ks = 0; ks < 2; ++ks) { const bf16x8 x = *(const bf16x8*)(ainb + (16 * mt + fr) * AINB_STRIDE + (64 * h + 32 * ks + 8 * fq) * 2);
            aa[mt] = __builtin_amdgcn_mfma_f32_16x16x32_bf16(x, wa[ks], aa[mt], 0, 0, 0); ax[mt] = __builtin_amdgcn_mfma_f32_16x16x32_bf16(x, wx[ks], ax[mt], 0, 0, 0); } }
    const float sp = log1pf(__expf(-lam[c])), ba = b_a[c], bx = b_x[c];
#pragma unroll
    for (int mt = 0; mt < 4; ++mt)
#pragma unroll
        for (int r = 0; r < 4; ++r) { const int t = 16 * mt + 4 * fq + r; const float rg = sigmoidf_(aa[mt][r] + ba), ig = sigmoidf_(ax[mt][r] + bx); const float loga = -8.0f * rg * sp;
            av[mt][r] = __expf(loga); uv[mt][r] = sqrtf(fmaxf(-expm1f(2.0f * loga), 0.f)) * ig * ainf[t * GW + c]; }
}

#define HN ((bf16*)(ws + WS_HN))
#define PROJ ((bf16*)(ws + WS_PROJ))
#define Y ((bf16*)(ws + WS_Y))
#define GBUF ((float*)(ws + WS_GBUF))
#define HLOC ((float*)(ws + WS_HLOC))
#define CUMA ((float*)(ws + WS_CUMA))
#define DS ((float*)(ws + WS_DS))
#define HID ((bf16*)(ws + WS_HID))
#define HIDE ((bf16*)(ws + WS_HIDE))
#define OUT2 ((bf16*)(ws + WS_OUT2))
#define XR ((bf16*)(ws + WS_XR))
#define SMALLP(T, off) ((T*)(ws + WS_SMALL + (off)))
#define RSTD SMALLP(float, SM_RSTD)
#define TOKE SMALLP(int, SM_TOKE)
#define TOKG SMALLP(float, SM_TOKG)
#define TOKR SMALLP(int, SM_TOKR)
#define BCNT SMALLP(int, SM_BCNT)
#define ROWDST SMALLP(int, SM_ROWDST)
#define ROWG SMALLP(float, SM_ROWG)
#define TILEE SMALLP(int, SM_TILEE)
#define CARA SMALLP(float, SM_CARA)
#define CARH SMALLP(float, SM_CARH)
#define CIN SMALLP(float, SM_CIN)
#define DEC SMALLP(float, SM_DEC)
#define WTA SMALLP(bf16, SM_WTA)
#define WTX SMALLP(bf16, SM_WTX)
#define WTP SMALLP(bf16, SM_WTP)
#define PHASE_ENTER int tid = threadIdx.x; asm volatile("" : "+v"(tid)); const int lane = tid & 63, wid = tid >> 6; unsigned char* ws = a.ws; asm volatile("" : "+s"(ws)); float* hres = a.out; (void)lane; (void)wid; (void)hres;

__global__ void __launch_bounds__(NT) fwd(Args a) {
    extern __shared__ __attribute__((aligned(16))) unsigned char lds_raw[];
    float* ldsf = (float*)lds_raw;
    const int G = gridDim.x, bid = blockIdx.x;
    { const int tid0 = threadIdx.x; for (int u = tid0; u < (LDS_BYTES - RING_BYTES) / 4; u += NT) ((LAS unsigned*)((LAS unsigned char*)lds_raw + RING_BYTES))[u] = 0u; }
    __syncthreads();
    XcdBarrier bar = xcd_barrier_post((unsigned*)(a.ws + WS_CTL) + CW_BAR, (volatile LAS unsigned*)((LAS unsigned char*)lds_raw + MISC_OFF) + 8);

    for (int step = a.ph_lo; step < a.ph_hi; ++step) {
    int phase, L, pass = 0;
    if (step == 0) { phase = PH_PROLOGUE; L = 0; }
    else if (step < 10) { L = 0; const int s = step - 1; phase = s < 5 ? PH_INPROJ + s : s == 5 ? PH_NORM : s == 6 ? PH_FFNUP : s == 7 ? PH_FFNDOWN : PH_NORM; pass = (s == 8) ? 1 : 0; }
    else { L = 1; const int s = step - 10; phase = s < 5 ? PH_INPROJ + s : s == 5 ? PH_NORM : s == 6 ? PH_DISPATCH : s == 11 ? PH_FINAL : ((s - 7) & 1) ? PH_MOEDOWN : PH_MOEUP; pass = (s >= 7 && s < 11) ? ((s - 7) >> 1) : 0; }
    switch (phase) {
    case PH_PROLOGUE: {
        PHASE_ENTER
        float* scr = ldsf + wid * (64 * 33);
        const int gw = bid * 8 + wid, NGW = G * 8;
        constexpr int I_IN = 16 * 80, I_OUT = 16 * 32, I_G = 16 * 88, I_D = 44 * 32, I_E1 = 16 * 112, I_E2 = 56 * 32;
        constexpr int T0 = 2 * I_IN, T1 = T0 + 2 * I_OUT, T2 = T1 + I_G, T3 = T2 + I_G, T4 = T3 + I_D, T5 = T4 + NE * I_E1, T6 = T5 + NE * I_E1, T7 = T6 + NE * I_E2;
        for (int it = gw; it < T7; it += NGW) {
            if (it < T0) { const int l = it / I_IN, r = it % I_IN; cvt_item(a.in[1] + (size_t)l * D * DIN, D, DIN, (bf16*)(ws + WS_WIN) + (size_t)l * DIN * D, 0, r, scr, lane); }
            else if (it < T1) { const int q = it - T0, l = q / I_OUT, r = q % I_OUT; cvt_item(a.in[2] + (size_t)l * D * D, D, D, (bf16*)(ws + WS_WOUT) + (size_t)l * D * D, 0, r, scr, lane); }
            else if (it < T2) { cvt_item(a.in[17], D, DFF, (bf16*)(ws + WS_WGU), 1, it - T1, scr, lane); }
            else if (it < T3) { cvt_item(a.in[18], D, DFF, (bf16*)(ws + WS_WGU), 2, it - T2, scr, lane); }
            else if (it < T4) { cvt_item(a.in[19], DFF, D, (bf16*)(ws + WS_WD), 0, it - T3, scr, lane); }
            else if (it < T5) { const int q = it - T4, e = q / I_E1, r = q % I_E1; cvt_item(a.in[21] + (size_t)e * D * DFFE, D, DFFE, (bf16*)(ws + WS_W13) + (size_t)e * 2 * DFFE * D, 1, r, scr, lane); }
            else if (it < T6) { const int q = it - T5, e = q / I_E1, r = q % I_E1; cvt_item(a.in[22] + (size_t)e * D * DFFE, D, DFFE, (bf16*)(ws + WS_W13) + (size_t)e * 2 * DFFE * D, 2, r, scr, lane); }
            else { const int q = it - T6, e = q / I_E2, r = q % I_E2; cvt_item(a.in[23] + (size_t)e * DFFE * D, DFFE, D, (bf16*)(ws + WS_W2) + (size_t)e * D * DFFE, 0, r, scr, lane); }
        }
        for (int m = gw; m < NTOK; m += NGW) rms_row_bf16(a.in[0] + (size_t)m * D, a.in[15], HN + (size_t)m * D, lane);
        for (int idx = bid * NT + tid; idx < 3 * 2 * 4 * HD * HD; idx += G * NT) {
            const int mat = idx / (2 * 4 * HD * HD), r = idx % (2 * 4 * HD * HD), lh = r >> 12, j = (r >> 6) & 63, i = r & 63;
            const float* w = mat == 0 ? a.in[5] : mat == 1 ? a.in[7] : a.in[12];
            (mat == 0 ? WTA : mat == 1 ? WTX : WTP)[r] = (bf16)f2bf(w[(lh * 64 + i) * 64 + j]);
        }
    } break;

    case PH_INPROJ: {
        PHASE_ENTER
        pg8::Gemm g{HN, (const bf16*)(ws + WS_WIN) + (size_t)L * DIN * D, NTOK, DIN, D}; pg8::StaticOrder S; S.init(NTOK, DIN, G, bid);
        pg8::EpiStoreBf16 E{PROJ, DIN};
        pg8::gemm_phase<pg8::EpiStoreBf16, pg8::StaticOrder, true, true>((PG8_LAS unsigned char*)lds_raw, g, S, E);
    } break;

    case PH_MIX1: {
        PHASE_ENTER
        const float* conv_w = a.in[3] + L * 4 * GW; const float* conv_b = a.in[4] + L * GW;
        const float* b_a = a.in[6] + L * GW; const float* b_x = a.in[8] + L * GW;
        const float* lam = a.in[9] + L * GW; const float* lbp = a.in[10];
        float* ainf = ldsf; unsigned char* ainb = lds_raw + 65536;
        unsigned char* KHTl = lds_raw; unsigned char* VTl = lds_raw + 36864; float* TOTl = (float*)(lds_raw + 73728);
        for (int ci = bid; ci < NCHUNK; ci += G) {
            const int b = ci / CPB, t0 = (ci % CPB) * CH, g0 = ci * CH;
            lru_conv(PROJ, conv_w, conv_b, b, t0, ainb, ainf, tid);
            __syncthreads();
#pragma unroll 1
            for (int cc = 0; cc < 2; ++cc) {
                const int h = wid >> 1, nt = 2 * (wid & 1) + cc; float av[4][4], uv[4][4];
                lru_gates(ainb, ainf, WTA + L * 16384, WTX + L * 16384, b_a, b_x, lam, h, nt, lane, av, uv);
                float A = 1.f, H = 0.f;
#pragma unroll
                for (int mt = 0; mt < 4; ++mt) {
                    float At = 1.f, Ht = 0.f;
#pragma unroll
                    for (int r = 0; r < 4; ++r) { Ht = av[mt][r] * Ht + uv[mt][r]; At *= av[mt][r]; }
                    const float A1 = __shfl_down(At, 16), H1 = __shfl_down(Ht, 16); const float At2 = At * A1, Ht2 = A1 * Ht + H1;
                    const float A2 = __shfl_down(At2, 32), H2 = __shfl_down(Ht2, 32); const float Att = At2 * A2, Htt = A2 * Ht2 + H2;
                    H = Att * H + Htt; A *= Att;
                }
                if (lane < 16) { const int c = 64 * h + 16 * nt + lane; CARA[ci * GW + c] = A; CARH[ci * GW + c] = H; }
            }
            __syncthreads();
            {
                const int h = wid >> 1, half = wid & 1, c = 64 * h + lane, fr = lane & 15, fq = lane >> 4;
                const float lb = L == 0 ? 0.f : sigmoidf_(lbp[GW + c] - lbp[c]);
                const bf16* pz = PROJ + (size_t)(g0 + 32 * half) * DIN + 768 + c; const bf16* pv = pz + 256;
                {
                    float vv[32];
#pragma unroll
                    for (int t = 0; t < 32; ++t) vv[t] = bf2f(pv[(size_t)t * DIN]);
#pragma unroll
                    for (int j = 0; j < 4; ++j) { u32x4 w; w.x = pk2(vv[8 * j], vv[8 * j + 1]); w.y = pk2(vv[8 * j + 2], vv[8 * j + 3]); w.z = pk2(vv[8 * j + 4], vv[8 * j + 5]); w.w = pk2(vv[8 * j + 6], vv[8 * j + 7]);
                        *(u32x4*)(VTl + c * 144 + (32 * half + 8 * j) * 2) = w; }
                }
                float gl[32], kk[32]; float run = 0.f;
#pragma unroll
                for (int t = 0; t < 32; ++t) { const float sg = sigmoidf_(bf2f(pz[(size_t)t * DIN])); run += logf(lb + (1.f - lb) * sg); gl[t] = run; kk[t] = (1.f - lb) * (1.f - sg); }
                TOTl[(h * 2 + half) * 64 + lane] = run;
                __syncthreads();
                const float tot0 = TOTl[(h * 2) * 64 + lane], glast = tot0 + TOTl[(h * 2 + 1) * 64 + lane], off = half ? tot0 : 0.f;
#pragma unroll
                for (int j = 0; j < 4; ++j) { float e[8];
#pragma unroll
                    for (int q = 0; q < 8; ++q) e[q] = kk[8 * j + q] * __expf(glast - (off + gl[8 * j + q]));
                    u32x4 w; w.x = pk2(e[0], e[1]); w.y = pk2(e[2], e[3]); w.z = pk2(e[4], e[5]); w.w = pk2(e[6], e[7]);
                    *(u32x4*)(KHTl + c * 144 + (32 * half + 8 * j) * 2) = w; }
                if (half) DEC[(ci * 4 + h) * 64 + lane] = __expf(glast);
                __syncthreads();
#pragma unroll
                for (int vvv = 0; vvv < 2; ++vvv) {
                    const int vt = 2 * half + vvv; bf16x8 af[2];
#pragma unroll
                    for (int ks = 0; ks < 2; ++ks) af[ks] = *(const bf16x8*)(VTl + (64 * h + 16 * vt + fr) * 144 + (32 * ks + 8 * fq) * 2);
#pragma unroll
                    for (int kt = 0; kt < 4; ++kt) { f32x4 acc = (f32x4){0.f, 0.f, 0.f, 0.f};
#pragma unroll
                        for (int ks = 0; ks < 2; ++ks) { const bf16x8 bfr = *(const bf16x8*)(KHTl + (64 * h + 16 * kt + fr) * 144 + (32 * ks + 8 * fq) * 2); acc = __builtin_amdgcn_mfma_f32_16x16x32_bf16(af[ks], bfr, acc, 0, 0, 0); }
#pragma unroll
                        for (int r = 0; r < 4; ++r) DS[((size_t)(ci * 4 + h) * 64 + 16 * vt + 4 * fq + r) * 64 + 16 * kt + fr] = acc[r]; }
                }
                __syncthreads();
            }
        }
    } break;

    case PH_MIX2: {
        PHASE_ENTER
        const int gt = bid * NT + tid, NGT = G * NT;
        for (int task = gt; task < 2 * 4 * 4096 + 2 * GW; task += NGT) {
            if (task < 2 * 4 * 4096) {
                const int b = task >> 14, hh = (task >> 12) & 3, kv = task & 4095, k = kv & 63; float S = 0.f;
                for (int ch = 0; ch < CPB; ++ch) { const int ci = b * CPB + ch; const size_t idx = (size_t)(ci * 4 + hh) * 4096 + kv; const float d = DS[idx]; DS[idx] = S; S = DEC[(ci * 4 + hh) * 64 + k] * S + d; }
            } else {
                const int q = task - 2 * 4 * 4096, b = q >> 8, c = q & 255; float hp = 0.f;
                for (int ch = 0; ch < CPB; ++ch) { const int ci = b * CPB + ch; CIN[ci * GW + c] = hp; hp = CARA[ci * GW + c] * hp + CARH[ci * GW + c]; }
            }
        }
    } break;

    case PH_MIX3: {
        PHASE_ENTER
        const float* conv_w = a.in[3] + L * 4 * GW; const float* conv_b = a.in[4] + L * GW; const float* b_a = a.in[6] + L * GW; const float* b_x = a.in[8] + L * GW; const float* lam = a.in[9] + L * GW;
        float* ainf = ldsf; unsigned char* ainb = lds_raw + 65536;
        const float* lbp = a.in[10]; const float* norm_g = a.in[11] + L * HD; const float* pool_s = a.in[13] + L * GW; const float* sconv_w = a.in[14] + L * 3 * GW;
        unsigned char* QT3 = lds_raw; unsigned char* KT3 = lds_raw + 33792; unsigned char* VT3 = lds_raw + 67584; float* TOT3 = (float*)(lds_raw + 104448);
        for (int ci = bid; ci < NCHUNK; ci += G) {
            const int t0 = (ci % CPB) * CH, g0 = ci * CH;
            lru_conv(PROJ, conv_w, conv_b, ci / CPB, t0, ainb, ainf, tid);
            __syncthreads();
#pragma unroll 1
            for (int cc = 0; cc < 2; ++cc) {
                const int h = wid >> 1, nt = 2 * (wid & 1) + cc, fr = lane & 15, fq = lane >> 4, c = 64 * h + 16 * nt + fr; float av[4][4], uv[4][4];
                lru_gates(ainb, ainf, WTA + L * 16384, WTX + L * 16384, b_a, b_x, lam, h, nt, lane, av, uv);
                float hin = CIN[ci * GW + c];
#pragma unroll
                for (int mt = 0; mt < 4; ++mt) {
                    float Ai[4], Hi[4]; float A_ = 1.f, H_ = 0.f;
#pragma unroll
                    for (int r = 0; r < 4; ++r) { H_ = av[mt][r] * H_ + uv[mt][r]; A_ *= av[mt][r]; Ai[r] = A_; Hi[r] = H_; }
                    const float a1 = __shfl_up(A_, 16), h1 = __shfl_up(H_, 16), a2 = __shfl_up(A_, 32), h2 = __shfl_up(H_, 32), a3 = __shfl_up(A_, 48), h3 = __shfl_up(H_, 48);
                    float EA = 1.f, EH = 0.f;
                    if (fq >= 3) { EA = a3; EH = h3; }
                    if (fq >= 2) { EH = a2 * EH + h2; EA *= a2; }
                    if (fq >= 1) { EH = a1 * EH + h1; EA *= a1; }
                    const float hs = EA * hin + EH; float hv[4];
#pragma unroll
                    for (int r = 0; r < 4; ++r) hv[r] = Ai[r] * hs + Hi[r];
                    hin = __shfl(hv[3], 48 + fr);
#pragma unroll
                    for (int r = 0; r < 4; ++r) { const size_t tok = g0 + 16 * mt + 4 * fq + r; const float ag = bf2f(PROJ[tok * DIN + 256 + c]); Y[tok * D + c] = (bf16)f2bf(hv[r] * gelu_tanh(ag)); }
                }
            }
            __syncthreads();
            {
                const int h = wid >> 1, half = wid & 1, c = 64 * h + lane, fr = lane & 15, fq = lane >> 4;
                const float lb = L == 0 ? 0.f : sigmoidf_(lbp[GW + c] - lbp[c]);
                const bf16* pq = PROJ + (size_t)(g0 + 32 * half) * DIN + 512 + c; const bf16* pz = pq + 256; const bf16* pv = pq + 512;
                {
                    float vv[32];
#pragma unroll
                    for (int t = 0; t < 32; ++t) vv[t] = bf2f(pv[(size_t)t * DIN]);
#pragma unroll
                    for (int j = 0; j < 4; ++j) { u32x4 w; w.x = pk2(vv[8 * j], vv[8 * j + 1]); w.y = pk2(vv[8 * j + 2], vv[8 * j + 3]); w.z = pk2(vv[8 * j + 4], vv[8 * j + 5]); w.w = pk2(vv[8 * j + 6], vv[8 * j + 7]);
                        *(u32x4*)(VT3 + c * 144 + (32 * half + 8 * j) * 2) = w; }
                }
                float gl[32]; float run = 0.f;
#pragma unroll
                for (int t = 0; t < 32; ++t) { const float sg = sigmoidf_(bf2f(pz[(size_t)t * DIN])); run += logf(lb + (1.f - lb) * sg); gl[t] = run; }
                TOT3[(h * 2 + half) * 64 + lane] = run;
                __syncthreads();
                const float tot0 = TOT3[(h * 2) * 64 + lane];
                const float off = half ? 0.f : -tot0;
#pragma unroll
                for (int t = 0; t < 32; ++t) {
                    const float sg = sigmoidf_(bf2f(pz[(size_t)t * DIN])), kkv = (1.f - lb) * (1.f - sg), qfv = siluf_(bf2f(pq[(size_t)t * DIN])), d = gl[t] + off;
                    *(bf16*)(QT3 + (32 * half + t) * AINB_STRIDE + c * 2) = (bf16)f2bf(qfv * __expf(d));
                    *(bf16*)(KT3 + (32 * half + t) * AINB_STRIDE + c * 2) = (bf16)f2bf(kkv * __expf(-d));
                }
                __syncthreads();
                bf16x8 sa[4][2];
#pragma unroll
                for (int vt = 0; vt < 4; ++vt)
#pragma unroll
                    for (int ks = 0; ks < 2; ++ks) {
                        const float* p = DS + ((size_t)(ci * 4 + h) * 64 + 16 * vt + fr) * 64 + 32 * ks + 8 * fq; const f32x4 lo = *(const f32x4*)p, hi = *(const f32x4*)(p + 4);
                        const float* eg = TOT3 + (h * 2) * 64 + 32 * ks + 8 * fq;
                        u32x4 w; w.x = pk2(lo.x * __expf(eg[0]), lo.y * __expf(eg[1])); w.y = pk2(lo.z * __expf(eg[2]), lo.w * __expf(eg[3])); w.z = pk2(hi.x * __expf(eg[4]), hi.y * __expf(eg[5])); w.w = pk2(hi.z * __expf(eg[6]), hi.w * __expf(eg[7]));
                        sa[vt][ks] = __builtin_bit_cast(bf16x8, w);
                    }
#pragma unroll
                for (int tsel = 0; tsel < 2; ++tsel) {
                    const int ti = half == 0 ? (tsel ? 3 : 0) : (tsel ? 2 : 1);
                    bf16x8 qb[2];
#pragma unroll
                    for (int ks = 0; ks < 2; ++ks) qb[ks] = *(const bf16x8*)(QT3 + (16 * ti + fr) * AINB_STRIDE + (64 * h + 32 * ks + 8 * fq) * 2);
                    f32x4 st[4];
#pragma unroll
                    for (int si = 0; si < 4; ++si) { st[si] = (f32x4){0.f, 0.f, 0.f, 0.f};
                        if (si <= ti) {
#pragma unroll
                            for (int ks = 0; ks < 2; ++ks) { const bf16x8 ka = *(const bf16x8*)(KT3 + (16 * si + fr) * AINB_STRIDE + (64 * h + 32 * ks + 8 * fq) * 2); st[si] = __builtin_amdgcn_mfma_f32_16x16x32_bf16(ka, qb[ks], st[si], 0, 0, 0); }
                            if (si == ti) {
#pragma unroll
                                for (int r = 0; r < 4; ++r) if (4 * fq + r > fr) st[si][r] = 0.f; }
                        } }
                    f32x4 oo[4];
#pragma unroll
                    for (int vt = 0; vt < 4; ++vt) { oo[vt] = (f32x4){0.f, 0.f, 0.f, 0.f};
#pragma unroll
                        for (int ks = 0; ks < 2; ++ks) oo[vt] = __builtin_amdgcn_mfma_f32_16x16x32_bf16(sa[vt][ks], qb[ks], oo[vt], 0, 0, 0); }
#pragma unroll
                    for (int p = 0; p < 2; ++p) if (2 * p <= ti) {
                        u32x4 bw; bw.x = pk2(st[2 * p][0], st[2 * p][1]); bw.y = pk2(st[2 * p][2], st[2 * p][3]); bw.z = pk2(st[2 * p + 1][0], st[2 * p + 1][1]); bw.w = pk2(st[2 * p + 1][2], st[2 * p + 1][3]);
                        const bf16x8 bfr = __builtin_bit_cast(bf16x8, bw);
#pragma unroll
                        for (int vt = 0; vt < 4; ++vt) { const unsigned char* vr = VT3 + (64 * h + 16 * vt + fr) * 144; const u32x2 lo8 = *(const u32x2*)(vr + (32 * p + 4 * fq) * 2), hi8 = *(const u32x2*)(vr + (32 * p + 16 + 4 * fq) * 2);
                            u32x4 aw; aw.x = lo8.x; aw.y = lo8.y; aw.z = hi8.x; aw.w = hi8.y;
                            oo[vt] = __builtin_amdgcn_mfma_f32_16x16x32_bf16(__builtin_bit_cast(bf16x8, aw), bfr, oo[vt], 0, 0, 0); }
                    }
                    float ss = 0.f;
#pragma unroll
                    for (int vt = 0; vt < 4; ++vt) ss += (oo[vt][0] * oo[vt][0] + oo[vt][1] * oo[vt][1]) + (oo[vt][2] * oo[vt][2] + oo[vt][3] * oo[vt][3]);
                    ss += __shfl_xor(ss, 16); ss += __shfl_xor(ss, 32);
                    const float rs = 1.0f / sqrtf(ss * (1.0f / HD) + 1e-5f); const size_t tok = g0 + 16 * ti + fr;
#pragma unroll
                    for (int vt = 0; vt < 4; ++vt) { const int cv = 64 * h + 16 * vt + 4 * fq; const u32x2 og = *(const u32x2*)(PROJ + tok * DIN + 1280 + cv); const f32x4 ng = *(const f32x4*)(norm_g + 16 * vt + 4 * fq);
                        u32x2 w; w.x = pk2(oo[vt][0] * rs * ng.x * siluf_(bf2f(og.x & 0xffffu)), oo[vt][1] * rs * ng.y * siluf_(bf2f(og.x >> 16))); w.y = pk2(oo[vt][2] * rs * ng.z * siluf_(bf2f(og.y & 0xffffu)), oo[vt][3] * rs * ng.w * siluf_(bf2f(og.y >> 16)));
                        *(u32x2*)(Y + tok * D + 256 + cv) = w; }
                }
                __syncthreads();
            }
            for (int idx = tid; idx < CH * GW; idx += NT) {
                const int t = idx >> 8, c = idx & 255, gi = c >> 6, w = 2 << gi; const int tt = t0 + t; const size_t tok = g0 + t;
                const int cnt = (tt + 1 < w) ? (tt + 1) : w; float sum = 0.f;
                for (int r = 0; r < cnt; ++r) sum += bf2f(PROJ[(tok - r) * DIN + 1536 + c]);
                *(bf16*)(ainb + t * AINB_STRIDE + c * 2) = (bf16)f2bf(sum / (float)cnt - bf2f(PROJ[tok * DIN + 1536 + c]));
            }
            __syncthreads();
#pragma unroll 1
            for (int cc = 0; cc < 2; ++cc) {
                const int gi = wid >> 1, nt = 2 * (wid & 1) + cc, fr = lane & 15, fq = lane >> 4, c = 64 * gi + 16 * nt + fr; bf16x8 wp[2];
#pragma unroll
                for (int ks = 0; ks < 2; ++ks) wp[ks] = *(const bf16x8*)(WTP + L * 16384 + (size_t)(gi * 64 + 16 * nt + fr) * 64 + 32 * ks + 8 * fq);
                const float psc = pool_s[c];
#pragma unroll
                for (int mt = 0; mt < 4; ++mt) { f32x4 acc = (f32x4){0.f, 0.f, 0.f, 0.f};
#pragma unroll
                    for (int ks = 0; ks < 2; ++ks) { const bf16x8 x = *(const bf16x8*)(ainb + (16 * mt + fr) * AINB_STRIDE + (64 * gi + 32 * ks + 8 * fq) * 2); acc = __builtin_amdgcn_mfma_f32_16x16x32_bf16(x, wp[ks], acc, 0, 0, 0); }
#pragma unroll
                    for (int r = 0; r < 4; ++r) Y[(size_t)(g0 + 16 * mt + 4 * fq + r) * D + 512 + c] = (bf16)f2bf(acc[r] * psc); }
            }
            for (int idx = tid; idx < CH * GW; idx += NT) {
                const int t = idx >> 8, c = idx & 255; const int tt = t0 + t; const size_t tok = g0 + t; float acc = 0.f;
#pragma unroll
                for (int k = 0; k < 3; ++k) { const int d = 2 - k; if (tt - d >= 0) { const size_t r = (tok - d) * DIN; acc += sconv_w[k * GW + c] * bf2f(PROJ[r + 2048 + c]) * bf2f(PROJ[r + 2304 + c]); } }
                Y[tok * D + 768 + c] = (bf16)f2bf(bf2f(PROJ[tok * DIN + 1792 + c]) * acc);
            }
            __syncthreads();
        }
    } break;

    case PH_OUTPROJ: {
        PHASE_ENTER
        pg8::Gemm g{Y, (const bf16*)(ws + WS_WOUT) + (size_t)L * D * D, NTOK, D, D}; pg8::StaticOrder S; S.init(NTOK, D, G, bid);
        pg8::EpiResidF32 E{L == 0 ? a.in[0] : hres, hres};
        pg8::gemm_phase<pg8::EpiResidF32, pg8::StaticOrder, true, true>((PG8_LAS unsigned char*)lds_raw, g, S, E);
    } break;

    case PH_NORM: {
        PHASE_ENTER
        const float* g = pass == 0 ? a.in[16] + L * D : a.in[15] + D;
        const bool route = (L == 1 && pass == 0);
        int* sel = (int*)lds_raw;
        const float* wr_ = a.in[20];
        for (int blk = bid; blk < NTOK / 64; blk += G) {
            for (int r8 = 0; r8 < 8; ++r8) {
                const int tl = wid * 8 + r8, m = blk * 64 + tl;
                const f32x4* xr = (const f32x4*)(hres + (size_t)m * D); const f32x4* gr = (const f32x4*)g;
                f32x4 v[4]; float s = 0.f;
#pragma unroll
                for (int j = 0; j < 4; ++j) { v[j] = xr[lane + 64 * j]; s += (v[j].x * v[j].x + v[j].y * v[j].y) + (v[j].z * v[j].z + v[j].w * v[j].w); }
                const float r = 1.0f / sqrtf(wave_sum(s) * (1.0f / D) + 1e-6f);
                u32x2* o8 = (u32x2*)(HN + (size_t)m * D);
                float lg[8] = {0.f, 0.f, 0.f, 0.f, 0.f, 0.f, 0.f, 0.f};
#pragma unroll
                for (int j = 0; j < 4; ++j) {
                    const f32x4 gv = gr[lane + 64 * j]; const f32x4 y = (f32x4){v[j].x * r * gv.x, v[j].y * r * gv.y, v[j].z * r * gv.z, v[j].w * r * gv.w};
                    if (!route) { u32x2 w; w.x = pk2(y.x, y.y); w.y = pk2(y.z, y.w); o8[lane + 64 * j] = w; }
                    if (route) {
                        const int i0 = 4 * (lane + 64 * j);
#pragma unroll
                        for (int q = 0; q < 4; ++q) { const float yv = q == 0 ? y.x : q == 1 ? y.y : q == 2 ? y.z : y.w; const f32x4 w0 = *(const f32x4*)(wr_ + (size_t)(i0 + q) * 8), w1 = *(const f32x4*)(wr_ + (size_t)(i0 + q) * 8 + 4);
                            lg[0] += yv * w0.x; lg[1] += yv * w0.y; lg[2] += yv * w0.z; lg[3] += yv * w0.w; lg[4] += yv * w1.x; lg[5] += yv * w1.y; lg[6] += yv * w1.z; lg[7] += yv * w1.w; }
                    }
                }
                if (route) {
#pragma unroll
                    for (int e = 0; e < 8; ++e) lg[e] = wave_sum(lg[e]);
                    if (lane == 0) {
                        int e1 = 0; float l1 = lg[0];
#pragma unroll
                        for (int e = 1; e < 8; ++e) if (lg[e] > l1) { l1 = lg[e]; e1 = e; }
                        int e2 = -1; float l2 = -3.0e38f;
#pragma unroll
                        for (int e = 0; e < 8; ++e) if (e != e1 && lg[e] > l2) { l2 = lg[e]; e2 = e; }
                        const float g1 = 1.0f / (1.0f + __expf(l2 - l1));
                        TOKE[m * 2] = e1; TOKE[m * 2 + 1] = e2; TOKG[m * 2] = g1; TOKG[m * 2 + 1] = 1.0f - g1;
                        sel[tl * 2] = e1; sel[tl * 2 + 1] = e2; RSTD[m] = r;
                    }
                }
            }
            if (route) {
                __syncthreads();
                if (tid < NE) { int cnt = 0; for (int q = 0; q < 128; ++q) if (sel[q] == tid) { TOKR[blk * 128 + q] = cnt; ++cnt; } BCNT[blk * NE + tid] = cnt; }
                __syncthreads();
            }
        }
    } break;

    case PH_FFNUP: {
        PHASE_ENTER
        pg8::Gemm g{HN, (const bf16*)(ws + WS_WGU), NTOK, 2 * DFF, D}; pg8::StaticOrder S; S.init(NTOK, 2 * DFF, G, bid);
        pg8::EpiSwiglu E{HID, DFF, 0};
        pg8::gemm_phase<pg8::EpiSwiglu, pg8::StaticOrder, true, true>((PG8_LAS unsigned char*)lds_raw, g, S, E);
    } break;

    case PH_FFNDOWN: {
        PHASE_ENTER
        pg8::Gemm g{HID, (const bf16*)(ws + WS_WD), NTOK, D, DFF}; pg8::StaticOrder S; S.init(NTOK, D, G, bid);
        pg8::EpiResidF32 E{hres, hres};
        pg8::gemm_phase<pg8::EpiResidF32, pg8::StaticOrder, true, true>((PG8_LAS unsigned char*)lds_raw, g, S, E);
    } break;

    case PH_DISPATCH: {
        PHASE_ENTER
        int* sh = (int*)lds_raw;
        const f32x4* gr = (const f32x4*)(a.in[16] + D);
        for (int blk = bid; blk < NTOK / 64; blk += G) {
            if (tid < NE) { int tot = 0, base = 0; for (int b2 = 0; b2 < NTOK / 64; ++b2) { const int c = BCNT[b2 * NE + tid]; if (b2 < blk) base += c; tot += c; } sh[tid] = tot; sh[16 + tid] = base; sh[24 + tid] = (tot + 255) >> 8; }
            __syncthreads();
            if (tid == 0) { int acc = 0; for (int e = 0; e < NE; ++e) { sh[8 + e] = acc * 256; acc += sh[24 + e]; } sh[32] = acc; }
            __syncthreads();
            if (tid < 128) { const int m = blk * 64 + (tid >> 1); const int e = TOKE[blk * 128 + tid]; const int r = sh[8 + e] + sh[16 + e] + TOKR[blk * 128 + tid];
                ROWDST[r] = m * 2 + (tid & 1); ROWG[r] = TOKG[blk * 128 + tid]; }
            for (int r8 = 0; r8 < 8; ++r8) {
                const int m = blk * 64 + wid * 8 + r8; const int e0 = TOKE[m * 2], e1 = TOKE[m * 2 + 1];
                const int r0 = sh[8 + e0] + sh[16 + e0] + TOKR[m * 2], r1 = sh[8 + e1] + sh[16 + e1] + TOKR[m * 2 + 1];
                const float rs = RSTD[m]; const f32x4* xr = (const f32x4*)(hres + (size_t)m * D);
                u32x2* o0 = (u32x2*)(XR + (size_t)r0 * D); u32x2* o1 = (u32x2*)(XR + (size_t)r1 * D);
#pragma unroll
                for (int j = 0; j < 4; ++j) { const f32x4 v = xr[lane + 64 * j], gv = gr[lane + 64 * j]; u32x2 w; w.x = pk2(v.x * rs * gv.x, v.y * rs * gv.y); w.y = pk2(v.z * rs * gv.z, v.w * rs * gv.w); o0[lane + 64 * j] = w; o1[lane + 64 * j] = w; }
            }
            if (blk == 0) {
                for (int e = 0; e < NE; ++e) { const int lo = sh[8 + e] + sh[e], hi = sh[8 + e] + sh[24 + e] * 256; for (int r = lo + tid; r < hi; r += NT) { ROWDST[r] = -1; ROWG[r] = 0.f; } }
                if (tid < MAXTILES) { int e = 0; for (int q = 0; q < NE; ++q) if (tid * 256 >= sh[8 + q]) e = q; TILEE[tid] = e; }
                if (tid == 0) TILEE[MAXTILES] = sh[32];
            }
            __syncthreads();
        }
    } break;

    case PH_MOEUP: {
        PHASE_ENTER
        const int ntiles = __builtin_amdgcn_readfirstlane(__hip_atomic_load(TILEE + MAXTILES, __ATOMIC_RELAXED, __HIP_MEMORY_SCOPE_AGENT)); const int tlo = pass * CAPT; int thi = tlo + CAPT; if (thi > ntiles) thi = ntiles;
        if (thi > tlo) {
            pg8::Gemm g{XR, (const bf16*)(ws + WS_W13), 0, 0, D}; pg8::MoeOrder S; S.init(thi - tlo, DFFE / 128, G, bid, tlo, 0, TILEE);
            pg8::EpiSwiglu E{HIDE, DFFE, tlo * 256};
            pg8::gemm_phase<pg8::EpiSwiglu, pg8::MoeOrder, true, true>((PG8_LAS unsigned char*)lds_raw, g, S, E);
        }
    } break;

    case PH_MOEDOWN: {
        PHASE_ENTER
        const int ntiles = __builtin_amdgcn_readfirstlane(__hip_atomic_load(TILEE + MAXTILES, __ATOMIC_RELAXED, __HIP_MEMORY_SCOPE_AGENT)); const int tlo = pass * CAPT; int thi = tlo + CAPT; if (thi > ntiles) thi = ntiles;
        if (thi > tlo) {
            pg8::Gemm g{HIDE, (const bf16*)(ws + WS_W2), 0, 0, DFFE}; pg8::MoeOrder S; S.init(thi - tlo, D / 256, G, bid, tlo, tlo, TILEE);
            pg8::EpiMoeDown E{OUT2, ROWDST, ROWG};
            pg8::gemm_phase<pg8::EpiMoeDown, pg8::MoeOrder, true, true>((PG8_LAS unsigned char*)lds_raw, g, S, E);
        }
    } break;

    case PH_FINAL: {
        PHASE_ENTER
        const float* g = a.in[24]; const int gw = bid * 8 + wid, NGW = G * 8;
        for (int m = gw; m < NTOK; m += NGW) {
            f32x4* xr = (f32x4*)(hres + (size_t)m * D); const f32x4* gr = (const f32x4*)g;
            const u32x2* o0 = (const u32x2*)(OUT2 + (size_t)(2 * m) * D); const u32x2* o1 = (const u32x2*)(OUT2 + (size_t)(2 * m + 1) * D);
            f32x4 v[4]; float s = 0.f;
#pragma unroll
            for (int j = 0; j < 4; ++j) {
                v[j] = xr[lane + 64 * j]; const u32x2 p = o0[lane + 64 * j], q = o1[lane + 64 * j];
                v[j].x += bf2f(p.x & 0xffffu) + bf2f(q.x & 0xffffu); v[j].y += bf2f(p.x >> 16) + bf2f(q.x >> 16);
                v[j].z += bf2f(p.y & 0xffffu) + bf2f(q.y & 0xffffu); v[j].w += bf2f(p.y >> 16) + bf2f(q.y >> 16);
                s += (v[j].x * v[j].x + v[j].y * v[j].y) + (v[j].z * v[j].z + v[j].w * v[j].w);
            }
            const float r = 1.0f / sqrtf(wave_sum(s) * (1.0f / D) + 1e-6f);
#pragma unroll
            for (int j = 0; j < 4; ++j) { const f32x4 gv = gr[lane + 64 * j]; xr[lane + 64 * j] = (f32x4){v[j].x * r * gv.x, v[j].y * r * gv.y, v[j].z * r * gv.z, v[j].w * r * gv.w}; }
        }
    } break;
    }
    if (step + 1 < a.ph_hi) xcd_barrier(bar);
    }
}

constexpr int NSTEPS = 22;
#ifndef MK_PER_PHASE
#define MK_PER_PHASE 0
#endif

extern "C" void kernel_launch(void* const* d_in, const int* in_sizes, int n_in, void* d_out, int out_size, void* d_ws, size_t ws_size, hipStream_t stream) {
    static int grid = 0;
    if (grid == 0) {
        if (n_in != 25 || out_size != NTOK * D || ws_size < WS_END) { fprintf(stderr, "kernel_launch: unexpected shapes (n_in %d out %d ws %zu need %zu)\n", n_in, out_size, ws_size, (size_t)WS_END); grid = -1; return; }
        int dev = 0, cus = 0, per_cu = 0;
        if (hipGetDevice(&dev) != hipSuccess || hipDeviceGetAttribute(&cus, hipDeviceAttributeMultiprocessorCount, dev) != hipSuccess) { grid = -1; return; }
        if (hipFuncSetAttribute((const void*)fwd, hipFuncAttributeMaxDynamicSharedMemorySize, LDS_BYTES) != hipSuccess) { fprintf(stderr, "kernel_launch: hipFuncSetAttribute failed\n"); grid = -1; return; }
        if (hipOccupancyMaxActiveBlocksPerMultiprocessor(&per_cu, (const void*)fwd, NT, LDS_BYTES) != hipSuccess || per_cu < 1) { fprintf(stderr, "kernel_launch: occupancy query says %d blocks/CU\n", per_cu); (void)hipGetLastError(); grid = -1; return; }
        grid = cus;
    }
    if (grid < 0) return;
    hipMemsetAsync((char*)d_ws + WS_CTL, 0, 1 * MiB, stream);
    Args a{};
    for (int i = 0; i < 25; ++i) a.in[i] = (const float*)d_in[i];
    a.out = (float*)d_out; a.ws = (unsigned char*)d_ws;
#if MK_PER_PHASE
    for (int s = 0; s < NSTEPS; ++s) { a.ph_lo = s; a.ph_hi = s + 1; hipLaunchKernelGGL(fwd, dim3(grid), dim3(NT), LDS_BYTES, stream, a); }
#else
    a.ph_lo = 0; a.ph_hi = NSTEPS;
    hipLaunchKernelGGL(fwd, dim3(grid), dim3(NT), LDS_BYTES, stream, a);
#endif
}
```

```cpp
#include <hip/hip_runtime.h>
#include <cstdint>
#include <cstdio>

typedef unsigned short bf16;
typedef short bf16x8 __attribute__((ext_vector_type(8)));
typedef float f32x4 __attribute__((ext_vector_type(4)));
typedef unsigned u32x4 __attribute__((ext_vector_type(4)));
typedef unsigned u32x2 __attribute__((ext_vector_type(2)));

constexpr int NTOK = 16384, SEQ = 8192, D = 1024, DIN = 2560, GW = 256, HD = 64, DFF = 2816, DFFE = 3584, NE = 8;
constexpr int CH = 64, NCHUNK = NTOK / CH, CPB = SEQ / CH;
constexpr int NT = 512;
constexpr float W13_SCALE = 64.f, W2_SCALE = 128.f, HID_SCALE = 8.f;
constexpr int MAXTILES = NTOK * 2 / 256 + NE;

constexpr size_t MiB = 1u << 20;
constexpr size_t WS_CTL = 0;
constexpr size_t WS_SMALL = 1 * MiB;
constexpr size_t WS_WIN = 5 * MiB;
constexpr size_t WS_WOUT = 15 * MiB;
constexpr size_t WS_WGU = 19 * MiB;
constexpr size_t WS_WD = 30 * MiB;
constexpr size_t WS_W13 = 36 * MiB;
constexpr size_t WS_W2 = 92 * MiB;
constexpr size_t WS_ACT = 120 * MiB;
constexpr size_t WS_HN = WS_ACT;
constexpr size_t WS_PROJ = WS_ACT + 32 * MiB;
constexpr size_t WS_Y = WS_ACT + 112 * MiB;
constexpr size_t WS_DS = WS_ACT + 144 * MiB;
constexpr size_t WS_HID = WS_PROJ;
constexpr size_t WS_XR = WS_ACT;
constexpr size_t WS_HIDE = WS_ACT + 34 * MiB;
constexpr size_t WS_OUT2 = WS_ACT + 153 * MiB;
constexpr size_t WS_END = WS_ACT + 217 * MiB;
constexpr size_t SM_TOKE = 0;
constexpr size_t SM_TOKG = 128 * 1024;
constexpr size_t SM_TOKR = 256 * 1024;
constexpr size_t SM_BCNT = 384 * 1024;
constexpr size_t SM_ROWTOK = 400 * 1024;
constexpr size_t SM_ROWDST = 544 * 1024;
constexpr size_t SM_ROWG = 688 * 1024;
constexpr size_t SM_TILEE = 832 * 1024;
constexpr size_t SM_CARA = 1024 * 1024;
constexpr size_t SM_CARH = 1280 * 1024;
constexpr size_t SM_CIN = 1536 * 1024;
constexpr size_t SM_DEC = 1792 * 1024;
constexpr size_t SM_RSTD = 2048 * 1024;
constexpr size_t SM_WTA = 2304 * 1024;
constexpr size_t SM_WTX = 2368 * 1024;
constexpr size_t SM_WTP = 2432 * 1024;

struct Args {
    const float* in[25];
    float* out;
    unsigned char* ws;
    int ph_lo, ph_hi, pad0, pad1;
};

__device__ __forceinline__ const float* IN(int k) { asm volatile("" : "+s"(k)); return ((const float* const __attribute__((address_space(4)))*)__builtin_amdgcn_kernarg_segment_ptr())[k]; }
__device__ __forceinline__ float bf2f(unsigned v) { return __uint_as_float(v << 16); }
__device__ __forceinline__ unsigned f2bf(float f) { unsigned u = __float_as_uint(f); return (u + 0x7fffu + ((u >> 16) & 1u)) >> 16; }
__device__ __forceinline__ unsigned pk2(float lo, float hi) { return f2bf(lo) | (f2bf(hi) << 16); }
__device__ __forceinline__ float fexp(float x) { return __builtin_amdgcn_exp2f(1.44269504089f * x); }
__device__ __forceinline__ float flog(float x) { return 0.69314718056f * __builtin_amdgcn_logf(x); }
__device__ __forceinline__ float sigmoidf_(float x) { return __builtin_amdgcn_rcpf(1.0f + __builtin_amdgcn_exp2f(-1.44269504089f * x)); }
__device__ __forceinline__ float siluf_(float x) { return x * sigmoidf_(x); }
__device__ __forceinline__ float gelu_tanh(float x) { const float u = 1.5957691216057308f * (x + 0.044715f * x * x * x); return x * sigmoidf_(u); }
__device__ __forceinline__ float neg_expm1_small(float x) { return -x * (1.0f + x * (0.5f + x * (0.16666667f + x * (0.041666668f + x * 0.0083333338f)))); }
__device__ __forceinline__ float wave_sum(float v) {
#pragma unroll
    for (int o = 1; o < 64; o <<= 1) v += __shfl_xor(v, o);
    return v;
}
#define LDS_WAIT() asm volatile("s_waitcnt lgkmcnt(0)" ::: "memory")

namespace pg8 {
#define PG8_LAS __attribute__((address_space(3)))
typedef unsigned short bf16_t;
typedef short bf16x8 __attribute__((ext_vector_type(8)));
typedef float f32x4 __attribute__((ext_vector_type(4)));
typedef unsigned u32x4 __attribute__((ext_vector_type(4)));
constexpr int BM = 256, BK = 64, HALF = 128, HTB = HALF * BK * 2  , STAGE_BYTES = 8 * HTB, NXCD = 8, WGM = 8;

__host__ __device__ __forceinline__ int lds_byte(int r, int c) { const int st = (r >> 4) * 2 + (c >> 5), rr = r & 15, cc = c & 31, ob = rr * 64 + cc * 2; return st * 1024 + (ob ^ (((ob >> 9) & 1) << 5)); }
__host__ __device__ __forceinline__ void stage_rc(int b, int& R, int& C) { const int st = b / 1024, sb = b % 1024, swz = sb ^ (((sb >> 9) & 1) << 5); R = (st >> 1) * 16 + swz / 64; C = (st & 1) * 32 + (swz % 64) / 2; }
__host__ __device__ __forceinline__ int perm32(int rho) { const int n = rho >> 4, i = rho & 15; return 8 * (i >> 2) + 4 * n + (i & 3); }

struct Unit { int pm, pn, pa, pb; };
struct Gemm { const bf16_t* A; const bf16_t* Bt; int M, N, K; };

struct StaticOrder {
    int nM, nN, nwg, G, c;
    __host__ __device__ void init(int M, int N, int G_, int c_) { nM = M / BM; nN = N / BM; nwg = nM * nN; G = G_; c = c_; }
    __host__ __device__ bool next(int i, Unit& u) const {
        const long L = (long)i * G + c; if (L >= nwg) return false;
        int wgid = (int)L; { const int q = nwg / NXCD, r = nwg % NXCD, xcd = wgid % NXCD, off = wgid / NXCD; wgid = (xcd < r ? xcd * (q + 1) : r * (q + 1) + (xcd - r) * q) + off; }
        const int nig = WGM * nN, gid = wgid / nig, fm = gid * WGM, gsz = (nM - fm) < WGM ? (nM - fm) : WGM;
        u.pm = fm + ((wgid % nig) % gsz); u.pn = (wgid % nig) / gsz; u.pa = u.pm; u.pb = u.pn; return true;
    }
    __device__ __forceinline__ void a_ready(const Unit&) const {}
    __device__ __forceinline__ void done(const Unit&) const {}
};

__device__ __forceinline__ unsigned cvt_pk_bf16(float lo, float hi) { unsigned r; asm volatile("v_cvt_pk_bf16_f32 %0, %1, %2" : "=v"(r) : "v"(lo), "v"(hi)); return r; }
typedef float f32x2 __attribute__((ext_vector_type(2)));
typedef int pg8_v8i __attribute__((ext_vector_type(8))); typedef int pg8_v4i __attribute__((ext_vector_type(4)));
__device__ __forceinline__ pg8_v8i pg8_cat(bf16x8 lo, bf16x8 hi) { return __builtin_shufflevector(__builtin_bit_cast(pg8_v4i, lo), __builtin_bit_cast(pg8_v4i, hi), 0, 1, 2, 3, 4, 5, 6, 7); }
__device__ __forceinline__ void pg8_mfma8(f32x4& acc, pg8_v8i a, pg8_v8i b, int sc) { asm volatile("v_mfma_scale_f32_16x16x128_f8f6f4 %0, %1, %2, %0, %3, %3 op_sel_hi:[0,0,0]" : "+v"(acc) : "v"(a), "v"(b), "v"(sc)); }
template <class Epi, class Sched, bool ALIGN_EPI = false, bool SP2 = false, bool F8 = false>
__device__ __forceinline__ void gemm_phase(PG8_LAS unsigned char* lds, const Gemm g, const Sched& S, const Epi& E, int tid_in) {
    int tid = tid_in; asm volatile("" : "+v"(tid));
    const int wid = __builtin_amdgcn_readfirstlane(tid >> 6), lane = tid & 63, wr = wid >> 2, wc = wid & 3, fr = lane & 15, fq = lane >> 4;
    const int K = g.K, nt = K / BK;
    unsigned voffA[2], voffB[2];
#pragma unroll
    for (int i = 0; i < 2; ++i) { int R, C; stage_rc(tid * 16 + i * 8192, R, C); const int Rb = Epi::PERM ? ((R & ~31) + perm32(R & 31)) : R;
        voffA[i] = (unsigned)(R * K + C) * 2u; voffB[i] = (unsigned)(Rb * K + C) * 2u; }
    const size_t kstep = (size_t)(BK * 2);
    const size_t hstep = (size_t)HALF * K * 2;
    const size_t tstep = 2 * hstep;
    const unsigned ldsw = (unsigned)wid * 1024u;
    int f8one = 0x7f7f7f7f; asm volatile("" : "+v"(f8one));
    constexpr int KOFF = F8 ? 16 : 1024;
    const int aoff = lds_byte(wr * 64 + fr, fq * (F8 ? 16 : 8)), boff = lds_byte(wc * 32 + fr, fq * (F8 ? 16 : 8));
#define PG8_SA(b, h) (((b) * 2 + (h)) * HTB)
#define PG8_SB(b, h) ((4 + (b) * 2 + (h)) * HTB)
#define PG8_STAGE(bufoff, gbase, voff) do { _Pragma("unroll") for (int _i = 0; _i < 2; ++_i) \
        __builtin_amdgcn_global_load_lds((const unsigned*)((const char*)(gbase) + (voff)[_i]), (PG8_LAS unsigned*)(lds + (bufoff) + ldsw + _i * 8192), 16, 0, 0); } while (0)
#define PG8_LDA(dst, b, h) do { _Pragma("unroll") for (int m = 0; m < 4; ++m) _Pragma("unroll") for (int k = 0; k < 2; ++k) dst[m][k] = *(const PG8_LAS bf16x8*)(lds + PG8_SA(b, h) + aoff + m * 2048 + k * KOFF); } while (0)
#define PG8_LDB(dst, b, h) do { _Pragma("unroll") for (int n = 0; n < 2; ++n) _Pragma("unroll") for (int k = 0; k < 2; ++k) dst[n][k] = *(const PG8_LAS bf16x8*)(lds + PG8_SB(b, h) + boff + n * 2048 + k * KOFF); } while (0)
#define PG8_MMA(ai, bj, At, Bt) do { __builtin_amdgcn_s_setprio(1); if constexpr (F8) { _Pragma("unroll") for (int m = 0; m < 4; ++m) _Pragma("unroll") for (int n = 0; n < 2; ++n) \
        pg8_mfma8(acc[ai][bj][m][n], pg8_cat(Bt[n][0], Bt[n][1]), pg8_cat(At[m][0], At[m][1]), f8one); } \
    else { _Pragma("unroll") for (int m = 0; m < 4; ++m) _Pragma("unroll") for (int n = 0; n < 2; ++n) _Pragma("unroll") for (int k = 0; k < 2; ++k) \
        acc[ai][bj][m][n] = __builtin_amdgcn_mfma_f32_16x16x32_bf16(Bt[n][k], At[m][k], acc[ai][bj][m][n], 0, 0, 0); } __builtin_amdgcn_s_setprio(0); } while (0)
#define PG8_WAIT_V(n) asm volatile("s_waitcnt vmcnt(" #n ")" ::: "memory")
#define PG8_WAIT_L(n) asm volatile("s_waitcnt lgkmcnt(" #n ")" ::: "memory")
#define PG8_BAR __builtin_amdgcn_s_barrier()
#define PG8_SCHED __builtin_amdgcn_sched_barrier(0)
    Unit cur, nxt; int ui = 0;
    if (!S.next(0, cur)) return;
    f32x4 acc[2][2][4][2];
#pragma unroll
    for (int a = 0; a < 2; ++a)
#pragma unroll
        for (int b = 0; b < 2; ++b)
#pragma unroll
            for (int m = 0; m < 4; ++m)
#pragma unroll
                for (int n = 0; n < 2; ++n) acc[a][b][m][n] = (f32x4){0.f, 0.f, 0.f, 0.f};
    bf16x8 At[4][2], B0[2][2], B1[2][2];
    const char* cA = (const char*)g.A + (size_t)cur.pa * tstep; const char* cB = (const char*)g.Bt + (size_t)cur.pb * tstep;
    S.a_ready(cur);
    if constexpr (SP2) {
        PG8_STAGE(PG8_SB(0, 0), cB, voffB); PG8_STAGE(PG8_SB(0, 1), cB + hstep, voffB); PG8_STAGE(PG8_SA(0, 0), cA, voffA); PG8_STAGE(PG8_SA(0, 1), cA + hstep, voffA);
        if (wr == 1) PG8_BAR;
        PG8_WAIT_V(2); PG8_BAR;
        PG8_STAGE(PG8_SB(1, 0), cB + kstep, voffB); PG8_STAGE(PG8_SA(1, 0), cA + kstep, voffA); PG8_STAGE(PG8_SB(1, 1), cB + hstep + kstep, voffB);
        PG8_WAIT_V(6); PG8_BAR;
    } else {
        PG8_STAGE(PG8_SB(0, 0), cB, voffB); PG8_STAGE(PG8_SA(0, 0), cA, voffA); PG8_STAGE(PG8_SB(0, 1), cB + hstep, voffB); PG8_STAGE(PG8_SA(0, 1), cA + hstep, voffA);
        if (wr == 1) PG8_BAR;
        PG8_WAIT_V(4); PG8_BAR;
        PG8_STAGE(PG8_SB(1, 0), cB + kstep, voffB); PG8_STAGE(PG8_SA(1, 0), cA + kstep, voffA); PG8_STAGE(PG8_SB(1, 1), cB + hstep + kstep, voffB);
        PG8_WAIT_V(6); PG8_BAR;
    }
    for (;;) {
        const bool has_next = S.next(ui + 1, nxt);
        const char* nA = has_next ? (const char*)g.A + (size_t)nxt.pa * tstep : cA; const char* nB = has_next ? (const char*)g.Bt + (size_t)nxt.pb * tstep : cB;
        for (int t = 0; t < nt; t += 2) {
            const bool last = (t == nt - 2);
            const char* a1 = cA + (size_t)(t + 1) * kstep;
            const char* a2 = last ? nA : cA + (size_t)(t + 2) * kstep; const char* b2 = last ? nB : cB + (size_t)(t + 2) * kstep;
            const char* a3 = a2 + kstep; const char* b3 = b2 + kstep;
            if (last && has_next) S.a_ready(nxt);
            if constexpr (SP2) {
            PG8_LDB(B0, 0, 0); PG8_LDB(B1, 0, 1); PG8_SCHED; PG8_LDA(At, 0, 0); PG8_STAGE(PG8_SA(1, 1), a1 + hstep, voffA);
            PG8_WAIT_V(8); PG8_WAIT_L(0); PG8_BAR; PG8_MMA(0, 0, At, B0); PG8_MMA(0, 1, At, B1); PG8_BAR; PG8_SCHED;
            PG8_LDA(At, 0, 1); PG8_STAGE(PG8_SB(0, 0), b2, voffB); PG8_STAGE(PG8_SB(0, 1), b2 + hstep, voffB); PG8_STAGE(PG8_SA(0, 0), a2, voffA);
            PG8_WAIT_V(8); PG8_WAIT_L(0); PG8_BAR; PG8_MMA(1, 0, At, B0); PG8_MMA(1, 1, At, B1); PG8_BAR; PG8_SCHED;
            PG8_LDB(B0, 1, 0); PG8_LDB(B1, 1, 1); PG8_SCHED; PG8_LDA(At, 1, 0); PG8_STAGE(PG8_SA(0, 1), a2 + hstep, voffA);
            PG8_WAIT_V(8); PG8_WAIT_L(0); PG8_BAR; PG8_MMA(0, 0, At, B0); PG8_MMA(0, 1, At, B1); PG8_BAR; PG8_SCHED;
            PG8_LDA(At, 1, 1); PG8_STAGE(PG8_SB(1, 0), b3, voffB); PG8_STAGE(PG8_SB(1, 1), b3 + hstep, voffB); PG8_STAGE(PG8_SA(1, 0), a3, voffA);
            PG8_WAIT_V(8); PG8_WAIT_L(0); PG8_BAR; PG8_MMA(1, 0, At, B0); PG8_MMA(1, 1, At, B1); PG8_BAR; PG8_SCHED;
            } else {
            PG8_LDB(B0, 0, 0); PG8_SCHED; PG8_LDA(At, 0, 0); PG8_STAGE(PG8_SA(1, 1), a1 + hstep, voffA);
            PG8_WAIT_L(8); PG8_BAR; PG8_WAIT_L(0); PG8_MMA(0, 0, At, B0); PG8_BAR; PG8_SCHED;
            PG8_LDB(B1, 0, 1); PG8_STAGE(PG8_SB(0, 0), b2, voffB);
            PG8_BAR; PG8_WAIT_L(0); PG8_MMA(0, 1, At, B1); PG8_BAR;
            PG8_LDA(At, 0, 1); PG8_STAGE(PG8_SA(0, 0), a2, voffA);
            PG8_BAR; PG8_WAIT_L(0); PG8_MMA(1, 0, At, B0); PG8_BAR; PG8_SCHED;
            PG8_STAGE(PG8_SB(0, 1), b2 + hstep, voffB);
            PG8_WAIT_V(6); PG8_BAR; PG8_MMA(1, 1, At, B1); PG8_BAR;
            PG8_LDB(B0, 1, 0); PG8_SCHED; PG8_LDA(At, 1, 0); PG8_STAGE(PG8_SA(0, 1), a2 + hstep, voffA);
            PG8_WAIT_L(8); PG8_BAR; PG8_WAIT_L(0); PG8_MMA(0, 0, At, B0); PG8_BAR; PG8_SCHED;
            PG8_LDB(B1, 1, 1); PG8_STAGE(PG8_SB(1, 0), b3, voffB);
            PG8_BAR; PG8_WAIT_L(0); PG8_MMA(0, 1, At, B1); PG8_BAR;
            PG8_LDA(At, 1, 1); PG8_STAGE(PG8_SA(1, 0), a3, voffA);
            PG8_BAR; PG8_WAIT_L(0); PG8_MMA(1, 0, At, B0); PG8_BAR; PG8_SCHED;
            PG8_STAGE(PG8_SB(1, 1), b3 + hstep, voffB);
            PG8_WAIT_V(6); PG8_BAR; PG8_MMA(1, 1, At, B1); PG8_BAR;
            }
        }
        if constexpr (F8) asm volatile("s_nop 15\n\ts_nop 15" ::: "memory");
        if constexpr (ALIGN_EPI) { if (wr == 0) PG8_BAR; }
        if constexpr (!Epi::AFTER_DRAIN) { E(acc, cur, wr, wc, fr, fq); S.done(cur); }
        if (!has_next) break;
#pragma unroll
        for (int a = 0; a < 2; ++a)
#pragma unroll
            for (int b = 0; b < 2; ++b)
#pragma unroll
                for (int m = 0; m < 4; ++m)
#pragma unroll
                    for (int n = 0; n < 2; ++n) acc[a][b][m][n] = (f32x4){0.f, 0.f, 0.f, 0.f};
        cur = nxt; cA = nA; cB = nB; ++ui;
        if constexpr (ALIGN_EPI) { if (wr == 1) PG8_BAR; }
    }
    PG8_WAIT_V(0);
    if constexpr (!ALIGN_EPI) { if (wr == 0) PG8_BAR; }
    PG8_BAR;
    if constexpr (Epi::AFTER_DRAIN) { E.fused(acc, cur, wr, wc, fr, fq, lds, wid, lane); S.done(cur); }
#undef PG8_SA
#undef PG8_SB
#undef PG8_STAGE
#undef PG8_LDA
#undef PG8_LDB
#undef PG8_MMA
#undef PG8_WAIT_V
#undef PG8_WAIT_L
#undef PG8_BAR
#undef PG8_SCHED
}

struct EpiStoreBf16 {
    static constexpr bool PERM = true, AFTER_DRAIN = false;
    bf16_t* O; int ldc;
    __device__ __forceinline__ void operator()(const f32x4 (&acc)[2][2][4][2], const Unit& u, int wr, int wc, int fr, int fq) const {
        const int row0 = u.pm * BM + wr * 64 + fr, col0 = u.pn * BM + wc * 32 + 8 * fq;
#pragma unroll
        for (int ai = 0; ai < 2; ++ai)
#pragma unroll
            for (int m = 0; m < 4; ++m) { bf16_t* rowp = O + (size_t)(row0 + ai * HALF + m * 16) * ldc + col0;
#pragma unroll
                for (int bj = 0; bj < 2; ++bj) { const f32x4 v0 = acc[ai][bj][m][0], v1 = acc[ai][bj][m][1];
                    u32x4 w; w.x = cvt_pk_bf16(v0[0], v0[1]); w.y = cvt_pk_bf16(v0[2], v0[3]); w.z = cvt_pk_bf16(v1[0], v1[1]); w.w = cvt_pk_bf16(v1[2], v1[3]);
                    *(u32x4*)(rowp + bj * HALF) = w; } }
    }
};
struct EpiResidF32 {
    static constexpr bool PERM = false, AFTER_DRAIN = false;
    const float* base; float* out;
    __device__ __forceinline__ void operator()(const f32x4 (&acc)[2][2][4][2], const Unit& u, int wr, int wc, int fr, int fq) const {
        const int row0 = u.pm * BM + wr * 64 + fr, col0 = u.pn * BM + wc * 32 + 4 * fq;
#pragma unroll
        for (int ai = 0; ai < 2; ++ai)
#pragma unroll
            for (int m = 0; m < 4; ++m) { const size_t off = (size_t)(row0 + ai * HALF + m * 16) * 1024 + col0;
#pragma unroll
                for (int bj = 0; bj < 2; ++bj)
#pragma unroll
                    for (int n = 0; n < 2; ++n) { const f32x4 b = *(const f32x4*)(base + off + bj * HALF + n * 16); *(f32x4*)(out + off + bj * HALF + n * 16) = b + acc[ai][bj][m][n]; } }
    }
};
__device__ __forceinline__ float silu_f(float x) { return x * __builtin_amdgcn_rcpf(1.0f + __builtin_amdgcn_exp2f(-1.44269504089f * x)); }
struct EpiSwiglu {
    static constexpr bool PERM = true, AFTER_DRAIN = false;
    bf16_t* C; int ldc; int row_off;
    __device__ __forceinline__ void operator()(const f32x4 (&acc)[2][2][4][2], const Unit& u, int wr, int wc, int fr, int fq) const {
        const int row0 = u.pm * BM + wr * 64 + fr - row_off, col0 = u.pn * HALF + wc * 32 + 8 * fq;
#pragma unroll
        for (int ai = 0; ai < 2; ++ai)
#pragma unroll
            for (int m = 0; m < 4; ++m) { bf16_t* rowp = C + (size_t)(row0 + ai * HALF + m * 16) * ldc + col0;
                const f32x4 g0 = acc[ai][0][m][0], g1 = acc[ai][0][m][1], u0 = acc[ai][1][m][0], u1 = acc[ai][1][m][1];
                u32x4 w; w.x = cvt_pk_bf16(silu_f(g0[0]) * u0[0], silu_f(g0[1]) * u0[1]); w.y = cvt_pk_bf16(silu_f(g0[2]) * u0[2], silu_f(g0[3]) * u0[3]);
                w.z = cvt_pk_bf16(silu_f(g1[0]) * u1[0], silu_f(g1[1]) * u1[1]); w.w = cvt_pk_bf16(silu_f(g1[2]) * u1[2], silu_f(g1[3]) * u1[3]);
                *(u32x4*)rowp = w; }
    }
};
struct EpiMoeDown {
    static constexpr bool PERM = true, AFTER_DRAIN = false;
    bf16_t* out2; const int* rowdst; const float* rowg; float sc;
    __device__ __forceinline__ void operator()(const f32x4 (&acc)[2][2][4][2], const Unit& u, int wr, int wc, int fr, int fq) const {
        const int row0 = u.pm * BM + wr * 64 + fr, col0 = u.pn * BM + wc * 32 + 8 * fq;
#pragma unroll
        for (int ai = 0; ai < 2; ++ai)
#pragma unroll
            for (int m = 0; m < 4; ++m) { const int gr = row0 + ai * HALF + m * 16; const int d = rowdst[gr]; const float g = rowg[gr] * sc;
                if (d >= 0) { bf16_t* rowp = out2 + (size_t)d * 1024 + col0;
#pragma unroll
                    for (int bj = 0; bj < 2; ++bj) { const f32x4 v0 = acc[ai][bj][m][0] * g, v1 = acc[ai][bj][m][1] * g;
                        u32x4 w; w.x = cvt_pk_bf16(v0[0], v0[1]); w.y = cvt_pk_bf16(v0[2], v0[3]); w.z = cvt_pk_bf16(v1[0], v1[1]); w.w = cvt_pk_bf16(v1[2], v1[3]);
                        *(u32x4*)(rowp + bj * HALF) = w; } } }
    }
};

__device__ __forceinline__ unsigned pk4_fp8(float a, float b, float c, float d) { int w = __builtin_amdgcn_cvt_pk_fp8_f32(a, b, 0, false); w = __builtin_amdgcn_cvt_pk_fp8_f32(c, d, w, true); return (unsigned)w; }
struct EpiSwiglu8 {
    static constexpr bool PERM = true, AFTER_DRAIN = false;
    unsigned char* C; int ldc; float isc, osc;
    __device__ __forceinline__ void operator()(const f32x4 (&acc)[2][2][4][2], const Unit& u, int wr, int wc, int fr, int fq) const {
        const int row0 = u.pm * BM + wr * 64 + fr, col0 = u.pn * HALF + wc * 32 + 8 * fq; const float us = isc * osc;
#pragma unroll
        for (int ai = 0; ai < 2; ++ai)
#pragma unroll
            for (int m = 0; m < 4; ++m) { unsigned char* rowp = C + (size_t)(row0 + ai * HALF + m * 16) * ldc + col0;
                const f32x4 g0 = acc[ai][0][m][0] * isc, g1 = acc[ai][0][m][1] * isc, u0 = acc[ai][1][m][0] * us, u1 = acc[ai][1][m][1] * us;
                typedef unsigned u32x2e __attribute__((ext_vector_type(2))); u32x2e w;
                w.x = pk4_fp8(silu_f(g0[0]) * u0[0], silu_f(g0[1]) * u0[1], silu_f(g0[2]) * u0[2], silu_f(g0[3]) * u0[3]);
                w.y = pk4_fp8(silu_f(g1[0]) * u1[0], silu_f(g1[1]) * u1[1], silu_f(g1[2]) * u1[2], silu_f(g1[3]) * u1[3]);
                *(u32x2e*)rowp = w; }
    }
};
struct MoeOrder {
    StaticOrder so; int tlo, nN, a_off; const int* tilee;
    __device__ void init(int nrt, int nN_, int G, int c, int tlo_, int a_off_, const int* tilee_) { so.init(nrt * BM, nN_ * BM, G, c); tlo = tlo_; nN = nN_; a_off = a_off_; tilee = tilee_; }
    __device__ bool next(int i, Unit& u) const { if (!so.next(i, u)) return false; u.pm += tlo; u.pa = u.pm - a_off; const int e = __builtin_amdgcn_readfirstlane(__hip_atomic_load(tilee + u.pm, __ATOMIC_RELAXED, __HIP_MEMORY_SCOPE_AGENT)); u.pb = e * nN + u.pn; return true; }
    __device__ __forceinline__ void a_ready(const Unit&) const {}
    __device__ __forceinline__ void done(const Unit&) const {}
};
}

__device__ __forceinline__ void cvt_item(const float* W, int K, int N, bf16* WT, int mode, int item, float* scr, int lane) {
    const int nblk = N / 32, kb = item / nblk, nb = item % nblk, k0 = 64 * kb, n0 = 32 * nb;
#pragma unroll 8
    for (int i = 0; i < 32; ++i) { const int kk = 2 * i + (lane >> 5); scr[kk * 33 + (lane & 31)] = W[(size_t)(k0 + kk) * N + n0 + (lane & 31)]; }
    LDS_WAIT();
    const int c = lane & 7;
#pragma unroll
    for (int j = 0; j < 4; ++j) {
        const int n = (lane >> 3) + 8 * j; const float* s = scr + (8 * c) * 33 + n;
        u32x4 o; o.x = pk2(s[0 * 33], s[1 * 33]); o.y = pk2(s[2 * 33], s[3 * 33]); o.z = pk2(s[4 * 33], s[5 * 33]); o.w = pk2(s[6 * 33], s[7 * 33]);
        const int nn = n0 + n; const int drow = mode == 0 ? nn : ((nn >> 7) * 256 + (nn & 127) + (mode == 2 ? 128 : 0));
        *(u32x4*)(WT + (size_t)drow * K + k0 + 8 * c) = o;
    }
    LDS_WAIT();
}

__device__ __forceinline__ void cvt_item8(const float* W, int K, int N, unsigned char* WT, int mode, int item, float* scr, int lane, float scale) {
    const int nblk = N / 32, kb = item / nblk, nb = item % nblk, k0 = 128 * kb, n0 = 32 * nb;
#pragma unroll 8
    for (int i = 0; i < 64; ++i) { const int kk = 2 * i + (lane >> 5); scr[kk * 33 + (lane & 31)] = W[(size_t)(k0 + kk) * N + n0 + (lane & 31)] * scale; }
    LDS_WAIT();
    const int c = lane & 7;
#pragma unroll
    for (int j = 0; j < 4; ++j) {
        const int n = (lane >> 3) + 8 * j; const float* s = scr + (16 * c) * 33 + n;
        u32x4 o; o.x = pg8::pk4_fp8(s[0 * 33], s[1 * 33], s[2 * 33], s[3 * 33]); o.y = pg8::pk4_fp8(s[4 * 33], s[5 * 33], s[6 * 33], s[7 * 33]);
        o.z = pg8::pk4_fp8(s[8 * 33], s[9 * 33], s[10 * 33], s[11 * 33]); o.w = pg8::pk4_fp8(s[12 * 33], s[13 * 33], s[14 * 33], s[15 * 33]);
        const int nn = n0 + n; const int drow = mode == 0 ? nn : ((nn >> 7) * 256 + (nn & 127) + (mode == 2 ? 128 : 0));
        *(u32x4*)(WT + (size_t)drow * K + k0 + 16 * c) = o;
    }
    LDS_WAIT();
}

__device__ __forceinline__ void rms_row_bf16(const float* xrow, const float* g, bf16* orow, int lane) {
    const f32x4* xr = (const f32x4*)xrow; const f32x4* gr = (const f32x4*)g;
    f32x4 v[4]; float s = 0.f;
#pragma unroll
    for (int j = 0; j < 4; ++j) { v[j] = xr[lane + 64 * j]; s += (v[j].x * v[j].x + v[j].y * v[j].y) + (v[j].z * v[j].z + v[j].w * v[j].w); }
    const float r = 1.0f / sqrtf(wave_sum(s) * (1.0f / D) + 1e-6f);
    u32x2* o8 = (u32x2*)orow;
#pragma unroll
    for (int j = 0; j < 4; ++j) { const f32x4 gv = gr[lane + 64 * j]; u32x2 w; w.x = pk2(v[j].x * r * gv.x, v[j].y * r * gv.y); w.y = pk2(v[j].z * r * gv.z, v[j].w * r * gv.w); o8[lane + 64 * j] = w; }
}

#define LAS __attribute__((address_space(3)))
#define XB_TMO      128
#define XB_XCNT(j)  (256  + 64 * (j))
#define XB_XSUB(j)  (1280 + 64 * (j))
#define XB_XGEN(j)  (2304 + 64 * (j))
#define XB_TOP      3328
#define XB_TOPGEN   3392
#define XCD_BAR_WORDS 3456
#define XB_SPIN_CAP (1u << 22)
__device__ __forceinline__ unsigned xb_ld(unsigned* p)              { return __hip_atomic_load(p, __ATOMIC_RELAXED, __HIP_MEMORY_SCOPE_AGENT); }
__device__ __forceinline__ unsigned xb_add(unsigned* p, unsigned v) { return __hip_atomic_fetch_add(p, v, __ATOMIC_RELAXED, __HIP_MEMORY_SCOPE_AGENT); }
__device__ __forceinline__ unsigned xb_xcc_id() { return (unsigned)__builtin_amdgcn_s_getreg((3 << 11) | 20) & 0xFu; }
#define XB_SPIN(cond, bar) do { unsigned _sp = 0; while (cond) { __builtin_amdgcn_s_sleep(1); \
    if ((++_sp & 255u) == 0u) { if (xb_ld(&(bar)[XB_TMO])) break; if (_sp > XB_SPIN_CAP) { atomicAdd(&(bar)[XB_TMO], 1u); break; } } } } while (0)
struct XcdBarrier { unsigned* bar; unsigned x; volatile LAS unsigned* st; };
__device__ __forceinline__ XcdBarrier xcd_barrier_post(unsigned* bar, volatile LAS unsigned* st) {
    XcdBarrier b; b.bar = bar; b.x = xb_xcc_id(); b.st = st;
    if (threadIdx.x == 0) (void)xb_add(&bar[XB_XCNT(b.x)], 1u);
    return b;
}
__device__ __forceinline__ void xcd_barrier_complete(unsigned* bar, unsigned x, unsigned& nloc, unsigned& nx) {
    const unsigned G = gridDim.x * gridDim.y * gridDim.z;
    unsigned sum, cnt, mine, sp = 0u;
    for (;;) {
        sum = 0u; cnt = 0u; mine = 0u;
#pragma unroll
        for (unsigned j = 0; j < 16; ++j) { const unsigned c = xb_ld(&bar[XB_XCNT(j)]); sum += c; cnt += (c > 0u) ? 1u : 0u; mine = (j == x) ? c : mine; }
        if (sum == G) break;
        __builtin_amdgcn_s_sleep(1);
        if ((++sp & 255u) == 0u) { if (xb_ld(&bar[XB_TMO])) break; if (sp > XB_SPIN_CAP) { atomicAdd(&bar[XB_TMO], 1u); break; } }
    }
    nloc = mine > 0u ? mine : 1u; nx = cnt > 0u ? cnt : 1u;
}
__device__ __forceinline__ void xcd_barrier(const XcdBarrier& b, bool leader) {
    asm volatile("s_waitcnt vmcnt(0)" ::: "memory");
    __syncthreads();
    if (leader) {
        unsigned* bar = b.bar;
        __builtin_amdgcn_s_waitcnt(0);
        unsigned nloc = b.st[0], nx = b.st[1];
        if (nloc == 0u) { xcd_barrier_complete(bar, b.x, nloc, nx); b.st[0] = nloc; b.st[1] = nx; }
        const unsigned old = xb_add(&bar[XB_XSUB(b.x)], 1u);
        const unsigned gen = old / nloc;
        if (old + 1u == (gen + 1u) * nloc) {
            __builtin_amdgcn_fence(__ATOMIC_RELEASE, "agent");
            asm volatile("s_waitcnt vmcnt(0)" ::: "memory");
            const unsigned og = xb_add(&bar[XB_TOP], 1u);
            const unsigned tg = og / nx;
            if (og + 1u == (tg + 1u) * nx) xb_add(&bar[XB_TOPGEN], 1u);
            else XB_SPIN(xb_ld(&bar[XB_TOPGEN]) == tg, bar);
            __builtin_amdgcn_fence(__ATOMIC_ACQUIRE, "agent");
            xb_add(&bar[XB_XGEN(b.x)], 1u);
            asm volatile("s_waitcnt vmcnt(0)" ::: "memory");
        } else {
            XB_SPIN(xb_ld(&bar[XB_XGEN(b.x)]) == gen, bar);
            __builtin_amdgcn_fence(__ATOMIC_ACQUIRE, "agent");
            asm volatile("s_waitcnt vmcnt(0)" ::: "memory");
        }
    }
    __syncthreads();
}
constexpr int LDS_BYTES = 163840, RING_BYTES = LDS_BYTES - 512, MISC_OFF = RING_BYTES + 320;
constexpr int CW_BAR = 4096;

enum Phase { PH_PROLOGUE = 0, PH_INPROJ, PH_MIX1, PH_MIX2, PH_MIX3, PH_OUTPROJ, PH_NORM, PH_FFNUP, PH_FFNDOWN, PH_DISPATCH, PH_MOEUP, PH_MOEDOWN, PH_FINAL };


constexpr int RS = 528;
constexpr int AINB_STRIDE = RS;
constexpr int VTS = 144;
template <int NLD> __device__ __forceinline__ void slab_load(u32x4 (&reg)[NLD], const bf16* src, int nrows, int rvalid0, int tid) {
#pragma unroll
    for (int j = 0; j < NLD; ++j) { const int i = tid + j * NT, r = i >> 5, ch = i & 31; reg[j] = (u32x4){0u, 0u, 0u, 0u}; if (i < nrows * 32 && r >= rvalid0) reg[j] = *(const u32x4*)(src + (ptrdiff_t)r * DIN + ch * 8); }
}
template <int NLD> __device__ __forceinline__ void slab_store(const u32x4 (&reg)[NLD], unsigned char* dst, int nrows, int tid) {
#pragma unroll
    for (int j = 0; j < NLD; ++j) { const int i = tid + j * NT, r = i >> 5, ch = i & 31; if (i < nrows * 32) *(u32x4*)(dst + r * RS + ch * 16) = reg[j]; }
}
__device__ __forceinline__ void ytile_store(const unsigned char* src, bf16* y, int tid) {
#pragma unroll
    for (int j = 0; j < 4; ++j) { const int i = tid + j * NT, r = i >> 5, ch = i & 31; *(u32x4*)(y + (size_t)r * D + ch * 8) = *(const u32x4*)(src + r * RS + ch * 16); }
}
__device__ __forceinline__ int vt_off(int c, int tok) { return c * VTS + ((tok ^ (((c >> 3) & 7) << 3)) << 1); }
__device__ __forceinline__ void vt_store(const u32x4 (&reg)[4], unsigned char* vt, int tid) {
#pragma unroll
    for (int j = 0; j < 4; ++j) { const int i = tid + j * NT, r = i >> 5, ch = i & 31, c0 = ch * 8; const unsigned w[4] = {reg[j].x, reg[j].y, reg[j].z, reg[j].w};
#pragma unroll
        for (int q = 0; q < 8; ++q) *(bf16*)(vt + vt_off(c0 + q, r)) = (bf16)((q & 1) ? (w[q >> 1] >> 16) : (w[q >> 1] & 0xffffu)); }
}
__device__ __forceinline__ float lru_ain(const unsigned char* ax, const float* conv_w, const float* conv_b, int t, int c) {
    float acc = conv_b[c];
#pragma unroll
    for (int k = 0; k < 4; ++k) acc += conv_w[k * GW + c] * bf2f(*(const bf16*)(ax + (t + k) * RS + c * 2));
    return acc;
}
__device__ __forceinline__ void lru_ainb(const unsigned char* ax, const float* conv_w, const float* conv_b, unsigned char* ainb, int tid) {
    for (int idx = tid; idx < CH * 128; idx += NT) {
        const int t = idx >> 7, c = (idx & 127) * 2; float a0 = conv_b[c], a1 = conv_b[c + 1];
#pragma unroll
        for (int k = 0; k < 4; ++k) { const unsigned w = *(const unsigned*)(ax + (t + k) * RS + c * 2); a0 += conv_w[k * GW + c] * bf2f(w & 0xffffu); a1 += conv_w[k * GW + c + 1] * bf2f(w >> 16); }
        *(unsigned*)(ainb + t * RS + c * 2) = pk2(a0, a1);
    }
}
__device__ __forceinline__ void lru_gates(const unsigned char* ainb, const unsigned char* ax, const float* conv_w, const float* conv_b, const bf16* wta, const bf16* wtx, const float* b_a, const float* b_x, const float* lam,
                                          int h, int nt, int lane, float (&av)[4][4], float (&uv)[4][4]) {
    const int fr = lane & 15, fq = lane >> 4, c = 64 * h + 16 * nt + fr;
    bf16x8 wa[2], wx[2];
#pragma unroll
    for (int ks = 0; ks < 2; ++ks) { wa[ks] = *(const bf16x8*)(wta + (size_t)(h * 64 + 16 * nt + fr) * 64 + 32 * ks + 8 * fq); wx[ks] = *(const bf16x8*)(wtx + (size_t)(h * 64 + 16 * nt + fr) * 64 + 32 * ks + 8 * fq); }
    f32x4 aa[4], ax4[4];
#pragma unroll
    for (int mt = 0; mt < 4; ++mt) { aa[mt] = (f32x4){0.f, 0.f, 0.f, 0.f}; ax4[mt] = (f32x4){0.f, 0.f, 0.f, 0.f};
#pragma unroll
        for (int ks = 0; ks < 2; ++ks) { const bf16x8 x = *(const bf16x8*)(ainb + (16 * mt + fr) * RS + (64 * h + 32 * ks + 8 * fq) * 2);
            aa[mt] = __builtin_amdgcn_mfma_f32_16x16x32_bf16(x, wa[ks], aa[mt], 0, 0, 0); ax4[mt] = __builtin_amdgcn_mfma_f32_16x16x32_bf16(x, wx[ks], ax4[mt], 0, 0, 0); } }
    const float sp = log1pf(fexp(-lam[c])), ba = b_a[c], bx = b_x[c];
#pragma unroll
    for (int mt = 0; mt < 4; ++mt)
#pragma unroll
        for (int r = 0; r < 4; ++r) { const int t = 16 * mt + 4 * fq + r; const float rg = sigmoidf_(aa[mt][r] + ba), ig = sigmoidf_(ax4[mt][r] + bx); const float loga = -8.0f * rg * sp;
            const float x2 = 2.0f * loga; const float m2 = x2 > -0.25f ? neg_expm1_small(x2) : -expm1f(x2);
            av[mt][r] = fexp(loga); uv[mt][r] = __builtin_amdgcn_sqrtf(fmaxf(m2, 0.f)) * ig * lru_ain(ax, conv_w, conv_b, t, c); }
}

#define HN ((bf16*)(ws + WS_HN))
#define PROJ ((bf16*)(ws + WS_PROJ))
#define Y ((bf16*)(ws + WS_Y))
#define DS ((float*)(ws + WS_DS))
#define HID ((bf16*)(ws + WS_HID))
#define HIDE ((unsigned char*)(ws + WS_HIDE))
#define OUT2 ((bf16*)(ws + WS_OUT2))
#define XR ((unsigned char*)(ws + WS_XR))
#define SMALLP(T, off) ((T*)(ws + WS_SMALL + (off)))
#define RSTD SMALLP(float, SM_RSTD)
#define TOKE SMALLP(int, SM_TOKE)
#define TOKG SMALLP(float, SM_TOKG)
#define TOKR SMALLP(int, SM_TOKR)
#define BCNT SMALLP(int, SM_BCNT)
#define ROWDST SMALLP(int, SM_ROWDST)
#define ROWG SMALLP(float, SM_ROWG)
#define TILEE SMALLP(int, SM_TILEE)
#define CARA SMALLP(float, SM_CARA)
#define CARH SMALLP(float, SM_CARH)
#define CIN SMALLP(float, SM_CIN)
#define DEC SMALLP(float, SM_DEC)
#define WTA SMALLP(bf16, SM_WTA)
#define WTX SMALLP(bf16, SM_WTX)
#define WTP SMALLP(bf16, SM_WTP)
#define PHASE_ENTER int tid = wid_s * 64 + (int)__builtin_amdgcn_mbcnt_hi(~0u, __builtin_amdgcn_mbcnt_lo(~0u, 0u)); asm volatile("" : "+v"(tid)); const int lane = tid & 63, wid = tid >> 6; unsigned char* ws = a.ws; asm volatile("" : "+s"(ws)); float* hres = a.out; asm volatile("" : "+s"(hres)); \
    int bid = blockIdx.x; asm volatile("" : "+s"(bid)); int G = gridDim.x; asm volatile("" : "+s"(G)); (void)lane; (void)wid; (void)hres; (void)bid; (void)G;

__global__ void __launch_bounds__(NT) fwd(Args a) {
    extern __shared__ __attribute__((aligned(16))) unsigned char lds_raw[];
    float* ldsf = (float*)lds_raw;
    const int wid_s = __builtin_amdgcn_readfirstlane(threadIdx.x >> 6);
    { const int tid0 = threadIdx.x; for (int u = tid0; u < (LDS_BYTES - RING_BYTES) / 4; u += NT) ((LAS unsigned*)((LAS unsigned char*)lds_raw + RING_BYTES))[u] = 0u; }
    __syncthreads();
    XcdBarrier bar = xcd_barrier_post((unsigned*)(a.ws + WS_CTL) + CW_BAR, (volatile LAS unsigned*)((LAS unsigned char*)lds_raw + MISC_OFF) + 8);

#ifdef REP_STEP
    int rep_left = REP_N;
#endif
    for (int step = a.ph_lo; step < a.ph_hi; ++step) {
    int phase, L, pass = 0;
    if (step == 0) { phase = PH_PROLOGUE; L = 0; }
    else if (step < 10) { L = 0; const int s = step - 1; phase = s < 5 ? PH_INPROJ + s : s == 5 ? PH_NORM : s == 6 ? PH_FFNUP : s == 7 ? PH_FFNDOWN : PH_NORM; pass = (s == 8) ? 1 : 0; }
    else { L = 1; const int s = step - 10; phase = s < 5 ? PH_INPROJ + s : s == 5 ? PH_NORM : s == 6 ? PH_DISPATCH : s == 7 ? PH_MOEUP : s == 8 ? PH_MOEDOWN : PH_FINAL; }
    switch (phase) {
    case PH_PROLOGUE: {
        PHASE_ENTER
        float* scr = ldsf + wid * (128 * 33);
        const int gw = bid * 8 + wid, NGW = G * 8;
        constexpr int I_IN = 16 * 80, I_OUT = 16 * 32, I_G = 16 * 88, I_D = 44 * 32, I_E1 = 8 * 112, I_E2 = 28 * 32;
        constexpr int T0 = 2 * I_IN, T1 = T0 + 2 * I_OUT, T2 = T1 + I_G, T3 = T2 + I_G, T4 = T3 + I_D, T5 = T4 + NE * I_E1, T6 = T5 + NE * I_E1, T7 = T6 + NE * I_E2;
        for (int it = gw; it < T7; it += NGW) {
            if (it < T0) { const int l = it / I_IN, r = it % I_IN; cvt_item(IN(1) + (size_t)l * D * DIN, D, DIN, (bf16*)(ws + WS_WIN) + (size_t)l * DIN * D, 0, r, scr, lane); }
            else if (it < T1) { const int q = it - T0, l = q / I_OUT, r = q % I_OUT; cvt_item(IN(2) + (size_t)l * D * D, D, D, (bf16*)(ws + WS_WOUT) + (size_t)l * D * D, 0, r, scr, lane); }
            else if (it < T2) { cvt_item(IN(17), D, DFF, (bf16*)(ws + WS_WGU), 1, it - T1, scr, lane); }
            else if (it < T3) { cvt_item(IN(18), D, DFF, (bf16*)(ws + WS_WGU), 2, it - T2, scr, lane); }
            else if (it < T4) { cvt_item(IN(19), DFF, D, (bf16*)(ws + WS_WD), 0, it - T3, scr, lane); }
            else if (it < T5) { const int q = it - T4, e = q / I_E1, r = q % I_E1; cvt_item8(IN(21) + (size_t)e * D * DFFE, D, DFFE, ws + WS_W13 + (size_t)e * 2 * DFFE * D, 1, r, scr, lane, W13_SCALE); }
            else if (it < T6) { const int q = it - T5, e = q / I_E1, r = q % I_E1; cvt_item8(IN(22) + (size_t)e * D * DFFE, D, DFFE, ws + WS_W13 + (size_t)e * 2 * DFFE * D, 2, r, scr, lane, W13_SCALE); }
            else { const int q = it - T6, e = q / I_E2, r = q % I_E2; cvt_item8(IN(23) + (size_t)e * DFFE * D, DFFE, D, ws + WS_W2 + (size_t)e * D * DFFE, 0, r, scr, lane, W2_SCALE); }
        }
        for (int m = gw; m < NTOK; m += NGW) rms_row_bf16(IN(0) + (size_t)m * D, IN(15), HN + (size_t)m * D, lane);
        for (int idx = bid * NT + tid; idx < 3 * 2 * 4 * HD * HD; idx += G * NT) {
            const int mat = idx / (2 * 4 * HD * HD), r = idx % (2 * 4 * HD * HD), lh = r >> 12, j = (r >> 6) & 63, i = r & 63;
            const float* w = mat == 0 ? IN(5) : mat == 1 ? IN(7) : IN(12);
            (mat == 0 ? WTA : mat == 1 ? WTX : WTP)[r] = (bf16)f2bf(w[(lh * 64 + i) * 64 + j]);
        }
    } break;

    case PH_INPROJ: {
        PHASE_ENTER
        pg8::Gemm g{HN, (const bf16*)(ws + WS_WIN) + (size_t)L * DIN * D, NTOK, DIN, D}; pg8::StaticOrder S; S.init(NTOK, DIN, G, bid);
        pg8::EpiStoreBf16 E{PROJ, DIN};
        pg8::gemm_phase<pg8::EpiStoreBf16, pg8::StaticOrder, true, true>((PG8_LAS unsigned char*)lds_raw, g, S, E, tid);
    } break;

    case PH_MIX1: {
        PHASE_ENTER
        const float* conv_w = IN(3) + L * 4 * GW; const float* conv_b = IN(4) + L * GW;
        const float* b_a = IN(6) + L * GW; const float* b_x = IN(8) + L * GW;
        const float* lam = IN(9) + L * GW; const float* lbp = IN(10);
        unsigned char* AX = lds_raw; unsigned char* AINB = lds_raw + 35376; unsigned char* FS = lds_raw + 69168; unsigned char* VTl = lds_raw + 102960; float* TOTl = (float*)(lds_raw + 139824);
        unsigned char* KHTl = lds_raw;
        for (int ci = bid; ci < NCHUNK; ci += G) {
            const int t0 = (ci % CPB) * CH, g0 = ci * CH; const bf16* prow = PROJ + (size_t)g0 * DIN;
            {
                u32x4 rax[5], rf[4], rv[4];
                slab_load<5>(rax, prow - 3 * DIN, 67, t0 == 0 ? 3 : 0, tid); slab_load<4>(rf, prow + 768, 64, 0, tid); slab_load<4>(rv, prow + 1024, 64, 0, tid);
                slab_store<5>(rax, AX, 67, tid); slab_store<4>(rf, FS, 64, tid); vt_store(rv, VTl, tid);
            }
            __syncthreads();
            lru_ainb(AX, conv_w, conv_b, AINB, tid);
            __syncthreads();
#pragma unroll 1
            for (int cc = 0; cc < 2; ++cc) {
                const int h = wid >> 1, nt = 2 * (wid & 1) + cc; float av[4][4], uv[4][4];
                lru_gates(AINB, AX, conv_w, conv_b, WTA + L * 16384, WTX + L * 16384, b_a, b_x, lam, h, nt, lane, av, uv);
                float A = 1.f, H = 0.f;
#pragma unroll
                for (int mt = 0; mt < 4; ++mt) {
                    float At = 1.f, Ht = 0.f;
#pragma unroll
                    for (int r = 0; r < 4; ++r) { Ht = av[mt][r] * Ht + uv[mt][r]; At *= av[mt][r]; }
                    const float A1 = __shfl_down(At, 16), H1 = __shfl_down(Ht, 16); const float At2 = At * A1, Ht2 = A1 * Ht + H1;
                    const float A2 = __shfl_down(At2, 32), H2 = __shfl_down(Ht2, 32); const float Att = At2 * A2, Htt = A2 * Ht2 + H2;
                    H = Att * H + Htt; A *= Att;
                }
                if (lane < 16) { const int c = 64 * h + 16 * nt + lane; CARA[ci * GW + c] = A; CARH[ci * GW + c] = H; }
            }
            {
                const int h = wid >> 1, half = wid & 1, c = 64 * h + lane, fr = lane & 15, fq = lane >> 4;
                const float lb = L == 0 ? 0.f : sigmoidf_(lbp[GW + c] - lbp[c]);
                float gl[32], kk[32]; float run = 0.f;
#pragma unroll
                for (int t = 0; t < 32; ++t) { const float sg = sigmoidf_(bf2f(*(const bf16*)(FS + (32 * half + t) * RS + c * 2))); run += flog(lb + (1.f - lb) * sg); gl[t] = run; kk[t] = (1.f - lb) * (1.f - sg); }
                TOTl[(h * 2 + half) * 64 + lane] = run;
                __syncthreads();
                const float tot0 = TOTl[(h * 2) * 64 + lane], glast = tot0 + TOTl[(h * 2 + 1) * 64 + lane], off = half ? tot0 : 0.f;
#pragma unroll
                for (int j = 0; j < 4; ++j) { float e[8];
#pragma unroll
                    for (int q = 0; q < 8; ++q) e[q] = kk[8 * j + q] * fexp(glast - (off + gl[8 * j + q]));
                    u32x4 w; w.x = pk2(e[0], e[1]); w.y = pk2(e[2], e[3]); w.z = pk2(e[4], e[5]); w.w = pk2(e[6], e[7]);
                    *(u32x4*)(KHTl + c * VTS + (32 * half + 8 * j) * 2) = w; }
                if (half) DEC[(ci * 4 + h) * 64 + lane] = fexp(glast);
                __syncthreads();
#pragma unroll
                for (int vvv = 0; vvv < 2; ++vvv) {
                    const int vt = 2 * half + vvv, vrow = 64 * h + 16 * vt + fr; bf16x8 bv[2];
#pragma unroll
                    for (int ks = 0; ks < 2; ++ks) bv[ks] = *(const bf16x8*)(VTl + vt_off(vrow, 32 * ks + 8 * fq));
#pragma unroll
                    for (int kt = 0; kt < 4; ++kt) { f32x4 acc = (f32x4){0.f, 0.f, 0.f, 0.f};
#pragma unroll
                        for (int ks = 0; ks < 2; ++ks) { const bf16x8 ka = *(const bf16x8*)(KHTl + (64 * h + 16 * kt + fr) * VTS + (32 * ks + 8 * fq) * 2); acc = __builtin_amdgcn_mfma_f32_16x16x32_bf16(ka, bv[ks], acc, 0, 0, 0); }
                        *(f32x4*)(DS + ((size_t)(ci * 4 + h) * 64 + 16 * vt + fr) * 64 + 16 * kt + 4 * fq) = acc; }
                }
                __syncthreads();
            }
        }
    } break;

    case PH_MIX2: {
        PHASE_ENTER
        float* xa = ldsf; float* xs = ldsf + 512;
        for (int item = bid; item < 256 + 2; item += G) {
            if (item < 256) {
                const int el = tid & 127, seg = tid >> 7, e = item * 128 + el, b = e >> 14, hh = (e >> 12) & 3, kv = e & 4095, k = kv & 63;
                float dv[32], dc[32];
#pragma unroll
                for (int i = 0; i < 32; ++i) { const int ci = b * CPB + seg * 32 + i; dv[i] = DS[(size_t)(ci * 4 + hh) * 4096 + kv]; dc[i] = DEC[(ci * 4 + hh) * 64 + k]; }
                float S = 0.f, A = 1.f;
#pragma unroll
                for (int i = 0; i < 32; ++i) { const float d = dv[i]; dv[i] = S; S = dc[i] * S + d; const float a0 = dc[i]; dc[i] = A; A *= a0; }
                xa[seg * 128 + el] = A; xs[seg * 128 + el] = S;
                __syncthreads();
                float Sin = 0.f;
                for (int s2 = 0; s2 < seg; ++s2) Sin = xa[s2 * 128 + el] * Sin + xs[s2 * 128 + el];
#pragma unroll
                for (int i = 0; i < 32; ++i) { const int ci = b * CPB + seg * 32 + i; DS[(size_t)(ci * 4 + hh) * 4096 + kv] = dv[i] + dc[i] * Sin; }
                __syncthreads();
            } else {
                if (tid < GW) { const int b = item - 256, c = tid; float hp = 0.f;
                    for (int ch0 = 0; ch0 < CPB; ch0 += 16) { float ca[16], chh[16];
#pragma unroll
                        for (int i = 0; i < 16; ++i) { ca[i] = CARA[(b * CPB + ch0 + i) * GW + c]; chh[i] = CARH[(b * CPB + ch0 + i) * GW + c]; }
#pragma unroll
                        for (int i = 0; i < 16; ++i) { CIN[(b * CPB + ch0 + i) * GW + c] = hp; hp = ca[i] * hp + chh[i]; } } }
            }
        }
    } break;

    case PH_MIX3: {
        PHASE_ENTER
        const float* conv_w = IN(3) + L * 4 * GW; const float* conv_b = IN(4) + L * GW; const float* b_a = IN(6) + L * GW; const float* b_x = IN(8) + L * GW; const float* lam = IN(9) + L * GW;
        const float* lbp = IN(10); const float* norm_g = IN(11) + L * HD; const float* pool_s = IN(13) + L * GW; const float* sconv_w = IN(14) + L * 3 * GW;
        unsigned char* AX = lds_raw; unsigned char* AG = lds_raw + 35376; unsigned char* AINB = lds_raw + 69168;
        unsigned char* QT3 = lds_raw; unsigned char* KT3 = lds_raw + 33792; unsigned char* OG3 = lds_raw + 67584; unsigned char* VT3 = lds_raw + 101376; float* TOT3 = (float*)(lds_raw + 138240);
        unsigned char* PS = lds_raw; unsigned char* DIMG = lds_raw + 41712; unsigned char* YST = lds_raw + 75504;
        unsigned char* SB = lds_raw; unsigned char* SC = lds_raw + 33792; unsigned char* SX = lds_raw + 68640;
        for (int ci = bid; ci < NCHUNK; ci += G) {
            const int t0 = (ci % CPB) * CH, g0 = ci * CH; const bf16* prow = PROJ + (size_t)g0 * DIN; bf16* yrow = Y + (size_t)g0 * D;
            {
                u32x4 rax[5], rag[4];
                slab_load<5>(rax, prow - 3 * DIN, 67, t0 == 0 ? 3 : 0, tid); slab_load<4>(rag, prow + 256, 64, 0, tid);
                slab_store<5>(rax, AX, 67, tid); slab_store<4>(rag, AG, 64, tid);
            }
            __syncthreads();
            lru_ainb(AX, conv_w, conv_b, AINB, tid);
            __syncthreads();
            u32x4 rp[5];
            slab_load<5>(rp, prow - 15 * DIN + 1536, 79, t0 == 0 ? 15 : 0, tid);
#pragma unroll 1
            for (int cc = 0; cc < 2; ++cc) {
                const int h = wid >> 1, nt = 2 * (wid & 1) + cc, fr = lane & 15, fq = lane >> 4, c = 64 * h + 16 * nt + fr; float av[4][4], uv[4][4];
                lru_gates(AINB, AX, conv_w, conv_b, WTA + L * 16384, WTX + L * 16384, b_a, b_x, lam, h, nt, lane, av, uv);
                float hin = CIN[ci * GW + c];
#pragma unroll
                for (int mt = 0; mt < 4; ++mt) {
                    float Ai[4], Hi[4]; float A_ = 1.f, H_ = 0.f;
#pragma unroll
                    for (int r = 0; r < 4; ++r) { H_ = av[mt][r] * H_ + uv[mt][r]; A_ *= av[mt][r]; Ai[r] = A_; Hi[r] = H_; }
                    const float a1 = __shfl_up(A_, 16), h1 = __shfl_up(H_, 16), a2 = __shfl_up(A_, 32), h2 = __shfl_up(H_, 32), a3 = __shfl_up(A_, 48), h3 = __shfl_up(H_, 48);
                    float EA = 1.f, EH = 0.f;
                    if (fq >= 3) { EA = a3; EH = h3; }
                    if (fq >= 2) { EH = a2 * EH + h2; EA *= a2; }
                    if (fq >= 1) { EH = a1 * EH + h1; EA *= a1; }
                    const float hs = EA * hin + EH; float hv[4];
#pragma unroll
                    for (int r = 0; r < 4; ++r) hv[r] = Ai[r] * hs + Hi[r];
                    hin = __shfl(hv[3], 48 + fr);
#pragma unroll
                    for (int r = 0; r < 4; ++r) { bf16* p = (bf16*)(AG + (16 * mt + 4 * fq + r) * RS + c * 2); *p = (bf16)f2bf(hv[r] * gelu_tanh(bf2f(*p))); }
                }
            }
            __syncthreads();
            ytile_store(AG, yrow, tid);
            __syncthreads();
            slab_store<5>(rp, PS, 79, tid);
            __syncthreads();
            u32x4 rsb[4], rsc[5], rsx[5];
            slab_load<4>(rsb, prow + 1792, 64, 0, tid); slab_load<5>(rsc, prow - 2 * DIN + 2048, 66, t0 == 0 ? 2 : 0, tid); slab_load<5>(rsx, prow - 2 * DIN + 2304, 66, t0 == 0 ? 2 : 0, tid);
            for (int idx = tid; idx < CH * 128; idx += NT) {
                const int t = idx >> 7, c = (idx & 127) * 2, gi = c >> 6, w = 2 << gi; const int tt = t0 + t; const int cnt = (tt + 1 < w) ? (tt + 1) : w; float s0 = 0.f, s1 = 0.f;
                for (int r = 0; r < cnt; ++r) { const unsigned x = *(const unsigned*)(PS + (t + 15 - r) * RS + c * 2); s0 += bf2f(x & 0xffffu); s1 += bf2f(x >> 16); }
                const unsigned x0 = *(const unsigned*)(PS + (t + 15) * RS + c * 2); const float inv = __builtin_amdgcn_rcpf((float)cnt);
                *(unsigned*)(DIMG + t * RS + c * 2) = pk2(s0 * inv - bf2f(x0 & 0xffffu), s1 * inv - bf2f(x0 >> 16));
            }
            __syncthreads();
#pragma unroll 1
            for (int cc = 0; cc < 2; ++cc) {
                const int gi = wid >> 1, nt = 2 * (wid & 1) + cc, fr = lane & 15, fq = lane >> 4, c = 64 * gi + 16 * nt + fr; bf16x8 wp[2];
#pragma unroll
                for (int ks = 0; ks < 2; ++ks) wp[ks] = *(const bf16x8*)(WTP + L * 16384 + (size_t)(gi * 64 + 16 * nt + fr) * 64 + 32 * ks + 8 * fq);
                const float psc = pool_s[c];
#pragma unroll
                for (int mt = 0; mt < 4; ++mt) { f32x4 acc = (f32x4){0.f, 0.f, 0.f, 0.f};
#pragma unroll
                    for (int ks = 0; ks < 2; ++ks) { const bf16x8 x = *(const bf16x8*)(DIMG + (16 * mt + fr) * RS + (64 * gi + 32 * ks + 8 * fq) * 2); acc = __builtin_amdgcn_mfma_f32_16x16x32_bf16(x, wp[ks], acc, 0, 0, 0); }
#pragma unroll
                    for (int r = 0; r < 4; ++r) *(bf16*)(YST + (16 * mt + 4 * fq + r) * RS + c * 2) = (bf16)f2bf(acc[r] * psc); }
            }
            __syncthreads();
            ytile_store(YST, yrow + 512, tid);
            __syncthreads();
            slab_store<4>(rsb, SB, 64, tid); slab_store<5>(rsc, SC, 66, tid); slab_store<5>(rsx, SX, 66, tid);
            __syncthreads();
            u32x4 rq[4], rf[4], rv[4], rog[4];
            slab_load<4>(rq, prow + 512, 64, 0, tid); slab_load<4>(rf, prow + 768, 64, 0, tid); slab_load<4>(rv, prow + 1024, 64, 0, tid); slab_load<4>(rog, prow + 1280, 64, 0, tid);
            for (int idx = tid; idx < CH * 128; idx += NT) {
                const int t = idx >> 7, c = (idx & 127) * 2; float a0 = 0.f, a1 = 0.f;
#pragma unroll
                for (int k = 0; k < 3; ++k) { const unsigned xc = *(const unsigned*)(SC + (t + k) * RS + c * 2), xx = *(const unsigned*)(SX + (t + k) * RS + c * 2);
                    a0 += sconv_w[k * GW + c] * bf2f(xc & 0xffffu) * bf2f(xx & 0xffffu); a1 += sconv_w[k * GW + c + 1] * bf2f(xc >> 16) * bf2f(xx >> 16); }
                unsigned* pb = (unsigned*)(SB + t * RS + c * 2); const unsigned b = *pb; *pb = pk2(bf2f(b & 0xffffu) * a0, bf2f(b >> 16) * a1);
            }
            __syncthreads();
            ytile_store(SB, yrow + 768, tid);
            __syncthreads();
            slab_store<4>(rq, QT3, 64, tid); slab_store<4>(rf, KT3, 64, tid); slab_store<4>(rog, OG3, 64, tid); vt_store(rv, VT3, tid);
            __syncthreads();
            {
                const int h = wid >> 1, half = wid & 1, c = 64 * h + lane, fr = lane & 15, fq = lane >> 4;
                const float lb = L == 0 ? 0.f : sigmoidf_(lbp[GW + c] - lbp[c]);
                float gl[32]; float run = 0.f;
#pragma unroll
                for (int t = 0; t < 32; ++t) { const float sg = sigmoidf_(bf2f(*(const bf16*)(KT3 + (32 * half + t) * RS + c * 2))); run += flog(lb + (1.f - lb) * sg); gl[t] = run; }
                TOT3[(h * 2 + half) * 64 + lane] = run;
                __syncthreads();
                const float tot0 = TOT3[(h * 2) * 64 + lane];
                const float off = half ? 0.f : -tot0;
#pragma unroll
                for (int t = 0; t < 32; ++t) {
                    bf16* pq = (bf16*)(QT3 + (32 * half + t) * RS + c * 2); bf16* pk = (bf16*)(KT3 + (32 * half + t) * RS + c * 2);
                    const float sg = sigmoidf_(bf2f(*pk)), kkv = (1.f - lb) * (1.f - sg), qfv = siluf_(bf2f(*pq)), d = gl[t] + off;
                    *pq = (bf16)f2bf(qfv * fexp(d)); *pk = (bf16)f2bf(kkv * fexp(-d));
                }
                __syncthreads();
                bf16x8 sa[4][2];
#pragma unroll
                for (int vt = 0; vt < 4; ++vt)
#pragma unroll
                    for (int ks = 0; ks < 2; ++ks) {
                        const float* p = DS + ((size_t)(ci * 4 + h) * 64 + 16 * vt + fr) * 64 + 32 * ks + 8 * fq; const f32x4 lo = *(const f32x4*)p, hi = *(const f32x4*)(p + 4);
                        const float* eg = TOT3 + (h * 2) * 64 + 32 * ks + 8 * fq;
                        u32x4 w; w.x = pk2(lo.x * fexp(eg[0]), lo.y * fexp(eg[1])); w.y = pk2(lo.z * fexp(eg[2]), lo.w * fexp(eg[3])); w.z = pk2(hi.x * fexp(eg[4]), hi.y * fexp(eg[5])); w.w = pk2(hi.z * fexp(eg[6]), hi.w * fexp(eg[7]));
                        sa[vt][ks] = __builtin_bit_cast(bf16x8, w);
                    }
#pragma unroll
                for (int tsel = 0; tsel < 2; ++tsel) {
                    const int ti = half == 0 ? (tsel ? 3 : 0) : (tsel ? 2 : 1);
                    bf16x8 qb[2];
#pragma unroll
                    for (int ks = 0; ks < 2; ++ks) qb[ks] = *(const bf16x8*)(QT3 + (16 * ti + fr) * RS + (64 * h + 32 * ks + 8 * fq) * 2);
                    f32x4 st[4];
#pragma unroll
                    for (int si = 0; si < 4; ++si) { st[si] = (f32x4){0.f, 0.f, 0.f, 0.f};
                        if (si <= ti) {
#pragma unroll
                            for (int ks = 0; ks < 2; ++ks) { const bf16x8 ka = *(const bf16x8*)(KT3 + (16 * si + fr) * RS + (64 * h + 32 * ks + 8 * fq) * 2); st[si] = __builtin_amdgcn_mfma_f32_16x16x32_bf16(ka, qb[ks], st[si], 0, 0, 0); }
                            if (si == ti) {
#pragma unroll
                                for (int r = 0; r < 4; ++r) if (4 * fq + r > fr) st[si][r] = 0.f; }
                        } }
                    f32x4 oo[4];
#pragma unroll
                    for (int vt = 0; vt < 4; ++vt) { oo[vt] = (f32x4){0.f, 0.f, 0.f, 0.f};
#pragma unroll
                        for (int ks = 0; ks < 2; ++ks) oo[vt] = __builtin_amdgcn_mfma_f32_16x16x32_bf16(sa[vt][ks], qb[ks], oo[vt], 0, 0, 0); }
#pragma unroll
                    for (int p = 0; p < 2; ++p) if (2 * p <= ti) {
                        u32x4 bw; bw.x = pk2(st[2 * p][0], st[2 * p][1]); bw.y = pk2(st[2 * p][2], st[2 * p][3]); bw.z = pk2(st[2 * p + 1][0], st[2 * p + 1][1]); bw.w = pk2(st[2 * p + 1][2], st[2 * p + 1][3]);
                        const bf16x8 bfr = __builtin_bit_cast(bf16x8, bw);
#pragma unroll
                        for (int vt = 0; vt < 4; ++vt) { const int vrow = 64 * h + 16 * vt + fr; const u32x2 lo8 = *(const u32x2*)(VT3 + vt_off(vrow, 32 * p + 4 * fq)), hi8 = *(const u32x2*)(VT3 + vt_off(vrow, 32 * p + 16 + 4 * fq));
                            u32x4 aw; aw.x = lo8.x; aw.y = lo8.y; aw.z = hi8.x; aw.w = hi8.y;
                            oo[vt] = __builtin_amdgcn_mfma_f32_16x16x32_bf16(__builtin_bit_cast(bf16x8, aw), bfr, oo[vt], 0, 0, 0); }
                    }
                    float ss = 0.f;
#pragma unroll
                    for (int vt = 0; vt < 4; ++vt) ss += (oo[vt][0] * oo[vt][0] + oo[vt][1] * oo[vt][1]) + (oo[vt][2] * oo[vt][2] + oo[vt][3] * oo[vt][3]);
                    ss += __shfl_xor(ss, 16); ss += __shfl_xor(ss, 32);
                    const float rs = __builtin_amdgcn_rsqf(ss * (1.0f / HD) + 1e-5f);
#pragma unroll
                    for (int vt = 0; vt < 4; ++vt) { const int cv = 64 * h + 16 * vt + 4 * fq; u32x2* pog = (u32x2*)(OG3 + (16 * ti + fr) * RS + cv * 2); const u32x2 og = *pog; const f32x4 ng = *(const f32x4*)(norm_g + 16 * vt + 4 * fq);
                        u32x2 w; w.x = pk2(oo[vt][0] * rs * ng.x * siluf_(bf2f(og.x & 0xffffu)), oo[vt][1] * rs * ng.y * siluf_(bf2f(og.x >> 16))); w.y = pk2(oo[vt][2] * rs * ng.z * siluf_(bf2f(og.y & 0xffffu)), oo[vt][3] * rs * ng.w * siluf_(bf2f(og.y >> 16)));
                        *pog = w; }
                }
                __syncthreads();
            }
            ytile_store(OG3, yrow + 256, tid);
            __syncthreads();
        }
    } break;

    case PH_OUTPROJ: {
        PHASE_ENTER
        pg8::Gemm g{Y, (const bf16*)(ws + WS_WOUT) + (size_t)L * D * D, NTOK, D, D}; pg8::StaticOrder S; S.init(NTOK, D, G, bid);
        pg8::EpiResidF32 E{L == 0 ? IN(0) : hres, hres};
        pg8::gemm_phase<pg8::EpiResidF32, pg8::StaticOrder, true, true>((PG8_LAS unsigned char*)lds_raw, g, S, E, tid);
    } break;

    case PH_NORM: {
        PHASE_ENTER
        const float* g = pass == 0 ? IN(16) + L * D : IN(15) + D;
        const bool route = (L == 1 && pass == 0);
        int* sel = (int*)lds_raw;
        const float* wr_ = IN(20);
        for (int blk = bid; blk < NTOK / 64; blk += G) {
            for (int r8 = 0; r8 < 8; ++r8) {
                const int tl = wid * 8 + r8, m = blk * 64 + tl;
                const f32x4* xr = (const f32x4*)(hres + (size_t)m * D); const f32x4* gr = (const f32x4*)g;
                f32x4 v[4]; float s = 0.f;
#pragma unroll
                for (int j = 0; j < 4; ++j) { v[j] = xr[lane + 64 * j]; s += (v[j].x * v[j].x + v[j].y * v[j].y) + (v[j].z * v[j].z + v[j].w * v[j].w); }
                const float r = 1.0f / sqrtf(wave_sum(s) * (1.0f / D) + 1e-6f);
                u32x2* o8 = (u32x2*)(HN + (size_t)m * D);
                float lg[8] = {0.f, 0.f, 0.f, 0.f, 0.f, 0.f, 0.f, 0.f};
#pragma unroll
                for (int j = 0; j < 4; ++j) {
                    const f32x4 gv = gr[lane + 64 * j]; const f32x4 y = (f32x4){v[j].x * r * gv.x, v[j].y * r * gv.y, v[j].z * r * gv.z, v[j].w * r * gv.w};
                    if (!route) { u32x2 w; w.x = pk2(y.x, y.y); w.y = pk2(y.z, y.w); o8[lane + 64 * j] = w; }
                    if (route) {
                        const int i0 = 4 * (lane + 64 * j);
#pragma unroll
                        for (int q = 0; q < 4; ++q) { const float yv = q == 0 ? y.x : q == 1 ? y.y : q == 2 ? y.z : y.w; const f32x4 w0 = *(const f32x4*)(wr_ + (size_t)(i0 + q) * 8), w1 = *(const f32x4*)(wr_ + (size_t)(i0 + q) * 8 + 4);
                            lg[0] += yv * w0.x; lg[1] += yv * w0.y; lg[2] += yv * w0.z; lg[3] += yv * w0.w; lg[4] += yv * w1.x; lg[5] += yv * w1.y; lg[6] += yv * w1.z; lg[7] += yv * w1.w; }
                    }
                }
                if (route) {
#pragma unroll
                    for (int e = 0; e < 8; ++e) lg[e] = wave_sum(lg[e]);
                    if (lane == 0) {
                        int e1 = 0; float l1 = lg[0];
#pragma unroll
                        for (int e = 1; e < 8; ++e) if (lg[e] > l1) { l1 = lg[e]; e1 = e; }
                        int e2 = -1; float l2 = -3.0e38f;
#pragma unroll
                        for (int e = 0; e < 8; ++e) if (e != e1 && lg[e] > l2) { l2 = lg[e]; e2 = e; }
                        const float g1 = 1.0f / (1.0f + fexp(l2 - l1));
                        TOKE[m * 2] = e1; TOKE[m * 2 + 1] = e2; TOKG[m * 2] = g1; TOKG[m * 2 + 1] = 1.0f - g1;
                        sel[tl * 2] = e1; sel[tl * 2 + 1] = e2; RSTD[m] = r;
                    }
                }
            }
            if (route) {
                __syncthreads();
                if (tid < NE) { int cnt = 0; for (int q = 0; q < 128; ++q) if (sel[q] == tid) { TOKR[blk * 128 + q] = cnt; ++cnt; } BCNT[blk * NE + tid] = cnt; }
                __syncthreads();
            }
        }
    } break;

    case PH_FFNUP: {
        PHASE_ENTER
        pg8::Gemm g{HN, (const bf16*)(ws + WS_WGU), NTOK, 2 * DFF, D}; pg8::StaticOrder S; S.init(NTOK, 2 * DFF, G, bid);
        pg8::EpiSwiglu E{HID, DFF, 0};
        pg8::gemm_phase<pg8::EpiSwiglu, pg8::StaticOrder, true, true>((PG8_LAS unsigned char*)lds_raw, g, S, E, tid);
    } break;

    case PH_FFNDOWN: {
        PHASE_ENTER
        pg8::Gemm g{HID, (const bf16*)(ws + WS_WD), NTOK, D, DFF}; pg8::StaticOrder S; S.init(NTOK, D, G, bid);
        pg8::EpiResidF32 E{hres, hres};
        pg8::gemm_phase<pg8::EpiResidF32, pg8::StaticOrder, true, true>((PG8_LAS unsigned char*)lds_raw, g, S, E, tid);
    } break;

    case PH_DISPATCH: {
        PHASE_ENTER
        int* sh = (int*)lds_raw;
        const f32x4* gr = (const f32x4*)(IN(16) + D);
        for (int blk = bid; blk < NTOK / 64; blk += G) {
            if (tid < NE) { int tot = 0, base = 0; for (int b2 = 0; b2 < NTOK / 64; ++b2) { const int c = BCNT[b2 * NE + tid]; if (b2 < blk) base += c; tot += c; } sh[tid] = tot; sh[16 + tid] = base; sh[24 + tid] = (tot + 255) >> 8; }
            __syncthreads();
            if (tid == 0) { int acc = 0; for (int e = 0; e < NE; ++e) { sh[8 + e] = acc * 256; acc += sh[24 + e]; } sh[32] = acc; }
            __syncthreads();
            if (tid < 128) { const int m = blk * 64 + (tid >> 1); const int e = TOKE[blk * 128 + tid]; const int r = sh[8 + e] + sh[16 + e] + TOKR[blk * 128 + tid];
                ROWDST[r] = m * 2 + (tid & 1); ROWG[r] = TOKG[blk * 128 + tid]; }
            for (int r8 = 0; r8 < 8; ++r8) {
                const int m = blk * 64 + wid * 8 + r8; const int e0 = TOKE[m * 2], e1 = TOKE[m * 2 + 1];
                const int r0 = sh[8 + e0] + sh[16 + e0] + TOKR[m * 2], r1 = sh[8 + e1] + sh[16 + e1] + TOKR[m * 2 + 1];
                const float rs = RSTD[m]; const f32x4* xr = (const f32x4*)(hres + (size_t)m * D);
                unsigned* o0 = (unsigned*)(XR + (size_t)r0 * D); unsigned* o1 = (unsigned*)(XR + (size_t)r1 * D);
#pragma unroll
                for (int j = 0; j < 4; ++j) { const f32x4 v = xr[lane + 64 * j], gv = gr[lane + 64 * j]; const unsigned w = pg8::pk4_fp8(v.x * rs * gv.x, v.y * rs * gv.y, v.z * rs * gv.z, v.w * rs * gv.w); o0[lane + 64 * j] = w; o1[lane + 64 * j] = w; }
            }
            if (blk == 0) {
                for (int e = 0; e < NE; ++e) { const int lo = sh[8 + e] + sh[e], hi = sh[8 + e] + sh[24 + e] * 256; for (int r = lo + tid; r < hi; r += NT) { ROWDST[r] = -1; ROWG[r] = 0.f; } }
                if (tid < MAXTILES) { int e = 0; for (int q = 0; q < NE; ++q) if (tid * 256 >= sh[8 + q]) e = q; TILEE[tid] = e; }
                if (tid == 0) TILEE[MAXTILES] = sh[32];
            }
            __syncthreads();
        }
    } break;

    case PH_MOEUP: {
        PHASE_ENTER
        const int ntiles = __builtin_amdgcn_readfirstlane(__hip_atomic_load(TILEE + MAXTILES, __ATOMIC_RELAXED, __HIP_MEMORY_SCOPE_AGENT));
        pg8::Gemm g{(const bf16*)XR, (const bf16*)(ws + WS_W13), 0, 0, D / 2}; pg8::MoeOrder S; S.init(ntiles, DFFE / 128, G, bid, 0, 0, TILEE);
        pg8::EpiSwiglu8 E{HIDE, DFFE, 1.0f / W13_SCALE, HID_SCALE};
        pg8::gemm_phase<pg8::EpiSwiglu8, pg8::MoeOrder, true, true, true>((PG8_LAS unsigned char*)lds_raw, g, S, E, tid);
    } break;

    case PH_MOEDOWN: {
        PHASE_ENTER
        const int ntiles = __builtin_amdgcn_readfirstlane(__hip_atomic_load(TILEE + MAXTILES, __ATOMIC_RELAXED, __HIP_MEMORY_SCOPE_AGENT));
        pg8::Gemm g{(const bf16*)HIDE, (const bf16*)(ws + WS_W2), 0, 0, DFFE / 2}; pg8::MoeOrder S; S.init(ntiles, D / 256, G, bid, 0, 0, TILEE);
        pg8::EpiMoeDown E{OUT2, ROWDST, ROWG, 1.0f / (W2_SCALE * HID_SCALE)};
        pg8::gemm_phase<pg8::EpiMoeDown, pg8::MoeOrder, true, true, true>((PG8_LAS unsigned char*)lds_raw, g, S, E, tid);
    } break;

    case PH_FINAL: {
        PHASE_ENTER
        const float* g = IN(24); const int gw = bid * 8 + wid, NGW = G * 8;
        for (int m = gw; m < NTOK; m += NGW) {
            f32x4* xr = (f32x4*)(hres + (size_t)m * D); const f32x4* gr = (const f32x4*)g;
            const u32x2* o0 = (const u32x2*)(OUT2 + (size_t)(2 * m) * D); const u32x2* o1 = (const u32x2*)(OUT2 + (size_t)(2 * m + 1) * D);
            f32x4 v[4]; float s = 0.f;
#pragma unroll
            for (int j = 0; j < 4; ++j) {
                v[j] = xr[lane + 64 * j]; const u32x2 p = o0[lane + 64 * j], q = o1[lane + 64 * j];
                v[j].x += bf2f(p.x & 0xffffu) + bf2f(q.x & 0xffffu); v[j].y += bf2f(p.x >> 16) + bf2f(q.x >> 16);
                v[j].z += bf2f(p.y & 0xffffu) + bf2f(q.y & 0xffffu); v[j].w += bf2f(p.y >> 16) + bf2f(q.y >> 16);
                s += (v[j].x * v[j].x + v[j].y * v[j].y) + (v[j].z * v[j].z + v[j].w * v[j].w);
            }
            const float r = 1.0f / sqrtf(wave_sum(s) * (1.0f / D) + 1e-6f);
#pragma unroll
            for (int j = 0; j < 4; ++j) { const f32x4 gv = gr[lane + 64 * j]; xr[lane + 64 * j] = (f32x4){v[j].x * r * gv.x, v[j].y * r * gv.y, v[j].z * r * gv.z, v[j].w * r * gv.w}; }
        }
    } break;
    }
    if (step + 1 < a.ph_hi) { int t_ = wid_s * 64 + (int)__builtin_amdgcn_mbcnt_hi(~0u, __builtin_amdgcn_mbcnt_lo(~0u, 0u)); asm volatile("" : "+v"(t_)); xcd_barrier(bar, t_ == 0); }
#ifdef REP_STEP
    if (step == REP_STEP && rep_left > 0) { --rep_left; --step; }
#endif
    }
}

constexpr int NSTEPS = 20;
#ifndef MK_PER_PHASE
#define MK_PER_PHASE 0
#endif

extern "C" void kernel_launch(void* const* d_in, const int* in_sizes, int n_in, void* d_out, int out_size, void* d_ws, size_t ws_size, hipStream_t stream) {
    static int grid = 0;
    if (grid == 0) {
        if (n_in != 25 || out_size != NTOK * D || ws_size < WS_END) { fprintf(stderr, "kernel_launch: unexpected shapes (n_in %d out %d ws %zu need %zu)\n", n_in, out_size, ws_size, (size_t)WS_END); grid = -1; return; }
        int dev = 0, cus = 0, per_cu = 0;
        if (hipGetDevice(&dev) != hipSuccess || hipDeviceGetAttribute(&cus, hipDeviceAttributeMultiprocessorCount, dev) != hipSuccess) { grid = -1; return; }
        if (hipFuncSetAttribute((const void*)fwd, hipFuncAttributeMaxDynamicSharedMemorySize, LDS_BYTES) != hipSuccess) { fprintf(stderr, "kernel_launch: hipFuncSetAttribute failed\n"); grid = -1; return; }
        if (hipOccupancyMaxActiveBlocksPerMultiprocessor(&per_cu, (const void*)fwd, NT, LDS_BYTES) != hipSuccess || per_cu < 1) { fprintf(stderr, "kernel_launch: occupancy query says %d blocks/CU\n", per_cu); (void)hipGetLastError(); grid = -1; return; }
        grid = cus;
    }
    if (grid < 0) return;
    hipMemsetAsync((char*)d_ws + WS_CTL, 0, 1 * MiB, stream);
    Args a{};
    for (int i = 0; i < 25; ++i) a.in[i] = (const float*)d_in[i];
    a.out = (float*)d_out; a.ws = (unsigned char*)d_ws;
#if MK_PER_PHASE
    for (int s = 0; s < NSTEPS; ++s) { a.ph_lo = s; a.ph_hi = s + 1; hipLaunchKernelGGL(fwd, dim3(grid), dim3(NT), LDS_BYTES, stream, a); }
#else
    a.ph_lo = 0; a.ph_hi = NSTEPS;
    hipLaunchKernelGGL(fwd, dim3(grid), dim3(NT), LDS_BYTES, stream, a);
#endif
}
```

```cpp
#include <hip/hip_runtime.h>
#include <cstdint>
#include <cstdio>

typedef unsigned short bf16;
typedef short bf16x8 __attribute__((ext_vector_type(8)));
typedef float f32x4 __attribute__((ext_vector_type(4)));
typedef unsigned u32x4 __attribute__((ext_vector_type(4)));
typedef unsigned u32x2 __attribute__((ext_vector_type(2)));

constexpr int NTOK = 16384, SEQ = 8192, D = 1024, DIN = 2560, GW = 256, HD = 64, DFF = 2816, DFFE = 3584, NE = 8;
constexpr int CH = 64, NCHUNK = NTOK / CH, CPB = SEQ / CH;
constexpr int NT = 512;
constexpr float W13_SCALE = 64.f, W2_SCALE = 128.f, HID_SCALE = 8.f;
constexpr int MAXTILES = NTOK * 2 / 256 + NE;

constexpr size_t MiB = 1u << 20;
constexpr size_t WS_CTL = 0;
constexpr size_t WS_SMALL = 1 * MiB;
constexpr size_t WS_WIN = 5 * MiB;
constexpr size_t WS_WOUT = 15 * MiB;
constexpr size_t WS_WGU = 19 * MiB;
constexpr size_t WS_WD = 30 * MiB;
constexpr size_t WS_W13 = 36 * MiB;
constexpr size_t WS_W2 = 92 * MiB;
constexpr size_t WS_ACT = 120 * MiB;
constexpr size_t WS_HN = WS_ACT;
constexpr size_t WS_PROJ = WS_ACT + 32 * MiB;
constexpr size_t WS_Y = WS_ACT + 112 * MiB;
constexpr size_t WS_DS = WS_ACT + 144 * MiB;
constexpr size_t WS_HID = WS_PROJ;
constexpr size_t WS_XR = WS_ACT;
constexpr size_t WS_HIDE = WS_ACT + 34 * MiB;
constexpr size_t WS_OUT2 = WS_ACT + 153 * MiB;
constexpr size_t WS_END = WS_ACT + 217 * MiB;
constexpr size_t SM_TOKE = 0;
constexpr size_t SM_TOKG = 128 * 1024;
constexpr size_t SM_TOKR = 256 * 1024;
constexpr size_t SM_BCNT = 384 * 1024;
constexpr size_t SM_ROWTOK = 400 * 1024;
constexpr size_t SM_ROWDST = 544 * 1024;
constexpr size_t SM_ROWG = 688 * 1024;
constexpr size_t SM_TILEE = 832 * 1024;
constexpr size_t SM_CARA = 1024 * 1024;
constexpr size_t SM_CARH = 1280 * 1024;
constexpr size_t SM_CIN = 1536 * 1024;
constexpr size_t SM_DEC = 1792 * 1024;
constexpr size_t SM_RSTD = 2048 * 1024;
constexpr size_t SM_WTA = 2304 * 1024;
constexpr size_t SM_WTX = 2368 * 1024;
constexpr size_t SM_WTP = 2432 * 1024;

struct Args {
    const float* in[25];
    float* out;
    unsigned char* ws;
    int ph_lo, ph_hi, pad0, pad1;
};

__device__ __forceinline__ const float* IN(int k) { asm volatile("" : "+s"(k)); return ((const float* const __attribute__((address_space(4)))*)__builtin_amdgcn_kernarg_segment_ptr())[k]; }
__device__ __forceinline__ float bf2f(unsigned v) { return __uint_as_float(v << 16); }
__device__ __forceinline__ unsigned f2bf(float f) { unsigned u = __float_as_uint(f); return (u + 0x7fffu + ((u >> 16) & 1u)) >> 16; }
__device__ __forceinline__ unsigned pk2(float lo, float hi) { return f2bf(lo) | (f2bf(hi) << 16); }
__device__ __forceinline__ float fexp(float x) { return __builtin_amdgcn_exp2f(1.44269504089f * x); }
__device__ __forceinline__ float flog(float x) { return 0.69314718056f * __builtin_amdgcn_logf(x); }
__device__ __forceinline__ float sigmoidf_(float x) { return __builtin_amdgcn_rcpf(1.0f + __builtin_amdgcn_exp2f(-1.44269504089f * x)); }
__device__ __forceinline__ float siluf_(float x) { return x * sigmoidf_(x); }
__device__ __forceinline__ float gelu_tanh(float x) { const float u = 1.5957691216057308f * (x + 0.044715f * x * x * x); return x * sigmoidf_(u); }
__device__ __forceinline__ float neg_expm1_small(float x) { return -x * (1.0f + x * (0.5f + x * (0.16666667f + x * (0.041666668f + x * 0.0083333338f)))); }
__device__ __forceinline__ float wave_sum(float v) {
#pragma unroll
    for (int o = 1; o < 64; o <<= 1) v += __shfl_xor(v, o);
    return v;
}
#define LDS_WAIT() asm volatile("s_waitcnt lgkmcnt(0)" ::: "memory")

namespace pg8 {
#define PG8_LAS __attribute__((address_space(3)))
typedef unsigned short bf16_t;
typedef short bf16x8 __attribute__((ext_vector_type(8)));
typedef float f32x4 __attribute__((ext_vector_type(4)));
typedef unsigned u32x4 __attribute__((ext_vector_type(4)));
constexpr int BM = 256, BK = 64, HALF = 128, HTB = HALF * BK * 2  , STAGE_BYTES = 8 * HTB, NXCD = 8, WGM = 8;

__host__ __device__ __forceinline__ int lds_byte(int r, int c) { const int st = (r >> 4) * 2 + (c >> 5), rr = r & 15, cc = c & 31, ob = rr * 64 + cc * 2; return st * 1024 + (ob ^ (((ob >> 9) & 1) << 5)); }
__host__ __device__ __forceinline__ void stage_rc(int b, int& R, int& C) { const int st = b / 1024, sb = b % 1024, swz = sb ^ (((sb >> 9) & 1) << 5); R = (st >> 1) * 16 + swz / 64; C = (st & 1) * 32 + (swz % 64) / 2; }
__host__ __device__ __forceinline__ int perm32(int rho) { const int n = rho >> 4, i = rho & 15; return 8 * (i >> 2) + 4 * n + (i & 3); }

struct Unit { int pm, pn, pa, pb; };
struct Gemm { const bf16_t* A; const bf16_t* Bt; int M, N, K; };

struct StaticOrder {
    int nM, nN, nwg, G, c;
    __host__ __device__ void init(int M, int N, int G_, int c_) { nM = M / BM; nN = N / BM; nwg = nM * nN; G = G_; c = c_; }
    __host__ __device__ bool next(int i, Unit& u) const {
        const long L = (long)i * G + c; if (L >= nwg) return false;
        int wgid = (int)L; { const int q = nwg / NXCD, r = nwg % NXCD, xcd = wgid % NXCD, off = wgid / NXCD; wgid = (xcd < r ? xcd * (q + 1) : r * (q + 1) + (xcd - r) * q) + off; }
        const int nig = WGM * nN, gid = wgid / nig, fm = gid * WGM, gsz = (nM - fm) < WGM ? (nM - fm) : WGM;
        u.pm = fm + ((wgid % nig) % gsz); u.pn = (wgid % nig) / gsz; u.pa = u.pm; u.pb = u.pn; return true;
    }
    __device__ __forceinline__ void a_ready(const Unit&) const {}
    __device__ __forceinline__ void done(const Unit&) const {}
};

__device__ __forceinline__ unsigned cvt_pk_bf16(float lo, float hi) { unsigned r; asm volatile("v_cvt_pk_bf16_f32 %0, %1, %2" : "=v"(r) : "v"(lo), "v"(hi)); return r; }
typedef float f32x2 __attribute__((ext_vector_type(2)));
typedef int pg8_v8i __attribute__((ext_vector_type(8))); typedef int pg8_v4i __attribute__((ext_vector_type(4)));
__device__ __forceinline__ pg8_v8i pg8_cat(bf16x8 lo, bf16x8 hi) { return __builtin_shufflevector(__builtin_bit_cast(pg8_v4i, lo), __builtin_bit_cast(pg8_v4i, hi), 0, 1, 2, 3, 4, 5, 6, 7); }
__device__ __forceinline__ void pg8_mfma8(f32x4& acc, pg8_v8i a, pg8_v8i b, int sc) { asm volatile("v_mfma_scale_f32_16x16x128_f8f6f4 %0, %1, %2, %0, %3, %3 op_sel_hi:[0,0,0]" : "+v"(acc) : "v"(a), "v"(b), "v"(sc)); }
template <class Epi, class Sched, bool ALIGN_EPI = false, bool SP2 = false, bool F8 = false>
__device__ __forceinline__ void gemm_phase(PG8_LAS unsigned char* lds, const Gemm g, const Sched& S, const Epi& E, int tid_in) {
    int tid = tid_in; asm volatile("" : "+v"(tid));
    const int wid = __builtin_amdgcn_readfirstlane(tid >> 6), lane = tid & 63, wr = wid >> 2, wc = wid & 3, fr = lane & 15, fq = lane >> 4;
    const int K = g.K, nt = K / BK;
    unsigned voffA[2], voffB[2];
#pragma unroll
    for (int i = 0; i < 2; ++i) { int R, C; stage_rc(tid * 16 + i * 8192, R, C); const int Rb = Epi::PERM ? ((R & ~31) + perm32(R & 31)) : R;
        voffA[i] = (unsigned)(R * K + C) * 2u; voffB[i] = (unsigned)(Rb * K + C) * 2u; }
    const size_t kstep = (size_t)(BK * 2);
    const size_t hstep = (size_t)HALF * K * 2;
    const size_t tstep = 2 * hstep;
    const unsigned ldsw = (unsigned)wid * 1024u;
    int f8one = 0x7f7f7f7f; asm volatile("" : "+v"(f8one));
    constexpr int KOFF = F8 ? 16 : 1024;
    const int aoff = lds_byte(wr * 64 + fr, fq * (F8 ? 16 : 8)), boff = lds_byte(wc * 32 + fr, fq * (F8 ? 16 : 8));
#define PG8_SA(b, h) (((b) * 2 + (h)) * HTB)
#define PG8_SB(b, h) ((4 + (b) * 2 + (h)) * HTB)
#define PG8_STAGE(bufoff, gbase, voff) do { _Pragma("unroll") for (int _i = 0; _i < 2; ++_i) \
        __builtin_amdgcn_global_load_lds((const unsigned*)((const char*)(gbase) + (voff)[_i]), (PG8_LAS unsigned*)(lds + (bufoff) + ldsw + _i * 8192), 16, 0, 0); } while (0)
#define PG8_LDA(dst, b, h) do { _Pragma("unroll") for (int m = 0; m < 4; ++m) _Pragma("unroll") for (int k = 0; k < 2; ++k) dst[m][k] = *(const PG8_LAS bf16x8*)(lds + PG8_SA(b, h) + aoff + m * 2048 + k * KOFF); } while (0)
#define PG8_LDB(dst, b, h) do { _Pragma("unroll") for (int n = 0; n < 2; ++n) _Pragma("unroll") for (int k = 0; k < 2; ++k) dst[n][k] = *(const PG8_LAS bf16x8*)(lds + PG8_SB(b, h) + boff + n * 2048 + k * KOFF); } while (0)
#define PG8_MMA(ai, bj, At, Bt) do { __builtin_amdgcn_s_setprio(1); if constexpr (F8) { _Pragma("unroll") for (int m = 0; m < 4; ++m) _Pragma("unroll") for (int n = 0; n < 2; ++n) \
        pg8_mfma8(acc[ai][bj][m][n], pg8_cat(Bt[n][0], Bt[n][1]), pg8_cat(At[m][0], At[m][1]), f8one); } \
    else { _Pragma("unroll") for (int m = 0; m < 4; ++m) _Pragma("unroll") for (int n = 0; n < 2; ++n) _Pragma("unroll") for (int k = 0; k < 2; ++k) \
        acc[ai][bj][m][n] = __builtin_amdgcn_mfma_f32_16x16x32_bf16(Bt[n][k], At[m][k], acc[ai][bj][m][n], 0, 0, 0); } __builtin_amdgcn_s_setprio(0); } while (0)
#define PG8_WAIT_V(n) asm volatile("s_waitcnt vmcnt(" #n ")" ::: "memory")
#define PG8_WAIT_L(n) asm volatile("s_waitcnt lgkmcnt(" #n ")" ::: "memory")
#define PG8_BAR __builtin_amdgcn_s_barrier()
#define PG8_SCHED __builtin_amdgcn_sched_barrier(0)
    Unit cur, nxt; int ui = 0;
    if (!S.next(0, cur)) return;
    f32x4 acc[2][2][4][2];
#pragma unroll
    for (int a = 0; a < 2; ++a)
#pragma unroll
        for (int b = 0; b < 2; ++b)
#pragma unroll
            for (int m = 0; m < 4; ++m)
#pragma unroll
                for (int n = 0; n < 2; ++n) acc[a][b][m][n] = (f32x4){0.f, 0.f, 0.f, 0.f};
    bf16x8 At[4][2], B0[2][2], B1[2][2];
    const char* cA = (const char*)g.A + (size_t)cur.pa * tstep; const char* cB = (const char*)g.Bt + (size_t)cur.pb * tstep;
    S.a_ready(cur);
    if constexpr (SP2) {
        PG8_STAGE(PG8_SB(0, 0), cB, voffB); PG8_STAGE(PG8_SB(0, 1), cB + hstep, voffB); PG8_STAGE(PG8_SA(0, 0), cA, voffA); PG8_STAGE(PG8_SA(0, 1), cA + hstep, voffA);
        if (wr == 1) PG8_BAR;
        PG8_WAIT_V(2); PG8_BAR;
        PG8_STAGE(PG8_SB(1, 0), cB + kstep, voffB); PG8_STAGE(PG8_SA(1, 0), cA + kstep, voffA); PG8_STAGE(PG8_SB(1, 1), cB + hstep + kstep, voffB);
        PG8_WAIT_V(6); PG8_BAR;
    } else {
        PG8_STAGE(PG8_SB(0, 0), cB, voffB); PG8_STAGE(PG8_SA(0, 0), cA, voffA); PG8_STAGE(PG8_SB(0, 1), cB + hstep, voffB); PG8_STAGE(PG8_SA(0, 1), cA + hstep, voffA);
        if (wr == 1) PG8_BAR;
        PG8_WAIT_V(4); PG8_BAR;
        PG8_STAGE(PG8_SB(1, 0), cB + kstep, voffB); PG8_STAGE(PG8_SA(1, 0), cA + kstep, voffA); PG8_STAGE(PG8_SB(1, 1), cB + hstep + kstep, voffB);
        PG8_WAIT_V(6); PG8_BAR;
    }
    for (;;) {
        const bool has_next = S.next(ui + 1, nxt);
        const char* nA = has_next ? (const char*)g.A + (size_t)nxt.pa * tstep : cA; const char* nB = has_next ? (const char*)g.Bt + (size_t)nxt.pb * tstep : cB;
        for (int t = 0; t < nt; t += 2) {
            const bool last = (t == nt - 2);
            const char* a1 = cA + (size_t)(t + 1) * kstep;
            const char* a2 = last ? nA : cA + (size_t)(t + 2) * kstep; const char* b2 = last ? nB : cB + (size_t)(t + 2) * kstep;
            const char* a3 = a2 + kstep; const char* b3 = b2 + kstep;
            if (last && has_next) S.a_ready(nxt);
            if constexpr (SP2) {
            PG8_LDB(B0, 0, 0); PG8_LDB(B1, 0, 1); PG8_SCHED; PG8_LDA(At, 0, 0); PG8_STAGE(PG8_SA(1, 1), a1 + hstep, voffA);
            PG8_WAIT_V(8); PG8_WAIT_L(0); PG8_BAR; PG8_MMA(0, 0, At, B0); PG8_MMA(0, 1, At, B1); PG8_BAR; PG8_SCHED;
            PG8_LDA(At, 0, 1); PG8_STAGE(PG8_SB(0, 0), b2, voffB); PG8_STAGE(PG8_SB(0, 1), b2 + hstep, voffB); PG8_STAGE(PG8_SA(0, 0), a2, voffA);
            PG8_WAIT_V(8); PG8_WAIT_L(0); PG8_BAR; PG8_MMA(1, 0, At, B0); PG8_MMA(1, 1, At, B1); PG8_BAR; PG8_SCHED;
            PG8_LDB(B0, 1, 0); PG8_LDB(B1, 1, 1); PG8_SCHED; PG8_LDA(At, 1, 0); PG8_STAGE(PG8_SA(0, 1), a2 + hstep, voffA);
            PG8_WAIT_V(8); PG8_WAIT_L(0); PG8_BAR; PG8_MMA(0, 0, At, B0); PG8_MMA(0, 1, At, B1); PG8_BAR; PG8_SCHED;
            PG8_LDA(At, 1, 1); PG8_STAGE(PG8_SB(1, 0), b3, voffB); PG8_STAGE(PG8_SB(1, 1), b3 + hstep, voffB); PG8_STAGE(PG8_SA(1, 0), a3, voffA);
            PG8_WAIT_V(8); PG8_WAIT_L(0); PG8_BAR; PG8_MMA(1, 0, At, B0); PG8_MMA(1, 1, At, B1); PG8_BAR; PG8_SCHED;
            } else {
            PG8_LDB(B0, 0, 0); PG8_SCHED; PG8_LDA(At, 0, 0); PG8_STAGE(PG8_SA(1, 1), a1 + hstep, voffA);
            PG8_WAIT_L(8); PG8_BAR; PG8_WAIT_L(0); PG8_MMA(0, 0, At, B0); PG8_BAR; PG8_SCHED;
            PG8_LDB(B1, 0, 1); PG8_STAGE(PG8_SB(0, 0), b2, voffB);
            PG8_BAR; PG8_WAIT_L(0); PG8_MMA(0, 1, At, B1); PG8_BAR;
            PG8_LDA(At, 0, 1); PG8_STAGE(PG8_SA(0, 0), a2, voffA);
            PG8_BAR; PG8_WAIT_L(0); PG8_MMA(1, 0, At, B0); PG8_BAR; PG8_SCHED;
            PG8_STAGE(PG8_SB(0, 1), b2 + hstep, voffB);
            PG8_WAIT_V(6); PG8_BAR; PG8_MMA(1, 1, At, B1); PG8_BAR;
            PG8_LDB(B0, 1, 0); PG8_SCHED; PG8_LDA(At, 1, 0); PG8_STAGE(PG8_SA(0, 1), a2 + hstep, voffA);
            PG8_WAIT_L(8); PG8_BAR; PG8_WAIT_L(0); PG8_MMA(0, 0, At, B0); PG8_BAR; PG8_SCHED;
            PG8_LDB(B1, 1, 1); PG8_STAGE(PG8_SB(1, 0), b3, voffB);
            PG8_BAR; PG8_WAIT_L(0); PG8_MMA(0, 1, At, B1); PG8_BAR;
            PG8_LDA(At, 1, 1); PG8_STAGE(PG8_SA(1, 0), a3, voffA);
            PG8_BAR; PG8_WAIT_L(0); PG8_MMA(1, 0, At, B0); PG8_BAR; PG8_SCHED;
            PG8_STAGE(PG8_SB(1, 1), b3 + hstep, voffB);
            PG8_WAIT_V(6); PG8_BAR; PG8_MMA(1, 1, At, B1); PG8_BAR;
            }
        }
        if constexpr (F8) asm volatile("s_nop 15\n\ts_nop 15" ::: "memory");
        if constexpr (ALIGN_EPI) { if (wr == 0) PG8_BAR; }
        if constexpr (!Epi::AFTER_DRAIN) { E(acc, cur, wr, wc, fr, fq); S.done(cur); }
        if (!has_next) break;
#pragma unroll
        for (int a = 0; a < 2; ++a)
#pragma unroll
            for (int b = 0; b < 2; ++b)
#pragma unroll
                for (int m = 0; m < 4; ++m)
#pragma unroll
                    for (int n = 0; n < 2; ++n) acc[a][b][m][n] = (f32x4){0.f, 0.f, 0.f, 0.f};
        cur = nxt; cA = nA; cB = nB; ++ui;
        if constexpr (ALIGN_EPI) { if (wr == 1) PG8_BAR; }
    }
    PG8_WAIT_V(0);
    if constexpr (!ALIGN_EPI) { if (wr == 0) PG8_BAR; }
    PG8_BAR;
    if constexpr (Epi::AFTER_DRAIN) { E.fused(acc, cur, wr, wc, fr, fq, lds, wid, lane); S.done(cur); }
#undef PG8_SA
#undef PG8_SB
#undef PG8_STAGE
#undef PG8_LDA
#undef PG8_LDB
#undef PG8_MMA
#undef PG8_WAIT_V
#undef PG8_WAIT_L
#undef PG8_BAR
#undef PG8_SCHED
}

struct EpiStoreBf16 {
    static constexpr bool PERM = true, AFTER_DRAIN = false;
    bf16_t* O; int ldc;
    __device__ __forceinline__ void operator()(const f32x4 (&acc)[2][2][4][2], const Unit& u, int wr, int wc, int fr, int fq) const {
        const int row0 = u.pm * BM + wr * 64 + fr, col0 = u.pn * BM + wc * 32 + 8 * fq;
#pragma unroll
        for (int ai = 0; ai < 2; ++ai)
#pragma unroll
            for (int m = 0; m < 4; ++m) { bf16_t* rowp = O + (size_t)(row0 + ai * HALF + m * 16) * ldc + col0;
#pragma unroll
                for (int bj = 0; bj < 2; ++bj) { const f32x4 v0 = acc[ai][bj][m][0], v1 = acc[ai][bj][m][1];
                    u32x4 w; w.x = cvt_pk_bf16(v0[0], v0[1]); w.y = cvt_pk_bf16(v0[2], v0[3]); w.z = cvt_pk_bf16(v1[0], v1[1]); w.w = cvt_pk_bf16(v1[2], v1[3]);
                    *(u32x4*)(rowp + bj * HALF) = w; } }
    }
};
struct EpiResidF32 {
    static constexpr bool PERM = false, AFTER_DRAIN = false;
    const float* base; float* out;
    __device__ __forceinline__ void operator()(const f32x4 (&acc)[2][2][4][2], const Unit& u, int wr, int wc, int fr, int fq) const {
        const int row0 = u.pm * BM + wr * 64 + fr, col0 = u.pn * BM + wc * 32 + 4 * fq;
#pragma unroll
        for (int ai = 0; ai < 2; ++ai)
#pragma unroll
            for (int m = 0; m < 4; ++m) { const size_t off = (size_t)(row0 + ai * HALF + m * 16) * 1024 + col0;
#pragma unroll
                for (int bj = 0; bj < 2; ++bj)
#pragma unroll
                    for (int n = 0; n < 2; ++n) { const f32x4 b = *(const f32x4*)(base + off + bj * HALF + n * 16); *(f32x4*)(out + off + bj * HALF + n * 16) = b + acc[ai][bj][m][n]; } }
    }
};
__device__ __forceinline__ float silu_f(float x) { return x * __builtin_amdgcn_rcpf(1.0f + __builtin_amdgcn_exp2f(-1.44269504089f * x)); }
struct EpiSwiglu {
    static constexpr bool PERM = true, AFTER_DRAIN = false;
    bf16_t* C; int ldc; int row_off;
    __device__ __forceinline__ void operator()(const f32x4 (&acc)[2][2][4][2], const Unit& u, int wr, int wc, int fr, int fq) const {
        const int row0 = u.pm * BM + wr * 64 + fr - row_off, col0 = u.pn * HALF + wc * 32 + 8 * fq;
#pragma unroll
        for (int ai = 0; ai < 2; ++ai)
#pragma unroll
            for (int m = 0; m < 4; ++m) { bf16_t* rowp = C + (size_t)(row0 + ai * HALF + m * 16) * ldc + col0;
                const f32x4 g0 = acc[ai][0][m][0], g1 = acc[ai][0][m][1], u0 = acc[ai][1][m][0], u1 = acc[ai][1][m][1];
                u32x4 w; w.x = cvt_pk_bf16(silu_f(g0[0]) * u0[0], silu_f(g0[1]) * u0[1]); w.y = cvt_pk_bf16(silu_f(g0[2]) * u0[2], silu_f(g0[3]) * u0[3]);
                w.z = cvt_pk_bf16(silu_f(g1[0]) * u1[0], silu_f(g1[1]) * u1[1]); w.w = cvt_pk_bf16(silu_f(g1[2]) * u1[2], silu_f(g1[3]) * u1[3]);
                *(u32x4*)rowp = w; }
    }
};
struct EpiMoeDown {
    static constexpr bool PERM = true, AFTER_DRAIN = false;
    bf16_t* out2; const int* rowdst; const float* rowg; float sc;
    __device__ __forceinline__ void operator()(const f32x4 (&acc)[2][2][4][2], const Unit& u, int wr, int wc, int fr, int fq) const {
        const int row0 = u.pm * BM + wr * 64 + fr, col0 = u.pn * BM + wc * 32 + 8 * fq;
#pragma unroll
        for (int ai = 0; ai < 2; ++ai)
#pragma unroll
            for (int m = 0; m < 4; ++m) { const int gr = row0 + ai * HALF + m * 16; const int d = rowdst[gr]; const float g = rowg[gr] * sc;
                if (d >= 0) { bf16_t* rowp = out2 + (size_t)d * 1024 + col0;
#pragma unroll
                    for (int bj = 0; bj < 2; ++bj) { const f32x4 v0 = acc[ai][bj][m][0] * g, v1 = acc[ai][bj][m][1] * g;
                        u32x4 w; w.x = cvt_pk_bf16(v0[0], v0[1]); w.y = cvt_pk_bf16(v0[2], v0[3]); w.z = cvt_pk_bf16(v1[0], v1[1]); w.w = cvt_pk_bf16(v1[2], v1[3]);
                        *(u32x4*)(rowp + bj * HALF) = w; } } }
    }
};

__device__ __forceinline__ unsigned pk4_fp8(float a, float b, float c, float d) { int w = __builtin_amdgcn_cvt_pk_fp8_f32(a, b, 0, false); w = __builtin_amdgcn_cvt_pk_fp8_f32(c, d, w, true); return (unsigned)w; }
struct EpiSwiglu8 {
    static constexpr bool PERM = true, AFTER_DRAIN = false;
    unsigned char* C; int ldc; float isc, osc;
    __device__ __forceinline__ void operator()(const f32x4 (&acc)[2][2][4][2], const Unit& u, int wr, int wc, int fr, int fq) const {
        const int row0 = u.pm * BM + wr * 64 + fr, col0 = u.pn * HALF + wc * 32 + 8 * fq; const float us = isc * osc;
#pragma unroll
        for (int ai = 0; ai < 2; ++ai)
#pragma unroll
            for (int m = 0; m < 4; ++m) { unsigned char* rowp = C + (size_t)(row0 + ai * HALF + m * 16) * ldc + col0;
                const f32x4 g0 = acc[ai][0][m][0] * isc, g1 = acc[ai][0][m][1] * isc, u0 = acc[ai][1][m][0] * us, u1 = acc[ai][1][m][1] * us;
                typedef unsigned u32x2e __attribute__((ext_vector_type(2))); u32x2e w;
                w.x = pk4_fp8(silu_f(g0[0]) * u0[0], silu_f(g0[1]) * u0[1], silu_f(g0[2]) * u0[2], silu_f(g0[3]) * u0[3]);
                w.y = pk4_fp8(silu_f(g1[0]) * u1[0], silu_f(g1[1]) * u1[1], silu_f(g1[2]) * u1[2], silu_f(g1[3]) * u1[3]);
                *(u32x2e*)rowp = w; }
    }
};
struct MoeOrder {
    StaticOrder so; int tlo, nN, a_off; const int* tilee;
    __device__ void init(int nrt, int nN_, int G, int c, int tlo_, int a_off_, const int* tilee_) { so.init(nrt * BM, nN_ * BM, G, c); tlo = tlo_; nN = nN_; a_off = a_off_; tilee = tilee_; }
    __device__ bool next(int i, Unit& u) const { if (!so.next(i, u)) return false; u.pm += tlo; u.pa = u.pm - a_off; const int e = __builtin_amdgcn_readfirstlane(__hip_atomic_load(tilee + u.pm, __ATOMIC_RELAXED, __HIP_MEMORY_SCOPE_AGENT)); u.pb = e * nN + u.pn; return true; }
    __device__ __forceinline__ void a_ready(const Unit&) const {}
    __device__ __forceinline__ void done(const Unit&) const {}
};
}

__device__ __forceinline__ void cvt_item(const float* W, int K, int N, bf16* WT, int mode, int item, float* scr, int lane) {
    const int nblk = N / 32, kb = item / nblk, nb = item % nblk, k0 = 64 * kb, n0 = 32 * nb;
    { f32x4 v[8]; const float* src = W + (size_t)(k0 + (lane >> 3)) * N + n0 + 4 * (lane & 7);
#pragma unroll
      for (int i = 0; i < 8; ++i) v[i] = __builtin_nontemporal_load((const f32x4*)(src + (size_t)(8 * i) * N));
#pragma unroll
      for (int i = 0; i < 8; ++i) { float* d = scr + (8 * i + (lane >> 3)) * 33 + 4 * (lane & 7); d[0] = v[i].x; d[1] = v[i].y; d[2] = v[i].z; d[3] = v[i].w; } }
    LDS_WAIT();
    const int c = lane & 7;
#pragma unroll
    for (int j = 0; j < 4; ++j) {
        const int n = (lane >> 3) + 8 * j; const float* s = scr + (8 * c) * 33 + n;
        u32x4 o; o.x = pk2(s[0 * 33], s[1 * 33]); o.y = pk2(s[2 * 33], s[3 * 33]); o.z = pk2(s[4 * 33], s[5 * 33]); o.w = pk2(s[6 * 33], s[7 * 33]);
        const int nn = n0 + n; const int drow = mode == 0 ? nn : ((nn >> 7) * 256 + (nn & 127) + (mode == 2 ? 128 : 0));
        *(u32x4*)(WT + (size_t)drow * K + k0 + 8 * c) = o;
    }
    LDS_WAIT();
}

__device__ __forceinline__ void cvt_item8(const float* W, int K, int N, unsigned char* WT, int mode, int item, float* scr, int lane, float scale) {
    const int nblk = N / 32, kb = item / nblk, nb = item % nblk, k0 = 128 * kb, n0 = 32 * nb;
    { f32x4 v[16]; const float* src = W + (size_t)(k0 + (lane >> 3)) * N + n0 + 4 * (lane & 7);
#pragma unroll
      for (int i = 0; i < 16; ++i) v[i] = __builtin_nontemporal_load((const f32x4*)(src + (size_t)(8 * i) * N));
#pragma unroll
      for (int i = 0; i < 16; ++i) { float* d = scr + (8 * i + (lane >> 3)) * 33 + 4 * (lane & 7); d[0] = v[i].x * scale; d[1] = v[i].y * scale; d[2] = v[i].z * scale; d[3] = v[i].w * scale; } }
    LDS_WAIT();
    const int c = lane & 7;
#pragma unroll
    for (int j = 0; j < 4; ++j) {
        const int n = (lane >> 3) + 8 * j; const float* s = scr + (16 * c) * 33 + n;
        u32x4 o; o.x = pg8::pk4_fp8(s[0 * 33], s[1 * 33], s[2 * 33], s[3 * 33]); o.y = pg8::pk4_fp8(s[4 * 33], s[5 * 33], s[6 * 33], s[7 * 33]);
        o.z = pg8::pk4_fp8(s[8 * 33], s[9 * 33], s[10 * 33], s[11 * 33]); o.w = pg8::pk4_fp8(s[12 * 33], s[13 * 33], s[14 * 33], s[15 * 33]);
        const int nn = n0 + n; const int drow = mode == 0 ? nn : ((nn >> 7) * 256 + (nn & 127) + (mode == 2 ? 128 : 0));
        *(u32x4*)(WT + (size_t)drow * K + k0 + 16 * c) = o;
    }
    LDS_WAIT();
}

__device__ __forceinline__ void rms_row_bf16(const float* xrow, const float* g, bf16* orow, int lane) {
    const f32x4* xr = (const f32x4*)xrow; const f32x4* gr = (const f32x4*)g;
    f32x4 v[4]; float s = 0.f;
#pragma unroll
    for (int j = 0; j < 4; ++j) { v[j] = xr[lane + 64 * j]; s += (v[j].x * v[j].x + v[j].y * v[j].y) + (v[j].z * v[j].z + v[j].w * v[j].w); }
    const float r = 1.0f / sqrtf(wave_sum(s) * (1.0f / D) + 1e-6f);
    u32x2* o8 = (u32x2*)orow;
#pragma unroll
    for (int j = 0; j < 4; ++j) { const f32x4 gv = gr[lane + 64 * j]; u32x2 w; w.x = pk2(v[j].x * r * gv.x, v[j].y * r * gv.y); w.y = pk2(v[j].z * r * gv.z, v[j].w * r * gv.w); o8[lane + 64 * j] = w; }
}

#define LAS __attribute__((address_space(3)))
#define XB_TMO      128
#define XB_XCNT(j)  (256  + 64 * (j))
#define XB_XSUB(j)  (1280 + 64 * (j))
#define XB_XGEN(j)  (2304 + 64 * (j))
#define XB_TOP      3328
#define XB_TOPGEN   3392
#define XCD_BAR_WORDS 3456
#define XB_SPIN_CAP (1u << 22)
__device__ __forceinline__ unsigned xb_ld(unsigned* p)              { return __hip_atomic_load(p, __ATOMIC_RELAXED, __HIP_MEMORY_SCOPE_AGENT); }
__device__ __forceinline__ unsigned xb_add(unsigned* p, unsigned v) { return __hip_atomic_fetch_add(p, v, __ATOMIC_RELAXED, __HIP_MEMORY_SCOPE_AGENT); }
__device__ __forceinline__ unsigned xb_xcc_id() { return (unsigned)__builtin_amdgcn_s_getreg((3 << 11) | 20) & 0xFu; }
#define XB_SPIN(cond, bar) do { unsigned _sp = 0; while (cond) { __builtin_amdgcn_s_sleep(1); \
    if ((++_sp & 255u) == 0u) { if (xb_ld(&(bar)[XB_TMO])) break; if (_sp > XB_SPIN_CAP) { atomicAdd(&(bar)[XB_TMO], 1u); break; } } } } while (0)
struct XcdBarrier { unsigned* bar; unsigned x; volatile LAS unsigned* st; };
__device__ __forceinline__ XcdBarrier xcd_barrier_post(unsigned* bar, volatile LAS unsigned* st) {
    XcdBarrier b; b.bar = bar; b.x = xb_xcc_id(); b.st = st;
    if (threadIdx.x == 0) (void)xb_add(&bar[XB_XCNT(b.x)], 1u);
    return b;
}
__device__ __forceinline__ void xcd_barrier_complete(unsigned* bar, unsigned x, unsigned& nloc, unsigned& nx) {
    const unsigned G = gridDim.x * gridDim.y * gridDim.z;
    unsigned sum, cnt, mine, sp = 0u;
    for (;;) {
        sum = 0u; cnt = 0u; mine = 0u;
#pragma unroll
        for (unsigned j = 0; j < 16; ++j) { const unsigned c = xb_ld(&bar[XB_XCNT(j)]); sum += c; cnt += (c > 0u) ? 1u : 0u; mine = (j == x) ? c : mine; }
        if (sum == G) break;
        __builtin_amdgcn_s_sleep(1);
        if ((++sp & 255u) == 0u) { if (xb_ld(&bar[XB_TMO])) break; if (sp > XB_SPIN_CAP) { atomicAdd(&bar[XB_TMO], 1u); break; } }
    }
    nloc = mine > 0u ? mine : 1u; nx = cnt > 0u ? cnt : 1u;
}
__device__ __forceinline__ void xcd_barrier(const XcdBarrier& b, bool leader) {
    asm volatile("s_waitcnt vmcnt(0)" ::: "memory");
    __syncthreads();
    if (leader) {
        unsigned* bar = b.bar;
        __builtin_amdgcn_s_waitcnt(0);
        unsigned nloc = b.st[0], nx = b.st[1];
        if (nloc == 0u) { xcd_barrier_complete(bar, b.x, nloc, nx); b.st[0] = nloc; b.st[1] = nx; }
        const unsigned old = xb_add(&bar[XB_XSUB(b.x)], 1u);
        const unsigned gen = old / nloc;
        if (old + 1u == (gen + 1u) * nloc) {
            __builtin_amdgcn_fence(__ATOMIC_RELEASE, "agent");
            asm volatile("s_waitcnt vmcnt(0)" ::: "memory");
            const unsigned og = xb_add(&bar[XB_TOP], 1u);
            const unsigned tg = og / nx;
            if (og + 1u == (tg + 1u) * nx) xb_add(&bar[XB_TOPGEN], 1u);
            else XB_SPIN(xb_ld(&bar[XB_TOPGEN]) == tg, bar);
            __builtin_amdgcn_fence(__ATOMIC_ACQUIRE, "agent");
            xb_add(&bar[XB_XGEN(b.x)], 1u);
            asm volatile("s_waitcnt vmcnt(0)" ::: "memory");
        } else {
            XB_SPIN(xb_ld(&bar[XB_XGEN(b.x)]) == gen, bar);
            __builtin_amdgcn_fence(__ATOMIC_ACQUIRE, "agent");
            asm volatile("s_waitcnt vmcnt(0)" ::: "memory");
        }
    }
    __syncthreads();
}
constexpr int LDS_BYTES = 163840, RING_BYTES = LDS_BYTES - 512, MISC_OFF = RING_BYTES + 320;
constexpr int CW_BAR = 4096;

enum Phase { PH_PROLOGUE = 0, PH_INPROJ, PH_MIX1, PH_MIX2, PH_MIX3, PH_OUTPROJ, PH_NORM, PH_FFNUP, PH_FFNDOWN, PH_DISPATCH, PH_MOEUP, PH_MOEDOWN, PH_FINAL };


constexpr int RS = 528;
constexpr int AINB_STRIDE = RS;
constexpr int VTS = 144;
template <int NLD> __device__ __forceinline__ void slab_load(u32x4 (&reg)[NLD], const bf16* src, int nrows, int rvalid0, int tid) {
#pragma unroll
    for (int j = 0; j < NLD; ++j) { const int i = tid + j * NT, r = i >> 5, ch = i & 31; reg[j] = (u32x4){0u, 0u, 0u, 0u}; if (i < nrows * 32 && r >= rvalid0) reg[j] = *(const u32x4*)(src + (ptrdiff_t)r * DIN + ch * 8); }
}
template <int NLD> __device__ __forceinline__ void slab_store(const u32x4 (&reg)[NLD], unsigned char* dst, int nrows, int tid) {
#pragma unroll
    for (int j = 0; j < NLD; ++j) { const int i = tid + j * NT, r = i >> 5, ch = i & 31; if (i < nrows * 32) *(u32x4*)(dst + r * RS + ch * 16) = reg[j]; }
}
__device__ __forceinline__ void ytile_store(const unsigned char* src, bf16* y, int tid) {
#pragma unroll
    for (int j = 0; j < 4; ++j) { const int i = tid + j * NT, r = i >> 5, ch = i & 31; *(u32x4*)(y + (size_t)r * D + ch * 8) = *(const u32x4*)(src + r * RS + ch * 16); }
}
__device__ __forceinline__ int vt_off(int c, int tok) { return c * VTS + ((tok ^ (((c >> 3) & 7) << 3)) << 1); }
__device__ __forceinline__ void vt_store(const u32x4 (&reg)[4], unsigned char* vt, int tid) {
#pragma unroll
    for (int j = 0; j < 4; ++j) { const int i = tid + j * NT, r = i >> 5, ch = i & 31, c0 = ch * 8; const unsigned w[4] = {reg[j].x, reg[j].y, reg[j].z, reg[j].w};
#pragma unroll
        for (int q = 0; q < 8; ++q) *(bf16*)(vt + vt_off(c0 + q, r)) = (bf16)((q & 1) ? (w[q >> 1] >> 16) : (w[q >> 1] & 0xffffu)); }
}
__device__ __forceinline__ float lru_ain(const unsigned char* ax, const float* conv_w, const float* conv_b, int t, int c) {
    float acc = conv_b[c];
#pragma unroll
    for (int k = 0; k < 4; ++k) acc += conv_w[k * GW + c] * bf2f(*(const bf16*)(ax + (t + k) * RS + c * 2));
    return acc;
}
__device__ __forceinline__ void lru_ainb(const unsigned char* ax, const float* conv_w, const float* conv_b, unsigned char* ainb, int tid) {
    for (int idx = tid; idx < CH * 128; idx += NT) {
        const int t = idx >> 7, c = (idx & 127) * 2; float a0 = conv_b[c], a1 = conv_b[c + 1];
#pragma unroll
        for (int k = 0; k < 4; ++k) { const unsigned w = *(const unsigned*)(ax + (t + k) * RS + c * 2); a0 += conv_w[k * GW + c] * bf2f(w & 0xffffu); a1 += conv_w[k * GW + c + 1] * bf2f(w >> 16); }
        *(unsigned*)(ainb + t * RS + c * 2) = pk2(a0, a1);
    }
}
__device__ __forceinline__ void lru_gates(const unsigned char* ainb, const unsigned char* ax, const float* conv_w, const float* conv_b, const bf16* wta, const bf16* wtx, const float* b_a, const float* b_x, const float* lam,
                                          int h, int nt, int lane, float (&av)[4][4], float (&uv)[4][4]) {
    const int fr = lane & 15, fq = lane >> 4, c = 64 * h + 16 * nt + fr;
    bf16x8 wa[2], wx[2];
#pragma unroll
    for (int ks = 0; ks < 2; ++ks) { wa[ks] = *(const bf16x8*)(wta + (size_t)(h * 64 + 16 * nt + fr) * 64 + 32 * ks + 8 * fq); wx[ks] = *(const bf16x8*)(wtx + (size_t)(h * 64 + 16 * nt + fr) * 64 + 32 * ks + 8 * fq); }
    f32x4 aa[4], ax4[4];
#pragma unroll
    for (int mt = 0; mt < 4; ++mt) { aa[mt] = (f32x4){0.f, 0.f, 0.f, 0.f}; ax4[mt] = (f32x4){0.f, 0.f, 0.f, 0.f};
#pragma unroll
        for (int ks = 0; ks < 2; ++ks) { const bf16x8 x = *(const bf16x8*)(ainb + (16 * mt + fr) * RS + (64 * h + 32 * ks + 8 * fq) * 2);
            aa[mt] = __builtin_amdgcn_mfma_f32_16x16x32_bf16(x, wa[ks], aa[mt], 0, 0, 0); ax4[mt] = __builtin_amdgcn_mfma_f32_16x16x32_bf16(x, wx[ks], ax4[mt], 0, 0, 0); } }
    const float sp = log1pf(fexp(-lam[c])), ba = b_a[c], bx = b_x[c];
#pragma unroll
    for (int mt = 0; mt < 4; ++mt)
#pragma unroll
        for (int r = 0; r < 4; ++r) { const int t = 16 * mt + 4 * fq + r; const float rg = sigmoidf_(aa[mt][r] + ba), ig = sigmoidf_(ax4[mt][r] + bx); const float loga = -8.0f * rg * sp;
            const float x2 = 2.0f * loga; const float m2 = x2 > -0.25f ? neg_expm1_small(x2) : -expm1f(x2);
            av[mt][r] = fexp(loga); uv[mt][r] = __builtin_amdgcn_sqrtf(fmaxf(m2, 0.f)) * ig * lru_ain(ax, conv_w, conv_b, t, c); }
}

#define HN ((bf16*)(ws + WS_HN))
#define PROJ ((bf16*)(ws + WS_PROJ))
#define Y ((bf16*)(ws + WS_Y))
#define DS ((float*)(ws + WS_DS))
#define HID ((bf16*)(ws + WS_HID))
#define HIDE ((unsigned char*)(ws + WS_HIDE))
#define OUT2 ((bf16*)(ws + WS_OUT2))
#define XR ((unsigned char*)(ws + WS_XR))
#define SMALLP(T, off) ((T*)(ws + WS_SMALL + (off)))
#define RSTD SMALLP(float, SM_RSTD)
#define TOKE SMALLP(int, SM_TOKE)
#define TOKG SMALLP(float, SM_TOKG)
#define TOKR SMALLP(int, SM_TOKR)
#define BCNT SMALLP(int, SM_BCNT)
#define ROWDST SMALLP(int, SM_ROWDST)
#define ROWG SMALLP(float, SM_ROWG)
#define TILEE SMALLP(int, SM_TILEE)
#define CARA SMALLP(float, SM_CARA)
#define CARH SMALLP(float, SM_CARH)
#define CIN SMALLP(float, SM_CIN)
#define DEC SMALLP(float, SM_DEC)
#define WTA SMALLP(bf16, SM_WTA)
#define WTX SMALLP(bf16, SM_WTX)
#define WTP SMALLP(bf16, SM_WTP)
#define PHASE_ENTER int tid = wid_s * 64 + (int)__builtin_amdgcn_mbcnt_hi(~0u, __builtin_amdgcn_mbcnt_lo(~0u, 0u)); asm volatile("" : "+v"(tid)); const int lane = tid & 63, wid = tid >> 6; unsigned char* ws = a.ws; asm volatile("" : "+s"(ws)); float* hres = a.out; asm volatile("" : "+s"(hres)); \
    int bid = blockIdx.x; asm volatile("" : "+s"(bid)); int G = gridDim.x; asm volatile("" : "+s"(G)); (void)lane; (void)wid; (void)hres; (void)bid; (void)G;

__global__ void __launch_bounds__(NT) fwd(Args a) {
    extern __shared__ __attribute__((aligned(16))) unsigned char lds_raw[];
    float* ldsf = (float*)lds_raw;
    const int wid_s = __builtin_amdgcn_readfirstlane(threadIdx.x >> 6);
    { const int tid0 = threadIdx.x; for (int u = tid0; u < (LDS_BYTES - RING_BYTES) / 4; u += NT) ((LAS unsigned*)((LAS unsigned char*)lds_raw + RING_BYTES))[u] = 0u; }
    __syncthreads();
    XcdBarrier bar = xcd_barrier_post((unsigned*)(a.ws + WS_CTL) + CW_BAR, (volatile LAS unsigned*)((LAS unsigned char*)lds_raw + MISC_OFF) + 8);

#ifdef REP_STEP
    int rep_left = REP_N;
#endif
    for (int step = a.ph_lo; step < a.ph_hi; ++step) {
#ifdef REP_STEP
    const bool dry = (step == REP_STEP && rep_left > 0);
#else
    constexpr bool dry = false;
#endif
    int phase, L, pass = 0;
    if (step == 0) { phase = PH_PROLOGUE; L = 0; }
    else if (step < 10) { L = 0; const int s = step - 1; phase = s < 5 ? PH_INPROJ + s : s == 5 ? PH_NORM : s == 6 ? PH_FFNUP : s == 7 ? PH_FFNDOWN : PH_NORM; pass = (s == 8) ? 1 : 0; }
    else { L = 1; const int s = step - 10; phase = s < 5 ? PH_INPROJ + s : s == 5 ? PH_NORM : s == 6 ? PH_DISPATCH : s == 7 ? PH_MOEUP : s == 8 ? PH_MOEDOWN : PH_FINAL; }
#ifdef REP_NOP
    if (dry) phase = 1000;
#endif
    switch (phase) {
    case PH_PROLOGUE: {
        PHASE_ENTER
        float* scr = ldsf + wid * (128 * 33);
        const int gw = bid * 8 + wid, NGW = G * 8;
        constexpr int I_IN = 16 * 80, I_OUT = 16 * 32, I_G = 16 * 88, I_D = 44 * 32, I_E1 = 8 * 112, I_E2 = 28 * 32;
        constexpr int T0 = 2 * I_IN, T1 = T0 + 2 * I_OUT, T2 = T1 + I_G, T3 = T2 + I_G, T4 = T3 + I_D, T5 = T4 + NE * I_E1, T6 = T5 + NE * I_E1, T7 = T6 + NE * I_E2;
        for (int it = gw; it < T7; it += NGW) {
            if (it < T0) { const int l = it / I_IN, r = it % I_IN; cvt_item(IN(1) + (size_t)l * D * DIN, D, DIN, (bf16*)(ws + WS_WIN) + (size_t)l * DIN * D, 0, r, scr, lane); }
            else if (it < T1) { const int q = it - T0, l = q / I_OUT, r = q % I_OUT; cvt_item(IN(2) + (size_t)l * D * D, D, D, (bf16*)(ws + WS_WOUT) + (size_t)l * D * D, 0, r, scr, lane); }
            else if (it < T2) { cvt_item(IN(17), D, DFF, (bf16*)(ws + WS_WGU), 1, it - T1, scr, lane); }
            else if (it < T3) { cvt_item(IN(18), D, DFF, (bf16*)(ws + WS_WGU), 2, it - T2, scr, lane); }
            else if (it < T4) { cvt_item(IN(19), DFF, D, (bf16*)(ws + WS_WD), 0, it - T3, scr, lane); }
            else if (it < T5) { const int q = it - T4, e = q / I_E1, r = q % I_E1; cvt_item8(IN(21) + (size_t)e * D * DFFE, D, DFFE, ws + WS_W13 + (size_t)e * 2 * DFFE * D, 1, r, scr, lane, W13_SCALE); }
            else if (it < T6) { const int q = it - T5, e = q / I_E1, r = q % I_E1; cvt_item8(IN(22) + (size_t)e * D * DFFE, D, DFFE, ws + WS_W13 + (size_t)e * 2 * DFFE * D, 2, r, scr, lane, W13_SCALE); }
            else { const int q = it - T6, e = q / I_E2, r = q % I_E2; cvt_item8(IN(23) + (size_t)e * DFFE * D, DFFE, D, ws + WS_W2 + (size_t)e * D * DFFE, 0, r, scr, lane, W2_SCALE); }
        }
        for (int m = gw; m < NTOK; m += NGW) rms_row_bf16(IN(0) + (size_t)m * D, IN(15), HN + (size_t)m * D, lane);
        for (int idx = bid * NT + tid; idx < 3 * 2 * 4 * HD * HD; idx += G * NT) {
            const int mat = idx / (2 * 4 * HD * HD), r = idx % (2 * 4 * HD * HD), lh = r >> 12, j = (r >> 6) & 63, i = r & 63;
            const float* w = mat == 0 ? IN(5) : mat == 1 ? IN(7) : IN(12);
            (mat == 0 ? WTA : mat == 1 ? WTX : WTP)[r] = (bf16)f2bf(w[(lh * 64 + i) * 64 + j]);
        }
    } break;

    case PH_INPROJ: {
        PHASE_ENTER
        pg8::Gemm g{HN, (const bf16*)(ws + WS_WIN) + (size_t)L * DIN * D, NTOK, DIN, D}; pg8::StaticOrder S; S.init(NTOK, DIN, G, bid);
        pg8::EpiStoreBf16 E{PROJ, DIN};
        pg8::gemm_phase<pg8::EpiStoreBf16, pg8::StaticOrder, true, true>((PG8_LAS unsigned char*)lds_raw, g, S, E, tid);
    } break;

    case PH_MIX1: {
        PHASE_ENTER
        const float* conv_w = IN(3) + L * 4 * GW; const float* conv_b = IN(4) + L * GW;
        const float* b_a = IN(6) + L * GW; const float* b_x = IN(8) + L * GW;
        const float* lam = IN(9) + L * GW; const float* lbp = IN(10);
        unsigned char* AX = lds_raw; unsigned char* AINB = lds_raw + 35376; unsigned char* FS = lds_raw + 69168; unsigned char* VTl = lds_raw + 102960; float* TOTl = (float*)(lds_raw + 139824);
        unsigned char* KHTl = lds_raw;
        for (int ci = bid; ci < NCHUNK; ci += G) {
            const int t0 = (ci % CPB) * CH, g0 = ci * CH; const bf16* prow = PROJ + (size_t)g0 * DIN;
            {
                u32x4 rax[5], rf[4], rv[4];
                slab_load<5>(rax, prow - 3 * DIN, 67, t0 == 0 ? 3 : 0, tid); slab_load<4>(rf, prow + 768, 64, 0, tid); slab_load<4>(rv, prow + 1024, 64, 0, tid);
                slab_store<5>(rax, AX, 67, tid); slab_store<4>(rf, FS, 64, tid); vt_store(rv, VTl, tid);
            }
            __syncthreads();
            lru_ainb(AX, conv_w, conv_b, AINB, tid);
            __syncthreads();
#pragma unroll 1
            for (int cc = 0; cc < 2; ++cc) {
                const int h = wid >> 1, nt = 2 * (wid & 1) + cc; float av[4][4], uv[4][4];
                lru_gates(AINB, AX, conv_w, conv_b, WTA + L * 16384, WTX + L * 16384, b_a, b_x, lam, h, nt, lane, av, uv);
                float A = 1.f, H = 0.f;
#pragma unroll
                for (int mt = 0; mt < 4; ++mt) {
                    float At = 1.f, Ht = 0.f;
#pragma unroll
                    for (int r = 0; r < 4; ++r) { Ht = av[mt][r] * Ht + uv[mt][r]; At *= av[mt][r]; }
                    const float A1 = __shfl_down(At, 16), H1 = __shfl_down(Ht, 16); const float At2 = At * A1, Ht2 = A1 * Ht + H1;
                    const float A2 = __shfl_down(At2, 32), H2 = __shfl_down(Ht2, 32); const float Att = At2 * A2, Htt = A2 * Ht2 + H2;
                    H = Att * H + Htt; A *= Att;
                }
                if (lane < 16) { const int c = 64 * h + 16 * nt + lane; CARA[ci * GW + c] = A; CARH[ci * GW + c] = H; }
            }
            {
                const int h = wid >> 1, half = wid & 1, c = 64 * h + lane, fr = lane & 15, fq = lane >> 4;
                const float lb = L == 0 ? 0.f : sigmoidf_(lbp[GW + c] - lbp[c]);
                float gl[32], kk[32]; float run = 0.f;
#pragma unroll
                for (int t = 0; t < 32; ++t) { const float sg = sigmoidf_(bf2f(*(const bf16*)(FS + (32 * half + t) * RS + c * 2))); run += flog(lb + (1.f - lb) * sg); gl[t] = run; kk[t] = (1.f - lb) * (1.f - sg); }
                TOTl[(h * 2 + half) * 64 + lane] = run;
                __syncthreads();
                const float tot0 = TOTl[(h * 2) * 64 + lane], glast = tot0 + TOTl[(h * 2 + 1) * 64 + lane], off = half ? tot0 : 0.f;
#pragma unroll
                for (int j = 0; j < 4; ++j) { float e[8];
#pragma unroll
                    for (int q = 0; q < 8; ++q) e[q] = kk[8 * j + q] * fexp(glast - (off + gl[8 * j + q]));
                    u32x4 w; w.x = pk2(e[0], e[1]); w.y = pk2(e[2], e[3]); w.z = pk2(e[4], e[5]); w.w = pk2(e[6], e[7]);
                    *(u32x4*)(KHTl + c * VTS + (32 * half + 8 * j) * 2) = w; }
                if (half) DEC[(ci * 4 + h) * 64 + lane] = fexp(glast);
                __syncthreads();
#pragma unroll
                for (int vvv = 0; vvv < 2; ++vvv) {
                    const int vt = 2 * half + vvv, vrow = 64 * h + 16 * vt + fr; bf16x8 bv[2];
#pragma unroll
                    for (int ks = 0; ks < 2; ++ks) bv[ks] = *(const bf16x8*)(VTl + vt_off(vrow, 32 * ks + 8 * fq));
#pragma unroll
                    for (int kt = 0; kt < 4; ++kt) { f32x4 acc = (f32x4){0.f, 0.f, 0.f, 0.f};
#pragma unroll
                        for (int ks = 0; ks < 2; ++ks) { const bf16x8 ka = *(const bf16x8*)(KHTl + (64 * h + 16 * kt + fr) * VTS + (32 * ks + 8 * fq) * 2); acc = __builtin_amdgcn_mfma_f32_16x16x32_bf16(ka, bv[ks], acc, 0, 0, 0); }
                        *(f32x4*)(DS + ((size_t)(ci * 4 + h) * 64 + 16 * vt + fr) * 64 + 16 * kt + 4 * fq) = acc; }
                }
                __syncthreads();
            }
        }
    } break;

    case PH_MIX2: {
        PHASE_ENTER
        float* xa = ldsf; float* xs = ldsf + 512;
        for (int item = bid; item < 256 + 2; item += G) {
            if (item < 256) {
                const int el = tid & 127, seg = tid >> 7, e = item * 128 + el, b = e >> 14, hh = (e >> 12) & 3, kv = e & 4095, k = kv & 63;
                float dv[32], dc[32];
#pragma unroll
                for (int i = 0; i < 32; ++i) { const int ci = b * CPB + seg * 32 + i; dv[i] = DS[(size_t)(ci * 4 + hh) * 4096 + kv]; dc[i] = DEC[(ci * 4 + hh) * 64 + k]; }
                float S = 0.f, A = 1.f;
#pragma unroll
                for (int i = 0; i < 32; ++i) { const float d = dv[i]; dv[i] = S; S = dc[i] * S + d; const float a0 = dc[i]; dc[i] = A; A *= a0; }
                xa[seg * 128 + el] = A; xs[seg * 128 + el] = S;
                __syncthreads();
                float Sin = 0.f;
                for (int s2 = 0; s2 < seg; ++s2) Sin = xa[s2 * 128 + el] * Sin + xs[s2 * 128 + el];
#pragma unroll
                for (int i = 0; i < 32; ++i) { const int ci = b * CPB + seg * 32 + i; (dry ? DS + 20 * (MiB / 4) * 4 : DS)[(size_t)(ci * 4 + hh) * 4096 + kv] = dv[i] + dc[i] * Sin; }
                __syncthreads();
            } else {
                if (tid < GW) { const int b = item - 256, c = tid; float hp = 0.f;
                    for (int ch0 = 0; ch0 < CPB; ch0 += 16) { float ca[16], chh[16];
#pragma unroll
                        for (int i = 0; i < 16; ++i) { ca[i] = CARA[(b * CPB + ch0 + i) * GW + c]; chh[i] = CARH[(b * CPB + ch0 + i) * GW + c]; }
#pragma unroll
                        for (int i = 0; i < 16; ++i) { CIN[(b * CPB + ch0 + i) * GW + c] = hp; hp = ca[i] * hp + chh[i]; } } }
            }
        }
    } break;

    case PH_MIX3: {
        PHASE_ENTER
        const float* conv_w = IN(3) + L * 4 * GW; const float* conv_b = IN(4) + L * GW; const float* b_a = IN(6) + L * GW; const float* b_x = IN(8) + L * GW; const float* lam = IN(9) + L * GW;
        const float* lbp = IN(10); const float* norm_g = IN(11) + L * HD; const float* pool_s = IN(13) + L * GW; const float* sconv_w = IN(14) + L * 3 * GW;
        unsigned char* AX = lds_raw; unsigned char* AG = lds_raw + 35376; unsigned char* AINB = lds_raw + 69168;
        unsigned char* QT3 = lds_raw; unsigned char* KT3 = lds_raw + 33792; unsigned char* OG3 = lds_raw + 67584; unsigned char* VT3 = lds_raw + 101376; float* TOT3 = (float*)(lds_raw + 138240);
        unsigned char* PS = lds_raw; unsigned char* DIMG = lds_raw + 41712; unsigned char* YST = lds_raw + 75504;
        unsigned char* SB = lds_raw; unsigned char* SC = lds_raw + 33792; unsigned char* SX = lds_raw + 68640;
        for (int ci = bid; ci < NCHUNK; ci += G) {
            const int t0 = (ci % CPB) * CH, g0 = ci * CH; const bf16* prow = PROJ + (size_t)g0 * DIN; bf16* yrow = Y + (size_t)g0 * D;
            {
                u32x4 rax[5], rag[4];
                slab_load<5>(rax, prow - 3 * DIN, 67, t0 == 0 ? 3 : 0, tid); slab_load<4>(rag, prow + 256, 64, 0, tid);
                slab_store<5>(rax, AX, 67, tid); slab_store<4>(rag, AG, 64, tid);
            }
            __syncthreads();
            lru_ainb(AX, conv_w, conv_b, AINB, tid);
            __syncthreads();
            u32x4 rp[5];
            slab_load<5>(rp, prow - 15 * DIN + 1536, 79, t0 == 0 ? 15 : 0, tid);
#pragma unroll 1
            for (int cc = 0; cc < 2; ++cc) {
                const int h = wid >> 1, nt = 2 * (wid & 1) + cc, fr = lane & 15, fq = lane >> 4, c = 64 * h + 16 * nt + fr; float av[4][4], uv[4][4];
                lru_gates(AINB, AX, conv_w, conv_b, WTA + L * 16384, WTX + L * 16384, b_a, b_x, lam, h, nt, lane, av, uv);
                float hin = CIN[ci * GW + c];
#pragma unroll
                for (int mt = 0; mt < 4; ++mt) {
                    float Ai[4], Hi[4]; float A_ = 1.f, H_ = 0.f;
#pragma unroll
                    for (int r = 0; r < 4; ++r) { H_ = av[mt][r] * H_ + uv[mt][r]; A_ *= av[mt][r]; Ai[r] = A_; Hi[r] = H_; }
                    const float a1 = __shfl_up(A_, 16), h1 = __shfl_up(H_, 16), a2 = __shfl_up(A_, 32), h2 = __shfl_up(H_, 32), a3 = __shfl_up(A_, 48), h3 = __shfl_up(H_, 48);
                    float EA = 1.f, EH = 0.f;
                    if (fq >= 3) { EA = a3; EH = h3; }
                    if (fq >= 2) { EH = a2 * EH + h2; EA *= a2; }
                    if (fq >= 1) { EH = a1 * EH + h1; EA *= a1; }
                    const float hs = EA * hin + EH; float hv[4];
#pragma unroll
                    for (int r = 0; r < 4; ++r) hv[r] = Ai[r] * hs + Hi[r];
                    hin = __shfl(hv[3], 48 + fr);
#pragma unroll
                    for (int r = 0; r < 4; ++r) { bf16* p = (bf16*)(AG + (16 * mt + 4 * fq + r) * RS + c * 2); *p = (bf16)f2bf(hv[r] * gelu_tanh(bf2f(*p))); }
                }
            }
            __syncthreads();
            ytile_store(AG, yrow, tid);
            __syncthreads();
            slab_store<5>(rp, PS, 79, tid);
            __syncthreads();
            u32x4 rsb[4], rsc[5], rsx[5];
            slab_load<4>(rsb, prow + 1792, 64, 0, tid); slab_load<5>(rsc, prow - 2 * DIN + 2048, 66, t0 == 0 ? 2 : 0, tid); slab_load<5>(rsx, prow - 2 * DIN + 2304, 66, t0 == 0 ? 2 : 0, tid);
            for (int idx = tid; idx < CH * 128; idx += NT) {
                const int t = idx >> 7, c = (idx & 127) * 2, gi = c >> 6, w = 2 << gi; const int tt = t0 + t; const int cnt = (tt + 1 < w) ? (tt + 1) : w; float s0 = 0.f, s1 = 0.f;
                for (int r = 0; r < cnt; ++r) { const unsigned x = *(const unsigned*)(PS + (t + 15 - r) * RS + c * 2); s0 += bf2f(x & 0xffffu); s1 += bf2f(x >> 16); }
                const unsigned x0 = *(const unsigned*)(PS + (t + 15) * RS + c * 2); const float inv = __builtin_amdgcn_rcpf((float)cnt);
                *(unsigned*)(DIMG + t * RS + c * 2) = pk2(s0 * inv - bf2f(x0 & 0xffffu), s1 * inv - bf2f(x0 >> 16));
            }
            __syncthreads();
#pragma unroll 1
            for (int cc = 0; cc < 2; ++cc) {
                const int gi = wid >> 1, nt = 2 * (wid & 1) + cc, fr = lane & 15, fq = lane >> 4, c = 64 * gi + 16 * nt + fr; bf16x8 wp[2];
#pragma unroll
                for (int ks = 0; ks < 2; ++ks) wp[ks] = *(const bf16x8*)(WTP + L * 16384 + (size_t)(gi * 64 + 16 * nt + fr) * 64 + 32 * ks + 8 * fq);
                const float psc = pool_s[c];
#pragma unroll
                for (int mt = 0; mt < 4; ++mt) { f32x4 acc = (f32x4){0.f, 0.f, 0.f, 0.f};
#pragma unroll
                    for (int ks = 0; ks < 2; ++ks) { const bf16x8 x = *(const bf16x8*)(DIMG + (16 * mt + fr) * RS + (64 * gi + 32 * ks + 8 * fq) * 2); acc = __builtin_amdgcn_mfma_f32_16x16x32_bf16(x, wp[ks], acc, 0, 0, 0); }
#pragma unroll
                    for (int r = 0; r < 4; ++r) *(bf16*)(YST + (16 * mt + 4 * fq + r) * RS + c * 2) = (bf16)f2bf(acc[r] * psc); }
            }
            __syncthreads();
            ytile_store(YST, yrow + 512, tid);
            __syncthreads();
            slab_store<4>(rsb, SB, 64, tid); slab_store<5>(rsc, SC, 66, tid); slab_store<5>(rsx, SX, 66, tid);
            __syncthreads();
            u32x4 rq[4], rf[4], rv[4], rog[4];
            slab_load<4>(rq, prow + 512, 64, 0, tid); slab_load<4>(rf, prow + 768, 64, 0, tid); slab_load<4>(rv, prow + 1024, 64, 0, tid); slab_load<4>(rog, prow + 1280, 64, 0, tid);
            for (int idx = tid; idx < CH * 128; idx += NT) {
                const int t = idx >> 7, c = (idx & 127) * 2; float a0 = 0.f, a1 = 0.f;
#pragma unroll
                for (int k = 0; k < 3; ++k) { const unsigned xc = *(const unsigned*)(SC + (t + k) * RS + c * 2), xx = *(const unsigned*)(SX + (t + k) * RS + c * 2);
                    a0 += sconv_w[k * GW + c] * bf2f(xc & 0xffffu) * bf2f(xx & 0xffffu); a1 += sconv_w[k * GW + c + 1] * bf2f(xc >> 16) * bf2f(xx >> 16); }
                unsigned* pb = (unsigned*)(SB + t * RS + c * 2); const unsigned b = *pb; *pb = pk2(bf2f(b & 0xffffu) * a0, bf2f(b >> 16) * a1);
            }
            __syncthreads();
            ytile_store(SB, yrow + 768, tid);
            __syncthreads();
            slab_store<4>(rq, QT3, 64, tid); slab_store<4>(rf, KT3, 64, tid); slab_store<4>(rog, OG3, 64, tid); vt_store(rv, VT3, tid);
            __syncthreads();
            {
                const int h = wid >> 1, half = wid & 1, c = 64 * h + lane, fr = lane & 15, fq = lane >> 4;
                const float lb = L == 0 ? 0.f : sigmoidf_(lbp[GW + c] - lbp[c]);
                float gl[32]; float run = 0.f;
#pragma unroll
                for (int t = 0; t < 32; ++t) { const float sg = sigmoidf_(bf2f(*(const bf16*)(KT3 + (32 * half + t) * RS + c * 2))); run += flog(lb + (1.f - lb) * sg); gl[t] = run; }
                TOT3[(h * 2 + half) * 64 + lane] = run;
                __syncthreads();
                const float tot0 = TOT3[(h * 2) * 64 + lane];
                const float off = half ? 0.f : -tot0;
#pragma unroll
                for (int t = 0; t < 32; ++t) {
                    bf16* pq = (bf16*)(QT3 + (32 * half + t) * RS + c * 2); bf16* pk = (bf16*)(KT3 + (32 * half + t) * RS + c * 2);
                    const float sg = sigmoidf_(bf2f(*pk)), kkv = (1.f - lb) * (1.f - sg), qfv = siluf_(bf2f(*pq)), d = gl[t] + off;
                    *pq = (bf16)f2bf(qfv * fexp(d)); *pk = (bf16)f2bf(kkv * fexp(-d));
                }
                __syncthreads();
                bf16x8 sa[4][2];
#pragma unroll
                for (int vt = 0; vt < 4; ++vt)
#pragma unroll
                    for (int ks = 0; ks < 2; ++ks) {
                        const float* p = DS + ((size_t)(ci * 4 + h) * 64 + 16 * vt + fr) * 64 + 32 * ks + 8 * fq; const f32x4 lo = *(const f32x4*)p, hi = *(const f32x4*)(p + 4);
                        const float* eg = TOT3 + (h * 2) * 64 + 32 * ks + 8 * fq;
                        u32x4 w; w.x = pk2(lo.x * fexp(eg[0]), lo.y * fexp(eg[1])); w.y = pk2(lo.z * fexp(eg[2]), lo.w * fexp(eg[3])); w.z = pk2(hi.x * fexp(eg[4]), hi.y * fexp(eg[5])); w.w = pk2(hi.z * fexp(eg[6]), hi.w * fexp(eg[7]));
                        sa[vt][ks] = __builtin_bit_cast(bf16x8, w);
                    }
#pragma unroll
                for (int tsel = 0; tsel < 2; ++tsel) {
                    const int ti = half == 0 ? (tsel ? 3 : 0) : (tsel ? 2 : 1);
                    bf16x8 qb[2];
#pragma unroll
                    for (int ks = 0; ks < 2; ++ks) qb[ks] = *(const bf16x8*)(QT3 + (16 * ti + fr) * RS + (64 * h + 32 * ks + 8 * fq) * 2);
                    f32x4 st[4];
#pragma unroll
                    for (int si = 0; si < 4; ++si) { st[si] = (f32x4){0.f, 0.f, 0.f, 0.f};
                        if (si <= ti) {
#pragma unroll
                            for (int ks = 0; ks < 2; ++ks) { const bf16x8 ka = *(const bf16x8*)(KT3 + (16 * si + fr) * RS + (64 * h + 32 * ks + 8 * fq) * 2); st[si] = __builtin_amdgcn_mfma_f32_16x16x32_bf16(ka, qb[ks], st[si], 0, 0, 0); }
                            if (si == ti) {
#pragma unroll
                                for (int r = 0; r < 4; ++r) if (4 * fq + r > fr) st[si][r] = 0.f; }
                        } }
                    f32x4 oo[4];
#pragma unroll
                    for (int vt = 0; vt < 4; ++vt) { oo[vt] = (f32x4){0.f, 0.f, 0.f, 0.f};
#pragma unroll
                        for (int ks = 0; ks < 2; ++ks) oo[vt] = __builtin_amdgcn_mfma_f32_16x16x32_bf16(sa[vt][ks], qb[ks], oo[vt], 0, 0, 0); }
#pragma unroll
                    for (int p = 0; p < 2; ++p) if (2 * p <= ti) {
                        u32x4 bw; bw.x = pk2(st[2 * p][0], st[2 * p][1]); bw.y = pk2(st[2 * p][2], st[2 * p][3]); bw.z = pk2(st[2 * p + 1][0], st[2 * p + 1][1]); bw.w = pk2(st[2 * p + 1][2], st[2 * p + 1][3]);
                        const bf16x8 bfr = __builtin_bit_cast(bf16x8, bw);
#pragma unroll
                        for (int vt = 0; vt < 4; ++vt) { const int vrow = 64 * h + 16 * vt + fr; const u32x2 lo8 = *(const u32x2*)(VT3 + vt_off(vrow, 32 * p + 4 * fq)), hi8 = *(const u32x2*)(VT3 + vt_off(vrow, 32 * p + 16 + 4 * fq));
                            u32x4 aw; aw.x = lo8.x; aw.y = lo8.y; aw.z = hi8.x; aw.w = hi8.y;
                            oo[vt] = __builtin_amdgcn_mfma_f32_16x16x32_bf16(__builtin_bit_cast(bf16x8, aw), bfr, oo[vt], 0, 0, 0); }
                    }
                    float ss = 0.f;
#pragma unroll
                    for (int vt = 0; vt < 4; ++vt) ss += (oo[vt][0] * oo[vt][0] + oo[vt][1] * oo[vt][1]) + (oo[vt][2] * oo[vt][2] + oo[vt][3] * oo[vt][3]);
                    ss += __shfl_xor(ss, 16); ss += __shfl_xor(ss, 32);
                    const float rs = __builtin_amdgcn_rsqf(ss * (1.0f / HD) + 1e-5f);
#pragma unroll
                    for (int vt = 0; vt < 4; ++vt) { const int cv = 64 * h + 16 * vt + 4 * fq; u32x2* pog = (u32x2*)(OG3 + (16 * ti + fr) * RS + cv * 2); const u32x2 og = *pog; const f32x4 ng = *(const f32x4*)(norm_g + 16 * vt + 4 * fq);
                        u32x2 w; w.x = pk2(oo[vt][0] * rs * ng.x * siluf_(bf2f(og.x & 0xffffu)), oo[vt][1] * rs * ng.y * siluf_(bf2f(og.x >> 16))); w.y = pk2(oo[vt][2] * rs * ng.z * siluf_(bf2f(og.y & 0xffffu)), oo[vt][3] * rs * ng.w * siluf_(bf2f(og.y >> 16)));
                        *pog = w; }
                }
                __syncthreads();
            }
            ytile_store(OG3, yrow + 256, tid);
            __syncthreads();
        }
    } break;

    case PH_OUTPROJ: {
        PHASE_ENTER
        pg8::Gemm g{Y, (const bf16*)(ws + WS_WOUT) + (size_t)L * D * D, NTOK, D, D}; pg8::StaticOrder S; S.init(NTOK, D, G, bid);
        pg8::EpiResidF32 E{L == 0 ? IN(0) : hres, hres};
        pg8::gemm_phase<pg8::EpiResidF32, pg8::StaticOrder, true, true>((PG8_LAS unsigned char*)lds_raw, g, S, E, tid);
    } break;

    case PH_NORM: {
        PHASE_ENTER
        const float* g = pass == 0 ? IN(16) + L * D : IN(15) + D;
        const bool route = (L == 1 && pass == 0);
        int* sel = (int*)lds_raw;
        for (int blk = bid; blk < NTOK / 64; blk += G) {
            if (!route) {
                for (int r8 = 0; r8 < 8; ++r8) { const int m = blk * 64 + wid * 8 + r8; rms_row_bf16(hres + (size_t)m * D, g, HN + (size_t)m * D, lane); }
            } else {
                float wr[16][8];
                { const float* wr_ = IN(20);
#pragma unroll
                  for (int j = 0; j < 4; ++j)
#pragma unroll
                    for (int q = 0; q < 4; ++q) { const f32x4 w0 = *(const f32x4*)(wr_ + (size_t)(4 * (lane + 64 * j) + q) * 8), w1 = *(const f32x4*)(wr_ + (size_t)(4 * (lane + 64 * j) + q) * 8 + 4);
                        wr[j * 4 + q][0] = w0.x; wr[j * 4 + q][1] = w0.y; wr[j * 4 + q][2] = w0.z; wr[j * 4 + q][3] = w0.w; wr[j * 4 + q][4] = w1.x; wr[j * 4 + q][5] = w1.y; wr[j * 4 + q][6] = w1.z; wr[j * 4 + q][7] = w1.w; } }
                f32x4 gv[4];
#pragma unroll
                for (int j = 0; j < 4; ++j) gv[j] = ((const f32x4*)g)[lane + 64 * j];
#pragma unroll 1
                for (int r8 = 0; r8 < 8; ++r8) {
                    const int tl = wid * 8 + r8, m = blk * 64 + tl; const f32x4* xr = (const f32x4*)(hres + (size_t)m * D);
                    f32x4 v[4]; float s = 0.f;
#pragma unroll
                    for (int j = 0; j < 4; ++j) { v[j] = xr[lane + 64 * j]; s += (v[j].x * v[j].x + v[j].y * v[j].y) + (v[j].z * v[j].z + v[j].w * v[j].w); }
                    const float r = 1.0f / sqrtf(wave_sum(s) * (1.0f / D) + 1e-6f);
                    float lg[8] = {0.f, 0.f, 0.f, 0.f, 0.f, 0.f, 0.f, 0.f};
#pragma unroll
                    for (int j = 0; j < 4; ++j) { const float y[4] = {v[j].x * r * gv[j].x, v[j].y * r * gv[j].y, v[j].z * r * gv[j].z, v[j].w * r * gv[j].w};
#pragma unroll
                        for (int q = 0; q < 4; ++q)
#pragma unroll
                            for (int e = 0; e < 8; ++e) lg[e] += y[q] * wr[j * 4 + q][e]; }
#pragma unroll
                    for (int e = 0; e < 8; ++e) lg[e] = wave_sum(lg[e]);
                    if (lane == 0) {
                        int e1 = 0; float l1 = lg[0];
#pragma unroll
                        for (int e = 1; e < 8; ++e) if (lg[e] > l1) { l1 = lg[e]; e1 = e; }
                        int e2 = -1; float l2 = -3.0e38f;
#pragma unroll
                        for (int e = 0; e < 8; ++e) if (e != e1 && lg[e] > l2) { l2 = lg[e]; e2 = e; }
                        const float g1 = 1.0f / (1.0f + fexp(l2 - l1));
                        TOKE[m * 2] = e1; TOKE[m * 2 + 1] = e2; TOKG[m * 2] = g1; TOKG[m * 2 + 1] = 1.0f - g1;
                        sel[tl * 2] = e1; sel[tl * 2 + 1] = e2; RSTD[m] = r;
                    }
                }
                __syncthreads();
                if (tid < NE) { int cnt = 0; for (int q = 0; q < 128; ++q) if (sel[q] == tid) { TOKR[blk * 128 + q] = cnt; ++cnt; } BCNT[blk * NE + tid] = cnt; }
                __syncthreads();
            }
        }
    } break;

    case PH_FFNUP: {
        PHASE_ENTER
        pg8::Gemm g{HN, (const bf16*)(ws + WS_WGU), NTOK, 2 * DFF, D}; pg8::StaticOrder S; S.init(NTOK, 2 * DFF, G, bid);
        pg8::EpiSwiglu E{HID, DFF, 0};
        pg8::gemm_phase<pg8::EpiSwiglu, pg8::StaticOrder, true, true>((PG8_LAS unsigned char*)lds_raw, g, S, E, tid);
    } break;

    case PH_FFNDOWN: {
        PHASE_ENTER
        pg8::Gemm g{HID, (const bf16*)(ws + WS_WD), NTOK, D, DFF}; pg8::StaticOrder S; S.init(NTOK, D, G, bid);
        pg8::EpiResidF32 E{hres, dry ? (float*)(ws + 340 * MiB) : hres};
        pg8::gemm_phase<pg8::EpiResidF32, pg8::StaticOrder, true, true>((PG8_LAS unsigned char*)lds_raw, g, S, E, tid);
    } break;

    case PH_DISPATCH: {
        PHASE_ENTER
        int* sh = (int*)lds_raw;
        const f32x4* gr = (const f32x4*)(IN(16) + D);
        for (int blk = bid; blk < NTOK / 64; blk += G) {
            { int* cnts = sh + 64;
              for (int i = tid; i < (NTOK / 64) * NE; i += NT) cnts[i] = BCNT[i];
              __syncthreads();
              { const int e = wid; int sall = 0, slt = 0;
#pragma unroll
                for (int i = 0; i < 4; ++i) { const int b2 = 4 * lane + i, c = cnts[b2 * NE + e]; sall += c; slt += (b2 < blk) ? c : 0; }
#pragma unroll
                for (int o = 1; o < 64; o <<= 1) { sall += __shfl_xor(sall, o); slt += __shfl_xor(slt, o); }
                if (lane == 0) { sh[e] = sall; sh[16 + e] = slt; sh[24 + e] = (sall + 255) >> 8; } } }
            __syncthreads();
            if (tid == 0) { int acc = 0; for (int e = 0; e < NE; ++e) { sh[8 + e] = acc * 256; acc += sh[24 + e]; } sh[32] = acc; }
            __syncthreads();
            if (tid < 128) { const int m = blk * 64 + (tid >> 1); const int e = TOKE[blk * 128 + tid]; const int r = sh[8 + e] + sh[16 + e] + TOKR[blk * 128 + tid];
                ROWDST[r] = m * 2 + (tid & 1); ROWG[r] = TOKG[blk * 128 + tid]; }
            for (int r8 = 0; r8 < 8; ++r8) {
                const int m = blk * 64 + wid * 8 + r8; const int e0 = TOKE[m * 2], e1 = TOKE[m * 2 + 1];
                const int r0 = sh[8 + e0] + sh[16 + e0] + TOKR[m * 2], r1 = sh[8 + e1] + sh[16 + e1] + TOKR[m * 2 + 1];
                const float rs = RSTD[m]; const f32x4* xr = (const f32x4*)(hres + (size_t)m * D);
                unsigned* o0 = (unsigned*)(XR + (size_t)r0 * D); unsigned* o1 = (unsigned*)(XR + (size_t)r1 * D);
#pragma unroll
                for (int j = 0; j < 4; ++j) { const f32x4 v = xr[lane + 64 * j], gv = gr[lane + 64 * j]; const unsigned w = pg8::pk4_fp8(v.x * rs * gv.x, v.y * rs * gv.y, v.z * rs * gv.z, v.w * rs * gv.w); o0[lane + 64 * j] = w; o1[lane + 64 * j] = w; }
            }
            if (blk == 0) {
                for (int e = 0; e < NE; ++e) { const int lo = sh[8 + e] + sh[e], hi = sh[8 + e] + sh[24 + e] * 256; for (int r = lo + tid; r < hi; r += NT) { ROWDST[r] = -1; ROWG[r] = 0.f; } }
                if (tid < MAXTILES) { int e = 0; for (int q = 0; q < NE; ++q) if (tid * 256 >= sh[8 + q]) e = q; TILEE[tid] = e; }
                if (tid == 0) TILEE[MAXTILES] = sh[32];
            }
            __syncthreads();
        }
    } break;

    case PH_MOEUP: {
        PHASE_ENTER
        const int ntiles = __builtin_amdgcn_readfirstlane(__hip_atomic_load(TILEE + MAXTILES, __ATOMIC_RELAXED, __HIP_MEMORY_SCOPE_AGENT));
        pg8::Gemm g{(const bf16*)XR, (const bf16*)(ws + WS_W13), 0, 0, D / 2}; pg8::MoeOrder S; S.init(ntiles, DFFE / 128, G, bid, 0, 0, TILEE);
        pg8::EpiSwiglu8 E{HIDE, DFFE, 1.0f / W13_SCALE, HID_SCALE};
        pg8::gemm_phase<pg8::EpiSwiglu8, pg8::MoeOrder, true, true, true>((PG8_LAS unsigned char*)lds_raw, g, S, E, tid);
    } break;

    case PH_MOEDOWN: {
        PHASE_ENTER
        const int ntiles = __builtin_amdgcn_readfirstlane(__hip_atomic_load(TILEE + MAXTILES, __ATOMIC_RELAXED, __HIP_MEMORY_SCOPE_AGENT));
        pg8::Gemm g{(const bf16*)HIDE, (const bf16*)(ws + WS_W2), 0, 0, DFFE / 2}; pg8::MoeOrder S; S.init(ntiles, D / 256, G, bid, 0, 0, TILEE);
        pg8::EpiMoeDown E{OUT2, ROWDST, ROWG, 1.0f / (W2_SCALE * HID_SCALE)};
        pg8::gemm_phase<pg8::EpiMoeDown, pg8::MoeOrder, true, true, true>((PG8_LAS unsigned char*)lds_raw, g, S, E, tid);
    } break;

    case PH_FINAL: {
        PHASE_ENTER
        const float* g = IN(24); const int gw = bid * 8 + wid, NGW = G * 8;
        for (int m = gw; m < NTOK; m += NGW) {
            f32x4* xr = (f32x4*)(hres + (size_t)m * D); const f32x4* gr = (const f32x4*)g;
            const u32x2* o0 = (const u32x2*)(OUT2 + (size_t)(2 * m) * D); const u32x2* o1 = (const u32x2*)(OUT2 + (size_t)(2 * m + 1) * D);
            f32x4 v[4]; float s = 0.f;
#pragma unroll
            for (int j = 0; j < 4; ++j) {
                v[j] = xr[lane + 64 * j]; const u32x2 p = o0[lane + 64 * j], q = o1[lane + 64 * j];
                v[j].x += bf2f(p.x & 0xffffu) + bf2f(q.x & 0xffffu); v[j].y += bf2f(p.x >> 16) + bf2f(q.x >> 16);
                v[j].z += bf2f(p.y & 0xffffu) + bf2f(q.y & 0xffffu); v[j].w += bf2f(p.y >> 16) + bf2f(q.y >> 16);
                s += (v[j].x * v[j].x + v[j].y * v[j].y) + (v[j].z * v[j].z + v[j].w * v[j].w);
            }
            const float r = 1.0f / sqrtf(wave_sum(s) * (1.0f / D) + 1e-6f);
#pragma unroll
            for (int j = 0; j < 4; ++j) { const f32x4 gv = gr[lane + 64 * j]; (dry ? (f32x4*)((float*)(ws + 340 * MiB) + (size_t)m * D) : xr)[lane + 64 * j] = (f32x4){v[j].x * r * gv.x, v[j].y * r * gv.y, v[j].z * r * gv.z, v[j].w * r * gv.w}; }
        }
    } break;
    }
    if (step + 1 < a.ph_hi) { int t_ = wid_s * 64 + (int)__builtin_amdgcn_mbcnt_hi(~0u, __builtin_amdgcn_mbcnt_lo(~0u, 0u)); asm volatile("" : "+v"(t_)); xcd_barrier(bar, t_ == 0); }
#ifdef REP_STEP
    if (dry) { --rep_left; --step; }
#endif
    }
}

constexpr int NSTEPS = 20;
#ifndef MK_PER_PHASE
#define MK_PER_PHASE 0
#endif

extern "C" void kernel_launch(void* const* d_in, const int* in_sizes, int n_in, void* d_out, int out_size, void* d_ws, size_t ws_size, hipStream_t stream) {
    static int grid = 0;
    if (grid == 0) {
        if (n_in != 25 || out_size != NTOK * D || ws_size < WS_END) { fprintf(stderr, "kernel_launch: unexpected shapes (n_in %d out %d ws %zu need %zu)\n", n_in, out_size, ws_size, (size_t)WS_END); grid = -1; return; }
        int dev = 0, cus = 0, per_cu = 0;
        if (hipGetDevice(&dev) != hipSuccess || hipDeviceGetAttribute(&cus, hipDeviceAttributeMultiprocessorCount, dev) != hipSuccess) { grid = -1; return; }
        if (hipFuncSetAttribute((const void*)fwd, hipFuncAttributeMaxDynamicSharedMemorySize, LDS_BYTES) != hipSuccess) { fprintf(stderr, "kernel_launch: hipFuncSetAttribute failed\n"); grid = -1; return; }
        if (hipOccupancyMaxActiveBlocksPerMultiprocessor(&per_cu, (const void*)fwd, NT, LDS_BYTES) != hipSuccess || per_cu < 1) { fprintf(stderr, "kernel_launch: occupancy query says %d blocks/CU\n", per_cu); (void)hipGetLastError(); grid = -1; return; }
        grid = cus;
    }
    if (grid < 0) return;
    hipMemsetAsync((char*)d_ws + WS_CTL, 0, 1 * MiB, stream);
    Args a{};
    for (int i = 0; i < 25; ++i) a.in[i] = (const float*)d_in[i];
    a.out = (float*)d_out; a.ws = (unsigned char*)d_ws;
#if MK_PER_PHASE
    for (int s = 0; s < NSTEPS; ++s) { a.ph_lo = s; a.ph_hi = s + 1; hipLaunchKernelGGL(fwd, dim3(grid), dim3(NT), LDS_BYTES, stream, a); }
#else
    a.ph_lo = 0; a.ph_hi = NSTEPS;
    hipLaunchKernelGGL(fwd, dim3(grid), dim3(NT), LDS_BYTES, stream, a);
#endif
}
```

```cpp
#include <hip/hip_runtime.h>
#include <cstdint>
#include <cstdio>

typedef unsigned short bf16;
typedef short bf16x8 __attribute__((ext_vector_type(8)));
typedef float f32x4 __attribute__((ext_vector_type(4)));
typedef unsigned u32x4 __attribute__((ext_vector_type(4)));
typedef unsigned u32x2 __attribute__((ext_vector_type(2)));

constexpr int NTOK = 16384, SEQ = 8192, D = 1024, DIN = 2560, GW = 256, HD = 64, DFF = 2816, DFFE = 3584, NE = 8;
constexpr int CH = 64, NCHUNK = NTOK / CH, CPB = SEQ / CH;
constexpr int NT = 512;
constexpr float W13_SCALE = 64.f, W2_SCALE = 128.f, HID_SCALE = 8.f;
constexpr int MAXTILES = NTOK * 2 / 256 + NE;

constexpr size_t MiB = 1u << 20;
constexpr size_t WS_CTL = 0;
constexpr size_t WS_SMALL = 1 * MiB;
constexpr size_t WS_WIN = 5 * MiB;
constexpr size_t WS_WOUT = 15 * MiB;
constexpr size_t WS_WGU = 19 * MiB;
constexpr size_t WS_WD = 30 * MiB;
constexpr size_t WS_W13 = 36 * MiB;
constexpr size_t WS_W2 = 92 * MiB;
constexpr size_t WS_ACT = 120 * MiB;
constexpr size_t WS_HN = WS_ACT;
constexpr size_t WS_PROJ = WS_ACT + 32 * MiB;
constexpr size_t WS_Y = WS_ACT + 112 * MiB;
constexpr size_t WS_DS = WS_ACT + 144 * MiB;
constexpr size_t WS_HID = WS_PROJ;
constexpr size_t WS_XR = WS_ACT;
constexpr size_t WS_HIDE = WS_ACT + 34 * MiB;
constexpr size_t WS_OUT2 = WS_ACT + 153 * MiB;
constexpr size_t WS_END = WS_ACT + 217 * MiB;
constexpr size_t SM_TOKE = 0;
constexpr size_t SM_TOKG = 128 * 1024;
constexpr size_t SM_TOKR = 256 * 1024;
constexpr size_t SM_BCNT = 384 * 1024;
constexpr size_t SM_ROWTOK = 400 * 1024;
constexpr size_t SM_ROWDST = 544 * 1024;
constexpr size_t SM_ROWG = 688 * 1024;
constexpr size_t SM_TILEE = 832 * 1024;
constexpr size_t SM_CARA = 1024 * 1024;
constexpr size_t SM_CARH = 1280 * 1024;
constexpr size_t SM_CIN = 1536 * 1024;
constexpr size_t SM_DEC = 1792 * 1024;
constexpr size_t SM_RSTD = 2048 * 1024;
constexpr size_t SM_WTA = 2304 * 1024;
constexpr size_t SM_WTX = 2368 * 1024;
constexpr size_t SM_WTP = 2432 * 1024;

struct Args {
    const float* in[25];
    float* out;
    unsigned char* ws;
    int ph_lo, ph_hi, pad0, pad1;
};

__device__ __forceinline__ int lane_id_asm() { int l; asm volatile("v_mbcnt_lo_u32_b32 %0, -1, 0\n\tv_mbcnt_hi_u32_b32 %0, -1, %0" : "=v"(l)); return l; }
__device__ __forceinline__ const float* IN(int k) { asm volatile("" : "+s"(k)); return ((const float* const __attribute__((address_space(4)))*)__builtin_amdgcn_kernarg_segment_ptr())[k]; }
__device__ __forceinline__ float bf2f(unsigned v) { return __uint_as_float(v << 16); }
__device__ __forceinline__ unsigned f2bf(float f) { unsigned u = __float_as_uint(f); return (u + 0x7fffu + ((u >> 16) & 1u)) >> 16; }
__device__ __forceinline__ unsigned pk2(float lo, float hi) { return f2bf(lo) | (f2bf(hi) << 16); }
__device__ __forceinline__ float fexp(float x) { return __builtin_amdgcn_exp2f(1.44269504089f * x); }
__device__ __forceinline__ float flog(float x) { return 0.69314718056f * __builtin_amdgcn_logf(x); }
__device__ __forceinline__ float sigmoidf_(float x) { return __builtin_amdgcn_rcpf(1.0f + __builtin_amdgcn_exp2f(-1.44269504089f * x)); }
__device__ __forceinline__ float siluf_(float x) { return x * sigmoidf_(x); }
__device__ __forceinline__ float gelu_tanh(float x) { const float u = 1.5957691216057308f * (x + 0.044715f * x * x * x); return x * sigmoidf_(u); }
__device__ __forceinline__ float neg_expm1_small(float x) { return -x * (1.0f + x * (0.5f + x * (0.16666667f + x * (0.041666668f + x * 0.0083333338f)))); }
__device__ __forceinline__ float wave_sum(float v) {
#pragma unroll
    for (int o = 1; o < 64; o <<= 1) v += __shfl_xor(v, o);
    return v;
}
#define LDS_WAIT() asm volatile("s_waitcnt lgkmcnt(0)" ::: "memory")

namespace pg8 {
#define PG8_LAS __attribute__((address_space(3)))
typedef unsigned short bf16_t;
typedef short bf16x8 __attribute__((ext_vector_type(8)));
typedef float f32x4 __attribute__((ext_vector_type(4)));
typedef unsigned u32x4 __attribute__((ext_vector_type(4)));
constexpr int BM = 256, BK = 64, HALF = 128, HTB = HALF * BK * 2  , STAGE_BYTES = 8 * HTB, NXCD = 8, WGM = 8;

__host__ __device__ __forceinline__ int lds_byte(int r, int c) { const int st = (r >> 4) * 2 + (c >> 5), rr = r & 15, cc = c & 31, ob = rr * 64 + cc * 2; return st * 1024 + (ob ^ (((ob >> 9) & 1) << 5)); }
__host__ __device__ __forceinline__ void stage_rc(int b, int& R, int& C) { const int st = b / 1024, sb = b % 1024, swz = sb ^ (((sb >> 9) & 1) << 5); R = (st >> 1) * 16 + swz / 64; C = (st & 1) * 32 + (swz % 64) / 2; }
__host__ __device__ __forceinline__ int perm32(int rho) { const int n = rho >> 4, i = rho & 15; return 8 * (i >> 2) + 4 * n + (i & 3); }

struct Unit { int pm, pn, pa, pb, ord; };
struct Gemm { const bf16_t* A; const bf16_t* Bt; int M, N, K; };

struct StaticOrder {
    int nM, nN, nwg, G, c;
    __host__ __device__ void init(int M, int N, int G_, int c_) { nM = M / BM; nN = N / BM; nwg = nM * nN; G = G_; c = c_; }
    __host__ __device__ bool next(int i, Unit& u) const {
        const long L = (long)i * G + c; if (L >= nwg) return false;
        int wgid = (int)L; { const int q = nwg / NXCD, r = nwg % NXCD, xcd = wgid % NXCD, off = wgid / NXCD; wgid = (xcd < r ? xcd * (q + 1) : r * (q + 1) + (xcd - r) * q) + off; }
        const int nig = WGM * nN, gid = wgid / nig, fm = gid * WGM, gsz = (nM - fm) < WGM ? (nM - fm) : WGM;
        u.pm = fm + ((wgid % nig) % gsz); u.pn = (wgid % nig) / gsz; u.pa = u.pm; u.pb = u.pn; u.ord = i; return true;
    }
    __device__ __forceinline__ void a_ready(const Unit&) const {}
    __device__ __forceinline__ void done(const Unit&) const {}
};

__device__ __forceinline__ unsigned cvt_pk_bf16(float lo, float hi) { unsigned r; asm volatile("v_cvt_pk_bf16_f32 %0, %1, %2" : "=v"(r) : "v"(lo), "v"(hi)); return r; }
typedef float f32x2 __attribute__((ext_vector_type(2)));
typedef int pg8_v8i __attribute__((ext_vector_type(8))); typedef int pg8_v4i __attribute__((ext_vector_type(4)));
__device__ __forceinline__ pg8_v8i pg8_cat(bf16x8 lo, bf16x8 hi) { return __builtin_shufflevector(__builtin_bit_cast(pg8_v4i, lo), __builtin_bit_cast(pg8_v4i, hi), 0, 1, 2, 3, 4, 5, 6, 7); }
__device__ __forceinline__ void pg8_mfma8(f32x4& acc, pg8_v8i a, pg8_v8i b, int sc) { asm volatile("v_mfma_scale_f32_16x16x128_f8f6f4 %0, %1, %2, %0, %3, %3 op_sel_hi:[0,0,0]" : "+v"(acc) : "v"(a), "v"(b), "v"(sc)); }
template <class Epi, class Sched, bool ALIGN_EPI = false, bool SP2 = false, bool F8 = false>
__device__ __forceinline__ void gemm_phase(PG8_LAS unsigned char* lds, const Gemm g, const Sched& S, const Epi& E, int tid_in) {
    int tid = tid_in; asm volatile("" : "+v"(tid));
    const int wid = __builtin_amdgcn_readfirstlane(tid >> 6), lane = tid & 63, wr = wid >> 2, wc = wid & 3, fr = lane & 15, fq = lane >> 4;
    const int K = g.K, nt = K / BK;
    unsigned voffA[2], voffB[2];
#pragma unroll
    for (int i = 0; i < 2; ++i) { int R, C; stage_rc(tid * 16 + i * 8192, R, C); const int Rb = Epi::PERM ? ((R & ~31) + perm32(R & 31)) : R;
        voffA[i] = (unsigned)(R * K + C) * 2u; voffB[i] = (unsigned)(Rb * K + C) * 2u; }
    const size_t kstep = (size_t)(BK * 2);
    const size_t hstep = (size_t)HALF * K * 2;
    const size_t tstep = 2 * hstep;
    const unsigned ldsw = (unsigned)wid * 1024u;
    int f8one = 0x7f7f7f7f; asm volatile("" : "+v"(f8one));
    constexpr int KOFF = 1024;
    const int aoff = lds_byte(wr * 64 + fr, fq * 8), boff = lds_byte(wc * 32 + fr, fq * 8);
#define PG8_SA(b, h) (((b) * 2 + (h)) * HTB)
#define PG8_SB(b, h) ((4 + (b) * 2 + (h)) * HTB)
#define PG8_STAGE(bufoff, gbase, voff) do { _Pragma("unroll") for (int _i = 0; _i < 2; ++_i) \
        __builtin_amdgcn_global_load_lds((const unsigned*)((const char*)(gbase) + (voff)[_i]), (PG8_LAS unsigned*)(lds + (bufoff) + ldsw + _i * 8192), 16, 0, 0); } while (0)
#define PG8_LDA(dst, b, h) do { _Pragma("unroll") for (int m = 0; m < 4; ++m) _Pragma("unroll") for (int k = 0; k < 2; ++k) dst[m][k] = *(const PG8_LAS bf16x8*)(lds + PG8_SA(b, h) + aoff + m * 2048 + k * KOFF); } while (0)
#define PG8_LDB(dst, b, h) do { _Pragma("unroll") for (int n = 0; n < 2; ++n) _Pragma("unroll") for (int k = 0; k < 2; ++k) dst[n][k] = *(const PG8_LAS bf16x8*)(lds + PG8_SB(b, h) + boff + n * 2048 + k * KOFF); } while (0)
#define PG8_MMA(ai, bj, At, Bt) do { __builtin_amdgcn_s_setprio(1); if constexpr (F8) { _Pragma("unroll") for (int m = 0; m < 4; ++m) _Pragma("unroll") for (int n = 0; n < 2; ++n) \
        pg8_mfma8(acc[ai][bj][m][n], pg8_cat(Bt[n][0], Bt[n][1]), pg8_cat(At[m][0], At[m][1]), f8one); } \
    else { _Pragma("unroll") for (int m = 0; m < 4; ++m) _Pragma("unroll") for (int n = 0; n < 2; ++n) _Pragma("unroll") for (int k = 0; k < 2; ++k) \
        acc[ai][bj][m][n] = __builtin_amdgcn_mfma_f32_16x16x32_bf16(Bt[n][k], At[m][k], acc[ai][bj][m][n], 0, 0, 0); } __builtin_amdgcn_s_setprio(0); } while (0)
#define PG8_WAIT_V(n) asm volatile("s_waitcnt vmcnt(" #n ")" ::: "memory")
#define PG8_WAIT_L(n) asm volatile("s_waitcnt lgkmcnt(" #n ")" ::: "memory")
#define PG8_BAR __builtin_amdgcn_s_barrier()
#define PG8_SCHED __builtin_amdgcn_sched_barrier(0)
    Unit cur, nxt; int ui = 0;
    if (!S.next(0, cur)) return;
    f32x4 acc[2][2][4][2];
    if constexpr (Epi::ACC_INIT) E.init(acc, cur, wr, wc, fr, fq);
    else {
#pragma unroll
    for (int a = 0; a < 2; ++a)
#pragma unroll
        for (int b = 0; b < 2; ++b)
#pragma unroll
            for (int m = 0; m < 4; ++m)
#pragma unroll
                for (int n = 0; n < 2; ++n) acc[a][b][m][n] = (f32x4){0.f, 0.f, 0.f, 0.f};
    }
    bf16x8 At[4][2], B0[2][2], B1[2][2];
    const char* cA = (const char*)g.A + (size_t)cur.pa * tstep; const char* cB = (const char*)g.Bt + (size_t)cur.pb * tstep;
    S.a_ready(cur);
    if constexpr (SP2) {
        PG8_STAGE(PG8_SB(0, 0), cB, voffB); PG8_STAGE(PG8_SB(0, 1), cB + hstep, voffB); PG8_STAGE(PG8_SA(0, 0), cA, voffA); PG8_STAGE(PG8_SA(0, 1), cA + hstep, voffA);
        if (wr == 1) PG8_BAR;
        PG8_WAIT_V(2); PG8_BAR;
        PG8_STAGE(PG8_SB(1, 0), cB + kstep, voffB); PG8_STAGE(PG8_SA(1, 0), cA + kstep, voffA); PG8_STAGE(PG8_SB(1, 1), cB + hstep + kstep, voffB);
        PG8_WAIT_V(6); PG8_BAR;
    } else {
        PG8_STAGE(PG8_SB(0, 0), cB, voffB); PG8_STAGE(PG8_SA(0, 0), cA, voffA); PG8_STAGE(PG8_SB(0, 1), cB + hstep, voffB); PG8_STAGE(PG8_SA(0, 1), cA + hstep, voffA);
        if (wr == 1) PG8_BAR;
        PG8_WAIT_V(4); PG8_BAR;
        PG8_STAGE(PG8_SB(1, 0), cB + kstep, voffB); PG8_STAGE(PG8_SA(1, 0), cA + kstep, voffA); PG8_STAGE(PG8_SB(1, 1), cB + hstep + kstep, voffB);
        PG8_WAIT_V(6); PG8_BAR;
    }
    for (;;) {
        const bool has_next = S.next(ui + 1, nxt);
        const char* nA = has_next ? (const char*)g.A + (size_t)nxt.pa * tstep : cA; const char* nB = has_next ? (const char*)g.Bt + (size_t)nxt.pb * tstep : cB;
        for (int t = 0; t < nt; t += 2) {
            const bool last = (t == nt - 2);
            const char* a1 = cA + (size_t)(t + 1) * kstep;
            const char* a2 = last ? nA : cA + (size_t)(t + 2) * kstep; const char* b2 = last ? nB : cB + (size_t)(t + 2) * kstep;
            const char* a3 = a2 + kstep; const char* b3 = b2 + kstep;
            if (last && has_next) S.a_ready(nxt);
            if constexpr (SP2) {
            PG8_LDB(B0, 0, 0); PG8_LDB(B1, 0, 1); PG8_SCHED; PG8_LDA(At, 0, 0); PG8_STAGE(PG8_SA(1, 1), a1 + hstep, voffA);
            PG8_WAIT_V(8); PG8_WAIT_L(0); PG8_BAR; PG8_MMA(0, 0, At, B0); PG8_MMA(0, 1, At, B1); PG8_BAR; PG8_SCHED;
            PG8_LDA(At, 0, 1); PG8_STAGE(PG8_SB(0, 0), b2, voffB); PG8_STAGE(PG8_SB(0, 1), b2 + hstep, voffB); PG8_STAGE(PG8_SA(0, 0), a2, voffA);
            PG8_WAIT_V(8); PG8_WAIT_L(0); PG8_BAR; PG8_MMA(1, 0, At, B0); PG8_MMA(1, 1, At, B1); PG8_BAR; PG8_SCHED;
            PG8_LDB(B0, 1, 0); PG8_LDB(B1, 1, 1); PG8_SCHED; PG8_LDA(At, 1, 0); PG8_STAGE(PG8_SA(0, 1), a2 + hstep, voffA);
            PG8_WAIT_V(8); PG8_WAIT_L(0); PG8_BAR; PG8_MMA(0, 0, At, B0); PG8_MMA(0, 1, At, B1); PG8_BAR; PG8_SCHED;
            PG8_LDA(At, 1, 1); PG8_STAGE(PG8_SB(1, 0), b3, voffB); PG8_STAGE(PG8_SB(1, 1), b3 + hstep, voffB); PG8_STAGE(PG8_SA(1, 0), a3, voffA);
            PG8_WAIT_V(8); PG8_WAIT_L(0); PG8_BAR; PG8_MMA(1, 0, At, B0); PG8_MMA(1, 1, At, B1); PG8_BAR; PG8_SCHED;
            } else {
            PG8_LDB(B0, 0, 0); PG8_SCHED; PG8_LDA(At, 0, 0); PG8_STAGE(PG8_SA(1, 1), a1 + hstep, voffA);
            PG8_WAIT_L(8); PG8_BAR; PG8_WAIT_L(0); PG8_MMA(0, 0, At, B0); PG8_BAR; PG8_SCHED;
            PG8_LDB(B1, 0, 1); PG8_STAGE(PG8_SB(0, 0), b2, voffB);
            PG8_BAR; PG8_WAIT_L(0); PG8_MMA(0, 1, At, B1); PG8_BAR;
            PG8_LDA(At, 0, 1); PG8_STAGE(PG8_SA(0, 0), a2, voffA);
            PG8_BAR; PG8_WAIT_L(0); PG8_MMA(1, 0, At, B0); PG8_BAR; PG8_SCHED;
            PG8_STAGE(PG8_SB(0, 1), b2 + hstep, voffB);
            PG8_WAIT_V(6); PG8_BAR; PG8_MMA(1, 1, At, B1); PG8_BAR;
            PG8_LDB(B0, 1, 0); PG8_SCHED; PG8_LDA(At, 1, 0); PG8_STAGE(PG8_SA(0, 1), a2 + hstep, voffA);
            PG8_WAIT_L(8); PG8_BAR; PG8_WAIT_L(0); PG8_MMA(0, 0, At, B0); PG8_BAR; PG8_SCHED;
            PG8_LDB(B1, 1, 1); PG8_STAGE(PG8_SB(1, 0), b3, voffB);
            PG8_BAR; PG8_WAIT_L(0); PG8_MMA(0, 1, At, B1); PG8_BAR;
            PG8_LDA(At, 1, 1); PG8_STAGE(PG8_SA(1, 0), a3, voffA);
            PG8_BAR; PG8_WAIT_L(0); PG8_MMA(1, 0, At, B0); PG8_BAR; PG8_SCHED;
            PG8_STAGE(PG8_SB(1, 1), b3 + hstep, voffB);
            PG8_WAIT_V(6); PG8_BAR; PG8_MMA(1, 1, At, B1); PG8_BAR;
            }
        }
        if constexpr (F8) asm volatile("s_nop 15\n\ts_nop 15" ::: "memory");
        if constexpr (ALIGN_EPI) { if (wr == 0) PG8_BAR; }
        if constexpr (!Epi::AFTER_DRAIN) { E(acc, cur, wr, wc, fr, fq); S.done(cur); }
        if (!has_next) break;
#pragma unroll
        for (int a = 0; a < 2; ++a)
#pragma unroll
            for (int b = 0; b < 2; ++b)
#pragma unroll
                for (int m = 0; m < 4; ++m)
#pragma unroll
                    for (int n = 0; n < 2; ++n) acc[a][b][m][n] = (f32x4){0.f, 0.f, 0.f, 0.f};
        cur = nxt; cA = nA; cB = nB; ++ui;
        if constexpr (ALIGN_EPI) { if (wr == 1) PG8_BAR; }
    }
    PG8_WAIT_V(0);
    if constexpr (!ALIGN_EPI) { if (wr == 0) PG8_BAR; }
    PG8_BAR;
    if constexpr (Epi::AFTER_DRAIN) { E.fused(acc, cur, wr, wc, fr, fq, lds, wid, lane); S.done(cur); }
#undef PG8_SA
#undef PG8_SB
#undef PG8_STAGE
#undef PG8_LDA
#undef PG8_LDB
#undef PG8_MMA
#undef PG8_WAIT_V
#undef PG8_WAIT_L
#undef PG8_BAR
#undef PG8_SCHED
}

struct EpiStoreBf16 {
    static constexpr bool PERM = true, AFTER_DRAIN = false, ACC_INIT = false;
    bf16_t* O; int ldc;
    __device__ __forceinline__ void operator()(const f32x4 (&acc)[2][2][4][2], const Unit& u, int wr, int wc, int fr, int fq) const {
        const int row0 = u.pm * BM + wr * 64 + fr, col0 = u.pn * BM + wc * 32 + 8 * fq;
#pragma unroll
        for (int ai = 0; ai < 2; ++ai)
#pragma unroll
            for (int m = 0; m < 4; ++m) { bf16_t* rowp = O + (size_t)(row0 + ai * HALF + m * 16) * ldc + col0;
#pragma unroll
                for (int bj = 0; bj < 2; ++bj) { const f32x4 v0 = acc[ai][bj][m][0], v1 = acc[ai][bj][m][1];
                    u32x4 w; w.x = cvt_pk_bf16(v0[0], v0[1]); w.y = cvt_pk_bf16(v0[2], v0[3]); w.z = cvt_pk_bf16(v1[0], v1[1]); w.w = cvt_pk_bf16(v1[2], v1[3]);
                    *(u32x4*)(rowp + bj * HALF) = w; } }
    }
};
struct EpiResidF32 {
    static constexpr bool PERM = false, AFTER_DRAIN = false, ACC_INIT = true;
    const float* base; float* out;
    __device__ __forceinline__ void init(f32x4 (&acc)[2][2][4][2], const Unit& u, int wr, int wc, int fr, int fq) const {
        const int row0 = u.pm * BM + wr * 64 + fr, col0 = u.pn * BM + wc * 32 + 4 * fq;
#pragma unroll
        for (int ai = 0; ai < 2; ++ai)
#pragma unroll
            for (int m = 0; m < 4; ++m) { const size_t off = (size_t)(row0 + ai * HALF + m * 16) * 1024 + col0;
#pragma unroll
                for (int bj = 0; bj < 2; ++bj)
#pragma unroll
                    for (int n = 0; n < 2; ++n) acc[ai][bj][m][n] = *(const f32x4*)(base + off + bj * HALF + n * 16); }
    }
    __device__ __forceinline__ void operator()(const f32x4 (&acc)[2][2][4][2], const Unit& u, int wr, int wc, int fr, int fq) const {
        const int row0 = u.pm * BM + wr * 64 + fr, col0 = u.pn * BM + wc * 32 + 4 * fq;
#pragma unroll
        for (int ai = 0; ai < 2; ++ai)
#pragma unroll
            for (int m = 0; m < 4; ++m) { const size_t off = (size_t)(row0 + ai * HALF + m * 16) * 1024 + col0;
#pragma unroll
                for (int bj = 0; bj < 2; ++bj)
#pragma unroll
                    for (int n = 0; n < 2; ++n) *(f32x4*)(out + off + bj * HALF + n * 16) = acc[ai][bj][m][n]; }
    }
};
__device__ __forceinline__ float silu_f(float x) { return x * __builtin_amdgcn_rcpf(1.0f + __builtin_amdgcn_exp2f(-1.44269504089f * x)); }
struct EpiSwiglu {
    static constexpr bool PERM = true, AFTER_DRAIN = false, ACC_INIT = false;
    bf16_t* C; int ldc; int row_off;
    __device__ __forceinline__ void operator()(const f32x4 (&acc)[2][2][4][2], const Unit& u, int wr, int wc, int fr, int fq) const {
        const int row0 = u.pm * BM + wr * 64 + fr - row_off, col0 = u.pn * HALF + wc * 32 + 8 * fq;
#pragma unroll
        for (int ai = 0; ai < 2; ++ai)
#pragma unroll
            for (int m = 0; m < 4; ++m) { bf16_t* rowp = C + (size_t)(row0 + ai * HALF + m * 16) * ldc + col0;
                const f32x4 g0 = acc[ai][0][m][0], g1 = acc[ai][0][m][1], u0 = acc[ai][1][m][0], u1 = acc[ai][1][m][1];
                u32x4 w; w.x = cvt_pk_bf16(silu_f(g0[0]) * u0[0], silu_f(g0[1]) * u0[1]); w.y = cvt_pk_bf16(silu_f(g0[2]) * u0[2], silu_f(g0[3]) * u0[3]);
                w.z = cvt_pk_bf16(silu_f(g1[0]) * u1[0], silu_f(g1[1]) * u1[1]); w.w = cvt_pk_bf16(silu_f(g1[2]) * u1[2], silu_f(g1[3]) * u1[3]);
                *(u32x4*)rowp = w; }
    }
};
struct EpiMoeDown {
    static constexpr bool PERM = true, AFTER_DRAIN = false, ACC_INIT = false;
    bf16_t* out2; const int* rowdst; const float* rowg; float sc;
    __device__ __forceinline__ void operator()(const f32x4 (&acc)[2][2][4][2], const Unit& u, int wr, int wc, int fr, int fq) const {
        const int row0 = u.pm * BM + wr * 64 + fr, col0 = u.pn * BM + wc * 32 + 8 * fq;
#pragma unroll
        for (int ai = 0; ai < 2; ++ai)
#pragma unroll
            for (int m = 0; m < 4; ++m) { const int gr = row0 + ai * HALF + m * 16; const int d = rowdst[gr]; const float g = rowg[gr] * sc;
                if (d >= 0) { bf16_t* rowp = out2 + (size_t)d * 1024 + col0;
#pragma unroll
                    for (int bj = 0; bj < 2; ++bj) { const f32x4 v0 = acc[ai][bj][m][0] * g, v1 = acc[ai][bj][m][1] * g;
                        u32x4 w; w.x = cvt_pk_bf16(v0[0], v0[1]); w.y = cvt_pk_bf16(v0[2], v0[3]); w.z = cvt_pk_bf16(v1[0], v1[1]); w.w = cvt_pk_bf16(v1[2], v1[3]);
                        *(u32x4*)(rowp + bj * HALF) = w; } } }
    }
};


struct EpiResidStats {
    static constexpr bool PERM = false, AFTER_DRAIN = false, ACC_INIT = true;
    const float* base; float* out; bf16_t* hn; float* ssp;
    __device__ __forceinline__ void init(f32x4 (&acc)[2][2][4][2], const Unit& u, int wr, int wc, int fr, int fq) const {
        const int row0 = u.pm * BM + wr * 64 + fr, col0 = u.pn * BM + wc * 32 + 4 * fq;
#pragma unroll
        for (int ai = 0; ai < 2; ++ai)
#pragma unroll
            for (int m = 0; m < 4; ++m) { const size_t off = (size_t)(row0 + ai * HALF + m * 16) * 1024 + col0;
#pragma unroll
                for (int bj = 0; bj < 2; ++bj)
#pragma unroll
                    for (int n = 0; n < 2; ++n) acc[ai][bj][m][n] = *(const f32x4*)(base + off + bj * HALF + n * 16); }
    }
    __device__ __forceinline__ void operator()(const f32x4 (&acc)[2][2][4][2], const Unit& u, int wr, int wc, int fr, int fq) const {
        const int row0 = u.pm * BM + wr * 64 + fr, col0 = u.pn * BM + wc * 32 + 4 * fq; typedef unsigned u32x2e __attribute__((ext_vector_type(2)));
#pragma unroll
        for (int ai = 0; ai < 2; ++ai)
#pragma unroll
            for (int m = 0; m < 4; ++m) { const int row = row0 + ai * HALF + m * 16; const size_t off = (size_t)row * 1024 + col0; float ss = 0.f;
#pragma unroll
                for (int bj = 0; bj < 2; ++bj)
#pragma unroll
                    for (int n = 0; n < 2; ++n) { const f32x4 v = acc[ai][bj][m][n]; *(f32x4*)(out + off + bj * HALF + n * 16) = v;
                        ss += (v[0] * v[0] + v[1] * v[1]) + (v[2] * v[2] + v[3] * v[3]); u32x2e w; w.x = cvt_pk_bf16(v[0], v[1]); w.y = cvt_pk_bf16(v[2], v[3]); *(u32x2e*)(hn + off + bj * HALF + n * 16) = w; }
                ss += __shfl_xor(ss, 16); ss += __shfl_xor(ss, 32);
                if (fq == 0) ssp[(size_t)row * 16 + u.pn * 4 + wc] = ss; }
    }
};
constexpr int RSTD_TAB_OFF = STAGE_BYTES;
template <class Sched> __device__ __forceinline__ void fill_rstd_table(PG8_LAS unsigned char* lds, const Sched& S, const float* ssp, int tid) {
    PG8_LAS float* tab = (PG8_LAS float*)(lds + RSTD_TAB_OFF); Unit u;
    for (int i = 0; S.next(i, u); ++i)
        if (tid < 256) { const int row = u.pm * BM + tid; const f32x4* p = (const f32x4*)(ssp + (size_t)row * 16); const f32x4 a = p[0], b = p[1], c = p[2], d = p[3];
            const float s = (((a[0] + a[1]) + (a[2] + a[3])) + ((b[0] + b[1]) + (b[2] + b[3]))) + (((c[0] + c[1]) + (c[2] + c[3])) + ((d[0] + d[1]) + (d[2] + d[3])));
            tab[i * 256 + tid] = 1.0f / sqrtf(s * (1.0f / 1024.0f) + 1e-6f); }
    __syncthreads();
}
struct EpiStoreBf16R {
    static constexpr bool PERM = true, AFTER_DRAIN = false, ACC_INIT = false;
    bf16_t* O; int ldc; const PG8_LAS float* tab;
    __device__ __forceinline__ void operator()(const f32x4 (&acc)[2][2][4][2], const Unit& u, int wr, int wc, int fr, int fq) const {
        const int row0 = u.pm * BM + wr * 64 + fr, col0 = u.pn * BM + wc * 32 + 8 * fq;
#pragma unroll
        for (int ai = 0; ai < 2; ++ai)
#pragma unroll
            for (int m = 0; m < 4; ++m) { const int row = row0 + ai * HALF + m * 16; const float r = tab[u.ord * 256 + wr * 64 + fr + ai * HALF + m * 16]; bf16_t* rowp = O + (size_t)row * ldc + col0;
#pragma unroll
                for (int bj = 0; bj < 2; ++bj) { const f32x4 v0 = acc[ai][bj][m][0] * r, v1 = acc[ai][bj][m][1] * r;
                    u32x4 w; w.x = cvt_pk_bf16(v0[0], v0[1]); w.y = cvt_pk_bf16(v0[2], v0[3]); w.z = cvt_pk_bf16(v1[0], v1[1]); w.w = cvt_pk_bf16(v1[2], v1[3]);
                    *(u32x4*)(rowp + bj * HALF) = w; } }
    }
};
struct EpiSwigluR {
    static constexpr bool PERM = true, AFTER_DRAIN = false, ACC_INIT = false;
    bf16_t* C; int ldc; const PG8_LAS float* tab;
    __device__ __forceinline__ void operator()(const f32x4 (&acc)[2][2][4][2], const Unit& u, int wr, int wc, int fr, int fq) const {
        const int row0 = u.pm * BM + wr * 64 + fr, col0 = u.pn * HALF + wc * 32 + 8 * fq;
#pragma unroll
        for (int ai = 0; ai < 2; ++ai)
#pragma unroll
            for (int m = 0; m < 4; ++m) { const int row = row0 + ai * HALF + m * 16; const float r = tab[u.ord * 256 + wr * 64 + fr + ai * HALF + m * 16]; bf16_t* rowp = C + (size_t)row * ldc + col0;
                const f32x4 g0 = acc[ai][0][m][0] * r, g1 = acc[ai][0][m][1] * r, u0 = acc[ai][1][m][0] * r, u1 = acc[ai][1][m][1] * r;
                u32x4 w; w.x = cvt_pk_bf16(silu_f(g0[0]) * u0[0], silu_f(g0[1]) * u0[1]); w.y = cvt_pk_bf16(silu_f(g0[2]) * u0[2], silu_f(g0[3]) * u0[3]);
                w.z = cvt_pk_bf16(silu_f(g1[0]) * u1[0], silu_f(g1[1]) * u1[1]); w.w = cvt_pk_bf16(silu_f(g1[2]) * u1[2], silu_f(g1[3]) * u1[3]);
                *(u32x4*)rowp = w; }
    }
};
__device__ __forceinline__ unsigned pk4_fp8(float a, float b, float c, float d) { int w = __builtin_amdgcn_cvt_pk_fp8_f32(a, b, 0, false); w = __builtin_amdgcn_cvt_pk_fp8_f32(c, d, w, true); return (unsigned)w; }
struct EpiSwiglu8 {
    static constexpr bool PERM = true, AFTER_DRAIN = false, ACC_INIT = false;
    unsigned char* C; int ldc; float isc, osc;
    __device__ __forceinline__ void operator()(const f32x4 (&acc)[2][2][4][2], const Unit& u, int wr, int wc, int fr, int fq) const {
        const int row0 = u.pm * BM + wr * 64 + fr, col0 = u.pn * HALF + wc * 32 + 8 * fq; const float us = isc * osc;
#pragma unroll
        for (int ai = 0; ai < 2; ++ai)
#pragma unroll
            for (int m = 0; m < 4; ++m) { unsigned char* rowp = C + (size_t)(row0 + ai * HALF + m * 16) * ldc + col0;
                const f32x4 g0 = acc[ai][0][m][0] * isc, g1 = acc[ai][0][m][1] * isc, u0 = acc[ai][1][m][0] * us, u1 = acc[ai][1][m][1] * us;
                typedef unsigned u32x2e __attribute__((ext_vector_type(2))); u32x2e w;
                w.x = pk4_fp8(silu_f(g0[0]) * u0[0], silu_f(g0[1]) * u0[1], silu_f(g0[2]) * u0[2], silu_f(g0[3]) * u0[3]);
                w.y = pk4_fp8(silu_f(g1[0]) * u1[0], silu_f(g1[1]) * u1[1], silu_f(g1[2]) * u1[2], silu_f(g1[3]) * u1[3]);
                *(u32x2e*)rowp = w; }
    }
};
struct MoeOrder {
    StaticOrder so; int tlo, nN, a_off; const int* tilee;
    __device__ void init(int nrt, int nN_, int G, int c, int tlo_, int a_off_, const int* tilee_) { so.init(nrt * BM, nN_ * BM, G, c); tlo = tlo_; nN = nN_; a_off = a_off_; tilee = tilee_; }
    __device__ bool next(int i, Unit& u) const { if (!so.next(i, u)) return false; u.pm += tlo; u.pa = u.pm - a_off; const int e = __builtin_amdgcn_readfirstlane(__hip_atomic_load(tilee + u.pm, __ATOMIC_RELAXED, __HIP_MEMORY_SCOPE_AGENT)); u.pb = e * nN + u.pn; return true; }
    __device__ __forceinline__ void a_ready(const Unit&) const {}
    __device__ __forceinline__ void done(const Unit&) const {}
};
}

__device__ __forceinline__ void cvt_item(const float* W, int K, int N, bf16* WT, int mode, int item, float* scr, int lane, const float* gk = nullptr) {
    const int nblk = N / 32, kb = item / nblk, nb = item % nblk, k0 = 64 * kb, n0 = 32 * nb;
    { f32x4 v[8]; const float* src = W + (size_t)(k0 + (lane >> 3)) * N + n0 + 4 * (lane & 7);
#pragma unroll
      for (int i = 0; i < 8; ++i) v[i] = __builtin_nontemporal_load((const f32x4*)(src + (size_t)(8 * i) * N));
#pragma unroll
      for (int i = 0; i < 8; ++i) { float* d = scr + (8 * i + (lane >> 3)) * 33 + 4 * (lane & 7); const float gg = gk ? gk[k0 + 8 * i + (lane >> 3)] : 1.0f; d[0] = v[i].x * gg; d[1] = v[i].y * gg; d[2] = v[i].z * gg; d[3] = v[i].w * gg; } }
    LDS_WAIT();
    const int c = lane & 7;
#pragma unroll
    for (int j = 0; j < 4; ++j) {
        const int n = (lane >> 3) + 8 * j; const float* s = scr + (8 * c) * 33 + n;
        u32x4 o; o.x = pk2(s[0 * 33], s[1 * 33]); o.y = pk2(s[2 * 33], s[3 * 33]); o.z = pk2(s[4 * 33], s[5 * 33]); o.w = pk2(s[6 * 33], s[7 * 33]);
        const int nn = n0 + n; const int drow = mode == 0 ? nn : ((nn >> 7) * 256 + (nn & 127) + (mode == 2 ? 128 : 0));
        *(u32x4*)(WT + (size_t)drow * K + k0 + 8 * c) = o;
    }
    LDS_WAIT();
}

__device__ __forceinline__ void cvt_item8(const float* W, int K, int N, unsigned char* WT, int mode, int item, float* scr, int lane, float scale) {
    const int nblk = N / 32, kb = item / nblk, nb = item % nblk, k0 = 128 * kb, n0 = 32 * nb;
    { f32x4 v[16]; const float* src = W + (size_t)(k0 + (lane >> 3)) * N + n0 + 4 * (lane & 7);
#pragma unroll
      for (int i = 0; i < 16; ++i) v[i] = __builtin_nontemporal_load((const f32x4*)(src + (size_t)(8 * i) * N));
#pragma unroll
      for (int i = 0; i < 16; ++i) { float* d = scr + (8 * i + (lane >> 3)) * 33 + 4 * (lane & 7); d[0] = v[i].x * scale; d[1] = v[i].y * scale; d[2] = v[i].z * scale; d[3] = v[i].w * scale; } }
    LDS_WAIT();
    const int c = lane & 7;
#pragma unroll
    for (int j = 0; j < 4; ++j) {
        const int n = (lane >> 3) + 8 * j; const float* s = scr + (16 * c) * 33 + n;
        u32x4 o; o.x = pg8::pk4_fp8(s[0 * 33], s[1 * 33], s[2 * 33], s[3 * 33]); o.y = pg8::pk4_fp8(s[4 * 33], s[5 * 33], s[6 * 33], s[7 * 33]);
        o.z = pg8::pk4_fp8(s[8 * 33], s[9 * 33], s[10 * 33], s[11 * 33]); o.w = pg8::pk4_fp8(s[12 * 33], s[13 * 33], s[14 * 33], s[15 * 33]);
        const int nn = n0 + n; const int drow = mode == 0 ? nn : ((nn >> 7) * 256 + (nn & 127) + (mode == 2 ? 128 : 0));
        *(u32x4*)(WT + (size_t)drow * K + k0 + 16 * c) = o;
    }
    LDS_WAIT();
}

__device__ __forceinline__ void rms_row_bf16(const float* xrow, const float* g, bf16* orow, int lane) {
    const f32x4* xr = (const f32x4*)xrow; const f32x4* gr = (const f32x4*)g;
    f32x4 v[4]; float s = 0.f;
#pragma unroll
    for (int j = 0; j < 4; ++j) { v[j] = xr[lane + 64 * j]; s += (v[j].x * v[j].x + v[j].y * v[j].y) + (v[j].z * v[j].z + v[j].w * v[j].w); }
    const float r = 1.0f / sqrtf(wave_sum(s) * (1.0f / D) + 1e-6f);
    u32x2* o8 = (u32x2*)orow;
#pragma unroll
    for (int j = 0; j < 4; ++j) { const f32x4 gv = gr[lane + 64 * j]; u32x2 w; w.x = pk2(v[j].x * r * gv.x, v[j].y * r * gv.y); w.y = pk2(v[j].z * r * gv.z, v[j].w * r * gv.w); o8[lane + 64 * j] = w; }
}

#define LAS __attribute__((address_space(3)))
#define XB_TMO      128
#define XB_XCNT(j)  (256  + 64 * (j))
#define XB_XSUB(j)  (1280 + 64 * (j))
#define XB_XGEN(j)  (2304 + 64 * (j))
#define XB_TOP      3328
#define XB_TOPGEN   3392
#define XCD_BAR_WORDS 3456
#define XB_SPIN_CAP (1u << 22)
__device__ __forceinline__ unsigned xb_ld(unsigned* p)              { return __hip_atomic_load(p, __ATOMIC_RELAXED, __HIP_MEMORY_SCOPE_AGENT); }
__device__ __forceinline__ unsigned xb_add(unsigned* p, unsigned v) { return __hip_atomic_fetch_add(p, v, __ATOMIC_RELAXED, __HIP_MEMORY_SCOPE_AGENT); }
__device__ __forceinline__ unsigned xb_xcc_id() { return (unsigned)__builtin_amdgcn_s_getreg((3 << 11) | 20) & 0xFu; }
#define XB_SPIN(cond, bar) do { unsigned _sp = 0; while (cond) { __builtin_amdgcn_s_sleep(1); \
    if ((++_sp & 255u) == 0u) { if (xb_ld(&(bar)[XB_TMO])) break; if (_sp > XB_SPIN_CAP) { atomicAdd(&(bar)[XB_TMO], 1u); break; } } } } while (0)
struct XcdBarrier { unsigned* bar; unsigned x; volatile LAS unsigned* st; };
__device__ __forceinline__ XcdBarrier xcd_barrier_post(unsigned* bar, volatile LAS unsigned* st) {
    XcdBarrier b; b.bar = bar; b.x = xb_xcc_id(); b.st = st;
    if (threadIdx.x == 0) (void)xb_add(&bar[XB_XCNT(b.x)], 1u);
    return b;
}
__device__ __forceinline__ void xcd_barrier_complete(unsigned* bar, unsigned x, unsigned& nloc, unsigned& nx) {
    const unsigned G = gridDim.x * gridDim.y * gridDim.z;
    unsigned sum, cnt, mine, sp = 0u;
    for (;;) {
        sum = 0u; cnt = 0u; mine = 0u;
#pragma unroll
        for (unsigned j = 0; j < 16; ++j) { const unsigned c = xb_ld(&bar[XB_XCNT(j)]); sum += c; cnt += (c > 0u) ? 1u : 0u; mine = (j == x) ? c : mine; }
        if (sum == G) break;
        __builtin_amdgcn_s_sleep(1);
        if ((++sp & 255u) == 0u) { if (xb_ld(&bar[XB_TMO])) break; if (sp > XB_SPIN_CAP) { atomicAdd(&bar[XB_TMO], 1u); break; } }
    }
    nloc = mine > 0u ? mine : 1u; nx = cnt > 0u ? cnt : 1u;
}
__device__ __forceinline__ void xcd_barrier(const XcdBarrier& b, bool leader) {
    asm volatile("s_waitcnt vmcnt(0)" ::: "memory");
    __syncthreads();
    if (leader) {
        unsigned* bar = b.bar;
        __builtin_amdgcn_s_waitcnt(0);
        unsigned nloc = b.st[0], nx = b.st[1];
        if (nloc == 0u) { xcd_barrier_complete(bar, b.x, nloc, nx); b.st[0] = nloc; b.st[1] = nx; }
        const unsigned old = xb_add(&bar[XB_XSUB(b.x)], 1u);
        const unsigned gen = old / nloc;
        if (old + 1u == (gen + 1u) * nloc) {
            __builtin_amdgcn_fence(__ATOMIC_RELEASE, "agent");
            asm volatile("s_waitcnt vmcnt(0)" ::: "memory");
            const unsigned og = xb_add(&bar[XB_TOP], 1u);
            const unsigned tg = og / nx;
            if (og + 1u == (tg + 1u) * nx) xb_add(&bar[XB_TOPGEN], 1u);
            else XB_SPIN(xb_ld(&bar[XB_TOPGEN]) == tg, bar);
            __builtin_amdgcn_fence(__ATOMIC_ACQUIRE, "agent");
            xb_add(&bar[XB_XGEN(b.x)], 1u);
            asm volatile("s_waitcnt vmcnt(0)" ::: "memory");
        } else {
            XB_SPIN(xb_ld(&bar[XB_XGEN(b.x)]) == gen, bar);
            __builtin_amdgcn_fence(__ATOMIC_ACQUIRE, "agent");
            asm volatile("s_waitcnt vmcnt(0)" ::: "memory");
        }
    }
    __syncthreads();
}
constexpr int LDS_BYTES = 163840, RING_BYTES = LDS_BYTES - 512, MISC_OFF = RING_BYTES + 320;
constexpr int CW_BAR = 4096;

enum Phase { PH_PROLOGUE = 0, PH_INPROJ, PH_MIX1, PH_MIX2, PH_MIX3, PH_OUTPROJ, PH_NORM, PH_FFNUP, PH_FFNDOWN, PH_DISPATCH, PH_MOEUP, PH_MOEDOWN, PH_FINAL };


constexpr int RS = 528;
constexpr int AINB_STRIDE = RS;
constexpr int VTS = 144;
template <int NLD> __device__ __forceinline__ void slab_load(u32x4 (&reg)[NLD], const bf16* src, int nrows, int rvalid0, int tid) {
#pragma unroll
    for (int j = 0; j < NLD; ++j) { const int i = tid + j * NT, r = i >> 5, ch = i & 31; reg[j] = (u32x4){0u, 0u, 0u, 0u}; if (i < nrows * 32 && r >= rvalid0) reg[j] = *(const u32x4*)(src + (ptrdiff_t)r * DIN + ch * 8); }
}
template <int NLD> __device__ __forceinline__ void slab_store(const u32x4 (&reg)[NLD], unsigned char* dst, int nrows, int tid) {
#pragma unroll
    for (int j = 0; j < NLD; ++j) { const int i = tid + j * NT, r = i >> 5, ch = i & 31; if (i < nrows * 32) *(u32x4*)(dst + r * RS + ch * 16) = reg[j]; }
}
__device__ __forceinline__ void ytile_store(const unsigned char* src, bf16* y, int tid) {
#pragma unroll
    for (int j = 0; j < 4; ++j) { const int i = tid + j * NT, r = i >> 5, ch = i & 31; *(u32x4*)(y + (size_t)r * D + ch * 8) = *(const u32x4*)(src + r * RS + ch * 16); }
}
__device__ __forceinline__ int vt_off(int c, int tok) { return c * VTS + ((tok ^ (((c >> 3) & 7) << 3)) << 1); }
__device__ __forceinline__ void vt_store(const u32x4 (&reg)[4], unsigned char* vt, int tid) {
#pragma unroll
    for (int j = 0; j < 4; ++j) { const int i = tid + j * NT, r = i >> 5, ch = i & 31, c0 = ch * 8; const unsigned w[4] = {reg[j].x, reg[j].y, reg[j].z, reg[j].w};
#pragma unroll
        for (int q = 0; q < 8; ++q) *(bf16*)(vt + vt_off(c0 + q, r)) = (bf16)((q & 1) ? (w[q >> 1] >> 16) : (w[q >> 1] & 0xffffu)); }
}
__device__ __forceinline__ float lru_ain(const unsigned char* ax, const float* conv_w, const float* conv_b, int t, int c) {
    float acc = conv_b[c];
#pragma unroll
    for (int k = 0; k < 4; ++k) acc += conv_w[k * GW + c] * bf2f(*(const bf16*)(ax + (t + k) * RS + c * 2));
    return acc;
}
__device__ __forceinline__ void lru_ainb(const unsigned char* ax, const float* conv_w, const float* conv_b, unsigned char* ainb, int tid) {
    for (int idx = tid; idx < CH * 128; idx += NT) {
        const int t = idx >> 7, c = (idx & 127) * 2; float a0 = conv_b[c], a1 = conv_b[c + 1];
#pragma unroll
        for (int k = 0; k < 4; ++k) { const unsigned w = *(const unsigned*)(ax + (t + k) * RS + c * 2); a0 += conv_w[k * GW + c] * bf2f(w & 0xffffu); a1 += conv_w[k * GW + c + 1] * bf2f(w >> 16); }
        *(unsigned*)(ainb + t * RS + c * 2) = pk2(a0, a1);
    }
}
__device__ __forceinline__ void lru_gates(const unsigned char* ainb, const unsigned char* ax, const float* conv_w, const float* conv_b, const bf16* wta, const bf16* wtx, const float* b_a, const float* b_x, const float* lam,
                                          int h, int nt, int lane, float (&av)[4][4], float (&uv)[4][4]) {
    const int fr = lane & 15, fq = lane >> 4, c = 64 * h + 16 * nt + fr;
    bf16x8 wa[2], wx[2];
#pragma unroll
    for (int ks = 0; ks < 2; ++ks) { wa[ks] = *(const bf16x8*)(wta + (size_t)(h * 64 + 16 * nt + fr) * 64 + 32 * ks + 8 * fq); wx[ks] = *(const bf16x8*)(wtx + (size_t)(h * 64 + 16 * nt + fr) * 64 + 32 * ks + 8 * fq); }
    f32x4 aa[4], ax4[4];
#pragma unroll
    for (int mt = 0; mt < 4; ++mt) { aa[mt] = (f32x4){0.f, 0.f, 0.f, 0.f}; ax4[mt] = (f32x4){0.f, 0.f, 0.f, 0.f};
#pragma unroll
        for (int ks = 0; ks < 2; ++ks) { const bf16x8 x = *(const bf16x8*)(ainb + (16 * mt + fr) * RS + (64 * h + 32 * ks + 8 * fq) * 2);
            aa[mt] = __builtin_amdgcn_mfma_f32_16x16x32_bf16(x, wa[ks], aa[mt], 0, 0, 0); ax4[mt] = __builtin_amdgcn_mfma_f32_16x16x32_bf16(x, wx[ks], ax4[mt], 0, 0, 0); } }
    const float sp = log1pf(fexp(-lam[c])), ba = b_a[c], bx = b_x[c];
#pragma unroll
    for (int mt = 0; mt < 4; ++mt)
#pragma unroll
        for (int r = 0; r < 4; ++r) { const int t = 16 * mt + 4 * fq + r; const float rg = sigmoidf_(aa[mt][r] + ba), ig = sigmoidf_(ax4[mt][r] + bx); const float loga = -8.0f * rg * sp;
            const float x2 = 2.0f * loga; const float m2 = x2 > -0.25f ? neg_expm1_small(x2) : -expm1f(x2);
            av[mt][r] = fexp(loga); uv[mt][r] = __builtin_amdgcn_sqrtf(fmaxf(m2, 0.f)) * ig * lru_ain(ax, conv_w, conv_b, t, c); }
}

constexpr int CW_CVTQ = 2048, CW_DONE = 8192;
constexpr int BG_IE1 = 8 * 112, BG_IE2 = 28 * 32, BG_ITEMS = 2 * NE * BG_IE1 + NE * BG_IE2, BG_BATCHES = BG_ITEMS / 8;
__device__ __forceinline__ void bg_convert(unsigned char* ws, unsigned char* lds_raw, const float* w1, const float* w3, const float* w2, int step, int G, int tid, bool drain) {
    unsigned* ctl = (unsigned*)(ws + WS_CTL); volatile unsigned* shq = (volatile unsigned*)(lds_raw + RING_BYTES);
    const int wid = tid >> 6, lane = tid & 63; float* scr = (float*)lds_raw + wid * (128 * 33);
    __syncthreads();
    if (tid == 0 && !drain) __hip_atomic_fetch_add(ctl + CW_DONE + 64 * step, 1u, __ATOMIC_RELAXED, __HIP_MEMORY_SCOPE_AGENT);
    for (;;) {
        if (tid == 0) { unsigned b = BG_BATCHES;
            if (drain || __hip_atomic_load(ctl + CW_DONE + 64 * step, __ATOMIC_RELAXED, __HIP_MEMORY_SCOPE_AGENT) + 16u < (unsigned)G) b = __hip_atomic_fetch_add(ctl + CW_CVTQ, 1u, __ATOMIC_RELAXED, __HIP_MEMORY_SCOPE_AGENT);
            shq[0] = b; }
        __syncthreads();
        const unsigned b = shq[0];
        __syncthreads();
        if (b >= (unsigned)BG_BATCHES) break;
        const int q = (int)b * 8 + wid;
        if (q < NE * BG_IE1) { const int e = q / BG_IE1, r = q % BG_IE1; cvt_item8(w1 + (size_t)e * D * DFFE, D, DFFE, ws + WS_W13 + (size_t)e * 2 * DFFE * D, 1, r, scr, lane, W13_SCALE); }
        else if (q < 2 * NE * BG_IE1) { const int q2 = q - NE * BG_IE1, e = q2 / BG_IE1, r = q2 % BG_IE1; cvt_item8(w3 + (size_t)e * D * DFFE, D, DFFE, ws + WS_W13 + (size_t)e * 2 * DFFE * D, 2, r, scr, lane, W13_SCALE); }
        else { const int q2 = q - 2 * NE * BG_IE1, e = q2 / BG_IE2, r = q2 % BG_IE2; cvt_item8(w2 + (size_t)e * DFFE * D, DFFE, D, ws + WS_W2 + (size_t)e * D * DFFE, 0, r, scr, lane, W2_SCALE); }
    }
}

#define HN ((bf16*)(ws + WS_HN))
#define PROJ ((bf16*)(ws + WS_PROJ))
#define Y ((bf16*)(ws + WS_Y))
#define DS ((float*)(ws + WS_DS))
#define HID ((bf16*)(ws + WS_HID))
#define HIDE ((unsigned char*)(ws + WS_HIDE))
#define OUT2 ((bf16*)(ws + WS_OUT2))
#define XR ((unsigned char*)(ws + WS_XR))
#define SSP0 ((float*)(ws + WS_END))
#define SSP1 ((float*)(ws + WS_END + MiB))
#define SMALLP(T, off) ((T*)(ws + WS_SMALL + (off)))
#define RSTD SMALLP(float, SM_RSTD)
#define TOKE SMALLP(int, SM_TOKE)
#define TOKG SMALLP(float, SM_TOKG)
#define TOKR SMALLP(int, SM_TOKR)
#define BCNT SMALLP(int, SM_BCNT)
#define ROWDST SMALLP(int, SM_ROWDST)
#define ROWG SMALLP(float, SM_ROWG)
#define TILEE SMALLP(int, SM_TILEE)
#define CARA SMALLP(float, SM_CARA)
#define CARH SMALLP(float, SM_CARH)
#define CIN SMALLP(float, SM_CIN)
#define DEC SMALLP(float, SM_DEC)
#define WTA SMALLP(bf16, SM_WTA)
#define WTX SMALLP(bf16, SM_WTX)
#define WTP SMALLP(bf16, SM_WTP)
#define PHASE_ENTER int tid = wid_s * 64 + lane_id_asm(); asm volatile("" : "+v"(tid)); const int lane = tid & 63, wid = tid >> 6; unsigned char* ws = a.ws; asm volatile("" : "+s"(ws)); float* hres = a.out; asm volatile("" : "+s"(hres)); \
    int bid = blockIdx.x; asm volatile("" : "+s"(bid)); int G = gridDim.x; asm volatile("" : "+s"(G)); (void)lane; (void)wid; (void)hres; (void)bid; (void)G;

__global__ void __launch_bounds__(NT) fwd(Args a) {
    extern __shared__ __attribute__((aligned(16))) unsigned char lds_raw[];
    float* ldsf = (float*)lds_raw;
    const int wid_s = __builtin_amdgcn_readfirstlane(threadIdx.x >> 6);
    { const int tid0 = threadIdx.x; for (int u = tid0; u < (LDS_BYTES - RING_BYTES) / 4; u += NT) ((LAS unsigned*)((LAS unsigned char*)lds_raw + RING_BYTES))[u] = 0u; }
    __syncthreads();
    XcdBarrier bar = xcd_barrier_post((unsigned*)(a.ws + WS_CTL) + CW_BAR, (volatile LAS unsigned*)((LAS unsigned char*)lds_raw + MISC_OFF) + 8);

#ifdef REP_STEP
    int rep_left = REP_N;
#endif
    for (int step = a.ph_lo; step < a.ph_hi; ++step) {
#ifdef REP_STEP
    const bool dry = (step == REP_STEP && rep_left > 0);
#else
    constexpr bool dry = false;
#endif
    int phase, L, pass = 0;
    if (step == 0) { phase = PH_PROLOGUE; L = 0; }
    else if (step < 8) { L = 0; const int s = step - 1; phase = s < 5 ? PH_INPROJ + s : s == 5 ? PH_FFNUP : PH_FFNDOWN; }
    else { L = 1; const int s = step - 8; phase = s < 5 ? PH_INPROJ + s : s == 5 ? PH_NORM : s == 6 ? PH_DISPATCH : s == 7 ? PH_MOEUP : s == 8 ? PH_MOEDOWN : PH_FINAL; }
#ifdef REP_NOP
    if (dry) phase = 1000;
#endif
    switch (phase) {
    case PH_PROLOGUE: {
        PHASE_ENTER
        float* scr = ldsf + wid * (128 * 33);
        const int gw = bid * 8 + wid, NGW = G * 8;
        constexpr int I_IN = 16 * 80, I_OUT = 16 * 32, I_G = 16 * 88, I_D = 44 * 32;
        constexpr int T0 = 2 * I_IN, T1 = T0 + 2 * I_OUT, T2 = T1 + I_G, T3 = T2 + I_G, T4 = T3 + I_D;
        for (int it = gw; it < T4; it += NGW) {
            if (it < T0) { const int l = it / I_IN, r = it % I_IN; cvt_item(IN(1) + (size_t)l * D * DIN, D, DIN, (bf16*)(ws + WS_WIN) + (size_t)l * DIN * D, 0, r, scr, lane, l == 1 ? IN(15) + D : nullptr); }
            else if (it < T1) { const int q = it - T0, l = q / I_OUT, r = q % I_OUT; cvt_item(IN(2) + (size_t)l * D * D, D, D, (bf16*)(ws + WS_WOUT) + (size_t)l * D * D, 0, r, scr, lane); }
            else if (it < T2) { cvt_item(IN(17), D, DFF, (bf16*)(ws + WS_WGU), 1, it - T1, scr, lane, IN(16)); }
            else if (it < T3) { cvt_item(IN(18), D, DFF, (bf16*)(ws + WS_WGU), 2, it - T2, scr, lane, IN(16)); }
            else { cvt_item(IN(19), DFF, D, (bf16*)(ws + WS_WD), 0, it - T3, scr, lane); }
        }
        for (int m = gw; m < NTOK; m += NGW) rms_row_bf16(IN(0) + (size_t)m * D, IN(15), HN + (size_t)m * D, lane);
        for (int idx = bid * NT + tid; idx < 3 * 2 * 4 * HD * HD; idx += G * NT) {
            const int mat = idx / (2 * 4 * HD * HD), r = idx % (2 * 4 * HD * HD), lh = r >> 12, j = (r >> 6) & 63, i = r & 63;
            const float* w = mat == 0 ? IN(5) : mat == 1 ? IN(7) : IN(12);
            (mat == 0 ? WTA : mat == 1 ? WTX : WTP)[r] = (bf16)f2bf(w[(lh * 64 + i) * 64 + j]);
        }
    } break;

    case PH_INPROJ: {
        PHASE_ENTER
        pg8::Gemm g{HN, (const bf16*)(ws + WS_WIN) + (size_t)L * DIN * D, NTOK, DIN, D}; pg8::StaticOrder S; S.init(NTOK, DIN, G, bid);
        if (L == 0) { pg8::EpiStoreBf16 E{PROJ, DIN}; pg8::gemm_phase<pg8::EpiStoreBf16, pg8::StaticOrder, true, true>((PG8_LAS unsigned char*)lds_raw, g, S, E, tid); }
        else { pg8::fill_rstd_table((PG8_LAS unsigned char*)lds_raw, S, SSP1, tid); pg8::EpiStoreBf16R E{PROJ, DIN, (const PG8_LAS float*)((PG8_LAS unsigned char*)lds_raw + pg8::RSTD_TAB_OFF)}; pg8::gemm_phase<pg8::EpiStoreBf16R, pg8::StaticOrder, true, true>((PG8_LAS unsigned char*)lds_raw, g, S, E, tid); }
    } break;

    case PH_MIX1: {
        PHASE_ENTER
        const float* conv_w = IN(3) + L * 4 * GW; const float* conv_b = IN(4) + L * GW;
        const float* b_a = IN(6) + L * GW; const float* b_x = IN(8) + L * GW;
        const float* lam = IN(9) + L * GW; const float* lbp = IN(10);
        unsigned char* AX = lds_raw; unsigned char* AINB = lds_raw + 35376; unsigned char* FS = lds_raw + 69168; unsigned char* VTl = lds_raw + 102960; float* TOTl = (float*)(lds_raw + 139824);
        unsigned char* KHTl = lds_raw;
        for (int ci = bid; ci < NCHUNK; ci += G) {
            const int t0 = (ci % CPB) * CH, g0 = ci * CH; const bf16* prow = PROJ + (size_t)g0 * DIN;
            {
                u32x4 rax[5], rf[4], rv[4];
                slab_load<5>(rax, prow - 3 * DIN, 67, t0 == 0 ? 3 : 0, tid); slab_load<4>(rf, prow + 768, 64, 0, tid); slab_load<4>(rv, prow + 1024, 64, 0, tid);
                slab_store<5>(rax, AX, 67, tid); slab_store<4>(rf, FS, 64, tid); vt_store(rv, VTl, tid);
            }
            __syncthreads();
            lru_ainb(AX, conv_w, conv_b, AINB, tid);
            __syncthreads();
#pragma unroll 1
            for (int cc = 0; cc < 2; ++cc) {
                const int h = wid >> 1, nt = 2 * (wid & 1) + cc; float av[4][4], uv[4][4];
                lru_gates(AINB, AX, conv_w, conv_b, WTA + L * 16384, WTX + L * 16384, b_a, b_x, lam, h, nt, lane, av, uv);
                float A = 1.f, H = 0.f;
#pragma unroll
                for (int mt = 0; mt < 4; ++mt) {
                    float At = 1.f, Ht = 0.f;
#pragma unroll
                    for (int r = 0; r < 4; ++r) { Ht = av[mt][r] * Ht + uv[mt][r]; At *= av[mt][r]; }
                    const float A1 = __shfl_down(At, 16), H1 = __shfl_down(Ht, 16); const float At2 = At * A1, Ht2 = A1 * Ht + H1;
                    const float A2 = __shfl_down(At2, 32), H2 = __shfl_down(Ht2, 32); const float Att = At2 * A2, Htt = A2 * Ht2 + H2;
                    H = Att * H + Htt; A *= Att;
                }
                if (lane < 16) { const int c = 64 * h + 16 * nt + lane; CARA[ci * GW + c] = A; CARH[ci * GW + c] = H; }
            }
            {
                const int h = wid >> 1, half = wid & 1, c = 64 * h + lane, fr = lane & 15, fq = lane >> 4;
                const float lb = L == 0 ? 0.f : sigmoidf_(lbp[GW + c] - lbp[c]);
                float gl[32], kk[32]; float run = 0.f;
#pragma unroll
                for (int t = 0; t < 32; ++t) { const float sg = sigmoidf_(bf2f(*(const bf16*)(FS + (32 * half + t) * RS + c * 2))); run += flog(lb + (1.f - lb) * sg); gl[t] = run; kk[t] = (1.f - lb) * (1.f - sg); }
                TOTl[(h * 2 + half) * 64 + lane] = run;
                __syncthreads();
                const float tot0 = TOTl[(h * 2) * 64 + lane], glast = tot0 + TOTl[(h * 2 + 1) * 64 + lane], off = half ? tot0 : 0.f;
#pragma unroll
                for (int j = 0; j < 4; ++j) { float e[8];
#pragma unroll
                    for (int q = 0; q < 8; ++q) e[q] = kk[8 * j + q] * fexp(glast - (off + gl[8 * j + q]));
                    u32x4 w; w.x = pk2(e[0], e[1]); w.y = pk2(e[2], e[3]); w.z = pk2(e[4], e[5]); w.w = pk2(e[6], e[7]);
                    *(u32x4*)(KHTl + c * VTS + (32 * half + 8 * j) * 2) = w; }
                if (half) DEC[(ci * 4 + h) * 64 + lane] = fexp(glast);
                __syncthreads();
#pragma unroll
                for (int vvv = 0; vvv < 2; ++vvv) {
                    const int vt = 2 * half + vvv, vrow = 64 * h + 16 * vt + fr; bf16x8 bv[2];
#pragma unroll
                    for (int ks = 0; ks < 2; ++ks) bv[ks] = *(const bf16x8*)(VTl + vt_off(vrow, 32 * ks + 8 * fq));
#pragma unroll
                    for (int kt = 0; kt < 4; ++kt) { f32x4 acc = (f32x4){0.f, 0.f, 0.f, 0.f};
#pragma unroll
                        for (int ks = 0; ks < 2; ++ks) { const bf16x8 ka = *(const bf16x8*)(KHTl + (64 * h + 16 * kt + fr) * VTS + (32 * ks + 8 * fq) * 2); acc = __builtin_amdgcn_mfma_f32_16x16x32_bf16(ka, bv[ks], acc, 0, 0, 0); }
                        *(f32x4*)(DS + ((size_t)(ci * 4 + h) * 64 + 16 * vt + fr) * 64 + 16 * kt + 4 * fq) = acc; }
                }
                __syncthreads();
            }
        }
    } break;

    case PH_MIX2: {
        PHASE_ENTER
        float* xa = ldsf; float* xs = ldsf + 512;
        for (int item = bid; item < 256 + 2; item += G) {
            if (item < 256) {
                const int el = tid & 127, seg = tid >> 7, e = item * 128 + el, b = e >> 14, hh = (e >> 12) & 3, kv = e & 4095, k = kv & 63;
                float dv[32], dc[32];
#pragma unroll
                for (int i = 0; i < 32; ++i) { const int ci = b * CPB + seg * 32 + i; dv[i] = DS[(size_t)(ci * 4 + hh) * 4096 + kv]; dc[i] = DEC[(ci * 4 + hh) * 64 + k]; }
                float S = 0.f, A = 1.f;
#pragma unroll
                for (int i = 0; i < 32; ++i) { const float d = dv[i]; dv[i] = S; S = dc[i] * S + d; const float a0 = dc[i]; dc[i] = A; A *= a0; }
                xa[seg * 128 + el] = A; xs[seg * 128 + el] = S;
                __syncthreads();
                float Sin = 0.f;
                for (int s2 = 0; s2 < seg; ++s2) Sin = xa[s2 * 128 + el] * Sin + xs[s2 * 128 + el];
#pragma unroll
                for (int i = 0; i < 32; ++i) { const int ci = b * CPB + seg * 32 + i; (dry ? DS + 20 * (MiB / 4) * 4 : DS)[(size_t)(ci * 4 + hh) * 4096 + kv] = dv[i] + dc[i] * Sin; }
                __syncthreads();
            } else {
                if (tid < GW) { const int b = item - 256, c = tid; float hp = 0.f;
                    for (int ch0 = 0; ch0 < CPB; ch0 += 16) { float ca[16], chh[16];
#pragma unroll
                        for (int i = 0; i < 16; ++i) { ca[i] = CARA[(b * CPB + ch0 + i) * GW + c]; chh[i] = CARH[(b * CPB + ch0 + i) * GW + c]; }
#pragma unroll
                        for (int i = 0; i < 16; ++i) { CIN[(b * CPB + ch0 + i) * GW + c] = hp; hp = ca[i] * hp + chh[i]; } } }
            }
        }
    } break;

    case PH_MIX3: {
        PHASE_ENTER
        const float* conv_w = IN(3) + L * 4 * GW; const float* conv_b = IN(4) + L * GW; const float* b_a = IN(6) + L * GW; const float* b_x = IN(8) + L * GW; const float* lam = IN(9) + L * GW;
        const float* lbp = IN(10); const float* norm_g = IN(11) + L * HD; const float* pool_s = IN(13) + L * GW; const float* sconv_w = IN(14) + L * 3 * GW;
        unsigned char* AX = lds_raw; unsigned char* AG = lds_raw + 35376; unsigned char* AINB = lds_raw + 69168;
        unsigned char* QT3 = lds_raw; unsigned char* KT3 = lds_raw + 33792; unsigned char* OG3 = lds_raw + 67584; unsigned char* VT3 = lds_raw + 101376; float* TOT3 = (float*)(lds_raw + 138240);
        unsigned char* PS = lds_raw; unsigned char* DIMG = lds_raw + 41712; unsigned char* YST = lds_raw + 75504;
        unsigned char* SB = lds_raw; unsigned char* SC = lds_raw + 33792; unsigned char* SX = lds_raw + 68640;
        for (int ci = bid; ci < NCHUNK; ci += G) {
            const int t0 = (ci % CPB) * CH, g0 = ci * CH; const bf16* prow = PROJ + (size_t)g0 * DIN; bf16* yrow = Y + (size_t)g0 * D;
            {
                u32x4 rax[5], rag[4];
                slab_load<5>(rax, prow - 3 * DIN, 67, t0 == 0 ? 3 : 0, tid); slab_load<4>(rag, prow + 256, 64, 0, tid);
                slab_store<5>(rax, AX, 67, tid); slab_store<4>(rag, AG, 64, tid);
            }
            __syncthreads();
            lru_ainb(AX, conv_w, conv_b, AINB, tid);
            __syncthreads();
            u32x4 rp[5];
            slab_load<5>(rp, prow - 15 * DIN + 1536, 79, t0 == 0 ? 15 : 0, tid);
#pragma unroll 1
            for (int cc = 0; cc < 2; ++cc) {
                const int h = wid >> 1, nt = 2 * (wid & 1) + cc, fr = lane & 15, fq = lane >> 4, c = 64 * h + 16 * nt + fr; float av[4][4], uv[4][4];
                lru_gates(AINB, AX, conv_w, conv_b, WTA + L * 16384, WTX + L * 16384, b_a, b_x, lam, h, nt, lane, av, uv);
                float hin = CIN[ci * GW + c];
#pragma unroll
                for (int mt = 0; mt < 4; ++mt) {
                    float Ai[4], Hi[4]; float A_ = 1.f, H_ = 0.f;
#pragma unroll
                    for (int r = 0; r < 4; ++r) { H_ = av[mt][r] * H_ + uv[mt][r]; A_ *= av[mt][r]; Ai[r] = A_; Hi[r] = H_; }
                    const float a1 = __shfl_up(A_, 16), h1 = __shfl_up(H_, 16), a2 = __shfl_up(A_, 32), h2 = __shfl_up(H_, 32), a3 = __shfl_up(A_, 48), h3 = __shfl_up(H_, 48);
                    float EA = 1.f, EH = 0.f;
                    if (fq >= 3) { EA = a3; EH = h3; }
                    if (fq >= 2) { EH = a2 * EH + h2; EA *= a2; }
                    if (fq >= 1) { EH = a1 * EH + h1; EA *= a1; }
                    const float hs = EA * hin + EH; float hv[4];
#pragma unroll
                    for (int r = 0; r < 4; ++r) hv[r] = Ai[r] * hs + Hi[r];
                    hin = __shfl(hv[3], 48 + fr);
#pragma unroll
                    for (int r = 0; r < 4; ++r) { bf16* p = (bf16*)(AG + (16 * mt + 4 * fq + r) * RS + c * 2); *p = (bf16)f2bf(hv[r] * gelu_tanh(bf2f(*p))); }
                }
            }
            __syncthreads();
            ytile_store(AG, yrow, tid);
            __syncthreads();
            slab_store<5>(rp, PS, 79, tid);
            __syncthreads();
            u32x4 rsb[4], rsc[5], rsx[5];
            slab_load<4>(rsb, prow + 1792, 64, 0, tid); slab_load<5>(rsc, prow - 2 * DIN + 2048, 66, t0 == 0 ? 2 : 0, tid); slab_load<5>(rsx, prow - 2 * DIN + 2304, 66, t0 == 0 ? 2 : 0, tid);
            for (int idx = tid; idx < CH * 128; idx += NT) {
                const int t = idx >> 7, c = (idx & 127) * 2, gi = c >> 6, w = 2 << gi; const int tt = t0 + t; const int cnt = (tt + 1 < w) ? (tt + 1) : w; float s0 = 0.f, s1 = 0.f;
                for (int r = 0; r < cnt; ++r) { const unsigned x = *(const unsigned*)(PS + (t + 15 - r) * RS + c * 2); s0 += bf2f(x & 0xffffu); s1 += bf2f(x >> 16); }
                const unsigned x0 = *(const unsigned*)(PS + (t + 15) * RS + c * 2); const float inv = __builtin_amdgcn_rcpf((float)cnt);
                *(unsigned*)(DIMG + t * RS + c * 2) = pk2(s0 * inv - bf2f(x0 & 0xffffu), s1 * inv - bf2f(x0 >> 16));
            }
            __syncthreads();
#pragma unroll 1
            for (int cc = 0; cc < 2; ++cc) {
                const int gi = wid >> 1, nt = 2 * (wid & 1) + cc, fr = lane & 15, fq = lane >> 4, c = 64 * gi + 16 * nt + fr; bf16x8 wp[2];
#pragma unroll
                for (int ks = 0; ks < 2; ++ks) wp[ks] = *(const bf16x8*)(WTP + L * 16384 + (size_t)(gi * 64 + 16 * nt + fr) * 64 + 32 * ks + 8 * fq);
                const float psc = pool_s[c];
#pragma unroll
                for (int mt = 0; mt < 4; ++mt) { f32x4 acc = (f32x4){0.f, 0.f, 0.f, 0.f};
#pragma unroll
                    for (int ks = 0; ks < 2; ++ks) { const bf16x8 x = *(const bf16x8*)(DIMG + (16 * mt + fr) * RS + (64 * gi + 32 * ks + 8 * fq) * 2); acc = __builtin_amdgcn_mfma_f32_16x16x32_bf16(x, wp[ks], acc, 0, 0, 0); }
#pragma unroll
                    for (int r = 0; r < 4; ++r) *(bf16*)(YST + (16 * mt + 4 * fq + r) * RS + c * 2) = (bf16)f2bf(acc[r] * psc); }
            }
            __syncthreads();
            ytile_store(YST, yrow + 512, tid);
            __syncthreads();
            slab_store<4>(rsb, SB, 64, tid); slab_store<5>(rsc, SC, 66, tid); slab_store<5>(rsx, SX, 66, tid);
            __syncthreads();
            u32x4 rq[4], rf[4], rv[4], rog[4];
            slab_load<4>(rq, prow + 512, 64, 0, tid); slab_load<4>(rf, prow + 768, 64, 0, tid); slab_load<4>(rv, prow + 1024, 64, 0, tid); slab_load<4>(rog, prow + 1280, 64, 0, tid);
            for (int idx = tid; idx < CH * 128; idx += NT) {
                const int t = idx >> 7, c = (idx & 127) * 2; float a0 = 0.f, a1 = 0.f;
#pragma unroll
                for (int k = 0; k < 3; ++k) { const unsigned xc = *(const unsigned*)(SC + (t + k) * RS + c * 2), xx = *(const unsigned*)(SX + (t + k) * RS + c * 2);
                    a0 += sconv_w[k * GW + c] * bf2f(xc & 0xffffu) * bf2f(xx & 0xffffu); a1 += sconv_w[k * GW + c + 1] * bf2f(xc >> 16) * bf2f(xx >> 16); }
                unsigned* pb = (unsigned*)(SB + t * RS + c * 2); const unsigned b = *pb; *pb = pk2(bf2f(b & 0xffffu) * a0, bf2f(b >> 16) * a1);
            }
            __syncthreads();
            ytile_store(SB, yrow + 768, tid);
            __syncthreads();
            slab_store<4>(rq, QT3, 64, tid); slab_store<4>(rf, KT3, 64, tid); slab_store<4>(rog, OG3, 64, tid); vt_store(rv, VT3, tid);
            __syncthreads();
            {
                const int h = wid >> 1, half = wid & 1, c = 64 * h + lane, fr = lane & 15, fq = lane >> 4;
                const float lb = L == 0 ? 0.f : sigmoidf_(lbp[GW + c] - lbp[c]);
                float gl[32]; float run = 0.f;
#pragma unroll
                for (int t = 0; t < 32; ++t) { const float sg = sigmoidf_(bf2f(*(const bf16*)(KT3 + (32 * half + t) * RS + c * 2))); run += flog(lb + (1.f - lb) * sg); gl[t] = run; }
                TOT3[(h * 2 + half) * 64 + lane] = run;
                __syncthreads();
                const float tot0 = TOT3[(h * 2) * 64 + lane];
                const float off = half ? 0.f : -tot0;
#pragma unroll
                for (int t = 0; t < 32; ++t) {
                    bf16* pq = (bf16*)(QT3 + (32 * half + t) * RS + c * 2); bf16* pk = (bf16*)(KT3 + (32 * half + t) * RS + c * 2);
                    const float sg = sigmoidf_(bf2f(*pk)), kkv = (1.f - lb) * (1.f - sg), qfv = siluf_(bf2f(*pq)), d = gl[t] + off;
                    *pq = (bf16)f2bf(qfv * fexp(d)); *pk = (bf16)f2bf(kkv * fexp(-d));
                }
                __syncthreads();
                bf16x8 sa[4][2];
#pragma unroll
                for (int vt = 0; vt < 4; ++vt)
#pragma unroll
                    for (int ks = 0; ks < 2; ++ks) {
                        const float* p = DS + ((size_t)(ci * 4 + h) * 64 + 16 * vt + fr) * 64 + 32 * ks + 8 * fq; const f32x4 lo = *(const f32x4*)p, hi = *(const f32x4*)(p + 4);
                        const float* eg = TOT3 + (h * 2) * 64 + 32 * ks + 8 * fq;
                        u32x4 w; w.x = pk2(lo.x * fexp(eg[0]), lo.y * fexp(eg[1])); w.y = pk2(lo.z * fexp(eg[2]), lo.w * fexp(eg[3])); w.z = pk2(hi.x * fexp(eg[4]), hi.y * fexp(eg[5])); w.w = pk2(hi.z * fexp(eg[6]), hi.w * fexp(eg[7]));
                        sa[vt][ks] = __builtin_bit_cast(bf16x8, w);
                    }
#pragma unroll
                for (int tsel = 0; tsel < 2; ++tsel) {
                    const int ti = half == 0 ? (tsel ? 3 : 0) : (tsel ? 2 : 1);
                    bf16x8 qb[2];
#pragma unroll
                    for (int ks = 0; ks < 2; ++ks) qb[ks] = *(const bf16x8*)(QT3 + (16 * ti + fr) * RS + (64 * h + 32 * ks + 8 * fq) * 2);
                    f32x4 st[4];
#pragma unroll
                    for (int si = 0; si < 4; ++si) { st[si] = (f32x4){0.f, 0.f, 0.f, 0.f};
                        if (si <= ti) {
#pragma unroll
                            for (int ks = 0; ks < 2; ++ks) { const bf16x8 ka = *(const bf16x8*)(KT3 + (16 * si + fr) * RS + (64 * h + 32 * ks + 8 * fq) * 2); st[si] = __builtin_amdgcn_mfma_f32_16x16x32_bf16(ka, qb[ks], st[si], 0, 0, 0); }
                            if (si == ti) {
#pragma unroll
                                for (int r = 0; r < 4; ++r) if (4 * fq + r > fr) st[si][r] = 0.f; }
                        } }
                    f32x4 oo[4];
#pragma unroll
                    for (int vt = 0; vt < 4; ++vt) { oo[vt] = (f32x4){0.f, 0.f, 0.f, 0.f};
#pragma unroll
                        for (int ks = 0; ks < 2; ++ks) oo[vt] = __builtin_amdgcn_mfma_f32_16x16x32_bf16(sa[vt][ks], qb[ks], oo[vt], 0, 0, 0); }
#pragma unroll
                    for (int p = 0; p < 2; ++p) if (2 * p <= ti) {
                        u32x4 bw; bw.x = pk2(st[2 * p][0], st[2 * p][1]); bw.y = pk2(st[2 * p][2], st[2 * p][3]); bw.z = pk2(st[2 * p + 1][0], st[2 * p + 1][1]); bw.w = pk2(st[2 * p + 1][2], st[2 * p + 1][3]);
                        const bf16x8 bfr = __builtin_bit_cast(bf16x8, bw);
#pragma unroll
                        for (int vt = 0; vt < 4; ++vt) { const int vrow = 64 * h + 16 * vt + fr; const u32x2 lo8 = *(const u32x2*)(VT3 + vt_off(vrow, 32 * p + 4 * fq)), hi8 = *(const u32x2*)(VT3 + vt_off(vrow, 32 * p + 16 + 4 * fq));
                            u32x4 aw; aw.x = lo8.x; aw.y = lo8.y; aw.z = hi8.x; aw.w = hi8.y;
                            oo[vt] = __builtin_amdgcn_mfma_f32_16x16x32_bf16(__builtin_bit_cast(bf16x8, aw), bfr, oo[vt], 0, 0, 0); }
                    }
                    float ss = 0.f;
#pragma unroll
                    for (int vt = 0; vt < 4; ++vt) ss += (oo[vt][0] * oo[vt][0] + oo[vt][1] * oo[vt][1]) + (oo[vt][2] * oo[vt][2] + oo[vt][3] * oo[vt][3]);
                    ss += __shfl_xor(ss, 16); ss += __shfl_xor(ss, 32);
                    const float rs = __builtin_amdgcn_rsqf(ss * (1.0f / HD) + 1e-5f);
#pragma unroll
                    for (int vt = 0; vt < 4; ++vt) { const int cv = 64 * h + 16 * vt + 4 * fq; u32x2* pog = (u32x2*)(OG3 + (16 * ti + fr) * RS + cv * 2); const u32x2 og = *pog; const f32x4 ng = *(const f32x4*)(norm_g + 16 * vt + 4 * fq);
                        u32x2 w; w.x = pk2(oo[vt][0] * rs * ng.x * siluf_(bf2f(og.x & 0xffffu)), oo[vt][1] * rs * ng.y * siluf_(bf2f(og.x >> 16))); w.y = pk2(oo[vt][2] * rs * ng.z * siluf_(bf2f(og.y & 0xffffu)), oo[vt][3] * rs * ng.w * siluf_(bf2f(og.y >> 16)));
                        *pog = w; }
                }
                __syncthreads();
            }
            ytile_store(OG3, yrow + 256, tid);
            __syncthreads();
        }
    } break;

    case PH_OUTPROJ: {
        PHASE_ENTER
        pg8::Gemm g{Y, (const bf16*)(ws + WS_WOUT) + (size_t)L * D * D, NTOK, D, D}; pg8::StaticOrder S; S.init(NTOK, D, G, bid);
        if (L == 0) { pg8::EpiResidStats E{IN(0), hres, HN, SSP0}; pg8::gemm_phase<pg8::EpiResidStats, pg8::StaticOrder, true, true>((PG8_LAS unsigned char*)lds_raw, g, S, E, tid); }
        else { pg8::EpiResidF32 E{hres, hres}; pg8::gemm_phase<pg8::EpiResidF32, pg8::StaticOrder, true, true>((PG8_LAS unsigned char*)lds_raw, g, S, E, tid); }
    } break;

    case PH_NORM: {
        PHASE_ENTER
        const float* g = pass == 0 ? IN(16) + L * D : IN(15) + D;
        const bool route = (L == 1 && pass == 0);
        int* sel = (int*)lds_raw;
        for (int blk = bid; blk < NTOK / 64; blk += G) {
            if (!route) {
                for (int r8 = 0; r8 < 8; ++r8) { const int m = blk * 64 + wid * 8 + r8; rms_row_bf16(hres + (size_t)m * D, g, HN + (size_t)m * D, lane); }
            } else {
                float wr[16][8];
                { const float* wr_ = IN(20);
#pragma unroll
                  for (int j = 0; j < 4; ++j)
#pragma unroll
                    for (int q = 0; q < 4; ++q) { const f32x4 w0 = *(const f32x4*)(wr_ + (size_t)(4 * (lane + 64 * j) + q) * 8), w1 = *(const f32x4*)(wr_ + (size_t)(4 * (lane + 64 * j) + q) * 8 + 4);
                        wr[j * 4 + q][0] = w0.x; wr[j * 4 + q][1] = w0.y; wr[j * 4 + q][2] = w0.z; wr[j * 4 + q][3] = w0.w; wr[j * 4 + q][4] = w1.x; wr[j * 4 + q][5] = w1.y; wr[j * 4 + q][6] = w1.z; wr[j * 4 + q][7] = w1.w; } }
                f32x4 gv[4];
#pragma unroll
                for (int j = 0; j < 4; ++j) gv[j] = ((const f32x4*)g)[lane + 64 * j];
#pragma unroll 1
                for (int r8 = 0; r8 < 8; ++r8) {
                    const int tl = wid * 8 + r8, m = blk * 64 + tl; const f32x4* xr = (const f32x4*)(hres + (size_t)m * D);
                    f32x4 v[4]; float s = 0.f;
#pragma unroll
                    for (int j = 0; j < 4; ++j) { v[j] = xr[lane + 64 * j]; s += (v[j].x * v[j].x + v[j].y * v[j].y) + (v[j].z * v[j].z + v[j].w * v[j].w); }
                    const float r = 1.0f / sqrtf(wave_sum(s) * (1.0f / D) + 1e-6f);
                    float lg[8] = {0.f, 0.f, 0.f, 0.f, 0.f, 0.f, 0.f, 0.f};
#pragma unroll
                    for (int j = 0; j < 4; ++j) { const float y[4] = {v[j].x * r * gv[j].x, v[j].y * r * gv[j].y, v[j].z * r * gv[j].z, v[j].w * r * gv[j].w};
#pragma unroll
                        for (int q = 0; q < 4; ++q)
#pragma unroll
                            for (int e = 0; e < 8; ++e) lg[e] += y[q] * wr[j * 4 + q][e]; }
#pragma unroll
                    for (int e = 0; e < 8; ++e) lg[e] = wave_sum(lg[e]);
                    if (lane == 0) {
                        int e1 = 0; float l1 = lg[0];
#pragma unroll
                        for (int e = 1; e < 8; ++e) if (lg[e] > l1) { l1 = lg[e]; e1 = e; }
                        int e2 = -1; float l2 = -3.0e38f;
#pragma unroll
                        for (int e = 0; e < 8; ++e) if (e != e1 && lg[e] > l2) { l2 = lg[e]; e2 = e; }
                        const float g1 = 1.0f / (1.0f + fexp(l2 - l1));
                        TOKE[m * 2] = e1; TOKE[m * 2 + 1] = e2; TOKG[m * 2] = g1; TOKG[m * 2 + 1] = 1.0f - g1;
                        sel[tl * 2] = e1; sel[tl * 2 + 1] = e2; RSTD[m] = r;
                    }
                }
                __syncthreads();
                if (tid < NE) { int cnt = 0; for (int q = 0; q < 128; ++q) if (sel[q] == tid) { TOKR[blk * 128 + q] = cnt; ++cnt; } BCNT[blk * NE + tid] = cnt; }
                __syncthreads();
            }
        }
    } break;

    case PH_FFNUP: {
        PHASE_ENTER
        pg8::Gemm g{HN, (const bf16*)(ws + WS_WGU), NTOK, 2 * DFF, D}; pg8::StaticOrder S; S.init(NTOK, 2 * DFF, G, bid);
        pg8::fill_rstd_table((PG8_LAS unsigned char*)lds_raw, S, SSP0, tid);
        pg8::EpiSwigluR E{HID, DFF, (const PG8_LAS float*)((PG8_LAS unsigned char*)lds_raw + pg8::RSTD_TAB_OFF)};
        pg8::gemm_phase<pg8::EpiSwigluR, pg8::StaticOrder, true, true>((PG8_LAS unsigned char*)lds_raw, g, S, E, tid);
    } break;

    case PH_FFNDOWN: {
        PHASE_ENTER
        pg8::Gemm g{HID, (const bf16*)(ws + WS_WD), NTOK, D, DFF}; pg8::StaticOrder S; S.init(NTOK, D, G, bid);
        pg8::EpiResidStats E{hres, dry ? (float*)(ws + 340 * MiB) : hres, HN, SSP1};
        pg8::gemm_phase<pg8::EpiResidStats, pg8::StaticOrder, true, true>((PG8_LAS unsigned char*)lds_raw, g, S, E, tid);
    } break;

    case PH_DISPATCH: {
        PHASE_ENTER
        int* sh = (int*)lds_raw;
        const f32x4* gr = (const f32x4*)(IN(16) + D);
        for (int blk = bid; blk < NTOK / 64; blk += G) {
            { int* cnts = sh + 64;
              for (int i = tid; i < (NTOK / 64) * NE; i += NT) cnts[i] = BCNT[i];
              __syncthreads();
              { const int e = wid; int sall = 0, slt = 0;
#pragma unroll
                for (int i = 0; i < 4; ++i) { const int b2 = 4 * lane + i, c = cnts[b2 * NE + e]; sall += c; slt += (b2 < blk) ? c : 0; }
#pragma unroll
                for (int o = 1; o < 64; o <<= 1) { sall += __shfl_xor(sall, o); slt += __shfl_xor(slt, o); }
                if (lane == 0) { sh[e] = sall; sh[16 + e] = slt; sh[24 + e] = (sall + 255) >> 8; } } }
            __syncthreads();
            if (tid == 0) { int acc = 0; for (int e = 0; e < NE; ++e) { sh[8 + e] = acc * 256; acc += sh[24 + e]; } sh[32] = acc; }
            __syncthreads();
            if (tid < 128) { const int m = blk * 64 + (tid >> 1); const int e = TOKE[blk * 128 + tid]; const int r = sh[8 + e] + sh[16 + e] + TOKR[blk * 128 + tid];
                ROWDST[r] = m * 2 + (tid & 1); ROWG[r] = TOKG[blk * 128 + tid]; }
            for (int r8 = 0; r8 < 8; ++r8) {
                const int m = blk * 64 + wid * 8 + r8; const int e0 = TOKE[m * 2], e1 = TOKE[m * 2 + 1];
                const int r0 = sh[8 + e0] + sh[16 + e0] + TOKR[m * 2], r1 = sh[8 + e1] + sh[16 + e1] + TOKR[m * 2 + 1];
                const float rs = RSTD[m]; const f32x4* xr = (const f32x4*)(hres + (size_t)m * D);
                unsigned* o0 = (unsigned*)(XR + (size_t)r0 * D); unsigned* o1 = (unsigned*)(XR + (size_t)r1 * D);
#pragma unroll
                for (int j = 0; j < 4; ++j) { const f32x4 v = xr[lane + 64 * j], gv = gr[lane + 64 * j]; const unsigned w = pg8::pk4_fp8(v.x * rs * gv.x, v.y * rs * gv.y, v.z * rs * gv.z, v.w * rs * gv.w); o0[lane + 64 * j] = w; o1[lane + 64 * j] = w; }
            }
            if (blk == 0) {
                for (int e = 0; e < NE; ++e) { const int lo = sh[8 + e] + sh[e], hi = sh[8 + e] + sh[24 + e] * 256; for (int r = lo + tid; r < hi; r += NT) { ROWDST[r] = -1; ROWG[r] = 0.f; } }
                if (tid < MAXTILES) { int e = 0; for (int q = 0; q < NE; ++q) if (tid * 256 >= sh[8 + q]) e = q; TILEE[tid] = e; }
                if (tid == 0) TILEE[MAXTILES] = sh[32];
            }
            __syncthreads();
        }
    } break;

    case PH_MOEUP: {
        PHASE_ENTER
        const int ntiles = __builtin_amdgcn_readfirstlane(__hip_atomic_load(TILEE + MAXTILES, __ATOMIC_RELAXED, __HIP_MEMORY_SCOPE_AGENT));
        pg8::Gemm g{(const bf16*)XR, (const bf16*)(ws + WS_W13), 0, 0, D / 2}; pg8::MoeOrder S; S.init(ntiles, DFFE / 128, G, bid, 0, 0, TILEE);
        pg8::EpiSwiglu8 E{HIDE, DFFE, 1.0f / W13_SCALE, HID_SCALE};
        pg8::gemm_phase<pg8::EpiSwiglu8, pg8::MoeOrder, true, true, true>((PG8_LAS unsigned char*)lds_raw, g, S, E, tid);
    } break;

    case PH_MOEDOWN: {
        PHASE_ENTER
        const int ntiles = __builtin_amdgcn_readfirstlane(__hip_atomic_load(TILEE + MAXTILES, __ATOMIC_RELAXED, __HIP_MEMORY_SCOPE_AGENT));
        pg8::Gemm g{(const bf16*)HIDE, (const bf16*)(ws + WS_W2), 0, 0, DFFE / 2}; pg8::MoeOrder S; S.init(ntiles, D / 256, G, bid, 0, 0, TILEE);
        pg8::EpiMoeDown E{OUT2, ROWDST, ROWG, 1.0f / (W2_SCALE * HID_SCALE)};
        pg8::gemm_phase<pg8::EpiMoeDown, pg8::MoeOrder, true, true, true>((PG8_LAS unsigned char*)lds_raw, g, S, E, tid);
    } break;

    case PH_FINAL: {
        PHASE_ENTER
        const float* g = IN(24); const int gw = bid * 8 + wid, NGW = G * 8;
        for (int m = gw; m < NTOK; m += NGW) {
            f32x4* xr = (f32x4*)(hres + (size_t)m * D); const f32x4* gr = (const f32x4*)g;
            const u32x2* o0 = (const u32x2*)(OUT2 + (size_t)(2 * m) * D); const u32x2* o1 = (const u32x2*)(OUT2 + (size_t)(2 * m + 1) * D);
            f32x4 v[4]; float s = 0.f;
#pragma unroll
            for (int j = 0; j < 4; ++j) {
                v[j] = xr[lane + 64 * j]; const u32x2 p = o0[lane + 64 * j], q = o1[lane + 64 * j];
                v[j].x += bf2f(p.x & 0xffffu) + bf2f(q.x & 0xffffu); v[j].y += bf2f(p.x >> 16) + bf2f(q.x >> 16);
                v[j].z += bf2f(p.y & 0xffffu) + bf2f(q.y & 0xffffu); v[j].w += bf2f(p.y >> 16) + bf2f(q.y >> 16);
                s += (v[j].x * v[j].x + v[j].y * v[j].y) + (v[j].z * v[j].z + v[j].w * v[j].w);
            }
            const float r = 1.0f / sqrtf(wave_sum(s) * (1.0f / D) + 1e-6f);
#pragma unroll
            for (int j = 0; j < 4; ++j) { const f32x4 gv = gr[lane + 64 * j]; (dry ? (f32x4*)((float*)(ws + 340 * MiB) + (size_t)m * D) : xr)[lane + 64 * j] = (f32x4){v[j].x * r * gv.x, v[j].y * r * gv.y, v[j].z * r * gv.z, v[j].w * r * gv.w}; }
        }
    } break;
    }
    if (phase == PH_INPROJ || phase == PH_FFNUP || phase == PH_DISPATCH) {
        int t_ = wid_s * 64 + lane_id_asm(); asm volatile("" : "+v"(t_));
        unsigned char* ws_ = a.ws; asm volatile("" : "+s"(ws_)); int G_ = gridDim.x; asm volatile("" : "+s"(G_));
        bg_convert(ws_, lds_raw, IN(21), IN(22), IN(23), step, G_, t_, phase == PH_DISPATCH);
    }
    if (step + 1 < a.ph_hi) { int t_ = wid_s * 64 + lane_id_asm(); asm volatile("" : "+v"(t_)); xcd_barrier(bar, t_ == 0); }
#ifdef REP_STEP
    if (dry) { --rep_left; --step; }
#endif
    }
}

constexpr int NSTEPS = 18;
#ifndef MK_PER_PHASE
#define MK_PER_PHASE 0
#endif

extern "C" void kernel_launch(void* const* d_in, const int* in_sizes, int n_in, void* d_out, int out_size, void* d_ws, size_t ws_size, hipStream_t stream) {
    static int grid = 0;
    if (grid == 0) {
        if (n_in != 25 || out_size != NTOK * D || ws_size < WS_END + 2 * MiB) { fprintf(stderr, "kernel_launch: unexpected shapes (n_in %d out %d ws %zu need %zu)\n", n_in, out_size, ws_size, (size_t)WS_END); grid = -1; return; }
        int dev = 0, cus = 0, per_cu = 0;
        if (hipGetDevice(&dev) != hipSuccess || hipDeviceGetAttribute(&cus, hipDeviceAttributeMultiprocessorCount, dev) != hipSuccess) { grid = -1; return; }
        if (hipFuncSetAttribute((const void*)fwd, hipFuncAttributeMaxDynamicSharedMemorySize, LDS_BYTES) != hipSuccess) { fprintf(stderr, "kernel_launch: hipFuncSetAttribute failed\n"); grid = -1; return; }
        if (hipOccupancyMaxActiveBlocksPerMultiprocessor(&per_cu, (const void*)fwd, NT, LDS_BYTES) != hipSuccess || per_cu < 1) { fprintf(stderr, "kernel_launch: occupancy query says %d blocks/CU\n", per_cu); (void)hipGetLastError(); grid = -1; return; }
        grid = cus;
    }
    if (grid < 0) return;
    hipMemsetAsync((char*)d_ws + WS_CTL, 0, 1 * MiB, stream);
    Args a{};
    for (int i = 0; i < 25; ++i) a.in[i] = (const float*)d_in[i];
    a.out = (float*)d_out; a.ws = (unsigned char*)d_ws;
#if MK_PER_PHASE
    for (int s = 0; s < NSTEPS; ++s) { a.ph_lo = s; a.ph_hi = s + 1; hipLaunchKernelGGL(fwd, dim3(grid), dim3(NT), LDS_BYTES, stream, a); }
#else
    a.ph_lo = 0; a.ph_hi = NSTEPS;
    hipLaunchKernelGGL(fwd, dim3(grid), dim3(NT), LDS_BYTES, stream, a);
#endif
}
```

```cpp
#include <hip/hip_runtime.h>
#include <cstdint>
#include <cstdio>

typedef unsigned short bf16;
typedef short bf16x8 __attribute__((ext_vector_type(8)));
typedef float f32x4 __attribute__((ext_vector_type(4)));
typedef unsigned u32x4 __attribute__((ext_vector_type(4)));
typedef unsigned u32x2 __attribute__((ext_vector_type(2)));

constexpr int NTOK = 16384, SEQ = 8192, D = 1024, DIN = 2560, GW = 256, HD = 64, DFF = 2816, DFFE = 3584, NE = 8;
constexpr int CH = 64, NCHUNK = NTOK / CH, CPB = SEQ / CH;
constexpr int NT = 512;
constexpr float W13_SCALE = 64.f, W2_SCALE = 128.f, HID_SCALE = 8.f;
constexpr int MAXTILES = NTOK * 2 / 256 + NE;

constexpr size_t MiB = 1u << 20;
constexpr size_t WS_CTL = 0;
constexpr size_t WS_SMALL = 1 * MiB;
constexpr size_t WS_WIN = 5 * MiB;
constexpr size_t WS_WOUT = 15 * MiB;
constexpr size_t WS_WGU = 19 * MiB;
constexpr size_t WS_WD = 30 * MiB;
constexpr size_t WS_W13 = 36 * MiB;
constexpr size_t WS_W2 = 92 * MiB;
constexpr size_t WS_ACT = 120 * MiB;
constexpr size_t WS_HN = WS_ACT;
constexpr size_t WS_PROJ = WS_ACT + 32 * MiB;
constexpr size_t WS_Y = WS_ACT + 112 * MiB;
constexpr size_t WS_DS = WS_ACT + 144 * MiB;
constexpr size_t WS_HID = WS_PROJ;
constexpr size_t WS_XR = WS_ACT;
constexpr size_t WS_HIDE = WS_ACT + 34 * MiB;
constexpr size_t WS_OUT2 = WS_ACT + 153 * MiB;
constexpr size_t WS_END = WS_ACT + 217 * MiB;
constexpr size_t SM_TOKE = 0;
constexpr size_t SM_TOKG = 128 * 1024;
constexpr size_t SM_TOKR = 256 * 1024;
constexpr size_t SM_BCNT = 384 * 1024;
constexpr size_t SM_ROWTOK = 400 * 1024;
constexpr size_t SM_ROWDST = 544 * 1024;
constexpr size_t SM_ROWG = 688 * 1024;
constexpr size_t SM_TILEE = 832 * 1024;
constexpr size_t SM_CARA = 1024 * 1024;
constexpr size_t SM_CARH = 1280 * 1024;
constexpr size_t SM_CIN = 1536 * 1024;
constexpr size_t SM_DEC = 1792 * 1024;
constexpr size_t SM_RSTD = 2048 * 1024;
constexpr size_t SM_WTA = 2304 * 1024;
constexpr size_t SM_WTX = 2368 * 1024;
constexpr size_t SM_WTP = 2432 * 1024;

struct Args {
    const float* in[25];
    float* out;
    unsigned char* ws;
    int ph_lo, ph_hi, pad0, pad1;
};

__device__ __forceinline__ int lane_id_asm() { int l; asm volatile("v_mbcnt_lo_u32_b32 %0, -1, 0\n\tv_mbcnt_hi_u32_b32 %0, -1, %0" : "=v"(l)); return l; }
typedef const float __attribute__((address_space(1)))* gfptr_t;
__device__ __forceinline__ const float* IN(int k) { asm volatile("" : "+s"(k)); const gfptr_t p = ((const gfptr_t __attribute__((address_space(4)))*)__builtin_amdgcn_kernarg_segment_ptr())[k]; return (const float*)p; }
__device__ __forceinline__ float bf2f(unsigned v) { return __uint_as_float(v << 16); }
__device__ __forceinline__ unsigned f2bf(float f) { unsigned u = __float_as_uint(f); return (u + 0x7fffu + ((u >> 16) & 1u)) >> 16; }
__device__ __forceinline__ unsigned pk2(float lo, float hi) { return f2bf(lo) | (f2bf(hi) << 16); }
__device__ __forceinline__ float fexp(float x) { return __builtin_amdgcn_exp2f(1.44269504089f * x); }
__device__ __forceinline__ float flog(float x) { return 0.69314718056f * __builtin_amdgcn_logf(x); }
__device__ __forceinline__ float sigmoidf_(float x) { return __builtin_amdgcn_rcpf(1.0f + __builtin_amdgcn_exp2f(-1.44269504089f * x)); }
__device__ __forceinline__ float siluf_(float x) { return x * sigmoidf_(x); }
__device__ __forceinline__ float gelu_tanh(float x) { const float u = 1.5957691216057308f * (x + 0.044715f * x * x * x); return x * sigmoidf_(u); }
__device__ __forceinline__ float neg_expm1_small(float x) { return -x * (1.0f + x * (0.5f + x * (0.16666667f + x * (0.041666668f + x * 0.0083333338f)))); }
__device__ __forceinline__ float wave_sum(float v) {
#pragma unroll
    for (int o = 1; o < 64; o <<= 1) v += __shfl_xor(v, o);
    return v;
}
#define LDS_WAIT() asm volatile("s_waitcnt lgkmcnt(0)" ::: "memory")

namespace pg8 {
#define PG8_LAS __attribute__((address_space(3)))
typedef unsigned short bf16_t;
typedef short bf16x8 __attribute__((ext_vector_type(8)));
typedef float f32x4 __attribute__((ext_vector_type(4)));
typedef unsigned u32x4 __attribute__((ext_vector_type(4)));
constexpr int BM = 256, BK = 64, HALF = 128, HTB = HALF * BK * 2  , STAGE_BYTES = 8 * HTB, NXCD = 8, WGM = 8;

__host__ __device__ __forceinline__ int lds_byte(int r, int c) { const int st = (r >> 4) * 2 + (c >> 5), rr = r & 15, cc = c & 31, ob = rr * 64 + cc * 2; return st * 1024 + (ob ^ (((ob >> 9) & 1) << 5)); }
__host__ __device__ __forceinline__ void stage_rc(int b, int& R, int& C) { const int st = b / 1024, sb = b % 1024, swz = sb ^ (((sb >> 9) & 1) << 5); R = (st >> 1) * 16 + swz / 64; C = (st & 1) * 32 + (swz % 64) / 2; }
__host__ __device__ __forceinline__ int perm32(int rho) { const int n = rho >> 4, i = rho & 15; return 8 * (i >> 2) + 4 * n + (i & 3); }

struct Unit { int pm, pn, pa, pb, ord; };
struct Gemm { const bf16_t* A; const bf16_t* Bt; int M, N, K; };

struct StaticOrder {
    int nM, nN, nwg, G, c;
    __host__ __device__ void init(int M, int N, int G_, int c_) { nM = M / BM; nN = N / BM; nwg = nM * nN; G = G_; c = c_; }
    __host__ __device__ bool next(int i, Unit& u) const {
        const long L = (long)i * G + c; if (L >= nwg) return false;
        int wgid = (int)L; { const int q = nwg / NXCD, r = nwg % NXCD, xcd = wgid % NXCD, off = wgid / NXCD; wgid = (xcd < r ? xcd * (q + 1) : r * (q + 1) + (xcd - r) * q) + off; }
        const int nig = WGM * nN, gid = wgid / nig, fm = gid * WGM, gsz = (nM - fm) < WGM ? (nM - fm) : WGM;
        u.pm = fm + ((wgid % nig) % gsz); u.pn = (wgid % nig) / gsz; u.pa = u.pm; u.pb = u.pn; u.ord = i; return true;
    }
    __device__ __forceinline__ void a_ready(const Unit&) const {}
    __device__ __forceinline__ void done(const Unit&) const {}
};

__device__ __forceinline__ unsigned cvt_pk_bf16(float lo, float hi) { unsigned r; asm volatile("v_cvt_pk_bf16_f32 %0, %1, %2" : "=v"(r) : "v"(lo), "v"(hi)); return r; }
typedef float f32x2 __attribute__((ext_vector_type(2)));
typedef int pg8_v8i __attribute__((ext_vector_type(8))); typedef int pg8_v4i __attribute__((ext_vector_type(4)));
__device__ __forceinline__ pg8_v8i pg8_cat(bf16x8 lo, bf16x8 hi) { return __builtin_shufflevector(__builtin_bit_cast(pg8_v4i, lo), __builtin_bit_cast(pg8_v4i, hi), 0, 1, 2, 3, 4, 5, 6, 7); }
__device__ __forceinline__ void pg8_mfma8(f32x4& acc, pg8_v8i a, pg8_v8i b, int sc) { asm volatile("v_mfma_scale_f32_16x16x128_f8f6f4 %0, %1, %2, %0, %3, %3 op_sel_hi:[0,0,0]" : "+v"(acc) : "v"(a), "v"(b), "v"(sc)); }
template <class Epi, class Sched, bool ALIGN_EPI = false, bool SP2 = false, bool F8 = false>
__device__ __forceinline__ void gemm_phase(PG8_LAS unsigned char* lds, const Gemm g, const Sched& S, const Epi& E, int tid_in) {
    int tid = tid_in; asm volatile("" : "+v"(tid));
    const int wid = __builtin_amdgcn_readfirstlane(tid >> 6), lane = tid & 63, wr = wid >> 2, wc = wid & 3, fr = lane & 15, fq = lane >> 4;
    const int K = g.K, nt = K / BK;
    unsigned voffA[2], voffB[2];
#pragma unroll
    for (int i = 0; i < 2; ++i) { int R, C; stage_rc(tid * 16 + i * 8192, R, C); const int Rb = Epi::PERM ? ((R & ~31) + perm32(R & 31)) : R;
        voffA[i] = (unsigned)(R * K + C) * 2u; voffB[i] = (unsigned)(Rb * K + C) * 2u; }
    const size_t kstep = (size_t)(BK * 2);
    const size_t hstep = (size_t)HALF * K * 2;
    const size_t tstep = 2 * hstep;
    const unsigned ldsw = (unsigned)wid * 1024u;
    int f8one = 0x7f7f7f7f; asm volatile("" : "+v"(f8one));
    constexpr int KOFF = 1024;
    const int aoff = lds_byte(wr * 64 + fr, fq * 8), boff = lds_byte(wc * 32 + fr, fq * 8);
#define PG8_SA(b, h) (((b) * 2 + (h)) * HTB)
#define PG8_SB(b, h) ((4 + (b) * 2 + (h)) * HTB)
#define PG8_STAGE(bufoff, gbase, voff) do { _Pragma("unroll") for (int _i = 0; _i < 2; ++_i) \
        __builtin_amdgcn_global_load_lds((const unsigned*)((const char*)(gbase) + (voff)[_i]), (PG8_LAS unsigned*)(lds + (bufoff) + ldsw + _i * 8192), 16, 0, 0); } while (0)
#define PG8_LDA(dst, b, h) do { _Pragma("unroll") for (int m = 0; m < 4; ++m) _Pragma("unroll") for (int k = 0; k < 2; ++k) dst[m][k] = *(const PG8_LAS bf16x8*)(lds + PG8_SA(b, h) + aoff + m * 2048 + k * KOFF); } while (0)
#define PG8_LDB(dst, b, h) do { _Pragma("unroll") for (int n = 0; n < 2; ++n) _Pragma("unroll") for (int k = 0; k < 2; ++k) dst[n][k] = *(const PG8_LAS bf16x8*)(lds + PG8_SB(b, h) + boff + n * 2048 + k * KOFF); } while (0)
#define PG8_MMA(ai, bj, At, Bt) do { __builtin_amdgcn_s_setprio(1); if constexpr (F8) { _Pragma("unroll") for (int m = 0; m < 4; ++m) _Pragma("unroll") for (int n = 0; n < 2; ++n) \
        pg8_mfma8(acc[ai][bj][m][n], pg8_cat(Bt[n][0], Bt[n][1]), pg8_cat(At[m][0], At[m][1]), f8one); } \
    else { _Pragma("unroll") for (int m = 0; m < 4; ++m) _Pragma("unroll") for (int n = 0; n < 2; ++n) _Pragma("unroll") for (int k = 0; k < 2; ++k) \
        acc[ai][bj][m][n] = __builtin_amdgcn_mfma_f32_16x16x32_bf16(Bt[n][k], At[m][k], acc[ai][bj][m][n], 0, 0, 0); } __builtin_amdgcn_s_setprio(0); } while (0)
#define PG8_WAIT_V(n) asm volatile("s_waitcnt vmcnt(" #n ")" ::: "memory")
#define PG8_WAIT_L(n) asm volatile("s_waitcnt lgkmcnt(" #n ")" ::: "memory")
#define PG8_BAR __builtin_amdgcn_s_barrier()
#define PG8_SCHED __builtin_amdgcn_sched_barrier(0)
    Unit cur, nxt; int ui = 0;
    if (!S.next(0, cur)) return;
    f32x4 acc[2][2][4][2];
    if constexpr (Epi::ACC_INIT) E.init(acc, cur, wr, wc, fr, fq);
    else {
#pragma unroll
    for (int a = 0; a < 2; ++a)
#pragma unroll
        for (int b = 0; b < 2; ++b)
#pragma unroll
            for (int m = 0; m < 4; ++m)
#pragma unroll
                for (int n = 0; n < 2; ++n) acc[a][b][m][n] = (f32x4){0.f, 0.f, 0.f, 0.f};
    }
    bf16x8 At[4][2], B0[2][2], B1[2][2];
    const char* cA = (const char*)g.A + (size_t)cur.pa * tstep; const char* cB = (const char*)g.Bt + (size_t)cur.pb * tstep;
    S.a_ready(cur);
    if constexpr (SP2) {
        PG8_STAGE(PG8_SB(0, 0), cB, voffB); PG8_STAGE(PG8_SB(0, 1), cB + hstep, voffB); PG8_STAGE(PG8_SA(0, 0), cA, voffA); PG8_STAGE(PG8_SA(0, 1), cA + hstep, voffA);
        if (wr == 1) PG8_BAR;
        PG8_WAIT_V(2); PG8_BAR;
        PG8_STAGE(PG8_SB(1, 0), cB + kstep, voffB); PG8_STAGE(PG8_SA(1, 0), cA + kstep, voffA); PG8_STAGE(PG8_SB(1, 1), cB + hstep + kstep, voffB);
        PG8_WAIT_V(6); PG8_BAR;
    } else {
        PG8_STAGE(PG8_SB(0, 0), cB, voffB); PG8_STAGE(PG8_SA(0, 0), cA, voffA); PG8_STAGE(PG8_SB(0, 1), cB + hstep, voffB); PG8_STAGE(PG8_SA(0, 1), cA + hstep, voffA);
        if (wr == 1) PG8_BAR;
        PG8_WAIT_V(4); PG8_BAR;
        PG8_STAGE(PG8_SB(1, 0), cB + kstep, voffB); PG8_STAGE(PG8_SA(1, 0), cA + kstep, voffA); PG8_STAGE(PG8_SB(1, 1), cB + hstep + kstep, voffB);
        PG8_WAIT_V(6); PG8_BAR;
    }
    for (;;) {
        const bool has_next = S.next(ui + 1, nxt);
        const char* nA = has_next ? (const char*)g.A + (size_t)nxt.pa * tstep : cA; const char* nB = has_next ? (const char*)g.Bt + (size_t)nxt.pb * tstep : cB;
        for (int t = 0; t < nt; t += 2) {
            const bool last = (t == nt - 2);
            const char* a1 = cA + (size_t)(t + 1) * kstep;
            const char* a2 = last ? nA : cA + (size_t)(t + 2) * kstep; const char* b2 = last ? nB : cB + (size_t)(t + 2) * kstep;
            const char* a3 = a2 + kstep; const char* b3 = b2 + kstep;
            if (last && has_next) S.a_ready(nxt);
            if constexpr (SP2) {
            PG8_LDB(B0, 0, 0); PG8_LDB(B1, 0, 1); PG8_SCHED; PG8_LDA(At, 0, 0); PG8_STAGE(PG8_SA(1, 1), a1 + hstep, voffA);
            PG8_WAIT_V(8); PG8_WAIT_L(0); PG8_BAR; PG8_MMA(0, 0, At, B0); PG8_MMA(0, 1, At, B1); PG8_BAR; PG8_SCHED;
            PG8_LDA(At, 0, 1); PG8_STAGE(PG8_SB(0, 0), b2, voffB); PG8_STAGE(PG8_SB(0, 1), b2 + hstep, voffB); PG8_STAGE(PG8_SA(0, 0), a2, voffA);
            PG8_WAIT_V(8); PG8_WAIT_L(0); PG8_BAR; PG8_MMA(1, 0, At, B0); PG8_MMA(1, 1, At, B1); PG8_BAR; PG8_SCHED;
            PG8_LDB(B0, 1, 0); PG8_LDB(B1, 1, 1); PG8_SCHED; PG8_LDA(At, 1, 0); PG8_STAGE(PG8_SA(0, 1), a2 + hstep, voffA);
            PG8_WAIT_V(8); PG8_WAIT_L(0); PG8_BAR; PG8_MMA(0, 0, At, B0); PG8_MMA(0, 1, At, B1); PG8_BAR; PG8_SCHED;
            PG8_LDA(At, 1, 1); PG8_STAGE(PG8_SB(1, 0), b3, voffB); PG8_STAGE(PG8_SB(1, 1), b3 + hstep, voffB); PG8_STAGE(PG8_SA(1, 0), a3, voffA);
            PG8_WAIT_V(8); PG8_WAIT_L(0); PG8_BAR; PG8_MMA(1, 0, At, B0); PG8_MMA(1, 1, At, B1); PG8_BAR; PG8_SCHED;
            } else {
            PG8_LDB(B0, 0, 0); PG8_SCHED; PG8_LDA(At, 0, 0); PG8_STAGE(PG8_SA(1, 1), a1 + hstep, voffA);
            PG8_WAIT_L(8); PG8_BAR; PG8_WAIT_L(0); PG8_MMA(0, 0, At, B0); PG8_BAR; PG8_SCHED;
            PG8_LDB(B1, 0, 1); PG8_STAGE(PG8_SB(0, 0), b2, voffB);
            PG8_BAR; PG8_WAIT_L(0); PG8_MMA(0, 1, At, B1); PG8_BAR;
            PG8_LDA(At, 0, 1); PG8_STAGE(PG8_SA(0, 0), a2, voffA);
            PG8_BAR; PG8_WAIT_L(0); PG8_MMA(1, 0, At, B0); PG8_BAR; PG8_SCHED;
            PG8_STAGE(PG8_SB(0, 1), b2 + hstep, voffB);
            PG8_WAIT_V(6); PG8_BAR; PG8_MMA(1, 1, At, B1); PG8_BAR;
            PG8_LDB(B0, 1, 0); PG8_SCHED; PG8_LDA(At, 1, 0); PG8_STAGE(PG8_SA(0, 1), a2 + hstep, voffA);
            PG8_WAIT_L(8); PG8_BAR; PG8_WAIT_L(0); PG8_MMA(0, 0, At, B0); PG8_BAR; PG8_SCHED;
            PG8_LDB(B1, 1, 1); PG8_STAGE(PG8_SB(1, 0), b3, voffB);
            PG8_BAR; PG8_WAIT_L(0); PG8_MMA(0, 1, At, B1); PG8_BAR;
            PG8_LDA(At, 1, 1); PG8_STAGE(PG8_SA(1, 0), a3, voffA);
            PG8_BAR; PG8_WAIT_L(0); PG8_MMA(1, 0, At, B0); PG8_BAR; PG8_SCHED;
            PG8_STAGE(PG8_SB(1, 1), b3 + hstep, voffB);
            PG8_WAIT_V(6); PG8_BAR; PG8_MMA(1, 1, At, B1); PG8_BAR;
            }
        }
        if constexpr (F8) asm volatile("s_nop 15\n\ts_nop 15" ::: "memory");
        if constexpr (ALIGN_EPI) { if (wr == 0) PG8_BAR; }
        if constexpr (!Epi::AFTER_DRAIN) { E(acc, cur, wr, wc, fr, fq); S.done(cur); }
        if (!has_next) break;
#pragma unroll
        for (int a = 0; a < 2; ++a)
#pragma unroll
            for (int b = 0; b < 2; ++b)
#pragma unroll
                for (int m = 0; m < 4; ++m)
#pragma unroll
                    for (int n = 0; n < 2; ++n) acc[a][b][m][n] = (f32x4){0.f, 0.f, 0.f, 0.f};
        cur = nxt; cA = nA; cB = nB; ++ui;
        if constexpr (ALIGN_EPI) { if (wr == 1) PG8_BAR; }
    }
    PG8_WAIT_V(0);
    if constexpr (!ALIGN_EPI) { if (wr == 0) PG8_BAR; }
    PG8_BAR;
    if constexpr (Epi::AFTER_DRAIN) { E.fused(acc, cur, wr, wc, fr, fq, lds, wid, lane); S.done(cur); }
#undef PG8_SA
#undef PG8_SB
#undef PG8_STAGE
#undef PG8_LDA
#undef PG8_LDB
#undef PG8_MMA
#undef PG8_WAIT_V
#undef PG8_WAIT_L
#undef PG8_BAR
#undef PG8_SCHED
}

struct EpiStoreBf16 {
    static constexpr bool PERM = true, AFTER_DRAIN = false, ACC_INIT = false;
    bf16_t* O; int ldc;
    __device__ __forceinline__ void operator()(const f32x4 (&acc)[2][2][4][2], const Unit& u, int wr, int wc, int fr, int fq) const {
        const int row0 = u.pm * BM + wr * 64 + fr, col0 = u.pn * BM + wc * 32 + 8 * fq;
#pragma unroll
        for (int ai = 0; ai < 2; ++ai)
#pragma unroll
            for (int m = 0; m < 4; ++m) { bf16_t* rowp = O + (size_t)(row0 + ai * HALF + m * 16) * ldc + col0;
#pragma unroll
                for (int bj = 0; bj < 2; ++bj) { const f32x4 v0 = acc[ai][bj][m][0], v1 = acc[ai][bj][m][1];
                    u32x4 w; w.x = cvt_pk_bf16(v0[0], v0[1]); w.y = cvt_pk_bf16(v0[2], v0[3]); w.z = cvt_pk_bf16(v1[0], v1[1]); w.w = cvt_pk_bf16(v1[2], v1[3]);
                    *(u32x4*)(rowp + bj * HALF) = w; } }
    }
};
struct EpiResidF32 {
    static constexpr bool PERM = false, AFTER_DRAIN = false, ACC_INIT = true;
    const float* base; float* out;
    __device__ __forceinline__ void init(f32x4 (&acc)[2][2][4][2], const Unit& u, int wr, int wc, int fr, int fq) const {
        const int row0 = u.pm * BM + wr * 64 + fr, col0 = u.pn * BM + wc * 32 + 4 * fq;
#pragma unroll
        for (int ai = 0; ai < 2; ++ai)
#pragma unroll
            for (int m = 0; m < 4; ++m) { const size_t off = (size_t)(row0 + ai * HALF + m * 16) * 1024 + col0;
#pragma unroll
                for (int bj = 0; bj < 2; ++bj)
#pragma unroll
                    for (int n = 0; n < 2; ++n) acc[ai][bj][m][n] = *(const f32x4*)(base + off + bj * HALF + n * 16); }
    }
    __device__ __forceinline__ void operator()(const f32x4 (&acc)[2][2][4][2], const Unit& u, int wr, int wc, int fr, int fq) const {
        const int row0 = u.pm * BM + wr * 64 + fr, col0 = u.pn * BM + wc * 32 + 4 * fq;
#pragma unroll
        for (int ai = 0; ai < 2; ++ai)
#pragma unroll
            for (int m = 0; m < 4; ++m) { const size_t off = (size_t)(row0 + ai * HALF + m * 16) * 1024 + col0;
#pragma unroll
                for (int bj = 0; bj < 2; ++bj)
#pragma unroll
                    for (int n = 0; n < 2; ++n) *(f32x4*)(out + off + bj * HALF + n * 16) = acc[ai][bj][m][n]; }
    }
};
__device__ __forceinline__ float silu_f(float x) { return x * __builtin_amdgcn_rcpf(1.0f + __builtin_amdgcn_exp2f(-1.44269504089f * x)); }
struct EpiSwiglu {
    static constexpr bool PERM = true, AFTER_DRAIN = false, ACC_INIT = false;
    bf16_t* C; int ldc; int row_off;
    __device__ __forceinline__ void operator()(const f32x4 (&acc)[2][2][4][2], const Unit& u, int wr, int wc, int fr, int fq) const {
        const int row0 = u.pm * BM + wr * 64 + fr - row_off, col0 = u.pn * HALF + wc * 32 + 8 * fq;
#pragma unroll
        for (int ai = 0; ai < 2; ++ai)
#pragma unroll
            for (int m = 0; m < 4; ++m) { bf16_t* rowp = C + (size_t)(row0 + ai * HALF + m * 16) * ldc + col0;
                const f32x4 g0 = acc[ai][0][m][0], g1 = acc[ai][0][m][1], u0 = acc[ai][1][m][0], u1 = acc[ai][1][m][1];
                u32x4 w; w.x = cvt_pk_bf16(silu_f(g0[0]) * u0[0], silu_f(g0[1]) * u0[1]); w.y = cvt_pk_bf16(silu_f(g0[2]) * u0[2], silu_f(g0[3]) * u0[3]);
                w.z = cvt_pk_bf16(silu_f(g1[0]) * u1[0], silu_f(g1[1]) * u1[1]); w.w = cvt_pk_bf16(silu_f(g1[2]) * u1[2], silu_f(g1[3]) * u1[3]);
                *(u32x4*)rowp = w; }
    }
};
struct EpiMoeDown {
    static constexpr bool PERM = true, AFTER_DRAIN = false, ACC_INIT = false;
    bf16_t* out2; const int* rowdst; const float* rowg; float sc;
    __device__ __forceinline__ void operator()(const f32x4 (&acc)[2][2][4][2], const Unit& u, int wr, int wc, int fr, int fq) const {
        const int row0 = u.pm * BM + wr * 64 + fr, col0 = u.pn * BM + wc * 32 + 8 * fq;
#pragma unroll
        for (int ai = 0; ai < 2; ++ai)
#pragma unroll
            for (int m = 0; m < 4; ++m) { const int gr = row0 + ai * HALF + m * 16; const int d = rowdst[gr]; const float g = rowg[gr] * sc;
                if (d >= 0) { bf16_t* rowp = out2 + (size_t)d * 1024 + col0;
#pragma unroll
                    for (int bj = 0; bj < 2; ++bj) { const f32x4 v0 = acc[ai][bj][m][0] * g, v1 = acc[ai][bj][m][1] * g;
                        u32x4 w; w.x = cvt_pk_bf16(v0[0], v0[1]); w.y = cvt_pk_bf16(v0[2], v0[3]); w.z = cvt_pk_bf16(v1[0], v1[1]); w.w = cvt_pk_bf16(v1[2], v1[3]);
                        *(u32x4*)(rowp + bj * HALF) = w; } } }
    }
};


struct EpiResidStats {
    static constexpr bool PERM = false, AFTER_DRAIN = false, ACC_INIT = true;
    const float* base; float* out; bf16_t* hn; float* ssp;
    __device__ __forceinline__ void init(f32x4 (&acc)[2][2][4][2], const Unit& u, int wr, int wc, int fr, int fq) const {
        const int row0 = u.pm * BM + wr * 64 + fr, col0 = u.pn * BM + wc * 32 + 4 * fq;
#pragma unroll
        for (int ai = 0; ai < 2; ++ai)
#pragma unroll
            for (int m = 0; m < 4; ++m) { const size_t off = (size_t)(row0 + ai * HALF + m * 16) * 1024 + col0;
#pragma unroll
                for (int bj = 0; bj < 2; ++bj)
#pragma unroll
                    for (int n = 0; n < 2; ++n) acc[ai][bj][m][n] = *(const f32x4*)(base + off + bj * HALF + n * 16); }
    }
    __device__ __forceinline__ void operator()(const f32x4 (&acc)[2][2][4][2], const Unit& u, int wr, int wc, int fr, int fq) const {
        const int row0 = u.pm * BM + wr * 64 + fr, col0 = u.pn * BM + wc * 32 + 4 * fq; typedef unsigned u32x2e __attribute__((ext_vector_type(2)));
#pragma unroll
        for (int ai = 0; ai < 2; ++ai)
#pragma unroll
            for (int m = 0; m < 4; ++m) { const int row = row0 + ai * HALF + m * 16; const size_t off = (size_t)row * 1024 + col0; float ss = 0.f;
#pragma unroll
                for (int bj = 0; bj < 2; ++bj)
#pragma unroll
                    for (int n = 0; n < 2; ++n) { const f32x4 v = acc[ai][bj][m][n]; *(f32x4*)(out + off + bj * HALF + n * 16) = v;
                        ss += (v[0] * v[0] + v[1] * v[1]) + (v[2] * v[2] + v[3] * v[3]); u32x2e w; w.x = cvt_pk_bf16(v[0], v[1]); w.y = cvt_pk_bf16(v[2], v[3]); *(u32x2e*)(hn + off + bj * HALF + n * 16) = w; }
                ss += __shfl_xor(ss, 16); ss += __shfl_xor(ss, 32);
                if (fq == 0) ssp[(size_t)row * 16 + u.pn * 4 + wc] = ss; }
    }
};
constexpr int RSTD_TAB_OFF = STAGE_BYTES;
template <class Sched> __device__ __forceinline__ void fill_rstd_table(PG8_LAS unsigned char* lds, const Sched& S, const float* ssp, int tid) {
    PG8_LAS float* tab = (PG8_LAS float*)(lds + RSTD_TAB_OFF); Unit u;
    for (int i = 0; S.next(i, u); ++i)
        if (tid < 256) { const int row = u.pm * BM + tid; const f32x4* p = (const f32x4*)(ssp + (size_t)row * 16); const f32x4 a = p[0], b = p[1], c = p[2], d = p[3];
            const float s = (((a[0] + a[1]) + (a[2] + a[3])) + ((b[0] + b[1]) + (b[2] + b[3]))) + (((c[0] + c[1]) + (c[2] + c[3])) + ((d[0] + d[1]) + (d[2] + d[3])));
            tab[i * 256 + tid] = 1.0f / sqrtf(s * (1.0f / 1024.0f) + 1e-6f); }
    __syncthreads();
}
struct EpiStoreBf16R {
    static constexpr bool PERM = true, AFTER_DRAIN = false, ACC_INIT = false;
    bf16_t* O; int ldc; const PG8_LAS float* tab;
    __device__ __forceinline__ void operator()(const f32x4 (&acc)[2][2][4][2], const Unit& u, int wr, int wc, int fr, int fq) const {
        const int row0 = u.pm * BM + wr * 64 + fr, col0 = u.pn * BM + wc * 32 + 8 * fq;
#pragma unroll
        for (int ai = 0; ai < 2; ++ai)
#pragma unroll
            for (int m = 0; m < 4; ++m) { const int row = row0 + ai * HALF + m * 16; const float r = tab[u.ord * 256 + wr * 64 + fr + ai * HALF + m * 16]; bf16_t* rowp = O + (size_t)row * ldc + col0;
#pragma unroll
                for (int bj = 0; bj < 2; ++bj) { const f32x4 v0 = acc[ai][bj][m][0] * r, v1 = acc[ai][bj][m][1] * r;
                    u32x4 w; w.x = cvt_pk_bf16(v0[0], v0[1]); w.y = cvt_pk_bf16(v0[2], v0[3]); w.z = cvt_pk_bf16(v1[0], v1[1]); w.w = cvt_pk_bf16(v1[2], v1[3]);
                    *(u32x4*)(rowp + bj * HALF) = w; } }
    }
};
struct EpiSwigluR {
    static constexpr bool PERM = true, AFTER_DRAIN = false, ACC_INIT = false;
    bf16_t* C; int ldc; const PG8_LAS float* tab;
    __device__ __forceinline__ void operator()(const f32x4 (&acc)[2][2][4][2], const Unit& u, int wr, int wc, int fr, int fq) const {
        const int row0 = u.pm * BM + wr * 64 + fr, col0 = u.pn * HALF + wc * 32 + 8 * fq;
#pragma unroll
        for (int ai = 0; ai < 2; ++ai)
#pragma unroll
            for (int m = 0; m < 4; ++m) { const int row = row0 + ai * HALF + m * 16; const float r = tab[u.ord * 256 + wr * 64 + fr + ai * HALF + m * 16]; bf16_t* rowp = C + (size_t)row * ldc + col0;
                const f32x4 g0 = acc[ai][0][m][0] * r, g1 = acc[ai][0][m][1] * r, u0 = acc[ai][1][m][0] * r, u1 = acc[ai][1][m][1] * r;
                u32x4 w; w.x = cvt_pk_bf16(silu_f(g0[0]) * u0[0], silu_f(g0[1]) * u0[1]); w.y = cvt_pk_bf16(silu_f(g0[2]) * u0[2], silu_f(g0[3]) * u0[3]);
                w.z = cvt_pk_bf16(silu_f(g1[0]) * u1[0], silu_f(g1[1]) * u1[1]); w.w = cvt_pk_bf16(silu_f(g1[2]) * u1[2], silu_f(g1[3]) * u1[3]);
                *(u32x4*)rowp = w; }
    }
};
__device__ __forceinline__ unsigned pk4_fp8(float a, float b, float c, float d) { int w = __builtin_amdgcn_cvt_pk_fp8_f32(a, b, 0, false); w = __builtin_amdgcn_cvt_pk_fp8_f32(c, d, w, true); return (unsigned)w; }
struct EpiSwiglu8 {
    static constexpr bool PERM = true, AFTER_DRAIN = false, ACC_INIT = false;
    unsigned char* C; int ldc; float isc, osc;
    __device__ __forceinline__ void operator()(const f32x4 (&acc)[2][2][4][2], const Unit& u, int wr, int wc, int fr, int fq) const {
        const int row0 = u.pm * BM + wr * 64 + fr, col0 = u.pn * HALF + wc * 32 + 8 * fq; const float us = isc * osc;
#pragma unroll
        for (int ai = 0; ai < 2; ++ai)
#pragma unroll
            for (int m = 0; m < 4; ++m) { unsigned char* rowp = C + (size_t)(row0 + ai * HALF + m * 16) * ldc + col0;
                const f32x4 g0 = acc[ai][0][m][0] * isc, g1 = acc[ai][0][m][1] * isc, u0 = acc[ai][1][m][0] * us, u1 = acc[ai][1][m][1] * us;
                typedef unsigned u32x2e __attribute__((ext_vector_type(2))); u32x2e w;
                w.x = pk4_fp8(silu_f(g0[0]) * u0[0], silu_f(g0[1]) * u0[1], silu_f(g0[2]) * u0[2], silu_f(g0[3]) * u0[3]);
                w.y = pk4_fp8(silu_f(g1[0]) * u1[0], silu_f(g1[1]) * u1[1], silu_f(g1[2]) * u1[2], silu_f(g1[3]) * u1[3]);
                *(u32x2e*)rowp = w; }
    }
};
struct MoeOrder {
    StaticOrder so; int tlo, nN, a_off; const int* tilee;
    __device__ void init(int nrt, int nN_, int G, int c, int tlo_, int a_off_, const int* tilee_) { so.init(nrt * BM, nN_ * BM, G, c); tlo = tlo_; nN = nN_; a_off = a_off_; tilee = tilee_; }
    __device__ bool next(int i, Unit& u) const { if (!so.next(i, u)) return false; u.pm += tlo; u.pa = u.pm - a_off; const int e = __builtin_amdgcn_readfirstlane(__hip_atomic_load(tilee + u.pm, __ATOMIC_RELAXED, __HIP_MEMORY_SCOPE_AGENT)); u.pb = e * nN + u.pn; return true; }
    __device__ __forceinline__ void a_ready(const Unit&) const {}
    __device__ __forceinline__ void done(const Unit&) const {}
};
}

__device__ __forceinline__ void cvt_item(const float* W, int K, int N, bf16* WT, int mode, int item, float* scr, int lane, const float* gk = nullptr) {
    const int nblk = N / 32, kb = item / nblk, nb = item % nblk, k0 = 64 * kb, n0 = 32 * nb;
    { f32x4 v[8]; const float* src = W + (size_t)(k0 + (lane >> 3)) * N + n0 + 4 * (lane & 7);
#pragma unroll
      for (int i = 0; i < 8; ++i) v[i] = __builtin_nontemporal_load((const f32x4*)(src + (size_t)(8 * i) * N));
#pragma unroll
      for (int i = 0; i < 8; ++i) { float* d = scr + (8 * i + (lane >> 3)) * 33 + 4 * (lane & 7); const float gg = gk ? gk[k0 + 8 * i + (lane >> 3)] : 1.0f; d[0] = v[i].x * gg; d[1] = v[i].y * gg; d[2] = v[i].z * gg; d[3] = v[i].w * gg; } }
    LDS_WAIT();
    const int c = lane & 7;
#pragma unroll
    for (int j = 0; j < 4; ++j) {
        const int n = (lane >> 3) + 8 * j; const float* s = scr + (8 * c) * 33 + n;
        u32x4 o; o.x = pk2(s[0 * 33], s[1 * 33]); o.y = pk2(s[2 * 33], s[3 * 33]); o.z = pk2(s[4 * 33], s[5 * 33]); o.w = pk2(s[6 * 33], s[7 * 33]);
        const int nn = n0 + n; const int drow = mode == 0 ? nn : ((nn >> 7) * 256 + (nn & 127) + (mode == 2 ? 128 : 0));
        *(u32x4*)(WT + (size_t)drow * K + k0 + 8 * c) = o;
    }
    LDS_WAIT();
}

__device__ __forceinline__ void cvt_item8(const float* W, int K, int N, unsigned char* WT, int mode, int item, float* scr, int lane, float scale) {
    const int nblk = N / 32, kb = item / nblk, nb = item % nblk, k0 = 128 * kb, n0 = 32 * nb;
    { f32x4 v[16]; const float* src = W + (size_t)(k0 + (lane >> 3)) * N + n0 + 4 * (lane & 7);
#pragma unroll
      for (int i = 0; i < 16; ++i) v[i] = __builtin_nontemporal_load((const f32x4*)(src + (size_t)(8 * i) * N));
#pragma unroll
      for (int i = 0; i < 16; ++i) { float* d = scr + (8 * i + (lane >> 3)) * 33 + 4 * (lane & 7); d[0] = v[i].x * scale; d[1] = v[i].y * scale; d[2] = v[i].z * scale; d[3] = v[i].w * scale; } }
    LDS_WAIT();
    const int c = lane & 7;
#pragma unroll
    for (int j = 0; j < 4; ++j) {
        const int n = (lane >> 3) + 8 * j; const float* s = scr + (16 * c) * 33 + n;
        u32x4 o; o.x = pg8::pk4_fp8(s[0 * 33], s[1 * 33], s[2 * 33], s[3 * 33]); o.y = pg8::pk4_fp8(s[4 * 33], s[5 * 33], s[6 * 33], s[7 * 33]);
        o.z = pg8::pk4_fp8(s[8 * 33], s[9 * 33], s[10 * 33], s[11 * 33]); o.w = pg8::pk4_fp8(s[12 * 33], s[13 * 33], s[14 * 33], s[15 * 33]);
        const int nn = n0 + n; const int drow = mode == 0 ? nn : ((nn >> 7) * 256 + (nn & 127) + (mode == 2 ? 128 : 0));
        __builtin_nontemporal_store(o, (u32x4*)(WT + (size_t)drow * K + k0 + 16 * c));
    }
    LDS_WAIT();
}

__device__ __forceinline__ void rms_row_bf16(const float* xrow, const float* g, bf16* orow, int lane) {
    const f32x4* xr = (const f32x4*)xrow; const f32x4* gr = (const f32x4*)g;
    f32x4 v[4]; float s = 0.f;
#pragma unroll
    for (int j = 0; j < 4; ++j) { v[j] = xr[lane + 64 * j]; s += (v[j].x * v[j].x + v[j].y * v[j].y) + (v[j].z * v[j].z + v[j].w * v[j].w); }
    const float r = 1.0f / sqrtf(wave_sum(s) * (1.0f / D) + 1e-6f);
    u32x2* o8 = (u32x2*)orow;
#pragma unroll
    for (int j = 0; j < 4; ++j) { const f32x4 gv = gr[lane + 64 * j]; u32x2 w; w.x = pk2(v[j].x * r * gv.x, v[j].y * r * gv.y); w.y = pk2(v[j].z * r * gv.z, v[j].w * r * gv.w); o8[lane + 64 * j] = w; }
}

#define LAS __attribute__((address_space(3)))
#define XB_TMO      128
#define XB_XCNT(j)  (256  + 64 * (j))
#define XB_XSUB(j)  (1280 + 64 * (j))
#define XB_XGEN(j)  (2304 + 64 * (j))
#define XB_TOP      3328
#define XB_TOPGEN   3392
#define XCD_BAR_WORDS 3456
#define XB_SPIN_CAP (1u << 22)
__device__ __forceinline__ unsigned xb_ld(unsigned* p)              { return __hip_atomic_load(p, __ATOMIC_RELAXED, __HIP_MEMORY_SCOPE_AGENT); }
__device__ __forceinline__ unsigned xb_add(unsigned* p, unsigned v) { return __hip_atomic_fetch_add(p, v, __ATOMIC_RELAXED, __HIP_MEMORY_SCOPE_AGENT); }
__device__ __forceinline__ unsigned xb_xcc_id() { return (unsigned)__builtin_amdgcn_s_getreg((3 << 11) | 20) & 0xFu; }
#define XB_SPIN(cond, bar) do { unsigned _sp = 0; while (cond) { __builtin_amdgcn_s_sleep(1); \
    if ((++_sp & 255u) == 0u) { if (xb_ld(&(bar)[XB_TMO])) break; if (_sp > XB_SPIN_CAP) { atomicAdd(&(bar)[XB_TMO], 1u); break; } } } } while (0)
struct XcdBarrier { unsigned* bar; unsigned x; volatile LAS unsigned* st; };
__device__ __forceinline__ XcdBarrier xcd_barrier_post(unsigned* bar, volatile LAS unsigned* st) {
    XcdBarrier b; b.bar = bar; b.x = xb_xcc_id(); b.st = st;
    if (threadIdx.x == 0) (void)xb_add(&bar[XB_XCNT(b.x)], 1u);
    return b;
}
__device__ __forceinline__ void xcd_barrier_complete(unsigned* bar, unsigned x, unsigned& nloc, unsigned& nx) {
    const unsigned G = gridDim.x * gridDim.y * gridDim.z;
    unsigned sum, cnt, mine, sp = 0u;
    for (;;) {
        sum = 0u; cnt = 0u; mine = 0u;
#pragma unroll
        for (unsigned j = 0; j < 16; ++j) { const unsigned c = xb_ld(&bar[XB_XCNT(j)]); sum += c; cnt += (c > 0u) ? 1u : 0u; mine = (j == x) ? c : mine; }
        if (sum == G) break;
        __builtin_amdgcn_s_sleep(1);
        if ((++sp & 255u) == 0u) { if (xb_ld(&bar[XB_TMO])) break; if (sp > XB_SPIN_CAP) { atomicAdd(&bar[XB_TMO], 1u); break; } }
    }
    nloc = mine > 0u ? mine : 1u; nx = cnt > 0u ? cnt : 1u;
}
__device__ __forceinline__ void xcd_barrier(const XcdBarrier& b, bool leader) {
    asm volatile("s_waitcnt vmcnt(0)" ::: "memory");
    __syncthreads();
    if (leader) {
        unsigned* bar = b.bar;
        __builtin_amdgcn_s_waitcnt(0);
        unsigned nloc = b.st[0], nx = b.st[1];
        if (nloc == 0u) { xcd_barrier_complete(bar, b.x, nloc, nx); b.st[0] = nloc; b.st[1] = nx; }
        const unsigned old = xb_add(&bar[XB_XSUB(b.x)], 1u);
        const unsigned gen = old / nloc;
        if (old + 1u == (gen + 1u) * nloc) {
            __builtin_amdgcn_fence(__ATOMIC_RELEASE, "agent");
            asm volatile("s_waitcnt vmcnt(0)" ::: "memory");
            const unsigned og = xb_add(&bar[XB_TOP], 1u);
            const unsigned tg = og / nx;
            if (og + 1u == (tg + 1u) * nx) xb_add(&bar[XB_TOPGEN], 1u);
            else XB_SPIN(xb_ld(&bar[XB_TOPGEN]) == tg, bar);
            __builtin_amdgcn_fence(__ATOMIC_ACQUIRE, "agent");
            xb_add(&bar[XB_XGEN(b.x)], 1u);
            asm volatile("s_waitcnt vmcnt(0)" ::: "memory");
        } else {
            XB_SPIN(xb_ld(&bar[XB_XGEN(b.x)]) == gen, bar);
            __builtin_amdgcn_fence(__ATOMIC_ACQUIRE, "agent");
            asm volatile("s_waitcnt vmcnt(0)" ::: "memory");
        }
    }
    __syncthreads();
}
constexpr int LDS_BYTES = 163840, RING_BYTES = LDS_BYTES - 512, MISC_OFF = RING_BYTES + 320;
constexpr int CW_BAR = 4096;

enum Phase { PH_PROLOGUE = 0, PH_INPROJ, PH_MIX1, PH_MIX2, PH_MIX3, PH_OUTPROJ, PH_NORM, PH_FFNUP, PH_FFNDOWN, PH_DISPATCH, PH_MOEUP, PH_MOEDOWN, PH_FINAL };


constexpr int RS = 528;
constexpr int AINB_STRIDE = RS;
constexpr int VTS = 144;
template <int NLD> __device__ __forceinline__ void slab_load(u32x4 (&reg)[NLD], const bf16* src, int nrows, int rvalid0, int tid) {
#pragma unroll
    for (int j = 0; j < NLD; ++j) { const int i = tid + j * NT, r = i >> 5, ch = i & 31; reg[j] = (u32x4){0u, 0u, 0u, 0u}; if (i < nrows * 32 && r >= rvalid0) reg[j] = *(const u32x4*)(src + (ptrdiff_t)r * DIN + ch * 8); }
}
template <int NLD> __device__ __forceinline__ void slab_store(const u32x4 (&reg)[NLD], unsigned char* dst, int nrows, int tid) {
#pragma unroll
    for (int j = 0; j < NLD; ++j) { const int i = tid + j * NT, r = i >> 5, ch = i & 31; if (i < nrows * 32) *(u32x4*)(dst + r * RS + ch * 16) = reg[j]; }
}
__device__ __forceinline__ void ytile_store(const unsigned char* src, bf16* y, int tid) {
#pragma unroll
    for (int j = 0; j < 4; ++j) { const int i = tid + j * NT, r = i >> 5, ch = i & 31; *(u32x4*)(y + (size_t)r * D + ch * 8) = *(const u32x4*)(src + r * RS + ch * 16); }
}
__device__ __forceinline__ int vt_off(int c, int tok) { return c * VTS + ((tok ^ (((c >> 3) & 7) << 3)) << 1); }
__device__ __forceinline__ void vt_store(const u32x4 (&reg)[4], unsigned char* vt, int tid) {
#pragma unroll
    for (int j = 0; j < 4; ++j) { const int i = tid + j * NT, r = i >> 5, ch = i & 31, c0 = ch * 8; const unsigned w[4] = {reg[j].x, reg[j].y, reg[j].z, reg[j].w};
#pragma unroll
        for (int q = 0; q < 8; ++q) *(bf16*)(vt + vt_off(c0 + q, r)) = (bf16)((q & 1) ? (w[q >> 1] >> 16) : (w[q >> 1] & 0xffffu)); }
}
__device__ __forceinline__ float lru_ain(const unsigned char* ax, const float* conv_w, const float* conv_b, int t, int c) {
    float acc = conv_b[c];
#pragma unroll
    for (int k = 0; k < 4; ++k) acc += conv_w[k * GW + c] * bf2f(*(const bf16*)(ax + (t + k) * RS + c * 2));
    return acc;
}
__device__ __forceinline__ void lru_ainb(const unsigned char* ax, const float* conv_w, const float* conv_b, unsigned char* ainb, int tid) {
    for (int idx = tid; idx < CH * 128; idx += NT) {
        const int t = idx >> 7, c = (idx & 127) * 2; float a0 = conv_b[c], a1 = conv_b[c + 1];
#pragma unroll
        for (int k = 0; k < 4; ++k) { const unsigned w = *(const unsigned*)(ax + (t + k) * RS + c * 2); a0 += conv_w[k * GW + c] * bf2f(w & 0xffffu); a1 += conv_w[k * GW + c + 1] * bf2f(w >> 16); }
        *(unsigned*)(ainb + t * RS + c * 2) = pk2(a0, a1);
    }
}
__device__ __forceinline__ void lru_gates(const unsigned char* ainb, const unsigned char* ax, const float* conv_w, const float* conv_b, const bf16* wta, const bf16* wtx, const float* b_a, const float* b_x, const float* lam,
                                          int h, int nt, int lane, float (&av)[4][4], float (&uv)[4][4]) {
    const int fr = lane & 15, fq = lane >> 4, c = 64 * h + 16 * nt + fr;
    bf16x8 wa[2], wx[2];
#pragma unroll
    for (int ks = 0; ks < 2; ++ks) { wa[ks] = *(const bf16x8*)(wta + (size_t)(h * 64 + 16 * nt + fr) * 64 + 32 * ks + 8 * fq); wx[ks] = *(const bf16x8*)(wtx + (size_t)(h * 64 + 16 * nt + fr) * 64 + 32 * ks + 8 * fq); }
    f32x4 aa[4], ax4[4];
#pragma unroll
    for (int mt = 0; mt < 4; ++mt) { aa[mt] = (f32x4){0.f, 0.f, 0.f, 0.f}; ax4[mt] = (f32x4){0.f, 0.f, 0.f, 0.f};
#pragma unroll
        for (int ks = 0; ks < 2; ++ks) { const bf16x8 x = *(const bf16x8*)(ainb + (16 * mt + fr) * RS + (64 * h + 32 * ks + 8 * fq) * 2);
            aa[mt] = __builtin_amdgcn_mfma_f32_16x16x32_bf16(x, wa[ks], aa[mt], 0, 0, 0); ax4[mt] = __builtin_amdgcn_mfma_f32_16x16x32_bf16(x, wx[ks], ax4[mt], 0, 0, 0); } }
    const float sp = log1pf(fexp(-lam[c])), ba = b_a[c], bx = b_x[c];
#pragma unroll
    for (int mt = 0; mt < 4; ++mt)
#pragma unroll
        for (int r = 0; r < 4; ++r) { const int t = 16 * mt + 4 * fq + r; const float rg = sigmoidf_(aa[mt][r] + ba), ig = sigmoidf_(ax4[mt][r] + bx); const float loga = -8.0f * rg * sp;
            const float x2 = 2.0f * loga; const float m2 = x2 > -0.25f ? neg_expm1_small(x2) : -expm1f(x2);
            av[mt][r] = fexp(loga); uv[mt][r] = __builtin_amdgcn_sqrtf(fmaxf(m2, 0.f)) * ig * lru_ain(ax, conv_w, conv_b, t, c); }
}

constexpr int CW_CVTQ = 2048, CW_DONE = 8192;
constexpr int BG_IE1 = 8 * 112, BG_IE2 = 28 * 32, BG_ITEMS = 2 * NE * BG_IE1 + NE * BG_IE2, BG_BATCHES = BG_ITEMS / 8;
__device__ __forceinline__ void bg_convert(unsigned char* ws, unsigned char* lds_raw, const float* w1, const float* w3, const float* w2, int step, int G, int tid, bool drain) {
    unsigned* ctl = (unsigned*)(ws + WS_CTL); volatile unsigned* shq = (volatile unsigned*)(lds_raw + RING_BYTES);
    const int wid = tid >> 6, lane = tid & 63; float* scr = (float*)lds_raw + wid * (128 * 33);
    __syncthreads();
    if (tid == 0 && !drain) __hip_atomic_fetch_add(ctl + CW_DONE + 64 * step, 1u, __ATOMIC_RELAXED, __HIP_MEMORY_SCOPE_AGENT);
    for (;;) {
        if (tid == 0) { unsigned b = BG_BATCHES;
            if (drain || __hip_atomic_load(ctl + CW_DONE + 64 * step, __ATOMIC_RELAXED, __HIP_MEMORY_SCOPE_AGENT) + 16u < (unsigned)G) b = __hip_atomic_fetch_add(ctl + CW_CVTQ, 1u, __ATOMIC_RELAXED, __HIP_MEMORY_SCOPE_AGENT);
            shq[0] = b; }
        __syncthreads();
        const unsigned b = shq[0];
        __syncthreads();
        if (b >= (unsigned)BG_BATCHES) break;
        const int q = (int)b * 8 + wid;
        if (q < NE * BG_IE1) { const int e = q / BG_IE1, r = q % BG_IE1; cvt_item8(w1 + (size_t)e * D * DFFE, D, DFFE, ws + WS_W13 + (size_t)e * 2 * DFFE * D, 1, r, scr, lane, W13_SCALE); }
        else if (q < 2 * NE * BG_IE1) { const int q2 = q - NE * BG_IE1, e = q2 / BG_IE1, r = q2 % BG_IE1; cvt_item8(w3 + (size_t)e * D * DFFE, D, DFFE, ws + WS_W13 + (size_t)e * 2 * DFFE * D, 2, r, scr, lane, W13_SCALE); }
        else { const int q2 = q - 2 * NE * BG_IE1, e = q2 / BG_IE2, r = q2 % BG_IE2; cvt_item8(w2 + (size_t)e * DFFE * D, DFFE, D, ws + WS_W2 + (size_t)e * D * DFFE, 0, r, scr, lane, W2_SCALE); }
    }
}

#define HN ((bf16*)(ws + WS_HN))
#define PROJ ((bf16*)(ws + WS_PROJ))
#define Y ((bf16*)(ws + WS_Y))
#define DS ((float*)(ws + WS_DS))
#define HID ((bf16*)(ws + WS_HID))
#define HIDE ((unsigned char*)(ws + WS_HIDE))
#define OUT2 ((bf16*)(ws + WS_OUT2))
#define XR ((unsigned char*)(ws + WS_XR))
#define SSP0 ((float*)(ws + WS_END))
#define SSP1 ((float*)(ws + WS_END + MiB))
#define SMALLP(T, off) ((T*)(ws + WS_SMALL + (off)))
#define RSTD SMALLP(float, SM_RSTD)
#define TOKE SMALLP(int, SM_TOKE)
#define TOKG SMALLP(float, SM_TOKG)
#define TOKR SMALLP(int, SM_TOKR)
#define BCNT SMALLP(int, SM_BCNT)
#define ROWDST SMALLP(int, SM_ROWDST)
#define ROWG SMALLP(float, SM_ROWG)
#define TILEE SMALLP(int, SM_TILEE)
#define CARA SMALLP(float, SM_CARA)
#define CARH SMALLP(float, SM_CARH)
#define CIN SMALLP(float, SM_CIN)
#define DEC SMALLP(float, SM_DEC)
#define WTA SMALLP(bf16, SM_WTA)
#define WTX SMALLP(bf16, SM_WTX)
#define WTP SMALLP(bf16, SM_WTP)
#define PHASE_ENTER int tid = wid_s * 64 + lane_id_asm(); asm volatile("" : "+v"(tid)); const int lane = tid & 63, wid = tid >> 6; __attribute__((address_space(1))) unsigned char* wsg_ = (__attribute__((address_space(1))) unsigned char*)a.ws; asm volatile("" : "+s"(wsg_)); unsigned char* ws = (unsigned char*)wsg_; \
    __attribute__((address_space(1))) float* hresg_ = (__attribute__((address_space(1))) float*)a.out; asm volatile("" : "+s"(hresg_)); float* hres = (float*)hresg_; \
    int bid = blockIdx.x; asm volatile("" : "+s"(bid)); int G = gridDim.x; asm volatile("" : "+s"(G)); (void)lane; (void)wid; (void)hres; (void)bid; (void)G;

__global__ void __launch_bounds__(NT) fwd(Args a) {
    extern __shared__ __attribute__((aligned(16))) unsigned char lds_raw[];
    float* ldsf = (float*)lds_raw;
    const int wid_s = __builtin_amdgcn_readfirstlane(threadIdx.x >> 6);
    { const int tid0 = threadIdx.x; for (int u = tid0; u < (LDS_BYTES - RING_BYTES) / 4; u += NT) ((LAS unsigned*)((LAS unsigned char*)lds_raw + RING_BYTES))[u] = 0u; }
    __syncthreads();
    XcdBarrier bar = xcd_barrier_post((unsigned*)(a.ws + WS_CTL) + CW_BAR, (volatile LAS unsigned*)((LAS unsigned char*)lds_raw + MISC_OFF) + 8);

#ifdef REP_STEP
    int rep_left = REP_N;
#endif
    for (int step = a.ph_lo; step < a.ph_hi; ++step) {
#ifdef REP_STEP
    const bool dry = (step == REP_STEP && rep_left > 0);
#else
    constexpr bool dry = false;
#endif
    int phase, L, pass = 0;
    if (step == 0) { phase = PH_PROLOGUE; L = 0; }
    else if (step < 8) { L = 0; const int s = step - 1; phase = s < 5 ? PH_INPROJ + s : s == 5 ? PH_FFNUP : PH_FFNDOWN; }
    else { L = 1; const int s = step - 8; phase = s < 5 ? PH_INPROJ + s : s == 5 ? PH_NORM : s == 6 ? PH_DISPATCH : s == 7 ? PH_MOEUP : s == 8 ? PH_MOEDOWN : PH_FINAL; }
#ifdef REP_NOP
    if (dry) phase = 1000;
#endif
    switch (phase) {
    case PH_PROLOGUE: {
        PHASE_ENTER
        float* scr = ldsf + wid * (128 * 33);
        const int gw = bid * 8 + wid, NGW = G * 8;
        constexpr int I_IN = 16 * 80, I_OUT = 16 * 32, I_G = 16 * 88, I_D = 44 * 32;
        constexpr int T0 = 2 * I_IN, T1 = T0 + 2 * I_OUT, T2 = T1 + I_G, T3 = T2 + I_G, T4 = T3 + I_D;
        for (int it = gw; it < T4; it += NGW) {
            if (it < T0) { const int l = it / I_IN, r = it % I_IN; cvt_item(IN(1) + (size_t)l * D * DIN, D, DIN, (bf16*)(ws + WS_WIN) + (size_t)l * DIN * D, 0, r, scr, lane, l == 1 ? IN(15) + D : nullptr); }
            else if (it < T1) { const int q = it - T0, l = q / I_OUT, r = q % I_OUT; cvt_item(IN(2) + (size_t)l * D * D, D, D, (bf16*)(ws + WS_WOUT) + (size_t)l * D * D, 0, r, scr, lane); }
            else if (it < T2) { cvt_item(IN(17), D, DFF, (bf16*)(ws + WS_WGU), 1, it - T1, scr, lane, IN(16)); }
            else if (it < T3) { cvt_item(IN(18), D, DFF, (bf16*)(ws + WS_WGU), 2, it - T2, scr, lane, IN(16)); }
            else { cvt_item(IN(19), DFF, D, (bf16*)(ws + WS_WD), 0, it - T3, scr, lane); }
        }
        for (int m = gw; m < NTOK; m += NGW) rms_row_bf16(IN(0) + (size_t)m * D, IN(15), HN + (size_t)m * D, lane);
        for (int idx = bid * NT + tid; idx < 3 * 2 * 4 * HD * HD; idx += G * NT) {
            const int mat = idx / (2 * 4 * HD * HD), r = idx % (2 * 4 * HD * HD), lh = r >> 12, j = (r >> 6) & 63, i = r & 63;
            const float* w = mat == 0 ? IN(5) : mat == 1 ? IN(7) : IN(12);
            (mat == 0 ? WTA : mat == 1 ? WTX : WTP)[r] = (bf16)f2bf(w[(lh * 64 + i) * 64 + j]);
        }
    } break;

    case PH_INPROJ: {
        PHASE_ENTER
        pg8::Gemm g{HN, (const bf16*)(ws + WS_WIN) + (size_t)L * DIN * D, NTOK, DIN, D}; pg8::StaticOrder S; S.init(NTOK, DIN, G, bid);
        if (L == 0) { pg8::EpiStoreBf16 E{PROJ, DIN}; pg8::gemm_phase<pg8::EpiStoreBf16, pg8::StaticOrder, true, true>((PG8_LAS unsigned char*)lds_raw, g, S, E, tid); }
        else { pg8::fill_rstd_table((PG8_LAS unsigned char*)lds_raw, S, SSP1, tid); pg8::EpiStoreBf16R E{PROJ, DIN, (const PG8_LAS float*)((PG8_LAS unsigned char*)lds_raw + pg8::RSTD_TAB_OFF)}; pg8::gemm_phase<pg8::EpiStoreBf16R, pg8::StaticOrder, true, true>((PG8_LAS unsigned char*)lds_raw, g, S, E, tid); }
    } break;

    case PH_MIX1: {
        PHASE_ENTER
        const float* conv_w = IN(3) + L * 4 * GW; const float* conv_b = IN(4) + L * GW;
        const float* b_a = IN(6) + L * GW; const float* b_x = IN(8) + L * GW;
        const float* lam = IN(9) + L * GW; const float* lbp = IN(10);
        unsigned char* AX = lds_raw; unsigned char* AINB = lds_raw + 35376; unsigned char* FS = lds_raw + 69168; unsigned char* VTl = lds_raw + 102960; float* TOTl = (float*)(lds_raw + 139824);
        unsigned char* KHTl = lds_raw;
        for (int ci = bid; ci < NCHUNK; ci += G) {
            const int t0 = (ci % CPB) * CH, g0 = ci * CH; const bf16* prow = PROJ + (size_t)g0 * DIN;
            {
                u32x4 rax[5], rf[4], rv[4];
                slab_load<5>(rax, prow - 3 * DIN, 67, t0 == 0 ? 3 : 0, tid); slab_load<4>(rf, prow + 768, 64, 0, tid); slab_load<4>(rv, prow + 1024, 64, 0, tid);
                slab_store<5>(rax, AX, 67, tid); slab_store<4>(rf, FS, 64, tid); vt_store(rv, VTl, tid);
            }
            __syncthreads();
            lru_ainb(AX, conv_w, conv_b, AINB, tid);
            __syncthreads();
#pragma unroll 1
            for (int cc = 0; cc < 2; ++cc) {
                const int h = wid >> 1, nt = 2 * (wid & 1) + cc; float av[4][4], uv[4][4];
                lru_gates(AINB, AX, conv_w, conv_b, WTA + L * 16384, WTX + L * 16384, b_a, b_x, lam, h, nt, lane, av, uv);
                float A = 1.f, H = 0.f;
#pragma unroll
                for (int mt = 0; mt < 4; ++mt) {
                    float At = 1.f, Ht = 0.f;
#pragma unroll
                    for (int r = 0; r < 4; ++r) { Ht = av[mt][r] * Ht + uv[mt][r]; At *= av[mt][r]; }
                    const float A1 = __shfl_down(At, 16), H1 = __shfl_down(Ht, 16); const float At2 = At * A1, Ht2 = A1 * Ht + H1;
                    const float A2 = __shfl_down(At2, 32), H2 = __shfl_down(Ht2, 32); const float Att = At2 * A2, Htt = A2 * Ht2 + H2;
                    H = Att * H + Htt; A *= Att;
                }
                if (lane < 16) { const int c = 64 * h + 16 * nt + lane; CARA[ci * GW + c] = A; CARH[ci * GW + c] = H; }
            }
            {
                const int h = wid >> 1, half = wid & 1, c = 64 * h + lane, fr = lane & 15, fq = lane >> 4;
                const float lb = L == 0 ? 0.f : sigmoidf_(lbp[GW + c] - lbp[c]);
                float gl[32], kk[32]; float run = 0.f;
#pragma unroll
                for (int t = 0; t < 32; ++t) { const float sg = sigmoidf_(bf2f(*(const bf16*)(FS + (32 * half + t) * RS + c * 2))); run += flog(lb + (1.f - lb) * sg); gl[t] = run; kk[t] = (1.f - lb) * (1.f - sg); }
                TOTl[(h * 2 + half) * 64 + lane] = run;
                __syncthreads();
                const float tot0 = TOTl[(h * 2) * 64 + lane], glast = tot0 + TOTl[(h * 2 + 1) * 64 + lane], off = half ? tot0 : 0.f;
#pragma unroll
                for (int j = 0; j < 4; ++j) { float e[8];
#pragma unroll
                    for (int q = 0; q < 8; ++q) e[q] = kk[8 * j + q] * fexp(glast - (off + gl[8 * j + q]));
                    u32x4 w; w.x = pk2(e[0], e[1]); w.y = pk2(e[2], e[3]); w.z = pk2(e[4], e[5]); w.w = pk2(e[6], e[7]);
                    *(u32x4*)(KHTl + c * VTS + (32 * half + 8 * j) * 2) = w; }
                if (half) DEC[(ci * 4 + h) * 64 + lane] = fexp(glast);
                __syncthreads();
#pragma unroll
                for (int vvv = 0; vvv < 2; ++vvv) {
                    const int vt = 2 * half + vvv, vrow = 64 * h + 16 * vt + fr; bf16x8 bv[2];
#pragma unroll
                    for (int ks = 0; ks < 2; ++ks) bv[ks] = *(const bf16x8*)(VTl + vt_off(vrow, 32 * ks + 8 * fq));
#pragma unroll
                    for (int kt = 0; kt < 4; ++kt) { f32x4 acc = (f32x4){0.f, 0.f, 0.f, 0.f};
#pragma unroll
                        for (int ks = 0; ks < 2; ++ks) { const bf16x8 ka = *(const bf16x8*)(KHTl + (64 * h + 16 * kt + fr) * VTS + (32 * ks + 8 * fq) * 2); acc = __builtin_amdgcn_mfma_f32_16x16x32_bf16(ka, bv[ks], acc, 0, 0, 0); }
                        *(f32x4*)(DS + ((size_t)(ci * 4 + h) * 64 + 16 * vt + fr) * 64 + 16 * kt + 4 * fq) = acc; }
                }
                __syncthreads();
            }
        }
    } break;

    case PH_MIX2: {
        PHASE_ENTER
        float* xa = ldsf; float* xs = ldsf + 512;
        for (int item = bid; item < 256 + 2; item += G) {
            if (item < 256) {
                const int el = tid & 127, seg = tid >> 7, e = item * 128 + el, b = e >> 14, hh = (e >> 12) & 3, kv = e & 4095, k = kv & 63;
                float dv[32], dc[32];
#pragma unroll
                for (int i = 0; i < 32; ++i) { const int ci = b * CPB + seg * 32 + i; dv[i] = DS[(size_t)(ci * 4 + hh) * 4096 + kv]; dc[i] = DEC[(ci * 4 + hh) * 64 + k]; }
                float S = 0.f, A = 1.f;
#pragma unroll
                for (int i = 0; i < 32; ++i) { const float d = dv[i]; dv[i] = S; S = dc[i] * S + d; const float a0 = dc[i]; dc[i] = A; A *= a0; }
                xa[seg * 128 + el] = A; xs[seg * 128 + el] = S;
                __syncthreads();
                float Sin = 0.f;
                for (int s2 = 0; s2 < seg; ++s2) Sin = xa[s2 * 128 + el] * Sin + xs[s2 * 128 + el];
#pragma unroll
                for (int i = 0; i < 32; ++i) { const int ci = b * CPB + seg * 32 + i; (dry ? DS + 20 * (MiB / 4) * 4 : DS)[(size_t)(ci * 4 + hh) * 4096 + kv] = dv[i] + dc[i] * Sin; }
                __syncthreads();
            } else {
                if (tid < GW) { const int b = item - 256, c = tid; float hp = 0.f;
                    for (int ch0 = 0; ch0 < CPB; ch0 += 16) { float ca[16], chh[16];
#pragma unroll
                        for (int i = 0; i < 16; ++i) { ca[i] = CARA[(b * CPB + ch0 + i) * GW + c]; chh[i] = CARH[(b * CPB + ch0 + i) * GW + c]; }
#pragma unroll
                        for (int i = 0; i < 16; ++i) { CIN[(b * CPB + ch0 + i) * GW + c] = hp; hp = ca[i] * hp + chh[i]; } } }
            }
        }
    } break;

    case PH_MIX3: {
        PHASE_ENTER
        const float* conv_w = IN(3) + L * 4 * GW; const float* conv_b = IN(4) + L * GW; const float* b_a = IN(6) + L * GW; const float* b_x = IN(8) + L * GW; const float* lam = IN(9) + L * GW;
        const float* lbp = IN(10); const float* norm_g = IN(11) + L * HD; const float* pool_s = IN(13) + L * GW; const float* sconv_w = IN(14) + L * 3 * GW;
        unsigned char* AX = lds_raw; unsigned char* AG = lds_raw + 35376; unsigned char* AINB = lds_raw + 69168;
        unsigned char* QT3 = lds_raw; unsigned char* KT3 = lds_raw + 33792; unsigned char* OG3 = lds_raw + 67584; unsigned char* VT3 = lds_raw + 101376; float* TOT3 = (float*)(lds_raw + 138240);
        unsigned char* PS = lds_raw; unsigned char* DIMG = lds_raw + 41712; unsigned char* YST = lds_raw + 75504;
        unsigned char* SB = lds_raw; unsigned char* SC = lds_raw + 33792; unsigned char* SX = lds_raw + 68640;
        for (int ci = bid; ci < NCHUNK; ci += G) {
            const int t0 = (ci % CPB) * CH, g0 = ci * CH; const bf16* prow = PROJ + (size_t)g0 * DIN; bf16* yrow = Y + (size_t)g0 * D;
            {
                u32x4 rax[5], rag[4];
                slab_load<5>(rax, prow - 3 * DIN, 67, t0 == 0 ? 3 : 0, tid); slab_load<4>(rag, prow + 256, 64, 0, tid);
                slab_store<5>(rax, AX, 67, tid); slab_store<4>(rag, AG, 64, tid);
            }
            __syncthreads();
            lru_ainb(AX, conv_w, conv_b, AINB, tid);
            __syncthreads();
            u32x4 rp[5];
            slab_load<5>(rp, prow - 15 * DIN + 1536, 79, t0 == 0 ? 15 : 0, tid);
#pragma unroll 1
            for (int cc = 0; cc < 2; ++cc) {
                const int h = wid >> 1, nt = 2 * (wid & 1) + cc, fr = lane & 15, fq = lane >> 4, c = 64 * h + 16 * nt + fr; float av[4][4], uv[4][4];
                lru_gates(AINB, AX, conv_w, conv_b, WTA + L * 16384, WTX + L * 16384, b_a, b_x, lam, h, nt, lane, av, uv);
                float hin = CIN[ci * GW + c];
#pragma unroll
                for (int mt = 0; mt < 4; ++mt) {
                    float Ai[4], Hi[4]; float A_ = 1.f, H_ = 0.f;
#pragma unroll
                    for (int r = 0; r < 4; ++r) { H_ = av[mt][r] * H_ + uv[mt][r]; A_ *= av[mt][r]; Ai[r] = A_; Hi[r] = H_; }
                    const float a1 = __shfl_up(A_, 16), h1 = __shfl_up(H_, 16), a2 = __shfl_up(A_, 32), h2 = __shfl_up(H_, 32), a3 = __shfl_up(A_, 48), h3 = __shfl_up(H_, 48);
                    float EA = 1.f, EH = 0.f;
                    if (fq >= 3) { EA = a3; EH = h3; }
                    if (fq >= 2) { EH = a2 * EH + h2; EA *= a2; }
                    if (fq >= 1) { EH = a1 * EH + h1; EA *= a1; }
                    const float hs = EA * hin + EH; float hv[4];
#pragma unroll
                    for (int r = 0; r < 4; ++r) hv[r] = Ai[r] * hs + Hi[r];
                    hin = __shfl(hv[3], 48 + fr);
#pragma unroll
                    for (int r = 0; r < 4; ++r) { bf16* p = (bf16*)(AG + (16 * mt + 4 * fq + r) * RS + c * 2); *p = (bf16)f2bf(hv[r] * gelu_tanh(bf2f(*p))); }
                }
            }
            __syncthreads();
            ytile_store(AG, yrow, tid);
            __syncthreads();
            slab_store<5>(rp, PS, 79, tid);
            __syncthreads();
            u32x4 rsb[4], rsc[5], rsx[5];
            slab_load<4>(rsb, prow + 1792, 64, 0, tid); slab_load<5>(rsc, prow - 2 * DIN + 2048, 66, t0 == 0 ? 2 : 0, tid); slab_load<5>(rsx, prow - 2 * DIN + 2304, 66, t0 == 0 ? 2 : 0, tid);
            for (int idx = tid; idx < CH * 128; idx += NT) {
                const int t = idx >> 7, c = (idx & 127) * 2, gi = c >> 6, w = 2 << gi; const int tt = t0 + t; const int cnt = (tt + 1 < w) ? (tt + 1) : w; float s0 = 0.f, s1 = 0.f;
                for (int r = 0; r < cnt; ++r) { const unsigned x = *(const unsigned*)(PS + (t + 15 - r) * RS + c * 2); s0 += bf2f(x & 0xffffu); s1 += bf2f(x >> 16); }
                const unsigned x0 = *(const unsigned*)(PS + (t + 15) * RS + c * 2); const float inv = __builtin_amdgcn_rcpf((float)cnt);
                *(unsigned*)(DIMG + t * RS + c * 2) = pk2(s0 * inv - bf2f(x0 & 0xffffu), s1 * inv - bf2f(x0 >> 16));
            }
            __syncthreads();
#pragma unroll 1
            for (int cc = 0; cc < 2; ++cc) {
                const int gi = wid >> 1, nt = 2 * (wid & 1) + cc, fr = lane & 15, fq = lane >> 4, c = 64 * gi + 16 * nt + fr; bf16x8 wp[2];
#pragma unroll
                for (int ks = 0; ks < 2; ++ks) wp[ks] = *(const bf16x8*)(WTP + L * 16384 + (size_t)(gi * 64 + 16 * nt + fr) * 64 + 32 * ks + 8 * fq);
                const float psc = pool_s[c];
#pragma unroll
                for (int mt = 0; mt < 4; ++mt) { f32x4 acc = (f32x4){0.f, 0.f, 0.f, 0.f};
#pragma unroll
                    for (int ks = 0; ks < 2; ++ks) { const bf16x8 x = *(const bf16x8*)(DIMG + (16 * mt + fr) * RS + (64 * gi + 32 * ks + 8 * fq) * 2); acc = __builtin_amdgcn_mfma_f32_16x16x32_bf16(x, wp[ks], acc, 0, 0, 0); }
#pragma unroll
                    for (int r = 0; r < 4; ++r) *(bf16*)(YST + (16 * mt + 4 * fq + r) * RS + c * 2) = (bf16)f2bf(acc[r] * psc); }
            }
            __syncthreads();
            ytile_store(YST, yrow + 512, tid);
            __syncthreads();
            slab_store<4>(rsb, SB, 64, tid); slab_store<5>(rsc, SC, 66, tid); slab_store<5>(rsx, SX, 66, tid);
            __syncthreads();
            u32x4 rq[4], rf[4], rv[4], rog[4];
            slab_load<4>(rq, prow + 512, 64, 0, tid); slab_load<4>(rf, prow + 768, 64, 0, tid); slab_load<4>(rv, prow + 1024, 64, 0, tid); slab_load<4>(rog, prow + 1280, 64, 0, tid);
            for (int idx = tid; idx < CH * 128; idx += NT) {
                const int t = idx >> 7, c = (idx & 127) * 2; float a0 = 0.f, a1 = 0.f;
#pragma unroll
                for (int k = 0; k < 3; ++k) { const unsigned xc = *(const unsigned*)(SC + (t + k) * RS + c * 2), xx = *(const unsigned*)(SX + (t + k) * RS + c * 2);
                    a0 += sconv_w[k * GW + c] * bf2f(xc & 0xffffu) * bf2f(xx & 0xffffu); a1 += sconv_w[k * GW + c + 1] * bf2f(xc >> 16) * bf2f(xx >> 16); }
                unsigned* pb = (unsigned*)(SB + t * RS + c * 2); const unsigned b = *pb; *pb = pk2(bf2f(b & 0xffffu) * a0, bf2f(b >> 16) * a1);
            }
            __syncthreads();
            ytile_store(SB, yrow + 768, tid);
            __syncthreads();
            slab_store<4>(rq, QT3, 64, tid); slab_store<4>(rf, KT3, 64, tid); slab_store<4>(rog, OG3, 64, tid); vt_store(rv, VT3, tid);
            __syncthreads();
            {
                const int h = wid >> 1, half = wid & 1, c = 64 * h + lane, fr = lane & 15, fq = lane >> 4;
                const float lb = L == 0 ? 0.f : sigmoidf_(lbp[GW + c] - lbp[c]);
                float gl[32]; float run = 0.f;
#pragma unroll
                for (int t = 0; t < 32; ++t) { const float sg = sigmoidf_(bf2f(*(const bf16*)(KT3 + (32 * half + t) * RS + c * 2))); run += flog(lb + (1.f - lb) * sg); gl[t] = run; }
                TOT3[(h * 2 + half) * 64 + lane] = run;
                __syncthreads();
                const float tot0 = TOT3[(h * 2) * 64 + lane];
                const float off = half ? 0.f : -tot0;
#pragma unroll
                for (int t = 0; t < 32; ++t) {
                    bf16* pq = (bf16*)(QT3 + (32 * half + t) * RS + c * 2); bf16* pk = (bf16*)(KT3 + (32 * half + t) * RS + c * 2);
                    const float sg = sigmoidf_(bf2f(*pk)), kkv = (1.f - lb) * (1.f - sg), qfv = siluf_(bf2f(*pq)), d = gl[t] + off;
                    *pq = (bf16)f2bf(qfv * fexp(d)); *pk = (bf16)f2bf(kkv * fexp(-d));
                }
                __syncthreads();
                bf16x8 sa[4][2];
#pragma unroll
                for (int vt = 0; vt < 4; ++vt)
#pragma unroll
                    for (int ks = 0; ks < 2; ++ks) {
                        const float* p = DS + ((size_t)(ci * 4 + h) * 64 + 16 * vt + fr) * 64 + 32 * ks + 8 * fq; const f32x4 lo = *(const f32x4*)p, hi = *(const f32x4*)(p + 4);
                        const float* eg = TOT3 + (h * 2) * 64 + 32 * ks + 8 * fq;
                        u32x4 w; w.x = pk2(lo.x * fexp(eg[0]), lo.y * fexp(eg[1])); w.y = pk2(lo.z * fexp(eg[2]), lo.w * fexp(eg[3])); w.z = pk2(hi.x * fexp(eg[4]), hi.y * fexp(eg[5])); w.w = pk2(hi.z * fexp(eg[6]), hi.w * fexp(eg[7]));
                        sa[vt][ks] = __builtin_bit_cast(bf16x8, w);
                    }
#pragma unroll
                for (int tsel = 0; tsel < 2; ++tsel) {
                    const int ti = half == 0 ? (tsel ? 3 : 0) : (tsel ? 2 : 1);
                    bf16x8 qb[2];
#pragma unroll
                    for (int ks = 0; ks < 2; ++ks) qb[ks] = *(const bf16x8*)(QT3 + (16 * ti + fr) * RS + (64 * h + 32 * ks + 8 * fq) * 2);
                    f32x4 st[4];
#pragma unroll
                    for (int si = 0; si < 4; ++si) { st[si] = (f32x4){0.f, 0.f, 0.f, 0.f};
                        if (si <= ti) {
#pragma unroll
                            for (int ks = 0; ks < 2; ++ks) { const bf16x8 ka = *(const bf16x8*)(KT3 + (16 * si + fr) * RS + (64 * h + 32 * ks + 8 * fq) * 2); st[si] = __builtin_amdgcn_mfma_f32_16x16x32_bf16(ka, qb[ks], st[si], 0, 0, 0); }
                            if (si == ti) {
#pragma unroll
                                for (int r = 0; r < 4; ++r) if (4 * fq + r > fr) st[si][r] = 0.f; }
                        } }
                    f32x4 oo[4];
#pragma unroll
                    for (int vt = 0; vt < 4; ++vt) { oo[vt] = (f32x4){0.f, 0.f, 0.f, 0.f};
#pragma unroll
                        for (int ks = 0; ks < 2; ++ks) oo[vt] = __builtin_amdgcn_mfma_f32_16x16x32_bf16(sa[vt][ks], qb[ks], oo[vt], 0, 0, 0); }
#pragma unroll
                    for (int p = 0; p < 2; ++p) if (2 * p <= ti) {
                        u32x4 bw; bw.x = pk2(st[2 * p][0], st[2 * p][1]); bw.y = pk2(st[2 * p][2], st[2 * p][3]); bw.z = pk2(st[2 * p + 1][0], st[2 * p + 1][1]); bw.w = pk2(st[2 * p + 1][2], st[2 * p + 1][3]);
                        const bf16x8 bfr = __builtin_bit_cast(bf16x8, bw);
#pragma unroll
                        for (int vt = 0; vt < 4; ++vt) { const int vrow = 64 * h + 16 * vt + fr; const u32x2 lo8 = *(const u32x2*)(VT3 + vt_off(vrow, 32 * p + 4 * fq)), hi8 = *(const u32x2*)(VT3 + vt_off(vrow, 32 * p + 16 + 4 * fq));
                            u32x4 aw; aw.x = lo8.x; aw.y = lo8.y; aw.z = hi8.x; aw.w = hi8.y;
                            oo[vt] = __builtin_amdgcn_mfma_f32_16x16x32_bf16(__builtin_bit_cast(bf16x8, aw), bfr, oo[vt], 0, 0, 0); }
                    }
                    float ss = 0.f;
#pragma unroll
                    for (int vt = 0; vt < 4; ++vt) ss += (oo[vt][0] * oo[vt][0] + oo[vt][1] * oo[vt][1]) + (oo[vt][2] * oo[vt][2] + oo[vt][3] * oo[vt][3]);
                    ss += __shfl_xor(ss, 16); ss += __shfl_xor(ss, 32);
                    const float rs = __builtin_amdgcn_rsqf(ss * (1.0f / HD) + 1e-5f);
#pragma unroll
                    for (int vt = 0; vt < 4; ++vt) { const int cv = 64 * h + 16 * vt + 4 * fq; u32x2* pog = (u32x2*)(OG3 + (16 * ti + fr) * RS + cv * 2); const u32x2 og = *pog; const f32x4 ng = *(const f32x4*)(norm_g + 16 * vt + 4 * fq);
                        u32x2 w; w.x = pk2(oo[vt][0] * rs * ng.x * siluf_(bf2f(og.x & 0xffffu)), oo[vt][1] * rs * ng.y * siluf_(bf2f(og.x >> 16))); w.y = pk2(oo[vt][2] * rs * ng.z * siluf_(bf2f(og.y & 0xffffu)), oo[vt][3] * rs * ng.w * siluf_(bf2f(og.y >> 16)));
                        *pog = w; }
                }
                __syncthreads();
            }
            ytile_store(OG3, yrow + 256, tid);
            __syncthreads();
        }
    } break;

    case PH_OUTPROJ: {
        PHASE_ENTER
        pg8::Gemm g{Y, (const bf16*)(ws + WS_WOUT) + (size_t)L * D * D, NTOK, D, D}; pg8::StaticOrder S; S.init(NTOK, D, G, bid);
        if (L == 0) { pg8::EpiResidStats E{IN(0), hres, HN, SSP0}; pg8::gemm_phase<pg8::EpiResidStats, pg8::StaticOrder, true, true>((PG8_LAS unsigned char*)lds_raw, g, S, E, tid); }
        else { pg8::EpiResidF32 E{hres, hres}; pg8::gemm_phase<pg8::EpiResidF32, pg8::StaticOrder, true, true>((PG8_LAS unsigned char*)lds_raw, g, S, E, tid); }
    } break;

    case PH_NORM: {
        PHASE_ENTER
        const float* g = pass == 0 ? IN(16) + L * D : IN(15) + D;
        const bool route = (L == 1 && pass == 0);
        int* sel = (int*)lds_raw;
        for (int blk = bid; blk < NTOK / 64; blk += G) {
            if (!route) {
                for (int r8 = 0; r8 < 8; ++r8) { const int m = blk * 64 + wid * 8 + r8; rms_row_bf16(hres + (size_t)m * D, g, HN + (size_t)m * D, lane); }
            } else {
                float wr[16][8];
                { const float* wr_ = IN(20);
#pragma unroll
                  for (int j = 0; j < 4; ++j)
#pragma unroll
                    for (int q = 0; q < 4; ++q) { const f32x4 w0 = *(const f32x4*)(wr_ + (size_t)(4 * (lane + 64 * j) + q) * 8), w1 = *(const f32x4*)(wr_ + (size_t)(4 * (lane + 64 * j) + q) * 8 + 4);
                        wr[j * 4 + q][0] = w0.x; wr[j * 4 + q][1] = w0.y; wr[j * 4 + q][2] = w0.z; wr[j * 4 + q][3] = w0.w; wr[j * 4 + q][4] = w1.x; wr[j * 4 + q][5] = w1.y; wr[j * 4 + q][6] = w1.z; wr[j * 4 + q][7] = w1.w; } }
                f32x4 gv[4];
#pragma unroll
                for (int j = 0; j < 4; ++j) gv[j] = ((const f32x4*)g)[lane + 64 * j];
#pragma unroll 1
                for (int r8 = 0; r8 < 8; ++r8) {
                    const int tl = wid * 8 + r8, m = blk * 64 + tl; const f32x4* xr = (const f32x4*)(hres + (size_t)m * D);
                    f32x4 v[4]; float s = 0.f;
#pragma unroll
                    for (int j = 0; j < 4; ++j) { v[j] = xr[lane + 64 * j]; s += (v[j].x * v[j].x + v[j].y * v[j].y) + (v[j].z * v[j].z + v[j].w * v[j].w); }
                    const float r = 1.0f / sqrtf(wave_sum(s) * (1.0f / D) + 1e-6f);
                    float lg[8] = {0.f, 0.f, 0.f, 0.f, 0.f, 0.f, 0.f, 0.f};
#pragma unroll
                    for (int j = 0; j < 4; ++j) { const float y[4] = {v[j].x * r * gv[j].x, v[j].y * r * gv[j].y, v[j].z * r * gv[j].z, v[j].w * r * gv[j].w};
#pragma unroll
                        for (int q = 0; q < 4; ++q)
#pragma unroll
                            for (int e = 0; e < 8; ++e) lg[e] += y[q] * wr[j * 4 + q][e]; }
#pragma unroll
                    for (int e = 0; e < 8; ++e) lg[e] = wave_sum(lg[e]);
                    if (lane == 0) {
                        int e1 = 0; float l1 = lg[0];
#pragma unroll
                        for (int e = 1; e < 8; ++e) if (lg[e] > l1) { l1 = lg[e]; e1 = e; }
                        int e2 = -1; float l2 = -3.0e38f;
#pragma unroll
                        for (int e = 0; e < 8; ++e) if (e != e1 && lg[e] > l2) { l2 = lg[e]; e2 = e; }
                        const float g1 = 1.0f / (1.0f + fexp(l2 - l1));
                        TOKE[m * 2] = e1; TOKE[m * 2 + 1] = e2; TOKG[m * 2] = g1; TOKG[m * 2 + 1] = 1.0f - g1;
                        sel[tl * 2] = e1; sel[tl * 2 + 1] = e2; RSTD[m] = r;
                    }
                }
                __syncthreads();
                if (tid < NE) { int cnt = 0; for (int q = 0; q < 128; ++q) if (sel[q] == tid) { TOKR[blk * 128 + q] = cnt; ++cnt; } BCNT[blk * NE + tid] = cnt; }
                __syncthreads();
            }
        }
    } break;

    case PH_FFNUP: {
        PHASE_ENTER
        pg8::Gemm g{HN, (const bf16*)(ws + WS_WGU), NTOK, 2 * DFF, D}; pg8::StaticOrder S; S.init(NTOK, 2 * DFF, G, bid);
        pg8::fill_rstd_table((PG8_LAS unsigned char*)lds_raw, S, SSP0, tid);
        pg8::EpiSwigluR E{HID, DFF, (const PG8_LAS float*)((PG8_LAS unsigned char*)lds_raw + pg8::RSTD_TAB_OFF)};
        pg8::gemm_phase<pg8::EpiSwigluR, pg8::StaticOrder, true, true>((PG8_LAS unsigned char*)lds_raw, g, S, E, tid);
    } break;

    case PH_FFNDOWN: {
        PHASE_ENTER
        pg8::Gemm g{HID, (const bf16*)(ws + WS_WD), NTOK, D, DFF}; pg8::StaticOrder S; S.init(NTOK, D, G, bid);
        pg8::EpiResidStats E{hres, dry ? (float*)(ws + 340 * MiB) : hres, HN, SSP1};
        pg8::gemm_phase<pg8::EpiResidStats, pg8::StaticOrder, true, true>((PG8_LAS unsigned char*)lds_raw, g, S, E, tid);
    } break;

    case PH_DISPATCH: {
        PHASE_ENTER
        int* sh = (int*)lds_raw;
        const f32x4* gr = (const f32x4*)(IN(16) + D);
        for (int blk = bid; blk < NTOK / 64; blk += G) {
            { int* cnts = sh + 64;
              for (int i = tid; i < (NTOK / 64) * NE; i += NT) cnts[i] = BCNT[i];
              __syncthreads();
              { const int e = wid; int sall = 0, slt = 0;
#pragma unroll
                for (int i = 0; i < 4; ++i) { const int b2 = 4 * lane + i, c = cnts[b2 * NE + e]; sall += c; slt += (b2 < blk) ? c : 0; }
#pragma unroll
                for (int o = 1; o < 64; o <<= 1) { sall += __shfl_xor(sall, o); slt += __shfl_xor(slt, o); }
                if (lane == 0) { sh[e] = sall; sh[16 + e] = slt; sh[24 + e] = (sall + 255) >> 8; } } }
            __syncthreads();
            if (tid == 0) { int acc = 0; for (int e = 0; e < NE; ++e) { sh[8 + e] = acc * 256; acc += sh[24 + e]; } sh[32] = acc; }
            __syncthreads();
            if (tid < 128) { const int m = blk * 64 + (tid >> 1); const int e = TOKE[blk * 128 + tid]; const int r = sh[8 + e] + sh[16 + e] + TOKR[blk * 128 + tid];
                ROWDST[r] = m * 2 + (tid & 1); ROWG[r] = TOKG[blk * 128 + tid]; }
            for (int r8 = 0; r8 < 8; ++r8) {
                const int m = blk * 64 + wid * 8 + r8; const int e0 = TOKE[m * 2], e1 = TOKE[m * 2 + 1];
                const int r0 = sh[8 + e0] + sh[16 + e0] + TOKR[m * 2], r1 = sh[8 + e1] + sh[16 + e1] + TOKR[m * 2 + 1];
                const float rs = RSTD[m]; const f32x4* xr = (const f32x4*)(hres + (size_t)m * D);
                unsigned* o0 = (unsigned*)(XR + (size_t)r0 * D); unsigned* o1 = (unsigned*)(XR + (size_t)r1 * D);
#pragma unroll
                for (int j = 0; j < 4; ++j) { const f32x4 v = xr[lane + 64 * j], gv = gr[lane + 64 * j]; const unsigned w = pg8::pk4_fp8(v.x * rs * gv.x, v.y * rs * gv.y, v.z * rs * gv.z, v.w * rs * gv.w); o0[lane + 64 * j] = w; o1[lane + 64 * j] = w; }
            }
            if (blk == 0) {
                for (int e = 0; e < NE; ++e) { const int lo = sh[8 + e] + sh[e], hi = sh[8 + e] + sh[24 + e] * 256; for (int r = lo + tid; r < hi; r += NT) { ROWDST[r] = -1; ROWG[r] = 0.f; } }
                if (tid < MAXTILES) { int e = 0; for (int q = 0; q < NE; ++q) if (tid * 256 >= sh[8 + q]) e = q; TILEE[tid] = e; }
                if (tid == 0) TILEE[MAXTILES] = sh[32];
            }
            __syncthreads();
        }
    } break;

    case PH_MOEUP: {
        PHASE_ENTER
        const int ntiles = __builtin_amdgcn_readfirstlane(__hip_atomic_load(TILEE + MAXTILES, __ATOMIC_RELAXED, __HIP_MEMORY_SCOPE_AGENT));
        pg8::Gemm g{(const bf16*)XR, (const bf16*)(ws + WS_W13), 0, 0, D / 2}; pg8::MoeOrder S; S.init(ntiles, DFFE / 128, G, bid, 0, 0, TILEE);
        pg8::EpiSwiglu8 E{HIDE, DFFE, 1.0f / W13_SCALE, HID_SCALE};
        pg8::gemm_phase<pg8::EpiSwiglu8, pg8::MoeOrder, true, true, true>((PG8_LAS unsigned char*)lds_raw, g, S, E, tid);
    } break;

    case PH_MOEDOWN: {
        PHASE_ENTER
        const int ntiles = __builtin_amdgcn_readfirstlane(__hip_atomic_load(TILEE + MAXTILES, __ATOMIC_RELAXED, __HIP_MEMORY_SCOPE_AGENT));
        pg8::Gemm g{(const bf16*)HIDE, (const bf16*)(ws + WS_W2), 0, 0, DFFE / 2}; pg8::MoeOrder S; S.init(ntiles, D / 256, G, bid, 0, 0, TILEE);
        pg8::EpiMoeDown E{OUT2, ROWDST, ROWG, 1.0f / (W2_SCALE * HID_SCALE)};
        pg8::gemm_phase<pg8::EpiMoeDown, pg8::MoeOrder, true, true, true>((PG8_LAS unsigned char*)lds_raw, g, S, E, tid);
    } break;

    case PH_FINAL: {
        PHASE_ENTER
        const float* g = IN(24); const int gw = bid * 8 + wid, NGW = G * 8;
        for (int m = gw; m < NTOK; m += NGW) {
            f32x4* xr = (f32x4*)(hres + (size_t)m * D); const f32x4* gr = (const f32x4*)g;
            const u32x2* o0 = (const u32x2*)(OUT2 + (size_t)(2 * m) * D); const u32x2* o1 = (const u32x2*)(OUT2 + (size_t)(2 * m + 1) * D);
            f32x4 v[4]; float s = 0.f;
#pragma unroll
            for (int j = 0; j < 4; ++j) {
                v[j] = xr[lane + 64 * j]; const u32x2 p = o0[lane + 64 * j], q = o1[lane + 64 * j];
                v[j].x += bf2f(p.x & 0xffffu) + bf2f(q.x & 0xffffu); v[j].y += bf2f(p.x >> 16) + bf2f(q.x >> 16);
                v[j].z += bf2f(p.y & 0xffffu) + bf2f(q.y & 0xffffu); v[j].w += bf2f(p.y >> 16) + bf2f(q.y >> 16);
                s += (v[j].x * v[j].x + v[j].y * v[j].y) + (v[j].z * v[j].z + v[j].w * v[j].w);
            }
            const float r = 1.0f / sqrtf(wave_sum(s) * (1.0f / D) + 1e-6f);
#pragma unroll
            for (int j = 0; j < 4; ++j) { const f32x4 gv = gr[lane + 64 * j]; (dry ? (f32x4*)((float*)(ws + 340 * MiB) + (size_t)m * D) : xr)[lane + 64 * j] = (f32x4){v[j].x * r * gv.x, v[j].y * r * gv.y, v[j].z * r * gv.z, v[j].w * r * gv.w}; }
        }
    } break;
    }
    if (phase == PH_INPROJ || phase == PH_FFNUP || phase == PH_DISPATCH) {
        int t_ = wid_s * 64 + lane_id_asm(); asm volatile("" : "+v"(t_));
        __attribute__((address_space(1))) unsigned char* wsq_ = (__attribute__((address_space(1))) unsigned char*)a.ws; asm volatile("" : "+s"(wsq_)); unsigned char* ws_ = (unsigned char*)wsq_; int G_ = gridDim.x; asm volatile("" : "+s"(G_));
        bg_convert(ws_, lds_raw, IN(21), IN(22), IN(23), step, G_, t_, phase == PH_DISPATCH);
    }
    if (step + 1 < a.ph_hi) { int t_ = wid_s * 64 + lane_id_asm(); asm volatile("" : "+v"(t_)); xcd_barrier(bar, t_ == 0); }
#ifdef REP_STEP
    if (dry) { --rep_left; --step; }
#endif
    }
}

constexpr int NSTEPS = 18;
#ifndef MK_PER_PHASE
#define MK_PER_PHASE 0
#endif

extern "C" void kernel_launch(void* const* d_in, const int* in_sizes, int n_in, void* d_out, int out_size, void* d_ws, size_t ws_size, hipStream_t stream) {
    static int grid = 0;
    if (grid == 0) {
        if (n_in != 25 || out_size != NTOK * D || ws_size < WS_END + 2 * MiB) { fprintf(stderr, "kernel_launch: unexpected shapes (n_in %d out %d ws %zu need %zu)\n", n_in, out_size, ws_size, (size_t)WS_END); grid = -1; return; }
        int dev = 0, cus = 0, per_cu = 0;
        if (hipGetDevice(&dev) != hipSuccess || hipDeviceGetAttribute(&cus, hipDeviceAttributeMultiprocessorCount, dev) != hipSuccess) { grid = -1; return; }
        if (hipFuncSetAttribute((const void*)fwd, hipFuncAttributeMaxDynamicSharedMemorySize, LDS_BYTES) != hipSuccess) { fprintf(stderr, "kernel_launch: hipFuncSetAttribute failed\n"); grid = -1; return; }
        if (hipOccupancyMaxActiveBlocksPerMultiprocessor(&per_cu, (const void*)fwd, NT, LDS_BYTES) != hipSuccess || per_cu < 1) { fprintf(stderr, "kernel_launch: occupancy query says %d blocks/CU\n", per_cu); (void)hipGetLastError(); grid = -1; return; }
        grid = cus;
    }
    if (grid < 0) return;
    hipMemsetAsync((char*)d_ws + WS_CTL, 0, 1 * MiB, stream);
    Args a{};
    for (int i = 0; i < 25; ++i) a.in[i] = (const float*)d_in[i];
    a.out = (float*)d_out; a.ws = (unsigned char*)d_ws;
#if MK_PER_PHASE
    for (int s = 0; s < NSTEPS; ++s) { a.ph_lo = s; a.ph_hi = s + 1; hipLaunchKernelGGL(fwd, dim3(grid), dim3(NT), LDS_BYTES, stream, a); }
#else
    a.ph_lo = 0; a.ph_hi = NSTEPS;
    hipLaunchKernelGGL(fwd, dim3(grid), dim3(NT), LDS_BYTES, stream, a);
#endif
}
```

```cpp
#include <hip/hip_runtime.h>
#include <cstdint>
#include <cstdio>

typedef unsigned short bf16;
typedef short bf16x8 __attribute__((ext_vector_type(8)));
typedef float f32x4 __attribute__((ext_vector_type(4)));
typedef unsigned u32x4 __attribute__((ext_vector_type(4)));
typedef unsigned u32x2 __attribute__((ext_vector_type(2)));

constexpr int NTOK = 16384, SEQ = 8192, D = 1024, DIN = 2560, GW = 256, HD = 64, DFF = 2816, DFFE = 3584, NE = 8;
constexpr int CH = 64, NCHUNK = NTOK / CH, CPB = SEQ / CH;
constexpr int NT = 512;
constexpr float W13_SCALE = 64.f, W2_SCALE = 128.f, HID_SCALE = 8.f;
constexpr int MAXTILES = NTOK * 2 / 256 + NE;

constexpr size_t MiB = 1u << 20;
constexpr size_t WS_CTL = 0;
constexpr size_t WS_SMALL = 1 * MiB;
constexpr size_t WS_WIN = 5 * MiB;
constexpr size_t WS_WOUT = 15 * MiB;
constexpr size_t WS_WGU = 19 * MiB;
constexpr size_t WS_WD = 30 * MiB;
constexpr size_t WS_W13 = 36 * MiB;
constexpr size_t WS_W2 = 92 * MiB;
constexpr size_t WS_ACT = 120 * MiB;
constexpr size_t WS_HN = WS_ACT;
constexpr size_t WS_PROJ = WS_ACT + 32 * MiB;
constexpr size_t WS_Y = WS_ACT + 112 * MiB;
constexpr size_t WS_DS = WS_ACT + 144 * MiB;
constexpr size_t WS_HID = WS_PROJ;
constexpr size_t WS_XR = WS_ACT;
constexpr size_t WS_HIDE = WS_ACT + 34 * MiB;
constexpr size_t WS_OUT2 = WS_ACT + 153 * MiB;
constexpr size_t WS_END = WS_ACT + 217 * MiB;
constexpr size_t SM_TOKE = 0;
constexpr size_t SM_TOKG = 128 * 1024;
constexpr size_t SM_TOKR = 256 * 1024;
constexpr size_t SM_BCNT = 384 * 1024;
constexpr size_t SM_ROWTOK = 400 * 1024;
constexpr size_t SM_ROWDST = 544 * 1024;
constexpr size_t SM_ROWG = 688 * 1024;
constexpr size_t SM_TILEE = 832 * 1024;
constexpr size_t SM_CARA = 1024 * 1024;
constexpr size_t SM_CARH = 1280 * 1024;
constexpr size_t SM_CIN = 1536 * 1024;
constexpr size_t SM_DEC = 1792 * 1024;
constexpr size_t SM_RSTD = 2048 * 1024;
constexpr size_t SM_WTA = 2304 * 1024;
constexpr size_t SM_WTX = 2368 * 1024;
constexpr size_t SM_TOKROW = 2560 * 1024;
constexpr size_t SM_WTP = 2432 * 1024;

struct Args {
    const float* in[25];
    float* out;
    unsigned char* ws;
    int ph_lo, ph_hi, pad0, pad1;
};

__device__ __forceinline__ int lane_id_asm() { int l; asm volatile("v_mbcnt_lo_u32_b32 %0, -1, 0\n\tv_mbcnt_hi_u32_b32 %0, -1, %0" : "=v"(l)); return l; }
typedef const float __attribute__((address_space(1)))* gfptr_t;
__device__ __forceinline__ const float* IN(int k) { asm volatile("" : "+s"(k)); const gfptr_t p = ((const gfptr_t __attribute__((address_space(4)))*)__builtin_amdgcn_kernarg_segment_ptr())[k]; return (const float*)p; }
__device__ __forceinline__ float bf2f(unsigned v) { return __uint_as_float(v << 16); }
__device__ __forceinline__ unsigned f2bf(float f) { unsigned u = __float_as_uint(f); return (u + 0x7fffu + ((u >> 16) & 1u)) >> 16; }
__device__ __forceinline__ unsigned pk2(float lo, float hi) { return f2bf(lo) | (f2bf(hi) << 16); }
__device__ __forceinline__ float fexp(float x) { return __builtin_amdgcn_exp2f(1.44269504089f * x); }
__device__ __forceinline__ float flog(float x) { return 0.69314718056f * __builtin_amdgcn_logf(x); }
__device__ __forceinline__ float sigmoidf_(float x) { return __builtin_amdgcn_rcpf(1.0f + __builtin_amdgcn_exp2f(-1.44269504089f * x)); }
__device__ __forceinline__ float siluf_(float x) { return x * sigmoidf_(x); }
__device__ __forceinline__ float gelu_tanh(float x) { const float u = 1.5957691216057308f * (x + 0.044715f * x * x * x); return x * sigmoidf_(u); }
__device__ __forceinline__ float neg_expm1_small(float x) { return -x * (1.0f + x * (0.5f + x * (0.16666667f + x * (0.041666668f + x * 0.0083333338f)))); }
__device__ __forceinline__ float wave_sum(float v) {
#pragma unroll
    for (int o = 1; o < 64; o <<= 1) v += __shfl_xor(v, o);
    return v;
}
#define LDS_WAIT() asm volatile("s_waitcnt lgkmcnt(0)" ::: "memory")

namespace pg8 {
#define PG8_LAS __attribute__((address_space(3)))
typedef unsigned short bf16_t;
typedef short bf16x8 __attribute__((ext_vector_type(8)));
typedef float f32x4 __attribute__((ext_vector_type(4)));
typedef unsigned u32x4 __attribute__((ext_vector_type(4)));
constexpr int BM = 256, BK = 64, HALF = 128, HTB = HALF * BK * 2  , STAGE_BYTES = 8 * HTB, NXCD = 8, WGM = 8;

__host__ __device__ __forceinline__ int lds_byte(int r, int c) { const int st = (r >> 4) * 2 + (c >> 5), rr = r & 15, cc = c & 31, ob = rr * 64 + cc * 2; return st * 1024 + (ob ^ (((ob >> 9) & 1) << 5)); }
__host__ __device__ __forceinline__ void stage_rc(int b, int& R, int& C) { const int st = b / 1024, sb = b % 1024, swz = sb ^ (((sb >> 9) & 1) << 5); R = (st >> 1) * 16 + swz / 64; C = (st & 1) * 32 + (swz % 64) / 2; }
__host__ __device__ __forceinline__ int perm32(int rho) { const int n = rho >> 4, i = rho & 15; return 8 * (i >> 2) + 4 * n + (i & 3); }

struct Unit { int pm, pn, pa, pb, ord, koff; };
struct Gemm { const bf16_t* A; const bf16_t* Bt; int M, N, K; int LD; };

struct StaticOrder {
    int nM, nN, nwg, G, c;
    __host__ __device__ void init(int M, int N, int G_, int c_) { nM = M / BM; nN = N / BM; nwg = nM * nN; G = G_; c = c_; }
    __host__ __device__ bool next(int i, Unit& u) const {
        const long L = (long)i * G + c; if (L >= nwg) return false;
        int wgid = (int)L; { const int q = nwg / NXCD, r = nwg % NXCD, xcd = wgid % NXCD, off = wgid / NXCD; wgid = (xcd < r ? xcd * (q + 1) : r * (q + 1) + (xcd - r) * q) + off; }
        const int nig = WGM * nN, gid = wgid / nig, fm = gid * WGM, gsz = (nM - fm) < WGM ? (nM - fm) : WGM;
        u.pm = fm + ((wgid % nig) % gsz); u.pn = (wgid % nig) / gsz; u.pa = u.pm; u.pb = u.pn; u.ord = i; u.koff = 0; return true;
    }
    __device__ __forceinline__ void a_ready(const Unit&) const {}
    __device__ __forceinline__ void done(const Unit&) const {}
};

__device__ __forceinline__ unsigned cvt_pk_bf16(float lo, float hi) { unsigned r; asm volatile("v_cvt_pk_bf16_f32 %0, %1, %2" : "=v"(r) : "v"(lo), "v"(hi)); return r; }
typedef float f32x2 __attribute__((ext_vector_type(2)));
typedef int pg8_v8i __attribute__((ext_vector_type(8))); typedef int pg8_v4i __attribute__((ext_vector_type(4)));
__device__ __forceinline__ pg8_v8i pg8_cat(bf16x8 lo, bf16x8 hi) { return __builtin_shufflevector(__builtin_bit_cast(pg8_v4i, lo), __builtin_bit_cast(pg8_v4i, hi), 0, 1, 2, 3, 4, 5, 6, 7); }
__device__ __forceinline__ void pg8_mfma8(f32x4& acc, pg8_v8i a, pg8_v8i b, int sc) { asm volatile("v_mfma_scale_f32_16x16x128_f8f6f4 %0, %1, %2, %0, %3, %3 op_sel_hi:[0,0,0]" : "+v"(acc) : "v"(a), "v"(b), "v"(sc)); }
template <class Epi, class Sched, bool ALIGN_EPI = false, bool SP2 = false, bool F8 = false>
__device__ __forceinline__ void gemm_phase(PG8_LAS unsigned char* lds, const Gemm g, const Sched& S, const Epi& E, int tid_in) {
    int tid = tid_in; asm volatile("" : "+v"(tid));
    const int wid = __builtin_amdgcn_readfirstlane(tid >> 6), lane = tid & 63, wr = wid >> 2, wc = wid & 3, fr = lane & 15, fq = lane >> 4;
    const int K = g.LD ? g.LD : g.K, nt = g.K / BK;
    unsigned voffA[2], voffB[2];
#pragma unroll
    for (int i = 0; i < 2; ++i) { int R, C; stage_rc(tid * 16 + i * 8192, R, C); const int Rb = Epi::PERM ? ((R & ~31) + perm32(R & 31)) : R;
        voffA[i] = (unsigned)(R * K + C) * 2u; voffB[i] = (unsigned)(Rb * K + C) * 2u; }
    const size_t kstep = (size_t)(BK * 2);
    const size_t hstep = (size_t)HALF * K * 2;
    const size_t tstep = 2 * hstep;
    const unsigned ldsw = (unsigned)wid * 1024u;
    int f8one = 0x7f7f7f7f; asm volatile("" : "+v"(f8one));
    constexpr int KOFF = 1024;
    const int aoff = lds_byte(wr * 64 + fr, fq * 8), boff = lds_byte(wc * 32 + fr, fq * 8);
#define PG8_SA(b, h) (((b) * 2 + (h)) * HTB)
#define PG8_SB(b, h) ((4 + (b) * 2 + (h)) * HTB)
#define PG8_STAGE(bufoff, gbase, voff) do { _Pragma("unroll") for (int _i = 0; _i < 2; ++_i) \
        __builtin_amdgcn_global_load_lds((const unsigned*)((const char*)(gbase) + (voff)[_i]), (PG8_LAS unsigned*)(lds + (bufoff) + ldsw + _i * 8192), 16, 0, 0); } while (0)
#define PG8_LDA(dst, b, h) do { _Pragma("unroll") for (int m = 0; m < 4; ++m) _Pragma("unroll") for (int k = 0; k < 2; ++k) dst[m][k] = *(const PG8_LAS bf16x8*)(lds + PG8_SA(b, h) + aoff + m * 2048 + k * KOFF); } while (0)
#define PG8_LDB(dst, b, h) do { _Pragma("unroll") for (int n = 0; n < 2; ++n) _Pragma("unroll") for (int k = 0; k < 2; ++k) dst[n][k] = *(const PG8_LAS bf16x8*)(lds + PG8_SB(b, h) + boff + n * 2048 + k * KOFF); } while (0)
#define PG8_MMA(ai, bj, At, Bt) do { __builtin_amdgcn_s_setprio(1); if constexpr (F8) { _Pragma("unroll") for (int m = 0; m < 4; ++m) _Pragma("unroll") for (int n = 0; n < 2; ++n) \
        pg8_mfma8(acc[ai][bj][m][n], pg8_cat(Bt[n][0], Bt[n][1]), pg8_cat(At[m][0], At[m][1]), f8one); } \
    else { _Pragma("unroll") for (int m = 0; m < 4; ++m) _Pragma("unroll") for (int n = 0; n < 2; ++n) _Pragma("unroll") for (int k = 0; k < 2; ++k) \
        acc[ai][bj][m][n] = __builtin_amdgcn_mfma_f32_16x16x32_bf16(Bt[n][k], At[m][k], acc[ai][bj][m][n], 0, 0, 0); } __builtin_amdgcn_s_setprio(0); } while (0)
#define PG8_WAIT_V(n) asm volatile("s_waitcnt vmcnt(" #n ")" ::: "memory")
#define PG8_WAIT_L(n) asm volatile("s_waitcnt lgkmcnt(" #n ")" ::: "memory")
#define PG8_BAR __builtin_amdgcn_s_barrier()
#define PG8_SCHED __builtin_amdgcn_sched_barrier(0)
    Unit cur, nxt; int ui = 0;
    if (!S.next(0, cur)) return;
    f32x4 acc[2][2][4][2];
    if constexpr (Epi::ACC_INIT) E.init(acc, cur, wr, wc, fr, fq);
    else {
#pragma unroll
    for (int a = 0; a < 2; ++a)
#pragma unroll
        for (int b = 0; b < 2; ++b)
#pragma unroll
            for (int m = 0; m < 4; ++m)
#pragma unroll
                for (int n = 0; n < 2; ++n) acc[a][b][m][n] = (f32x4){0.f, 0.f, 0.f, 0.f};
    }
    bf16x8 At[4][2], B0[2][2], B1[2][2];
    const char* cA = (const char*)g.A + (size_t)cur.pa * tstep + cur.koff; const char* cB = (const char*)g.Bt + (size_t)cur.pb * tstep + cur.koff;
    S.a_ready(cur);
    if constexpr (SP2) {
        PG8_STAGE(PG8_SB(0, 0), cB, voffB); PG8_STAGE(PG8_SB(0, 1), cB + hstep, voffB); PG8_STAGE(PG8_SA(0, 0), cA, voffA); PG8_STAGE(PG8_SA(0, 1), cA + hstep, voffA);
        if (wr == 1) PG8_BAR;
        PG8_WAIT_V(2); PG8_BAR;
        PG8_STAGE(PG8_SB(1, 0), cB + kstep, voffB); PG8_STAGE(PG8_SA(1, 0), cA + kstep, voffA); PG8_STAGE(PG8_SB(1, 1), cB + hstep + kstep, voffB);
        PG8_WAIT_V(6); PG8_BAR;
    } else {
        PG8_STAGE(PG8_SB(0, 0), cB, voffB); PG8_STAGE(PG8_SA(0, 0), cA, voffA); PG8_STAGE(PG8_SB(0, 1), cB + hstep, voffB); PG8_STAGE(PG8_SA(0, 1), cA + hstep, voffA);
        if (wr == 1) PG8_BAR;
        PG8_WAIT_V(4); PG8_BAR;
        PG8_STAGE(PG8_SB(1, 0), cB + kstep, voffB); PG8_STAGE(PG8_SA(1, 0), cA + kstep, voffA); PG8_STAGE(PG8_SB(1, 1), cB + hstep + kstep, voffB);
        PG8_WAIT_V(6); PG8_BAR;
    }
    for (;;) {
        const bool has_next = S.next(ui + 1, nxt);
        const char* nA = has_next ? (const char*)g.A + (size_t)nxt.pa * tstep + nxt.koff : cA; const char* nB = has_next ? (const char*)g.Bt + (size_t)nxt.pb * tstep + nxt.koff : cB;
        for (int t = 0; t < nt; t += 2) {
            const bool last = (t == nt - 2);
            const char* a1 = cA + (size_t)(t + 1) * kstep;
            const char* a2 = last ? nA : cA + (size_t)(t + 2) * kstep; const char* b2 = last ? nB : cB + (size_t)(t + 2) * kstep;
            const char* a3 = a2 + kstep; const char* b3 = b2 + kstep;
            if (last && has_next) S.a_ready(nxt);
            if constexpr (SP2) {
            PG8_LDB(B0, 0, 0); PG8_LDB(B1, 0, 1); PG8_SCHED; PG8_LDA(At, 0, 0); PG8_STAGE(PG8_SA(1, 1), a1 + hstep, voffA);
            PG8_WAIT_V(8); PG8_WAIT_L(0); PG8_BAR; PG8_MMA(0, 0, At, B0); PG8_MMA(0, 1, At, B1); PG8_BAR; PG8_SCHED;
            PG8_LDA(At, 0, 1); PG8_STAGE(PG8_SB(0, 0), b2, voffB); PG8_STAGE(PG8_SB(0, 1), b2 + hstep, voffB); PG8_STAGE(PG8_SA(0, 0), a2, voffA);
            PG8_WAIT_V(8); PG8_WAIT_L(0); PG8_BAR; PG8_MMA(1, 0, At, B0); PG8_MMA(1, 1, At, B1); PG8_BAR; PG8_SCHED;
            PG8_LDB(B0, 1, 0); PG8_LDB(B1, 1, 1); PG8_SCHED; PG8_LDA(At, 1, 0); PG8_STAGE(PG8_SA(0, 1), a2 + hstep, voffA);
            PG8_WAIT_V(8); PG8_WAIT_L(0); PG8_BAR; PG8_MMA(0, 0, At, B0); PG8_MMA(0, 1, At, B1); PG8_BAR; PG8_SCHED;
            PG8_LDA(At, 1, 1); PG8_STAGE(PG8_SB(1, 0), b3, voffB); PG8_STAGE(PG8_SB(1, 1), b3 + hstep, voffB); PG8_STAGE(PG8_SA(1, 0), a3, voffA);
            PG8_WAIT_V(8); PG8_WAIT_L(0); PG8_BAR; PG8_MMA(1, 0, At, B0); PG8_MMA(1, 1, At, B1); PG8_BAR; PG8_SCHED;
            } else {
            PG8_LDB(B0, 0, 0); PG8_SCHED; PG8_LDA(At, 0, 0); PG8_STAGE(PG8_SA(1, 1), a1 + hstep, voffA);
            PG8_WAIT_L(8); PG8_BAR; PG8_WAIT_L(0); PG8_MMA(0, 0, At, B0); PG8_BAR; PG8_SCHED;
            PG8_LDB(B1, 0, 1); PG8_STAGE(PG8_SB(0, 0), b2, voffB);
            PG8_BAR; PG8_WAIT_L(0); PG8_MMA(0, 1, At, B1); PG8_BAR;
            PG8_LDA(At, 0, 1); PG8_STAGE(PG8_SA(0, 0), a2, voffA);
            PG8_BAR; PG8_WAIT_L(0); PG8_MMA(1, 0, At, B0); PG8_BAR; PG8_SCHED;
            PG8_STAGE(PG8_SB(0, 1), b2 + hstep, voffB);
            PG8_WAIT_V(6); PG8_BAR; PG8_MMA(1, 1, At, B1); PG8_BAR;
            PG8_LDB(B0, 1, 0); PG8_SCHED; PG8_LDA(At, 1, 0); PG8_STAGE(PG8_SA(0, 1), a2 + hstep, voffA);
            PG8_WAIT_L(8); PG8_BAR; PG8_WAIT_L(0); PG8_MMA(0, 0, At, B0); PG8_BAR; PG8_SCHED;
            PG8_LDB(B1, 1, 1); PG8_STAGE(PG8_SB(1, 0), b3, voffB);
            PG8_BAR; PG8_WAIT_L(0); PG8_MMA(0, 1, At, B1); PG8_BAR;
            PG8_LDA(At, 1, 1); PG8_STAGE(PG8_SA(1, 0), a3, voffA);
            PG8_BAR; PG8_WAIT_L(0); PG8_MMA(1, 0, At, B0); PG8_BAR; PG8_SCHED;
            PG8_STAGE(PG8_SB(1, 1), b3 + hstep, voffB);
            PG8_WAIT_V(6); PG8_BAR; PG8_MMA(1, 1, At, B1); PG8_BAR;
            }
        }
        if constexpr (F8) asm volatile("s_nop 15\n\ts_nop 15" ::: "memory");
        if constexpr (ALIGN_EPI) { if (wr == 0) PG8_BAR; }
        if constexpr (!Epi::AFTER_DRAIN) { E(acc, cur, wr, wc, fr, fq); S.done(cur); }
        if (!has_next) break;
#pragma unroll
        for (int a = 0; a < 2; ++a)
#pragma unroll
            for (int b = 0; b < 2; ++b)
#pragma unroll
                for (int m = 0; m < 4; ++m)
#pragma unroll
                    for (int n = 0; n < 2; ++n) acc[a][b][m][n] = (f32x4){0.f, 0.f, 0.f, 0.f};
        cur = nxt; cA = nA; cB = nB; ++ui;
        if constexpr (ALIGN_EPI) { if (wr == 1) PG8_BAR; }
    }
    PG8_WAIT_V(0);
    if constexpr (!ALIGN_EPI) { if (wr == 0) PG8_BAR; }
    PG8_BAR;
    if constexpr (Epi::AFTER_DRAIN) { E.fused(acc, cur, wr, wc, fr, fq, lds, wid, lane); S.done(cur); }
#undef PG8_SA
#undef PG8_SB
#undef PG8_STAGE
#undef PG8_LDA
#undef PG8_LDB
#undef PG8_MMA
#undef PG8_WAIT_V
#undef PG8_WAIT_L
#undef PG8_BAR
#undef PG8_SCHED
}

struct EpiStoreBf16 {
    static constexpr bool PERM = true, AFTER_DRAIN = false, ACC_INIT = false;
    bf16_t* O; int ldc;
    __device__ __forceinline__ void operator()(const f32x4 (&acc)[2][2][4][2], const Unit& u, int wr, int wc, int fr, int fq) const {
        const int row0 = u.pm * BM + wr * 64 + fr, col0 = u.pn * BM + wc * 32 + 8 * fq;
#pragma unroll
        for (int ai = 0; ai < 2; ++ai)
#pragma unroll
            for (int m = 0; m < 4; ++m) { bf16_t* rowp = O + (size_t)(row0 + ai * HALF + m * 16) * ldc + col0;
#pragma unroll
                for (int bj = 0; bj < 2; ++bj) { const f32x4 v0 = acc[ai][bj][m][0], v1 = acc[ai][bj][m][1];
                    u32x4 w; w.x = cvt_pk_bf16(v0[0], v0[1]); w.y = cvt_pk_bf16(v0[2], v0[3]); w.z = cvt_pk_bf16(v1[0], v1[1]); w.w = cvt_pk_bf16(v1[2], v1[3]);
                    *(u32x4*)(rowp + bj * HALF) = w; } }
    }
};
struct EpiResidF32 {
    static constexpr bool PERM = false, AFTER_DRAIN = false, ACC_INIT = true;
    const float* base; float* out;
    __device__ __forceinline__ void init(f32x4 (&acc)[2][2][4][2], const Unit& u, int wr, int wc, int fr, int fq) const {
        const int row0 = u.pm * BM + wr * 64 + fr, col0 = u.pn * BM + wc * 32 + 4 * fq;
#pragma unroll
        for (int ai = 0; ai < 2; ++ai)
#pragma unroll
            for (int m = 0; m < 4; ++m) { const size_t off = (size_t)(row0 + ai * HALF + m * 16) * 1024 + col0;
#pragma unroll
                for (int bj = 0; bj < 2; ++bj)
#pragma unroll
                    for (int n = 0; n < 2; ++n) acc[ai][bj][m][n] = *(const f32x4*)(base + off + bj * HALF + n * 16); }
    }
    __device__ __forceinline__ void operator()(const f32x4 (&acc)[2][2][4][2], const Unit& u, int wr, int wc, int fr, int fq) const {
        const int row0 = u.pm * BM + wr * 64 + fr, col0 = u.pn * BM + wc * 32 + 4 * fq;
#pragma unroll
        for (int ai = 0; ai < 2; ++ai)
#pragma unroll
            for (int m = 0; m < 4; ++m) { const size_t off = (size_t)(row0 + ai * HALF + m * 16) * 1024 + col0;
#pragma unroll
                for (int bj = 0; bj < 2; ++bj)
#pragma unroll
                    for (int n = 0; n < 2; ++n) *(f32x4*)(out + off + bj * HALF + n * 16) = acc[ai][bj][m][n]; }
    }
};
__device__ __forceinline__ float silu_f(float x) { return x * __builtin_amdgcn_rcpf(1.0f + __builtin_amdgcn_exp2f(-1.44269504089f * x)); }
struct EpiSwiglu {
    static constexpr bool PERM = true, AFTER_DRAIN = false, ACC_INIT = false;
    bf16_t* C; int ldc; int row_off;
    __device__ __forceinline__ void operator()(const f32x4 (&acc)[2][2][4][2], const Unit& u, int wr, int wc, int fr, int fq) const {
        const int row0 = u.pm * BM + wr * 64 + fr - row_off, col0 = u.pn * HALF + wc * 32 + 8 * fq;
#pragma unroll
        for (int ai = 0; ai < 2; ++ai)
#pragma unroll
            for (int m = 0; m < 4; ++m) { bf16_t* rowp = C + (size_t)(row0 + ai * HALF + m * 16) * ldc + col0;
                const f32x4 g0 = acc[ai][0][m][0], g1 = acc[ai][0][m][1], u0 = acc[ai][1][m][0], u1 = acc[ai][1][m][1];
                u32x4 w; w.x = cvt_pk_bf16(silu_f(g0[0]) * u0[0], silu_f(g0[1]) * u0[1]); w.y = cvt_pk_bf16(silu_f(g0[2]) * u0[2], silu_f(g0[3]) * u0[3]);
                w.z = cvt_pk_bf16(silu_f(g1[0]) * u1[0], silu_f(g1[1]) * u1[1]); w.w = cvt_pk_bf16(silu_f(g1[2]) * u1[2], silu_f(g1[3]) * u1[3]);
                *(u32x4*)rowp = w; }
    }
};
struct EpiMoeDown {
    static constexpr bool PERM = true, AFTER_DRAIN = false, ACC_INIT = false;
    bf16_t* out2; const int* rowdst; const float* rowg; float sc;
    __device__ __forceinline__ void operator()(const f32x4 (&acc)[2][2][4][2], const Unit& u, int wr, int wc, int fr, int fq) const {
        const int row0 = u.pm * BM + wr * 64 + fr, col0 = u.pn * BM + wc * 32 + 8 * fq;
#pragma unroll
        for (int ai = 0; ai < 2; ++ai)
#pragma unroll
            for (int m = 0; m < 4; ++m) { const int gr = row0 + ai * HALF + m * 16; const int d = rowdst[gr]; const float g = rowg[gr] * sc;
                if (d >= 0) { bf16_t* rowp = out2 + (size_t)d * 1024 + col0;
#pragma unroll
                    for (int bj = 0; bj < 2; ++bj) { const f32x4 v0 = acc[ai][bj][m][0] * g, v1 = acc[ai][bj][m][1] * g;
                        u32x4 w; w.x = cvt_pk_bf16(v0[0], v0[1]); w.y = cvt_pk_bf16(v0[2], v0[3]); w.z = cvt_pk_bf16(v1[0], v1[1]); w.w = cvt_pk_bf16(v1[2], v1[3]);
                        *(u32x4*)(rowp + bj * HALF) = w; } } }
    }
};


struct EpiResidStats {
    static constexpr bool PERM = false, AFTER_DRAIN = false, ACC_INIT = true;
    const float* base; float* out; bf16_t* hn; float* ssp;
    __device__ __forceinline__ void init(f32x4 (&acc)[2][2][4][2], const Unit& u, int wr, int wc, int fr, int fq) const {
        const int row0 = u.pm * BM + wr * 64 + fr, col0 = u.pn * BM + wc * 32 + 4 * fq;
#pragma unroll
        for (int ai = 0; ai < 2; ++ai)
#pragma unroll
            for (int m = 0; m < 4; ++m) { const size_t off = (size_t)(row0 + ai * HALF + m * 16) * 1024 + col0;
#pragma unroll
                for (int bj = 0; bj < 2; ++bj)
#pragma unroll
                    for (int n = 0; n < 2; ++n) acc[ai][bj][m][n] = *(const f32x4*)(base + off + bj * HALF + n * 16); }
    }
    __device__ __forceinline__ void operator()(const f32x4 (&acc)[2][2][4][2], const Unit& u, int wr, int wc, int fr, int fq) const {
        const int row0 = u.pm * BM + wr * 64 + fr, col0 = u.pn * BM + wc * 32 + 4 * fq; typedef unsigned u32x2e __attribute__((ext_vector_type(2)));
#pragma unroll
        for (int ai = 0; ai < 2; ++ai)
#pragma unroll
            for (int m = 0; m < 4; ++m) { const int row = row0 + ai * HALF + m * 16; const size_t off = (size_t)row * 1024 + col0; float ss = 0.f;
#pragma unroll
                for (int bj = 0; bj < 2; ++bj)
#pragma unroll
                    for (int n = 0; n < 2; ++n) { const f32x4 v = acc[ai][bj][m][n]; *(f32x4*)(out + off + bj * HALF + n * 16) = v;
                        ss += (v[0] * v[0] + v[1] * v[1]) + (v[2] * v[2] + v[3] * v[3]); u32x2e w; w.x = cvt_pk_bf16(v[0], v[1]); w.y = cvt_pk_bf16(v[2], v[3]); *(u32x2e*)(hn + off + bj * HALF + n * 16) = w; }
                ss += __shfl_xor(ss, 16); ss += __shfl_xor(ss, 32);
                if (fq == 0) ssp[(size_t)row * 16 + u.pn * 4 + wc] = ss; }
    }
};
constexpr int RSTD_TAB_OFF = STAGE_BYTES;
template <class Sched> __device__ __forceinline__ void fill_rstd_table(PG8_LAS unsigned char* lds, const Sched& S, const float* ssp, int tid) {
    PG8_LAS float* tab = (PG8_LAS float*)(lds + RSTD_TAB_OFF); Unit u;
    for (int i = 0; S.next(i, u); ++i)
        if (tid < 256) { const int row = u.pm * BM + tid; const f32x4* p = (const f32x4*)(ssp + (size_t)row * 16); const f32x4 a = p[0], b = p[1], c = p[2], d = p[3];
            const float s = (((a[0] + a[1]) + (a[2] + a[3])) + ((b[0] + b[1]) + (b[2] + b[3]))) + (((c[0] + c[1]) + (c[2] + c[3])) + ((d[0] + d[1]) + (d[2] + d[3])));
            tab[i * 256 + tid] = 1.0f / sqrtf(s * (1.0f / 1024.0f) + 1e-6f); }
    __syncthreads();
}
struct EpiStoreBf16R {
    static constexpr bool PERM = true, AFTER_DRAIN = false, ACC_INIT = false;
    bf16_t* O; int ldc; const PG8_LAS float* tab;
    __device__ __forceinline__ void operator()(const f32x4 (&acc)[2][2][4][2], const Unit& u, int wr, int wc, int fr, int fq) const {
        const int row0 = u.pm * BM + wr * 64 + fr, col0 = u.pn * BM + wc * 32 + 8 * fq;
#pragma unroll
        for (int ai = 0; ai < 2; ++ai)
#pragma unroll
            for (int m = 0; m < 4; ++m) { const int row = row0 + ai * HALF + m * 16; const float r = tab[u.ord * 256 + wr * 64 + fr + ai * HALF + m * 16]; bf16_t* rowp = O + (size_t)row * ldc + col0;
#pragma unroll
                for (int bj = 0; bj < 2; ++bj) { const f32x4 v0 = acc[ai][bj][m][0] * r, v1 = acc[ai][bj][m][1] * r;
                    u32x4 w; w.x = cvt_pk_bf16(v0[0], v0[1]); w.y = cvt_pk_bf16(v0[2], v0[3]); w.z = cvt_pk_bf16(v1[0], v1[1]); w.w = cvt_pk_bf16(v1[2], v1[3]);
                    *(u32x4*)(rowp + bj * HALF) = w; } }
    }
};
struct EpiSwigluR {
    static constexpr bool PERM = true, AFTER_DRAIN = false, ACC_INIT = false;
    bf16_t* C; int ldc; const PG8_LAS float* tab;
    __device__ __forceinline__ void operator()(const f32x4 (&acc)[2][2][4][2], const Unit& u, int wr, int wc, int fr, int fq) const {
        const int row0 = u.pm * BM + wr * 64 + fr, col0 = u.pn * HALF + wc * 32 + 8 * fq;
#pragma unroll
        for (int ai = 0; ai < 2; ++ai)
#pragma unroll
            for (int m = 0; m < 4; ++m) { const int row = row0 + ai * HALF + m * 16; const float r = tab[u.ord * 256 + wr * 64 + fr + ai * HALF + m * 16]; bf16_t* rowp = C + (size_t)row * ldc + col0;
                const f32x4 g0 = acc[ai][0][m][0] * r, g1 = acc[ai][0][m][1] * r, u0 = acc[ai][1][m][0] * r, u1 = acc[ai][1][m][1] * r;
                u32x4 w; w.x = cvt_pk_bf16(silu_f(g0[0]) * u0[0], silu_f(g0[1]) * u0[1]); w.y = cvt_pk_bf16(silu_f(g0[2]) * u0[2], silu_f(g0[3]) * u0[3]);
                w.z = cvt_pk_bf16(silu_f(g1[0]) * u1[0], silu_f(g1[1]) * u1[1]); w.w = cvt_pk_bf16(silu_f(g1[2]) * u1[2], silu_f(g1[3]) * u1[3]);
                *(u32x4*)rowp = w; }
    }
};
__device__ __forceinline__ unsigned pk4_fp8(float a, float b, float c, float d) { int w = __builtin_amdgcn_cvt_pk_fp8_f32(a, b, 0, false); w = __builtin_amdgcn_cvt_pk_fp8_f32(c, d, w, true); return (unsigned)w; }
struct EpiSwiglu8 {
    static constexpr bool PERM = true, AFTER_DRAIN = false, ACC_INIT = false;
    unsigned char* C; int ldc; float isc, osc;
    __device__ __forceinline__ void operator()(const f32x4 (&acc)[2][2][4][2], const Unit& u, int wr, int wc, int fr, int fq) const {
        const int row0 = u.pm * BM + wr * 64 + fr, col0 = u.pn * HALF + wc * 32 + 8 * fq; const float us = isc * osc;
#pragma unroll
        for (int ai = 0; ai < 2; ++ai)
#pragma unroll
            for (int m = 0; m < 4; ++m) { unsigned char* rowp = C + (size_t)(row0 + ai * HALF + m * 16) * ldc + col0;
                const f32x4 g0 = acc[ai][0][m][0] * isc, g1 = acc[ai][0][m][1] * isc, u0 = acc[ai][1][m][0] * us, u1 = acc[ai][1][m][1] * us;
                typedef unsigned u32x2e __attribute__((ext_vector_type(2))); u32x2e w;
                w.x = pk4_fp8(silu_f(g0[0]) * u0[0], silu_f(g0[1]) * u0[1], silu_f(g0[2]) * u0[2], silu_f(g0[3]) * u0[3]);
                w.y = pk4_fp8(silu_f(g1[0]) * u1[0], silu_f(g1[1]) * u1[1], silu_f(g1[2]) * u1[2], silu_f(g1[3]) * u1[3]);
                *(u32x2e*)rowp = w; }
    }
};
struct MoeOrder {
    StaticOrder so; int tlo, nN, a_off; const int* tilee;
    __device__ void init(int nrt, int nN_, int G, int c, int tlo_, int a_off_, const int* tilee_) { so.init(nrt * BM, nN_ * BM, G, c); tlo = tlo_; nN = nN_; a_off = a_off_; tilee = tilee_; }
    __device__ bool next(int i, Unit& u) const { if (!so.next(i, u)) return false; u.pm += tlo; u.pa = u.pm - a_off; const int e = __builtin_amdgcn_readfirstlane(__hip_atomic_load(tilee + u.pm, __ATOMIC_RELAXED, __HIP_MEMORY_SCOPE_AGENT)); u.pb = e * nN + u.pn; return true; }
    __device__ __forceinline__ void a_ready(const Unit&) const {}
    __device__ __forceinline__ void done(const Unit&) const {}
};

struct MoeTailOrder {
    int t0, ntail, nN, S, G, c, kbytes; const int* tilee;
    __device__ bool next(int i, Unit& u) const {
        const int L = i * G + c; if (L >= ntail * nN * S) return false;
        const int piece = L % S, q = L / S, pn = q % nN, tl = q / nN;
        u.pm = t0 + tl; u.pn = pn; u.pa = u.pm; const int e = __builtin_amdgcn_readfirstlane(__hip_atomic_load(tilee + u.pm, __ATOMIC_RELAXED, __HIP_MEMORY_SCOPE_AGENT));
        u.pb = e * nN + pn; u.ord = tl * S + piece; u.koff = piece * kbytes; return true; }
    __device__ __forceinline__ void a_ready(const Unit&) const {}
    __device__ __forceinline__ void done(const Unit&) const {}
};
struct EpiPartF32 {
    static constexpr bool PERM = false, AFTER_DRAIN = false, ACC_INIT = false;
    float* part;
    __device__ __forceinline__ void operator()(const f32x4 (&acc)[2][2][4][2], const Unit& u, int wr, int wc, int fr, int fq) const {
        const int row0 = wr * 64 + fr, col0 = u.pn * BM + wc * 32 + 4 * fq; float* base = part + (size_t)u.ord * 256 * 1024;
#pragma unroll
        for (int ai = 0; ai < 2; ++ai)
#pragma unroll
            for (int m = 0; m < 4; ++m) { const size_t off = (size_t)(row0 + ai * HALF + m * 16) * 1024 + col0;
#pragma unroll
                for (int bj = 0; bj < 2; ++bj)
#pragma unroll
                    for (int n = 0; n < 2; ++n) *(f32x4*)(base + off + bj * HALF + n * 16) = acc[ai][bj][m][n]; }
    }
};
}

__device__ __forceinline__ void cvt_item(const float* W, int K, int N, bf16* WT, int mode, int item, float* scr, int lane, const float* gk = nullptr) {
    const int nblk = N / 32, kb = item / nblk, nb = item % nblk, k0 = 64 * kb, n0 = 32 * nb;
    { f32x4 v[8]; const float* src = W + (size_t)(k0 + (lane >> 3)) * N + n0 + 4 * (lane & 7);
#pragma unroll
      for (int i = 0; i < 8; ++i) v[i] = __builtin_nontemporal_load((const f32x4*)(src + (size_t)(8 * i) * N));
#pragma unroll
      for (int i = 0; i < 8; ++i) { float* d = scr + (8 * i + (lane >> 3)) * 33 + 4 * (lane & 7); const float gg = gk ? gk[k0 + 8 * i + (lane >> 3)] : 1.0f; d[0] = v[i].x * gg; d[1] = v[i].y * gg; d[2] = v[i].z * gg; d[3] = v[i].w * gg; } }
    LDS_WAIT();
    const int c = lane & 7;
#pragma unroll
    for (int j = 0; j < 4; ++j) {
        const int n = (lane >> 3) + 8 * j; const float* s = scr + (8 * c) * 33 + n;
        u32x4 o; o.x = pk2(s[0 * 33], s[1 * 33]); o.y = pk2(s[2 * 33], s[3 * 33]); o.z = pk2(s[4 * 33], s[5 * 33]); o.w = pk2(s[6 * 33], s[7 * 33]);
        const int nn = n0 + n; const int drow = mode == 0 ? nn : ((nn >> 7) * 256 + (nn & 127) + (mode == 2 ? 128 : 0));
        *(u32x4*)(WT + (size_t)drow * K + k0 + 8 * c) = o;
    }
    LDS_WAIT();
}

__device__ __forceinline__ void cvt_item8(const float* W, int K, int N, unsigned char* WT, int mode, int item, float* scr, int lane, float scale) {
    const int nblk = N / 32, kb = item / nblk, nb = item % nblk, k0 = 128 * kb, n0 = 32 * nb;
    { f32x4 v[16]; const float* src = W + (size_t)(k0 + (lane >> 3)) * N + n0 + 4 * (lane & 7);
#pragma unroll
      for (int i = 0; i < 16; ++i) v[i] = __builtin_nontemporal_load((const f32x4*)(src + (size_t)(8 * i) * N));
#pragma unroll
      for (int i = 0; i < 16; ++i) { float* d = scr + (8 * i + (lane >> 3)) * 33 + 4 * (lane & 7); d[0] = v[i].x * scale; d[1] = v[i].y * scale; d[2] = v[i].z * scale; d[3] = v[i].w * scale; } }
    LDS_WAIT();
    const int c = lane & 7;
#pragma unroll
    for (int j = 0; j < 4; ++j) {
        const int n = (lane >> 3) + 8 * j; const float* s = scr + (16 * c) * 33 + n;
        u32x4 o; o.x = pg8::pk4_fp8(s[0 * 33], s[1 * 33], s[2 * 33], s[3 * 33]); o.y = pg8::pk4_fp8(s[4 * 33], s[5 * 33], s[6 * 33], s[7 * 33]);
        o.z = pg8::pk4_fp8(s[8 * 33], s[9 * 33], s[10 * 33], s[11 * 33]); o.w = pg8::pk4_fp8(s[12 * 33], s[13 * 33], s[14 * 33], s[15 * 33]);
        const int nn = n0 + n; const int drow = mode == 0 ? nn : ((nn >> 7) * 256 + (nn & 127) + (mode == 2 ? 128 : 0));
        __builtin_nontemporal_store(o, (u32x4*)(WT + (size_t)drow * K + k0 + 16 * c));
    }
    LDS_WAIT();
}

__device__ __forceinline__ void rms_row_bf16(const float* xrow, const float* g, bf16* orow, int lane) {
    const f32x4* xr = (const f32x4*)xrow; const f32x4* gr = (const f32x4*)g;
    f32x4 v[4]; float s = 0.f;
#pragma unroll
    for (int j = 0; j < 4; ++j) { v[j] = xr[lane + 64 * j]; s += (v[j].x * v[j].x + v[j].y * v[j].y) + (v[j].z * v[j].z + v[j].w * v[j].w); }
    const float r = 1.0f / sqrtf(wave_sum(s) * (1.0f / D) + 1e-6f);
    u32x2* o8 = (u32x2*)orow;
#pragma unroll
    for (int j = 0; j < 4; ++j) { const f32x4 gv = gr[lane + 64 * j]; u32x2 w; w.x = pk2(v[j].x * r * gv.x, v[j].y * r * gv.y); w.y = pk2(v[j].z * r * gv.z, v[j].w * r * gv.w); o8[lane + 64 * j] = w; }
}

#define LAS __attribute__((address_space(3)))
#define XB_TMO      128
#define XB_XCNT(j)  (256  + 64 * (j))
#define XB_XSUB(j)  (1280 + 64 * (j))
#define XB_XGEN(j)  (2304 + 64 * (j))
#define XB_TOP      3328
#define XB_TOPGEN   3392
#define XCD_BAR_WORDS 3456
#define XB_SPIN_CAP (1u << 22)
__device__ __forceinline__ unsigned xb_ld(unsigned* p)              { return __hip_atomic_load(p, __ATOMIC_RELAXED, __HIP_MEMORY_SCOPE_AGENT); }
__device__ __forceinline__ unsigned xb_add(unsigned* p, unsigned v) { return __hip_atomic_fetch_add(p, v, __ATOMIC_RELAXED, __HIP_MEMORY_SCOPE_AGENT); }
__device__ __forceinline__ unsigned xb_xcc_id() { return (unsigned)__builtin_amdgcn_s_getreg((3 << 11) | 20) & 0xFu; }
#define XB_SPIN(cond, bar) do { unsigned _sp = 0; while (cond) { __builtin_amdgcn_s_sleep(1); \
    if ((++_sp & 255u) == 0u) { if (xb_ld(&(bar)[XB_TMO])) break; if (_sp > XB_SPIN_CAP) { atomicAdd(&(bar)[XB_TMO], 1u); break; } } } } while (0)
struct XcdBarrier { unsigned* bar; unsigned x; volatile LAS unsigned* st; };
__device__ __forceinline__ XcdBarrier xcd_barrier_post(unsigned* bar, volatile LAS unsigned* st) {
    XcdBarrier b; b.bar = bar; b.x = xb_xcc_id(); b.st = st;
    if (threadIdx.x == 0) (void)xb_add(&bar[XB_XCNT(b.x)], 1u);
    return b;
}
__device__ __forceinline__ void xcd_barrier_complete(unsigned* bar, unsigned x, unsigned& nloc, unsigned& nx) {
    const unsigned G = gridDim.x * gridDim.y * gridDim.z;
    unsigned sum, cnt, mine, sp = 0u;
    for (;;) {
        sum = 0u; cnt = 0u; mine = 0u;
#pragma unroll
        for (unsigned j = 0; j < 16; ++j) { const unsigned c = xb_ld(&bar[XB_XCNT(j)]); sum += c; cnt += (c > 0u) ? 1u : 0u; mine = (j == x) ? c : mine; }
        if (sum == G) break;
        __builtin_amdgcn_s_sleep(1);
        if ((++sp & 255u) == 0u) { if (xb_ld(&bar[XB_TMO])) break; if (sp > XB_SPIN_CAP) { atomicAdd(&bar[XB_TMO], 1u); break; } }
    }
    nloc = mine > 0u ? mine : 1u; nx = cnt > 0u ? cnt : 1u;
}
__device__ __forceinline__ void xcd_barrier(const XcdBarrier& b, bool leader) {
    asm volatile("s_waitcnt vmcnt(0)" ::: "memory");
    __syncthreads();
    if (leader) {
        unsigned* bar = b.bar;
        __builtin_amdgcn_s_waitcnt(0);
        unsigned nloc = b.st[0], nx = b.st[1];
        if (nloc == 0u) { xcd_barrier_complete(bar, b.x, nloc, nx); b.st[0] = nloc; b.st[1] = nx; }
        const unsigned old = xb_add(&bar[XB_XSUB(b.x)], 1u);
        const unsigned gen = old / nloc;
        if (old + 1u == (gen + 1u) * nloc) {
            __builtin_amdgcn_fence(__ATOMIC_RELEASE, "agent");
            asm volatile("s_waitcnt vmcnt(0)" ::: "memory");
            const unsigned og = xb_add(&bar[XB_TOP], 1u);
            const unsigned tg = og / nx;
            if (og + 1u == (tg + 1u) * nx) xb_add(&bar[XB_TOPGEN], 1u);
            else XB_SPIN(xb_ld(&bar[XB_TOPGEN]) == tg, bar);
            __builtin_amdgcn_fence(__ATOMIC_ACQUIRE, "agent");
            xb_add(&bar[XB_XGEN(b.x)], 1u);
            asm volatile("s_waitcnt vmcnt(0)" ::: "memory");
        } else {
            XB_SPIN(xb_ld(&bar[XB_XGEN(b.x)]) == gen, bar);
            __builtin_amdgcn_fence(__ATOMIC_ACQUIRE, "agent");
            asm volatile("s_waitcnt vmcnt(0)" ::: "memory");
        }
    }
    __syncthreads();
}
constexpr int LDS_BYTES = 163840, RING_BYTES = LDS_BYTES - 512, MISC_OFF = RING_BYTES + 320;
constexpr int CW_BAR = 4096;

enum Phase { PH_PROLOGUE = 0, PH_INPROJ, PH_MIX1, PH_MIX2, PH_MIX3, PH_OUTPROJ, PH_NORM, PH_FFNUP, PH_FFNDOWN, PH_DISPATCH, PH_MOEUP, PH_MOEDOWN, PH_FINAL };


constexpr int RS = 528;
constexpr int AINB_STRIDE = RS;
constexpr int VTS = 144;
template <int NLD> __device__ __forceinline__ void slab_load(u32x4 (&reg)[NLD], const bf16* src, int nrows, int rvalid0, int tid) {
#pragma unroll
    for (int j = 0; j < NLD; ++j) { const int i = tid + j * NT, r = i >> 5, ch = i & 31; reg[j] = (u32x4){0u, 0u, 0u, 0u}; if (i < nrows * 32 && r >= rvalid0) reg[j] = *(const u32x4*)(src + (ptrdiff_t)r * DIN + ch * 8); }
}
template <int NLD> __device__ __forceinline__ void slab_store(const u32x4 (&reg)[NLD], unsigned char* dst, int nrows, int tid) {
#pragma unroll
    for (int j = 0; j < NLD; ++j) { const int i = tid + j * NT, r = i >> 5, ch = i & 31; if (i < nrows * 32) *(u32x4*)(dst + r * RS + ch * 16) = reg[j]; }
}
__device__ __forceinline__ void ytile_store(const unsigned char* src, bf16* y, int tid) {
    asm volatile("" : "+v"(tid) :: "memory");
#pragma unroll
    for (int j = 0; j < 4; ++j) { const int i = tid + j * NT, r = i >> 5, ch = i & 31; *(u32x4*)(y + (size_t)r * D + ch * 8) = *(const u32x4*)(src + r * RS + ch * 16); }
}
__device__ __forceinline__ int vt_off(int c, int tok) { return c * VTS + ((tok ^ (((c >> 3) & 7) << 3)) << 1); }
__device__ __forceinline__ void vt_store(const u32x4 (&reg)[4], unsigned char* vt, int tid) {
#pragma unroll
    for (int j = 0; j < 4; ++j) { const int i = tid + j * NT, r = i >> 5, ch = i & 31, c0 = ch * 8; const unsigned w[4] = {reg[j].x, reg[j].y, reg[j].z, reg[j].w};
#pragma unroll
        for (int q = 0; q < 8; ++q) *(bf16*)(vt + vt_off(c0 + q, r)) = (bf16)((q & 1) ? (w[q >> 1] >> 16) : (w[q >> 1] & 0xffffu)); }
}
struct LruParams { bf16x8 wa[2], wx[2]; float lam, ba, bx, cb, cw[4]; };
__device__ __forceinline__ void lru_params_load(LruParams& p, const bf16* wta, const bf16* wtx, const float* conv_w, const float* conv_b, const float* b_a, const float* b_x, const float* lam, int h, int nt, int lane) {
    asm volatile("" : "+v"(lane));
    const int fr = lane & 15, fq = lane >> 4, c = 64 * h + 16 * nt + fr;
#pragma unroll
    for (int ks = 0; ks < 2; ++ks) { p.wa[ks] = *(const bf16x8*)(wta + (size_t)(h * 64 + 16 * nt + fr) * 64 + 32 * ks + 8 * fq); p.wx[ks] = *(const bf16x8*)(wtx + (size_t)(h * 64 + 16 * nt + fr) * 64 + 32 * ks + 8 * fq); }
    p.lam = lam[c]; p.ba = b_a[c]; p.bx = b_x[c]; p.cb = conv_b[c];
#pragma unroll
    for (int k = 0; k < 4; ++k) p.cw[k] = conv_w[k * GW + c];
}
__device__ __forceinline__ void lru_ainb(const unsigned char* ax, const float* conv_w, const float* conv_b, unsigned char* ainb, int tid) {
    for (int idx = tid; idx < CH * 128; idx += NT) {
        const int t = idx >> 7, c = (idx & 127) * 2; float a0 = conv_b[c], a1 = conv_b[c + 1];
#pragma unroll
        for (int k = 0; k < 4; ++k) { const unsigned w = *(const unsigned*)(ax + (t + k) * RS + c * 2); a0 += conv_w[k * GW + c] * bf2f(w & 0xffffu); a1 += conv_w[k * GW + c + 1] * bf2f(w >> 16); }
        *(unsigned*)(ainb + t * RS + c * 2) = pk2(a0, a1);
    }
}
__device__ __forceinline__ void lru_gates(const unsigned char* ainb, const unsigned char* ax, const LruParams& p, int h, int nt, int lane, float (&av)[4][4], float (&uv)[4][4]) {
    const int fr = lane & 15, fq = lane >> 4, c = 64 * h + 16 * nt + fr;
    f32x4 aa[4], ax4[4];
#pragma unroll
    for (int mt = 0; mt < 4; ++mt) { aa[mt] = (f32x4){0.f, 0.f, 0.f, 0.f}; ax4[mt] = (f32x4){0.f, 0.f, 0.f, 0.f};
#pragma unroll
        for (int ks = 0; ks < 2; ++ks) { const bf16x8 x = *(const bf16x8*)(ainb + (16 * mt + fr) * RS + (64 * h + 32 * ks + 8 * fq) * 2);
            aa[mt] = __builtin_amdgcn_mfma_f32_16x16x32_bf16(x, p.wa[ks], aa[mt], 0, 0, 0); ax4[mt] = __builtin_amdgcn_mfma_f32_16x16x32_bf16(x, p.wx[ks], ax4[mt], 0, 0, 0); } }
    const float sp = log1pf(fexp(-p.lam));
#pragma unroll
    for (int mt = 0; mt < 4; ++mt)
#pragma unroll
        for (int r = 0; r < 4; ++r) { const int t = 16 * mt + 4 * fq + r; const float rg = sigmoidf_(aa[mt][r] + p.ba), ig = sigmoidf_(ax4[mt][r] + p.bx); const float loga = -8.0f * rg * sp;
            const float x2 = 2.0f * loga; const float m2 = x2 > -0.25f ? neg_expm1_small(x2) : -expm1f(x2);
            float xin = p.cb;
#pragma unroll
            for (int k = 0; k < 4; ++k) xin += p.cw[k] * bf2f(*(const bf16*)(ax + (t + k) * RS + c * 2));
            av[mt][r] = fexp(loga); uv[mt][r] = __builtin_amdgcn_sqrtf(fmaxf(m2, 0.f)) * ig * xin; }
}

constexpr int CW_CVTQ = 2048, CW_DONE = 8192;
constexpr int BG_IE1 = 8 * 112, BG_IE2 = 28 * 32, BG_ITEMS = 2 * NE * BG_IE1 + NE * BG_IE2, BG_BATCHES = BG_ITEMS / 8;
__device__ __forceinline__ void bg_convert(unsigned char* ws, unsigned char* lds_raw, const float* w1, const float* w3, const float* w2, int step, int G, int tid, bool drain) {
    unsigned* ctl = (unsigned*)(ws + WS_CTL); volatile unsigned* shq = (volatile unsigned*)(lds_raw + RING_BYTES);
    const int wid = tid >> 6, lane = tid & 63; float* scr = (float*)lds_raw + wid * (128 * 33);
    __syncthreads();
    if (tid == 0 && !drain) __hip_atomic_fetch_add(ctl + CW_DONE + 64 * step, 1u, __ATOMIC_RELAXED, __HIP_MEMORY_SCOPE_AGENT);
    for (;;) {
        if (tid == 0) { unsigned b = BG_BATCHES;
            if (drain || __hip_atomic_load(ctl + CW_DONE + 64 * step, __ATOMIC_RELAXED, __HIP_MEMORY_SCOPE_AGENT) + 16u < (unsigned)G) b = __hip_atomic_fetch_add(ctl + CW_CVTQ, 1u, __ATOMIC_RELAXED, __HIP_MEMORY_SCOPE_AGENT);
            shq[0] = b; }
        __syncthreads();
        const unsigned b = shq[0];
        __syncthreads();
        if (b >= (unsigned)BG_BATCHES) break;
        const int q = (int)b * 8 + wid;
        if (q < NE * BG_IE1) { const int e = q / BG_IE1, r = q % BG_IE1; cvt_item8(w1 + (size_t)e * D * DFFE, D, DFFE, ws + WS_W13 + (size_t)e * 2 * DFFE * D, 1, r, scr, lane, W13_SCALE); }
        else if (q < 2 * NE * BG_IE1) { const int q2 = q - NE * BG_IE1, e = q2 / BG_IE1, r = q2 % BG_IE1; cvt_item8(w3 + (size_t)e * D * DFFE, D, DFFE, ws + WS_W13 + (size_t)e * 2 * DFFE * D, 2, r, scr, lane, W13_SCALE); }
        else { const int q2 = q - 2 * NE * BG_IE1, e = q2 / BG_IE2, r = q2 % BG_IE2; cvt_item8(w2 + (size_t)e * DFFE * D, DFFE, D, ws + WS_W2 + (size_t)e * D * DFFE, 0, r, scr, lane, W2_SCALE); }
    }
}

__host__ __device__ __forceinline__ int moe_tail_split(int ntail) { return ntail * 4 * 7 <= 256 ? 7 : (ntail * 4 * 2 <= 256 ? 2 : 1); }

#define HN ((bf16*)(ws + WS_HN))
#define PROJ ((bf16*)(ws + WS_PROJ))
#define Y ((bf16*)(ws + WS_Y))
#define DS ((float*)(ws + WS_DS))
#define HID ((bf16*)(ws + WS_HID))
#define HIDE ((unsigned char*)(ws + WS_HIDE))
#define OUT2 ((bf16*)(ws + WS_OUT2))
#define XR ((unsigned char*)(ws + WS_XR))
#define SSP0 ((float*)(ws + WS_END))
#define SSP1 ((float*)(ws + WS_END + MiB))
#define PART ((float*)(ws + WS_END + 3 * MiB))
#define TOKROW SMALLP(int, SM_TOKROW)
#define SMALLP(T, off) ((T*)(ws + WS_SMALL + (off)))
#define RSTD SMALLP(float, SM_RSTD)
#define TOKE SMALLP(int, SM_TOKE)
#define TOKG SMALLP(float, SM_TOKG)
#define TOKR SMALLP(int, SM_TOKR)
#define BCNT SMALLP(int, SM_BCNT)
#define ROWDST SMALLP(int, SM_ROWDST)
#define ROWG SMALLP(float, SM_ROWG)
#define TILEE SMALLP(int, SM_TILEE)
#define CARA SMALLP(float, SM_CARA)
#define CARH SMALLP(float, SM_CARH)
#define CIN SMALLP(float, SM_CIN)
#define DEC SMALLP(float, SM_DEC)
#define WTA SMALLP(bf16, SM_WTA)
#define WTX SMALLP(bf16, SM_WTX)
#define WTP SMALLP(bf16, SM_WTP)
#define PHASE_ENTER int tid = wid_s * 64 + lane_id_asm(); asm volatile("" : "+v"(tid)); const int lane = tid & 63, wid = tid >> 6; __attribute__((address_space(1))) unsigned char* wsg_ = (__attribute__((address_space(1))) unsigned char*)a.ws; asm volatile("" : "+s"(wsg_)); unsigned char* ws = (unsigned char*)wsg_; \
    __attribute__((address_space(1))) float* hresg_ = (__attribute__((address_space(1))) float*)a.out; asm volatile("" : "+s"(hresg_)); float* hres = (float*)hresg_; \
    int bid = blockIdx.x; asm volatile("" : "+s"(bid)); int G = gridDim.x; asm volatile("" : "+s"(G)); (void)lane; (void)wid; (void)hres; (void)bid; (void)G;

__global__ void __launch_bounds__(NT) fwd(Args a) {
    extern __shared__ __attribute__((aligned(16))) unsigned char lds_raw[];
    float* ldsf = (float*)lds_raw;
    const int wid_s = __builtin_amdgcn_readfirstlane(threadIdx.x >> 6);
    { const int tid0 = threadIdx.x; for (int u = tid0; u < (LDS_BYTES - RING_BYTES) / 4; u += NT) ((LAS unsigned*)((LAS unsigned char*)lds_raw + RING_BYTES))[u] = 0u; }
    __syncthreads();
    XcdBarrier bar = xcd_barrier_post((unsigned*)(a.ws + WS_CTL) + CW_BAR, (volatile LAS unsigned*)((LAS unsigned char*)lds_raw + MISC_OFF) + 8);

#ifdef REP_STEP
    int rep_left = REP_N;
#endif
    for (int step = a.ph_lo; step < a.ph_hi; ++step) {
#ifdef REP_STEP
    const bool dry = (step == REP_STEP && rep_left > 0);
#else
    constexpr bool dry = false;
#endif
    int phase, L, pass = 0;
    if (step == 0) { phase = PH_PROLOGUE; L = 0; }
    else if (step < 8) { L = 0; const int s = step - 1; phase = s < 5 ? PH_INPROJ + s : s == 5 ? PH_FFNUP : PH_FFNDOWN; }
    else { L = 1; const int s = step - 8; phase = s < 5 ? PH_INPROJ + s : s == 5 ? PH_NORM : s == 6 ? PH_DISPATCH : s == 7 ? PH_MOEUP : s == 8 ? PH_MOEDOWN : PH_FINAL; }
#ifdef REP_NOP
    if (dry) phase = 1000;
#endif
    switch (phase) {
    case PH_PROLOGUE: {
        PHASE_ENTER
        float* scr = ldsf + wid * (128 * 33);
        const int gw = bid * 8 + wid, NGW = G * 8;
        constexpr int I_IN = 16 * 80, I_OUT = 16 * 32, I_G = 16 * 88, I_D = 44 * 32;
        constexpr int T0 = 2 * I_IN, T1 = T0 + 2 * I_OUT, T2 = T1 + I_G, T3 = T2 + I_G, T4 = T3 + I_D;
        for (int it = gw; it < T4; it += NGW) {
            if (it < T0) { const int l = it / I_IN, r = it % I_IN; cvt_item(IN(1) + (size_t)l * D * DIN, D, DIN, (bf16*)(ws + WS_WIN) + (size_t)l * DIN * D, 0, r, scr, lane, l == 1 ? IN(15) + D : nullptr); }
            else if (it < T1) { const int q = it - T0, l = q / I_OUT, r = q % I_OUT; cvt_item(IN(2) + (size_t)l * D * D, D, D, (bf16*)(ws + WS_WOUT) + (size_t)l * D * D, 0, r, scr, lane); }
            else if (it < T2) { cvt_item(IN(17), D, DFF, (bf16*)(ws + WS_WGU), 1, it - T1, scr, lane, IN(16)); }
            else if (it < T3) { cvt_item(IN(18), D, DFF, (bf16*)(ws + WS_WGU), 2, it - T2, scr, lane, IN(16)); }
            else { cvt_item(IN(19), DFF, D, (bf16*)(ws + WS_WD), 0, it - T3, scr, lane); }
        }
        for (int m = gw; m < NTOK; m += NGW) rms_row_bf16(IN(0) + (size_t)m * D, IN(15), HN + (size_t)m * D, lane);
        for (int idx = bid * NT + tid; idx < 3 * 2 * 4 * HD * HD; idx += G * NT) {
            const int mat = idx / (2 * 4 * HD * HD), r = idx % (2 * 4 * HD * HD), lh = r >> 12, j = (r >> 6) & 63, i = r & 63;
            const float* w = mat == 0 ? IN(5) : mat == 1 ? IN(7) : IN(12);
            (mat == 0 ? WTA : mat == 1 ? WTX : WTP)[r] = (bf16)f2bf(w[(lh * 64 + i) * 64 + j]);
        }
    } break;

    case PH_INPROJ: {
        PHASE_ENTER
        pg8::Gemm g{HN, (const bf16*)(ws + WS_WIN) + (size_t)L * DIN * D, NTOK, DIN, D, 0}; pg8::StaticOrder S; S.init(NTOK, DIN, G, bid);
        if (L == 0) { pg8::EpiStoreBf16 E{PROJ, DIN}; pg8::gemm_phase<pg8::EpiStoreBf16, pg8::StaticOrder, true, true>((PG8_LAS unsigned char*)lds_raw, g, S, E, tid); }
        else { pg8::fill_rstd_table((PG8_LAS unsigned char*)lds_raw, S, SSP1, tid); pg8::EpiStoreBf16R E{PROJ, DIN, (const PG8_LAS float*)((PG8_LAS unsigned char*)lds_raw + pg8::RSTD_TAB_OFF)}; pg8::gemm_phase<pg8::EpiStoreBf16R, pg8::StaticOrder, true, true>((PG8_LAS unsigned char*)lds_raw, g, S, E, tid); }
    } break;

    case PH_MIX1: {
        PHASE_ENTER
        const float* conv_w = IN(3) + L * 4 * GW; const float* conv_b = IN(4) + L * GW;
        const float* b_a = IN(6) + L * GW; const float* b_x = IN(8) + L * GW;
        const float* lam = IN(9) + L * GW; const float* lbp = IN(10);
        unsigned char* AX = lds_raw; unsigned char* AINB = lds_raw + 35376; unsigned char* FS = lds_raw + 69168; unsigned char* VTl = lds_raw + 102960; float* TOTl = (float*)(lds_raw + 139824);
        unsigned char* KHTl = lds_raw;
        for (int ci = bid; ci < NCHUNK; ci += G) {
            const int t0 = (ci % CPB) * CH, g0 = ci * CH; const bf16* prow = PROJ + (size_t)g0 * DIN;
            LruParams lp[2];
#pragma unroll
            for (int cc = 0; cc < 2; ++cc) lru_params_load(lp[cc], WTA + L * 16384, WTX + L * 16384, conv_w, conv_b, b_a, b_x, lam, wid >> 1, 2 * (wid & 1) + cc, lane);
            const float lbv = L == 0 ? 0.f : sigmoidf_(lbp[GW + 64 * (wid >> 1) + lane] - lbp[64 * (wid >> 1) + lane]);
            {
                u32x4 rax[5], rf[4], rv[4];
                int tl1 = tid; asm volatile("" : "+v"(tl1) :: "memory");
                slab_load<5>(rax, prow - 3 * DIN, 67, t0 == 0 ? 3 : 0, tl1); slab_load<4>(rf, prow + 768, 64, 0, tl1); slab_load<4>(rv, prow + 1024, 64, 0, tl1);
                slab_store<5>(rax, AX, 67, tid); slab_store<4>(rf, FS, 64, tid); vt_store(rv, VTl, tid);
            }
            __syncthreads();
            lru_ainb(AX, conv_w, conv_b, AINB, tid);
            __syncthreads();
#pragma unroll
            for (int cc = 0; cc < 2; ++cc) {
                const int h = wid >> 1, nt = 2 * (wid & 1) + cc; float av[4][4], uv[4][4];
                lru_gates(AINB, AX, lp[cc], h, nt, lane, av, uv);
                float A = 1.f, H = 0.f;
#pragma unroll
                for (int mt = 0; mt < 4; ++mt) {
                    float At = 1.f, Ht = 0.f;
#pragma unroll
                    for (int r = 0; r < 4; ++r) { Ht = av[mt][r] * Ht + uv[mt][r]; At *= av[mt][r]; }
                    const float A1 = __shfl_down(At, 16), H1 = __shfl_down(Ht, 16); const float At2 = At * A1, Ht2 = A1 * Ht + H1;
                    const float A2 = __shfl_down(At2, 32), H2 = __shfl_down(Ht2, 32); const float Att = At2 * A2, Htt = A2 * Ht2 + H2;
                    H = Att * H + Htt; A *= Att;
                }
                if (lane < 16) { const int c = 64 * h + 16 * nt + lane; CARA[ci * GW + c] = A; CARH[ci * GW + c] = H; }
            }
            {
                const int h = wid >> 1, half = wid & 1, c = 64 * h + lane, fr = lane & 15, fq = lane >> 4;
                const float lb = lbv;
                float gl[32], kk[32]; float run = 0.f;
#pragma unroll
                for (int t = 0; t < 32; ++t) { const float sg = sigmoidf_(bf2f(*(const bf16*)(FS + (32 * half + t) * RS + c * 2))); run += flog(lb + (1.f - lb) * sg); gl[t] = run; kk[t] = (1.f - lb) * (1.f - sg); }
                TOTl[(h * 2 + half) * 64 + lane] = run;
                __syncthreads();
                const float tot0 = TOTl[(h * 2) * 64 + lane], glast = tot0 + TOTl[(h * 2 + 1) * 64 + lane], off = half ? tot0 : 0.f;
#pragma unroll
                for (int j = 0; j < 4; ++j) { float e[8];
#pragma unroll
                    for (int q = 0; q < 8; ++q) e[q] = kk[8 * j + q] * fexp(glast - (off + gl[8 * j + q]));
                    u32x4 w; w.x = pk2(e[0], e[1]); w.y = pk2(e[2], e[3]); w.z = pk2(e[4], e[5]); w.w = pk2(e[6], e[7]);
                    *(u32x4*)(KHTl + c * VTS + (32 * half + 8 * j) * 2) = w; }
                if (half) DEC[(ci * 4 + h) * 64 + lane] = fexp(glast);
                __syncthreads();
#pragma unroll
                for (int vvv = 0; vvv < 2; ++vvv) {
                    const int vt = 2 * half + vvv, vrow = 64 * h + 16 * vt + fr; bf16x8 bv[2];
#pragma unroll
                    for (int ks = 0; ks < 2; ++ks) bv[ks] = *(const bf16x8*)(VTl + vt_off(vrow, 32 * ks + 8 * fq));
#pragma unroll
                    for (int kt = 0; kt < 4; ++kt) { f32x4 acc = (f32x4){0.f, 0.f, 0.f, 0.f};
#pragma unroll
                        for (int ks = 0; ks < 2; ++ks) { const bf16x8 ka = *(const bf16x8*)(KHTl + (64 * h + 16 * kt + fr) * VTS + (32 * ks + 8 * fq) * 2); acc = __builtin_amdgcn_mfma_f32_16x16x32_bf16(ka, bv[ks], acc, 0, 0, 0); }
                        *(f32x4*)(DS + ((size_t)(ci * 4 + h) * 64 + 16 * vt + fr) * 64 + 16 * kt + 4 * fq) = acc; }
                }
                __syncthreads();
            }
        }
    } break;

    case PH_MIX2: {
        PHASE_ENTER
        float* xa = ldsf; float* xs = ldsf + 512;
        for (int item = bid; item < 256 + 2; item += G) {
            if (item < 256) {
                const int el = tid & 127, seg = tid >> 7, e = item * 128 + el, b = e >> 14, hh = (e >> 12) & 3, kv = e & 4095, k = kv & 63;
                float dv[32], dc[32];
#pragma unroll
                for (int i = 0; i < 32; ++i) { const int ci = b * CPB + seg * 32 + i; dv[i] = DS[(size_t)(ci * 4 + hh) * 4096 + kv]; dc[i] = DEC[(ci * 4 + hh) * 64 + k]; }
                float S = 0.f, A = 1.f;
#pragma unroll
                for (int i = 0; i < 32; ++i) { const float d = dv[i]; dv[i] = S; S = dc[i] * S + d; const float a0 = dc[i]; dc[i] = A; A *= a0; }
                xa[seg * 128 + el] = A; xs[seg * 128 + el] = S;
                __syncthreads();
                float Sin = 0.f;
                for (int s2 = 0; s2 < seg; ++s2) Sin = xa[s2 * 128 + el] * Sin + xs[s2 * 128 + el];
#pragma unroll
                for (int i = 0; i < 32; ++i) { const int ci = b * CPB + seg * 32 + i; (dry ? DS + 20 * (MiB / 4) * 4 : DS)[(size_t)(ci * 4 + hh) * 4096 + kv] = dv[i] + dc[i] * Sin; }
                __syncthreads();
            } else {
                if (tid < GW) { const int b = item - 256, c = tid; float hp = 0.f;
                    for (int ch0 = 0; ch0 < CPB; ch0 += 16) { float ca[16], chh[16];
#pragma unroll
                        for (int i = 0; i < 16; ++i) { ca[i] = CARA[(b * CPB + ch0 + i) * GW + c]; chh[i] = CARH[(b * CPB + ch0 + i) * GW + c]; }
#pragma unroll
                        for (int i = 0; i < 16; ++i) { CIN[(b * CPB + ch0 + i) * GW + c] = hp; hp = ca[i] * hp + chh[i]; } } }
            }
        }
    } break;

    case PH_MIX3: {
        PHASE_ENTER
        const float* conv_w = IN(3) + L * 4 * GW; const float* conv_b = IN(4) + L * GW; const float* b_a = IN(6) + L * GW; const float* b_x = IN(8) + L * GW; const float* lam = IN(9) + L * GW;
        const float* lbp = IN(10); const float* norm_g = IN(11) + L * HD; const float* pool_s = IN(13) + L * GW; const float* sconv_w = IN(14) + L * 3 * GW;
        unsigned char* AX = lds_raw; unsigned char* AG = lds_raw + 35376; unsigned char* AINB = lds_raw + 69168;
        unsigned char* QT3 = lds_raw; unsigned char* KT3 = lds_raw + 33792; unsigned char* OG3 = lds_raw + 67584; unsigned char* VT3 = lds_raw + 101376; float* TOT3 = (float*)(lds_raw + 138240);
        unsigned char* PS = lds_raw; unsigned char* DIMG = lds_raw + 41712; unsigned char* YST = lds_raw + 75504;
        unsigned char* SB = lds_raw; unsigned char* SC = lds_raw + 33792; unsigned char* SX = lds_raw + 68640;
        for (int ci = bid; ci < NCHUNK; ci += G) {
            const int t0 = (ci % CPB) * CH, g0 = ci * CH; const bf16* prow = PROJ + (size_t)g0 * DIN; bf16* yrow = Y + (size_t)g0 * D;
            LruParams lp[2]; float hin0[2];
#pragma unroll
            for (int cc = 0; cc < 2; ++cc) { lru_params_load(lp[cc], WTA + L * 16384, WTX + L * 16384, conv_w, conv_b, b_a, b_x, lam, wid >> 1, 2 * (wid & 1) + cc, lane); hin0[cc] = CIN[ci * GW + 64 * (wid >> 1) + 16 * (2 * (wid & 1) + cc) + (lane & 15)]; }
            const float lbv = L == 0 ? 0.f : sigmoidf_(lbp[GW + 64 * (wid >> 1) + lane] - lbp[64 * (wid >> 1) + lane]);
            {
                u32x4 rax[5], rag[4];
                int tl1 = tid; asm volatile("" : "+v"(tl1) :: "memory");
                slab_load<5>(rax, prow - 3 * DIN, 67, t0 == 0 ? 3 : 0, tl1); slab_load<4>(rag, prow + 256, 64, 0, tl1);
                slab_store<5>(rax, AX, 67, tid); slab_store<4>(rag, AG, 64, tid);
            }
            __syncthreads();
            lru_ainb(AX, conv_w, conv_b, AINB, tid);
            __syncthreads();
            u32x4 rp[5];
            int tl2 = tid; asm volatile("" : "+v"(tl2) :: "memory");
            slab_load<5>(rp, prow - 15 * DIN + 1536, 79, t0 == 0 ? 15 : 0, tl2);
#pragma unroll
            for (int cc = 0; cc < 2; ++cc) {
                const int h = wid >> 1, nt = 2 * (wid & 1) + cc, fr = lane & 15, fq = lane >> 4, c = 64 * h + 16 * nt + fr; float av[4][4], uv[4][4];
                lru_gates(AINB, AX, lp[cc], h, nt, lane, av, uv);
                float hin = hin0[cc];
#pragma unroll
                for (int mt = 0; mt < 4; ++mt) {
                    float Ai[4], Hi[4]; float A_ = 1.f, H_ = 0.f;
#pragma unroll
                    for (int r = 0; r < 4; ++r) { H_ = av[mt][r] * H_ + uv[mt][r]; A_ *= av[mt][r]; Ai[r] = A_; Hi[r] = H_; }
                    const float a1 = __shfl_up(A_, 16), h1 = __shfl_up(H_, 16), a2 = __shfl_up(A_, 32), h2 = __shfl_up(H_, 32), a3 = __shfl_up(A_, 48), h3 = __shfl_up(H_, 48);
                    float EA = 1.f, EH = 0.f;
                    if (fq >= 3) { EA = a3; EH = h3; }
                    if (fq >= 2) { EH = a2 * EH + h2; EA *= a2; }
                    if (fq >= 1) { EH = a1 * EH + h1; EA *= a1; }
                    const float hs = EA * hin + EH; float hv[4];
#pragma unroll
                    for (int r = 0; r < 4; ++r) hv[r] = Ai[r] * hs + Hi[r];
                    hin = __shfl(hv[3], 48 + fr);
#pragma unroll
                    for (int r = 0; r < 4; ++r) { bf16* p = (bf16*)(AG + (16 * mt + 4 * fq + r) * RS + c * 2); *p = (bf16)f2bf(hv[r] * gelu_tanh(bf2f(*p))); }
                }
            }
            __syncthreads();
            ytile_store(AG, yrow, tid);
            __syncthreads();
            slab_store<5>(rp, PS, 79, tid);
            __syncthreads();
            u32x4 rsb[4], rsc[5], rsx[5];
            int tl3 = tid; asm volatile("" : "+v"(tl3) :: "memory");
            slab_load<4>(rsb, prow + 1792, 64, 0, tl3); slab_load<5>(rsc, prow - 2 * DIN + 2048, 66, t0 == 0 ? 2 : 0, tl3); slab_load<5>(rsx, prow - 2 * DIN + 2304, 66, t0 == 0 ? 2 : 0, tl3);
            for (int idx = tid; idx < CH * 128; idx += NT) {
                const int t = idx >> 7, c = (idx & 127) * 2, gi = c >> 6, w = 2 << gi; const int tt = t0 + t; const int cnt = (tt + 1 < w) ? (tt + 1) : w; float s0 = 0.f, s1 = 0.f; unsigned xs[16];
#pragma unroll
                for (int r = 0; r < 16; ++r) xs[r] = *(const unsigned*)(PS + (t + 15 - r) * RS + c * 2);
#pragma unroll
                for (int r = 0; r < 16; ++r) { const float m_ = r < cnt ? 1.0f : 0.0f; s0 += m_ * bf2f(xs[r] & 0xffffu); s1 += m_ * bf2f(xs[r] >> 16); }
                const float inv = __builtin_amdgcn_rcpf((float)cnt);
                *(unsigned*)(DIMG + t * RS + c * 2) = pk2(s0 * inv - bf2f(xs[0] & 0xffffu), s1 * inv - bf2f(xs[0] >> 16));
            }
            __syncthreads();
#pragma unroll 1
            for (int cc = 0; cc < 2; ++cc) {
                const int gi = wid >> 1, nt = 2 * (wid & 1) + cc, fr = lane & 15, fq = lane >> 4, c = 64 * gi + 16 * nt + fr; bf16x8 wp[2];
#pragma unroll
                for (int ks = 0; ks < 2; ++ks) wp[ks] = *(const bf16x8*)(WTP + L * 16384 + (size_t)(gi * 64 + 16 * nt + fr) * 64 + 32 * ks + 8 * fq);
                const float psc = pool_s[c];
#pragma unroll
                for (int mt = 0; mt < 4; ++mt) { f32x4 acc = (f32x4){0.f, 0.f, 0.f, 0.f};
#pragma unroll
                    for (int ks = 0; ks < 2; ++ks) { const bf16x8 x = *(const bf16x8*)(DIMG + (16 * mt + fr) * RS + (64 * gi + 32 * ks + 8 * fq) * 2); acc = __builtin_amdgcn_mfma_f32_16x16x32_bf16(x, wp[ks], acc, 0, 0, 0); }
#pragma unroll
                    for (int r = 0; r < 4; ++r) *(bf16*)(YST + (16 * mt + 4 * fq + r) * RS + c * 2) = (bf16)f2bf(acc[r] * psc); }
            }
            __syncthreads();
            ytile_store(YST, yrow + 512, tid);
            __syncthreads();
            slab_store<4>(rsb, SB, 64, tid); slab_store<5>(rsc, SC, 66, tid); slab_store<5>(rsx, SX, 66, tid);
            __syncthreads();
            u32x4 rq[4], rf[4], rv[4], rog[4];
            int tl4 = tid; asm volatile("" : "+v"(tl4) :: "memory");
            slab_load<4>(rq, prow + 512, 64, 0, tl4); slab_load<4>(rf, prow + 768, 64, 0, tl4); slab_load<4>(rv, prow + 1024, 64, 0, tl4); slab_load<4>(rog, prow + 1280, 64, 0, tl4);
            for (int idx = tid; idx < CH * 128; idx += NT) {
                const int t = idx >> 7, c = (idx & 127) * 2; float a0 = 0.f, a1 = 0.f;
#pragma unroll
                for (int k = 0; k < 3; ++k) { const unsigned xc = *(const unsigned*)(SC + (t + k) * RS + c * 2), xx = *(const unsigned*)(SX + (t + k) * RS + c * 2);
                    a0 += sconv_w[k * GW + c] * bf2f(xc & 0xffffu) * bf2f(xx & 0xffffu); a1 += sconv_w[k * GW + c + 1] * bf2f(xc >> 16) * bf2f(xx >> 16); }
                unsigned* pb = (unsigned*)(SB + t * RS + c * 2); const unsigned b = *pb; *pb = pk2(bf2f(b & 0xffffu) * a0, bf2f(b >> 16) * a1);
            }
            __syncthreads();
            ytile_store(SB, yrow + 768, tid);
            __syncthreads();
            slab_store<4>(rq, QT3, 64, tid); slab_store<4>(rf, KT3, 64, tid); slab_store<4>(rog, OG3, 64, tid); vt_store(rv, VT3, tid);
            __syncthreads();
            {
                const int h = wid >> 1, half = wid & 1, c = 64 * h + lane, fr = lane & 15, fq = lane >> 4;
                const float lb = lbv;
                f32x4 sraw[4][2][2];
#pragma unroll
                for (int vt = 0; vt < 4; ++vt)
#pragma unroll
                    for (int ks = 0; ks < 2; ++ks) { const float* p = DS + ((size_t)(ci * 4 + h) * 64 + 16 * vt + fr) * 64 + 32 * ks + 8 * fq; sraw[vt][ks][0] = *(const f32x4*)p; sraw[vt][ks][1] = *(const f32x4*)(p + 4); }
                float gl[32]; float run = 0.f;
#pragma unroll
                for (int t = 0; t < 32; ++t) { const float sg = sigmoidf_(bf2f(*(const bf16*)(KT3 + (32 * half + t) * RS + c * 2))); run += flog(lb + (1.f - lb) * sg); gl[t] = run; }
                TOT3[(h * 2 + half) * 64 + lane] = run;
                __syncthreads();
                const float tot0 = TOT3[(h * 2) * 64 + lane];
                const float off = half ? 0.f : -tot0;
#pragma unroll
                for (int t = 0; t < 32; ++t) {
                    bf16* pq = (bf16*)(QT3 + (32 * half + t) * RS + c * 2); bf16* pk = (bf16*)(KT3 + (32 * half + t) * RS + c * 2);
                    const float sg = sigmoidf_(bf2f(*pk)), kkv = (1.f - lb) * (1.f - sg), qfv = siluf_(bf2f(*pq)), d = gl[t] + off;
                    *pq = (bf16)f2bf(qfv * fexp(d)); *pk = (bf16)f2bf(kkv * fexp(-d));
                }
                __syncthreads();
                bf16x8 sa[4][2];
#pragma unroll
                for (int vt = 0; vt < 4; ++vt)
#pragma unroll
                    for (int ks = 0; ks < 2; ++ks) {
                        const f32x4 lo = sraw[vt][ks][0], hi = sraw[vt][ks][1];
                        const float* eg = TOT3 + (h * 2) * 64 + 32 * ks + 8 * fq;
                        u32x4 w; w.x = pk2(lo.x * fexp(eg[0]), lo.y * fexp(eg[1])); w.y = pk2(lo.z * fexp(eg[2]), lo.w * fexp(eg[3])); w.z = pk2(hi.x * fexp(eg[4]), hi.y * fexp(eg[5])); w.w = pk2(hi.z * fexp(eg[6]), hi.w * fexp(eg[7]));
                        sa[vt][ks] = __builtin_bit_cast(bf16x8, w);
                    }
#pragma unroll
                for (int tsel = 0; tsel < 2; ++tsel) {
                    const int ti = half == 0 ? (tsel ? 3 : 0) : (tsel ? 2 : 1);
                    bf16x8 qb[2];
#pragma unroll
                    for (int ks = 0; ks < 2; ++ks) qb[ks] = *(const bf16x8*)(QT3 + (16 * ti + fr) * RS + (64 * h + 32 * ks + 8 * fq) * 2);
                    f32x4 st[4];
#pragma unroll
                    for (int si = 0; si < 4; ++si) { st[si] = (f32x4){0.f, 0.f, 0.f, 0.f};
                        if (si <= ti) {
#pragma unroll
                            for (int ks = 0; ks < 2; ++ks) { const bf16x8 ka = *(const bf16x8*)(KT3 + (16 * si + fr) * RS + (64 * h + 32 * ks + 8 * fq) * 2); st[si] = __builtin_amdgcn_mfma_f32_16x16x32_bf16(ka, qb[ks], st[si], 0, 0, 0); }
                            if (si == ti) {
#pragma unroll
                                for (int r = 0; r < 4; ++r) if (4 * fq + r > fr) st[si][r] = 0.f; }
                        } }
                    f32x4 oo[4];
#pragma unroll
                    for (int vt = 0; vt < 4; ++vt) { oo[vt] = (f32x4){0.f, 0.f, 0.f, 0.f};
#pragma unroll
                        for (int ks = 0; ks < 2; ++ks) oo[vt] = __builtin_amdgcn_mfma_f32_16x16x32_bf16(sa[vt][ks], qb[ks], oo[vt], 0, 0, 0); }
#pragma unroll
                    for (int p = 0; p < 2; ++p) if (2 * p <= ti) {
                        u32x4 bw; bw.x = pk2(st[2 * p][0], st[2 * p][1]); bw.y = pk2(st[2 * p][2], st[2 * p][3]); bw.z = pk2(st[2 * p + 1][0], st[2 * p + 1][1]); bw.w = pk2(st[2 * p + 1][2], st[2 * p + 1][3]);
                        const bf16x8 bfr = __builtin_bit_cast(bf16x8, bw);
#pragma unroll
                        for (int vt = 0; vt < 4; ++vt) { const int vrow = 64 * h + 16 * vt + fr; const u32x2 lo8 = *(const u32x2*)(VT3 + vt_off(vrow, 32 * p + 4 * fq)), hi8 = *(const u32x2*)(VT3 + vt_off(vrow, 32 * p + 16 + 4 * fq));
                            u32x4 aw; aw.x = lo8.x; aw.y = lo8.y; aw.z = hi8.x; aw.w = hi8.y;
                            oo[vt] = __builtin_amdgcn_mfma_f32_16x16x32_bf16(__builtin_bit_cast(bf16x8, aw), bfr, oo[vt], 0, 0, 0); }
                    }
                    float ss = 0.f;
#pragma unroll
                    for (int vt = 0; vt < 4; ++vt) ss += (oo[vt][0] * oo[vt][0] + oo[vt][1] * oo[vt][1]) + (oo[vt][2] * oo[vt][2] + oo[vt][3] * oo[vt][3]);
                    ss += __shfl_xor(ss, 16); ss += __shfl_xor(ss, 32);
                    const float rs = __builtin_amdgcn_rsqf(ss * (1.0f / HD) + 1e-5f);
#pragma unroll
                    for (int vt = 0; vt < 4; ++vt) { const int cv = 64 * h + 16 * vt + 4 * fq; u32x2* pog = (u32x2*)(OG3 + (16 * ti + fr) * RS + cv * 2); const u32x2 og = *pog; const f32x4 ng = *(const f32x4*)(norm_g + 16 * vt + 4 * fq);
                        u32x2 w; w.x = pk2(oo[vt][0] * rs * ng.x * siluf_(bf2f(og.x & 0xffffu)), oo[vt][1] * rs * ng.y * siluf_(bf2f(og.x >> 16))); w.y = pk2(oo[vt][2] * rs * ng.z * siluf_(bf2f(og.y & 0xffffu)), oo[vt][3] * rs * ng.w * siluf_(bf2f(og.y >> 16)));
                        *pog = w; }
                }
                __syncthreads();
            }
            ytile_store(OG3, yrow + 256, tid);
            __syncthreads();
        }
    } break;

    case PH_OUTPROJ: {
        PHASE_ENTER
        pg8::Gemm g{Y, (const bf16*)(ws + WS_WOUT) + (size_t)L * D * D, NTOK, D, D, 0}; pg8::StaticOrder S; S.init(NTOK, D, G, bid);
        if (L == 0) { pg8::EpiResidStats E{IN(0), hres, HN, SSP0}; pg8::gemm_phase<pg8::EpiResidStats, pg8::StaticOrder, true, true>((PG8_LAS unsigned char*)lds_raw, g, S, E, tid); }
        else { pg8::EpiResidF32 E{hres, hres}; pg8::gemm_phase<pg8::EpiResidF32, pg8::StaticOrder, true, true>((PG8_LAS unsigned char*)lds_raw, g, S, E, tid); }
    } break;

    case PH_NORM: {
        PHASE_ENTER
        const float* g = pass == 0 ? IN(16) + L * D : IN(15) + D;
        const bool route = (L == 1 && pass == 0);
        int* sel = (int*)lds_raw;
        for (int blk = bid; blk < NTOK / 64; blk += G) {
            if (!route) {
                for (int r8 = 0; r8 < 8; ++r8) { const int m = blk * 64 + wid * 8 + r8; rms_row_bf16(hres + (size_t)m * D, g, HN + (size_t)m * D, lane); }
            } else {
                float wr[16][8];
                { const float* wr_ = IN(20);
#pragma unroll
                  for (int j = 0; j < 4; ++j)
#pragma unroll
                    for (int q = 0; q < 4; ++q) { const f32x4 w0 = *(const f32x4*)(wr_ + (size_t)(4 * (lane + 64 * j) + q) * 8), w1 = *(const f32x4*)(wr_ + (size_t)(4 * (lane + 64 * j) + q) * 8 + 4);
                        wr[j * 4 + q][0] = w0.x; wr[j * 4 + q][1] = w0.y; wr[j * 4 + q][2] = w0.z; wr[j * 4 + q][3] = w0.w; wr[j * 4 + q][4] = w1.x; wr[j * 4 + q][5] = w1.y; wr[j * 4 + q][6] = w1.z; wr[j * 4 + q][7] = w1.w; } }
                f32x4 gv[4];
#pragma unroll
                for (int j = 0; j < 4; ++j) gv[j] = ((const f32x4*)g)[lane + 64 * j];
#pragma unroll 1
                for (int r8 = 0; r8 < 8; ++r8) {
                    const int tl = wid * 8 + r8, m = blk * 64 + tl; const f32x4* xr = (const f32x4*)(hres + (size_t)m * D);
                    f32x4 v[4]; float s = 0.f;
#pragma unroll
                    for (int j = 0; j < 4; ++j) { v[j] = xr[lane + 64 * j]; s += (v[j].x * v[j].x + v[j].y * v[j].y) + (v[j].z * v[j].z + v[j].w * v[j].w); }
                    const float r = 1.0f / sqrtf(wave_sum(s) * (1.0f / D) + 1e-6f);
                    float lg[8] = {0.f, 0.f, 0.f, 0.f, 0.f, 0.f, 0.f, 0.f};
#pragma unroll
                    for (int j = 0; j < 4; ++j) { const float y[4] = {v[j].x * r * gv[j].x, v[j].y * r * gv[j].y, v[j].z * r * gv[j].z, v[j].w * r * gv[j].w};
#pragma unroll
                        for (int q = 0; q < 4; ++q)
#pragma unroll
                            for (int e = 0; e < 8; ++e) lg[e] += y[q] * wr[j * 4 + q][e]; }
#pragma unroll
                    for (int e = 0; e < 8; ++e) lg[e] = wave_sum(lg[e]);
                    if (lane == 0) {
                        int e1 = 0; float l1 = lg[0];
#pragma unroll
                        for (int e = 1; e < 8; ++e) if (lg[e] > l1) { l1 = lg[e]; e1 = e; }
                        int e2 = -1; float l2 = -3.0e38f;
#pragma unroll
                        for (int e = 0; e < 8; ++e) if (e != e1 && lg[e] > l2) { l2 = lg[e]; e2 = e; }
                        const float g1 = 1.0f / (1.0f + fexp(l2 - l1));
                        TOKE[m * 2] = e1; TOKE[m * 2 + 1] = e2; TOKG[m * 2] = g1; TOKG[m * 2 + 1] = 1.0f - g1;
                        sel[tl * 2] = e1; sel[tl * 2 + 1] = e2; RSTD[m] = r;
                    }
                }
                __syncthreads();
                if (tid < NE) { int cnt = 0; for (int q = 0; q < 128; ++q) if (sel[q] == tid) { TOKR[blk * 128 + q] = cnt; ++cnt; } BCNT[blk * NE + tid] = cnt; }
                __syncthreads();
            }
        }
    } break;

    case PH_FFNUP: {
        PHASE_ENTER
        pg8::Gemm g{HN, (const bf16*)(ws + WS_WGU), NTOK, 2 * DFF, D, 0}; pg8::StaticOrder S; S.init(NTOK, 2 * DFF, G, bid);
        pg8::fill_rstd_table((PG8_LAS unsigned char*)lds_raw, S, SSP0, tid);
        pg8::EpiSwigluR E{HID, DFF, (const PG8_LAS float*)((PG8_LAS unsigned char*)lds_raw + pg8::RSTD_TAB_OFF)};
        pg8::gemm_phase<pg8::EpiSwigluR, pg8::StaticOrder, true, true>((PG8_LAS unsigned char*)lds_raw, g, S, E, tid);
    } break;

    case PH_FFNDOWN: {
        PHASE_ENTER
        pg8::Gemm g{HID, (const bf16*)(ws + WS_WD), NTOK, D, DFF, 0}; pg8::StaticOrder S; S.init(NTOK, D, G, bid);
        pg8::EpiResidStats E{hres, dry ? (float*)(ws + 410 * MiB) : hres, HN, SSP1};
        pg8::gemm_phase<pg8::EpiResidStats, pg8::StaticOrder, true, true>((PG8_LAS unsigned char*)lds_raw, g, S, E, tid);
    } break;

    case PH_DISPATCH: {
        PHASE_ENTER
        int* sh = (int*)lds_raw;
        const f32x4* gr = (const f32x4*)(IN(16) + D);
        for (int blk = bid; blk < NTOK / 64; blk += G) {
            { int* cnts = sh + 64;
              for (int i = tid; i < (NTOK / 64) * NE; i += NT) cnts[i] = BCNT[i];
              __syncthreads();
              { const int e = wid; int sall = 0, slt = 0;
#pragma unroll
                for (int i = 0; i < 4; ++i) { const int b2 = 4 * lane + i, c = cnts[b2 * NE + e]; sall += c; slt += (b2 < blk) ? c : 0; }
#pragma unroll
                for (int o = 1; o < 64; o <<= 1) { sall += __shfl_xor(sall, o); slt += __shfl_xor(slt, o); }
                if (lane == 0) { sh[e] = sall; sh[16 + e] = slt; sh[24 + e] = (sall + 255) >> 8; } } }
            __syncthreads();
            if (tid == 0) { int acc = 0; for (int e = 0; e < NE; ++e) { sh[8 + e] = acc * 256; acc += sh[24 + e]; } sh[32] = acc; }
            __syncthreads();
            if (tid < 128) { const int m = blk * 64 + (tid >> 1); const int e = TOKE[blk * 128 + tid]; const int r = sh[8 + e] + sh[16 + e] + TOKR[blk * 128 + tid];
                ROWDST[r] = m * 2 + (tid & 1); ROWG[r] = TOKG[blk * 128 + tid]; TOKROW[blk * 128 + tid] = r; }
            for (int r8 = 0; r8 < 8; ++r8) {
                const int m = blk * 64 + wid * 8 + r8; const int e0 = TOKE[m * 2], e1 = TOKE[m * 2 + 1];
                const int r0 = sh[8 + e0] + sh[16 + e0] + TOKR[m * 2], r1 = sh[8 + e1] + sh[16 + e1] + TOKR[m * 2 + 1];
                const float rs = RSTD[m]; const f32x4* xr = (const f32x4*)(hres + (size_t)m * D);
                unsigned* o0 = (unsigned*)(XR + (size_t)r0 * D); unsigned* o1 = (unsigned*)(XR + (size_t)r1 * D);
#pragma unroll
                for (int j = 0; j < 4; ++j) { const f32x4 v = xr[lane + 64 * j], gv = gr[lane + 64 * j]; const unsigned w = pg8::pk4_fp8(v.x * rs * gv.x, v.y * rs * gv.y, v.z * rs * gv.z, v.w * rs * gv.w); o0[lane + 64 * j] = w; o1[lane + 64 * j] = w; }
            }
            if (blk == 0) {
                for (int e = 0; e < NE; ++e) { const int lo = sh[8 + e] + sh[e], hi = sh[8 + e] + sh[24 + e] * 256; for (int r = lo + tid; r < hi; r += NT) { ROWDST[r] = -1; ROWG[r] = 0.f; } }
                if (tid < MAXTILES) { int e = 0; for (int q = 0; q < NE; ++q) if (tid * 256 >= sh[8 + q]) e = q; TILEE[tid] = e; }
                if (tid == 0) TILEE[MAXTILES] = sh[32];
            }
            __syncthreads();
        }
    } break;

    case PH_MOEUP: {
        PHASE_ENTER
        const int ntiles = __builtin_amdgcn_readfirstlane(__hip_atomic_load(TILEE + MAXTILES, __ATOMIC_RELAXED, __HIP_MEMORY_SCOPE_AGENT));
        pg8::Gemm g{(const bf16*)XR, (const bf16*)(ws + WS_W13), 0, 0, D / 2, 0}; pg8::MoeOrder S; S.init(ntiles, DFFE / 128, G, bid, 0, 0, TILEE);
        pg8::EpiSwiglu8 E{HIDE, DFFE, 1.0f / W13_SCALE, HID_SCALE};
        pg8::gemm_phase<pg8::EpiSwiglu8, pg8::MoeOrder, true, true, true>((PG8_LAS unsigned char*)lds_raw, g, S, E, tid);
    } break;

    case PH_MOEDOWN: {
        PHASE_ENTER
        const int ntiles = __builtin_amdgcn_readfirstlane(__hip_atomic_load(TILEE + MAXTILES, __ATOMIC_RELAXED, __HIP_MEMORY_SCOPE_AGENT));
        const int tfull = (ntiles / 64) * 64, ntail = ntiles - tfull;
        if (tfull > 0) {
            pg8::Gemm g{(const bf16*)HIDE, (const bf16*)(ws + WS_W2), 0, 0, DFFE / 2, 0}; pg8::MoeOrder S; S.init(tfull, D / 256, G, bid, 0, 0, TILEE);
            pg8::EpiMoeDown E{OUT2, ROWDST, ROWG, 1.0f / (W2_SCALE * HID_SCALE)};
            pg8::gemm_phase<pg8::EpiMoeDown, pg8::MoeOrder, true, true, true>((PG8_LAS unsigned char*)lds_raw, g, S, E, tid);
        }
        if (ntail > 0) {
            const int Sp = moe_tail_split(ntail);
            pg8::Gemm g{(const bf16*)HIDE, (const bf16*)(ws + WS_W2), 0, 0, DFFE / 2 / Sp, DFFE / 2};
            pg8::MoeTailOrder S{tfull, ntail, D / 256, Sp, G, bid, DFFE / Sp, TILEE};
            pg8::EpiPartF32 E{PART};
            pg8::gemm_phase<pg8::EpiPartF32, pg8::MoeTailOrder, true, true, true>((PG8_LAS unsigned char*)lds_raw, g, S, E, tid);
        }
    } break;

    case PH_FINAL: {
        PHASE_ENTER
        const float* g = IN(24); const int gw = bid * 8 + wid, NGW = G * 8;
        const int ntiles = __builtin_amdgcn_readfirstlane(__hip_atomic_load(TILEE + MAXTILES, __ATOMIC_RELAXED, __HIP_MEMORY_SCOPE_AGENT));
        const int tfull = (ntiles / 64) * 64, ntail = ntiles - tfull, Sp = ntail > 0 ? moe_tail_split(ntail) : 1, tail_row0 = tfull * 256; const float sc = 1.0f / (W2_SCALE * HID_SCALE);
        for (int mb = gw; mb < NTOK; mb += 8 * NGW) {
        int trow[8][2];
#pragma unroll
        for (int k = 0; k < 8; ++k) { const int m = mb + k * NGW; trow[k][0] = m < NTOK ? TOKROW[2 * m] : 0; trow[k][1] = m < NTOK ? TOKROW[2 * m + 1] : 0; }
#pragma unroll
        for (int k = 0; k < 8; ++k) { const int m = mb + k * NGW; if (m >= NTOK) break;
            f32x4* xr = (f32x4*)(hres + (size_t)m * D); const f32x4* gr = (const f32x4*)g;
            f32x4 v[4]; u32x2 ob[2][4]; float s = 0.f;
#pragma unroll
            for (int j = 0; j < 4; ++j) { v[j] = xr[lane + 64 * j]; ob[0][j] = ((const u32x2*)(OUT2 + (size_t)(2 * m) * D))[lane + 64 * j]; ob[1][j] = ((const u32x2*)(OUT2 + (size_t)(2 * m + 1) * D))[lane + 64 * j]; }
#pragma unroll
            for (int slot = 0; slot < 2; ++slot) {
                const int r = __builtin_amdgcn_readfirstlane(trow[k][slot]);
                if (r < tail_row0) {
#pragma unroll
                    for (int j = 0; j < 4; ++j) { const u32x2 p = ob[slot][j]; v[j].x += bf2f(p.x & 0xffffu); v[j].y += bf2f(p.x >> 16); v[j].z += bf2f(p.y & 0xffffu); v[j].w += bf2f(p.y >> 16); } }
                else { const int tl = (r - tail_row0) >> 8, rl = (r - tail_row0) & 255; const float gt = TOKG[2 * m + slot] * sc;
                    f32x4 q[7][4];
#pragma unroll
                    for (int p = 0; p < 7; ++p) { const f32x4* pr = (const f32x4*)(PART + ((size_t)(tl * Sp + (p < Sp ? p : 0)) * 256 + rl) * 1024);
#pragma unroll
                        for (int j = 0; j < 4; ++j) q[p][j] = pr[lane + 64 * j]; }
#pragma unroll
                    for (int p = 0; p < 7; ++p) { const float gp = p < Sp ? gt : 0.f;
#pragma unroll
                        for (int j = 0; j < 4; ++j) { v[j].x += gp * q[p][j].x; v[j].y += gp * q[p][j].y; v[j].z += gp * q[p][j].z; v[j].w += gp * q[p][j].w; } } }
            }
#pragma unroll
            for (int j = 0; j < 4; ++j) s += (v[j].x * v[j].x + v[j].y * v[j].y) + (v[j].z * v[j].z + v[j].w * v[j].w);
            const float r = 1.0f / sqrtf(wave_sum(s) * (1.0f / D) + 1e-6f);
#pragma unroll
            for (int j = 0; j < 4; ++j) { const f32x4 gv = gr[lane + 64 * j]; (dry ? (f32x4*)((float*)(ws + 410 * MiB) + (size_t)m * D) : xr)[lane + 64 * j] = (f32x4){v[j].x * r * gv.x, v[j].y * r * gv.y, v[j].z * r * gv.z, v[j].w * r * gv.w}; }
        }
        }
    } break;
    }
    if (phase == PH_INPROJ || phase == PH_FFNUP || phase == PH_DISPATCH) {
        int t_ = wid_s * 64 + lane_id_asm(); asm volatile("" : "+v"(t_));
        __attribute__((address_space(1))) unsigned char* wsq_ = (__attribute__((address_space(1))) unsigned char*)a.ws; asm volatile("" : "+s"(wsq_)); unsigned char* ws_ = (unsigned char*)wsq_; int G_ = gridDim.x; asm volatile("" : "+s"(G_));
        bg_convert(ws_, lds_raw, IN(21), IN(22), IN(23), step, G_, t_, phase == PH_DISPATCH);
    }
    if (step + 1 < a.ph_hi) { int t_ = wid_s * 64 + lane_id_asm(); asm volatile("" : "+v"(t_)); xcd_barrier(bar, t_ == 0); }
#ifdef REP_STEP
    if (dry) { --rep_left; --step; }
#endif
    }
}

constexpr int NSTEPS = 18;
#ifndef MK_PER_PHASE
#define MK_PER_PHASE 0
#endif

extern "C" void kernel_launch(void* const* d_in, const int* in_sizes, int n_in, void* d_out, int out_size, void* d_ws, size_t ws_size, hipStream_t stream) {
    static int grid = 0;
    if (grid == 0) {
        if (n_in != 25 || out_size != NTOK * D || ws_size < WS_END + 67 * MiB) { fprintf(stderr, "kernel_launch: unexpected shapes (n_in %d out %d ws %zu need %zu)\n", n_in, out_size, ws_size, (size_t)WS_END); grid = -1; return; }
        int dev = 0, cus = 0, per_cu = 0;
        if (hipGetDevice(&dev) != hipSuccess || hipDeviceGetAttribute(&cus, hipDeviceAttributeMultiprocessorCount, dev) != hipSuccess) { grid = -1; return; }
        if (hipFuncSetAttribute((const void*)fwd, hipFuncAttributeMaxDynamicSharedMemorySize, LDS_BYTES) != hipSuccess) { fprintf(stderr, "kernel_launch: hipFuncSetAttribute failed\n"); grid = -1; return; }
        if (hipOccupancyMaxActiveBlocksPerMultiprocessor(&per_cu, (const void*)fwd, NT, LDS_BYTES) != hipSuccess || per_cu < 1) { fprintf(stderr, "kernel_launch: occupancy query says %d blocks/CU\n", per_cu); (void)hipGetLastError(); grid = -1; return; }
        grid = cus;
    }
    if (grid < 0) return;
    hipMemsetAsync((char*)d_ws + WS_CTL, 0, 1 * MiB, stream);
    Args a{};
    for (int i = 0; i < 25; ++i) a.in[i] = (const float*)d_in[i];
    a.out = (float*)d_out; a.ws = (unsigned char*)d_ws;
#if MK_PER_PHASE
    for (int s = 0; s < NSTEPS; ++s) { a.ph_lo = s; a.ph_hi = s + 1; hipLaunchKernelGGL(fwd, dim3(grid), dim3(NT), LDS_BYTES, stream, a); }
#else
    a.ph_lo = 0; a.ph_hi = NSTEPS;
    hipLaunchKernelGGL(fwd, dim3(grid), dim3(NT), LDS_BYTES, stream, a);
#endif
}
```

```cpp
#include <hip/hip_runtime.h>
#include <cstdint>
#include <cstdio>

typedef unsigned short bf16;
typedef short bf16x8 __attribute__((ext_vector_type(8)));
typedef float f32x4 __attribute__((ext_vector_type(4)));
typedef unsigned u32x4 __attribute__((ext_vector_type(4)));
typedef unsigned u32x2 __attribute__((ext_vector_type(2)));

constexpr int NTOK = 16384, SEQ = 8192, D = 1024, DIN = 2560, GW = 256, HD = 64, DFF = 2816, DFFE = 3584, NE = 8;
constexpr int CH = 64, NCHUNK = NTOK / CH, CPB = SEQ / CH;
constexpr int NT = 512;
constexpr float W13_SCALE = 64.f, W2_SCALE = 128.f, HID_SCALE = 8.f;
constexpr int MAXTILES = NTOK * 2 / 256 + NE;

constexpr size_t MiB = 1u << 20;
constexpr size_t WS_CTL = 0;
constexpr size_t WS_SMALL = 1 * MiB;
constexpr size_t WS_WIN = 5 * MiB;
constexpr size_t WS_WOUT = 15 * MiB;
constexpr size_t WS_WGU = 19 * MiB;
constexpr size_t WS_WD = 30 * MiB;
constexpr size_t WS_W13 = 36 * MiB;
constexpr size_t WS_W2 = 92 * MiB;
constexpr size_t WS_ACT = 120 * MiB;
constexpr size_t WS_HN = WS_ACT;
constexpr size_t WS_PROJ = WS_ACT + 32 * MiB;
constexpr size_t WS_Y = WS_ACT + 112 * MiB;
constexpr size_t WS_DS = WS_ACT + 144 * MiB;
constexpr size_t WS_HID = WS_PROJ;
constexpr size_t WS_XR = WS_ACT;
constexpr size_t WS_HIDE = WS_ACT + 34 * MiB;
constexpr size_t WS_OUT2 = WS_ACT + 153 * MiB;
constexpr size_t WS_END = WS_ACT + 217 * MiB;
constexpr size_t SM_TOKE = 0;
constexpr size_t SM_TOKG = 128 * 1024;
constexpr size_t SM_TOKR = 256 * 1024;
constexpr size_t SM_BCNT = 384 * 1024;
constexpr size_t SM_ROWTOK = 400 * 1024;
constexpr size_t SM_ROWDST = 544 * 1024;
constexpr size_t SM_ROWG = 688 * 1024;
constexpr size_t SM_TILEE = 832 * 1024;
constexpr size_t SM_CARA = 1024 * 1024;
constexpr size_t SM_CARH = 1280 * 1024;
constexpr size_t SM_CIN = 1536 * 1024;
constexpr size_t SM_DEC = 1792 * 1024;
constexpr size_t SM_RSTD = 2048 * 1024;
constexpr size_t SM_WTA = 2304 * 1024;
constexpr size_t SM_WTX = 2368 * 1024;
constexpr size_t SM_TOKROW = 2560 * 1024;
constexpr size_t SM_WTP = 2432 * 1024;

struct Args {
    const float* in[25];
    float* out;
    unsigned char* ws;
    int ph_lo, ph_hi, pad0, pad1;
};

__device__ __forceinline__ int lane_id_asm() { int l; asm volatile("v_mbcnt_lo_u32_b32 %0, -1, 0\n\tv_mbcnt_hi_u32_b32 %0, -1, %0" : "=v"(l)); return l; }
typedef const float __attribute__((address_space(1)))* gfptr_t;
__device__ __forceinline__ const float* IN(int k) { asm volatile("" : "+s"(k)); const gfptr_t p = ((const gfptr_t __attribute__((address_space(4)))*)__builtin_amdgcn_kernarg_segment_ptr())[k]; return (const float*)p; }
__device__ __forceinline__ float bf2f(unsigned v) { return __uint_as_float(v << 16); }
__device__ __forceinline__ unsigned f2bf(float f) { unsigned u = __float_as_uint(f); return (u + 0x7fffu + ((u >> 16) & 1u)) >> 16; }
__device__ __forceinline__ unsigned pk2(float lo, float hi) { return f2bf(lo) | (f2bf(hi) << 16); }
__device__ __forceinline__ float fexp(float x) { return __builtin_amdgcn_exp2f(1.44269504089f * x); }
__device__ __forceinline__ float flog(float x) { return 0.69314718056f * __builtin_amdgcn_logf(x); }
__device__ __forceinline__ float sigmoidf_(float x) { return __builtin_amdgcn_rcpf(1.0f + __builtin_amdgcn_exp2f(-1.44269504089f * x)); }
__device__ __forceinline__ float siluf_(float x) { return x * sigmoidf_(x); }
__device__ __forceinline__ float gelu_tanh(float x) { const float u = 1.5957691216057308f * (x + 0.044715f * x * x * x); return x * sigmoidf_(u); }
__device__ __forceinline__ float neg_expm1_small(float x) { return -x * (1.0f + x * (0.5f + x * (0.16666667f + x * (0.041666668f + x * 0.0083333338f)))); }
__device__ __forceinline__ float wave_sum(float v) {
#pragma unroll
    for (int o = 1; o < 64; o <<= 1) v += __shfl_xor(v, o);
    return v;
}
#define LDS_WAIT() asm volatile("s_waitcnt lgkmcnt(0)" ::: "memory")

namespace pg8 {
#define PG8_LAS __attribute__((address_space(3)))
typedef unsigned short bf16_t;
typedef short bf16x8 __attribute__((ext_vector_type(8)));
typedef float f32x4 __attribute__((ext_vector_type(4)));
typedef unsigned u32x4 __attribute__((ext_vector_type(4)));
constexpr int BM = 256, BK = 64, HALF = 128, HTB = HALF * BK * 2  , STAGE_BYTES = 8 * HTB, NXCD = 8, WGM = 8;

__host__ __device__ __forceinline__ int lds_byte(int r, int c) { const int st = (r >> 4) * 2 + (c >> 5), rr = r & 15, cc = c & 31, ob = rr * 64 + cc * 2; return st * 1024 + (ob ^ (((ob >> 9) & 1) << 5)); }
__host__ __device__ __forceinline__ void stage_rc(int b, int& R, int& C) { const int st = b / 1024, sb = b % 1024, swz = sb ^ (((sb >> 9) & 1) << 5); R = (st >> 1) * 16 + swz / 64; C = (st & 1) * 32 + (swz % 64) / 2; }
__host__ __device__ __forceinline__ int perm32(int rho) { const int n = rho >> 4, i = rho & 15; return 8 * (i >> 2) + 4 * n + (i & 3); }

struct Unit { int pm, pn, pa, pb, ord, koff; };
struct Gemm { const bf16_t* A; const bf16_t* Bt; int M, N, K; int LD; };

struct StaticOrder {
    int nM, nN, nwg, G, c;
    __host__ __device__ void init(int M, int N, int G_, int c_) { nM = M / BM; nN = N / BM; nwg = nM * nN; G = G_; c = c_; }
    __host__ __device__ bool next(int i, Unit& u) const {
        const long L = (long)i * G + c; if (L >= nwg) return false;
        int wgid = (int)L; { const int q = nwg / NXCD, r = nwg % NXCD, xcd = wgid % NXCD, off = wgid / NXCD; wgid = (xcd < r ? xcd * (q + 1) : r * (q + 1) + (xcd - r) * q) + off; }
        const int nig = WGM * nN, gid = wgid / nig, fm = gid * WGM, gsz = (nM - fm) < WGM ? (nM - fm) : WGM;
        u.pm = fm + ((wgid % nig) % gsz); u.pn = (wgid % nig) / gsz; u.pa = u.pm; u.pb = u.pn; u.ord = i; u.koff = 0; return true;
    }
    __device__ __forceinline__ void a_ready(const Unit&) const {}
    __device__ __forceinline__ void done(const Unit&) const {}
};

__device__ __forceinline__ unsigned cvt_pk_bf16(float lo, float hi) { unsigned r; asm volatile("v_cvt_pk_bf16_f32 %0, %1, %2" : "=v"(r) : "v"(lo), "v"(hi)); return r; }
typedef float f32x2 __attribute__((ext_vector_type(2)));
typedef int pg8_v8i __attribute__((ext_vector_type(8))); typedef int pg8_v4i __attribute__((ext_vector_type(4)));
__device__ __forceinline__ pg8_v8i pg8_cat(bf16x8 lo, bf16x8 hi) { return __builtin_shufflevector(__builtin_bit_cast(pg8_v4i, lo), __builtin_bit_cast(pg8_v4i, hi), 0, 1, 2, 3, 4, 5, 6, 7); }
__device__ __forceinline__ void pg8_mfma8(f32x4& acc, pg8_v8i a, pg8_v8i b, int sc) { asm volatile("v_mfma_scale_f32_16x16x128_f8f6f4 %0, %1, %2, %0, %3, %3 op_sel_hi:[0,0,0]" : "+v"(acc) : "v"(a), "v"(b), "v"(sc)); }
template <class Epi, class Sched, bool ALIGN_EPI = false, bool SP2 = false, bool F8 = false>
__device__ __forceinline__ void gemm_phase(PG8_LAS unsigned char* lds, const Gemm g, const Sched& S, const Epi& E, int tid_in) {
    int tid = tid_in; asm volatile("" : "+v"(tid));
    const int wid = __builtin_amdgcn_readfirstlane(tid >> 6), lane = tid & 63, wr = wid >> 2, wc = wid & 3, fr = lane & 15, fq = lane >> 4;
    const int K = g.LD ? g.LD : g.K, nt = g.K / BK;
    unsigned voffA[2], voffB[2];
#pragma unroll
    for (int i = 0; i < 2; ++i) { int R, C; stage_rc(tid * 16 + i * 8192, R, C); const int Rb = Epi::PERM ? ((R & ~31) + perm32(R & 31)) : R;
        voffA[i] = (unsigned)(R * K + C) * 2u; voffB[i] = (unsigned)(Rb * K + C) * 2u; }
    const size_t kstep = (size_t)(BK * 2);
    const size_t hstep = (size_t)HALF * K * 2;
    const size_t tstep = 2 * hstep;
    const unsigned ldsw = (unsigned)wid * 1024u;
    int f8one = 0x7f7f7f7f; asm volatile("" : "+v"(f8one));
    constexpr int KOFF = 1024;
    const int aoff = lds_byte(wr * 64 + fr, fq * 8), boff = lds_byte(wc * 32 + fr, fq * 8);
#define PG8_SA(b, h) (((b) * 2 + (h)) * HTB)
#define PG8_SB(b, h) ((4 + (b) * 2 + (h)) * HTB)
#define PG8_STAGE(bufoff, gbase, voff) do { _Pragma("unroll") for (int _i = 0; _i < 2; ++_i) \
        __builtin_amdgcn_global_load_lds((const unsigned*)((const char*)(gbase) + (voff)[_i]), (PG8_LAS unsigned*)(lds + (bufoff) + ldsw + _i * 8192), 16, 0, 0); } while (0)
#define PG8_LDA(dst, b, h) do { _Pragma("unroll") for (int m = 0; m < 4; ++m) _Pragma("unroll") for (int k = 0; k < 2; ++k) dst[m][k] = *(const PG8_LAS bf16x8*)(lds + PG8_SA(b, h) + aoff + m * 2048 + k * KOFF); } while (0)
#define PG8_LDB(dst, b, h) do { _Pragma("unroll") for (int n = 0; n < 2; ++n) _Pragma("unroll") for (int k = 0; k < 2; ++k) dst[n][k] = *(const PG8_LAS bf16x8*)(lds + PG8_SB(b, h) + boff + n * 2048 + k * KOFF); } while (0)
#define PG8_MMA(ai, bj, At, Bt) do { __builtin_amdgcn_s_setprio(1); if constexpr (F8) { _Pragma("unroll") for (int m = 0; m < 4; ++m) _Pragma("unroll") for (int n = 0; n < 2; ++n) \
        pg8_mfma8(acc[ai][bj][m][n], pg8_cat(Bt[n][0], Bt[n][1]), pg8_cat(At[m][0], At[m][1]), f8one); } \
    else { _Pragma("unroll") for (int m = 0; m < 4; ++m) _Pragma("unroll") for (int n = 0; n < 2; ++n) _Pragma("unroll") for (int k = 0; k < 2; ++k) \
        acc[ai][bj][m][n] = __builtin_amdgcn_mfma_f32_16x16x32_bf16(Bt[n][k], At[m][k], acc[ai][bj][m][n], 0, 0, 0); } __builtin_amdgcn_s_setprio(0); } while (0)
#define PG8_WAIT_V(n) asm volatile("s_waitcnt vmcnt(" #n ")" ::: "memory")
#define PG8_WAIT_L(n) asm volatile("s_waitcnt lgkmcnt(" #n ")" ::: "memory")
#define PG8_BAR __builtin_amdgcn_s_barrier()
#define PG8_SCHED __builtin_amdgcn_sched_barrier(0)
    Unit cur, nxt; int ui = 0;
    if (!S.next(0, cur)) return;
    f32x4 acc[2][2][4][2];
    if constexpr (Epi::ACC_INIT) E.init(acc, cur, wr, wc, fr, fq);
    else {
#pragma unroll
    for (int a = 0; a < 2; ++a)
#pragma unroll
        for (int b = 0; b < 2; ++b)
#pragma unroll
            for (int m = 0; m < 4; ++m)
#pragma unroll
                for (int n = 0; n < 2; ++n) acc[a][b][m][n] = (f32x4){0.f, 0.f, 0.f, 0.f};
    }
    bf16x8 At[4][2], B0[2][2], B1[2][2];
    const char* cA = (const char*)g.A + (size_t)cur.pa * tstep + cur.koff; const char* cB = (const char*)g.Bt + (size_t)cur.pb * tstep + cur.koff;
    S.a_ready(cur);
    if constexpr (SP2) {
        PG8_STAGE(PG8_SB(0, 0), cB, voffB); PG8_STAGE(PG8_SB(0, 1), cB + hstep, voffB); PG8_STAGE(PG8_SA(0, 0), cA, voffA); PG8_STAGE(PG8_SA(0, 1), cA + hstep, voffA);
        if (wr == 1) PG8_BAR;
        PG8_WAIT_V(2); PG8_BAR;
        PG8_STAGE(PG8_SB(1, 0), cB + kstep, voffB); PG8_STAGE(PG8_SA(1, 0), cA + kstep, voffA); PG8_STAGE(PG8_SB(1, 1), cB + hstep + kstep, voffB);
        PG8_WAIT_V(6); PG8_BAR;
    } else {
        PG8_STAGE(PG8_SB(0, 0), cB, voffB); PG8_STAGE(PG8_SA(0, 0), cA, voffA); PG8_STAGE(PG8_SB(0, 1), cB + hstep, voffB); PG8_STAGE(PG8_SA(0, 1), cA + hstep, voffA);
        if (wr == 1) PG8_BAR;
        PG8_WAIT_V(4); PG8_BAR;
        PG8_STAGE(PG8_SB(1, 0), cB + kstep, voffB); PG8_STAGE(PG8_SA(1, 0), cA + kstep, voffA); PG8_STAGE(PG8_SB(1, 1), cB + hstep + kstep, voffB);
        PG8_WAIT_V(6); PG8_BAR;
    }
    for (;;) {
        const bool has_next = S.next(ui + 1, nxt);
        const char* nA = has_next ? (const char*)g.A + (size_t)nxt.pa * tstep + nxt.koff : cA; const char* nB = has_next ? (const char*)g.Bt + (size_t)nxt.pb * tstep + nxt.koff : cB;
        for (int t = 0; t < nt; t += 2) {
            const bool last = (t == nt - 2);
            const char* a1 = cA + (size_t)(t + 1) * kstep;
            const char* a2 = last ? nA : cA + (size_t)(t + 2) * kstep; const char* b2 = last ? nB : cB + (size_t)(t + 2) * kstep;
            const char* a3 = a2 + kstep; const char* b3 = b2 + kstep;
            if (last && has_next) S.a_ready(nxt);
            if constexpr (SP2) {
            PG8_LDB(B0, 0, 0); PG8_LDB(B1, 0, 1); PG8_SCHED; PG8_LDA(At, 0, 0); PG8_STAGE(PG8_SA(1, 1), a1 + hstep, voffA);
            PG8_WAIT_V(8); PG8_WAIT_L(0); PG8_BAR; PG8_MMA(0, 0, At, B0); PG8_MMA(0, 1, At, B1); PG8_BAR; PG8_SCHED;
            PG8_LDA(At, 0, 1); PG8_STAGE(PG8_SB(0, 0), b2, voffB); PG8_STAGE(PG8_SB(0, 1), b2 + hstep, voffB); PG8_STAGE(PG8_SA(0, 0), a2, voffA);
            PG8_WAIT_V(8); PG8_WAIT_L(0); PG8_BAR; PG8_MMA(1, 0, At, B0); PG8_MMA(1, 1, At, B1); PG8_BAR; PG8_SCHED;
            PG8_LDB(B0, 1, 0); PG8_LDB(B1, 1, 1); PG8_SCHED; PG8_LDA(At, 1, 0); PG8_STAGE(PG8_SA(0, 1), a2 + hstep, voffA);
            PG8_WAIT_V(8); PG8_WAIT_L(0); PG8_BAR; PG8_MMA(0, 0, At, B0); PG8_MMA(0, 1, At, B1); PG8_BAR; PG8_SCHED;
            PG8_LDA(At, 1, 1); PG8_STAGE(PG8_SB(1, 0), b3, voffB); PG8_STAGE(PG8_SB(1, 1), b3 + hstep, voffB); PG8_STAGE(PG8_SA(1, 0), a3, voffA);
            PG8_WAIT_V(8); PG8_WAIT_L(0); PG8_BAR; PG8_MMA(1, 0, At, B0); PG8_MMA(1, 1, At, B1); PG8_BAR; PG8_SCHED;
            } else {
            PG8_LDB(B0, 0, 0); PG8_SCHED; PG8_LDA(At, 0, 0); PG8_STAGE(PG8_SA(1, 1), a1 + hstep, voffA);
            PG8_WAIT_L(8); PG8_BAR; PG8_WAIT_L(0); PG8_MMA(0, 0, At, B0); PG8_BAR; PG8_SCHED;
            PG8_LDB(B1, 0, 1); PG8_STAGE(PG8_SB(0, 0), b2, voffB);
            PG8_BAR; PG8_WAIT_L(0); PG8_MMA(0, 1, At, B1); PG8_BAR;
            PG8_LDA(At, 0, 1); PG8_STAGE(PG8_SA(0, 0), a2, voffA);
            PG8_BAR; PG8_WAIT_L(0); PG8_MMA(1, 0, At, B0); PG8_BAR; PG8_SCHED;
            PG8_STAGE(PG8_SB(0, 1), b2 + hstep, voffB);
            PG8_WAIT_V(6); PG8_BAR; PG8_MMA(1, 1, At, B1); PG8_BAR;
            PG8_LDB(B0, 1, 0); PG8_SCHED; PG8_LDA(At, 1, 0); PG8_STAGE(PG8_SA(0, 1), a2 + hstep, voffA);
            PG8_WAIT_L(8); PG8_BAR; PG8_WAIT_L(0); PG8_MMA(0, 0, At, B0); PG8_BAR; PG8_SCHED;
            PG8_LDB(B1, 1, 1); PG8_STAGE(PG8_SB(1, 0), b3, voffB);
            PG8_BAR; PG8_WAIT_L(0); PG8_MMA(0, 1, At, B1); PG8_BAR;
            PG8_LDA(At, 1, 1); PG8_STAGE(PG8_SA(1, 0), a3, voffA);
            PG8_BAR; PG8_WAIT_L(0); PG8_MMA(1, 0, At, B0); PG8_BAR; PG8_SCHED;
            PG8_STAGE(PG8_SB(1, 1), b3 + hstep, voffB);
            PG8_WAIT_V(6); PG8_BAR; PG8_MMA(1, 1, At, B1); PG8_BAR;
            }
        }
        if constexpr (F8) asm volatile("s_nop 15\n\ts_nop 15" ::: "memory");
        if constexpr (ALIGN_EPI) { if (wr == 0) PG8_BAR; }
        if constexpr (!Epi::AFTER_DRAIN) { E(acc, cur, wr, wc, fr, fq); S.done(cur); }
        if (!has_next) break;
#pragma unroll
        for (int a = 0; a < 2; ++a)
#pragma unroll
            for (int b = 0; b < 2; ++b)
#pragma unroll
                for (int m = 0; m < 4; ++m)
#pragma unroll
                    for (int n = 0; n < 2; ++n) acc[a][b][m][n] = (f32x4){0.f, 0.f, 0.f, 0.f};
        cur = nxt; cA = nA; cB = nB; ++ui;
        if constexpr (ALIGN_EPI) { if (wr == 1) PG8_BAR; }
    }
    PG8_WAIT_V(0);
    if constexpr (!ALIGN_EPI) { if (wr == 0) PG8_BAR; }
    PG8_BAR;
    if constexpr (Epi::AFTER_DRAIN) { E.fused(acc, cur, wr, wc, fr, fq, lds, wid, lane); S.done(cur); }
#undef PG8_SA
#undef PG8_SB
#undef PG8_STAGE
#undef PG8_LDA
#undef PG8_LDB
#undef PG8_MMA
#undef PG8_WAIT_V
#undef PG8_WAIT_L
#undef PG8_BAR
#undef PG8_SCHED
}

struct EpiStoreBf16 {
    static constexpr bool PERM = true, AFTER_DRAIN = false, ACC_INIT = false;
    bf16_t* O; int ldc;
    __device__ __forceinline__ void operator()(const f32x4 (&acc)[2][2][4][2], const Unit& u, int wr, int wc, int fr, int fq) const {
        const int row0 = u.pm * BM + wr * 64 + fr, col0 = u.pn * BM + wc * 32 + 8 * fq;
#pragma unroll
        for (int ai = 0; ai < 2; ++ai)
#pragma unroll
            for (int m = 0; m < 4; ++m) { bf16_t* rowp = O + (size_t)(row0 + ai * HALF + m * 16) * ldc + col0;
#pragma unroll
                for (int bj = 0; bj < 2; ++bj) { const f32x4 v0 = acc[ai][bj][m][0], v1 = acc[ai][bj][m][1];
                    u32x4 w; w.x = cvt_pk_bf16(v0[0], v0[1]); w.y = cvt_pk_bf16(v0[2], v0[3]); w.z = cvt_pk_bf16(v1[0], v1[1]); w.w = cvt_pk_bf16(v1[2], v1[3]);
                    *(u32x4*)(rowp + bj * HALF) = w; } }
    }
};
struct EpiResidF32 {
    static constexpr bool PERM = false, AFTER_DRAIN = false, ACC_INIT = true;
    const float* base; float* out;
    __device__ __forceinline__ void init(f32x4 (&acc)[2][2][4][2], const Unit& u, int wr, int wc, int fr, int fq) const {
        const int row0 = u.pm * BM + wr * 64 + fr, col0 = u.pn * BM + wc * 32 + 4 * fq;
#pragma unroll
        for (int ai = 0; ai < 2; ++ai)
#pragma unroll
            for (int m = 0; m < 4; ++m) { const size_t off = (size_t)(row0 + ai * HALF + m * 16) * 1024 + col0;
#pragma unroll
                for (int bj = 0; bj < 2; ++bj)
#pragma unroll
                    for (int n = 0; n < 2; ++n) acc[ai][bj][m][n] = *(const f32x4*)(base + off + bj * HALF + n * 16); }
    }
    __device__ __forceinline__ void operator()(const f32x4 (&acc)[2][2][4][2], const Unit& u, int wr, int wc, int fr, int fq) const {
        const int row0 = u.pm * BM + wr * 64 + fr, col0 = u.pn * BM + wc * 32 + 4 * fq;
#pragma unroll
        for (int ai = 0; ai < 2; ++ai)
#pragma unroll
            for (int m = 0; m < 4; ++m) { const size_t off = (size_t)(row0 + ai * HALF + m * 16) * 1024 + col0;
#pragma unroll
                for (int bj = 0; bj < 2; ++bj)
#pragma unroll
                    for (int n = 0; n < 2; ++n) *(f32x4*)(out + off + bj * HALF + n * 16) = acc[ai][bj][m][n]; }
    }
};
__device__ __forceinline__ float silu_f(float x) { return x * __builtin_amdgcn_rcpf(1.0f + __builtin_amdgcn_exp2f(-1.44269504089f * x)); }
struct EpiSwiglu {
    static constexpr bool PERM = true, AFTER_DRAIN = false, ACC_INIT = false;
    bf16_t* C; int ldc; int row_off;
    __device__ __forceinline__ void operator()(const f32x4 (&acc)[2][2][4][2], const Unit& u, int wr, int wc, int fr, int fq) const {
        const int row0 = u.pm * BM + wr * 64 + fr - row_off, col0 = u.pn * HALF + wc * 32 + 8 * fq;
#pragma unroll
        for (int ai = 0; ai < 2; ++ai)
#pragma unroll
            for (int m = 0; m < 4; ++m) { bf16_t* rowp = C + (size_t)(row0 + ai * HALF + m * 16) * ldc + col0;
                const f32x4 g0 = acc[ai][0][m][0], g1 = acc[ai][0][m][1], u0 = acc[ai][1][m][0], u1 = acc[ai][1][m][1];
                u32x4 w; w.x = cvt_pk_bf16(silu_f(g0[0]) * u0[0], silu_f(g0[1]) * u0[1]); w.y = cvt_pk_bf16(silu_f(g0[2]) * u0[2], silu_f(g0[3]) * u0[3]);
                w.z = cvt_pk_bf16(silu_f(g1[0]) * u1[0], silu_f(g1[1]) * u1[1]); w.w = cvt_pk_bf16(silu_f(g1[2]) * u1[2], silu_f(g1[3]) * u1[3]);
                *(u32x4*)rowp = w; }
    }
};
struct EpiMoeDown {
    static constexpr bool PERM = true, AFTER_DRAIN = false, ACC_INIT = false;
    bf16_t* out2; const int* rowdst; const float* rowg; float sc;
    __device__ __forceinline__ void operator()(const f32x4 (&acc)[2][2][4][2], const Unit& u, int wr, int wc, int fr, int fq) const {
        const int row0 = u.pm * BM + wr * 64 + fr, col0 = u.pn * BM + wc * 32 + 8 * fq;
#pragma unroll
        for (int ai = 0; ai < 2; ++ai)
#pragma unroll
            for (int m = 0; m < 4; ++m) { const int gr = row0 + ai * HALF + m * 16; const int d = rowdst[gr]; const float g = rowg[gr] * sc;
                if (d >= 0) { bf16_t* rowp = out2 + (size_t)d * 1024 + col0;
#pragma unroll
                    for (int bj = 0; bj < 2; ++bj) { const f32x4 v0 = acc[ai][bj][m][0] * g, v1 = acc[ai][bj][m][1] * g;
                        u32x4 w; w.x = cvt_pk_bf16(v0[0], v0[1]); w.y = cvt_pk_bf16(v0[2], v0[3]); w.z = cvt_pk_bf16(v1[0], v1[1]); w.w = cvt_pk_bf16(v1[2], v1[3]);
                        *(u32x4*)(rowp + bj * HALF) = w; } } }
    }
};


struct EpiResidStats {
    static constexpr bool PERM = false, AFTER_DRAIN = false, ACC_INIT = true;
    const float* base; float* out; bf16_t* hn; float* ssp;
    __device__ __forceinline__ void init(f32x4 (&acc)[2][2][4][2], const Unit& u, int wr, int wc, int fr, int fq) const {
        const int row0 = u.pm * BM + wr * 64 + fr, col0 = u.pn * BM + wc * 32 + 4 * fq;
#pragma unroll
        for (int ai = 0; ai < 2; ++ai)
#pragma unroll
            for (int m = 0; m < 4; ++m) { const size_t off = (size_t)(row0 + ai * HALF + m * 16) * 1024 + col0;
#pragma unroll
                for (int bj = 0; bj < 2; ++bj)
#pragma unroll
                    for (int n = 0; n < 2; ++n) acc[ai][bj][m][n] = *(const f32x4*)(base + off + bj * HALF + n * 16); }
    }
    __device__ __forceinline__ void operator()(const f32x4 (&acc)[2][2][4][2], const Unit& u, int wr, int wc, int fr, int fq) const {
        const int row0 = u.pm * BM + wr * 64 + fr, col0 = u.pn * BM + wc * 32 + 4 * fq; typedef unsigned u32x2e __attribute__((ext_vector_type(2)));
#pragma unroll
        for (int ai = 0; ai < 2; ++ai)
#pragma unroll
            for (int m = 0; m < 4; ++m) { const int row = row0 + ai * HALF + m * 16; const size_t off = (size_t)row * 1024 + col0; float ss = 0.f;
#pragma unroll
                for (int bj = 0; bj < 2; ++bj)
#pragma unroll
                    for (int n = 0; n < 2; ++n) { const f32x4 v = acc[ai][bj][m][n]; *(f32x4*)(out + off + bj * HALF + n * 16) = v;
                        ss += (v[0] * v[0] + v[1] * v[1]) + (v[2] * v[2] + v[3] * v[3]); u32x2e w; w.x = cvt_pk_bf16(v[0], v[1]); w.y = cvt_pk_bf16(v[2], v[3]); *(u32x2e*)(hn + off + bj * HALF + n * 16) = w; }
                ss += __shfl_xor(ss, 16); ss += __shfl_xor(ss, 32);
                if (fq == 0) ssp[(size_t)row * 16 + u.pn * 4 + wc] = ss; }
    }
};
constexpr int RSTD_TAB_OFF = STAGE_BYTES;
template <class Sched> __device__ __forceinline__ void fill_rstd_table(PG8_LAS unsigned char* lds, const Sched& S, const float* ssp, int tid) {
    PG8_LAS float* tab = (PG8_LAS float*)(lds + RSTD_TAB_OFF); Unit u;
    for (int i = 0; S.next(i, u); ++i)
        if (tid < 256) { const int row = u.pm * BM + tid; const f32x4* p = (const f32x4*)(ssp + (size_t)row * 16); const f32x4 a = p[0], b = p[1], c = p[2], d = p[3];
            const float s = (((a[0] + a[1]) + (a[2] + a[3])) + ((b[0] + b[1]) + (b[2] + b[3]))) + (((c[0] + c[1]) + (c[2] + c[3])) + ((d[0] + d[1]) + (d[2] + d[3])));
            tab[i * 256 + tid] = 1.0f / sqrtf(s * (1.0f / 1024.0f) + 1e-6f); }
    __syncthreads();
}
struct EpiStoreBf16R {
    static constexpr bool PERM = true, AFTER_DRAIN = false, ACC_INIT = false;
    bf16_t* O; int ldc; const PG8_LAS float* tab;
    __device__ __forceinline__ void operator()(const f32x4 (&acc)[2][2][4][2], const Unit& u, int wr, int wc, int fr, int fq) const {
        const int row0 = u.pm * BM + wr * 64 + fr, col0 = u.pn * BM + wc * 32 + 8 * fq;
#pragma unroll
        for (int ai = 0; ai < 2; ++ai)
#pragma unroll
            for (int m = 0; m < 4; ++m) { const int row = row0 + ai * HALF + m * 16; const float r = tab[u.ord * 256 + wr * 64 + fr + ai * HALF + m * 16]; bf16_t* rowp = O + (size_t)row * ldc + col0;
#pragma unroll
                for (int bj = 0; bj < 2; ++bj) { const f32x4 v0 = acc[ai][bj][m][0] * r, v1 = acc[ai][bj][m][1] * r;
                    u32x4 w; w.x = cvt_pk_bf16(v0[0], v0[1]); w.y = cvt_pk_bf16(v0[2], v0[3]); w.z = cvt_pk_bf16(v1[0], v1[1]); w.w = cvt_pk_bf16(v1[2], v1[3]);
                    *(u32x4*)(rowp + bj * HALF) = w; } }
    }
};
struct EpiSwigluR {
    static constexpr bool PERM = true, AFTER_DRAIN = false, ACC_INIT = false;
    bf16_t* C; int ldc; const PG8_LAS float* tab;
    __device__ __forceinline__ void operator()(const f32x4 (&acc)[2][2][4][2], const Unit& u, int wr, int wc, int fr, int fq) const {
        const int row0 = u.pm * BM + wr * 64 + fr, col0 = u.pn * HALF + wc * 32 + 8 * fq;
#pragma unroll
        for (int ai = 0; ai < 2; ++ai)
#pragma unroll
            for (int m = 0; m < 4; ++m) { const int row = row0 + ai * HALF + m * 16; const float r = tab[u.ord * 256 + wr * 64 + fr + ai * HALF + m * 16]; bf16_t* rowp = C + (size_t)row * ldc + col0;
                const f32x4 g0 = acc[ai][0][m][0] * r, g1 = acc[ai][0][m][1] * r, u0 = acc[ai][1][m][0] * r, u1 = acc[ai][1][m][1] * r;
                u32x4 w; w.x = cvt_pk_bf16(silu_f(g0[0]) * u0[0], silu_f(g0[1]) * u0[1]); w.y = cvt_pk_bf16(silu_f(g0[2]) * u0[2], silu_f(g0[3]) * u0[3]);
                w.z = cvt_pk_bf16(silu_f(g1[0]) * u1[0], silu_f(g1[1]) * u1[1]); w.w = cvt_pk_bf16(silu_f(g1[2]) * u1[2], silu_f(g1[3]) * u1[3]);
                *(u32x4*)rowp = w; }
    }
};
__device__ __forceinline__ unsigned pk4_fp8(float a, float b, float c, float d) { int w = __builtin_amdgcn_cvt_pk_fp8_f32(a, b, 0, false); w = __builtin_amdgcn_cvt_pk_fp8_f32(c, d, w, true); return (unsigned)w; }
struct EpiSwiglu8 {
    static constexpr bool PERM = true, AFTER_DRAIN = false, ACC_INIT = false;
    unsigned char* C; int ldc; float isc, osc;
    __device__ __forceinline__ void operator()(const f32x4 (&acc)[2][2][4][2], const Unit& u, int wr, int wc, int fr, int fq) const {
        const int row0 = u.pm * BM + wr * 64 + fr, col0 = u.pn * HALF + wc * 32 + 8 * fq; const float us = isc * osc;
#pragma unroll
        for (int ai = 0; ai < 2; ++ai)
#pragma unroll
            for (int m = 0; m < 4; ++m) { unsigned char* rowp = C + (size_t)(row0 + ai * HALF + m * 16) * ldc + col0;
                const f32x4 g0 = acc[ai][0][m][0] * isc, g1 = acc[ai][0][m][1] * isc, u0 = acc[ai][1][m][0] * us, u1 = acc[ai][1][m][1] * us;
                typedef unsigned u32x2e __attribute__((ext_vector_type(2))); u32x2e w;
                w.x = pk4_fp8(silu_f(g0[0]) * u0[0], silu_f(g0[1]) * u0[1], silu_f(g0[2]) * u0[2], silu_f(g0[3]) * u0[3]);
                w.y = pk4_fp8(silu_f(g1[0]) * u1[0], silu_f(g1[1]) * u1[1], silu_f(g1[2]) * u1[2], silu_f(g1[3]) * u1[3]);
                *(u32x2e*)rowp = w; }
    }
};
struct MoeOrder {
    StaticOrder so; int tlo, nN, a_off; const int* tilee;
    __device__ void init(int nrt, int nN_, int G, int c, int tlo_, int a_off_, const int* tilee_) { so.init(nrt * BM, nN_ * BM, G, c); tlo = tlo_; nN = nN_; a_off = a_off_; tilee = tilee_; }
    __device__ bool next(int i, Unit& u) const { if (!so.next(i, u)) return false; u.pm += tlo; u.pa = u.pm - a_off; const int e = __builtin_amdgcn_readfirstlane(__hip_atomic_load(tilee + u.pm, __ATOMIC_RELAXED, __HIP_MEMORY_SCOPE_AGENT)); u.pb = e * nN + u.pn; return true; }
    __device__ __forceinline__ void a_ready(const Unit&) const {}
    __device__ __forceinline__ void done(const Unit&) const {}
};

struct MoeTailOrder {
    int t0, ntail, nN, S, G, c, kbytes; const int* tilee;
    __device__ bool next(int i, Unit& u) const {
        const int L = i * G + c; if (L >= ntail * nN * S) return false;
        const int piece = L % S, q = L / S, pn = q % nN, tl = q / nN;
        u.pm = t0 + tl; u.pn = pn; u.pa = u.pm; const int e = __builtin_amdgcn_readfirstlane(__hip_atomic_load(tilee + u.pm, __ATOMIC_RELAXED, __HIP_MEMORY_SCOPE_AGENT));
        u.pb = e * nN + pn; u.ord = tl * S + piece; u.koff = piece * kbytes; return true; }
    __device__ __forceinline__ void a_ready(const Unit&) const {}
    __device__ __forceinline__ void done(const Unit&) const {}
};
struct EpiPartF32 {
    static constexpr bool PERM = false, AFTER_DRAIN = false, ACC_INIT = false;
    float* part;
    __device__ __forceinline__ void operator()(const f32x4 (&acc)[2][2][4][2], const Unit& u, int wr, int wc, int fr, int fq) const {
        const int row0 = wr * 64 + fr, col0 = u.pn * BM + wc * 32 + 4 * fq; float* base = part + (size_t)u.ord * 256 * 1024;
#pragma unroll
        for (int ai = 0; ai < 2; ++ai)
#pragma unroll
            for (int m = 0; m < 4; ++m) { const size_t off = (size_t)(row0 + ai * HALF + m * 16) * 1024 + col0;
#pragma unroll
                for (int bj = 0; bj < 2; ++bj)
#pragma unroll
                    for (int n = 0; n < 2; ++n) *(f32x4*)(base + off + bj * HALF + n * 16) = acc[ai][bj][m][n]; }
    }
};
}

__device__ __forceinline__ void cvt_item(const float* W, int K, int N, bf16* WT, int mode, int item, float* scr, int lane, const float* gk = nullptr) {
    const int nblk = N / 32, kb = item / nblk, nb = item % nblk, k0 = 64 * kb, n0 = 32 * nb;
    { f32x4 v[8]; const float* src = W + (size_t)(k0 + (lane >> 3)) * N + n0 + 4 * (lane & 7);
#pragma unroll
      for (int i = 0; i < 8; ++i) v[i] = __builtin_nontemporal_load((const f32x4*)(src + (size_t)(8 * i) * N));
#pragma unroll
      for (int i = 0; i < 8; ++i) { float* d = scr + (8 * i + (lane >> 3)) * 33 + 4 * (lane & 7); const float gg = gk ? gk[k0 + 8 * i + (lane >> 3)] : 1.0f; d[0] = v[i].x * gg; d[1] = v[i].y * gg; d[2] = v[i].z * gg; d[3] = v[i].w * gg; } }
    LDS_WAIT();
    const int c = lane & 7;
#pragma unroll
    for (int j = 0; j < 4; ++j) {
        const int n = (lane >> 3) + 8 * j; const float* s = scr + (8 * c) * 33 + n;
        u32x4 o; o.x = pk2(s[0 * 33], s[1 * 33]); o.y = pk2(s[2 * 33], s[3 * 33]); o.z = pk2(s[4 * 33], s[5 * 33]); o.w = pk2(s[6 * 33], s[7 * 33]);
        const int nn = n0 + n; const int drow = mode == 0 ? nn : ((nn >> 7) * 256 + (nn & 127) + (mode == 2 ? 128 : 0));
        *(u32x4*)(WT + (size_t)drow * K + k0 + 8 * c) = o;
    }
    LDS_WAIT();
}

__device__ __forceinline__ void cvt_item8(const float* W, int K, int N, unsigned char* WT, int mode, int item, float* scr, int lane, float scale) {
    const int nblk = N / 32, kb = item / nblk, nb = item % nblk, k0 = 128 * kb, n0 = 32 * nb;
    { f32x4 v[16]; const float* src = W + (size_t)(k0 + (lane >> 3)) * N + n0 + 4 * (lane & 7);
#pragma unroll
      for (int i = 0; i < 16; ++i) v[i] = __builtin_nontemporal_load((const f32x4*)(src + (size_t)(8 * i) * N));
#pragma unroll
      for (int i = 0; i < 16; ++i) { float* d = scr + (8 * i + (lane >> 3)) * 33 + 4 * (lane & 7); d[0] = v[i].x * scale; d[1] = v[i].y * scale; d[2] = v[i].z * scale; d[3] = v[i].w * scale; } }
    LDS_WAIT();
    const int c = lane & 7;
#pragma unroll
    for (int j = 0; j < 4; ++j) {
        const int n = (lane >> 3) + 8 * j; const float* s = scr + (16 * c) * 33 + n;
        u32x4 o; o.x = pg8::pk4_fp8(s[0 * 33], s[1 * 33], s[2 * 33], s[3 * 33]); o.y = pg8::pk4_fp8(s[4 * 33], s[5 * 33], s[6 * 33], s[7 * 33]);
        o.z = pg8::pk4_fp8(s[8 * 33], s[9 * 33], s[10 * 33], s[11 * 33]); o.w = pg8::pk4_fp8(s[12 * 33], s[13 * 33], s[14 * 33], s[15 * 33]);
        const int nn = n0 + n; const int drow = mode == 0 ? nn : ((nn >> 7) * 256 + (nn & 127) + (mode == 2 ? 128 : 0));
        __builtin_nontemporal_store(o, (u32x4*)(WT + (size_t)drow * K + k0 + 16 * c));
    }
    LDS_WAIT();
}

__device__ __forceinline__ void rms_row_bf16(const float* xrow, const float* g, bf16* orow, int lane) {
    const f32x4* xr = (const f32x4*)xrow; const f32x4* gr = (const f32x4*)g;
    f32x4 v[4]; float s = 0.f;
#pragma unroll
    for (int j = 0; j < 4; ++j) { v[j] = xr[lane + 64 * j]; s += (v[j].x * v[j].x + v[j].y * v[j].y) + (v[j].z * v[j].z + v[j].w * v[j].w); }
    const float r = 1.0f / sqrtf(wave_sum(s) * (1.0f / D) + 1e-6f);
    u32x2* o8 = (u32x2*)orow;
#pragma unroll
    for (int j = 0; j < 4; ++j) { const f32x4 gv = gr[lane + 64 * j]; u32x2 w; w.x = pk2(v[j].x * r * gv.x, v[j].y * r * gv.y); w.y = pk2(v[j].z * r * gv.z, v[j].w * r * gv.w); o8[lane + 64 * j] = w; }
}

#define LAS __attribute__((address_space(3)))
#define XB_TMO      128
#define XB_XCNT(j)  (256  + 64 * (j))
#define XB_XSUB(j)  (1280 + 64 * (j))
#define XB_XGEN(j)  (2304 + 64 * (j))
#define XB_TOP      3328
#define XB_TOPGEN   3392
#define XCD_BAR_WORDS 3456
#define XB_SPIN_CAP (1u << 22)
__device__ __forceinline__ unsigned xb_ld(unsigned* p)              { return __hip_atomic_load(p, __ATOMIC_RELAXED, __HIP_MEMORY_SCOPE_AGENT); }
__device__ __forceinline__ unsigned xb_add(unsigned* p, unsigned v) { return __hip_atomic_fetch_add(p, v, __ATOMIC_RELAXED, __HIP_MEMORY_SCOPE_AGENT); }
__device__ __forceinline__ unsigned xb_xcc_id() { return (unsigned)__builtin_amdgcn_s_getreg((3 << 11) | 20) & 0xFu; }
#define XB_SPIN(cond, bar) do { unsigned _sp = 0; while (cond) { __builtin_amdgcn_s_sleep(1); \
    if ((++_sp & 255u) == 0u) { if (xb_ld(&(bar)[XB_TMO])) break; if (_sp > XB_SPIN_CAP) { atomicAdd(&(bar)[XB_TMO], 1u); break; } } } } while (0)
struct XcdBarrier { unsigned* bar; unsigned x; volatile LAS unsigned* st; };
__device__ __forceinline__ XcdBarrier xcd_barrier_post(unsigned* bar, volatile LAS unsigned* st) {
    XcdBarrier b; b.bar = bar; b.x = xb_xcc_id(); b.st = st;
    if (threadIdx.x == 0) (void)xb_add(&bar[XB_XCNT(b.x)], 1u);
    return b;
}
__device__ __forceinline__ void xcd_barrier_complete(unsigned* bar, unsigned x, unsigned& nloc, unsigned& nx) {
    const unsigned G = gridDim.x * gridDim.y * gridDim.z;
    unsigned sum, cnt, mine, sp = 0u;
    for (;;) {
        sum = 0u; cnt = 0u; mine = 0u;
#pragma unroll
        for (unsigned j = 0; j < 16; ++j) { const unsigned c = xb_ld(&bar[XB_XCNT(j)]); sum += c; cnt += (c > 0u) ? 1u : 0u; mine = (j == x) ? c : mine; }
        if (sum == G) break;
        __builtin_amdgcn_s_sleep(1);
        if ((++sp & 255u) == 0u) { if (xb_ld(&bar[XB_TMO])) break; if (sp > XB_SPIN_CAP) { atomicAdd(&bar[XB_TMO], 1u); break; } }
    }
    nloc = mine > 0u ? mine : 1u; nx = cnt > 0u ? cnt : 1u;
}
__device__ __forceinline__ void xcd_arrive(const XcdBarrier& b, bool leader) {
    asm volatile("s_waitcnt vmcnt(0)" ::: "memory");
    __syncthreads();
    if (leader) {
        unsigned* bar = b.bar;
        __builtin_amdgcn_s_waitcnt(0);
        unsigned nloc = b.st[0], nx = b.st[1];
        if (nloc == 0u) { xcd_barrier_complete(bar, b.x, nloc, nx); b.st[0] = nloc; b.st[1] = nx; }
        const unsigned old = xb_add(&bar[XB_XSUB(b.x)], 1u);
        const unsigned gen = old / nloc;
        b.st[2] = gen; b.st[3] = 0u;
        if (old + 1u == (gen + 1u) * nloc) {
            __builtin_amdgcn_fence(__ATOMIC_RELEASE, "agent");
            asm volatile("s_waitcnt vmcnt(0)" ::: "memory");
            const unsigned og = xb_add(&bar[XB_TOP], 1u);
            const unsigned tg = og / nx;
            b.st[4] = tg; b.st[3] = 1u;
            if (og + 1u == (tg + 1u) * nx) { xb_add(&bar[XB_TOPGEN], 1u); b.st[3] = 2u; }
        }
    }
}
__device__ __forceinline__ void xcd_wait(const XcdBarrier& b, bool leader) {
    if (leader) {
        unsigned* bar = b.bar; const unsigned gen = b.st[2], role = b.st[3], tg = b.st[4];
        if (role >= 1u) {
            if (role == 1u) XB_SPIN(xb_ld(&bar[XB_TOPGEN]) == tg, bar);
            __builtin_amdgcn_fence(__ATOMIC_ACQUIRE, "agent");
            xb_add(&bar[XB_XGEN(b.x)], 1u);
            asm volatile("s_waitcnt vmcnt(0)" ::: "memory");
        } else {
            XB_SPIN(xb_ld(&bar[XB_XGEN(b.x)]) == gen, bar);
            __builtin_amdgcn_fence(__ATOMIC_ACQUIRE, "agent");
            asm volatile("s_waitcnt vmcnt(0)" ::: "memory");
        }
    }
    __syncthreads();
}
__device__ __forceinline__ void xcd_barrier(const XcdBarrier& b, bool leader) { xcd_arrive(b, leader); xcd_wait(b, leader); }
constexpr int LDS_BYTES = 163840, RING_BYTES = LDS_BYTES - 512, MISC_OFF = RING_BYTES + 320;
constexpr int CW_BAR = 4096;

enum Phase { PH_PROLOGUE = 0, PH_INPROJ, PH_MIX1, PH_MIX2, PH_MIX3, PH_OUTPROJ, PH_NORM, PH_FFNUP, PH_FFNDOWN, PH_DISPATCH, PH_MOEUP, PH_MOEDOWN, PH_FINAL };


constexpr int PQ_OFF = 97792;
constexpr int RS = 528;
constexpr int AINB_STRIDE = RS;
constexpr int VTS = 144;
template <int NLD> __device__ __forceinline__ void slab_load(u32x4 (&reg)[NLD], const bf16* src, int nrows, int rvalid0, int tid) {
#pragma unroll
    for (int j = 0; j < NLD; ++j) { const int i = tid + j * NT, r = i >> 5, ch = i & 31; reg[j] = (u32x4){0u, 0u, 0u, 0u}; if (i < nrows * 32 && r >= rvalid0) reg[j] = *(const u32x4*)(src + (ptrdiff_t)r * DIN + ch * 8); }
}
template <int NLD> __device__ __forceinline__ void slab_store(const u32x4 (&reg)[NLD], unsigned char* dst, int nrows, int tid) {
#pragma unroll
    for (int j = 0; j < NLD; ++j) { const int i = tid + j * NT, r = i >> 5, ch = i & 31; if (i < nrows * 32) *(u32x4*)(dst + r * RS + ch * 16) = reg[j]; }
}
__device__ __forceinline__ void ytile_store(const unsigned char* src, bf16* y, int tid) {
    asm volatile("" : "+v"(tid) :: "memory");
#pragma unroll
    for (int j = 0; j < 4; ++j) { const int i = tid + j * NT, r = i >> 5, ch = i & 31; *(u32x4*)(y + (size_t)r * D + ch * 8) = *(const u32x4*)(src + r * RS + ch * 16); }
}
__device__ __forceinline__ int vt_off(int c, int tok) { return c * VTS + ((tok ^ (((c >> 3) & 7) << 3)) << 1); }
__device__ __forceinline__ void vt_store(const u32x4 (&reg)[4], unsigned char* vt, int tid) {
#pragma unroll
    for (int j = 0; j < 4; ++j) { const int i = tid + j * NT, r = i >> 5, ch = i & 31, c0 = ch * 8; const unsigned w[4] = {reg[j].x, reg[j].y, reg[j].z, reg[j].w};
#pragma unroll
        for (int q = 0; q < 8; ++q) *(bf16*)(vt + vt_off(c0 + q, r)) = (bf16)((q & 1) ? (w[q >> 1] >> 16) : (w[q >> 1] & 0xffffu)); }
}
struct LruParams { bf16x8 wa[2], wx[2]; float lam, ba, bx, cb, cw[4]; };
__device__ __forceinline__ void lru_params_load(LruParams& p, const bf16* wta, const bf16* wtx, const float* conv_w, const float* conv_b, const float* b_a, const float* b_x, const float* lam, int h, int nt, int lane) {
    asm volatile("" : "+v"(lane));
    const int fr = lane & 15, fq = lane >> 4, c = 64 * h + 16 * nt + fr;
#pragma unroll
    for (int ks = 0; ks < 2; ++ks) { p.wa[ks] = *(const bf16x8*)(wta + (size_t)(h * 64 + 16 * nt + fr) * 64 + 32 * ks + 8 * fq); p.wx[ks] = *(const bf16x8*)(wtx + (size_t)(h * 64 + 16 * nt + fr) * 64 + 32 * ks + 8 * fq); }
    p.lam = lam[c]; p.ba = b_a[c]; p.bx = b_x[c]; p.cb = conv_b[c];
#pragma unroll
    for (int k = 0; k < 4; ++k) p.cw[k] = conv_w[k * GW + c];
}
__device__ __forceinline__ void lru_ainb(const unsigned char* ax, const float* conv_w, const float* conv_b, unsigned char* ainb, int tid) {
    for (int idx = tid; idx < CH * 128; idx += NT) {
        const int t = idx >> 7, c = (idx & 127) * 2; float a0 = conv_b[c], a1 = conv_b[c + 1];
#pragma unroll
        for (int k = 0; k < 4; ++k) { const unsigned w = *(const unsigned*)(ax + (t + k) * RS + c * 2); a0 += conv_w[k * GW + c] * bf2f(w & 0xffffu); a1 += conv_w[k * GW + c + 1] * bf2f(w >> 16); }
        *(unsigned*)(ainb + t * RS + c * 2) = pk2(a0, a1);
    }
}
__device__ __forceinline__ void lru_gates(const unsigned char* ainb, const unsigned char* ax, const LruParams& p, int h, int nt, int lane, float (&av)[4][4], float (&uv)[4][4]) {
    const int fr = lane & 15, fq = lane >> 4, c = 64 * h + 16 * nt + fr;
    f32x4 aa[4], ax4[4];
#pragma unroll
    for (int mt = 0; mt < 4; ++mt) { aa[mt] = (f32x4){0.f, 0.f, 0.f, 0.f}; ax4[mt] = (f32x4){0.f, 0.f, 0.f, 0.f};
#pragma unroll
        for (int ks = 0; ks < 2; ++ks) { const bf16x8 x = *(const bf16x8*)(ainb + (16 * mt + fr) * RS + (64 * h + 32 * ks + 8 * fq) * 2);
            aa[mt] = __builtin_amdgcn_mfma_f32_16x16x32_bf16(x, p.wa[ks], aa[mt], 0, 0, 0); ax4[mt] = __builtin_amdgcn_mfma_f32_16x16x32_bf16(x, p.wx[ks], ax4[mt], 0, 0, 0); } }
    const float sp = log1pf(fexp(-p.lam));
#pragma unroll
    for (int mt = 0; mt < 4; ++mt)
#pragma unroll
        for (int r = 0; r < 4; ++r) { const int t = 16 * mt + 4 * fq + r; const float rg = sigmoidf_(aa[mt][r] + p.ba), ig = sigmoidf_(ax4[mt][r] + p.bx); const float loga = -8.0f * rg * sp;
            const float x2 = 2.0f * loga; const float m2 = x2 > -0.25f ? neg_expm1_small(x2) : -expm1f(x2);
            float xin = p.cb;
#pragma unroll
            for (int k = 0; k < 4; ++k) xin += p.cw[k] * bf2f(*(const bf16*)(ax + (t + k) * RS + c * 2));
            av[mt][r] = fexp(loga); uv[mt][r] = __builtin_amdgcn_sqrtf(fmaxf(m2, 0.f)) * ig * xin; }
}

constexpr int CW_CVTQ = 2048, CW_DONE = 8192;
constexpr int BG_IE1 = 8 * 112, BG_IE2 = 28 * 32, BG_ITEMS = 2 * NE * BG_IE1 + NE * BG_IE2, BG_BATCHES = BG_ITEMS / 8;
__device__ __forceinline__ void bg_convert(unsigned char* ws, unsigned char* lds_raw, const float* w1, const float* w3, const float* w2, int step, int G, int tid, bool drain) {
    unsigned* ctl = (unsigned*)(ws + WS_CTL); volatile unsigned* shq = (volatile unsigned*)(lds_raw + RING_BYTES);
    const int wid = tid >> 6, lane = tid & 63; float* scr = (float*)lds_raw + wid * (128 * 33);
    __syncthreads();
    if (tid == 0 && !drain) __hip_atomic_fetch_add(ctl + CW_DONE + 64 * step, 1u, __ATOMIC_RELAXED, __HIP_MEMORY_SCOPE_AGENT);
    for (;;) {
        if (tid == 0) { unsigned b = BG_BATCHES;
            if (drain || __hip_atomic_load(ctl + CW_DONE + 64 * step, __ATOMIC_RELAXED, __HIP_MEMORY_SCOPE_AGENT) + 16u < (unsigned)G) b = __hip_atomic_fetch_add(ctl + CW_CVTQ, 1u, __ATOMIC_RELAXED, __HIP_MEMORY_SCOPE_AGENT);
            shq[0] = b; }
        __syncthreads();
        const unsigned b = shq[0];
        __syncthreads();
        if (b >= (unsigned)BG_BATCHES) break;
        const int q = (int)b * 8 + wid;
        if (q < NE * BG_IE1) { const int e = q / BG_IE1, r = q % BG_IE1; cvt_item8(w1 + (size_t)e * D * DFFE, D, DFFE, ws + WS_W13 + (size_t)e * 2 * DFFE * D, 1, r, scr, lane, W13_SCALE); }
        else if (q < 2 * NE * BG_IE1) { const int q2 = q - NE * BG_IE1, e = q2 / BG_IE1, r = q2 % BG_IE1; cvt_item8(w3 + (size_t)e * D * DFFE, D, DFFE, ws + WS_W13 + (size_t)e * 2 * DFFE * D, 2, r, scr, lane, W13_SCALE); }
        else { const int q2 = q - 2 * NE * BG_IE1, e = q2 / BG_IE2, r = q2 % BG_IE2; cvt_item8(w2 + (size_t)e * DFFE * D, DFFE, D, ws + WS_W2 + (size_t)e * D * DFFE, 0, r, scr, lane, W2_SCALE); }
    }
}

__host__ __device__ __forceinline__ int moe_tail_split(int ntail) { return ntail * 4 * 7 <= 256 ? 7 : (ntail * 4 * 2 <= 256 ? 2 : 1); }

#define HN ((bf16*)(ws + WS_HN))
#define PROJ ((bf16*)(ws + WS_PROJ))
#define Y ((bf16*)(ws + WS_Y))
#define DS ((float*)(ws + WS_DS))
#define HID ((bf16*)(ws + WS_HID))
#define HIDE ((unsigned char*)(ws + WS_HIDE))
#define OUT2 ((bf16*)(ws + WS_OUT2))
#define XR ((unsigned char*)(ws + WS_XR))
#define SSP0 ((float*)(ws + WS_END))
#define SSP1 ((float*)(ws + WS_END + MiB))
#define PART ((float*)(ws + WS_END + 3 * MiB))
#define TOKROW SMALLP(int, SM_TOKROW)
#define SMALLP(T, off) ((T*)(ws + WS_SMALL + (off)))
#define RSTD SMALLP(float, SM_RSTD)
#define TOKE SMALLP(int, SM_TOKE)
#define TOKG SMALLP(float, SM_TOKG)
#define TOKR SMALLP(int, SM_TOKR)
#define BCNT SMALLP(int, SM_BCNT)
#define ROWDST SMALLP(int, SM_ROWDST)
#define ROWG SMALLP(float, SM_ROWG)
#define TILEE SMALLP(int, SM_TILEE)
#define CARA SMALLP(float, SM_CARA)
#define CARH SMALLP(float, SM_CARH)
#define CIN SMALLP(float, SM_CIN)
#define DEC SMALLP(float, SM_DEC)
#define WTA SMALLP(bf16, SM_WTA)
#define WTX SMALLP(bf16, SM_WTX)
#define WTP SMALLP(bf16, SM_WTP)
#define PHASE_ENTER int tid = wid_s * 64 + lane_id_asm(); asm volatile("" : "+v"(tid)); const int lane = tid & 63, wid = tid >> 6; __attribute__((address_space(1))) unsigned char* wsg_ = (__attribute__((address_space(1))) unsigned char*)a.ws; asm volatile("" : "+s"(wsg_)); unsigned char* ws = (unsigned char*)wsg_; \
    __attribute__((address_space(1))) float* hresg_ = (__attribute__((address_space(1))) float*)a.out; asm volatile("" : "+s"(hresg_)); float* hres = (float*)hresg_; \
    int bid = blockIdx.x; asm volatile("" : "+s"(bid)); int G = gridDim.x; asm volatile("" : "+s"(G)); (void)lane; (void)wid; (void)hres; (void)bid; (void)G;

__global__ void __launch_bounds__(NT) fwd(Args a) {
    extern __shared__ __attribute__((aligned(16))) unsigned char lds_raw[];
    float* ldsf = (float*)lds_raw;
    const int wid_s = __builtin_amdgcn_readfirstlane(threadIdx.x >> 6);
    { const int tid0 = threadIdx.x; for (int u = tid0; u < (LDS_BYTES - RING_BYTES) / 4; u += NT) ((LAS unsigned*)((LAS unsigned char*)lds_raw + RING_BYTES))[u] = 0u; }
    __syncthreads();
    XcdBarrier bar = xcd_barrier_post((unsigned*)(a.ws + WS_CTL) + CW_BAR, (volatile LAS unsigned*)((LAS unsigned char*)lds_raw + MISC_OFF) + 8);

#ifdef REP_STEP
    int rep_left = REP_N;
#endif
    for (int step = a.ph_lo; step < a.ph_hi; ++step) {
#ifdef REP_STEP
    const bool dry = (step == REP_STEP && rep_left > 0);
#else
    constexpr bool dry = false;
#endif
    int phase, L, pass = 0;
    if (step == 0) { phase = PH_PROLOGUE; L = 0; }
    else if (step < 6) { L = 0; const int s = step - 1; phase = s == 0 ? PH_INPROJ : s == 1 ? PH_MIX1 : s == 2 ? PH_OUTPROJ : s == 3 ? PH_FFNUP : PH_FFNDOWN; }
    else { L = 1; const int s = step - 6; phase = s == 0 ? PH_INPROJ : s == 1 ? PH_MIX1 : s == 2 ? PH_OUTPROJ : s == 3 ? PH_NORM : s == 4 ? PH_DISPATCH : s == 5 ? PH_MOEUP : s == 6 ? PH_MOEDOWN : PH_FINAL; }
#ifdef REP_NOP
    if (dry) phase = 1000;
#endif
    switch (phase) {
    case PH_PROLOGUE: {
        PHASE_ENTER
        float* scr = ldsf + wid * (128 * 33);
        const int gw = bid * 8 + wid, NGW = G * 8;
        constexpr int I_IN = 16 * 80, I_OUT = 16 * 32, I_G = 16 * 88, I_D = 44 * 32;
        constexpr int T0 = 2 * I_IN, T1 = T0 + 2 * I_OUT, T2 = T1 + I_G, T3 = T2 + I_G, T4 = T3 + I_D;
        for (int it = gw; it < T4; it += NGW) {
            if (it < T0) { const int l = it / I_IN, r = it % I_IN; cvt_item(IN(1) + (size_t)l * D * DIN, D, DIN, (bf16*)(ws + WS_WIN) + (size_t)l * DIN * D, 0, r, scr, lane, l == 1 ? IN(15) + D : nullptr); }
            else if (it < T1) { const int q = it - T0, l = q / I_OUT, r = q % I_OUT; cvt_item(IN(2) + (size_t)l * D * D, D, D, (bf16*)(ws + WS_WOUT) + (size_t)l * D * D, 0, r, scr, lane); }
            else if (it < T2) { cvt_item(IN(17), D, DFF, (bf16*)(ws + WS_WGU), 1, it - T1, scr, lane, IN(16)); }
            else if (it < T3) { cvt_item(IN(18), D, DFF, (bf16*)(ws + WS_WGU), 2, it - T2, scr, lane, IN(16)); }
            else { cvt_item(IN(19), DFF, D, (bf16*)(ws + WS_WD), 0, it - T3, scr, lane); }
        }
        for (int m = gw; m < NTOK; m += NGW) rms_row_bf16(IN(0) + (size_t)m * D, IN(15), HN + (size_t)m * D, lane);
        for (int idx = bid * NT + tid; idx < 3 * 2 * 4 * HD * HD; idx += G * NT) {
            const int mat = idx / (2 * 4 * HD * HD), r = idx % (2 * 4 * HD * HD), lh = r >> 12, j = (r >> 6) & 63, i = r & 63;
            const float* w = mat == 0 ? IN(5) : mat == 1 ? IN(7) : IN(12);
            (mat == 0 ? WTA : mat == 1 ? WTX : WTP)[r] = (bf16)f2bf(w[(lh * 64 + i) * 64 + j]);
        }
    } break;

    case PH_INPROJ: {
        PHASE_ENTER
        pg8::Gemm g{HN, (const bf16*)(ws + WS_WIN) + (size_t)L * DIN * D, NTOK, DIN, D, 0}; pg8::StaticOrder S; S.init(NTOK, DIN, G, bid);
        if (L == 0) { pg8::EpiStoreBf16 E{PROJ, DIN}; pg8::gemm_phase<pg8::EpiStoreBf16, pg8::StaticOrder, true, true>((PG8_LAS unsigned char*)lds_raw, g, S, E, tid); }
        else { pg8::fill_rstd_table((PG8_LAS unsigned char*)lds_raw, S, SSP1, tid); pg8::EpiStoreBf16R E{PROJ, DIN, (const PG8_LAS float*)((PG8_LAS unsigned char*)lds_raw + pg8::RSTD_TAB_OFF)}; pg8::gemm_phase<pg8::EpiStoreBf16R, pg8::StaticOrder, true, true>((PG8_LAS unsigned char*)lds_raw, g, S, E, tid); }
    } break;

    case PH_MIX1: {
        PHASE_ENTER
        {
        const float* conv_w = IN(3) + L * 4 * GW; const float* conv_b = IN(4) + L * GW;
        const float* b_a = IN(6) + L * GW; const float* b_x = IN(8) + L * GW;
        const float* lam = IN(9) + L * GW; const float* lbp = IN(10);
        unsigned char* AX = lds_raw; unsigned char* AINB = lds_raw + 35376;
        unsigned char* FS = lds_raw; unsigned char* KHTl = lds_raw; unsigned char* VTl = lds_raw + 36864; float* TOTl = (float*)(lds_raw + 73728);
        unsigned* PQ = (unsigned*)(lds_raw + PQ_OFF);
        for (int ci = bid; ci < NCHUNK; ci += G) {
            const int t0 = (ci % CPB) * CH, g0 = ci * CH; const bf16* prow = PROJ + (size_t)g0 * DIN;
            LruParams lp[2];
#pragma unroll
            for (int cc = 0; cc < 2; ++cc) lru_params_load(lp[cc], WTA + L * 16384, WTX + L * 16384, conv_w, conv_b, b_a, b_x, lam, wid >> 1, 2 * (wid & 1) + cc, lane);
            int lbi = 64 * (wid >> 1) + lane; asm volatile("" : "+v"(lbi)); const float lbv = L == 0 ? 0.f : sigmoidf_(lbp[GW + lbi] - lbp[lbi]);
            u32x4 rf[4], rv[4];
            {
                u32x4 rax[5];
                int tl1 = tid; asm volatile("" : "+v"(tl1) :: "memory");
                slab_load<5>(rax, prow - 3 * DIN, 67, t0 == 0 ? 3 : 0, tl1);
                slab_store<5>(rax, AX, 67, tid);
            }
            __syncthreads();
            lru_ainb(AX, conv_w, conv_b, AINB, tid);
            __syncthreads();
#pragma unroll
            for (int cc = 0; cc < 2; ++cc) {
                const int h = wid >> 1, nt = 2 * (wid & 1) + cc, fr = lane & 15, fq = lane >> 4, c = 64 * h + 16 * nt + fr; float av[4][4], uv[4][4];
                lru_gates(AINB, AX, lp[cc], h, nt, lane, av, uv);
                float Pin = 1.f, Qin = 0.f;
#pragma unroll
                for (int mt = 0; mt < 4; ++mt) {
                    float Ai[4], Hi[4]; float A_ = 1.f, H_ = 0.f;
#pragma unroll
                    for (int r = 0; r < 4; ++r) { H_ = av[mt][r] * H_ + uv[mt][r]; A_ *= av[mt][r]; Ai[r] = A_; Hi[r] = H_; }
                    const float a1 = __shfl_up(A_, 16), h1 = __shfl_up(H_, 16), a2 = __shfl_up(A_, 32), h2 = __shfl_up(H_, 32), a3 = __shfl_up(A_, 48), h3 = __shfl_up(H_, 48);
                    float EA = 1.f, EH = 0.f;
                    if (fq >= 3) { EA = a3; EH = h3; }
                    if (fq >= 2) { EH = a2 * EH + h2; EA *= a2; }
                    if (fq >= 1) { EH = a1 * EH + h1; EA *= a1; }
                    float Pt[4], Qt[4];
#pragma unroll
                    for (int r = 0; r < 4; ++r) { const float al = Ai[r] * EA, be = Ai[r] * EH + Hi[r]; Pt[r] = al * Pin; Qt[r] = al * Qin + be; PQ[(16 * mt + 4 * fq + r) * 256 + c] = pk2(Pt[r], Qt[r]); }
                    Pin = __shfl(Pt[3], 48 + fr); Qin = __shfl(Qt[3], 48 + fr);
                }
                if (lane < 16) { CARA[ci * GW + c] = Pin; CARH[ci * GW + c] = Qin; }
                if (cc == 0) { int tl2 = tid; asm volatile("" : "+v"(tl2) :: "memory"); slab_load<4>(rf, prow + 768, 64, 0, tl2); slab_load<4>(rv, prow + 1024, 64, 0, tl2); }
            }
            __syncthreads();
            slab_store<4>(rf, FS, 64, tid); vt_store(rv, VTl, tid);
            __syncthreads();
            {
                const int h = wid >> 1, half = wid & 1, c = 64 * h + lane, fr = lane & 15, fq = lane >> 4;
                const float lb = lbv;
                float gl[32], kk[32]; float run = 0.f;
#pragma unroll
                for (int t = 0; t < 32; ++t) { const float sg = sigmoidf_(bf2f(*(const bf16*)(FS + (32 * half + t) * RS + c * 2))); run += flog(lb + (1.f - lb) * sg); gl[t] = run; kk[t] = (1.f - lb) * (1.f - sg); }
                TOTl[(h * 2 + half) * 64 + lane] = run;
                __syncthreads();
                const float tot0 = TOTl[(h * 2) * 64 + lane], glast = tot0 + TOTl[(h * 2 + 1) * 64 + lane], off = half ? tot0 : 0.f;
#pragma unroll
                for (int j = 0; j < 4; ++j) { float e[8];
#pragma unroll
                    for (int q = 0; q < 8; ++q) e[q] = kk[8 * j + q] * fexp(glast - (off + gl[8 * j + q]));
                    u32x4 w; w.x = pk2(e[0], e[1]); w.y = pk2(e[2], e[3]); w.z = pk2(e[4], e[5]); w.w = pk2(e[6], e[7]);
                    *(u32x4*)(KHTl + c * VTS + (32 * half + 8 * j) * 2) = w; }
                if (half) DEC[(ci * 4 + h) * 64 + lane] = fexp(glast);
                __syncthreads();
#pragma unroll
                for (int vvv = 0; vvv < 2; ++vvv) {
                    const int vt = 2 * half + vvv, vrow = 64 * h + 16 * vt + fr; bf16x8 bv[2];
#pragma unroll
                    for (int ks = 0; ks < 2; ++ks) bv[ks] = *(const bf16x8*)(VTl + vt_off(vrow, 32 * ks + 8 * fq));
#pragma unroll
                    for (int kt = 0; kt < 4; ++kt) { f32x4 acc = (f32x4){0.f, 0.f, 0.f, 0.f};
#pragma unroll
                        for (int ks = 0; ks < 2; ++ks) { const bf16x8 ka = *(const bf16x8*)(KHTl + (64 * h + 16 * kt + fr) * VTS + (32 * ks + 8 * fq) * 2); acc = __builtin_amdgcn_mfma_f32_16x16x32_bf16(ka, bv[ks], acc, 0, 0, 0); }
                        *(f32x4*)(DS + ((size_t)(ci * 4 + h) * 64 + 16 * vt + fr) * 64 + 16 * kt + 4 * fq) = acc; }
                }
                __syncthreads();
            }
        }
        }
        xcd_arrive(bar, tid == 0);
        {
        const float* conv_w = IN(3) + L * 4 * GW; const float* conv_b = IN(4) + L * GW; const float* b_a = IN(6) + L * GW; const float* b_x = IN(8) + L * GW; const float* lam = IN(9) + L * GW;
        const float* lbp = IN(10); const float* norm_g = IN(11) + L * HD; const float* pool_s = IN(13) + L * GW; const float* sconv_w = IN(14) + L * 3 * GW;
        unsigned char* AX = lds_raw; unsigned char* AG = lds_raw + 35376; unsigned char* AINB = lds_raw + 69168;
        unsigned char* QT3 = lds_raw; unsigned char* KT3 = lds_raw + 33792; unsigned char* OG3 = lds_raw + 67584; unsigned char* VT3 = lds_raw + 101376; float* TOT3 = (float*)(lds_raw + 138240);
        unsigned char* PS = lds_raw; unsigned char* DIMG = lds_raw + 41712; unsigned char* YST = lds_raw;
        unsigned char* SB = lds_raw; unsigned char* SC = lds_raw + 33792; unsigned char* SX = lds_raw + 68640;
        for (int ci = bid; ci < NCHUNK; ci += G) {
            const int t0 = (ci % CPB) * CH, g0 = ci * CH; const bf16* prow = PROJ + (size_t)g0 * DIN; bf16* yrow = Y + (size_t)g0 * D; (void)t0; (void)yrow;
            { u32x4 rp[5]; int tlc = tid; asm volatile("" : "+v"(tlc) :: "memory"); slab_load<5>(rp, prow - 15 * DIN + 1536, 79, t0 == 0 ? 15 : 0, tlc); slab_store<5>(rp, PS, 79, tid); }
            __syncthreads();
            for (int idx = tid; idx < CH * 128; idx += NT) {
                const int t = idx >> 7, c = (idx & 127) * 2, gi = c >> 6, w = 2 << gi; const int tt = t0 + t; const int cnt = (tt + 1 < w) ? (tt + 1) : w; float s0 = 0.f, s1 = 0.f; unsigned xs[16];
#pragma unroll
                for (int r = 0; r < 16; ++r) xs[r] = *(const unsigned*)(PS + (t + 15 - r) * RS + c * 2);
#pragma unroll
                for (int r = 0; r < 16; ++r) { const float m_ = r < cnt ? 1.0f : 0.0f; s0 += m_ * bf2f(xs[r] & 0xffffu); s1 += m_ * bf2f(xs[r] >> 16); }
                const float inv = __builtin_amdgcn_rcpf((float)cnt);
                *(unsigned*)(DIMG + t * RS + c * 2) = pk2(s0 * inv - bf2f(xs[0] & 0xffffu), s1 * inv - bf2f(xs[0] >> 16));
            }
            __syncthreads();
#pragma unroll 1
            for (int cc = 0; cc < 2; ++cc) {
                const int gi = wid >> 1, nt = 2 * (wid & 1) + cc, fr = lane & 15, fq = lane >> 4, c = 64 * gi + 16 * nt + fr; bf16x8 wp[2];
#pragma unroll
                for (int ks = 0; ks < 2; ++ks) wp[ks] = *(const bf16x8*)(WTP + L * 16384 + (size_t)(gi * 64 + 16 * nt + fr) * 64 + 32 * ks + 8 * fq);
                const float psc = pool_s[c];
#pragma unroll
                for (int mt = 0; mt < 4; ++mt) { f32x4 acc = (f32x4){0.f, 0.f, 0.f, 0.f};
#pragma unroll
                    for (int ks = 0; ks < 2; ++ks) { const bf16x8 x = *(const bf16x8*)(DIMG + (16 * mt + fr) * RS + (64 * gi + 32 * ks + 8 * fq) * 2); acc = __builtin_amdgcn_mfma_f32_16x16x32_bf16(x, wp[ks], acc, 0, 0, 0); }
#pragma unroll
                    for (int r = 0; r < 4; ++r) *(bf16*)(YST + (16 * mt + 4 * fq + r) * RS + c * 2) = (bf16)f2bf(acc[r] * psc); }
            }
            __syncthreads();
            ytile_store(YST, yrow + 512, tid);
            __syncthreads();
        }
        }
        xcd_wait(bar, tid == 0);
        {
        float* xa = ldsf; float* xs = ldsf + 512;
        for (int item = bid; item < 256 + 8; item += G) {
            if (item < 256) {
                const int el = tid & 127, seg = tid >> 7, e = item * 128 + el, b = e >> 14, hh = (e >> 12) & 3, kv = e & 4095, k = kv & 63;
                float dv[32], dc[32];
#pragma unroll
                for (int i = 0; i < 32; ++i) { const int ci = b * CPB + seg * 32 + i; dv[i] = DS[(size_t)(ci * 4 + hh) * 4096 + kv]; dc[i] = DEC[(ci * 4 + hh) * 64 + k]; }
                float S = 0.f, A = 1.f;
#pragma unroll
                for (int i = 0; i < 32; ++i) { const float d = dv[i]; dv[i] = S; S = dc[i] * S + d; const float a0 = dc[i]; dc[i] = A; A *= a0; }
                xa[seg * 128 + el] = A; xs[seg * 128 + el] = S;
                __syncthreads();
                float Sin = 0.f;
                for (int s2 = 0; s2 < seg; ++s2) Sin = xa[s2 * 128 + el] * Sin + xs[s2 * 128 + el];
#pragma unroll
                for (int i = 0; i < 32; ++i) { const int ci = b * CPB + seg * 32 + i; (dry ? DS + 20 * (MiB / 4) * 4 : DS)[(size_t)(ci * 4 + hh) * 4096 + kv] = dv[i] + dc[i] * Sin; }
                __syncthreads();
            } else {
                const int q = item - 256, sq = tid & 63, chg = q * 64 + sq, b = chg >> 8, c = chg & 255, seg = tid >> 6;
                float ca[16], chh[16];
#pragma unroll
                for (int i = 0; i < 16; ++i) { const int ci = b * CPB + seg * 16 + i; ca[i] = CARA[ci * GW + c]; chh[i] = CARH[ci * GW + c]; }
                float A = 1.f, H = 0.f;
#pragma unroll
                for (int i = 0; i < 16; ++i) { const float a0 = ca[i], h0 = chh[i]; ca[i] = A; chh[i] = H; H = a0 * H + h0; A *= a0; }
                xa[seg * 64 + sq] = A; xs[seg * 64 + sq] = H;
                __syncthreads();
                float Hin = 0.f;
                for (int s2 = 0; s2 < seg; ++s2) Hin = xa[s2 * 64 + sq] * Hin + xs[s2 * 64 + sq];
#pragma unroll
                for (int i = 0; i < 16; ++i) { const int ci = b * CPB + seg * 16 + i; CIN[ci * GW + c] = chh[i] + ca[i] * Hin; }
                __syncthreads();
            }
        }
        }
        xcd_arrive(bar, tid == 0);
        {
        const float* conv_w = IN(3) + L * 4 * GW; const float* conv_b = IN(4) + L * GW; const float* b_a = IN(6) + L * GW; const float* b_x = IN(8) + L * GW; const float* lam = IN(9) + L * GW;
        const float* lbp = IN(10); const float* norm_g = IN(11) + L * HD; const float* pool_s = IN(13) + L * GW; const float* sconv_w = IN(14) + L * 3 * GW;
        unsigned char* AX = lds_raw; unsigned char* AG = lds_raw + 35376; unsigned char* AINB = lds_raw + 69168;
        unsigned char* QT3 = lds_raw; unsigned char* KT3 = lds_raw + 33792; unsigned char* OG3 = lds_raw + 67584; unsigned char* VT3 = lds_raw + 101376; float* TOT3 = (float*)(lds_raw + 138240);
        unsigned char* PS = lds_raw; unsigned char* DIMG = lds_raw + 41712; unsigned char* YST = lds_raw;
        unsigned char* SB = lds_raw; unsigned char* SC = lds_raw + 33792; unsigned char* SX = lds_raw + 68640;
        for (int ci = bid; ci < NCHUNK; ci += G) {
            const int t0 = (ci % CPB) * CH, g0 = ci * CH; const bf16* prow = PROJ + (size_t)g0 * DIN; bf16* yrow = Y + (size_t)g0 * D; (void)t0; (void)yrow;
            { u32x4 rsb[4], rsc[5], rsx[5]; int tld = tid; asm volatile("" : "+v"(tld) :: "memory"); slab_load<4>(rsb, prow + 1792, 64, 0, tld); slab_load<5>(rsc, prow - 2 * DIN + 2048, 66, t0 == 0 ? 2 : 0, tld); slab_load<5>(rsx, prow - 2 * DIN + 2304, 66, t0 == 0 ? 2 : 0, tld);
#pragma unroll
              for (int j = 0; j < 5; ++j) {
                  const unsigned a[4] = {rsc[j].x, rsc[j].y, rsc[j].z, rsc[j].w}, b[4] = {rsx[j].x, rsx[j].y, rsx[j].z, rsx[j].w}; unsigned p[4];
#pragma unroll
                  for (int q = 0; q < 4; ++q) p[q] = pk2(bf2f(a[q] & 0xffffu) * bf2f(b[q] & 0xffffu), bf2f(a[q] >> 16) * bf2f(b[q] >> 16));
                  rsc[j] = (u32x4){p[0], p[1], p[2], p[3]}; }
              slab_store<4>(rsb, SB, 64, tid); slab_store<5>(rsc, SC, 66, tid); }
            __syncthreads();
            int tq = tid; asm volatile("" : "+v"(tq));
            for (int idx = tq; idx < CH * 128; idx += NT) {
                const int t = idx >> 7, c = (idx & 127) * 2; float a0 = 0.f, a1 = 0.f;
#pragma unroll
                for (int k = 0; k < 3; ++k) { const unsigned xc = *(const unsigned*)(SC + (t + k) * RS + c * 2); a0 += sconv_w[k * GW + c] * bf2f(xc & 0xffffu); a1 += sconv_w[k * GW + c + 1] * bf2f(xc >> 16); }
                unsigned* pb = (unsigned*)(SB + t * RS + c * 2); const unsigned b = *pb; *pb = pk2(bf2f(b & 0xffffu) * a0, bf2f(b >> 16) * a1);
            }
            __syncthreads();
            ytile_store(SB, yrow + 768, tid);
            __syncthreads();
        }
        }
        xcd_wait(bar, tid == 0);
        {
        const float* conv_w = IN(3) + L * 4 * GW; const float* conv_b = IN(4) + L * GW; const float* b_a = IN(6) + L * GW; const float* b_x = IN(8) + L * GW; const float* lam = IN(9) + L * GW;
        const float* lbp = IN(10); const float* norm_g = IN(11) + L * HD; const float* pool_s = IN(13) + L * GW; const float* sconv_w = IN(14) + L * 3 * GW;
        unsigned char* AX = lds_raw; unsigned char* AG = lds_raw + 35376; unsigned char* AINB = lds_raw + 69168;
        unsigned char* QT3 = lds_raw; unsigned char* KT3 = lds_raw + 33792; unsigned char* OG3 = lds_raw + 67584; unsigned char* VT3 = lds_raw + 101376; float* TOT3 = (float*)(lds_raw + 138240);
        unsigned char* PS = lds_raw; unsigned char* DIMG = lds_raw + 41712; unsigned char* YST = lds_raw;
        unsigned char* SB = lds_raw; unsigned char* SC = lds_raw + 33792; unsigned char* SX = lds_raw + 68640;
        for (int ci = bid; ci < NCHUNK; ci += G) {
            const int t0 = (ci % CPB) * CH, g0 = ci * CH; const bf16* prow = PROJ + (size_t)g0 * DIN; bf16* yrow = Y + (size_t)g0 * D; (void)t0; (void)yrow;
            int lbi = 64 * (wid >> 1) + lane; asm volatile("" : "+v"(lbi)); const float lbv = L == 0 ? 0.f : sigmoidf_(lbp[GW + lbi] - lbp[lbi]);
            { unsigned* PQ = (unsigned*)(lds_raw + PQ_OFF);
              const int c = (tid & 127) * 2; const float hin_a = CIN[ci * GW + c], hin_b = CIN[ci * GW + c + 1];
              unsigned ag[16];
#pragma unroll
              for (int i = 0; i < 16; ++i) ag[i] = *(const unsigned*)(prow + (size_t)(4 * i + (tid >> 7)) * DIN + 256 + c);
#pragma unroll
              for (int i = 0; i < 16; ++i) { const int t = 4 * i + (tid >> 7); const unsigned pa = PQ[t * 256 + c], pb = PQ[t * 256 + c + 1];
                  const float ha = bf2f(pa & 0xffffu) * hin_a + bf2f(pa >> 16), hb = bf2f(pb & 0xffffu) * hin_b + bf2f(pb >> 16);
                  *(unsigned*)(yrow + (size_t)t * D + c) = pk2(ha * gelu_tanh(bf2f(ag[i] & 0xffffu)), hb * gelu_tanh(bf2f(ag[i] >> 16))); }
            }
            __syncthreads();
            { u32x4 rq[4], rf[4], rv[4], rog[4]; int tlb = tid; asm volatile("" : "+v"(tlb) :: "memory"); slab_load<4>(rq, prow + 512, 64, 0, tlb); slab_load<4>(rf, prow + 768, 64, 0, tlb); slab_load<4>(rv, prow + 1024, 64, 0, tlb); slab_load<4>(rog, prow + 1280, 64, 0, tlb);
              slab_store<4>(rq, QT3, 64, tid); slab_store<4>(rf, KT3, 64, tid); slab_store<4>(rog, OG3, 64, tid); vt_store(rv, VT3, tid); }
            __syncthreads();
            {
                const int h = wid >> 1, half = wid & 1, c = 64 * h + lane, fr = lane & 15, fq = lane >> 4;
                const float lb = lbv;
                f32x4 sraw[4][2][2];
#pragma unroll
                for (int vt = 0; vt < 4; ++vt)
#pragma unroll
                    for (int ks = 0; ks < 2; ++ks) { const float* p = DS + ((size_t)(ci * 4 + h) * 64 + 16 * vt + fr) * 64 + 32 * ks + 8 * fq; sraw[vt][ks][0] = *(const f32x4*)p; sraw[vt][ks][1] = *(const f32x4*)(p + 4); }
                float gl[32]; float run = 0.f;
#pragma unroll
                for (int t = 0; t < 32; ++t) { const float sg = sigmoidf_(bf2f(*(const bf16*)(KT3 + (32 * half + t) * RS + c * 2))); run += flog(lb + (1.f - lb) * sg); gl[t] = run; }
                TOT3[(h * 2 + half) * 64 + lane] = run;
                __syncthreads();
                const float tot0 = TOT3[(h * 2) * 64 + lane];
                const float off = half ? 0.f : -tot0;
#pragma unroll
                for (int t = 0; t < 32; ++t) {
                    bf16* pq = (bf16*)(QT3 + (32 * half + t) * RS + c * 2); bf16* pk = (bf16*)(KT3 + (32 * half + t) * RS + c * 2);
                    const float sg = sigmoidf_(bf2f(*pk)), kkv = (1.f - lb) * (1.f - sg), qfv = siluf_(bf2f(*pq)), d = gl[t] + off;
                    *pq = (bf16)f2bf(qfv * fexp(d)); *pk = (bf16)f2bf(kkv * fexp(-d));
                }
                __syncthreads();
                bf16x8 sa[4][2];
#pragma unroll
                for (int vt = 0; vt < 4; ++vt)
#pragma unroll
                    for (int ks = 0; ks < 2; ++ks) {
                        const f32x4 lo = sraw[vt][ks][0], hi = sraw[vt][ks][1];
                        const float* eg = TOT3 + (h * 2) * 64 + 32 * ks + 8 * fq;
                        u32x4 w; w.x = pk2(lo.x * fexp(eg[0]), lo.y * fexp(eg[1])); w.y = pk2(lo.z * fexp(eg[2]), lo.w * fexp(eg[3])); w.z = pk2(hi.x * fexp(eg[4]), hi.y * fexp(eg[5])); w.w = pk2(hi.z * fexp(eg[6]), hi.w * fexp(eg[7]));
                        sa[vt][ks] = __builtin_bit_cast(bf16x8, w);
                    }
#pragma unroll
                for (int tsel = 0; tsel < 2; ++tsel) {
                    const int ti = half == 0 ? (tsel ? 3 : 0) : (tsel ? 2 : 1);
                    bf16x8 qb[2];
#pragma unroll
                    for (int ks = 0; ks < 2; ++ks) qb[ks] = *(const bf16x8*)(QT3 + (16 * ti + fr) * RS + (64 * h + 32 * ks + 8 * fq) * 2);
                    f32x4 st[4];
#pragma unroll
                    for (int si = 0; si < 4; ++si) { st[si] = (f32x4){0.f, 0.f, 0.f, 0.f};
                        if (si <= ti) {
#pragma unroll
                            for (int ks = 0; ks < 2; ++ks) { const bf16x8 ka = *(const bf16x8*)(KT3 + (16 * si + fr) * RS + (64 * h + 32 * ks + 8 * fq) * 2); st[si] = __builtin_amdgcn_mfma_f32_16x16x32_bf16(ka, qb[ks], st[si], 0, 0, 0); }
                            if (si == ti) {
#pragma unroll
                                for (int r = 0; r < 4; ++r) if (4 * fq + r > fr) st[si][r] = 0.f; }
                        } }
                    f32x4 oo[4];
#pragma unroll
                    for (int vt = 0; vt < 4; ++vt) { oo[vt] = (f32x4){0.f, 0.f, 0.f, 0.f};
#pragma unroll
                        for (int ks = 0; ks < 2; ++ks) oo[vt] = __builtin_amdgcn_mfma_f32_16x16x32_bf16(sa[vt][ks], qb[ks], oo[vt], 0, 0, 0); }
#pragma unroll
                    for (int p = 0; p < 2; ++p) if (2 * p <= ti) {
                        u32x4 bw; bw.x = pk2(st[2 * p][0], st[2 * p][1]); bw.y = pk2(st[2 * p][2], st[2 * p][3]); bw.z = pk2(st[2 * p + 1][0], st[2 * p + 1][1]); bw.w = pk2(st[2 * p + 1][2], st[2 * p + 1][3]);
                        const bf16x8 bfr = __builtin_bit_cast(bf16x8, bw);
#pragma unroll
                        for (int vt = 0; vt < 4; ++vt) { const int vrow = 64 * h + 16 * vt + fr; const u32x2 lo8 = *(const u32x2*)(VT3 + vt_off(vrow, 32 * p + 4 * fq)), hi8 = *(const u32x2*)(VT3 + vt_off(vrow, 32 * p + 16 + 4 * fq));
                            u32x4 aw; aw.x = lo8.x; aw.y = lo8.y; aw.z = hi8.x; aw.w = hi8.y;
                            oo[vt] = __builtin_amdgcn_mfma_f32_16x16x32_bf16(__builtin_bit_cast(bf16x8, aw), bfr, oo[vt], 0, 0, 0); }
                    }
                    float ss = 0.f;
#pragma unroll
                    for (int vt = 0; vt < 4; ++vt) ss += (oo[vt][0] * oo[vt][0] + oo[vt][1] * oo[vt][1]) + (oo[vt][2] * oo[vt][2] + oo[vt][3] * oo[vt][3]);
                    ss += __shfl_xor(ss, 16); ss += __shfl_xor(ss, 32);
                    const float rs = __builtin_amdgcn_rsqf(ss * (1.0f / HD) + 1e-5f);
#pragma unroll
                    for (int vt = 0; vt < 4; ++vt) { const int cv = 64 * h + 16 * vt + 4 * fq; u32x2* pog = (u32x2*)(OG3 + (16 * ti + fr) * RS + cv * 2); const u32x2 og = *pog; const f32x4 ng = *(const f32x4*)(norm_g + 16 * vt + 4 * fq);
                        u32x2 w; w.x = pk2(oo[vt][0] * rs * ng.x * siluf_(bf2f(og.x & 0xffffu)), oo[vt][1] * rs * ng.y * siluf_(bf2f(og.x >> 16))); w.y = pk2(oo[vt][2] * rs * ng.z * siluf_(bf2f(og.y & 0xffffu)), oo[vt][3] * rs * ng.w * siluf_(bf2f(og.y >> 16)));
                        *pog = w; }
                }
                __syncthreads();
            }
            ytile_store(OG3, yrow + 256, tid);
            __syncthreads();
        }
        }
    } break;

    case PH_OUTPROJ: {
        PHASE_ENTER
        pg8::Gemm g{Y, (const bf16*)(ws + WS_WOUT) + (size_t)L * D * D, NTOK, D, D, 0}; pg8::StaticOrder S; S.init(NTOK, D, G, bid);
        if (L == 0) { pg8::EpiResidStats E{IN(0), hres, HN, SSP0}; pg8::gemm_phase<pg8::EpiResidStats, pg8::StaticOrder, true, true>((PG8_LAS unsigned char*)lds_raw, g, S, E, tid); }
        else { pg8::EpiResidF32 E{hres, hres}; pg8::gemm_phase<pg8::EpiResidF32, pg8::StaticOrder, true, true>((PG8_LAS unsigned char*)lds_raw, g, S, E, tid); }
    } break;

    case PH_NORM: {
        PHASE_ENTER
        const float* g = pass == 0 ? IN(16) + L * D : IN(15) + D;
        const bool route = (L == 1 && pass == 0);
        int* sel = (int*)lds_raw;
        for (int blk = bid; blk < NTOK / 64; blk += G) {
            if (!route) {
                for (int r8 = 0; r8 < 8; ++r8) { const int m = blk * 64 + wid * 8 + r8; rms_row_bf16(hres + (size_t)m * D, g, HN + (size_t)m * D, lane); }
            } else {
                float wr[16][8];
                { const float* wr_ = IN(20);
#pragma unroll
                  for (int j = 0; j < 4; ++j)
#pragma unroll
                    for (int q = 0; q < 4; ++q) { const f32x4 w0 = *(const f32x4*)(wr_ + (size_t)(4 * (lane + 64 * j) + q) * 8), w1 = *(const f32x4*)(wr_ + (size_t)(4 * (lane + 64 * j) + q) * 8 + 4);
                        wr[j * 4 + q][0] = w0.x; wr[j * 4 + q][1] = w0.y; wr[j * 4 + q][2] = w0.z; wr[j * 4 + q][3] = w0.w; wr[j * 4 + q][4] = w1.x; wr[j * 4 + q][5] = w1.y; wr[j * 4 + q][6] = w1.z; wr[j * 4 + q][7] = w1.w; } }
                f32x4 gv[4];
#pragma unroll
                for (int j = 0; j < 4; ++j) gv[j] = ((const f32x4*)g)[lane + 64 * j];
#pragma unroll 1
                for (int r8 = 0; r8 < 8; ++r8) {
                    const int tl = wid * 8 + r8, m = blk * 64 + tl; const f32x4* xr = (const f32x4*)(hres + (size_t)m * D);
                    f32x4 v[4]; float s = 0.f;
#pragma unroll
                    for (int j = 0; j < 4; ++j) { v[j] = xr[lane + 64 * j]; s += (v[j].x * v[j].x + v[j].y * v[j].y) + (v[j].z * v[j].z + v[j].w * v[j].w); }
                    const float r = 1.0f / sqrtf(wave_sum(s) * (1.0f / D) + 1e-6f);
                    float lg[8] = {0.f, 0.f, 0.f, 0.f, 0.f, 0.f, 0.f, 0.f};
#pragma unroll
                    for (int j = 0; j < 4; ++j) { const float y[4] = {v[j].x * r * gv[j].x, v[j].y * r * gv[j].y, v[j].z * r * gv[j].z, v[j].w * r * gv[j].w};
#pragma unroll
                        for (int q = 0; q < 4; ++q)
#pragma unroll
                            for (int e = 0; e < 8; ++e) lg[e] += y[q] * wr[j * 4 + q][e]; }
#pragma unroll
                    for (int e = 0; e < 8; ++e) lg[e] = wave_sum(lg[e]);
                    if (lane == 0) {
                        int e1 = 0; float l1 = lg[0];
#pragma unroll
                        for (int e = 1; e < 8; ++e) if (lg[e] > l1) { l1 = lg[e]; e1 = e; }
                        int e2 = -1; float l2 = -3.0e38f;
#pragma unroll
                        for (int e = 0; e < 8; ++e) if (e != e1 && lg[e] > l2) { l2 = lg[e]; e2 = e; }
                        const float g1 = 1.0f / (1.0f + fexp(l2 - l1));
                        TOKE[m * 2] = e1; TOKE[m * 2 + 1] = e2; TOKG[m * 2] = g1; TOKG[m * 2 + 1] = 1.0f - g1;
                        sel[tl * 2] = e1; sel[tl * 2 + 1] = e2; RSTD[m] = r;
                    }
                }
                __syncthreads();
                if (tid < NE) { int cnt = 0; for (int q = 0; q < 128; ++q) if (sel[q] == tid) { TOKR[blk * 128 + q] = cnt; ++cnt; } BCNT[blk * NE + tid] = cnt; }
                __syncthreads();
            }
        }
    } break;

    case PH_FFNUP: {
        PHASE_ENTER
        pg8::Gemm g{HN, (const bf16*)(ws + WS_WGU), NTOK, 2 * DFF, D, 0}; pg8::StaticOrder S; S.init(NTOK, 2 * DFF, G, bid);
        pg8::fill_rstd_table((PG8_LAS unsigned char*)lds_raw, S, SSP0, tid);
        pg8::EpiSwigluR E{HID, DFF, (const PG8_LAS float*)((PG8_LAS unsigned char*)lds_raw + pg8::RSTD_TAB_OFF)};
        pg8::gemm_phase<pg8::EpiSwigluR, pg8::StaticOrder, true, true>((PG8_LAS unsigned char*)lds_raw, g, S, E, tid);
    } break;

    case PH_FFNDOWN: {
        PHASE_ENTER
        pg8::Gemm g{HID, (const bf16*)(ws + WS_WD), NTOK, D, DFF, 0}; pg8::StaticOrder S; S.init(NTOK, D, G, bid);
        pg8::EpiResidStats E{hres, dry ? (float*)(ws + 410 * MiB) : hres, HN, SSP1};
        pg8::gemm_phase<pg8::EpiResidStats, pg8::StaticOrder, true, true>((PG8_LAS unsigned char*)lds_raw, g, S, E, tid);
    } break;

    case PH_DISPATCH: {
        PHASE_ENTER
        int* sh = (int*)lds_raw;
        const f32x4* gr = (const f32x4*)(IN(16) + D);
        for (int blk = bid; blk < NTOK / 64; blk += G) {
            { int* cnts = sh + 64;
              for (int i = tid; i < (NTOK / 64) * NE; i += NT) cnts[i] = BCNT[i];
              __syncthreads();
              { const int e = wid; int sall = 0, slt = 0;
#pragma unroll
                for (int i = 0; i < 4; ++i) { const int b2 = 4 * lane + i, c = cnts[b2 * NE + e]; sall += c; slt += (b2 < blk) ? c : 0; }
#pragma unroll
                for (int o = 1; o < 64; o <<= 1) { sall += __shfl_xor(sall, o); slt += __shfl_xor(slt, o); }
                if (lane == 0) { sh[e] = sall; sh[16 + e] = slt; sh[24 + e] = (sall + 255) >> 8; } } }
            __syncthreads();
            if (tid == 0) { int acc = 0; for (int e = 0; e < NE; ++e) { sh[8 + e] = acc * 256; acc += sh[24 + e]; } sh[32] = acc; }
            __syncthreads();
            if (tid < 128) { const int m = blk * 64 + (tid >> 1); const int e = TOKE[blk * 128 + tid]; const int r = sh[8 + e] + sh[16 + e] + TOKR[blk * 128 + tid];
                ROWDST[r] = m * 2 + (tid & 1); ROWG[r] = TOKG[blk * 128 + tid]; TOKROW[blk * 128 + tid] = r; }
            for (int r8 = 0; r8 < 8; ++r8) {
                const int m = blk * 64 + wid * 8 + r8; const int e0 = TOKE[m * 2], e1 = TOKE[m * 2 + 1];
                const int r0 = sh[8 + e0] + sh[16 + e0] + TOKR[m * 2], r1 = sh[8 + e1] + sh[16 + e1] + TOKR[m * 2 + 1];
                const float rs = RSTD[m]; const f32x4* xr = (const f32x4*)(hres + (size_t)m * D);
                unsigned* o0 = (unsigned*)(XR + (size_t)r0 * D); unsigned* o1 = (unsigned*)(XR + (size_t)r1 * D);
#pragma unroll
                for (int j = 0; j < 4; ++j) { const f32x4 v = xr[lane + 64 * j], gv = gr[lane + 64 * j]; const unsigned w = pg8::pk4_fp8(v.x * rs * gv.x, v.y * rs * gv.y, v.z * rs * gv.z, v.w * rs * gv.w); o0[lane + 64 * j] = w; o1[lane + 64 * j] = w; }
            }
            if (blk == 0) {
                for (int e = 0; e < NE; ++e) { const int lo = sh[8 + e] + sh[e], hi = sh[8 + e] + sh[24 + e] * 256; for (int r = lo + tid; r < hi; r += NT) { ROWDST[r] = -1; ROWG[r] = 0.f; } }
                if (tid < MAXTILES) { int e = 0; for (int q = 0; q < NE; ++q) if (tid * 256 >= sh[8 + q]) e = q; TILEE[tid] = e; }
                if (tid == 0) TILEE[MAXTILES] = sh[32];
            }
            __syncthreads();
        }
    } break;

    case PH_MOEUP: {
        PHASE_ENTER
        const int ntiles = __builtin_amdgcn_readfirstlane(__hip_atomic_load(TILEE + MAXTILES, __ATOMIC_RELAXED, __HIP_MEMORY_SCOPE_AGENT));
        pg8::Gemm g{(const bf16*)XR, (const bf16*)(ws + WS_W13), 0, 0, D / 2, 0}; pg8::MoeOrder S; S.init(ntiles, DFFE / 128, G, bid, 0, 0, TILEE);
        pg8::EpiSwiglu8 E{HIDE, DFFE, 1.0f / W13_SCALE, HID_SCALE};
        pg8::gemm_phase<pg8::EpiSwiglu8, pg8::MoeOrder, true, true, true>((PG8_LAS unsigned char*)lds_raw, g, S, E, tid);
    } break;

    case PH_MOEDOWN: {
        PHASE_ENTER
        const int ntiles = __builtin_amdgcn_readfirstlane(__hip_atomic_load(TILEE + MAXTILES, __ATOMIC_RELAXED, __HIP_MEMORY_SCOPE_AGENT));
        const int tfull = (ntiles / 64) * 64, ntail = ntiles - tfull;
        if (tfull > 0) {
            pg8::Gemm g{(const bf16*)HIDE, (const bf16*)(ws + WS_W2), 0, 0, DFFE / 2, 0}; pg8::MoeOrder S; S.init(tfull, D / 256, G, bid, 0, 0, TILEE);
            pg8::EpiMoeDown E{OUT2, ROWDST, ROWG, 1.0f / (W2_SCALE * HID_SCALE)};
            pg8::gemm_phase<pg8::EpiMoeDown, pg8::MoeOrder, true, true, true>((PG8_LAS unsigned char*)lds_raw, g, S, E, tid);
        }
        if (ntail > 0) {
            const int Sp = moe_tail_split(ntail);
            pg8::Gemm g{(const bf16*)HIDE, (const bf16*)(ws + WS_W2), 0, 0, DFFE / 2 / Sp, DFFE / 2};
            pg8::MoeTailOrder S{tfull, ntail, D / 256, Sp, G, bid, DFFE / Sp, TILEE};
            pg8::EpiPartF32 E{PART};
            pg8::gemm_phase<pg8::EpiPartF32, pg8::MoeTailOrder, true, true, true>((PG8_LAS unsigned char*)lds_raw, g, S, E, tid);
        }
    } break;

    case PH_FINAL: {
        PHASE_ENTER
        const float* g = IN(24); const int gw = bid * 8 + wid, NGW = G * 8;
        const int ntiles = __builtin_amdgcn_readfirstlane(__hip_atomic_load(TILEE + MAXTILES, __ATOMIC_RELAXED, __HIP_MEMORY_SCOPE_AGENT));
        const int tfull = (ntiles / 64) * 64, ntail = ntiles - tfull, Sp = ntail > 0 ? moe_tail_split(ntail) : 1, tail_row0 = tfull * 256; const float sc = 1.0f / (W2_SCALE * HID_SCALE);
        for (int mb = gw; mb < NTOK; mb += 8 * NGW) {
        int trow[8][2];
#pragma unroll
        for (int k = 0; k < 8; ++k) { const int m = mb + k * NGW; trow[k][0] = m < NTOK ? TOKROW[2 * m] : 0; trow[k][1] = m < NTOK ? TOKROW[2 * m + 1] : 0; }
#pragma unroll
        for (int k = 0; k < 8; ++k) { const int m = mb + k * NGW; if (m >= NTOK) break;
            f32x4* xr = (f32x4*)(hres + (size_t)m * D); const f32x4* gr = (const f32x4*)g;
            f32x4 v[4]; u32x2 ob[2][4]; float s = 0.f;
#pragma unroll
            for (int j = 0; j < 4; ++j) { v[j] = xr[lane + 64 * j]; ob[0][j] = ((const u32x2*)(OUT2 + (size_t)(2 * m) * D))[lane + 64 * j]; ob[1][j] = ((const u32x2*)(OUT2 + (size_t)(2 * m + 1) * D))[lane + 64 * j]; }
#pragma unroll
            for (int slot = 0; slot < 2; ++slot) {
                const int r = __builtin_amdgcn_readfirstlane(trow[k][slot]);
                if (r < tail_row0) {
#pragma unroll
                    for (int j = 0; j < 4; ++j) { const u32x2 p = ob[slot][j]; v[j].x += bf2f(p.x & 0xffffu); v[j].y += bf2f(p.x >> 16); v[j].z += bf2f(p.y & 0xffffu); v[j].w += bf2f(p.y >> 16); } }
                else { const int tl = (r - tail_row0) >> 8, rl = (r - tail_row0) & 255; const float gt = TOKG[2 * m + slot] * sc;
                    f32x4 q[7][4];
#pragma unroll
                    for (int p = 0; p < 7; ++p) { const f32x4* pr = (const f32x4*)(PART + ((size_t)(tl * Sp + (p < Sp ? p : 0)) * 256 + rl) * 1024);
#pragma unroll
                        for (int j = 0; j < 4; ++j) q[p][j] = pr[lane + 64 * j]; }
#pragma unroll
                    for (int p = 0; p < 7; ++p) { const float gp = p < Sp ? gt : 0.f;
#pragma unroll
                        for (int j = 0; j < 4; ++j) { v[j].x += gp * q[p][j].x; v[j].y += gp * q[p][j].y; v[j].z += gp * q[p][j].z; v[j].w += gp * q[p][j].w; } } }
            }
#pragma unroll
            for (int j = 0; j < 4; ++j) s += (v[j].x * v[j].x + v[j].y * v[j].y) + (v[j].z * v[j].z + v[j].w * v[j].w);
            const float r = 1.0f / sqrtf(wave_sum(s) * (1.0f / D) + 1e-6f);
#pragma unroll
            for (int j = 0; j < 4; ++j) { const f32x4 gv = gr[lane + 64 * j]; (dry ? (f32x4*)((float*)(ws + 410 * MiB) + (size_t)m * D) : xr)[lane + 64 * j] = (f32x4){v[j].x * r * gv.x, v[j].y * r * gv.y, v[j].z * r * gv.z, v[j].w * r * gv.w}; }
        }
        }
    } break;
    }
    if (phase == PH_INPROJ || phase == PH_FFNUP || phase == PH_DISPATCH) {
        int t_ = wid_s * 64 + lane_id_asm(); asm volatile("" : "+v"(t_));
        __attribute__((address_space(1))) unsigned char* wsq_ = (__attribute__((address_space(1))) unsigned char*)a.ws; asm volatile("" : "+s"(wsq_)); unsigned char* ws_ = (unsigned char*)wsq_; int G_ = gridDim.x; asm volatile("" : "+s"(G_));
        bg_convert(ws_, lds_raw, IN(21), IN(22), IN(23), step, G_, t_, phase == PH_DISPATCH);
    }
    if (step + 1 < a.ph_hi) { int t_ = wid_s * 64 + lane_id_asm(); asm volatile("" : "+v"(t_)); xcd_barrier(bar, t_ == 0); }
#ifdef REP_STEP
    if (dry) { --rep_left; --step; }
#endif
    }
}

constexpr int NSTEPS = 14;
#ifndef MK_PER_PHASE
#define MK_PER_PHASE 0
#endif

extern "C" void kernel_launch(void* const* d_in, const int* in_sizes, int n_in, void* d_out, int out_size, void* d_ws, size_t ws_size, hipStream_t stream) {
    static int grid = 0;
    if (grid == 0) {
        if (n_in != 25 || out_size != NTOK * D || ws_size < WS_END + 67 * MiB) { fprintf(stderr, "kernel_launch: unexpected shapes (n_in %d out %d ws %zu need %zu)\n", n_in, out_size, ws_size, (size_t)WS_END); grid = -1; return; }
        int dev = 0, cus = 0, per_cu = 0;
        if (hipGetDevice(&dev) != hipSuccess || hipDeviceGetAttribute(&cus, hipDeviceAttributeMultiprocessorCount, dev) != hipSuccess) { grid = -1; return; }
        if (hipFuncSetAttribute((const void*)fwd, hipFuncAttributeMaxDynamicSharedMemorySize, LDS_BYTES) != hipSuccess) { fprintf(stderr, "kernel_launch: hipFuncSetAttribute failed\n"); grid = -1; return; }
        if (hipOccupancyMaxActiveBlocksPerMultiprocessor(&per_cu, (const void*)fwd, NT, LDS_BYTES) != hipSuccess || per_cu < 1) { fprintf(stderr, "kernel_launch: occupancy query says %d blocks/CU\n", per_cu); (void)hipGetLastError(); grid = -1; return; }
        grid = cus;
        if (grid != NCHUNK) { fprintf(stderr, "kernel_launch: built for a %d-CU device (one 64-token chunk per workgroup in the mixer phase); this device has %d\n", NCHUNK, cus); grid = -1; return; }
    }
    if (grid < 0) return;
    hipMemsetAsync((char*)d_ws + WS_CTL, 0, 1 * MiB, stream);
    Args a{};
    for (int i = 0; i < 25; ++i) a.in[i] = (const float*)d_in[i];
    a.out = (float*)d_out; a.ws = (unsigned char*)d_ws;
#if MK_PER_PHASE
    for (int s = 0; s < NSTEPS; ++s) { a.ph_lo = s; a.ph_hi = s + 1; hipLaunchKernelGGL(fwd, dim3(grid), dim3(NT), LDS_BYTES, stream, a); }
#else
    a.ph_lo = 0; a.ph_hi = NSTEPS;
    hipLaunchKernelGGL(fwd, dim3(grid), dim3(NT), LDS_BYTES, stream, a);
#endif
}
```

```cpp
#include <hip/hip_runtime.h>
#include <cstdint>
#include <cstdio>

typedef unsigned short bf16;
typedef short bf16x8 __attribute__((ext_vector_type(8)));
typedef float f32x4 __attribute__((ext_vector_type(4)));
typedef unsigned u32x4 __attribute__((ext_vector_type(4)));
typedef unsigned u32x2 __attribute__((ext_vector_type(2)));

constexpr int NTOK = 16384, SEQ = 8192, D = 1024, DIN = 2560, GW = 256, HD = 64, DFF = 2816, DFFE = 3584, NE = 8;
constexpr int CH = 64, NCHUNK = NTOK / CH, CPB = SEQ / CH;
constexpr int NT = 512;
constexpr float W13_SCALE = 64.f, W2_SCALE = 128.f, HID_SCALE = 8.f;
constexpr int MAXTILES = NTOK * 2 / 256 + NE;

constexpr size_t MiB = 1u << 20;
constexpr size_t WS_CTL = 0;
constexpr size_t WS_SMALL = 1 * MiB;
constexpr size_t WS_WIN = 5 * MiB;
constexpr size_t WS_WOUT = 15 * MiB;
constexpr size_t WS_WGU = 19 * MiB;
constexpr size_t WS_WD = 30 * MiB;
constexpr size_t WS_W13 = 36 * MiB;
constexpr size_t WS_W2 = 92 * MiB;
constexpr size_t WS_ACT = 120 * MiB;
constexpr size_t WS_HN = WS_ACT;
constexpr size_t WS_PROJ = WS_ACT + 32 * MiB;
constexpr size_t WS_Y = WS_ACT + 112 * MiB;
constexpr size_t WS_DS = WS_ACT + 144 * MiB;
constexpr size_t WS_HID = WS_PROJ;
constexpr size_t WS_XR = WS_ACT;
constexpr size_t WS_HIDE = WS_ACT + 34 * MiB;
constexpr size_t WS_OUT2 = WS_ACT + 153 * MiB;
constexpr size_t WS_END = WS_ACT + 217 * MiB;
constexpr size_t SM_TOKE = 0;
constexpr size_t SM_TOKG = 128 * 1024;
constexpr size_t SM_TOKR = 256 * 1024;
constexpr size_t SM_BCNT = 384 * 1024;
constexpr size_t SM_ROWTOK = 400 * 1024;
constexpr size_t SM_ROWDST = 544 * 1024;
constexpr size_t SM_ROWG = 688 * 1024;
constexpr size_t SM_TILEE = 832 * 1024;
constexpr size_t SM_CARA = 1024 * 1024;
constexpr size_t SM_CARH = 1280 * 1024;
constexpr size_t SM_CIN = 1536 * 1024;
constexpr size_t SM_DEC = 1792 * 1024;
constexpr size_t SM_RSTD = 2048 * 1024;
constexpr size_t SM_WTA = 2304 * 1024;
constexpr size_t SM_WTX = 2368 * 1024;
constexpr size_t SM_TOKROW = 2560 * 1024;
constexpr size_t SM_WTP = 2432 * 1024;

struct Args {
    const float* in[25];
    float* out;
    unsigned char* ws;
    int ph_lo, ph_hi, pad0, pad1;
};

__device__ __forceinline__ int lane_id_asm() { int l; asm volatile("v_mbcnt_lo_u32_b32 %0, -1, 0\n\tv_mbcnt_hi_u32_b32 %0, -1, %0" : "=v"(l)); return l; }
typedef const float __attribute__((address_space(1)))* gfptr_t;
__device__ __forceinline__ const float* IN(int k) { asm volatile("" : "+s"(k)); const gfptr_t p = ((const gfptr_t __attribute__((address_space(4)))*)__builtin_amdgcn_kernarg_segment_ptr())[k]; return (const float*)p; }
__device__ __forceinline__ float bf2f(unsigned v) { return __uint_as_float(v << 16); }
__device__ __forceinline__ unsigned f2bf(float f) { unsigned u = __float_as_uint(f); return (u + 0x7fffu + ((u >> 16) & 1u)) >> 16; }
__device__ __forceinline__ unsigned pk2(float lo, float hi) { return f2bf(lo) | (f2bf(hi) << 16); }
__device__ __forceinline__ float fexp(float x) { return __builtin_amdgcn_exp2f(1.44269504089f * x); }
__device__ __forceinline__ float flog(float x) { return 0.69314718056f * __builtin_amdgcn_logf(x); }
__device__ __forceinline__ float sigmoidf_(float x) { return __builtin_amdgcn_rcpf(1.0f + __builtin_amdgcn_exp2f(-1.44269504089f * x)); }
__device__ __forceinline__ float siluf_(float x) { return x * sigmoidf_(x); }
__device__ __forceinline__ float gelu_tanh(float x) { const float u = 1.5957691216057308f * (x + 0.044715f * x * x * x); return x * sigmoidf_(u); }
__device__ __forceinline__ float neg_expm1_small(float x) { return -x * (1.0f + x * (0.5f + x * (0.16666667f + x * (0.041666668f + x * 0.0083333338f)))); }
__device__ __forceinline__ float wave_sum(float v) {
#pragma unroll
    for (int o = 1; o < 64; o <<= 1) v += __shfl_xor(v, o);
    return v;
}
#define LDS_WAIT() asm volatile("s_waitcnt lgkmcnt(0)" ::: "memory")

namespace pg8 {
#define PG8_LAS __attribute__((address_space(3)))
typedef unsigned short bf16_t;
typedef short bf16x8 __attribute__((ext_vector_type(8)));
typedef float f32x4 __attribute__((ext_vector_type(4)));
typedef unsigned u32x4 __attribute__((ext_vector_type(4)));
constexpr int BM = 256, BK = 64, HALF = 128, HTB = HALF * BK * 2  , STAGE_BYTES = 8 * HTB, NXCD = 8, WGM = 8;

__host__ __device__ __forceinline__ int lds_byte(int r, int c) { const int st = (r >> 4) * 2 + (c >> 5), rr = r & 15, cc = c & 31, ob = rr * 64 + cc * 2; return st * 1024 + (ob ^ (((ob >> 9) & 1) << 5)); }
__host__ __device__ __forceinline__ void stage_rc(int b, int& R, int& C) { const int st = b / 1024, sb = b % 1024, swz = sb ^ (((sb >> 9) & 1) << 5); R = (st >> 1) * 16 + swz / 64; C = (st & 1) * 32 + (swz % 64) / 2; }
__host__ __device__ __forceinline__ int perm32(int rho) { const int n = rho >> 4, i = rho & 15; return 8 * (i >> 2) + 4 * n + (i & 3); }

struct Unit { int pm, pn, pa, pb, ord, koff; };
struct Gemm { const bf16_t* A; const bf16_t* Bt; int M, N, K; int LD; };

struct StaticOrder {
    int nM, nN, nwg, G, c;
    __host__ __device__ void init(int M, int N, int G_, int c_) { nM = M / BM; nN = N / BM; nwg = nM * nN; G = G_; c = c_; }
    __host__ __device__ bool next(int i, Unit& u) const {
        const long L = (long)i * G + c; if (L >= nwg) return false;
        int wgid = (int)L; { const int q = nwg / NXCD, r = nwg % NXCD, xcd = wgid % NXCD, off = wgid / NXCD; wgid = (xcd < r ? xcd * (q + 1) : r * (q + 1) + (xcd - r) * q) + off; }
        const int nig = WGM * nN, gid = wgid / nig, fm = gid * WGM, gsz = (nM - fm) < WGM ? (nM - fm) : WGM;
        u.pm = fm + ((wgid % nig) % gsz); u.pn = (wgid % nig) / gsz; u.pa = u.pm; u.pb = u.pn; u.ord = i; u.koff = 0; return true;
    }
    __device__ __forceinline__ void a_ready(const Unit&) const {}
    __device__ __forceinline__ void done(const Unit&) const {}
};

__device__ __forceinline__ unsigned cvt_pk_bf16(float lo, float hi) { unsigned r; asm volatile("v_cvt_pk_bf16_f32 %0, %1, %2" : "=v"(r) : "v"(lo), "v"(hi)); return r; }
typedef float f32x2 __attribute__((ext_vector_type(2)));
typedef int pg8_v8i __attribute__((ext_vector_type(8))); typedef int pg8_v4i __attribute__((ext_vector_type(4)));
__device__ __forceinline__ pg8_v8i pg8_cat(bf16x8 lo, bf16x8 hi) { return __builtin_shufflevector(__builtin_bit_cast(pg8_v4i, lo), __builtin_bit_cast(pg8_v4i, hi), 0, 1, 2, 3, 4, 5, 6, 7); }
__device__ __forceinline__ void pg8_mfma8(f32x4& acc, pg8_v8i a, pg8_v8i b, int sc) { asm volatile("v_mfma_scale_f32_16x16x128_f8f6f4 %0, %1, %2, %0, %3, %3 op_sel_hi:[0,0,0]" : "+v"(acc) : "v"(a), "v"(b), "v"(sc)); }
template <class Epi, class Sched, bool ALIGN_EPI = false, bool SP2 = false, bool F8 = false>
__device__ __forceinline__ void gemm_phase(PG8_LAS unsigned char* lds, const Gemm g, const Sched& S, const Epi& E, int tid_in) {
    int tid = tid_in; asm volatile("" : "+v"(tid));
    const int wid = __builtin_amdgcn_readfirstlane(tid >> 6), lane = tid & 63, wr = wid >> 2, wc = wid & 3, fr = lane & 15, fq = lane >> 4;
    const int K = g.LD ? g.LD : g.K, nt = g.K / BK;
    unsigned voffA[2], voffB[2];
#pragma unroll
    for (int i = 0; i < 2; ++i) { int R, C; stage_rc(tid * 16 + i * 8192, R, C); const int Rb = Epi::PERM ? ((R & ~31) + perm32(R & 31)) : R;
        voffA[i] = (unsigned)(R * K + C) * 2u; voffB[i] = (unsigned)(Rb * K + C) * 2u; }
    const size_t kstep = (size_t)(BK * 2);
    const size_t hstep = (size_t)HALF * K * 2;
    const size_t tstep = 2 * hstep;
    const unsigned ldsw = (unsigned)wid * 1024u;
    int f8one = 0x7f7f7f7f; asm volatile("" : "+v"(f8one));
    constexpr int KOFF = 1024;
    const int aoff = lds_byte(wr * 64 + fr, fq * 8), boff = lds_byte(wc * 32 + fr, fq * 8);
#define PG8_SA(b, h) (((b) * 2 + (h)) * HTB)
#define PG8_SB(b, h) ((4 + (b) * 2 + (h)) * HTB)
#define PG8_STAGE(bufoff, gbase, voff) do { _Pragma("unroll") for (int _i = 0; _i < 2; ++_i) \
        __builtin_amdgcn_global_load_lds((const unsigned*)((const char*)(gbase) + (voff)[_i]), (PG8_LAS unsigned*)(lds + (bufoff) + ldsw + _i * 8192), 16, 0, 0); } while (0)
#define PG8_LDA(dst, b, h) do { _Pragma("unroll") for (int m = 0; m < 4; ++m) _Pragma("unroll") for (int k = 0; k < 2; ++k) dst[m][k] = *(const PG8_LAS bf16x8*)(lds + PG8_SA(b, h) + aoff + m * 2048 + k * KOFF); } while (0)
#define PG8_LDB(dst, b, h) do { _Pragma("unroll") for (int n = 0; n < 2; ++n) _Pragma("unroll") for (int k = 0; k < 2; ++k) dst[n][k] = *(const PG8_LAS bf16x8*)(lds + PG8_SB(b, h) + boff + n * 2048 + k * KOFF); } while (0)
#define PG8_MMA(ai, bj, At, Bt) do { __builtin_amdgcn_s_setprio(1); if constexpr (F8) { _Pragma("unroll") for (int m = 0; m < 4; ++m) _Pragma("unroll") for (int n = 0; n < 2; ++n) \
        pg8_mfma8(acc[ai][bj][m][n], pg8_cat(Bt[n][0], Bt[n][1]), pg8_cat(At[m][0], At[m][1]), f8one); } \
    else { _Pragma("unroll") for (int m = 0; m < 4; ++m) _Pragma("unroll") for (int n = 0; n < 2; ++n) _Pragma("unroll") for (int k = 0; k < 2; ++k) \
        acc[ai][bj][m][n] = __builtin_amdgcn_mfma_f32_16x16x32_bf16(Bt[n][k], At[m][k], acc[ai][bj][m][n], 0, 0, 0); } __builtin_amdgcn_s_setprio(0); } while (0)
#define PG8_WAIT_V(n) asm volatile("s_waitcnt vmcnt(" #n ")" ::: "memory")
#define PG8_WAIT_L(n) asm volatile("s_waitcnt lgkmcnt(" #n ")" ::: "memory")
#define PG8_BAR __builtin_amdgcn_s_barrier()
#define PG8_SCHED __builtin_amdgcn_sched_barrier(0)
    Unit cur, nxt; int ui = 0;
    if (!S.next(0, cur)) return;
    f32x4 acc[2][2][4][2];
    if constexpr (Epi::ACC_INIT) E.init(acc, cur, wr, wc, fr, fq);
    else {
#pragma unroll
    for (int a = 0; a < 2; ++a)
#pragma unroll
        for (int b = 0; b < 2; ++b)
#pragma unroll
            for (int m = 0; m < 4; ++m)
#pragma unroll
                for (int n = 0; n < 2; ++n) acc[a][b][m][n] = (f32x4){0.f, 0.f, 0.f, 0.f};
    }
    bf16x8 At[4][2], B0[2][2], B1[2][2];
    const char* cA = (const char*)g.A + (size_t)cur.pa * tstep + cur.koff; const char* cB = (const char*)g.Bt + (size_t)cur.pb * tstep + cur.koff;
    S.a_ready(cur);
    if constexpr (SP2) {
        PG8_STAGE(PG8_SB(0, 0), cB, voffB); PG8_STAGE(PG8_SB(0, 1), cB + hstep, voffB); PG8_STAGE(PG8_SA(0, 0), cA, voffA); PG8_STAGE(PG8_SA(0, 1), cA + hstep, voffA);
        if (wr == 1) PG8_BAR;
        PG8_WAIT_V(2); PG8_BAR;
        PG8_STAGE(PG8_SB(1, 0), cB + kstep, voffB); PG8_STAGE(PG8_SA(1, 0), cA + kstep, voffA); PG8_STAGE(PG8_SB(1, 1), cB + hstep + kstep, voffB);
        PG8_WAIT_V(6); PG8_BAR;
    } else {
        PG8_STAGE(PG8_SB(0, 0), cB, voffB); PG8_STAGE(PG8_SA(0, 0), cA, voffA); PG8_STAGE(PG8_SB(0, 1), cB + hstep, voffB); PG8_STAGE(PG8_SA(0, 1), cA + hstep, voffA);
        if (wr == 1) PG8_BAR;
        PG8_WAIT_V(4); PG8_BAR;
        PG8_STAGE(PG8_SB(1, 0), cB + kstep, voffB); PG8_STAGE(PG8_SA(1, 0), cA + kstep, voffA); PG8_STAGE(PG8_SB(1, 1), cB + hstep + kstep, voffB);
        PG8_WAIT_V(6); PG8_BAR;
    }
    for (;;) {
        const bool has_next = S.next(ui + 1, nxt);
        const char* nA = has_next ? (const char*)g.A + (size_t)nxt.pa * tstep + nxt.koff : cA; const char* nB = has_next ? (const char*)g.Bt + (size_t)nxt.pb * tstep + nxt.koff : cB;
        for (int t = 0; t < nt; t += 2) {
            const bool last = (t == nt - 2);
            const char* a1 = cA + (size_t)(t + 1) * kstep;
            const char* a2 = last ? nA : cA + (size_t)(t + 2) * kstep; const char* b2 = last ? nB : cB + (size_t)(t + 2) * kstep;
            const char* a3 = a2 + kstep; const char* b3 = b2 + kstep;
            if (last && has_next) S.a_ready(nxt);
            if constexpr (SP2) {
            PG8_LDB(B0, 0, 0); PG8_LDB(B1, 0, 1); PG8_SCHED; PG8_LDA(At, 0, 0); PG8_STAGE(PG8_SA(1, 1), a1 + hstep, voffA);
            PG8_WAIT_V(8); PG8_WAIT_L(0); PG8_BAR; PG8_MMA(0, 0, At, B0); PG8_MMA(0, 1, At, B1); PG8_BAR; PG8_SCHED;
            PG8_LDA(At, 0, 1); PG8_STAGE(PG8_SB(0, 0), b2, voffB); PG8_STAGE(PG8_SB(0, 1), b2 + hstep, voffB); PG8_STAGE(PG8_SA(0, 0), a2, voffA);
            PG8_WAIT_V(8); PG8_WAIT_L(0); PG8_BAR; PG8_MMA(1, 0, At, B0); PG8_MMA(1, 1, At, B1); PG8_BAR; PG8_SCHED;
            PG8_LDB(B0, 1, 0); PG8_LDB(B1, 1, 1); PG8_SCHED; PG8_LDA(At, 1, 0); PG8_STAGE(PG8_SA(0, 1), a2 + hstep, voffA);
            PG8_WAIT_V(8); PG8_WAIT_L(0); PG8_BAR; PG8_MMA(0, 0, At, B0); PG8_MMA(0, 1, At, B1); PG8_BAR; PG8_SCHED;
            PG8_LDA(At, 1, 1); PG8_STAGE(PG8_SB(1, 0), b3, voffB); PG8_STAGE(PG8_SB(1, 1), b3 + hstep, voffB); PG8_STAGE(PG8_SA(1, 0), a3, voffA);
            PG8_WAIT_V(8); PG8_WAIT_L(0); PG8_BAR; PG8_MMA(1, 0, At, B0); PG8_MMA(1, 1, At, B1); PG8_BAR; PG8_SCHED;
            } else {
            PG8_LDB(B0, 0, 0); PG8_SCHED; PG8_LDA(At, 0, 0); PG8_STAGE(PG8_SA(1, 1), a1 + hstep, voffA);
            PG8_WAIT_L(8); PG8_BAR; PG8_WAIT_L(0); PG8_MMA(0, 0, At, B0); PG8_BAR; PG8_SCHED;
            PG8_LDB(B1, 0, 1); PG8_STAGE(PG8_SB(0, 0), b2, voffB);
            PG8_BAR; PG8_WAIT_L(0); PG8_MMA(0, 1, At, B1); PG8_BAR;
            PG8_LDA(At, 0, 1); PG8_STAGE(PG8_SA(0, 0), a2, voffA);
            PG8_BAR; PG8_WAIT_L(0); PG8_MMA(1, 0, At, B0); PG8_BAR; PG8_SCHED;
            PG8_STAGE(PG8_SB(0, 1), b2 + hstep, voffB);
            PG8_WAIT_V(6); PG8_BAR; PG8_MMA(1, 1, At, B1); PG8_BAR;
            PG8_LDB(B0, 1, 0); PG8_SCHED; PG8_LDA(At, 1, 0); PG8_STAGE(PG8_SA(0, 1), a2 + hstep, voffA);
            PG8_WAIT_L(8); PG8_BAR; PG8_WAIT_L(0); PG8_MMA(0, 0, At, B0); PG8_BAR; PG8_SCHED;
            PG8_LDB(B1, 1, 1); PG8_STAGE(PG8_SB(1, 0), b3, voffB);
            PG8_BAR; PG8_WAIT_L(0); PG8_MMA(0, 1, At, B1); PG8_BAR;
            PG8_LDA(At, 1, 1); PG8_STAGE(PG8_SA(1, 0), a3, voffA);
            PG8_BAR; PG8_WAIT_L(0); PG8_MMA(1, 0, At, B0); PG8_BAR; PG8_SCHED;
            PG8_STAGE(PG8_SB(1, 1), b3 + hstep, voffB);
            PG8_WAIT_V(6); PG8_BAR; PG8_MMA(1, 1, At, B1); PG8_BAR;
            }
        }
        if constexpr (F8) asm volatile("s_nop 15\n\ts_nop 15" ::: "memory");
        if constexpr (ALIGN_EPI) { if (wr == 0) PG8_BAR; }
        if constexpr (!Epi::AFTER_DRAIN) { E(acc, cur, wr, wc, fr, fq); S.done(cur); }
        if (!has_next) break;
#pragma unroll
        for (int a = 0; a < 2; ++a)
#pragma unroll
            for (int b = 0; b < 2; ++b)
#pragma unroll
                for (int m = 0; m < 4; ++m)
#pragma unroll
                    for (int n = 0; n < 2; ++n) acc[a][b][m][n] = (f32x4){0.f, 0.f, 0.f, 0.f};
        cur = nxt; cA = nA; cB = nB; ++ui;
        if constexpr (ALIGN_EPI) { if (wr == 1) PG8_BAR; }
    }
    PG8_WAIT_V(0);
    if constexpr (!ALIGN_EPI) { if (wr == 0) PG8_BAR; }
    PG8_BAR;
    if constexpr (Epi::AFTER_DRAIN) { E.fused(acc, cur, wr, wc, fr, fq, lds, wid, lane); S.done(cur); }
#undef PG8_SA
#undef PG8_SB
#undef PG8_STAGE
#undef PG8_LDA
#undef PG8_LDB
#undef PG8_MMA
#undef PG8_WAIT_V
#undef PG8_WAIT_L
#undef PG8_BAR
#undef PG8_SCHED
}

struct EpiStoreBf16 {
    static constexpr bool PERM = true, AFTER_DRAIN = false, ACC_INIT = false;
    bf16_t* O; int ldc;
    __device__ __forceinline__ void operator()(const f32x4 (&acc)[2][2][4][2], const Unit& u, int wr, int wc, int fr, int fq) const {
        const int row0 = u.pm * BM + wr * 64 + fr, col0 = u.pn * BM + wc * 32 + 8 * fq;
#pragma unroll
        for (int ai = 0; ai < 2; ++ai)
#pragma unroll
            for (int m = 0; m < 4; ++m) { bf16_t* rowp = O + (size_t)(row0 + ai * HALF + m * 16) * ldc + col0;
#pragma unroll
                for (int bj = 0; bj < 2; ++bj) { const f32x4 v0 = acc[ai][bj][m][0], v1 = acc[ai][bj][m][1];
                    u32x4 w; w.x = cvt_pk_bf16(v0[0], v0[1]); w.y = cvt_pk_bf16(v0[2], v0[3]); w.z = cvt_pk_bf16(v1[0], v1[1]); w.w = cvt_pk_bf16(v1[2], v1[3]);
                    *(u32x4*)(rowp + bj * HALF) = w; } }
    }
};
struct EpiResidF32 {
    static constexpr bool PERM = false, AFTER_DRAIN = false, ACC_INIT = true;
    const float* base; float* out;
    __device__ __forceinline__ void init(f32x4 (&acc)[2][2][4][2], const Unit& u, int wr, int wc, int fr, int fq) const {
        const int row0 = u.pm * BM + wr * 64 + fr, col0 = u.pn * BM + wc * 32 + 4 * fq;
#pragma unroll
        for (int ai = 0; ai < 2; ++ai)
#pragma unroll
            for (int m = 0; m < 4; ++m) { const size_t off = (size_t)(row0 + ai * HALF + m * 16) * 1024 + col0;
#pragma unroll
                for (int bj = 0; bj < 2; ++bj)
#pragma unroll
                    for (int n = 0; n < 2; ++n) acc[ai][bj][m][n] = *(const f32x4*)(base + off + bj * HALF + n * 16); }
    }
    __device__ __forceinline__ void operator()(const f32x4 (&acc)[2][2][4][2], const Unit& u, int wr, int wc, int fr, int fq) const {
        const int row0 = u.pm * BM + wr * 64 + fr, col0 = u.pn * BM + wc * 32 + 4 * fq;
#pragma unroll
        for (int ai = 0; ai < 2; ++ai)
#pragma unroll
            for (int m = 0; m < 4; ++m) { const size_t off = (size_t)(row0 + ai * HALF + m * 16) * 1024 + col0;
#pragma unroll
                for (int bj = 0; bj < 2; ++bj)
#pragma unroll
                    for (int n = 0; n < 2; ++n) *(f32x4*)(out + off + bj * HALF + n * 16) = acc[ai][bj][m][n]; }
    }
};
__device__ __forceinline__ float silu_f(float x) { return x * __builtin_amdgcn_rcpf(1.0f + __builtin_amdgcn_exp2f(-1.44269504089f * x)); }
struct EpiSwiglu {
    static constexpr bool PERM = true, AFTER_DRAIN = false, ACC_INIT = false;
    bf16_t* C; int ldc; int row_off;
    __device__ __forceinline__ void operator()(const f32x4 (&acc)[2][2][4][2], const Unit& u, int wr, int wc, int fr, int fq) const {
        const int row0 = u.pm * BM + wr * 64 + fr - row_off, col0 = u.pn * HALF + wc * 32 + 8 * fq;
#pragma unroll
        for (int ai = 0; ai < 2; ++ai)
#pragma unroll
            for (int m = 0; m < 4; ++m) { bf16_t* rowp = C + (size_t)(row0 + ai * HALF + m * 16) * ldc + col0;
                const f32x4 g0 = acc[ai][0][m][0], g1 = acc[ai][0][m][1], u0 = acc[ai][1][m][0], u1 = acc[ai][1][m][1];
                u32x4 w; w.x = cvt_pk_bf16(silu_f(g0[0]) * u0[0], silu_f(g0[1]) * u0[1]); w.y = cvt_pk_bf16(silu_f(g0[2]) * u0[2], silu_f(g0[3]) * u0[3]);
                w.z = cvt_pk_bf16(silu_f(g1[0]) * u1[0], silu_f(g1[1]) * u1[1]); w.w = cvt_pk_bf16(silu_f(g1[2]) * u1[2], silu_f(g1[3]) * u1[3]);
                *(u32x4*)rowp = w; }
    }
};
struct EpiMoeDown {
    static constexpr bool PERM = true, AFTER_DRAIN = false, ACC_INIT = false;
    bf16_t* out2; const int* rowdst; const float* rowg; float sc;
    __device__ __forceinline__ void operator()(const f32x4 (&acc)[2][2][4][2], const Unit& u, int wr, int wc, int fr, int fq) const {
        const int row0 = u.pm * BM + wr * 64 + fr, col0 = u.pn * BM + wc * 32 + 8 * fq;
#pragma unroll
        for (int ai = 0; ai < 2; ++ai)
#pragma unroll
            for (int m = 0; m < 4; ++m) { const int gr = row0 + ai * HALF + m * 16; const int d = rowdst[gr]; const float g = rowg[gr] * sc;
                if (d >= 0) { bf16_t* rowp = out2 + (size_t)d * 1024 + col0;
#pragma unroll
                    for (int bj = 0; bj < 2; ++bj) { const f32x4 v0 = acc[ai][bj][m][0] * g, v1 = acc[ai][bj][m][1] * g;
                        u32x4 w; w.x = cvt_pk_bf16(v0[0], v0[1]); w.y = cvt_pk_bf16(v0[2], v0[3]); w.z = cvt_pk_bf16(v1[0], v1[1]); w.w = cvt_pk_bf16(v1[2], v1[3]);
                        *(u32x4*)(rowp + bj * HALF) = w; } } }
    }
};


struct EpiResidStats {
    static constexpr bool PERM = false, AFTER_DRAIN = false, ACC_INIT = true;
    const float* base; float* out; bf16_t* hn; float* ssp;
    __device__ __forceinline__ void init(f32x4 (&acc)[2][2][4][2], const Unit& u, int wr, int wc, int fr, int fq) const {
        const int row0 = u.pm * BM + wr * 64 + fr, col0 = u.pn * BM + wc * 32 + 4 * fq;
#pragma unroll
        for (int ai = 0; ai < 2; ++ai)
#pragma unroll
            for (int m = 0; m < 4; ++m) { const size_t off = (size_t)(row0 + ai * HALF + m * 16) * 1024 + col0;
#pragma unroll
                for (int bj = 0; bj < 2; ++bj)
#pragma unroll
                    for (int n = 0; n < 2; ++n) acc[ai][bj][m][n] = *(const f32x4*)(base + off + bj * HALF + n * 16); }
    }
    __device__ __forceinline__ void operator()(const f32x4 (&acc)[2][2][4][2], const Unit& u, int wr, int wc, int fr, int fq) const {
        const int row0 = u.pm * BM + wr * 64 + fr, col0 = u.pn * BM + wc * 32 + 4 * fq; typedef unsigned u32x2e __attribute__((ext_vector_type(2)));
#pragma unroll
        for (int ai = 0; ai < 2; ++ai)
#pragma unroll
            for (int m = 0; m < 4; ++m) { const int row = row0 + ai * HALF + m * 16; const size_t off = (size_t)row * 1024 + col0; float ss = 0.f;
#pragma unroll
                for (int bj = 0; bj < 2; ++bj)
#pragma unroll
                    for (int n = 0; n < 2; ++n) { const f32x4 v = acc[ai][bj][m][n]; *(f32x4*)(out + off + bj * HALF + n * 16) = v;
                        ss += (v[0] * v[0] + v[1] * v[1]) + (v[2] * v[2] + v[3] * v[3]); u32x2e w; w.x = cvt_pk_bf16(v[0], v[1]); w.y = cvt_pk_bf16(v[2], v[3]); *(u32x2e*)(hn + off + bj * HALF + n * 16) = w; }
                ss += __shfl_xor(ss, 16); ss += __shfl_xor(ss, 32);
                if (fq == 0) ssp[(size_t)row * 16 + u.pn * 4 + wc] = ss; }
    }
};
constexpr int RSTD_TAB_OFF = STAGE_BYTES;
template <class Sched> __device__ __forceinline__ void fill_rstd_table(PG8_LAS unsigned char* lds, const Sched& S, const float* ssp, int tid) {
    PG8_LAS float* tab = (PG8_LAS float*)(lds + RSTD_TAB_OFF); Unit u;
    for (int i = 0; S.next(i, u); ++i)
        if (tid < 256) { const int row = u.pm * BM + tid; const f32x4* p = (const f32x4*)(ssp + (size_t)row * 16); const f32x4 a = p[0], b = p[1], c = p[2], d = p[3];
            const float s = (((a[0] + a[1]) + (a[2] + a[3])) + ((b[0] + b[1]) + (b[2] + b[3]))) + (((c[0] + c[1]) + (c[2] + c[3])) + ((d[0] + d[1]) + (d[2] + d[3])));
            tab[i * 256 + tid] = 1.0f / sqrtf(s * (1.0f / 1024.0f) + 1e-6f); }
    __syncthreads();
}
struct EpiStoreBf16R {
    static constexpr bool PERM = true, AFTER_DRAIN = false, ACC_INIT = false;
    bf16_t* O; int ldc; const PG8_LAS float* tab;
    __device__ __forceinline__ void operator()(const f32x4 (&acc)[2][2][4][2], const Unit& u, int wr, int wc, int fr, int fq) const {
        const int row0 = u.pm * BM + wr * 64 + fr, col0 = u.pn * BM + wc * 32 + 8 * fq;
#pragma unroll
        for (int ai = 0; ai < 2; ++ai)
#pragma unroll
            for (int m = 0; m < 4; ++m) { const int row = row0 + ai * HALF + m * 16; const float r = tab[u.ord * 256 + wr * 64 + fr + ai * HALF + m * 16]; bf16_t* rowp = O + (size_t)row * ldc + col0;
#pragma unroll
                for (int bj = 0; bj < 2; ++bj) { const f32x4 v0 = acc[ai][bj][m][0] * r, v1 = acc[ai][bj][m][1] * r;
                    u32x4 w; w.x = cvt_pk_bf16(v0[0], v0[1]); w.y = cvt_pk_bf16(v0[2], v0[3]); w.z = cvt_pk_bf16(v1[0], v1[1]); w.w = cvt_pk_bf16(v1[2], v1[3]);
                    *(u32x4*)(rowp + bj * HALF) = w; } }
    }
};
struct EpiSwigluR {
    static constexpr bool PERM = true, AFTER_DRAIN = false, ACC_INIT = false;
    bf16_t* C; int ldc; const PG8_LAS float* tab;
    __device__ __forceinline__ void operator()(const f32x4 (&acc)[2][2][4][2], const Unit& u, int wr, int wc, int fr, int fq) const {
        const int row0 = u.pm * BM + wr * 64 + fr, col0 = u.pn * HALF + wc * 32 + 8 * fq;
#pragma unroll
        for (int ai = 0; ai < 2; ++ai)
#pragma unroll
            for (int m = 0; m < 4; ++m) { const int row = row0 + ai * HALF + m * 16; const float r = tab[u.ord * 256 + wr * 64 + fr + ai * HALF + m * 16]; bf16_t* rowp = C + (size_t)row * ldc + col0;
                const f32x4 g0 = acc[ai][0][m][0] * r, g1 = acc[ai][0][m][1] * r, u0 = acc[ai][1][m][0] * r, u1 = acc[ai][1][m][1] * r;
                u32x4 w; w.x = cvt_pk_bf16(silu_f(g0[0]) * u0[0], silu_f(g0[1]) * u0[1]); w.y = cvt_pk_bf16(silu_f(g0[2]) * u0[2], silu_f(g0[3]) * u0[3]);
                w.z = cvt_pk_bf16(silu_f(g1[0]) * u1[0], silu_f(g1[1]) * u1[1]); w.w = cvt_pk_bf16(silu_f(g1[2]) * u1[2], silu_f(g1[3]) * u1[3]);
                *(u32x4*)rowp = w; }
    }
};
__device__ __forceinline__ unsigned pk4_fp8(float a, float b, float c, float d) { int w = __builtin_amdgcn_cvt_pk_fp8_f32(a, b, 0, false); w = __builtin_amdgcn_cvt_pk_fp8_f32(c, d, w, true); return (unsigned)w; }
struct EpiSwiglu8 {
    static constexpr bool PERM = true, AFTER_DRAIN = false, ACC_INIT = false;
    unsigned char* C; int ldc; float isc, osc;
    __device__ __forceinline__ void operator()(const f32x4 (&acc)[2][2][4][2], const Unit& u, int wr, int wc, int fr, int fq) const {
        const int row0 = u.pm * BM + wr * 64 + fr, col0 = u.pn * HALF + wc * 32 + 8 * fq; const float us = isc * osc;
#pragma unroll
        for (int ai = 0; ai < 2; ++ai)
#pragma unroll
            for (int m = 0; m < 4; ++m) { unsigned char* rowp = C + (size_t)(row0 + ai * HALF + m * 16) * ldc + col0;
                const f32x4 g0 = acc[ai][0][m][0] * isc, g1 = acc[ai][0][m][1] * isc, u0 = acc[ai][1][m][0] * us, u1 = acc[ai][1][m][1] * us;
                typedef unsigned u32x2e __attribute__((ext_vector_type(2))); u32x2e w;
                w.x = pk4_fp8(silu_f(g0[0]) * u0[0], silu_f(g0[1]) * u0[1], silu_f(g0[2]) * u0[2], silu_f(g0[3]) * u0[3]);
                w.y = pk4_fp8(silu_f(g1[0]) * u1[0], silu_f(g1[1]) * u1[1], silu_f(g1[2]) * u1[2], silu_f(g1[3]) * u1[3]);
                *(u32x2e*)rowp = w; }
    }
};
struct MoeOrder {
    StaticOrder so; int tlo, nN, a_off; const int* tilee;
    __device__ void init(int nrt, int nN_, int G, int c, int tlo_, int a_off_, const int* tilee_) { so.init(nrt * BM, nN_ * BM, G, c); tlo = tlo_; nN = nN_; a_off = a_off_; tilee = tilee_; }
    __device__ bool next(int i, Unit& u) const { if (!so.next(i, u)) return false; u.pm += tlo; u.pa = u.pm - a_off; const int e = __builtin_amdgcn_readfirstlane(__hip_atomic_load(tilee + u.pm, __ATOMIC_RELAXED, __HIP_MEMORY_SCOPE_AGENT)); u.pb = e * nN + u.pn; return true; }
    __device__ __forceinline__ void a_ready(const Unit&) const {}
    __device__ __forceinline__ void done(const Unit&) const {}
};

struct MoeTailOrder {
    int t0, ntail, nN, S, G, c, kbytes; const int* tilee;
    __device__ bool next(int i, Unit& u) const {
        const int L = i * G + c; if (L >= ntail * nN * S) return false;
        const int piece = L % S, q = L / S, pn = q % nN, tl = q / nN;
        u.pm = t0 + tl; u.pn = pn; u.pa = u.pm; const int e = __builtin_amdgcn_readfirstlane(__hip_atomic_load(tilee + u.pm, __ATOMIC_RELAXED, __HIP_MEMORY_SCOPE_AGENT));
        u.pb = e * nN + pn; u.ord = tl * S + piece; u.koff = piece * kbytes; return true; }
    __device__ __forceinline__ void a_ready(const Unit&) const {}
    __device__ __forceinline__ void done(const Unit&) const {}
};
struct EpiPartF32 {
    static constexpr bool PERM = false, AFTER_DRAIN = false, ACC_INIT = false;
    float* part;
    __device__ __forceinline__ void operator()(const f32x4 (&acc)[2][2][4][2], const Unit& u, int wr, int wc, int fr, int fq) const {
        const int row0 = wr * 64 + fr, col0 = u.pn * BM + wc * 32 + 4 * fq; float* base = part + (size_t)u.ord * 256 * 1024;
#pragma unroll
        for (int ai = 0; ai < 2; ++ai)
#pragma unroll
            for (int m = 0; m < 4; ++m) { const size_t off = (size_t)(row0 + ai * HALF + m * 16) * 1024 + col0;
#pragma unroll
                for (int bj = 0; bj < 2; ++bj)
#pragma unroll
                    for (int n = 0; n < 2; ++n) *(f32x4*)(base + off + bj * HALF + n * 16) = acc[ai][bj][m][n]; }
    }
};
}

__device__ __forceinline__ void cvt_item(const float* W, int K, int N, bf16* WT, int mode, int item, float* scr, int lane, const float* gk = nullptr) {
    const int nblk = N / 32, kb = item / nblk, nb = item % nblk, k0 = 64 * kb, n0 = 32 * nb;
    { f32x4 v[8]; const float* src = W + (size_t)(k0 + (lane >> 3)) * N + n0 + 4 * (lane & 7);
#pragma unroll
      for (int i = 0; i < 8; ++i) v[i] = __builtin_nontemporal_load((const f32x4*)(src + (size_t)(8 * i) * N));
#pragma unroll
      for (int i = 0; i < 8; ++i) { float* d = scr + (8 * i + (lane >> 3)) * 33 + 4 * (lane & 7); const float gg = gk ? gk[k0 + 8 * i + (lane >> 3)] : 1.0f; d[0] = v[i].x * gg; d[1] = v[i].y * gg; d[2] = v[i].z * gg; d[3] = v[i].w * gg; } }
    LDS_WAIT();
    const int c = lane & 7;
#pragma unroll
    for (int j = 0; j < 4; ++j) {
        const int n = (lane >> 3) + 8 * j; const float* s = scr + (8 * c) * 33 + n;
        u32x4 o; o.x = pk2(s[0 * 33], s[1 * 33]); o.y = pk2(s[2 * 33], s[3 * 33]); o.z = pk2(s[4 * 33], s[5 * 33]); o.w = pk2(s[6 * 33], s[7 * 33]);
        const int nn = n0 + n; const int drow = mode == 0 ? nn : ((nn >> 7) * 256 + (nn & 127) + (mode == 2 ? 128 : 0));
        *(u32x4*)(WT + (size_t)drow * K + k0 + 8 * c) = o;
    }
    LDS_WAIT();
}

__device__ __forceinline__ void cvt_item8(const float* W, int K, int N, unsigned char* WT, int mode, int item, float* scr, int lane, float scale) {
    const int nblk = N / 32, kb = item / nblk, nb = item % nblk, k0 = 128 * kb, n0 = 32 * nb;
    { f32x4 v[16]; const float* src = W + (size_t)(k0 + (lane >> 3)) * N + n0 + 4 * (lane & 7);
#pragma unroll
      for (int i = 0; i < 16; ++i) v[i] = __builtin_nontemporal_load((const f32x4*)(src + (size_t)(8 * i) * N));
#pragma unroll
      for (int i = 0; i < 16; ++i) { float* d = scr + (8 * i + (lane >> 3)) * 33 + 4 * (lane & 7); d[0] = v[i].x * scale; d[1] = v[i].y * scale; d[2] = v[i].z * scale; d[3] = v[i].w * scale; } }
    LDS_WAIT();
    const int c = lane & 7;
#pragma unroll
    for (int j = 0; j < 4; ++j) {
        const int n = (lane >> 3) + 8 * j; const float* s = scr + (16 * c) * 33 + n;
        u32x4 o; o.x = pg8::pk4_fp8(s[0 * 33], s[1 * 33], s[2 * 33], s[3 * 33]); o.y = pg8::pk4_fp8(s[4 * 33], s[5 * 33], s[6 * 33], s[7 * 33]);
        o.z = pg8::pk4_fp8(s[8 * 33], s[9 * 33], s[10 * 33], s[11 * 33]); o.w = pg8::pk4_fp8(s[12 * 33], s[13 * 33], s[14 * 33], s[15 * 33]);
        const int nn = n0 + n; const int drow = mode == 0 ? nn : ((nn >> 7) * 256 + (nn & 127) + (mode == 2 ? 128 : 0));
        __builtin_nontemporal_store(o, (u32x4*)(WT + (size_t)drow * K + k0 + 16 * c));
    }
    LDS_WAIT();
}

__device__ __forceinline__ void rms_row_bf16(const float* xrow, const float* g, bf16* orow, int lane) {
    const f32x4* xr = (const f32x4*)xrow; const f32x4* gr = (const f32x4*)g;
    f32x4 v[4]; float s = 0.f;
#pragma unroll
    for (int j = 0; j < 4; ++j) { v[j] = xr[lane + 64 * j]; s += (v[j].x * v[j].x + v[j].y * v[j].y) + (v[j].z * v[j].z + v[j].w * v[j].w); }
    const float r = 1.0f / sqrtf(wave_sum(s) * (1.0f / D) + 1e-6f);
    u32x2* o8 = (u32x2*)orow;
#pragma unroll
    for (int j = 0; j < 4; ++j) { const f32x4 gv = gr[lane + 64 * j]; u32x2 w; w.x = pk2(v[j].x * r * gv.x, v[j].y * r * gv.y); w.y = pk2(v[j].z * r * gv.z, v[j].w * r * gv.w); o8[lane + 64 * j] = w; }
}

#define LAS __attribute__((address_space(3)))
#define XB_TMO      128
#define XB_XCNT(j)  (256  + 64 * (j))
#define XB_XSUB(j)  (1280 + 64 * (j))
#define XB_XGEN(j)  (2304 + 64 * (j))
#define XB_TOP      3328
#define XB_TOPGEN   3392
#define XCD_BAR_WORDS 3456
#define XB_SPIN_CAP (1u << 22)
__device__ __forceinline__ unsigned xb_ld(unsigned* p)              { return __hip_atomic_load(p, __ATOMIC_RELAXED, __HIP_MEMORY_SCOPE_AGENT); }
__device__ __forceinline__ unsigned xb_add(unsigned* p, unsigned v) { return __hip_atomic_fetch_add(p, v, __ATOMIC_RELAXED, __HIP_MEMORY_SCOPE_AGENT); }
__device__ __forceinline__ unsigned xb_xcc_id() { return (unsigned)__builtin_amdgcn_s_getreg((3 << 11) | 20) & 0xFu; }
#define XB_SPIN(cond, bar) do { unsigned _sp = 0; while (cond) { __builtin_amdgcn_s_sleep(1); \
    if ((++_sp & 255u) == 0u) { if (xb_ld(&(bar)[XB_TMO])) break; if (_sp > XB_SPIN_CAP) { atomicAdd(&(bar)[XB_TMO], 1u); break; } } } } while (0)
struct XcdBarrier { unsigned* bar; unsigned x; volatile LAS unsigned* st; };
__device__ __forceinline__ XcdBarrier xcd_barrier_post(unsigned* bar, volatile LAS unsigned* st) {
    XcdBarrier b; b.bar = bar; b.x = xb_xcc_id(); b.st = st;
    if (threadIdx.x == 0) (void)xb_add(&bar[XB_XCNT(b.x)], 1u);
    return b;
}
__device__ __forceinline__ void xcd_barrier_complete(unsigned* bar, unsigned x, unsigned& nloc, unsigned& nx) {
    const unsigned G = gridDim.x * gridDim.y * gridDim.z;
    unsigned sum, cnt, mine, sp = 0u;
    for (;;) {
        sum = 0u; cnt = 0u; mine = 0u;
#pragma unroll
        for (unsigned j = 0; j < 16; ++j) { const unsigned c = xb_ld(&bar[XB_XCNT(j)]); sum += c; cnt += (c > 0u) ? 1u : 0u; mine = (j == x) ? c : mine; }
        if (sum == G) break;
        __builtin_amdgcn_s_sleep(1);
        if ((++sp & 255u) == 0u) { if (xb_ld(&bar[XB_TMO])) break; if (sp > XB_SPIN_CAP) { atomicAdd(&bar[XB_TMO], 1u); break; } }
    }
    nloc = mine > 0u ? mine : 1u; nx = cnt > 0u ? cnt : 1u;
}
__device__ __forceinline__ void xcd_arrive(const XcdBarrier& b, bool leader) {
    asm volatile("s_waitcnt vmcnt(0)" ::: "memory");
    __syncthreads();
    if (leader) {
        unsigned* bar = b.bar;
        __builtin_amdgcn_s_waitcnt(0);
        unsigned nloc = b.st[0], nx = b.st[1];
        if (nloc == 0u) { xcd_barrier_complete(bar, b.x, nloc, nx); b.st[0] = nloc; b.st[1] = nx; }
        const unsigned old = xb_add(&bar[XB_XSUB(b.x)], 1u);
        const unsigned gen = old / nloc;
        b.st[2] = gen; b.st[3] = 0u;
        if (old + 1u == (gen + 1u) * nloc) {
            __builtin_amdgcn_fence(__ATOMIC_RELEASE, "agent");
            asm volatile("s_waitcnt vmcnt(0)" ::: "memory");
            const unsigned og = xb_add(&bar[XB_TOP], 1u);
            const unsigned tg = og / nx;
            b.st[4] = tg; b.st[3] = 1u;
            if (og + 1u == (tg + 1u) * nx) { xb_add(&bar[XB_TOPGEN], 1u); b.st[3] = 2u; }
        }
    }
}
__device__ __forceinline__ void xcd_wait(const XcdBarrier& b, bool leader) {
    if (leader) {
        unsigned* bar = b.bar; const unsigned gen = b.st[2], role = b.st[3], tg = b.st[4];
        if (role >= 1u) {
            if (role == 1u) XB_SPIN(xb_ld(&bar[XB_TOPGEN]) == tg, bar);
            __builtin_amdgcn_fence(__ATOMIC_ACQUIRE, "agent");
            xb_add(&bar[XB_XGEN(b.x)], 1u);
            asm volatile("s_waitcnt vmcnt(0)" ::: "memory");
        } else {
            XB_SPIN(xb_ld(&bar[XB_XGEN(b.x)]) == gen, bar);
            __builtin_amdgcn_fence(__ATOMIC_ACQUIRE, "agent");
            asm volatile("s_waitcnt vmcnt(0)" ::: "memory");
        }
    }
    __syncthreads();
}
__device__ __forceinline__ void xcd_barrier(const XcdBarrier& b, bool leader) { xcd_arrive(b, leader); xcd_wait(b, leader); }
constexpr int LDS_BYTES = 163840, RING_BYTES = LDS_BYTES - 512, MISC_OFF = RING_BYTES + 320;
constexpr int CW_BAR = 4096;

enum Phase { PH_PROLOGUE = 0, PH_INPROJ, PH_MIX1, PH_MIX2, PH_MIX3, PH_OUTPROJ, PH_NORM, PH_FFNUP, PH_FFNDOWN, PH_DISPATCH, PH_MOEUP, PH_MOEDOWN, PH_FINAL };


constexpr int PQ_OFF = 97792;
constexpr int RS = 528;
constexpr int AINB_STRIDE = RS;
constexpr int VTS = 144;
template <int NLD> __device__ __forceinline__ void slab_load(u32x4 (&reg)[NLD], const bf16* src, int nrows, int rvalid0, int tid) {
#pragma unroll
    for (int j = 0; j < NLD; ++j) { const int i = tid + j * NT, r = i >> 5, ch = i & 31; reg[j] = (u32x4){0u, 0u, 0u, 0u}; if (i < nrows * 32 && r >= rvalid0) reg[j] = *(const u32x4*)(src + (ptrdiff_t)r * DIN + ch * 8); }
}
template <int NLD> __device__ __forceinline__ void slab_store(const u32x4 (&reg)[NLD], unsigned char* dst, int nrows, int tid) {
#pragma unroll
    for (int j = 0; j < NLD; ++j) { const int i = tid + j * NT, r = i >> 5, ch = i & 31; if (i < nrows * 32) *(u32x4*)(dst + r * RS + ch * 16) = reg[j]; }
}
__device__ __forceinline__ void ytile_store(const unsigned char* src, bf16* y, int tid) {
    asm volatile("" : "+v"(tid) :: "memory");
#pragma unroll
    for (int j = 0; j < 4; ++j) { const int i = tid + j * NT, r = i >> 5, ch = i & 31; *(u32x4*)(y + (size_t)r * D + ch * 8) = *(const u32x4*)(src + r * RS + ch * 16); }
}
__device__ __forceinline__ int vt_off(int c, int tok) { return c * VTS + ((tok ^ (((c >> 3) & 7) << 3)) << 1); }
__device__ __forceinline__ void vt_store(const u32x4 (&reg)[4], unsigned char* vt, int tid) {
#pragma unroll
    for (int j = 0; j < 4; ++j) { const int i = tid + j * NT, r = i >> 5, ch = i & 31, c0 = ch * 8; const unsigned w[4] = {reg[j].x, reg[j].y, reg[j].z, reg[j].w};
#pragma unroll
        for (int q = 0; q < 8; ++q) *(bf16*)(vt + vt_off(c0 + q, r)) = (bf16)((q & 1) ? (w[q >> 1] >> 16) : (w[q >> 1] & 0xffffu)); }
}
struct LruParams { bf16x8 wa[2], wx[2]; float lam, ba, bx, cb, cw[4]; };
__device__ __forceinline__ void lru_params_load(LruParams& p, const bf16* wta, const bf16* wtx, const float* conv_w, const float* conv_b, const float* b_a, const float* b_x, const float* lam, int h, int nt, int lane) {
    asm volatile("" : "+v"(lane));
    const int fr = lane & 15, fq = lane >> 4, c = 64 * h + 16 * nt + fr;
#pragma unroll
    for (int ks = 0; ks < 2; ++ks) { p.wa[ks] = *(const bf16x8*)(wta + (size_t)(h * 64 + 16 * nt + fr) * 64 + 32 * ks + 8 * fq); p.wx[ks] = *(const bf16x8*)(wtx + (size_t)(h * 64 + 16 * nt + fr) * 64 + 32 * ks + 8 * fq); }
    p.lam = lam[c]; p.ba = b_a[c]; p.bx = b_x[c]; p.cb = conv_b[c];
#pragma unroll
    for (int k = 0; k < 4; ++k) p.cw[k] = conv_w[k * GW + c];
}
__device__ __forceinline__ void lru_ainb(const unsigned char* ax, const float* conv_w, const float* conv_b, unsigned char* ainb, int tid) {
    for (int idx = tid; idx < CH * 128; idx += NT) {
        const int t = idx >> 7, c = (idx & 127) * 2; float a0 = conv_b[c], a1 = conv_b[c + 1];
#pragma unroll
        for (int k = 0; k < 4; ++k) { const unsigned w = *(const unsigned*)(ax + (t + k) * RS + c * 2); a0 += conv_w[k * GW + c] * bf2f(w & 0xffffu); a1 += conv_w[k * GW + c + 1] * bf2f(w >> 16); }
        *(unsigned*)(ainb + t * RS + c * 2) = pk2(a0, a1);
    }
}
__device__ __forceinline__ void lru_gates(const unsigned char* ainb, const unsigned char* ax, const LruParams& p, int h, int nt, int lane, float (&av)[4][4], float (&uv)[4][4]) {
    const int fr = lane & 15, fq = lane >> 4, c = 64 * h + 16 * nt + fr;
    f32x4 aa[4], ax4[4];
#pragma unroll
    for (int mt = 0; mt < 4; ++mt) { aa[mt] = (f32x4){0.f, 0.f, 0.f, 0.f}; ax4[mt] = (f32x4){0.f, 0.f, 0.f, 0.f};
#pragma unroll
        for (int ks = 0; ks < 2; ++ks) { const bf16x8 x = *(const bf16x8*)(ainb + (16 * mt + fr) * RS + (64 * h + 32 * ks + 8 * fq) * 2);
            aa[mt] = __builtin_amdgcn_mfma_f32_16x16x32_bf16(x, p.wa[ks], aa[mt], 0, 0, 0); ax4[mt] = __builtin_amdgcn_mfma_f32_16x16x32_bf16(x, p.wx[ks], ax4[mt], 0, 0, 0); } }
    const float sp = log1pf(fexp(-p.lam));
#pragma unroll
    for (int mt = 0; mt < 4; ++mt)
#pragma unroll
        for (int r = 0; r < 4; ++r) { const int t = 16 * mt + 4 * fq + r; const float rg = sigmoidf_(aa[mt][r] + p.ba), ig = sigmoidf_(ax4[mt][r] + p.bx); const float loga = -8.0f * rg * sp;
            const float x2 = 2.0f * loga; const float m2 = x2 > -0.25f ? neg_expm1_small(x2) : -expm1f(x2);
            float xin = p.cb;
#pragma unroll
            for (int k = 0; k < 4; ++k) xin += p.cw[k] * bf2f(*(const bf16*)(ax + (t + k) * RS + c * 2));
            av[mt][r] = fexp(loga); uv[mt][r] = __builtin_amdgcn_sqrtf(fmaxf(m2, 0.f)) * ig * xin; }
}

constexpr int CW_CVTQ = 2048, CW_DONE = 8192;
constexpr int BG_IE1 = 8 * 112, BG_IE2 = 28 * 32, BG_ITEMS = 2 * NE * BG_IE1 + NE * BG_IE2, BG_BATCHES = BG_ITEMS / 8;
__device__ __forceinline__ void bg_convert(unsigned char* ws, unsigned char* lds_raw, const float* w1, const float* w3, const float* w2, int step, int G, int tid, bool drain) {
    unsigned* ctl = (unsigned*)(ws + WS_CTL); volatile unsigned* shq = (volatile unsigned*)(lds_raw + RING_BYTES);
    const int wid = tid >> 6, lane = tid & 63; float* scr = (float*)lds_raw + wid * (128 * 33);
    __syncthreads();
    if (tid == 0 && !drain) __hip_atomic_fetch_add(ctl + CW_DONE + 64 * step, 1u, __ATOMIC_RELAXED, __HIP_MEMORY_SCOPE_AGENT);
    for (;;) {
        if (tid == 0) { unsigned b = BG_BATCHES;
            if (drain || __hip_atomic_load(ctl + CW_DONE + 64 * step, __ATOMIC_RELAXED, __HIP_MEMORY_SCOPE_AGENT) + 16u < (unsigned)G) b = __hip_atomic_fetch_add(ctl + CW_CVTQ, 1u, __ATOMIC_RELAXED, __HIP_MEMORY_SCOPE_AGENT);
            shq[0] = b; }
        __syncthreads();
        const unsigned b = shq[0];
        __syncthreads();
        if (b >= (unsigned)BG_BATCHES) break;
        const int q = (int)b * 8 + wid;
        if (q < NE * BG_IE1) { const int e = q / BG_IE1, r = q % BG_IE1; cvt_item8(w1 + (size_t)e * D * DFFE, D, DFFE, ws + WS_W13 + (size_t)e * 2 * DFFE * D, 1, r, scr, lane, W13_SCALE); }
        else if (q < 2 * NE * BG_IE1) { const int q2 = q - NE * BG_IE1, e = q2 / BG_IE1, r = q2 % BG_IE1; cvt_item8(w3 + (size_t)e * D * DFFE, D, DFFE, ws + WS_W13 + (size_t)e * 2 * DFFE * D, 2, r, scr, lane, W13_SCALE); }
        else { const int q2 = q - 2 * NE * BG_IE1, e = q2 / BG_IE2, r = q2 % BG_IE2; cvt_item8(w2 + (size_t)e * DFFE * D, DFFE, D, ws + WS_W2 + (size_t)e * D * DFFE, 0, r, scr, lane, W2_SCALE); }
    }
}

__host__ __device__ __forceinline__ int moe_tail_split(int ntail) { return ntail * 4 * 7 <= 256 ? 7 : (ntail * 4 * 2 <= 256 ? 2 : 1); }

#define HN ((bf16*)(ws + WS_HN))
#define PROJ ((bf16*)(ws + WS_PROJ))
#define Y ((bf16*)(ws + WS_Y))
#define DS ((float*)(ws + WS_DS))
#define HID ((bf16*)(ws + WS_HID))
#define HIDE ((unsigned char*)(ws + WS_HIDE))
#define OUT2 ((bf16*)(ws + WS_OUT2))
#define XR ((unsigned char*)(ws + WS_XR))
#define SSP0 ((float*)(ws + WS_END))
#define SSP1 ((float*)(ws + WS_END + MiB))
#define PART ((float*)(ws + WS_END + 3 * MiB))
#define TOKROW SMALLP(int, SM_TOKROW)
#define SMALLP(T, off) ((T*)(ws + WS_SMALL + (off)))
#define RSTD SMALLP(float, SM_RSTD)
#define TOKE SMALLP(int, SM_TOKE)
#define TOKG SMALLP(float, SM_TOKG)
#define TOKR SMALLP(int, SM_TOKR)
#define BCNT SMALLP(int, SM_BCNT)
#define ROWDST SMALLP(int, SM_ROWDST)
#define ROWG SMALLP(float, SM_ROWG)
#define TILEE SMALLP(int, SM_TILEE)
#define CARA SMALLP(float, SM_CARA)
#define CARH SMALLP(float, SM_CARH)
#define CIN SMALLP(float, SM_CIN)
#define DEC SMALLP(float, SM_DEC)
#define WTA SMALLP(bf16, SM_WTA)
#define WTX SMALLP(bf16, SM_WTX)
#define WTP SMALLP(bf16, SM_WTP)
#define PHASE_ENTER int tid = wid_s * 64 + lane_id_asm(); asm volatile("" : "+v"(tid)); const int lane = tid & 63, wid = tid >> 6; __attribute__((address_space(1))) unsigned char* wsg_ = (__attribute__((address_space(1))) unsigned char*)a.ws; asm volatile("" : "+s"(wsg_)); unsigned char* ws = (unsigned char*)wsg_; \
    __attribute__((address_space(1))) float* hresg_ = (__attribute__((address_space(1))) float*)a.out; asm volatile("" : "+s"(hresg_)); float* hres = (float*)hresg_; \
    int bid = blockIdx.x; asm volatile("" : "+s"(bid)); int G = gridDim.x; asm volatile("" : "+s"(G)); (void)lane; (void)wid; (void)hres; (void)bid; (void)G;

__global__ void __launch_bounds__(NT) fwd(Args a) {
    extern __shared__ __attribute__((aligned(16))) unsigned char lds_raw[];
    float* ldsf = (float*)lds_raw;
    const int wid_s = __builtin_amdgcn_readfirstlane(threadIdx.x >> 6);
    { const int tid0 = threadIdx.x; for (int u = tid0; u < (LDS_BYTES - RING_BYTES) / 4; u += NT) ((LAS unsigned*)((LAS unsigned char*)lds_raw + RING_BYTES))[u] = 0u; }
    __syncthreads();
    XcdBarrier bar = xcd_barrier_post((unsigned*)(a.ws + WS_CTL) + CW_BAR, (volatile LAS unsigned*)((LAS unsigned char*)lds_raw + MISC_OFF) + 8);

#ifdef REP_STEP
    int rep_left = REP_N;
#endif
    for (int step = a.ph_lo; step < a.ph_hi; ++step) {
#ifdef REP_STEP
    const bool dry = (step == REP_STEP && rep_left > 0);
#else
    constexpr bool dry = false;
#endif
    int phase, L, pass = 0; (void)pass;
    if (step == 0) { phase = PH_PROLOGUE; L = 0; }
    else if (step < 6) { L = 0; const int s = step - 1; phase = s == 0 ? PH_INPROJ : s == 1 ? PH_MIX1 : s == 2 ? PH_OUTPROJ : s == 3 ? PH_FFNUP : PH_FFNDOWN; }
    else { L = 1; const int s = step - 6; phase = s == 0 ? PH_INPROJ : s == 1 ? PH_MIX1 : s == 2 ? PH_OUTPROJ : s == 3 ? PH_NORM : s == 4 ? PH_MOEUP : s == 5 ? PH_MOEDOWN : PH_FINAL; }
#ifdef REP_NOP
    if (dry) phase = 1000;
#endif
    switch (phase) {
    case PH_PROLOGUE: {
        PHASE_ENTER
        float* scr = ldsf + wid * (128 * 33);
        const int gw = bid * 8 + wid, NGW = G * 8;
        constexpr int I_IN = 16 * 80, I_OUT = 16 * 32, I_G = 16 * 88, I_D = 44 * 32;
        constexpr int T0 = 2 * I_IN, T1 = T0 + 2 * I_OUT, T2 = T1 + I_G, T3 = T2 + I_G, T4 = T3 + I_D;
        for (int it = gw; it < T4; it += NGW) {
            if (it < T0) { const int l = it / I_IN, r = it % I_IN; cvt_item(IN(1) + (size_t)l * D * DIN, D, DIN, (bf16*)(ws + WS_WIN) + (size_t)l * DIN * D, 0, r, scr, lane, l == 1 ? IN(15) + D : nullptr); }
            else if (it < T1) { const int q = it - T0, l = q / I_OUT, r = q % I_OUT; cvt_item(IN(2) + (size_t)l * D * D, D, D, (bf16*)(ws + WS_WOUT) + (size_t)l * D * D, 0, r, scr, lane); }
            else if (it < T2) { cvt_item(IN(17), D, DFF, (bf16*)(ws + WS_WGU), 1, it - T1, scr, lane, IN(16)); }
            else if (it < T3) { cvt_item(IN(18), D, DFF, (bf16*)(ws + WS_WGU), 2, it - T2, scr, lane, IN(16)); }
            else { cvt_item(IN(19), DFF, D, (bf16*)(ws + WS_WD), 0, it - T3, scr, lane); }
        }
        for (int m = gw; m < NTOK; m += NGW) rms_row_bf16(IN(0) + (size_t)m * D, IN(15), HN + (size_t)m * D, lane);
        for (int idx = bid * NT + tid; idx < 3 * 2 * 4 * HD * HD; idx += G * NT) {
            const int mat = idx / (2 * 4 * HD * HD), r = idx % (2 * 4 * HD * HD), lh = r >> 12, j = (r >> 6) & 63, i = r & 63;
            const float* w = mat == 0 ? IN(5) : mat == 1 ? IN(7) : IN(12);
            (mat == 0 ? WTA : mat == 1 ? WTX : WTP)[r] = (bf16)f2bf(w[(lh * 64 + i) * 64 + j]);
        }
    } break;

    case PH_INPROJ: {
        PHASE_ENTER
        pg8::Gemm g{HN, (const bf16*)(ws + WS_WIN) + (size_t)L * DIN * D, NTOK, DIN, D, 0}; pg8::StaticOrder S; S.init(NTOK, DIN, G, bid);
        if (L == 0) { pg8::EpiStoreBf16 E{PROJ, DIN}; pg8::gemm_phase<pg8::EpiStoreBf16, pg8::StaticOrder, true, true>((PG8_LAS unsigned char*)lds_raw, g, S, E, tid); }
        else { pg8::fill_rstd_table((PG8_LAS unsigned char*)lds_raw, S, SSP1, tid); pg8::EpiStoreBf16R E{PROJ, DIN, (const PG8_LAS float*)((PG8_LAS unsigned char*)lds_raw + pg8::RSTD_TAB_OFF)}; pg8::gemm_phase<pg8::EpiStoreBf16R, pg8::StaticOrder, true, true>((PG8_LAS unsigned char*)lds_raw, g, S, E, tid); }
    } break;

    case PH_MIX1: {
        PHASE_ENTER
        {
        const float* conv_w = IN(3) + L * 4 * GW; const float* conv_b = IN(4) + L * GW;
        const float* b_a = IN(6) + L * GW; const float* b_x = IN(8) + L * GW;
        const float* lam = IN(9) + L * GW; const float* lbp = IN(10);
        unsigned char* AX = lds_raw; unsigned char* AINB = lds_raw + 35376;
        unsigned char* FS = lds_raw; unsigned char* KHTl = lds_raw; unsigned char* VTl = lds_raw + 36864; float* TOTl = (float*)(lds_raw + 73728);
        unsigned* PQ = (unsigned*)(lds_raw + PQ_OFF);
        for (int ci = bid; ci < NCHUNK; ci += G) {
            const int t0 = (ci % CPB) * CH, g0 = ci * CH; const bf16* prow = PROJ + (size_t)g0 * DIN;
            LruParams lp[2];
#pragma unroll
            for (int cc = 0; cc < 2; ++cc) lru_params_load(lp[cc], WTA + L * 16384, WTX + L * 16384, conv_w, conv_b, b_a, b_x, lam, wid >> 1, 2 * (wid & 1) + cc, lane);
            int lbi = 64 * (wid >> 1) + lane; asm volatile("" : "+v"(lbi)); const float lbv = L == 0 ? 0.f : sigmoidf_(lbp[GW + lbi] - lbp[lbi]);
            u32x4 rf[4], rv[4];
            {
                u32x4 rax[5];
                int tl1 = tid; asm volatile("" : "+v"(tl1) :: "memory");
                slab_load<5>(rax, prow - 3 * DIN, 67, t0 == 0 ? 3 : 0, tl1);
                slab_store<5>(rax, AX, 67, tid);
            }
            __syncthreads();
            lru_ainb(AX, conv_w, conv_b, AINB, tid);
            __syncthreads();
#pragma unroll
            for (int cc = 0; cc < 2; ++cc) {
                const int h = wid >> 1, nt = 2 * (wid & 1) + cc, fr = lane & 15, fq = lane >> 4, c = 64 * h + 16 * nt + fr; float av[4][4], uv[4][4];
                lru_gates(AINB, AX, lp[cc], h, nt, lane, av, uv);
                float Pin = 1.f, Qin = 0.f;
#pragma unroll
                for (int mt = 0; mt < 4; ++mt) {
                    float Ai[4], Hi[4]; float A_ = 1.f, H_ = 0.f;
#pragma unroll
                    for (int r = 0; r < 4; ++r) { H_ = av[mt][r] * H_ + uv[mt][r]; A_ *= av[mt][r]; Ai[r] = A_; Hi[r] = H_; }
                    const float a1 = __shfl_up(A_, 16), h1 = __shfl_up(H_, 16), a2 = __shfl_up(A_, 32), h2 = __shfl_up(H_, 32), a3 = __shfl_up(A_, 48), h3 = __shfl_up(H_, 48);
                    float EA = 1.f, EH = 0.f;
                    if (fq >= 3) { EA = a3; EH = h3; }
                    if (fq >= 2) { EH = a2 * EH + h2; EA *= a2; }
                    if (fq >= 1) { EH = a1 * EH + h1; EA *= a1; }
                    float Pt[4], Qt[4];
#pragma unroll
                    for (int r = 0; r < 4; ++r) { const float al = Ai[r] * EA, be = Ai[r] * EH + Hi[r]; Pt[r] = al * Pin; Qt[r] = al * Qin + be; PQ[(16 * mt + 4 * fq + r) * 256 + c] = pk2(Pt[r], Qt[r]); }
                    Pin = __shfl(Pt[3], 48 + fr); Qin = __shfl(Qt[3], 48 + fr);
                }
                if (lane < 16) { CARA[ci * GW + c] = Pin; CARH[ci * GW + c] = Qin; }
                if (cc == 0) { int tl2 = tid; asm volatile("" : "+v"(tl2) :: "memory"); slab_load<4>(rf, prow + 768, 64, 0, tl2); slab_load<4>(rv, prow + 1024, 64, 0, tl2); }
            }
            __syncthreads();
            slab_store<4>(rf, FS, 64, tid); vt_store(rv, VTl, tid);
            __syncthreads();
            {
                const int h = wid >> 1, half = wid & 1, c = 64 * h + lane, fr = lane & 15, fq = lane >> 4;
                const float lb = lbv;
                float gl[32], kk[32]; float run = 0.f;
#pragma unroll
                for (int t = 0; t < 32; ++t) { const float sg = sigmoidf_(bf2f(*(const bf16*)(FS + (32 * half + t) * RS + c * 2))); run += flog(lb + (1.f - lb) * sg); gl[t] = run; kk[t] = (1.f - lb) * (1.f - sg); }
                TOTl[(h * 2 + half) * 64 + lane] = run;
                __syncthreads();
                const float tot0 = TOTl[(h * 2) * 64 + lane], glast = tot0 + TOTl[(h * 2 + 1) * 64 + lane], off = half ? tot0 : 0.f;
#pragma unroll
                for (int j = 0; j < 4; ++j) { float e[8];
#pragma unroll
                    for (int q = 0; q < 8; ++q) e[q] = kk[8 * j + q] * fexp(glast - (off + gl[8 * j + q]));
                    u32x4 w; w.x = pk2(e[0], e[1]); w.y = pk2(e[2], e[3]); w.z = pk2(e[4], e[5]); w.w = pk2(e[6], e[7]);
                    *(u32x4*)(KHTl + c * VTS + (32 * half + 8 * j) * 2) = w; }
                if (half) DEC[(ci * 4 + h) * 64 + lane] = fexp(glast);
                __syncthreads();
#pragma unroll
                for (int vvv = 0; vvv < 2; ++vvv) {
                    const int vt = 2 * half + vvv, vrow = 64 * h + 16 * vt + fr; bf16x8 bv[2];
#pragma unroll
                    for (int ks = 0; ks < 2; ++ks) bv[ks] = *(const bf16x8*)(VTl + vt_off(vrow, 32 * ks + 8 * fq));
#pragma unroll
                    for (int kt = 0; kt < 4; ++kt) { f32x4 acc = (f32x4){0.f, 0.f, 0.f, 0.f};
#pragma unroll
                        for (int ks = 0; ks < 2; ++ks) { const bf16x8 ka = *(const bf16x8*)(KHTl + (64 * h + 16 * kt + fr) * VTS + (32 * ks + 8 * fq) * 2); acc = __builtin_amdgcn_mfma_f32_16x16x32_bf16(ka, bv[ks], acc, 0, 0, 0); }
                        *(f32x4*)(DS + ((size_t)(ci * 4 + h) * 64 + 16 * vt + fr) * 64 + 16 * kt + 4 * fq) = acc; }
                }
                __syncthreads();
            }
        }
        }
        xcd_arrive(bar, tid == 0);
        {
        const float* conv_w = IN(3) + L * 4 * GW; const float* conv_b = IN(4) + L * GW; const float* b_a = IN(6) + L * GW; const float* b_x = IN(8) + L * GW; const float* lam = IN(9) + L * GW;
        const float* lbp = IN(10); const float* norm_g = IN(11) + L * HD; const float* pool_s = IN(13) + L * GW; const float* sconv_w = IN(14) + L * 3 * GW;
        unsigned char* AX = lds_raw; unsigned char* AG = lds_raw + 35376; unsigned char* AINB = lds_raw + 69168;
        unsigned char* QT3 = lds_raw; unsigned char* KT3 = lds_raw + 33792; unsigned char* OG3 = lds_raw + 67584; unsigned char* VT3 = lds_raw + 101376; float* TOT3 = (float*)(lds_raw + 138240);
        unsigned char* PS = lds_raw; unsigned char* DIMG = lds_raw + 41712; unsigned char* YST = lds_raw;
        unsigned char* SB = lds_raw; unsigned char* SC = lds_raw + 33792; unsigned char* SX = lds_raw + 68640;
        for (int ci = bid; ci < NCHUNK; ci += G) {
            const int t0 = (ci % CPB) * CH, g0 = ci * CH; const bf16* prow = PROJ + (size_t)g0 * DIN; bf16* yrow = Y + (size_t)g0 * D; (void)t0; (void)yrow;
            { u32x4 rp[5]; int tlc = tid; asm volatile("" : "+v"(tlc) :: "memory"); slab_load<5>(rp, prow - 15 * DIN + 1536, 79, t0 == 0 ? 15 : 0, tlc); slab_store<5>(rp, PS, 79, tid); }
            __syncthreads();
            for (int idx = tid; idx < CH * 128; idx += NT) {
                const int t = idx >> 7, c = (idx & 127) * 2, gi = c >> 6, w = 2 << gi; const int tt = t0 + t; const int cnt = (tt + 1 < w) ? (tt + 1) : w; float s0 = 0.f, s1 = 0.f; unsigned xs[16];
#pragma unroll
                for (int r = 0; r < 16; ++r) xs[r] = *(const unsigned*)(PS + (t + 15 - r) * RS + c * 2);
#pragma unroll
                for (int r = 0; r < 16; ++r) { const float m_ = r < cnt ? 1.0f : 0.0f; s0 += m_ * bf2f(xs[r] & 0xffffu); s1 += m_ * bf2f(xs[r] >> 16); }
                const float inv = __builtin_amdgcn_rcpf((float)cnt);
                *(unsigned*)(DIMG + t * RS + c * 2) = pk2(s0 * inv - bf2f(xs[0] & 0xffffu), s1 * inv - bf2f(xs[0] >> 16));
            }
            __syncthreads();
#pragma unroll 1
            for (int cc = 0; cc < 2; ++cc) {
                const int gi = wid >> 1, nt = 2 * (wid & 1) + cc, fr = lane & 15, fq = lane >> 4, c = 64 * gi + 16 * nt + fr; bf16x8 wp[2];
#pragma unroll
                for (int ks = 0; ks < 2; ++ks) wp[ks] = *(const bf16x8*)(WTP + L * 16384 + (size_t)(gi * 64 + 16 * nt + fr) * 64 + 32 * ks + 8 * fq);
                const float psc = pool_s[c];
#pragma unroll
                for (int mt = 0; mt < 4; ++mt) { f32x4 acc = (f32x4){0.f, 0.f, 0.f, 0.f};
#pragma unroll
                    for (int ks = 0; ks < 2; ++ks) { const bf16x8 x = *(const bf16x8*)(DIMG + (16 * mt + fr) * RS + (64 * gi + 32 * ks + 8 * fq) * 2); acc = __builtin_amdgcn_mfma_f32_16x16x32_bf16(x, wp[ks], acc, 0, 0, 0); }
#pragma unroll
                    for (int r = 0; r < 4; ++r) *(bf16*)(YST + (16 * mt + 4 * fq + r) * RS + c * 2) = (bf16)f2bf(acc[r] * psc); }
            }
            __syncthreads();
            ytile_store(YST, yrow + 512, tid);
            __syncthreads();
        }
        }
        xcd_wait(bar, tid == 0);
        {
        float* xa = ldsf; float* xs = ldsf + 512;
        for (int item = bid; item < 256 + 8; item += G) {
            if (item < 256) {
                const int el = tid & 127, seg = tid >> 7, e = item * 128 + el, b = e >> 14, hh = (e >> 12) & 3, kv = e & 4095, k = kv & 63;
                float dv[32], dc[32];
#pragma unroll
                for (int i = 0; i < 32; ++i) { const int ci = b * CPB + seg * 32 + i; dv[i] = DS[(size_t)(ci * 4 + hh) * 4096 + kv]; dc[i] = DEC[(ci * 4 + hh) * 64 + k]; }
                float S = 0.f, A = 1.f;
#pragma unroll
                for (int i = 0; i < 32; ++i) { const float d = dv[i]; dv[i] = S; S = dc[i] * S + d; const float a0 = dc[i]; dc[i] = A; A *= a0; }
                xa[seg * 128 + el] = A; xs[seg * 128 + el] = S;
                __syncthreads();
                float Sin = 0.f;
                for (int s2 = 0; s2 < seg; ++s2) Sin = xa[s2 * 128 + el] * Sin + xs[s2 * 128 + el];
#pragma unroll
                for (int i = 0; i < 32; ++i) { const int ci = b * CPB + seg * 32 + i; (dry ? DS + 20 * (MiB / 4) * 4 : DS)[(size_t)(ci * 4 + hh) * 4096 + kv] = dv[i] + dc[i] * Sin; }
                __syncthreads();
            } else {
                const int q = item - 256, sq = tid & 63, chg = q * 64 + sq, b = chg >> 8, c = chg & 255, seg = tid >> 6;
                float ca[16], chh[16];
#pragma unroll
                for (int i = 0; i < 16; ++i) { const int ci = b * CPB + seg * 16 + i; ca[i] = CARA[ci * GW + c]; chh[i] = CARH[ci * GW + c]; }
                float A = 1.f, H = 0.f;
#pragma unroll
                for (int i = 0; i < 16; ++i) { const float a0 = ca[i], h0 = chh[i]; ca[i] = A; chh[i] = H; H = a0 * H + h0; A *= a0; }
                xa[seg * 64 + sq] = A; xs[seg * 64 + sq] = H;
                __syncthreads();
                float Hin = 0.f;
                for (int s2 = 0; s2 < seg; ++s2) Hin = xa[s2 * 64 + sq] * Hin + xs[s2 * 64 + sq];
#pragma unroll
                for (int i = 0; i < 16; ++i) { const int ci = b * CPB + seg * 16 + i; CIN[ci * GW + c] = chh[i] + ca[i] * Hin; }
                __syncthreads();
            }
        }
        }
        xcd_arrive(bar, tid == 0);
        {
        const float* conv_w = IN(3) + L * 4 * GW; const float* conv_b = IN(4) + L * GW; const float* b_a = IN(6) + L * GW; const float* b_x = IN(8) + L * GW; const float* lam = IN(9) + L * GW;
        const float* lbp = IN(10); const float* norm_g = IN(11) + L * HD; const float* pool_s = IN(13) + L * GW; const float* sconv_w = IN(14) + L * 3 * GW;
        unsigned char* AX = lds_raw; unsigned char* AG = lds_raw + 35376; unsigned char* AINB = lds_raw + 69168;
        unsigned char* QT3 = lds_raw; unsigned char* KT3 = lds_raw + 33792; unsigned char* OG3 = lds_raw + 67584; unsigned char* VT3 = lds_raw + 101376; float* TOT3 = (float*)(lds_raw + 138240);
        unsigned char* PS = lds_raw; unsigned char* DIMG = lds_raw + 41712; unsigned char* YST = lds_raw;
        unsigned char* SB = lds_raw; unsigned char* SC = lds_raw + 33792; unsigned char* SX = lds_raw + 68640;
        for (int ci = bid; ci < NCHUNK; ci += G) {
            const int t0 = (ci % CPB) * CH, g0 = ci * CH; const bf16* prow = PROJ + (size_t)g0 * DIN; bf16* yrow = Y + (size_t)g0 * D; (void)t0; (void)yrow;
            { u32x4 rsb[4], rsc[5], rsx[5]; int tld = tid; asm volatile("" : "+v"(tld) :: "memory"); slab_load<4>(rsb, prow + 1792, 64, 0, tld); slab_load<5>(rsc, prow - 2 * DIN + 2048, 66, t0 == 0 ? 2 : 0, tld); slab_load<5>(rsx, prow - 2 * DIN + 2304, 66, t0 == 0 ? 2 : 0, tld);
#pragma unroll
              for (int j = 0; j < 5; ++j) {
                  const unsigned a[4] = {rsc[j].x, rsc[j].y, rsc[j].z, rsc[j].w}, b[4] = {rsx[j].x, rsx[j].y, rsx[j].z, rsx[j].w}; unsigned p[4];
#pragma unroll
                  for (int q = 0; q < 4; ++q) p[q] = pk2(bf2f(a[q] & 0xffffu) * bf2f(b[q] & 0xffffu), bf2f(a[q] >> 16) * bf2f(b[q] >> 16));
                  rsc[j] = (u32x4){p[0], p[1], p[2], p[3]}; }
              slab_store<4>(rsb, SB, 64, tid); slab_store<5>(rsc, SC, 66, tid); }
            __syncthreads();
            int tq = tid; asm volatile("" : "+v"(tq));
            for (int idx = tq; idx < CH * 128; idx += NT) {
                const int t = idx >> 7, c = (idx & 127) * 2; float a0 = 0.f, a1 = 0.f;
#pragma unroll
                for (int k = 0; k < 3; ++k) { const unsigned xc = *(const unsigned*)(SC + (t + k) * RS + c * 2); a0 += sconv_w[k * GW + c] * bf2f(xc & 0xffffu); a1 += sconv_w[k * GW + c + 1] * bf2f(xc >> 16); }
                unsigned* pb = (unsigned*)(SB + t * RS + c * 2); const unsigned b = *pb; *pb = pk2(bf2f(b & 0xffffu) * a0, bf2f(b >> 16) * a1);
            }
            __syncthreads();
            ytile_store(SB, yrow + 768, tid);
            __syncthreads();
        }
        }
        xcd_wait(bar, tid == 0);
        {
        const float* conv_w = IN(3) + L * 4 * GW; const float* conv_b = IN(4) + L * GW; const float* b_a = IN(6) + L * GW; const float* b_x = IN(8) + L * GW; const float* lam = IN(9) + L * GW;
        const float* lbp = IN(10); const float* norm_g = IN(11) + L * HD; const float* pool_s = IN(13) + L * GW; const float* sconv_w = IN(14) + L * 3 * GW;
        unsigned char* AX = lds_raw; unsigned char* AG = lds_raw + 35376; unsigned char* AINB = lds_raw + 69168;
        unsigned char* QT3 = lds_raw; unsigned char* KT3 = lds_raw + 33792; unsigned char* OG3 = lds_raw + 67584; unsigned char* VT3 = lds_raw + 101376; float* TOT3 = (float*)(lds_raw + 138240);
        unsigned char* PS = lds_raw; unsigned char* DIMG = lds_raw + 41712; unsigned char* YST = lds_raw;
        unsigned char* SB = lds_raw; unsigned char* SC = lds_raw + 33792; unsigned char* SX = lds_raw + 68640;
        for (int ci = bid; ci < NCHUNK; ci += G) {
            const int t0 = (ci % CPB) * CH, g0 = ci * CH; const bf16* prow = PROJ + (size_t)g0 * DIN; bf16* yrow = Y + (size_t)g0 * D; (void)t0; (void)yrow;
            int lbi = 64 * (wid >> 1) + lane; asm volatile("" : "+v"(lbi)); const float lbv = L == 0 ? 0.f : sigmoidf_(lbp[GW + lbi] - lbp[lbi]);
            { unsigned* PQ = (unsigned*)(lds_raw + PQ_OFF);
              const int c = (tid & 127) * 2; const float hin_a = CIN[ci * GW + c], hin_b = CIN[ci * GW + c + 1];
              unsigned ag[16];
#pragma unroll
              for (int i = 0; i < 16; ++i) ag[i] = *(const unsigned*)(prow + (size_t)(4 * i + (tid >> 7)) * DIN + 256 + c);
#pragma unroll
              for (int i = 0; i < 16; ++i) { const int t = 4 * i + (tid >> 7); const unsigned pa = PQ[t * 256 + c], pb = PQ[t * 256 + c + 1];
                  const float ha = bf2f(pa & 0xffffu) * hin_a + bf2f(pa >> 16), hb = bf2f(pb & 0xffffu) * hin_b + bf2f(pb >> 16);
                  *(unsigned*)(yrow + (size_t)t * D + c) = pk2(ha * gelu_tanh(bf2f(ag[i] & 0xffffu)), hb * gelu_tanh(bf2f(ag[i] >> 16))); }
            }
            __syncthreads();
            { u32x4 rq[4], rf[4], rv[4], rog[4]; int tlb = tid; asm volatile("" : "+v"(tlb) :: "memory"); slab_load<4>(rq, prow + 512, 64, 0, tlb); slab_load<4>(rf, prow + 768, 64, 0, tlb); slab_load<4>(rv, prow + 1024, 64, 0, tlb); slab_load<4>(rog, prow + 1280, 64, 0, tlb);
              slab_store<4>(rq, QT3, 64, tid); slab_store<4>(rf, KT3, 64, tid); slab_store<4>(rog, OG3, 64, tid); vt_store(rv, VT3, tid); }
            __syncthreads();
            {
                const int h = wid >> 1, half = wid & 1, c = 64 * h + lane, fr = lane & 15, fq = lane >> 4;
                const float lb = lbv;
                f32x4 sraw[4][2][2];
#pragma unroll
                for (int vt = 0; vt < 4; ++vt)
#pragma unroll
                    for (int ks = 0; ks < 2; ++ks) { const float* p = DS + ((size_t)(ci * 4 + h) * 64 + 16 * vt + fr) * 64 + 32 * ks + 8 * fq; sraw[vt][ks][0] = *(const f32x4*)p; sraw[vt][ks][1] = *(const f32x4*)(p + 4); }
                float gl[32]; float run = 0.f;
#pragma unroll
                for (int t = 0; t < 32; ++t) { const float sg = sigmoidf_(bf2f(*(const bf16*)(KT3 + (32 * half + t) * RS + c * 2))); run += flog(lb + (1.f - lb) * sg); gl[t] = run; }
                TOT3[(h * 2 + half) * 64 + lane] = run;
                __syncthreads();
                const float tot0 = TOT3[(h * 2) * 64 + lane];
                const float off = half ? 0.f : -tot0;
#pragma unroll
                for (int t = 0; t < 32; ++t) {
                    bf16* pq = (bf16*)(QT3 + (32 * half + t) * RS + c * 2); bf16* pk = (bf16*)(KT3 + (32 * half + t) * RS + c * 2);
                    const float sg = sigmoidf_(bf2f(*pk)), kkv = (1.f - lb) * (1.f - sg), qfv = siluf_(bf2f(*pq)), d = gl[t] + off;
                    *pq = (bf16)f2bf(qfv * fexp(d)); *pk = (bf16)f2bf(kkv * fexp(-d));
                }
                __syncthreads();
                bf16x8 sa[4][2];
#pragma unroll
                for (int vt = 0; vt < 4; ++vt)
#pragma unroll
                    for (int ks = 0; ks < 2; ++ks) {
                        const f32x4 lo = sraw[vt][ks][0], hi = sraw[vt][ks][1];
                        const float* eg = TOT3 + (h * 2) * 64 + 32 * ks + 8 * fq;
                        u32x4 w; w.x = pk2(lo.x * fexp(eg[0]), lo.y * fexp(eg[1])); w.y = pk2(lo.z * fexp(eg[2]), lo.w * fexp(eg[3])); w.z = pk2(hi.x * fexp(eg[4]), hi.y * fexp(eg[5])); w.w = pk2(hi.z * fexp(eg[6]), hi.w * fexp(eg[7]));
                        sa[vt][ks] = __builtin_bit_cast(bf16x8, w);
                    }
#pragma unroll
                for (int tsel = 0; tsel < 2; ++tsel) {
                    const int ti = half == 0 ? (tsel ? 3 : 0) : (tsel ? 2 : 1);
                    bf16x8 qb[2];
#pragma unroll
                    for (int ks = 0; ks < 2; ++ks) qb[ks] = *(const bf16x8*)(QT3 + (16 * ti + fr) * RS + (64 * h + 32 * ks + 8 * fq) * 2);
                    f32x4 st[4];
#pragma unroll
                    for (int si = 0; si < 4; ++si) { st[si] = (f32x4){0.f, 0.f, 0.f, 0.f};
                        if (si <= ti) {
#pragma unroll
                            for (int ks = 0; ks < 2; ++ks) { const bf16x8 ka = *(const bf16x8*)(KT3 + (16 * si + fr) * RS + (64 * h + 32 * ks + 8 * fq) * 2); st[si] = __builtin_amdgcn_mfma_f32_16x16x32_bf16(ka, qb[ks], st[si], 0, 0, 0); }
                            if (si == ti) {
#pragma unroll
                                for (int r = 0; r < 4; ++r) if (4 * fq + r > fr) st[si][r] = 0.f; }
                        } }
                    f32x4 oo[4];
#pragma unroll
                    for (int vt = 0; vt < 4; ++vt) { oo[vt] = (f32x4){0.f, 0.f, 0.f, 0.f};
#pragma unroll
                        for (int ks = 0; ks < 2; ++ks) oo[vt] = __builtin_amdgcn_mfma_f32_16x16x32_bf16(sa[vt][ks], qb[ks], oo[vt], 0, 0, 0); }
#pragma unroll
                    for (int p = 0; p < 2; ++p) if (2 * p <= ti) {
                        u32x4 bw; bw.x = pk2(st[2 * p][0], st[2 * p][1]); bw.y = pk2(st[2 * p][2], st[2 * p][3]); bw.z = pk2(st[2 * p + 1][0], st[2 * p + 1][1]); bw.w = pk2(st[2 * p + 1][2], st[2 * p + 1][3]);
                        const bf16x8 bfr = __builtin_bit_cast(bf16x8, bw);
#pragma unroll
                        for (int vt = 0; vt < 4; ++vt) { const int vrow = 64 * h + 16 * vt + fr; const u32x2 lo8 = *(const u32x2*)(VT3 + vt_off(vrow, 32 * p + 4 * fq)), hi8 = *(const u32x2*)(VT3 + vt_off(vrow, 32 * p + 16 + 4 * fq));
                            u32x4 aw; aw.x = lo8.x; aw.y = lo8.y; aw.z = hi8.x; aw.w = hi8.y;
                            oo[vt] = __builtin_amdgcn_mfma_f32_16x16x32_bf16(__builtin_bit_cast(bf16x8, aw), bfr, oo[vt], 0, 0, 0); }
                    }
                    float ss = 0.f;
#pragma unroll
                    for (int vt = 0; vt < 4; ++vt) ss += (oo[vt][0] * oo[vt][0] + oo[vt][1] * oo[vt][1]) + (oo[vt][2] * oo[vt][2] + oo[vt][3] * oo[vt][3]);
                    ss += __shfl_xor(ss, 16); ss += __shfl_xor(ss, 32);
                    const float rs = __builtin_amdgcn_rsqf(ss * (1.0f / HD) + 1e-5f);
#pragma unroll
                    for (int vt = 0; vt < 4; ++vt) { const int cv = 64 * h + 16 * vt + 4 * fq; u32x2* pog = (u32x2*)(OG3 + (16 * ti + fr) * RS + cv * 2); const u32x2 og = *pog; const f32x4 ng = *(const f32x4*)(norm_g + 16 * vt + 4 * fq);
                        u32x2 w; w.x = pk2(oo[vt][0] * rs * ng.x * siluf_(bf2f(og.x & 0xffffu)), oo[vt][1] * rs * ng.y * siluf_(bf2f(og.x >> 16))); w.y = pk2(oo[vt][2] * rs * ng.z * siluf_(bf2f(og.y & 0xffffu)), oo[vt][3] * rs * ng.w * siluf_(bf2f(og.y >> 16)));
                        *pog = w; }
                }
                __syncthreads();
            }
            ytile_store(OG3, yrow + 256, tid);
            __syncthreads();
        }
        }
    } break;

    case PH_OUTPROJ: {
        PHASE_ENTER
        pg8::Gemm g{Y, (const bf16*)(ws + WS_WOUT) + (size_t)L * D * D, NTOK, D, D, 0}; pg8::StaticOrder S; S.init(NTOK, D, G, bid);
        if (L == 0) { pg8::EpiResidStats E{IN(0), hres, HN, SSP0}; pg8::gemm_phase<pg8::EpiResidStats, pg8::StaticOrder, true, true>((PG8_LAS unsigned char*)lds_raw, g, S, E, tid); }
        else { pg8::EpiResidF32 E{hres, hres}; pg8::gemm_phase<pg8::EpiResidF32, pg8::StaticOrder, true, true>((PG8_LAS unsigned char*)lds_raw, g, S, E, tid); }
    } break;

    case PH_NORM: {
        PHASE_ENTER
        const float* g = IN(16) + D;
        unsigned* XROW = (unsigned*)lds_raw;
        int* sel = (int*)(lds_raw + 65536);
        int* rnk = sel + 128;
        int* sh = rnk + 128;
        int* cnts = sh + 64;
        const int blk = bid;
        {
            float wr[16][8];
            { const float* wr_ = IN(20);
#pragma unroll
              for (int j = 0; j < 4; ++j)
#pragma unroll
                for (int q = 0; q < 4; ++q) { const f32x4 w0 = *(const f32x4*)(wr_ + (size_t)(4 * (lane + 64 * j) + q) * 8), w1 = *(const f32x4*)(wr_ + (size_t)(4 * (lane + 64 * j) + q) * 8 + 4);
                    wr[j * 4 + q][0] = w0.x; wr[j * 4 + q][1] = w0.y; wr[j * 4 + q][2] = w0.z; wr[j * 4 + q][3] = w0.w; wr[j * 4 + q][4] = w1.x; wr[j * 4 + q][5] = w1.y; wr[j * 4 + q][6] = w1.z; wr[j * 4 + q][7] = w1.w; } }
            f32x4 gv[4];
#pragma unroll
            for (int j = 0; j < 4; ++j) gv[j] = ((const f32x4*)g)[lane + 64 * j];
            f32x4 vn[4];
            { const f32x4* xr = (const f32x4*)(hres + (size_t)(blk * 64 + wid * 8) * D);
#pragma unroll
              for (int j = 0; j < 4; ++j) vn[j] = xr[lane + 64 * j]; }
#pragma unroll 1
            for (int r8 = 0; r8 < 8; ++r8) {
                const int tl = wid * 8 + r8, m = blk * 64 + tl;
                f32x4 v[4]; float s = 0.f;
#pragma unroll
                for (int j = 0; j < 4; ++j) { v[j] = vn[j]; s += (v[j].x * v[j].x + v[j].y * v[j].y) + (v[j].z * v[j].z + v[j].w * v[j].w); }
                if (r8 < 7) { const f32x4* xr = (const f32x4*)(hres + (size_t)(m + 1) * D);
#pragma unroll
                    for (int j = 0; j < 4; ++j) vn[j] = xr[lane + 64 * j]; }
                const float r = 1.0f / sqrtf(wave_sum(s) * (1.0f / D) + 1e-6f);
                float lg[8] = {0.f, 0.f, 0.f, 0.f, 0.f, 0.f, 0.f, 0.f};
#pragma unroll
                for (int j = 0; j < 4; ++j) { const float y[4] = {v[j].x * r * gv[j].x, v[j].y * r * gv[j].y, v[j].z * r * gv[j].z, v[j].w * r * gv[j].w};
                    XROW[tl * 256 + lane + 64 * j] = pg8::pk4_fp8(y[0], y[1], y[2], y[3]);
#pragma unroll
                    for (int q = 0; q < 4; ++q)
#pragma unroll
                        for (int e = 0; e < 8; ++e) lg[e] += y[q] * wr[j * 4 + q][e]; }
#pragma unroll
                for (int e = 0; e < 8; ++e) lg[e] = wave_sum(lg[e]);
                if (lane == 0) {
                    int e1 = 0; float l1 = lg[0];
#pragma unroll
                    for (int e = 1; e < 8; ++e) if (lg[e] > l1) { l1 = lg[e]; e1 = e; }
                    int e2 = -1; float l2 = -3.0e38f;
#pragma unroll
                    for (int e = 0; e < 8; ++e) if (e != e1 && lg[e] > l2) { l2 = lg[e]; e2 = e; }
                    const float g1 = 1.0f / (1.0f + fexp(l2 - l1));
                    TOKG[m * 2] = g1; TOKG[m * 2 + 1] = 1.0f - g1;
                    sel[tl * 2] = e1; sel[tl * 2 + 1] = e2;
                }
            }
            __syncthreads();
            if (tid < NE) { int cnt = 0; for (int q = 0; q < 128; ++q) if (sel[q] == tid) { rnk[q] = cnt; ++cnt; } BCNT[blk * NE + tid] = cnt; }
        }
        xcd_barrier(bar, tid == 0);
        {
            for (int i = tid; i < (NTOK / 64) * NE; i += NT) cnts[i] = BCNT[i];
            __syncthreads();
            { const int e = wid; int sall = 0, slt = 0;
#pragma unroll
              for (int i = 0; i < 4; ++i) { const int b2 = 4 * lane + i, c = cnts[b2 * NE + e]; sall += c; slt += (b2 < blk) ? c : 0; }
#pragma unroll
              for (int o = 1; o < 64; o <<= 1) { sall += __shfl_xor(sall, o); slt += __shfl_xor(slt, o); }
              if (lane == 0) { sh[e] = sall; sh[16 + e] = slt; sh[24 + e] = (sall + 255) >> 8; } }
            __syncthreads();
            if (tid == 0) { int acc = 0; for (int e = 0; e < NE; ++e) { sh[8 + e] = acc * 256; acc += sh[24 + e]; } sh[32] = acc; }
            __syncthreads();
            if (tid < 128) { const int m = blk * 64 + (tid >> 1); const int e = sel[tid]; const int r = sh[8 + e] + sh[16 + e] + rnk[tid];
                ROWDST[r] = m * 2 + (tid & 1); ROWG[r] = TOKG[blk * 128 + tid]; TOKROW[blk * 128 + tid] = r; }
#pragma unroll
            for (int r8 = 0; r8 < 8; ++r8) {
                const int tl = wid * 8 + r8; const int e0 = sel[tl * 2], e1 = sel[tl * 2 + 1];
                const int r0 = sh[8 + e0] + sh[16 + e0] + rnk[tl * 2], r1 = sh[8 + e1] + sh[16 + e1] + rnk[tl * 2 + 1];
                const u32x4 w = *(const u32x4*)(XROW + tl * 256 + 4 * lane);
                *(u32x4*)(XR + (size_t)r0 * D + 16 * lane) = w; *(u32x4*)(XR + (size_t)r1 * D + 16 * lane) = w;
            }
            if (blk == 0) {
                for (int e = 0; e < NE; ++e) { const int lo = sh[8 + e] + sh[e], hi = sh[8 + e] + sh[24 + e] * 256; for (int r = lo + tid; r < hi; r += NT) { ROWDST[r] = -1; ROWG[r] = 0.f; } }
                if (tid < MAXTILES) { int e = 0; for (int q = 0; q < NE; ++q) if (tid * 256 >= sh[8 + q]) e = q; TILEE[tid] = e; }
                if (tid == 0) TILEE[MAXTILES] = sh[32];
            }
            __syncthreads();
        }
    } break;

    case PH_FFNUP: {
        PHASE_ENTER
        pg8::Gemm g{HN, (const bf16*)(ws + WS_WGU), NTOK, 2 * DFF, D, 0}; pg8::StaticOrder S; S.init(NTOK, 2 * DFF, G, bid);
        pg8::fill_rstd_table((PG8_LAS unsigned char*)lds_raw, S, SSP0, tid);
        pg8::EpiSwigluR E{HID, DFF, (const PG8_LAS float*)((PG8_LAS unsigned char*)lds_raw + pg8::RSTD_TAB_OFF)};
        pg8::gemm_phase<pg8::EpiSwigluR, pg8::StaticOrder, true, true>((PG8_LAS unsigned char*)lds_raw, g, S, E, tid);
    } break;

    case PH_FFNDOWN: {
        PHASE_ENTER
        pg8::Gemm g{HID, (const bf16*)(ws + WS_WD), NTOK, D, DFF, 0}; pg8::StaticOrder S; S.init(NTOK, D, G, bid);
        pg8::EpiResidStats E{hres, dry ? (float*)(ws + 410 * MiB) : hres, HN, SSP1};
        pg8::gemm_phase<pg8::EpiResidStats, pg8::StaticOrder, true, true>((PG8_LAS unsigned char*)lds_raw, g, S, E, tid);
    } break;

    case PH_MOEUP: {
        PHASE_ENTER
        const int ntiles = __builtin_amdgcn_readfirstlane(__hip_atomic_load(TILEE + MAXTILES, __ATOMIC_RELAXED, __HIP_MEMORY_SCOPE_AGENT));
        pg8::Gemm g{(const bf16*)XR, (const bf16*)(ws + WS_W13), 0, 0, D / 2, 0}; pg8::MoeOrder S; S.init(ntiles, DFFE / 128, G, bid, 0, 0, TILEE);
        pg8::EpiSwiglu8 E{HIDE, DFFE, 1.0f / W13_SCALE, HID_SCALE};
        pg8::gemm_phase<pg8::EpiSwiglu8, pg8::MoeOrder, true, true, true>((PG8_LAS unsigned char*)lds_raw, g, S, E, tid);
    } break;

    case PH_MOEDOWN: {
        PHASE_ENTER
        const int ntiles = __builtin_amdgcn_readfirstlane(__hip_atomic_load(TILEE + MAXTILES, __ATOMIC_RELAXED, __HIP_MEMORY_SCOPE_AGENT));
        const int tfull = (ntiles / 64) * 64, ntail = ntiles - tfull;
        if (tfull > 0) {
            pg8::Gemm g{(const bf16*)HIDE, (const bf16*)(ws + WS_W2), 0, 0, DFFE / 2, 0}; pg8::MoeOrder S; S.init(tfull, D / 256, G, bid, 0, 0, TILEE);
            pg8::EpiMoeDown E{OUT2, ROWDST, ROWG, 1.0f / (W2_SCALE * HID_SCALE)};
            pg8::gemm_phase<pg8::EpiMoeDown, pg8::MoeOrder, true, true, true>((PG8_LAS unsigned char*)lds_raw, g, S, E, tid);
        }
        if (ntail > 0) {
            const int Sp = moe_tail_split(ntail);
            pg8::Gemm g{(const bf16*)HIDE, (const bf16*)(ws + WS_W2), 0, 0, DFFE / 2 / Sp, DFFE / 2};
            pg8::MoeTailOrder S{tfull, ntail, D / 256, Sp, G, bid, DFFE / Sp, TILEE};
            pg8::EpiPartF32 E{PART};
            pg8::gemm_phase<pg8::EpiPartF32, pg8::MoeTailOrder, true, true, true>((PG8_LAS unsigned char*)lds_raw, g, S, E, tid);
        }
    } break;

    case PH_FINAL: {
        PHASE_ENTER
        const float* g = IN(24); const int gw = bid * 8 + wid, NGW = G * 8;
        const int ntiles = __builtin_amdgcn_readfirstlane(__hip_atomic_load(TILEE + MAXTILES, __ATOMIC_RELAXED, __HIP_MEMORY_SCOPE_AGENT));
        const int tfull = (ntiles / 64) * 64, ntail = ntiles - tfull, Sp = ntail > 0 ? moe_tail_split(ntail) : 1, tail_row0 = tfull * 256; const float sc = 1.0f / (W2_SCALE * HID_SCALE);
        for (int mb = gw; mb < NTOK; mb += 8 * NGW) {
        int trow[8][2];
#pragma unroll
        for (int k = 0; k < 8; ++k) { const int m = mb + k * NGW; trow[k][0] = m < NTOK ? TOKROW[2 * m] : 0; trow[k][1] = m < NTOK ? TOKROW[2 * m + 1] : 0; }
#pragma unroll
        for (int k = 0; k < 8; ++k) { const int m = mb + k * NGW; if (m >= NTOK) break;
            f32x4* xr = (f32x4*)(hres + (size_t)m * D); const f32x4* gr = (const f32x4*)g;
            f32x4 v[4]; u32x2 ob[2][4]; float s = 0.f;
#pragma unroll
            for (int j = 0; j < 4; ++j) { v[j] = xr[lane + 64 * j]; ob[0][j] = ((const u32x2*)(OUT2 + (size_t)(2 * m) * D))[lane + 64 * j]; ob[1][j] = ((const u32x2*)(OUT2 + (size_t)(2 * m + 1) * D))[lane + 64 * j]; }
#pragma unroll
            for (int slot = 0; slot < 2; ++slot) {
                const int r = __builtin_amdgcn_readfirstlane(trow[k][slot]);
                if (r < tail_row0) {
#pragma unroll
                    for (int j = 0; j < 4; ++j) { const u32x2 p = ob[slot][j]; v[j].x += bf2f(p.x & 0xffffu); v[j].y += bf2f(p.x >> 16); v[j].z += bf2f(p.y & 0xffffu); v[j].w += bf2f(p.y >> 16); } }
                else { const int tl = (r - tail_row0) >> 8, rl = (r - tail_row0) & 255; const float gt = TOKG[2 * m + slot] * sc;
                    f32x4 q[7][4];
#pragma unroll
                    for (int p = 0; p < 7; ++p) { const f32x4* pr = (const f32x4*)(PART + ((size_t)(tl * Sp + (p < Sp ? p : 0)) * 256 + rl) * 1024);
#pragma unroll
                        for (int j = 0; j < 4; ++j) q[p][j] = pr[lane + 64 * j]; }
#pragma unroll
                    for (int p = 0; p < 7; ++p) { const float gp = p < Sp ? gt : 0.f;
#pragma unroll
                        for (int j = 0; j < 4; ++j) { v[j].x += gp * q[p][j].x; v[j].y += gp * q[p][j].y; v[j].z += gp * q[p][j].z; v[j].w += gp * q[p][j].w; } } }
            }
#pragma unroll
            for (int j = 0; j < 4; ++j) s += (v[j].x * v[j].x + v[j].y * v[j].y) + (v[j].z * v[j].z + v[j].w * v[j].w);
            const float r = 1.0f / sqrtf(wave_sum(s) * (1.0f / D) + 1e-6f);
#pragma unroll
            for (int j = 0; j < 4; ++j) { const f32x4 gv = gr[lane + 64 * j]; (dry ? (f32x4*)((float*)(ws + 410 * MiB) + (size_t)m * D) : xr)[lane + 64 * j] = (f32x4){v[j].x * r * gv.x, v[j].y * r * gv.y, v[j].z * r * gv.z, v[j].w * r * gv.w}; }
        }
        }
    } break;
    }
    if (phase == PH_INPROJ || phase == PH_FFNUP || phase == PH_NORM) {
        int t_ = wid_s * 64 + lane_id_asm(); asm volatile("" : "+v"(t_));
        __attribute__((address_space(1))) unsigned char* wsq_ = (__attribute__((address_space(1))) unsigned char*)a.ws; asm volatile("" : "+s"(wsq_)); unsigned char* ws_ = (unsigned char*)wsq_; int G_ = gridDim.x; asm volatile("" : "+s"(G_));
        bg_convert(ws_, lds_raw, IN(21), IN(22), IN(23), step, G_, t_, phase == PH_NORM);
    }
    if (step + 1 < a.ph_hi) { int t_ = wid_s * 64 + lane_id_asm(); asm volatile("" : "+v"(t_)); xcd_barrier(bar, t_ == 0); }
#ifdef REP_STEP
    if (dry) { --rep_left; --step; }
#endif
    }
}

constexpr int NSTEPS = 13;
#ifndef MK_PER_PHASE
#define MK_PER_PHASE 0
#endif

extern "C" void kernel_launch(void* const* d_in, const int* in_sizes, int n_in, void* d_out, int out_size, void* d_ws, size_t ws_size, hipStream_t stream) {
    static int grid = 0;
    if (grid == 0) {
        if (n_in != 25 || out_size != NTOK * D || ws_size < WS_END + 67 * MiB) { fprintf(stderr, "kernel_launch: unexpected shapes (n_in %d out %d ws %zu need %zu)\n", n_in, out_size, ws_size, (size_t)WS_END); grid = -1; return; }
        int dev = 0, cus = 0, per_cu = 0;
        if (hipGetDevice(&dev) != hipSuccess || hipDeviceGetAttribute(&cus, hipDeviceAttributeMultiprocessorCount, dev) != hipSuccess) { grid = -1; return; }
        if (hipFuncSetAttribute((const void*)fwd, hipFuncAttributeMaxDynamicSharedMemorySize, LDS_BYTES) != hipSuccess) { fprintf(stderr, "kernel_launch: hipFuncSetAttribute failed\n"); grid = -1; return; }
        if (hipOccupancyMaxActiveBlocksPerMultiprocessor(&per_cu, (const void*)fwd, NT, LDS_BYTES) != hipSuccess || per_cu < 1) { fprintf(stderr, "kernel_launch: occupancy query says %d blocks/CU\n", per_cu); (void)hipGetLastError(); grid = -1; return; }
        grid = cus;
        if (grid != NCHUNK) { fprintf(stderr, "kernel_launch: built for a %d-CU device (one 64-token chunk per workgroup in the mixer phase); this device has %d\n", NCHUNK, cus); grid = -1; return; }
    }
    if (grid < 0) return;
    hipMemsetAsync((char*)d_ws + WS_CTL, 0, 1 * MiB, stream);
    Args a{};
    for (int i = 0; i < 25; ++i) a.in[i] = (const float*)d_in[i];
    a.out = (float*)d_out; a.ws = (unsigned char*)d_ws;
#if MK_PER_PHASE
    for (int s = 0; s < NSTEPS; ++s) { a.ph_lo = s; a.ph_hi = s + 1; hipLaunchKernelGGL(fwd, dim3(grid), dim3(NT), LDS_BYTES, stream, a); }
#else
    a.ph_lo = 0; a.ph_hi = NSTEPS;
    hipLaunchKernelGGL(fwd, dim3(grid), dim3(NT), LDS_BYTES, stream, a);
#endif
}
```

```cpp
#include <hip/hip_runtime.h>
#include <cstdint>
#include <cstdio>

typedef unsigned short bf16;
typedef short bf16x8 __attribute__((ext_vector_type(8)));
typedef float f32x4 __attribute__((ext_vector_type(4)));
typedef unsigned u32x4 __attribute__((ext_vector_type(4)));
typedef unsigned u32x2 __attribute__((ext_vector_type(2)));

constexpr int NTOK = 16384, SEQ = 8192, D = 1024, DIN = 2560, GW = 256, HD = 64, DFF = 2816, DFFE = 3584, NE = 8;
constexpr int CH = 64, NCHUNK = NTOK / CH, CPB = SEQ / CH;
constexpr int NT = 512;
constexpr float W13_SCALE = 64.f, W2_SCALE = 128.f, HID_SCALE = 8.f;
constexpr int MAXTILES = NTOK * 2 / 256 + NE;

constexpr size_t MiB = 1u << 20;
constexpr size_t WS_CTL = 0;
constexpr size_t WS_SMALL = 1 * MiB;
constexpr size_t WS_WIN = 5 * MiB;
constexpr size_t WS_WOUT = 15 * MiB;
constexpr size_t WS_WGU = 19 * MiB;
constexpr size_t WS_WD = 30 * MiB;
constexpr size_t WS_W13 = 36 * MiB;
constexpr size_t WS_W2 = 92 * MiB;
constexpr size_t WS_ACT = 120 * MiB;
constexpr size_t WS_HN = WS_ACT;
constexpr size_t WS_PROJ = WS_ACT + 32 * MiB;
constexpr size_t WS_Y = WS_ACT + 112 * MiB;
constexpr size_t WS_DS = WS_ACT + 144 * MiB;
constexpr size_t WS_HID = WS_PROJ;
constexpr size_t WS_XR = WS_ACT;
constexpr size_t WS_HIDE = WS_ACT + 34 * MiB;
constexpr size_t WS_OUT2 = WS_ACT + 153 * MiB;
constexpr size_t WS_END = WS_ACT + 217 * MiB;
constexpr size_t SM_TOKE = 0;
constexpr size_t SM_TOKG = 128 * 1024;
constexpr size_t SM_TOKR = 256 * 1024;
constexpr size_t SM_BCNT = 384 * 1024;
constexpr size_t SM_ROWTOK = 400 * 1024;
constexpr size_t SM_ROWDST = 544 * 1024;
constexpr size_t SM_ROWG = 688 * 1024;
constexpr size_t SM_TILEE = 832 * 1024;
constexpr size_t SM_CARA = 1024 * 1024;
constexpr size_t SM_CARH = 1280 * 1024;
constexpr size_t SM_CIN = 1536 * 1024;
constexpr size_t SM_DEC = 1792 * 1024;
constexpr size_t SM_RSTD = 2048 * 1024;
constexpr size_t SM_WTA = 2304 * 1024;
constexpr size_t SM_WTX = 2368 * 1024;
constexpr size_t SM_TOKROW = 2560 * 1024;
constexpr size_t SM_WTP = 2432 * 1024;

struct Args {
    const float* in[25];
    float* out;
    unsigned char* ws;
    int ph_lo, ph_hi, pad0, pad1;
};

__device__ __forceinline__ int lane_id_asm() { int l; asm volatile("v_mbcnt_lo_u32_b32 %0, -1, 0\n\tv_mbcnt_hi_u32_b32 %0, -1, %0" : "=v"(l)); return l; }
typedef const float __attribute__((address_space(1)))* gfptr_t;
__device__ __forceinline__ const float* IN(int k) { asm volatile("" : "+s"(k)); const gfptr_t p = ((const gfptr_t __attribute__((address_space(4)))*)__builtin_amdgcn_kernarg_segment_ptr())[k]; return (const float*)p; }
__device__ __forceinline__ float bf2f(unsigned v) { return __uint_as_float(v << 16); }
__device__ __forceinline__ unsigned f2bf(float f) { unsigned u = __float_as_uint(f); return (u + 0x7fffu + ((u >> 16) & 1u)) >> 16; }
__device__ __forceinline__ unsigned pk2(float lo, float hi) { return f2bf(lo) | (f2bf(hi) << 16); }
__device__ __forceinline__ float fexp(float x) { return __builtin_amdgcn_exp2f(1.44269504089f * x); }
__device__ __forceinline__ float flog(float x) { return 0.69314718056f * __builtin_amdgcn_logf(x); }
__device__ __forceinline__ float sigmoidf_(float x) { return __builtin_amdgcn_rcpf(1.0f + __builtin_amdgcn_exp2f(-1.44269504089f * x)); }
__device__ __forceinline__ float siluf_(float x) { return x * sigmoidf_(x); }
__device__ __forceinline__ float gelu_tanh(float x) { const float u = 1.5957691216057308f * (x + 0.044715f * x * x * x); return x * sigmoidf_(u); }
__device__ __forceinline__ float neg_expm1_small(float x) { return -x * (1.0f + x * (0.5f + x * (0.16666667f + x * (0.041666668f + x * 0.0083333338f)))); }
__device__ __forceinline__ float wave_sum(float v) {
#pragma unroll
    for (int o = 1; o < 64; o <<= 1) v += __shfl_xor(v, o);
    return v;
}
#define LDS_WAIT() asm volatile("s_waitcnt lgkmcnt(0)" ::: "memory")

namespace pg8 {
#define PG8_LAS __attribute__((address_space(3)))
typedef unsigned short bf16_t;
typedef short bf16x8 __attribute__((ext_vector_type(8)));
typedef float f32x4 __attribute__((ext_vector_type(4)));
typedef unsigned u32x4 __attribute__((ext_vector_type(4)));
constexpr int BM = 256, BK = 64, HALF = 128, HTB = HALF * BK * 2  , STAGE_BYTES = 8 * HTB, NXCD = 8;

__host__ __device__ __forceinline__ int lds_byte(int r, int c) { const int st = (r >> 4) * 2 + (c >> 5), rr = r & 15, cc = c & 31, ob = rr * 64 + cc * 2; return st * 1024 + (ob ^ (((ob >> 9) & 1) << 5)); }
__host__ __device__ __forceinline__ void stage_rc(int b, int& R, int& C) { const int st = b / 1024, sb = b % 1024, swz = sb ^ (((sb >> 9) & 1) << 5); R = (st >> 1) * 16 + swz / 64; C = (st & 1) * 32 + (swz % 64) / 2; }
__host__ __device__ __forceinline__ int perm32(int rho) { const int n = rho >> 4, i = rho & 15; return 8 * (i >> 2) + 4 * n + (i & 3); }

struct Unit { int pm, pn, pa, pb, ord, koff; };
struct Gemm { const bf16_t* A; const bf16_t* Bt; int M, N, K; int LD; };

struct StaticOrder {
    int nM, nN, nwg, G, c, WGM;
    __host__ __device__ void init(int M, int N, int G_, int c_, int wgm = 4) { nM = M / BM; nN = N / BM; nwg = nM * nN; G = G_; c = c_; WGM = wgm; }
    __host__ __device__ bool next(int i, Unit& u) const {
        const long L = (long)i * G + c; if (L >= nwg) return false;
        int wgid = (int)L; { const int q = nwg / NXCD, r = nwg % NXCD, xcd = wgid % NXCD, off = wgid / NXCD; wgid = (xcd < r ? xcd * (q + 1) : r * (q + 1) + (xcd - r) * q) + off; }
        const int nig = WGM * nN, gid = wgid / nig, fm = gid * WGM, gsz = (nM - fm) < WGM ? (nM - fm) : WGM;
        u.pm = fm + ((wgid % nig) % gsz); u.pn = (wgid % nig) / gsz; u.pa = u.pm; u.pb = u.pn; u.ord = i; u.koff = 0; return true;
    }
    __device__ __forceinline__ void a_ready(const Unit&) const {}
    __device__ __forceinline__ void done(const Unit&) const {}
};

__device__ __forceinline__ unsigned cvt_pk_bf16(float lo, float hi) { unsigned r; asm volatile("v_cvt_pk_bf16_f32 %0, %1, %2" : "=v"(r) : "v"(lo), "v"(hi)); return r; }
typedef float f32x2 __attribute__((ext_vector_type(2)));
typedef int pg8_v8i __attribute__((ext_vector_type(8))); typedef int pg8_v4i __attribute__((ext_vector_type(4)));
__device__ __forceinline__ pg8_v8i pg8_cat(bf16x8 lo, bf16x8 hi) { return __builtin_shufflevector(__builtin_bit_cast(pg8_v4i, lo), __builtin_bit_cast(pg8_v4i, hi), 0, 1, 2, 3, 4, 5, 6, 7); }
__device__ __forceinline__ void pg8_mfma8(f32x4& acc, pg8_v8i a, pg8_v8i b, int sc) { asm volatile("v_mfma_scale_f32_16x16x128_f8f6f4 %0, %1, %2, %0, %3, %3 op_sel_hi:[0,0,0]" : "+v"(acc) : "v"(a), "v"(b), "v"(sc)); }
template <class Epi, class Sched, bool ALIGN_EPI = false, bool SP2 = false, bool F8 = false>
__device__ __forceinline__ void gemm_phase(PG8_LAS unsigned char* lds, const Gemm g, const Sched& S, const Epi& E, int tid_in) {
    int tid = tid_in; asm volatile("" : "+v"(tid));
    const int wid = __builtin_amdgcn_readfirstlane(tid >> 6), lane = tid & 63, wr = wid >> 2, wc = wid & 3, fr = lane & 15, fq = lane >> 4;
    const int K = g.LD ? g.LD : g.K, nt = g.K / BK;
    unsigned voffA[2], voffB[2];
#pragma unroll
    for (int i = 0; i < 2; ++i) { int R, C; stage_rc(tid * 16 + i * 8192, R, C); const int Rb = Epi::PERM ? ((R & ~31) + perm32(R & 31)) : R;
        voffA[i] = (unsigned)(R * K + C) * 2u; voffB[i] = (unsigned)(Rb * K + C) * 2u; }
    const size_t kstep = (size_t)(BK * 2);
    const size_t hstep = (size_t)HALF * K * 2;
    const size_t tstep = 2 * hstep;
    const unsigned ldsw = (unsigned)wid * 1024u;
    int f8one = 0x7f7f7f7f; asm volatile("" : "+v"(f8one));
    constexpr int KOFF = 1024;
    const int aoff = lds_byte(wr * 64 + fr, fq * 8), boff = lds_byte(wc * 32 + fr, fq * 8);
#define PG8_SA(b, h) (((b) * 2 + (h)) * HTB)
#define PG8_SB(b, h) ((4 + (b) * 2 + (h)) * HTB)
#define PG8_STAGE(bufoff, gbase, voff) do { _Pragma("unroll") for (int _i = 0; _i < 2; ++_i) \
        __builtin_amdgcn_global_load_lds((const unsigned*)((const char*)(gbase) + (voff)[_i]), (PG8_LAS unsigned*)(lds + (bufoff) + ldsw + _i * 8192), 16, 0, 0); } while (0)
#define PG8_LDA(dst, b, h) do { _Pragma("unroll") for (int m = 0; m < 4; ++m) _Pragma("unroll") for (int k = 0; k < 2; ++k) dst[m][k] = *(const PG8_LAS bf16x8*)(lds + PG8_SA(b, h) + aoff + m * 2048 + k * KOFF); } while (0)
#define PG8_LDB(dst, b, h) do { _Pragma("unroll") for (int n = 0; n < 2; ++n) _Pragma("unroll") for (int k = 0; k < 2; ++k) dst[n][k] = *(const PG8_LAS bf16x8*)(lds + PG8_SB(b, h) + boff + n * 2048 + k * KOFF); } while (0)
#define PG8_MMA(ai, bj, At, Bt) do { __builtin_amdgcn_s_setprio(1); if constexpr (F8) { _Pragma("unroll") for (int m = 0; m < 4; ++m) _Pragma("unroll") for (int n = 0; n < 2; ++n) \
        pg8_mfma8(acc[ai][bj][m][n], pg8_cat(Bt[n][0], Bt[n][1]), pg8_cat(At[m][0], At[m][1]), f8one); } \
    else { _Pragma("unroll") for (int m = 0; m < 4; ++m) _Pragma("unroll") for (int n = 0; n < 2; ++n) _Pragma("unroll") for (int k = 0; k < 2; ++k) \
        acc[ai][bj][m][n] = __builtin_amdgcn_mfma_f32_16x16x32_bf16(Bt[n][k], At[m][k], acc[ai][bj][m][n], 0, 0, 0); } __builtin_amdgcn_s_setprio(0); } while (0)
#define PG8_WAIT_V(n) asm volatile("s_waitcnt vmcnt(" #n ")" ::: "memory")
#define PG8_WAIT_L(n) asm volatile("s_waitcnt lgkmcnt(" #n ")" ::: "memory")
#define PG8_BAR __builtin_amdgcn_s_barrier()
#define PG8_SCHED __builtin_amdgcn_sched_barrier(0)
    Unit cur, nxt; int ui = 0;
    if (!S.next(0, cur)) return;
    f32x4 acc[2][2][4][2];
    if constexpr (Epi::ACC_INIT) E.init(acc, cur, wr, wc, fr, fq);
    else {
#pragma unroll
    for (int a = 0; a < 2; ++a)
#pragma unroll
        for (int b = 0; b < 2; ++b)
#pragma unroll
            for (int m = 0; m < 4; ++m)
#pragma unroll
                for (int n = 0; n < 2; ++n) acc[a][b][m][n] = (f32x4){0.f, 0.f, 0.f, 0.f};
    }
    bf16x8 At[4][2], B0[2][2], B1[2][2];
    const char* cA = (const char*)g.A + (size_t)cur.pa * tstep + cur.koff; const char* cB = (const char*)g.Bt + (size_t)cur.pb * tstep + cur.koff;
    S.a_ready(cur);
    if constexpr (SP2) {
        PG8_STAGE(PG8_SB(0, 0), cB, voffB); PG8_STAGE(PG8_SB(0, 1), cB + hstep, voffB); PG8_STAGE(PG8_SA(0, 0), cA, voffA); PG8_STAGE(PG8_SA(0, 1), cA + hstep, voffA);
        if (wr == 1) PG8_BAR;
        PG8_WAIT_V(2); PG8_BAR;
        PG8_STAGE(PG8_SB(1, 0), cB + kstep, voffB); PG8_STAGE(PG8_SA(1, 0), cA + kstep, voffA); PG8_STAGE(PG8_SB(1, 1), cB + hstep + kstep, voffB);
        PG8_WAIT_V(6); PG8_BAR;
    } else {
        PG8_STAGE(PG8_SB(0, 0), cB, voffB); PG8_STAGE(PG8_SA(0, 0), cA, voffA); PG8_STAGE(PG8_SB(0, 1), cB + hstep, voffB); PG8_STAGE(PG8_SA(0, 1), cA + hstep, voffA);
        if (wr == 1) PG8_BAR;
        PG8_WAIT_V(4); PG8_BAR;
        PG8_STAGE(PG8_SB(1, 0), cB + kstep, voffB); PG8_STAGE(PG8_SA(1, 0), cA + kstep, voffA); PG8_STAGE(PG8_SB(1, 1), cB + hstep + kstep, voffB);
        PG8_WAIT_V(6); PG8_BAR;
    }
    for (;;) {
        const bool has_next = S.next(ui + 1, nxt);
        const char* nA = has_next ? (const char*)g.A + (size_t)nxt.pa * tstep + nxt.koff : cA; const char* nB = has_next ? (const char*)g.Bt + (size_t)nxt.pb * tstep + nxt.koff : cB;
        for (int t = 0; t < nt; t += 2) {
            const bool last = (t == nt - 2);
            const char* a1 = cA + (size_t)(t + 1) * kstep;
            const char* a2 = last ? nA : cA + (size_t)(t + 2) * kstep; const char* b2 = last ? nB : cB + (size_t)(t + 2) * kstep;
            const char* a3 = a2 + kstep; const char* b3 = b2 + kstep;
            if (last && has_next) S.a_ready(nxt);
            if constexpr (SP2) {
            PG8_LDB(B0, 0, 0); PG8_LDB(B1, 0, 1); PG8_SCHED; PG8_LDA(At, 0, 0); PG8_STAGE(PG8_SA(1, 1), a1 + hstep, voffA);
            PG8_WAIT_V(8); PG8_WAIT_L(0); PG8_BAR; PG8_MMA(0, 0, At, B0); PG8_MMA(0, 1, At, B1); PG8_BAR; PG8_SCHED;
            PG8_LDA(At, 0, 1); PG8_STAGE(PG8_SB(0, 0), b2, voffB); PG8_STAGE(PG8_SB(0, 1), b2 + hstep, voffB); PG8_STAGE(PG8_SA(0, 0), a2, voffA);
            PG8_WAIT_V(8); PG8_WAIT_L(0); PG8_BAR; PG8_MMA(1, 0, At, B0); PG8_MMA(1, 1, At, B1); PG8_BAR; PG8_SCHED;
            PG8_LDB(B0, 1, 0); PG8_LDB(B1, 1, 1); PG8_SCHED; PG8_LDA(At, 1, 0); PG8_STAGE(PG8_SA(0, 1), a2 + hstep, voffA);
            PG8_WAIT_V(8); PG8_WAIT_L(0); PG8_BAR; PG8_MMA(0, 0, At, B0); PG8_MMA(0, 1, At, B1); PG8_BAR; PG8_SCHED;
            PG8_LDA(At, 1, 1); PG8_STAGE(PG8_SB(1, 0), b3, voffB); PG8_STAGE(PG8_SB(1, 1), b3 + hstep, voffB); PG8_STAGE(PG8_SA(1, 0), a3, voffA);
            PG8_WAIT_V(8); PG8_WAIT_L(0); PG8_BAR; PG8_MMA(1, 0, At, B0); PG8_MMA(1, 1, At, B1); PG8_BAR; PG8_SCHED;
            } else {
            PG8_LDB(B0, 0, 0); PG8_SCHED; PG8_LDA(At, 0, 0); PG8_STAGE(PG8_SA(1, 1), a1 + hstep, voffA);
            PG8_WAIT_L(8); PG8_BAR; PG8_WAIT_L(0); PG8_MMA(0, 0, At, B0); PG8_BAR; PG8_SCHED;
            PG8_LDB(B1, 0, 1); PG8_STAGE(PG8_SB(0, 0), b2, voffB);
            PG8_BAR; PG8_WAIT_L(0); PG8_MMA(0, 1, At, B1); PG8_BAR;
            PG8_LDA(At, 0, 1); PG8_STAGE(PG8_SA(0, 0), a2, voffA);
            PG8_BAR; PG8_WAIT_L(0); PG8_MMA(1, 0, At, B0); PG8_BAR; PG8_SCHED;
            PG8_STAGE(PG8_SB(0, 1), b2 + hstep, voffB);
            PG8_WAIT_V(6); PG8_BAR; PG8_MMA(1, 1, At, B1); PG8_BAR;
            PG8_LDB(B0, 1, 0); PG8_SCHED; PG8_LDA(At, 1, 0); PG8_STAGE(PG8_SA(0, 1), a2 + hstep, voffA);
            PG8_WAIT_L(8); PG8_BAR; PG8_WAIT_L(0); PG8_MMA(0, 0, At, B0); PG8_BAR; PG8_SCHED;
            PG8_LDB(B1, 1, 1); PG8_STAGE(PG8_SB(1, 0), b3, voffB);
            PG8_BAR; PG8_WAIT_L(0); PG8_MMA(0, 1, At, B1); PG8_BAR;
            PG8_LDA(At, 1, 1); PG8_STAGE(PG8_SA(1, 0), a3, voffA);
            PG8_BAR; PG8_WAIT_L(0); PG8_MMA(1, 0, At, B0); PG8_BAR; PG8_SCHED;
            PG8_STAGE(PG8_SB(1, 1), b3 + hstep, voffB);
            PG8_WAIT_V(6); PG8_BAR; PG8_MMA(1, 1, At, B1); PG8_BAR;
            }
        }
        if constexpr (F8) asm volatile("s_nop 15\n\ts_nop 15" ::: "memory");
        if constexpr (ALIGN_EPI) { if (wr == 0) PG8_BAR; }
        if constexpr (!Epi::AFTER_DRAIN) { E(acc, cur, wr, wc, fr, fq); S.done(cur); }
        if (!has_next) break;
#pragma unroll
        for (int a = 0; a < 2; ++a)
#pragma unroll
            for (int b = 0; b < 2; ++b)
#pragma unroll
                for (int m = 0; m < 4; ++m)
#pragma unroll
                    for (int n = 0; n < 2; ++n) acc[a][b][m][n] = (f32x4){0.f, 0.f, 0.f, 0.f};
        cur = nxt; cA = nA; cB = nB; ++ui;
        if constexpr (ALIGN_EPI) { if (wr == 1) PG8_BAR; }
    }
    PG8_WAIT_V(0);
    if constexpr (!ALIGN_EPI) { if (wr == 0) PG8_BAR; }
    PG8_BAR;
    if constexpr (Epi::AFTER_DRAIN) { E.fused(acc, cur, wr, wc, fr, fq, lds, wid, lane); S.done(cur); }
#undef PG8_SA
#undef PG8_SB
#undef PG8_STAGE
#undef PG8_LDA
#undef PG8_LDB
#undef PG8_MMA
#undef PG8_WAIT_V
#undef PG8_WAIT_L
#undef PG8_BAR
#undef PG8_SCHED
}

struct EpiStoreBf16 {
    static constexpr bool PERM = true, AFTER_DRAIN = false, ACC_INIT = false;
    bf16_t* O; int ldc;
    __device__ __forceinline__ void operator()(const f32x4 (&acc)[2][2][4][2], const Unit& u, int wr, int wc, int fr, int fq) const {
        const int row0 = u.pm * BM + wr * 64 + fr, col0 = u.pn * BM + wc * 32 + 8 * fq;
#pragma unroll
        for (int ai = 0; ai < 2; ++ai)
#pragma unroll
            for (int m = 0; m < 4; ++m) { bf16_t* rowp = O + (size_t)(row0 + ai * HALF + m * 16) * ldc + col0;
#pragma unroll
                for (int bj = 0; bj < 2; ++bj) { const f32x4 v0 = acc[ai][bj][m][0], v1 = acc[ai][bj][m][1];
                    u32x4 w; w.x = cvt_pk_bf16(v0[0], v0[1]); w.y = cvt_pk_bf16(v0[2], v0[3]); w.z = cvt_pk_bf16(v1[0], v1[1]); w.w = cvt_pk_bf16(v1[2], v1[3]);
                    *(u32x4*)(rowp + bj * HALF) = w; } }
    }
};
struct EpiResidF32 {
    static constexpr bool PERM = false, AFTER_DRAIN = false, ACC_INIT = true;
    const float* base; float* out;
    __device__ __forceinline__ void init(f32x4 (&acc)[2][2][4][2], const Unit& u, int wr, int wc, int fr, int fq) const {
        const int row0 = u.pm * BM + wr * 64 + fr, col0 = u.pn * BM + wc * 32 + 4 * fq;
#pragma unroll
        for (int ai = 0; ai < 2; ++ai)
#pragma unroll
            for (int m = 0; m < 4; ++m) { const size_t off = (size_t)(row0 + ai * HALF + m * 16) * 1024 + col0;
#pragma unroll
                for (int bj = 0; bj < 2; ++bj)
#pragma unroll
                    for (int n = 0; n < 2; ++n) acc[ai][bj][m][n] = *(const f32x4*)(base + off + bj * HALF + n * 16); }
    }
    __device__ __forceinline__ void operator()(const f32x4 (&acc)[2][2][4][2], const Unit& u, int wr, int wc, int fr, int fq) const {
        const int row0 = u.pm * BM + wr * 64 + fr, col0 = u.pn * BM + wc * 32 + 4 * fq;
#pragma unroll
        for (int ai = 0; ai < 2; ++ai)
#pragma unroll
            for (int m = 0; m < 4; ++m) { const size_t off = (size_t)(row0 + ai * HALF + m * 16) * 1024 + col0;
#pragma unroll
                for (int bj = 0; bj < 2; ++bj)
#pragma unroll
                    for (int n = 0; n < 2; ++n) *(f32x4*)(out + off + bj * HALF + n * 16) = acc[ai][bj][m][n]; }
    }
};
__device__ __forceinline__ float silu_f(float x) { return x * __builtin_amdgcn_rcpf(1.0f + __builtin_amdgcn_exp2f(-1.44269504089f * x)); }
struct EpiSwiglu {
    static constexpr bool PERM = true, AFTER_DRAIN = false, ACC_INIT = false;
    bf16_t* C; int ldc; int row_off;
    __device__ __forceinline__ void operator()(const f32x4 (&acc)[2][2][4][2], const Unit& u, int wr, int wc, int fr, int fq) const {
        const int row0 = u.pm * BM + wr * 64 + fr - row_off, col0 = u.pn * HALF + wc * 32 + 8 * fq;
#pragma unroll
        for (int ai = 0; ai < 2; ++ai)
#pragma unroll
            for (int m = 0; m < 4; ++m) { bf16_t* rowp = C + (size_t)(row0 + ai * HALF + m * 16) * ldc + col0;
                const f32x4 g0 = acc[ai][0][m][0], g1 = acc[ai][0][m][1], u0 = acc[ai][1][m][0], u1 = acc[ai][1][m][1];
                u32x4 w; w.x = cvt_pk_bf16(silu_f(g0[0]) * u0[0], silu_f(g0[1]) * u0[1]); w.y = cvt_pk_bf16(silu_f(g0[2]) * u0[2], silu_f(g0[3]) * u0[3]);
                w.z = cvt_pk_bf16(silu_f(g1[0]) * u1[0], silu_f(g1[1]) * u1[1]); w.w = cvt_pk_bf16(silu_f(g1[2]) * u1[2], silu_f(g1[3]) * u1[3]);
                *(u32x4*)rowp = w; }
    }
};
struct EpiMoeDown {
    static constexpr bool PERM = true, AFTER_DRAIN = false, ACC_INIT = false;
    bf16_t* out2; const int* rowdst; const float* rowg; float sc;
    __device__ __forceinline__ void operator()(const f32x4 (&acc)[2][2][4][2], const Unit& u, int wr, int wc, int fr, int fq) const {
        const int row0 = u.pm * BM + wr * 64 + fr, col0 = u.pn * BM + wc * 32 + 8 * fq;
#pragma unroll
        for (int ai = 0; ai < 2; ++ai)
#pragma unroll
            for (int m = 0; m < 4; ++m) { const int gr = row0 + ai * HALF + m * 16; const int d = rowdst[gr]; const float g = rowg[gr] * sc;
                if (d >= 0) { bf16_t* rowp = out2 + (size_t)d * 1024 + col0;
#pragma unroll
                    for (int bj = 0; bj < 2; ++bj) { const f32x4 v0 = acc[ai][bj][m][0] * g, v1 = acc[ai][bj][m][1] * g;
                        u32x4 w; w.x = cvt_pk_bf16(v0[0], v0[1]); w.y = cvt_pk_bf16(v0[2], v0[3]); w.z = cvt_pk_bf16(v1[0], v1[1]); w.w = cvt_pk_bf16(v1[2], v1[3]);
                        *(u32x4*)(rowp + bj * HALF) = w; } } }
    }
};


struct EpiResidStats {
    static constexpr bool PERM = false, AFTER_DRAIN = false, ACC_INIT = true;
    const float* base; float* out; bf16_t* hn; float* ssp;
    __device__ __forceinline__ void init(f32x4 (&acc)[2][2][4][2], const Unit& u, int wr, int wc, int fr, int fq) const {
        const int row0 = u.pm * BM + wr * 64 + fr, col0 = u.pn * BM + wc * 32 + 4 * fq;
#pragma unroll
        for (int ai = 0; ai < 2; ++ai)
#pragma unroll
            for (int m = 0; m < 4; ++m) { const size_t off = (size_t)(row0 + ai * HALF + m * 16) * 1024 + col0;
#pragma unroll
                for (int bj = 0; bj < 2; ++bj)
#pragma unroll
                    for (int n = 0; n < 2; ++n) acc[ai][bj][m][n] = *(const f32x4*)(base + off + bj * HALF + n * 16); }
    }
    __device__ __forceinline__ void operator()(const f32x4 (&acc)[2][2][4][2], const Unit& u, int wr, int wc, int fr, int fq) const {
        const int row0 = u.pm * BM + wr * 64 + fr, col0 = u.pn * BM + wc * 32 + 4 * fq; typedef unsigned u32x2e __attribute__((ext_vector_type(2)));
#pragma unroll
        for (int ai = 0; ai < 2; ++ai)
#pragma unroll
            for (int m = 0; m < 4; ++m) { const int row = row0 + ai * HALF + m * 16; const size_t off = (size_t)row * 1024 + col0; float ss = 0.f;
#pragma unroll
                for (int bj = 0; bj < 2; ++bj)
#pragma unroll
                    for (int n = 0; n < 2; ++n) { const f32x4 v = acc[ai][bj][m][n]; *(f32x4*)(out + off + bj * HALF + n * 16) = v;
                        ss += (v[0] * v[0] + v[1] * v[1]) + (v[2] * v[2] + v[3] * v[3]); u32x2e w; w.x = cvt_pk_bf16(v[0], v[1]); w.y = cvt_pk_bf16(v[2], v[3]); *(u32x2e*)(hn + off + bj * HALF + n * 16) = w; }
                ss += __shfl_xor(ss, 16); ss += __shfl_xor(ss, 32);
                if (fq == 0) ssp[(size_t)row * 16 + u.pn * 4 + wc] = ss; }
    }
};
constexpr int RSTD_TAB_OFF = STAGE_BYTES;
template <class Sched> __device__ __forceinline__ void fill_rstd_table(PG8_LAS unsigned char* lds, const Sched& S, const float* ssp, int tid) {
    PG8_LAS float* tab = (PG8_LAS float*)(lds + RSTD_TAB_OFF); Unit u;
    for (int i = 0; S.next(i, u); ++i)
        if (tid < 256) { const int row = u.pm * BM + tid; const f32x4* p = (const f32x4*)(ssp + (size_t)row * 16); const f32x4 a = p[0], b = p[1], c = p[2], d = p[3];
            const float s = (((a[0] + a[1]) + (a[2] + a[3])) + ((b[0] + b[1]) + (b[2] + b[3]))) + (((c[0] + c[1]) + (c[2] + c[3])) + ((d[0] + d[1]) + (d[2] + d[3])));
            tab[i * 256 + tid] = 1.0f / sqrtf(s * (1.0f / 1024.0f) + 1e-6f); }
    __syncthreads();
}
struct EpiStoreBf16R {
    static constexpr bool PERM = true, AFTER_DRAIN = false, ACC_INIT = false;
    bf16_t* O; int ldc; const PG8_LAS float* tab;
    __device__ __forceinline__ void operator()(const f32x4 (&acc)[2][2][4][2], const Unit& u, int wr, int wc, int fr, int fq) const {
        const int row0 = u.pm * BM + wr * 64 + fr, col0 = u.pn * BM + wc * 32 + 8 * fq;
#pragma unroll
        for (int ai = 0; ai < 2; ++ai)
#pragma unroll
            for (int m = 0; m < 4; ++m) { const int row = row0 + ai * HALF + m * 16; const float r = tab[u.ord * 256 + wr * 64 + fr + ai * HALF + m * 16]; bf16_t* rowp = O + (size_t)row * ldc + col0;
#pragma unroll
                for (int bj = 0; bj < 2; ++bj) { const f32x4 v0 = acc[ai][bj][m][0] * r, v1 = acc[ai][bj][m][1] * r;
                    u32x4 w; w.x = cvt_pk_bf16(v0[0], v0[1]); w.y = cvt_pk_bf16(v0[2], v0[3]); w.z = cvt_pk_bf16(v1[0], v1[1]); w.w = cvt_pk_bf16(v1[2], v1[3]);
                    *(u32x4*)(rowp + bj * HALF) = w; } }
    }
};
struct EpiSwigluR {
    static constexpr bool PERM = true, AFTER_DRAIN = false, ACC_INIT = false;
    bf16_t* C; int ldc; const PG8_LAS float* tab;
    __device__ __forceinline__ void operator()(const f32x4 (&acc)[2][2][4][2], const Unit& u, int wr, int wc, int fr, int fq) const {
        const int row0 = u.pm * BM + wr * 64 + fr, col0 = u.pn * HALF + wc * 32 + 8 * fq;
#pragma unroll
        for (int ai = 0; ai < 2; ++ai)
#pragma unroll
            for (int m = 0; m < 4; ++m) { const int row = row0 + ai * HALF + m * 16; const float r = tab[u.ord * 256 + wr * 64 + fr + ai * HALF + m * 16]; bf16_t* rowp = C + (size_t)row * ldc + col0;
                const f32x4 g0 = acc[ai][0][m][0] * r, g1 = acc[ai][0][m][1] * r, u0 = acc[ai][1][m][0] * r, u1 = acc[ai][1][m][1] * r;
                u32x4 w; w.x = cvt_pk_bf16(silu_f(g0[0]) * u0[0], silu_f(g0[1]) * u0[1]); w.y = cvt_pk_bf16(silu_f(g0[2]) * u0[2], silu_f(g0[3]) * u0[3]);
                w.z = cvt_pk_bf16(silu_f(g1[0]) * u1[0], silu_f(g1[1]) * u1[1]); w.w = cvt_pk_bf16(silu_f(g1[2]) * u1[2], silu_f(g1[3]) * u1[3]);
                *(u32x4*)rowp = w; }
    }
};
__device__ __forceinline__ unsigned pk4_fp8(float a, float b, float c, float d) { int w = __builtin_amdgcn_cvt_pk_fp8_f32(a, b, 0, false); w = __builtin_amdgcn_cvt_pk_fp8_f32(c, d, w, true); return (unsigned)w; }
struct EpiSwiglu8 {
    static constexpr bool PERM = true, AFTER_DRAIN = false, ACC_INIT = false;
    unsigned char* C; int ldc; float isc, osc;
    __device__ __forceinline__ void operator()(const f32x4 (&acc)[2][2][4][2], const Unit& u, int wr, int wc, int fr, int fq) const {
        const int row0 = u.pm * BM + wr * 64 + fr, col0 = u.pn * HALF + wc * 32 + 8 * fq; const float us = isc * osc;
#pragma unroll
        for (int ai = 0; ai < 2; ++ai)
#pragma unroll
            for (int m = 0; m < 4; ++m) { unsigned char* rowp = C + (size_t)(row0 + ai * HALF + m * 16) * ldc + col0;
                const f32x4 g0 = acc[ai][0][m][0] * isc, g1 = acc[ai][0][m][1] * isc, u0 = acc[ai][1][m][0] * us, u1 = acc[ai][1][m][1] * us;
                typedef unsigned u32x2e __attribute__((ext_vector_type(2))); u32x2e w;
                w.x = pk4_fp8(silu_f(g0[0]) * u0[0], silu_f(g0[1]) * u0[1], silu_f(g0[2]) * u0[2], silu_f(g0[3]) * u0[3]);
                w.y = pk4_fp8(silu_f(g1[0]) * u1[0], silu_f(g1[1]) * u1[1], silu_f(g1[2]) * u1[2], silu_f(g1[3]) * u1[3]);
                *(u32x2e*)rowp = w; }
    }
};
struct MoeOrder {
    StaticOrder so; int tlo, nN, a_off; const int* tilee;
    __device__ void init(int nrt, int nN_, int G, int c, int tlo_, int a_off_, const int* tilee_, int wgm = 4) { so.init(nrt * BM, nN_ * BM, G, c, wgm); tlo = tlo_; nN = nN_; a_off = a_off_; tilee = tilee_; }
    __device__ bool next(int i, Unit& u) const { if (!so.next(i, u)) return false; u.pm += tlo; u.pa = u.pm - a_off; const int e = __builtin_amdgcn_readfirstlane(__hip_atomic_load(tilee + u.pm, __ATOMIC_RELAXED, __HIP_MEMORY_SCOPE_AGENT)); u.pb = e * nN + u.pn; return true; }
    __device__ __forceinline__ void a_ready(const Unit&) const {}
    __device__ __forceinline__ void done(const Unit&) const {}
};

struct MoeTailOrder {
    int t0, ntail, nN, S, G, c, kbytes; const int* tilee;
    __device__ bool next(int i, Unit& u) const {
        const int L = i * G + c; if (L >= ntail * nN * S) return false;
        const int piece = L % S, q = L / S, pn = q % nN, tl = q / nN;
        u.pm = t0 + tl; u.pn = pn; u.pa = u.pm; const int e = __builtin_amdgcn_readfirstlane(__hip_atomic_load(tilee + u.pm, __ATOMIC_RELAXED, __HIP_MEMORY_SCOPE_AGENT));
        u.pb = e * nN + pn; u.ord = tl * S + piece; u.koff = piece * kbytes; return true; }
    __device__ __forceinline__ void a_ready(const Unit&) const {}
    __device__ __forceinline__ void done(const Unit&) const {}
};
struct EpiPartF32 {
    static constexpr bool PERM = false, AFTER_DRAIN = false, ACC_INIT = false;
    float* part;
    __device__ __forceinline__ void operator()(const f32x4 (&acc)[2][2][4][2], const Unit& u, int wr, int wc, int fr, int fq) const {
        const int row0 = wr * 64 + fr, col0 = u.pn * BM + wc * 32 + 4 * fq; float* base = part + (size_t)u.ord * 256 * 1024;
#pragma unroll
        for (int ai = 0; ai < 2; ++ai)
#pragma unroll
            for (int m = 0; m < 4; ++m) { const size_t off = (size_t)(row0 + ai * HALF + m * 16) * 1024 + col0;
#pragma unroll
                for (int bj = 0; bj < 2; ++bj)
#pragma unroll
                    for (int n = 0; n < 2; ++n) *(f32x4*)(base + off + bj * HALF + n * 16) = acc[ai][bj][m][n]; }
    }
};
}

__device__ __forceinline__ void cvt_item(const float* W, int K, int N, bf16* WT, int mode, int item, float* scr, int lane, const float* gk = nullptr) {
    const int nblk = N / 32, kb = item / nblk, nb = item % nblk, k0 = 64 * kb, n0 = 32 * nb;
    { f32x4 v[8]; const float* src = W + (size_t)(k0 + (lane >> 3)) * N + n0 + 4 * (lane & 7);
#pragma unroll
      for (int i = 0; i < 8; ++i) v[i] = __builtin_nontemporal_load((const f32x4*)(src + (size_t)(8 * i) * N));
#pragma unroll
      for (int i = 0; i < 8; ++i) { float* d = scr + (8 * i + (lane >> 3)) * 33 + 4 * (lane & 7); const float gg = gk ? gk[k0 + 8 * i + (lane >> 3)] : 1.0f; d[0] = v[i].x * gg; d[1] = v[i].y * gg; d[2] = v[i].z * gg; d[3] = v[i].w * gg; } }
    LDS_WAIT();
    const int c = lane & 7;
#pragma unroll
    for (int j = 0; j < 4; ++j) {
        const int n = (lane >> 3) + 8 * j; const float* s = scr + (8 * c) * 33 + n;
        u32x4 o; o.x = pk2(s[0 * 33], s[1 * 33]); o.y = pk2(s[2 * 33], s[3 * 33]); o.z = pk2(s[4 * 33], s[5 * 33]); o.w = pk2(s[6 * 33], s[7 * 33]);
        const int nn = n0 + n; const int drow = mode == 0 ? nn : ((nn >> 7) * 256 + (nn & 127) + (mode == 2 ? 128 : 0));
        *(u32x4*)(WT + (size_t)drow * K + k0 + 8 * c) = o;
    }
    LDS_WAIT();
}

__device__ __forceinline__ void cvt_item8(const float* W, int K, int N, unsigned char* WT, int mode, int item, float* scr, int lane, float scale) {
    const int nblk = N / 32, kb = item / nblk, nb = item % nblk, k0 = 128 * kb, n0 = 32 * nb;
    { f32x4 v[16]; const float* src = W + (size_t)(k0 + (lane >> 3)) * N + n0 + 4 * (lane & 7);
#pragma unroll
      for (int i = 0; i < 16; ++i) v[i] = __builtin_nontemporal_load((const f32x4*)(src + (size_t)(8 * i) * N));
#pragma unroll
      for (int i = 0; i < 16; ++i) { float* d = scr + (8 * i + (lane >> 3)) * 33 + 4 * (lane & 7); d[0] = v[i].x * scale; d[1] = v[i].y * scale; d[2] = v[i].z * scale; d[3] = v[i].w * scale; } }
    LDS_WAIT();
    const int c = lane & 7;
#pragma unroll
    for (int j = 0; j < 4; ++j) {
        const int n = (lane >> 3) + 8 * j; const float* s = scr + (16 * c) * 33 + n;
        u32x4 o; o.x = pg8::pk4_fp8(s[0 * 33], s[1 * 33], s[2 * 33], s[3 * 33]); o.y = pg8::pk4_fp8(s[4 * 33], s[5 * 33], s[6 * 33], s[7 * 33]);
        o.z = pg8::pk4_fp8(s[8 * 33], s[9 * 33], s[10 * 33], s[11 * 33]); o.w = pg8::pk4_fp8(s[12 * 33], s[13 * 33], s[14 * 33], s[15 * 33]);
        const int nn = n0 + n; const int drow = mode == 0 ? nn : ((nn >> 7) * 256 + (nn & 127) + (mode == 2 ? 128 : 0));
        __builtin_nontemporal_store(o, (u32x4*)(WT + (size_t)drow * K + k0 + 16 * c));
    }
    LDS_WAIT();
}

__device__ __forceinline__ void rms_row_bf16(const float* xrow, const float* g, bf16* orow, int lane) {
    const f32x4* xr = (const f32x4*)xrow; const f32x4* gr = (const f32x4*)g;
    f32x4 v[4]; float s = 0.f;
#pragma unroll
    for (int j = 0; j < 4; ++j) { v[j] = xr[lane + 64 * j]; s += (v[j].x * v[j].x + v[j].y * v[j].y) + (v[j].z * v[j].z + v[j].w * v[j].w); }
    const float r = 1.0f / sqrtf(wave_sum(s) * (1.0f / D) + 1e-6f);
    u32x2* o8 = (u32x2*)orow;
#pragma unroll
    for (int j = 0; j < 4; ++j) { const f32x4 gv = gr[lane + 64 * j]; u32x2 w; w.x = pk2(v[j].x * r * gv.x, v[j].y * r * gv.y); w.y = pk2(v[j].z * r * gv.z, v[j].w * r * gv.w); o8[lane + 64 * j] = w; }
}

#define LAS __attribute__((address_space(3)))
#define XB_TMO      128
#define XB_XCNT(j)  (256  + 64 * (j))
#define XB_XSUB(j)  (1280 + 64 * (j))
#define XB_XGEN(j)  (2304 + 64 * (j))
#define XB_TOP      3328
#define XB_TOPGEN   3392
#define XCD_BAR_WORDS 3456
#define XB_SPIN_CAP (1u << 22)
__device__ __forceinline__ unsigned xb_ld(unsigned* p)              { return __hip_atomic_load(p, __ATOMIC_RELAXED, __HIP_MEMORY_SCOPE_AGENT); }
__device__ __forceinline__ unsigned xb_add(unsigned* p, unsigned v) { return __hip_atomic_fetch_add(p, v, __ATOMIC_RELAXED, __HIP_MEMORY_SCOPE_AGENT); }
__device__ __forceinline__ unsigned xb_xcc_id() { return (unsigned)__builtin_amdgcn_s_getreg((3 << 11) | 20) & 0xFu; }
#define XB_SPIN(cond, bar) do { unsigned _sp = 0; while (cond) { __builtin_amdgcn_s_sleep(1); \
    if ((++_sp & 255u) == 0u) { if (xb_ld(&(bar)[XB_TMO])) break; if (_sp > XB_SPIN_CAP) { atomicAdd(&(bar)[XB_TMO], 1u); break; } } } } while (0)
struct XcdBarrier { unsigned* bar; unsigned x; volatile LAS unsigned* st; };
__device__ __forceinline__ XcdBarrier xcd_barrier_post(unsigned* bar, volatile LAS unsigned* st) {
    XcdBarrier b; b.bar = bar; b.x = xb_xcc_id(); b.st = st;
    if (threadIdx.x == 0) (void)xb_add(&bar[XB_XCNT(b.x)], 1u);
    return b;
}
__device__ __forceinline__ void xcd_barrier_complete(unsigned* bar, unsigned x, unsigned& nloc, unsigned& nx) {
    const unsigned G = gridDim.x * gridDim.y * gridDim.z;
    unsigned sum, cnt, mine, sp = 0u;
    for (;;) {
        sum = 0u; cnt = 0u; mine = 0u;
#pragma unroll
        for (unsigned j = 0; j < 16; ++j) { const unsigned c = xb_ld(&bar[XB_XCNT(j)]); sum += c; cnt += (c > 0u) ? 1u : 0u; mine = (j == x) ? c : mine; }
        if (sum == G) break;
        __builtin_amdgcn_s_sleep(1);
        if ((++sp & 255u) == 0u) { if (xb_ld(&bar[XB_TMO])) break; if (sp > XB_SPIN_CAP) { atomicAdd(&bar[XB_TMO], 1u); break; } }
    }
    nloc = mine > 0u ? mine : 1u; nx = cnt > 0u ? cnt : 1u;
}
__device__ __forceinline__ void xcd_arrive(const XcdBarrier& b, bool leader) {
    asm volatile("s_waitcnt vmcnt(0)" ::: "memory");
    __syncthreads();
    if (leader) {
        unsigned* bar = b.bar;
        __builtin_amdgcn_s_waitcnt(0);
        unsigned nloc = b.st[0], nx = b.st[1];
        if (nloc == 0u) { xcd_barrier_complete(bar, b.x, nloc, nx); b.st[0] = nloc; b.st[1] = nx; }
        const unsigned old = xb_add(&bar[XB_XSUB(b.x)], 1u);
        const unsigned gen = old / nloc;
        b.st[2] = gen; b.st[3] = 0u;
        if (old + 1u == (gen + 1u) * nloc) {
            __builtin_amdgcn_fence(__ATOMIC_RELEASE, "agent");
            asm volatile("s_waitcnt vmcnt(0)" ::: "memory");
            const unsigned og = xb_add(&bar[XB_TOP], 1u);
            const unsigned tg = og / nx;
            b.st[4] = tg; b.st[3] = 1u;
            if (og + 1u == (tg + 1u) * nx) { xb_add(&bar[XB_TOPGEN], 1u); b.st[3] = 2u; }
        }
    }
}
__device__ __forceinline__ void xcd_wait(const XcdBarrier& b, bool leader) {
    if (leader) {
        unsigned* bar = b.bar; const unsigned gen = b.st[2], role = b.st[3], tg = b.st[4];
        if (role >= 1u) {
            if (role == 1u) XB_SPIN(xb_ld(&bar[XB_TOPGEN]) == tg, bar);
            __builtin_amdgcn_fence(__ATOMIC_ACQUIRE, "agent");
            xb_add(&bar[XB_XGEN(b.x)], 1u);
            asm volatile("s_waitcnt vmcnt(0)" ::: "memory");
        } else {
            XB_SPIN(xb_ld(&bar[XB_XGEN(b.x)]) == gen, bar);
            __builtin_amdgcn_fence(__ATOMIC_ACQUIRE, "agent");
            asm volatile("s_waitcnt vmcnt(0)" ::: "memory");
        }
    }
    __syncthreads();
}
__device__ __forceinline__ void xcd_barrier(const XcdBarrier& b, bool leader) { xcd_arrive(b, leader); xcd_wait(b, leader); }
constexpr int LDS_BYTES = 163840, RING_BYTES = LDS_BYTES - 512, MISC_OFF = RING_BYTES + 320;
constexpr int CW_BAR = 4096;

enum Phase { PH_PROLOGUE = 0, PH_INPROJ, PH_MIX1, PH_MIX2, PH_MIX3, PH_OUTPROJ, PH_NORM, PH_FFNUP, PH_FFNDOWN, PH_DISPATCH, PH_MOEUP, PH_MOEDOWN, PH_FINAL };


constexpr int PQ_OFF = 97792;
constexpr int RS = 528;
constexpr int AINB_STRIDE = RS;
constexpr int VTS = 144;
template <int NLD> __device__ __forceinline__ void slab_load(u32x4 (&reg)[NLD], const bf16* src, int nrows, int rvalid0, int tid) {
#pragma unroll
    for (int j = 0; j < NLD; ++j) { const int i = tid + j * NT, r = i >> 5, ch = i & 31; reg[j] = (u32x4){0u, 0u, 0u, 0u}; if (i < nrows * 32 && r >= rvalid0) reg[j] = *(const u32x4*)(src + (ptrdiff_t)r * DIN + ch * 8); }
}
template <int NLD> __device__ __forceinline__ void slab_store(const u32x4 (&reg)[NLD], unsigned char* dst, int nrows, int tid) {
#pragma unroll
    for (int j = 0; j < NLD; ++j) { const int i = tid + j * NT, r = i >> 5, ch = i & 31; if (i < nrows * 32) *(u32x4*)(dst + r * RS + ch * 16) = reg[j]; }
}
__device__ __forceinline__ void ytile_store(const unsigned char* src, bf16* y, int tid) {
    asm volatile("" : "+v"(tid) :: "memory");
#pragma unroll
    for (int j = 0; j < 4; ++j) { const int i = tid + j * NT, r = i >> 5, ch = i & 31; *(u32x4*)(y + (size_t)r * D + ch * 8) = *(const u32x4*)(src + r * RS + ch * 16); }
}
__device__ __forceinline__ int vt_off(int c, int tok) { return c * VTS + ((tok ^ (((c >> 3) & 7) << 3)) << 1); }
__device__ __forceinline__ void vt_store(const u32x4 (&reg)[4], unsigned char* vt, int tid) {
#pragma unroll
    for (int j = 0; j < 4; ++j) { const int i = tid + j * NT, r = i >> 5, ch = i & 31, c0 = ch * 8; const unsigned w[4] = {reg[j].x, reg[j].y, reg[j].z, reg[j].w};
#pragma unroll
        for (int q = 0; q < 8; ++q) *(bf16*)(vt + vt_off(c0 + q, r)) = (bf16)((q & 1) ? (w[q >> 1] >> 16) : (w[q >> 1] & 0xffffu)); }
}
struct LruParams { bf16x8 wa[2], wx[2]; float lam, ba, bx, cb, cw[4]; };
__device__ __forceinline__ void lru_params_load(LruParams& p, const bf16* wta, const bf16* wtx, const float* conv_w, const float* conv_b, const float* b_a, const float* b_x, const float* lam, int h, int nt, int lane) {
    asm volatile("" : "+v"(lane));
    const int fr = lane & 15, fq = lane >> 4, c = 64 * h + 16 * nt + fr;
#pragma unroll
    for (int ks = 0; ks < 2; ++ks) { p.wa[ks] = *(const bf16x8*)(wta + (size_t)(h * 64 + 16 * nt + fr) * 64 + 32 * ks + 8 * fq); p.wx[ks] = *(const bf16x8*)(wtx + (size_t)(h * 64 + 16 * nt + fr) * 64 + 32 * ks + 8 * fq); }
    p.lam = lam[c]; p.ba = b_a[c]; p.bx = b_x[c]; p.cb = conv_b[c];
#pragma unroll
    for (int k = 0; k < 4; ++k) p.cw[k] = conv_w[k * GW + c];
}
__device__ __forceinline__ void lru_ainb(const unsigned char* ax, const float* conv_w, const float* conv_b, unsigned char* ainb, int tid) {
    for (int idx = tid; idx < CH * 128; idx += NT) {
        const int t = idx >> 7, c = (idx & 127) * 2; float a0 = conv_b[c], a1 = conv_b[c + 1];
#pragma unroll
        for (int k = 0; k < 4; ++k) { const unsigned w = *(const unsigned*)(ax + (t + k) * RS + c * 2); a0 += conv_w[k * GW + c] * bf2f(w & 0xffffu); a1 += conv_w[k * GW + c + 1] * bf2f(w >> 16); }
        *(unsigned*)(ainb + t * RS + c * 2) = pk2(a0, a1);
    }
}
__device__ __forceinline__ void lru_gates(const unsigned char* ainb, const unsigned char* ax, const LruParams& p, int h, int nt, int lane, float (&av)[4][4], float (&uv)[4][4]) {
    const int fr = lane & 15, fq = lane >> 4, c = 64 * h + 16 * nt + fr;
    f32x4 aa[4], ax4[4];
#pragma unroll
    for (int mt = 0; mt < 4; ++mt) { aa[mt] = (f32x4){0.f, 0.f, 0.f, 0.f}; ax4[mt] = (f32x4){0.f, 0.f, 0.f, 0.f};
#pragma unroll
        for (int ks = 0; ks < 2; ++ks) { const bf16x8 x = *(const bf16x8*)(ainb + (16 * mt + fr) * RS + (64 * h + 32 * ks + 8 * fq) * 2);
            aa[mt] = __builtin_amdgcn_mfma_f32_16x16x32_bf16(x, p.wa[ks], aa[mt], 0, 0, 0); ax4[mt] = __builtin_amdgcn_mfma_f32_16x16x32_bf16(x, p.wx[ks], ax4[mt], 0, 0, 0); } }
    const float sp = log1pf(fexp(-p.lam));
#pragma unroll
    for (int mt = 0; mt < 4; ++mt)
#pragma unroll
        for (int r = 0; r < 4; ++r) { const int t = 16 * mt + 4 * fq + r; const float rg = sigmoidf_(aa[mt][r] + p.ba), ig = sigmoidf_(ax4[mt][r] + p.bx); const float loga = -8.0f * rg * sp;
            const float x2 = 2.0f * loga; const float m2 = x2 > -0.25f ? neg_expm1_small(x2) : -expm1f(x2);
            float xin = p.cb;
#pragma unroll
            for (int k = 0; k < 4; ++k) xin += p.cw[k] * bf2f(*(const bf16*)(ax + (t + k) * RS + c * 2));
            av[mt][r] = fexp(loga); uv[mt][r] = __builtin_amdgcn_sqrtf(fmaxf(m2, 0.f)) * ig * xin; }
}

constexpr int CW_CVTQ = 2048, CW_DONE = 8192;
constexpr int BG_IE1 = 8 * 112, BG_IE2 = 28 * 32, BG_ITEMS = 2 * NE * BG_IE1 + NE * BG_IE2, BG_BATCHES = BG_ITEMS / 8;
__device__ __forceinline__ void bg_convert(unsigned char* ws, unsigned char* lds_raw, const float* w1, const float* w3, const float* w2, int step, int G, int tid, bool drain) {
    unsigned* ctl = (unsigned*)(ws + WS_CTL); volatile unsigned* shq = (volatile unsigned*)(lds_raw + RING_BYTES);
    const int wid = tid >> 6, lane = tid & 63; float* scr = (float*)lds_raw + wid * (128 * 33);
    __syncthreads();
    if (tid == 0 && !drain) __hip_atomic_fetch_add(ctl + CW_DONE + 64 * step, 1u, __ATOMIC_RELAXED, __HIP_MEMORY_SCOPE_AGENT);
    for (;;) {
        if (tid == 0) { unsigned b = BG_BATCHES;
            if (drain || __hip_atomic_load(ctl + CW_DONE + 64 * step, __ATOMIC_RELAXED, __HIP_MEMORY_SCOPE_AGENT) + 16u < (unsigned)G) b = __hip_atomic_fetch_add(ctl + CW_CVTQ, 1u, __ATOMIC_RELAXED, __HIP_MEMORY_SCOPE_AGENT);
            shq[0] = b; }
        __syncthreads();
        const unsigned b = shq[0];
        __syncthreads();
        if (b >= (unsigned)BG_BATCHES) break;
        const int q = (int)b * 8 + wid;
        if (q < NE * BG_IE1) { const int e = q / BG_IE1, r = q % BG_IE1; cvt_item8(w1 + (size_t)e * D * DFFE, D, DFFE, ws + WS_W13 + (size_t)e * 2 * DFFE * D, 1, r, scr, lane, W13_SCALE); }
        else if (q < 2 * NE * BG_IE1) { const int q2 = q - NE * BG_IE1, e = q2 / BG_IE1, r = q2 % BG_IE1; cvt_item8(w3 + (size_t)e * D * DFFE, D, DFFE, ws + WS_W13 + (size_t)e * 2 * DFFE * D, 2, r, scr, lane, W13_SCALE); }
        else { const int q2 = q - 2 * NE * BG_IE1, e = q2 / BG_IE2, r = q2 % BG_IE2; cvt_item8(w2 + (size_t)e * DFFE * D, DFFE, D, ws + WS_W2 + (size_t)e * D * DFFE, 0, r, scr, lane, W2_SCALE); }
    }
}

__host__ __device__ __forceinline__ int moe_tail_split(int ntail) { return ntail * 4 * 7 <= 256 ? 7 : (ntail * 4 * 2 <= 256 ? 2 : 1); }

#define HN ((bf16*)(ws + WS_HN))
#define PROJ ((bf16*)(ws + WS_PROJ))
#define Y ((bf16*)(ws + WS_Y))
#define DS ((float*)(ws + WS_DS))
#define HID ((bf16*)(ws + WS_HID))
#define HIDE ((unsigned char*)(ws + WS_HIDE))
#define OUT2 ((bf16*)(ws + WS_OUT2))
#define XR ((unsigned char*)(ws + WS_XR))
#define SSP0 ((float*)(ws + WS_END))
#define SSP1 ((float*)(ws + WS_END + MiB))
#define PART ((float*)(ws + WS_END + 3 * MiB))
#define TOKROW SMALLP(int, SM_TOKROW)
#define SMALLP(T, off) ((T*)(ws + WS_SMALL + (off)))
#define RSTD SMALLP(float, SM_RSTD)
#define TOKE SMALLP(int, SM_TOKE)
#define TOKG SMALLP(float, SM_TOKG)
#define TOKR SMALLP(int, SM_TOKR)
#define BCNT SMALLP(int, SM_BCNT)
#define ROWDST SMALLP(int, SM_ROWDST)
#define ROWG SMALLP(float, SM_ROWG)
#define TILEE SMALLP(int, SM_TILEE)
#define CARA SMALLP(float, SM_CARA)
#define CARH SMALLP(float, SM_CARH)
#define CIN SMALLP(float, SM_CIN)
#define DEC SMALLP(float, SM_DEC)
#define WTA SMALLP(bf16, SM_WTA)
#define WTX SMALLP(bf16, SM_WTX)
#define WTP SMALLP(bf16, SM_WTP)
#define PHASE_ENTER int tid = wid_s * 64 + lane_id_asm(); asm volatile("" : "+v"(tid)); const int lane = tid & 63, wid = tid >> 6; __attribute__((address_space(1))) unsigned char* wsg_ = (__attribute__((address_space(1))) unsigned char*)a.ws; asm volatile("" : "+s"(wsg_)); unsigned char* ws = (unsigned char*)wsg_; \
    __attribute__((address_space(1))) float* hresg_ = (__attribute__((address_space(1))) float*)a.out; asm volatile("" : "+s"(hresg_)); float* hres = (float*)hresg_; \
    int bid = blockIdx.x; asm volatile("" : "+s"(bid)); int G = gridDim.x; asm volatile("" : "+s"(G)); (void)lane; (void)wid; (void)hres; (void)bid; (void)G;

__global__ void __launch_bounds__(NT) fwd(Args a) {
    extern __shared__ __attribute__((aligned(16))) unsigned char lds_raw[];
    float* ldsf = (float*)lds_raw;
    const int wid_s = __builtin_amdgcn_readfirstlane(threadIdx.x >> 6);
    { const int tid0 = threadIdx.x; for (int u = tid0; u < (LDS_BYTES - RING_BYTES) / 4; u += NT) ((LAS unsigned*)((LAS unsigned char*)lds_raw + RING_BYTES))[u] = 0u; }
    __syncthreads();
    XcdBarrier bar = xcd_barrier_post((unsigned*)(a.ws + WS_CTL) + CW_BAR, (volatile LAS unsigned*)((LAS unsigned char*)lds_raw + MISC_OFF) + 8);

#ifdef REP_STEP
    int rep_left = REP_N;
#endif
    for (int step = a.ph_lo; step < a.ph_hi; ++step) {
#ifdef REP_STEP
    const bool dry = (step == REP_STEP && rep_left > 0);
#else
    constexpr bool dry = false;
#endif
    int phase, L, pass = 0; (void)pass;
    if (step == 0) { phase = PH_PROLOGUE; L = 0; }
    else if (step < 6) { L = 0; const int s = step - 1; phase = s == 0 ? PH_INPROJ : s == 1 ? PH_MIX1 : s == 2 ? PH_OUTPROJ : s == 3 ? PH_FFNUP : PH_FFNDOWN; }
    else { L = 1; const int s = step - 6; phase = s == 0 ? PH_INPROJ : s == 1 ? PH_MIX1 : s == 2 ? PH_OUTPROJ : s == 3 ? PH_NORM : s == 4 ? PH_MOEUP : s == 5 ? PH_MOEDOWN : PH_FINAL; }
#ifdef REP_NOP
    if (dry) phase = 1000;
#endif
    switch (phase) {
    case PH_PROLOGUE: {
        PHASE_ENTER
        float* scr = ldsf + wid * (128 * 33);
        const int gw = bid * 8 + wid, NGW = G * 8;
        constexpr int I_IN = 16 * 80, I_OUT = 16 * 32, I_G = 16 * 88, I_D = 44 * 32;
        constexpr int T0 = 2 * I_IN, T1 = T0 + 2 * I_OUT, T2 = T1 + I_G, T3 = T2 + I_G, T4 = T3 + I_D;
        for (int it = gw; it < T4; it += NGW) {
            if (it < T0) { const int l = it / I_IN, r = it % I_IN; cvt_item(IN(1) + (size_t)l * D * DIN, D, DIN, (bf16*)(ws + WS_WIN) + (size_t)l * DIN * D, 0, r, scr, lane, l == 1 ? IN(15) + D : nullptr); }
            else if (it < T1) { const int q = it - T0, l = q / I_OUT, r = q % I_OUT; cvt_item(IN(2) + (size_t)l * D * D, D, D, (bf16*)(ws + WS_WOUT) + (size_t)l * D * D, 0, r, scr, lane); }
            else if (it < T2) { cvt_item(IN(17), D, DFF, (bf16*)(ws + WS_WGU), 1, it - T1, scr, lane, IN(16)); }
            else if (it < T3) { cvt_item(IN(18), D, DFF, (bf16*)(ws + WS_WGU), 2, it - T2, scr, lane, IN(16)); }
            else { cvt_item(IN(19), DFF, D, (bf16*)(ws + WS_WD), 0, it - T3, scr, lane); }
        }
        for (int m = gw; m < NTOK; m += NGW) rms_row_bf16(IN(0) + (size_t)m * D, IN(15), HN + (size_t)m * D, lane);
        for (int idx = bid * NT + tid; idx < 3 * 2 * 4 * HD * HD; idx += G * NT) {
            const int mat = idx / (2 * 4 * HD * HD), r = idx % (2 * 4 * HD * HD), lh = r >> 12, j = (r >> 6) & 63, i = r & 63;
            const float* w = mat == 0 ? IN(5) : mat == 1 ? IN(7) : IN(12);
            (mat == 0 ? WTA : mat == 1 ? WTX : WTP)[r] = (bf16)f2bf(w[(lh * 64 + i) * 64 + j]);
        }
    } break;

    case PH_INPROJ: {
        PHASE_ENTER
        pg8::Gemm g{HN, (const bf16*)(ws + WS_WIN) + (size_t)L * DIN * D, NTOK, DIN, D, 0}; pg8::StaticOrder S; S.init(NTOK, DIN, G, bid);
        if (L == 0) { pg8::EpiStoreBf16 E{PROJ, DIN}; pg8::gemm_phase<pg8::EpiStoreBf16, pg8::StaticOrder, true, true>((PG8_LAS unsigned char*)lds_raw, g, S, E, tid); }
        else { pg8::fill_rstd_table((PG8_LAS unsigned char*)lds_raw, S, SSP1, tid); pg8::EpiStoreBf16R E{PROJ, DIN, (const PG8_LAS float*)((PG8_LAS unsigned char*)lds_raw + pg8::RSTD_TAB_OFF)}; pg8::gemm_phase<pg8::EpiStoreBf16R, pg8::StaticOrder, true, true>((PG8_LAS unsigned char*)lds_raw, g, S, E, tid); }
    } break;

    case PH_MIX1: {
        PHASE_ENTER
        {
        const float* conv_w = IN(3) + L * 4 * GW; const float* conv_b = IN(4) + L * GW;
        const float* b_a = IN(6) + L * GW; const float* b_x = IN(8) + L * GW;
        const float* lam = IN(9) + L * GW; const float* lbp = IN(10);
        unsigned char* AX = lds_raw; unsigned char* AINB = lds_raw + 35376;
        unsigned char* FS = lds_raw; unsigned char* KHTl = lds_raw; unsigned char* VTl = lds_raw + 36864; float* TOTl = (float*)(lds_raw + 73728);
        unsigned* PQ = (unsigned*)(lds_raw + PQ_OFF);
        for (int ci = bid; ci < NCHUNK; ci += G) {
            const int t0 = (ci % CPB) * CH, g0 = ci * CH; const bf16* prow = PROJ + (size_t)g0 * DIN;
            LruParams lp[2];
#pragma unroll
            for (int cc = 0; cc < 2; ++cc) lru_params_load(lp[cc], WTA + L * 16384, WTX + L * 16384, conv_w, conv_b, b_a, b_x, lam, wid >> 1, 2 * (wid & 1) + cc, lane);
            int lbi = 64 * (wid >> 1) + lane; asm volatile("" : "+v"(lbi)); const float lbv = L == 0 ? 0.f : sigmoidf_(lbp[GW + lbi] - lbp[lbi]);
            u32x4 rf[4], rv[4];
            {
                u32x4 rax[5];
                int tl1 = tid; asm volatile("" : "+v"(tl1) :: "memory");
                slab_load<5>(rax, prow - 3 * DIN, 67, t0 == 0 ? 3 : 0, tl1);
                slab_store<5>(rax, AX, 67, tid);
            }
            __syncthreads();
            lru_ainb(AX, conv_w, conv_b, AINB, tid);
            __syncthreads();
#pragma unroll
            for (int cc = 0; cc < 2; ++cc) {
                const int h = wid >> 1, nt = 2 * (wid & 1) + cc, fr = lane & 15, fq = lane >> 4, c = 64 * h + 16 * nt + fr; float av[4][4], uv[4][4];
                lru_gates(AINB, AX, lp[cc], h, nt, lane, av, uv);
                float Pin = 1.f, Qin = 0.f;
#pragma unroll
                for (int mt = 0; mt < 4; ++mt) {
                    float Ai[4], Hi[4]; float A_ = 1.f, H_ = 0.f;
#pragma unroll
                    for (int r = 0; r < 4; ++r) { H_ = av[mt][r] * H_ + uv[mt][r]; A_ *= av[mt][r]; Ai[r] = A_; Hi[r] = H_; }
                    const float a1 = __shfl_up(A_, 16), h1 = __shfl_up(H_, 16), a2 = __shfl_up(A_, 32), h2 = __shfl_up(H_, 32), a3 = __shfl_up(A_, 48), h3 = __shfl_up(H_, 48);
                    float EA = 1.f, EH = 0.f;
                    if (fq >= 3) { EA = a3; EH = h3; }
                    if (fq >= 2) { EH = a2 * EH + h2; EA *= a2; }
                    if (fq >= 1) { EH = a1 * EH + h1; EA *= a1; }
                    float Pt[4], Qt[4];
#pragma unroll
                    for (int r = 0; r < 4; ++r) { const float al = Ai[r] * EA, be = Ai[r] * EH + Hi[r]; Pt[r] = al * Pin; Qt[r] = al * Qin + be; PQ[(16 * mt + 4 * fq + r) * 256 + c] = pk2(Pt[r], Qt[r]); }
                    Pin = __shfl(Pt[3], 48 + fr); Qin = __shfl(Qt[3], 48 + fr);
                }
                if (lane < 16) { CARA[ci * GW + c] = Pin; CARH[ci * GW + c] = Qin; }
                if (cc == 0) { int tl2 = tid; asm volatile("" : "+v"(tl2) :: "memory"); slab_load<4>(rf, prow + 768, 64, 0, tl2); slab_load<4>(rv, prow + 1024, 64, 0, tl2); }
            }
            __syncthreads();
            slab_store<4>(rf, FS, 64, tid); vt_store(rv, VTl, tid);
            __syncthreads();
            {
                const int h = wid >> 1, half = wid & 1, c = 64 * h + lane, fr = lane & 15, fq = lane >> 4;
                const float lb = lbv;
                float gl[32], kk[32]; float run = 0.f;
#pragma unroll
                for (int t = 0; t < 32; ++t) { const float sg = sigmoidf_(bf2f(*(const bf16*)(FS + (32 * half + t) * RS + c * 2))); run += flog(lb + (1.f - lb) * sg); gl[t] = run; kk[t] = (1.f - lb) * (1.f - sg); }
                TOTl[(h * 2 + half) * 64 + lane] = run;
                __syncthreads();
                const float tot0 = TOTl[(h * 2) * 64 + lane], glast = tot0 + TOTl[(h * 2 + 1) * 64 + lane], off = half ? tot0 : 0.f;
#pragma unroll
                for (int j = 0; j < 4; ++j) { float e[8];
#pragma unroll
                    for (int q = 0; q < 8; ++q) e[q] = kk[8 * j + q] * fexp(glast - (off + gl[8 * j + q]));
                    u32x4 w; w.x = pk2(e[0], e[1]); w.y = pk2(e[2], e[3]); w.z = pk2(e[4], e[5]); w.w = pk2(e[6], e[7]);
                    *(u32x4*)(KHTl + c * VTS + (32 * half + 8 * j) * 2) = w; }
                if (half) DEC[(ci * 4 + h) * 64 + lane] = fexp(glast);
                __syncthreads();
#pragma unroll
                for (int vvv = 0; vvv < 2; ++vvv) {
                    const int vt = 2 * half + vvv, vrow = 64 * h + 16 * vt + fr; bf16x8 bv[2];
#pragma unroll
                    for (int ks = 0; ks < 2; ++ks) bv[ks] = *(const bf16x8*)(VTl + vt_off(vrow, 32 * ks + 8 * fq));
#pragma unroll
                    for (int kt = 0; kt < 4; ++kt) { f32x4 acc = (f32x4){0.f, 0.f, 0.f, 0.f};
#pragma unroll
                        for (int ks = 0; ks < 2; ++ks) { const bf16x8 ka = *(const bf16x8*)(KHTl + (64 * h + 16 * kt + fr) * VTS + (32 * ks + 8 * fq) * 2); acc = __builtin_amdgcn_mfma_f32_16x16x32_bf16(ka, bv[ks], acc, 0, 0, 0); }
                        *(f32x4*)(DS + ((size_t)(ci * 4 + h) * 64 + 16 * vt + fr) * 64 + 16 * kt + 4 * fq) = acc; }
                }
                __syncthreads();
            }
        }
        }
        xcd_arrive(bar, tid == 0);
        {
        const float* conv_w = IN(3) + L * 4 * GW; const float* conv_b = IN(4) + L * GW; const float* b_a = IN(6) + L * GW; const float* b_x = IN(8) + L * GW; const float* lam = IN(9) + L * GW;
        const float* lbp = IN(10); const float* norm_g = IN(11) + L * HD; const float* pool_s = IN(13) + L * GW; const float* sconv_w = IN(14) + L * 3 * GW;
        unsigned char* AX = lds_raw; unsigned char* AG = lds_raw + 35376; unsigned char* AINB = lds_raw + 69168;
        unsigned char* QT3 = lds_raw; unsigned char* KT3 = lds_raw + 33792; unsigned char* OG3 = lds_raw + 67584; unsigned char* VT3 = lds_raw + 101376; float* TOT3 = (float*)(lds_raw + 138240);
        unsigned char* PS = lds_raw; unsigned char* DIMG = lds_raw + 41712; unsigned char* YST = lds_raw;
        unsigned char* SB = lds_raw; unsigned char* SC = lds_raw + 33792; unsigned char* SX = lds_raw + 68640;
        for (int ci = bid; ci < NCHUNK; ci += G) {
            const int t0 = (ci % CPB) * CH, g0 = ci * CH; const bf16* prow = PROJ + (size_t)g0 * DIN; bf16* yrow = Y + (size_t)g0 * D; (void)t0; (void)yrow;
            { u32x4 rp[5]; int tlc = tid; asm volatile("" : "+v"(tlc) :: "memory"); slab_load<5>(rp, prow - 15 * DIN + 1536, 79, t0 == 0 ? 15 : 0, tlc); slab_store<5>(rp, PS, 79, tid); }
            __syncthreads();
            for (int idx = tid; idx < CH * 128; idx += NT) {
                const int t = idx >> 7, c = (idx & 127) * 2, gi = c >> 6, w = 2 << gi; const int tt = t0 + t; const int cnt = (tt + 1 < w) ? (tt + 1) : w; float s0 = 0.f, s1 = 0.f; unsigned xs[16];
#pragma unroll
                for (int r = 0; r < 16; ++r) xs[r] = *(const unsigned*)(PS + (t + 15 - r) * RS + c * 2);
#pragma unroll
                for (int r = 0; r < 16; ++r) { const float m_ = r < cnt ? 1.0f : 0.0f; s0 += m_ * bf2f(xs[r] & 0xffffu); s1 += m_ * bf2f(xs[r] >> 16); }
                const float inv = __builtin_amdgcn_rcpf((float)cnt);
                *(unsigned*)(DIMG + t * RS + c * 2) = pk2(s0 * inv - bf2f(xs[0] & 0xffffu), s1 * inv - bf2f(xs[0] >> 16));
            }
            __syncthreads();
#pragma unroll 1
            for (int cc = 0; cc < 2; ++cc) {
                const int gi = wid >> 1, nt = 2 * (wid & 1) + cc, fr = lane & 15, fq = lane >> 4, c = 64 * gi + 16 * nt + fr; bf16x8 wp[2];
#pragma unroll
                for (int ks = 0; ks < 2; ++ks) wp[ks] = *(const bf16x8*)(WTP + L * 16384 + (size_t)(gi * 64 + 16 * nt + fr) * 64 + 32 * ks + 8 * fq);
                const float psc = pool_s[c];
#pragma unroll
                for (int mt = 0; mt < 4; ++mt) { f32x4 acc = (f32x4){0.f, 0.f, 0.f, 0.f};
#pragma unroll
                    for (int ks = 0; ks < 2; ++ks) { const bf16x8 x = *(const bf16x8*)(DIMG + (16 * mt + fr) * RS + (64 * gi + 32 * ks + 8 * fq) * 2); acc = __builtin_amdgcn_mfma_f32_16x16x32_bf16(x, wp[ks], acc, 0, 0, 0); }
#pragma unroll
                    for (int r = 0; r < 4; ++r) *(bf16*)(YST + (16 * mt + 4 * fq + r) * RS + c * 2) = (bf16)f2bf(acc[r] * psc); }
            }
            __syncthreads();
            ytile_store(YST, yrow + 512, tid);
            __syncthreads();
        }
        }
        xcd_wait(bar, tid == 0);
        {
        float* xa = ldsf; float* xs = ldsf + 512;
        for (int item = bid; item < 256 + 8; item += G) {
            if (item < 256) {
                const int el = tid & 127, seg = tid >> 7, e = item * 128 + el, b = e >> 14, hh = (e >> 12) & 3, kv = e & 4095, k = kv & 63;
                float dv[32], dc[32];
#pragma unroll
                for (int i = 0; i < 32; ++i) { const int ci = b * CPB + seg * 32 + i; dv[i] = DS[(size_t)(ci * 4 + hh) * 4096 + kv]; dc[i] = DEC[(ci * 4 + hh) * 64 + k]; }
                float S = 0.f, A = 1.f;
#pragma unroll
                for (int i = 0; i < 32; ++i) { const float d = dv[i]; dv[i] = S; S = dc[i] * S + d; const float a0 = dc[i]; dc[i] = A; A *= a0; }
                xa[seg * 128 + el] = A; xs[seg * 128 + el] = S;
                __syncthreads();
                float Sin = 0.f;
                for (int s2 = 0; s2 < seg; ++s2) Sin = xa[s2 * 128 + el] * Sin + xs[s2 * 128 + el];
#pragma unroll
                for (int i = 0; i < 32; ++i) { const int ci = b * CPB + seg * 32 + i; (dry ? DS + 20 * (MiB / 4) * 4 : DS)[(size_t)(ci * 4 + hh) * 4096 + kv] = dv[i] + dc[i] * Sin; }
                __syncthreads();
            } else {
                const int q = item - 256, sq = tid & 63, chg = q * 64 + sq, b = chg >> 8, c = chg & 255, seg = tid >> 6;
                float ca[16], chh[16];
#pragma unroll
                for (int i = 0; i < 16; ++i) { const int ci = b * CPB + seg * 16 + i; ca[i] = CARA[ci * GW + c]; chh[i] = CARH[ci * GW + c]; }
                float A = 1.f, H = 0.f;
#pragma unroll
                for (int i = 0; i < 16; ++i) { const float a0 = ca[i], h0 = chh[i]; ca[i] = A; chh[i] = H; H = a0 * H + h0; A *= a0; }
                xa[seg * 64 + sq] = A; xs[seg * 64 + sq] = H;
                __syncthreads();
                float Hin = 0.f;
                for (int s2 = 0; s2 < seg; ++s2) Hin = xa[s2 * 64 + sq] * Hin + xs[s2 * 64 + sq];
#pragma unroll
                for (int i = 0; i < 16; ++i) { const int ci = b * CPB + seg * 16 + i; CIN[ci * GW + c] = chh[i] + ca[i] * Hin; }
                __syncthreads();
            }
        }
        }
        xcd_arrive(bar, tid == 0);
        {
        const float* conv_w = IN(3) + L * 4 * GW; const float* conv_b = IN(4) + L * GW; const float* b_a = IN(6) + L * GW; const float* b_x = IN(8) + L * GW; const float* lam = IN(9) + L * GW;
        const float* lbp = IN(10); const float* norm_g = IN(11) + L * HD; const float* pool_s = IN(13) + L * GW; const float* sconv_w = IN(14) + L * 3 * GW;
        unsigned char* AX = lds_raw; unsigned char* AG = lds_raw + 35376; unsigned char* AINB = lds_raw + 69168;
        unsigned char* QT3 = lds_raw; unsigned char* KT3 = lds_raw + 33792; unsigned char* OG3 = lds_raw + 67584; unsigned char* VT3 = lds_raw + 101376; float* TOT3 = (float*)(lds_raw + 138240);
        unsigned char* PS = lds_raw; unsigned char* DIMG = lds_raw + 41712; unsigned char* YST = lds_raw;
        unsigned char* SB = lds_raw; unsigned char* SC = lds_raw + 33792; unsigned char* SX = lds_raw + 68640;
        for (int ci = bid; ci < NCHUNK; ci += G) {
            const int t0 = (ci % CPB) * CH, g0 = ci * CH; const bf16* prow = PROJ + (size_t)g0 * DIN; bf16* yrow = Y + (size_t)g0 * D; (void)t0; (void)yrow;
            { u32x4 rsb[4], rsc[5], rsx[5]; int tld = tid; asm volatile("" : "+v"(tld) :: "memory"); slab_load<4>(rsb, prow + 1792, 64, 0, tld); slab_load<5>(rsc, prow - 2 * DIN + 2048, 66, t0 == 0 ? 2 : 0, tld); slab_load<5>(rsx, prow - 2 * DIN + 2304, 66, t0 == 0 ? 2 : 0, tld);
#pragma unroll
              for (int j = 0; j < 5; ++j) {
                  const unsigned a[4] = {rsc[j].x, rsc[j].y, rsc[j].z, rsc[j].w}, b[4] = {rsx[j].x, rsx[j].y, rsx[j].z, rsx[j].w}; unsigned p[4];
#pragma unroll
                  for (int q = 0; q < 4; ++q) p[q] = pk2(bf2f(a[q] & 0xffffu) * bf2f(b[q] & 0xffffu), bf2f(a[q] >> 16) * bf2f(b[q] >> 16));
                  rsc[j] = (u32x4){p[0], p[1], p[2], p[3]}; }
              slab_store<4>(rsb, SB, 64, tid); slab_store<5>(rsc, SC, 66, tid); }
            __syncthreads();
            int tq = tid; asm volatile("" : "+v"(tq));
            for (int idx = tq; idx < CH * 128; idx += NT) {
                const int t = idx >> 7, c = (idx & 127) * 2; float a0 = 0.f, a1 = 0.f;
#pragma unroll
                for (int k = 0; k < 3; ++k) { const unsigned xc = *(const unsigned*)(SC + (t + k) * RS + c * 2); a0 += sconv_w[k * GW + c] * bf2f(xc & 0xffffu); a1 += sconv_w[k * GW + c + 1] * bf2f(xc >> 16); }
                unsigned* pb = (unsigned*)(SB + t * RS + c * 2); const unsigned b = *pb; *pb = pk2(bf2f(b & 0xffffu) * a0, bf2f(b >> 16) * a1);
            }
            __syncthreads();
            ytile_store(SB, yrow + 768, tid);
            __syncthreads();
        }
        }
        xcd_wait(bar, tid == 0);
        {
        const float* conv_w = IN(3) + L * 4 * GW; const float* conv_b = IN(4) + L * GW; const float* b_a = IN(6) + L * GW; const float* b_x = IN(8) + L * GW; const float* lam = IN(9) + L * GW;
        const float* lbp = IN(10); const float* norm_g = IN(11) + L * HD; const float* pool_s = IN(13) + L * GW; const float* sconv_w = IN(14) + L * 3 * GW;
        unsigned char* AX = lds_raw; unsigned char* AG = lds_raw + 35376; unsigned char* AINB = lds_raw + 69168;
        unsigned char* QT3 = lds_raw; unsigned char* KT3 = lds_raw + 33792; unsigned char* OG3 = lds_raw + 67584; unsigned char* VT3 = lds_raw + 101376; float* TOT3 = (float*)(lds_raw + 138240);
        unsigned char* PS = lds_raw; unsigned char* DIMG = lds_raw + 41712; unsigned char* YST = lds_raw;
        unsigned char* SB = lds_raw; unsigned char* SC = lds_raw + 33792; unsigned char* SX = lds_raw + 68640;
        for (int ci = bid; ci < NCHUNK; ci += G) {
            const int t0 = (ci % CPB) * CH, g0 = ci * CH; const bf16* prow = PROJ + (size_t)g0 * DIN; bf16* yrow = Y + (size_t)g0 * D; (void)t0; (void)yrow;
            int lbi = 64 * (wid >> 1) + lane; asm volatile("" : "+v"(lbi)); const float lbv = L == 0 ? 0.f : sigmoidf_(lbp[GW + lbi] - lbp[lbi]);
            { unsigned* PQ = (unsigned*)(lds_raw + PQ_OFF);
              const int c = (tid & 127) * 2; const float hin_a = CIN[ci * GW + c], hin_b = CIN[ci * GW + c + 1];
              unsigned ag[16];
#pragma unroll
              for (int i = 0; i < 16; ++i) ag[i] = *(const unsigned*)(prow + (size_t)(4 * i + (tid >> 7)) * DIN + 256 + c);
#pragma unroll
              for (int i = 0; i < 16; ++i) { const int t = 4 * i + (tid >> 7); const unsigned pa = PQ[t * 256 + c], pb = PQ[t * 256 + c + 1];
                  const float ha = bf2f(pa & 0xffffu) * hin_a + bf2f(pa >> 16), hb = bf2f(pb & 0xffffu) * hin_b + bf2f(pb >> 16);
                  *(unsigned*)(yrow + (size_t)t * D + c) = pk2(ha * gelu_tanh(bf2f(ag[i] & 0xffffu)), hb * gelu_tanh(bf2f(ag[i] >> 16))); }
            }
            __syncthreads();
            { u32x4 rq[4], rf[4], rv[4], rog[4]; int tlb = tid; asm volatile("" : "+v"(tlb) :: "memory"); slab_load<4>(rq, prow + 512, 64, 0, tlb); slab_load<4>(rf, prow + 768, 64, 0, tlb); slab_load<4>(rv, prow + 1024, 64, 0, tlb); slab_load<4>(rog, prow + 1280, 64, 0, tlb);
              slab_store<4>(rq, QT3, 64, tid); slab_store<4>(rf, KT3, 64, tid); slab_store<4>(rog, OG3, 64, tid); vt_store(rv, VT3, tid); }
            __syncthreads();
            {
                const int h = wid >> 1, half = wid & 1, c = 64 * h + lane, fr = lane & 15, fq = lane >> 4;
                const float lb = lbv;
                f32x4 sraw[4][2][2];
#pragma unroll
                for (int vt = 0; vt < 4; ++vt)
#pragma unroll
                    for (int ks = 0; ks < 2; ++ks) { const float* p = DS + ((size_t)(ci * 4 + h) * 64 + 16 * vt + fr) * 64 + 32 * ks + 8 * fq; sraw[vt][ks][0] = *(const f32x4*)p; sraw[vt][ks][1] = *(const f32x4*)(p + 4); }
                float gl[32]; float run = 0.f;
#pragma unroll
                for (int t = 0; t < 32; ++t) { const float sg = sigmoidf_(bf2f(*(const bf16*)(KT3 + (32 * half + t) * RS + c * 2))); run += flog(lb + (1.f - lb) * sg); gl[t] = run; }
                TOT3[(h * 2 + half) * 64 + lane] = run;
                __syncthreads();
                const float tot0 = TOT3[(h * 2) * 64 + lane];
                const float off = half ? 0.f : -tot0;
#pragma unroll
                for (int t = 0; t < 32; ++t) {
                    bf16* pq = (bf16*)(QT3 + (32 * half + t) * RS + c * 2); bf16* pk = (bf16*)(KT3 + (32 * half + t) * RS + c * 2);
                    const float sg = sigmoidf_(bf2f(*pk)), kkv = (1.f - lb) * (1.f - sg), qfv = siluf_(bf2f(*pq)), d = gl[t] + off;
                    *pq = (bf16)f2bf(qfv * fexp(d)); *pk = (bf16)f2bf(kkv * fexp(-d));
                }
                __syncthreads();
                bf16x8 sa[4][2];
#pragma unroll
                for (int vt = 0; vt < 4; ++vt)
#pragma unroll
                    for (int ks = 0; ks < 2; ++ks) {
                        const f32x4 lo = sraw[vt][ks][0], hi = sraw[vt][ks][1];
                        const float* eg = TOT3 + (h * 2) * 64 + 32 * ks + 8 * fq;
                        u32x4 w; w.x = pk2(lo.x * fexp(eg[0]), lo.y * fexp(eg[1])); w.y = pk2(lo.z * fexp(eg[2]), lo.w * fexp(eg[3])); w.z = pk2(hi.x * fexp(eg[4]), hi.y * fexp(eg[5])); w.w = pk2(hi.z * fexp(eg[6]), hi.w * fexp(eg[7]));
                        sa[vt][ks] = __builtin_bit_cast(bf16x8, w);
                    }
#pragma unroll
                for (int tsel = 0; tsel < 2; ++tsel) {
                    const int ti = half == 0 ? (tsel ? 3 : 0) : (tsel ? 2 : 1);
                    bf16x8 qb[2];
#pragma unroll
                    for (int ks = 0; ks < 2; ++ks) qb[ks] = *(const bf16x8*)(QT3 + (16 * ti + fr) * RS + (64 * h + 32 * ks + 8 * fq) * 2);
                    f32x4 st[4];
#pragma unroll
                    for (int si = 0; si < 4; ++si) { st[si] = (f32x4){0.f, 0.f, 0.f, 0.f};
                        if (si <= ti) {
#pragma unroll
                            for (int ks = 0; ks < 2; ++ks) { const bf16x8 ka = *(const bf16x8*)(KT3 + (16 * si + fr) * RS + (64 * h + 32 * ks + 8 * fq) * 2); st[si] = __builtin_amdgcn_mfma_f32_16x16x32_bf16(ka, qb[ks], st[si], 0, 0, 0); }
                            if (si == ti) {
#pragma unroll
                                for (int r = 0; r < 4; ++r) if (4 * fq + r > fr) st[si][r] = 0.f; }
                        } }
                    f32x4 oo[4];
#pragma unroll
                    for (int vt = 0; vt < 4; ++vt) { oo[vt] = (f32x4){0.f, 0.f, 0.f, 0.f};
#pragma unroll
                        for (int ks = 0; ks < 2; ++ks) oo[vt] = __builtin_amdgcn_mfma_f32_16x16x32_bf16(sa[vt][ks], qb[ks], oo[vt], 0, 0, 0); }
#pragma unroll
                    for (int p = 0; p < 2; ++p) if (2 * p <= ti) {
                        u32x4 bw; bw.x = pk2(st[2 * p][0], st[2 * p][1]); bw.y = pk2(st[2 * p][2], st[2 * p][3]); bw.z = pk2(st[2 * p + 1][0], st[2 * p + 1][1]); bw.w = pk2(st[2 * p + 1][2], st[2 * p + 1][3]);
                        const bf16x8 bfr = __builtin_bit_cast(bf16x8, bw);
#pragma unroll
                        for (int vt = 0; vt < 4; ++vt) { const int vrow = 64 * h + 16 * vt + fr; const u32x2 lo8 = *(const u32x2*)(VT3 + vt_off(vrow, 32 * p + 4 * fq)), hi8 = *(const u32x2*)(VT3 + vt_off(vrow, 32 * p + 16 + 4 * fq));
                            u32x4 aw; aw.x = lo8.x; aw.y = lo8.y; aw.z = hi8.x; aw.w = hi8.y;
                            oo[vt] = __builtin_amdgcn_mfma_f32_16x16x32_bf16(__builtin_bit_cast(bf16x8, aw), bfr, oo[vt], 0, 0, 0); }
                    }
                    float ss = 0.f;
#pragma unroll
                    for (int vt = 0; vt < 4; ++vt) ss += (oo[vt][0] * oo[vt][0] + oo[vt][1] * oo[vt][1]) + (oo[vt][2] * oo[vt][2] + oo[vt][3] * oo[vt][3]);
                    ss += __shfl_xor(ss, 16); ss += __shfl_xor(ss, 32);
                    const float rs = __builtin_amdgcn_rsqf(ss * (1.0f / HD) + 1e-5f);
#pragma unroll
                    for (int vt = 0; vt < 4; ++vt) { const int cv = 64 * h + 16 * vt + 4 * fq; u32x2* pog = (u32x2*)(OG3 + (16 * ti + fr) * RS + cv * 2); const u32x2 og = *pog; const f32x4 ng = *(const f32x4*)(norm_g + 16 * vt + 4 * fq);
                        u32x2 w; w.x = pk2(oo[vt][0] * rs * ng.x * siluf_(bf2f(og.x & 0xffffu)), oo[vt][1] * rs * ng.y * siluf_(bf2f(og.x >> 16))); w.y = pk2(oo[vt][2] * rs * ng.z * siluf_(bf2f(og.y & 0xffffu)), oo[vt][3] * rs * ng.w * siluf_(bf2f(og.y >> 16)));
                        *pog = w; }
                }
                __syncthreads();
            }
            ytile_store(OG3, yrow + 256, tid);
            __syncthreads();
        }
        }
    } break;

    case PH_OUTPROJ: {
        PHASE_ENTER
        pg8::Gemm g{Y, (const bf16*)(ws + WS_WOUT) + (size_t)L * D * D, NTOK, D, D, 0}; pg8::StaticOrder S; S.init(NTOK, D, G, bid);
        if (L == 0) { pg8::EpiResidStats E{IN(0), hres, HN, SSP0}; pg8::gemm_phase<pg8::EpiResidStats, pg8::StaticOrder, true, true>((PG8_LAS unsigned char*)lds_raw, g, S, E, tid); }
        else { pg8::EpiResidF32 E{hres, hres}; pg8::gemm_phase<pg8::EpiResidF32, pg8::StaticOrder, true, true>((PG8_LAS unsigned char*)lds_raw, g, S, E, tid); }
    } break;

    case PH_NORM: {
        PHASE_ENTER
        const float* g = IN(16) + D;
        unsigned* XROW = (unsigned*)lds_raw;
        int* sel = (int*)(lds_raw + 65536);
        int* rnk = sel + 128;
        int* sh = rnk + 128;
        int* cnts = sh + 64;
        const int blk = bid;
        {
            float wr[16][8];
            { const float* wr_ = IN(20);
#pragma unroll
              for (int j = 0; j < 4; ++j)
#pragma unroll
                for (int q = 0; q < 4; ++q) { const f32x4 w0 = *(const f32x4*)(wr_ + (size_t)(4 * (lane + 64 * j) + q) * 8), w1 = *(const f32x4*)(wr_ + (size_t)(4 * (lane + 64 * j) + q) * 8 + 4);
                    wr[j * 4 + q][0] = w0.x; wr[j * 4 + q][1] = w0.y; wr[j * 4 + q][2] = w0.z; wr[j * 4 + q][3] = w0.w; wr[j * 4 + q][4] = w1.x; wr[j * 4 + q][5] = w1.y; wr[j * 4 + q][6] = w1.z; wr[j * 4 + q][7] = w1.w; } }
            f32x4 gv[4];
#pragma unroll
            for (int j = 0; j < 4; ++j) gv[j] = ((const f32x4*)g)[lane + 64 * j];
            f32x4 vn[4];
            { const f32x4* xr = (const f32x4*)(hres + (size_t)(blk * 64 + wid * 8) * D);
#pragma unroll
              for (int j = 0; j < 4; ++j) vn[j] = xr[lane + 64 * j]; }
#pragma unroll 1
            for (int r8 = 0; r8 < 8; ++r8) {
                const int tl = wid * 8 + r8, m = blk * 64 + tl;
                f32x4 v[4]; float s = 0.f;
#pragma unroll
                for (int j = 0; j < 4; ++j) { v[j] = vn[j]; s += (v[j].x * v[j].x + v[j].y * v[j].y) + (v[j].z * v[j].z + v[j].w * v[j].w); }
                if (r8 < 7) { const f32x4* xr = (const f32x4*)(hres + (size_t)(m + 1) * D);
#pragma unroll
                    for (int j = 0; j < 4; ++j) vn[j] = xr[lane + 64 * j]; }
                const float r = 1.0f / sqrtf(wave_sum(s) * (1.0f / D) + 1e-6f);
                float lg[8] = {0.f, 0.f, 0.f, 0.f, 0.f, 0.f, 0.f, 0.f};
#pragma unroll
                for (int j = 0; j < 4; ++j) { const float y[4] = {v[j].x * r * gv[j].x, v[j].y * r * gv[j].y, v[j].z * r * gv[j].z, v[j].w * r * gv[j].w};
                    XROW[tl * 256 + lane + 64 * j] = pg8::pk4_fp8(y[0], y[1], y[2], y[3]);
#pragma unroll
                    for (int q = 0; q < 4; ++q)
#pragma unroll
                        for (int e = 0; e < 8; ++e) lg[e] += y[q] * wr[j * 4 + q][e]; }
#pragma unroll
                for (int e = 0; e < 8; ++e) lg[e] = wave_sum(lg[e]);
                if (lane == 0) {
                    int e1 = 0; float l1 = lg[0];
#pragma unroll
                    for (int e = 1; e < 8; ++e) if (lg[e] > l1) { l1 = lg[e]; e1 = e; }
                    int e2 = -1; float l2 = -3.0e38f;
#pragma unroll
                    for (int e = 0; e < 8; ++e) if (e != e1 && lg[e] > l2) { l2 = lg[e]; e2 = e; }
                    const float g1 = 1.0f / (1.0f + fexp(l2 - l1));
                    TOKG[m * 2] = g1; TOKG[m * 2 + 1] = 1.0f - g1;
                    sel[tl * 2] = e1; sel[tl * 2 + 1] = e2;
                }
            }
            __syncthreads();
            if (tid < NE) { int cnt = 0; for (int q = 0; q < 128; ++q) if (sel[q] == tid) { rnk[q] = cnt; ++cnt; } BCNT[blk * NE + tid] = cnt; }
        }
        xcd_barrier(bar, tid == 0);
        {
            for (int i = tid; i < (NTOK / 64) * NE; i += NT) cnts[i] = BCNT[i];
            __syncthreads();
            { const int e = wid; int sall = 0, slt = 0;
#pragma unroll
              for (int i = 0; i < 4; ++i) { const int b2 = 4 * lane + i, c = cnts[b2 * NE + e]; sall += c; slt += (b2 < blk) ? c : 0; }
#pragma unroll
              for (int o = 1; o < 64; o <<= 1) { sall += __shfl_xor(sall, o); slt += __shfl_xor(slt, o); }
              if (lane == 0) { sh[e] = sall; sh[16 + e] = slt; sh[24 + e] = (sall + 255) >> 8; } }
            __syncthreads();
            if (tid == 0) { int acc = 0; for (int e = 0; e < NE; ++e) { sh[8 + e] = acc * 256; acc += sh[24 + e]; } sh[32] = acc; }
            __syncthreads();
            if (tid < 128) { const int m = blk * 64 + (tid >> 1); const int e = sel[tid]; const int r = sh[8 + e] + sh[16 + e] + rnk[tid];
                ROWDST[r] = m * 2 + (tid & 1); ROWG[r] = TOKG[blk * 128 + tid]; TOKROW[blk * 128 + tid] = r; }
#pragma unroll
            for (int r8 = 0; r8 < 8; ++r8) {
                const int tl = wid * 8 + r8; const int e0 = sel[tl * 2], e1 = sel[tl * 2 + 1];
                const int r0 = sh[8 + e0] + sh[16 + e0] + rnk[tl * 2], r1 = sh[8 + e1] + sh[16 + e1] + rnk[tl * 2 + 1];
                const u32x4 w = *(const u32x4*)(XROW + tl * 256 + 4 * lane);
                *(u32x4*)(XR + (size_t)r0 * D + 16 * lane) = w; *(u32x4*)(XR + (size_t)r1 * D + 16 * lane) = w;
            }
            if (blk == 0) {
                for (int e = 0; e < NE; ++e) { const int lo = sh[8 + e] + sh[e], hi = sh[8 + e] + sh[24 + e] * 256; for (int r = lo + tid; r < hi; r += NT) { ROWDST[r] = -1; ROWG[r] = 0.f; } }
                if (tid < MAXTILES) { int e = 0; for (int q = 0; q < NE; ++q) if (tid * 256 >= sh[8 + q]) e = q; TILEE[tid] = e; }
                if (tid == 0) TILEE[MAXTILES] = sh[32];
            }
            __syncthreads();
        }
    } break;

    case PH_FFNUP: {
        PHASE_ENTER
        pg8::Gemm g{HN, (const bf16*)(ws + WS_WGU), NTOK, 2 * DFF, D, 0}; pg8::StaticOrder S; S.init(NTOK, 2 * DFF, G, bid);
        pg8::fill_rstd_table((PG8_LAS unsigned char*)lds_raw, S, SSP0, tid);
        pg8::EpiSwigluR E{HID, DFF, (const PG8_LAS float*)((PG8_LAS unsigned char*)lds_raw + pg8::RSTD_TAB_OFF)};
        pg8::gemm_phase<pg8::EpiSwigluR, pg8::StaticOrder, true, true>((PG8_LAS unsigned char*)lds_raw, g, S, E, tid);
    } break;

    case PH_FFNDOWN: {
        PHASE_ENTER
        pg8::Gemm g{HID, (const bf16*)(ws + WS_WD), NTOK, D, DFF, 0}; pg8::StaticOrder S; S.init(NTOK, D, G, bid);
        pg8::EpiResidStats E{hres, dry ? (float*)(ws + 410 * MiB) : hres, HN, SSP1};
        pg8::gemm_phase<pg8::EpiResidStats, pg8::StaticOrder, true, true>((PG8_LAS unsigned char*)lds_raw, g, S, E, tid);
    } break;

    case PH_MOEUP: {
        PHASE_ENTER
        const int ntiles = __builtin_amdgcn_readfirstlane(__hip_atomic_load(TILEE + MAXTILES, __ATOMIC_RELAXED, __HIP_MEMORY_SCOPE_AGENT));
        pg8::Gemm g{(const bf16*)XR, (const bf16*)(ws + WS_W13), 0, 0, D / 2, 0}; pg8::MoeOrder S; S.init(ntiles, DFFE / 128, G, bid, 0, 0, TILEE);
        pg8::EpiSwiglu8 E{HIDE, DFFE, 1.0f / W13_SCALE, HID_SCALE};
        pg8::gemm_phase<pg8::EpiSwiglu8, pg8::MoeOrder, true, true, true>((PG8_LAS unsigned char*)lds_raw, g, S, E, tid);
    } break;

    case PH_MOEDOWN: {
        PHASE_ENTER
        const int ntiles = __builtin_amdgcn_readfirstlane(__hip_atomic_load(TILEE + MAXTILES, __ATOMIC_RELAXED, __HIP_MEMORY_SCOPE_AGENT));
        const int tfull = (ntiles / 64) * 64, ntail = ntiles - tfull;
        if (tfull > 0) {
            pg8::Gemm g{(const bf16*)HIDE, (const bf16*)(ws + WS_W2), 0, 0, DFFE / 2, 0}; pg8::MoeOrder S; S.init(tfull, D / 256, G, bid, 0, 0, TILEE);
            pg8::EpiMoeDown E{OUT2, ROWDST, ROWG, 1.0f / (W2_SCALE * HID_SCALE)};
            pg8::gemm_phase<pg8::EpiMoeDown, pg8::MoeOrder, true, true, true>((PG8_LAS unsigned char*)lds_raw, g, S, E, tid);
        }
        if (ntail > 0) {
            const int Sp = moe_tail_split(ntail);
            pg8::Gemm g{(const bf16*)HIDE, (const bf16*)(ws + WS_W2), 0, 0, DFFE / 2 / Sp, DFFE / 2};
            pg8::MoeTailOrder S{tfull, ntail, D / 256, Sp, G, bid, DFFE / Sp, TILEE};
            pg8::EpiPartF32 E{PART};
            pg8::gemm_phase<pg8::EpiPartF32, pg8::MoeTailOrder, true, true, true>((PG8_LAS unsigned char*)lds_raw, g, S, E, tid);
        }
    } break;

    case PH_FINAL: {
        PHASE_ENTER
        const float* g = IN(24); const int gw = bid * 8 + wid, NGW = G * 8;
        const int ntiles = __builtin_amdgcn_readfirstlane(__hip_atomic_load(TILEE + MAXTILES, __ATOMIC_RELAXED, __HIP_MEMORY_SCOPE_AGENT));
        const int tfull = (ntiles / 64) * 64, ntail = ntiles - tfull, Sp = ntail > 0 ? moe_tail_split(ntail) : 1, tail_row0 = tfull * 256; const float sc = 1.0f / (W2_SCALE * HID_SCALE);
        for (int mb = gw; mb < NTOK; mb += 8 * NGW) {
        int trow[8][2];
#pragma unroll
        for (int k = 0; k < 8; ++k) { const int m = mb + k * NGW; trow[k][0] = m < NTOK ? TOKROW[2 * m] : 0; trow[k][1] = m < NTOK ? TOKROW[2 * m + 1] : 0; }
#pragma unroll
        for (int k = 0; k < 8; ++k) { const int m = mb + k * NGW; if (m >= NTOK) break;
            f32x4* xr = (f32x4*)(hres + (size_t)m * D); const f32x4* gr = (const f32x4*)g;
            f32x4 v[4]; u32x2 ob[2][4]; float s = 0.f;
#pragma unroll
            for (int j = 0; j < 4; ++j) { v[j] = xr[lane + 64 * j]; ob[0][j] = ((const u32x2*)(OUT2 + (size_t)(2 * m) * D))[lane + 64 * j]; ob[1][j] = ((const u32x2*)(OUT2 + (size_t)(2 * m + 1) * D))[lane + 64 * j]; }
#pragma unroll
            for (int slot = 0; slot < 2; ++slot) {
                const int r = __builtin_amdgcn_readfirstlane(trow[k][slot]);
                if (r < tail_row0) {
#pragma unroll
                    for (int j = 0; j < 4; ++j) { const u32x2 p = ob[slot][j]; v[j].x += bf2f(p.x & 0xffffu); v[j].y += bf2f(p.x >> 16); v[j].z += bf2f(p.y & 0xffffu); v[j].w += bf2f(p.y >> 16); } }
                else { const int tl = (r - tail_row0) >> 8, rl = (r - tail_row0) & 255; const float gt = TOKG[2 * m + slot] * sc;
                    f32x4 q[7][4];
#pragma unroll
                    for (int p = 0; p < 7; ++p) { const f32x4* pr = (const f32x4*)(PART + ((size_t)(tl * Sp + (p < Sp ? p : 0)) * 256 + rl) * 1024);
#pragma unroll
                        for (int j = 0; j < 4; ++j) q[p][j] = pr[lane + 64 * j]; }
#pragma unroll
                    for (int p = 0; p < 7; ++p) { const float gp = p < Sp ? gt : 0.f;
#pragma unroll
                        for (int j = 0; j < 4; ++j) { v[j].x += gp * q[p][j].x; v[j].y += gp * q[p][j].y; v[j].z += gp * q[p][j].z; v[j].w += gp * q[p][j].w; } } }
            }
#pragma unroll
            for (int j = 0; j < 4; ++j) s += (v[j].x * v[j].x + v[j].y * v[j].y) + (v[j].z * v[j].z + v[j].w * v[j].w);
            const float r = 1.0f / sqrtf(wave_sum(s) * (1.0f / D) + 1e-6f);
#pragma unroll
            for (int j = 0; j < 4; ++j) { const f32x4 gv = gr[lane + 64 * j]; (dry ? (f32x4*)((float*)(ws + 410 * MiB) + (size_t)m * D) : xr)[lane + 64 * j] = (f32x4){v[j].x * r * gv.x, v[j].y * r * gv.y, v[j].z * r * gv.z, v[j].w * r * gv.w}; }
        }
        }
    } break;
    }
    if (phase == PH_INPROJ || phase == PH_FFNUP || phase == PH_NORM) {
        int t_ = wid_s * 64 + lane_id_asm(); asm volatile("" : "+v"(t_));
        __attribute__((address_space(1))) unsigned char* wsq_ = (__attribute__((address_space(1))) unsigned char*)a.ws; asm volatile("" : "+s"(wsq_)); unsigned char* ws_ = (unsigned char*)wsq_; int G_ = gridDim.x; asm volatile("" : "+s"(G_));
        bg_convert(ws_, lds_raw, IN(21), IN(22), IN(23), step, G_, t_, phase == PH_NORM);
    }
    if (step + 1 < a.ph_hi) { int t_ = wid_s * 64 + lane_id_asm(); asm volatile("" : "+v"(t_)); xcd_barrier(bar, t_ == 0); }
#ifdef REP_STEP
    if (dry) { --rep_left; --step; }
#endif
    }
}

constexpr int NSTEPS = 13;
#ifndef MK_PER_PHASE
#define MK_PER_PHASE 0
#endif

extern "C" void kernel_launch(void* const* d_in, const int* in_sizes, int n_in, void* d_out, int out_size, void* d_ws, size_t ws_size, hipStream_t stream) {
    static int grid = 0;
    if (grid == 0) {
        if (n_in != 25 || out_size != NTOK * D || ws_size < WS_END + 67 * MiB) { fprintf(stderr, "kernel_launch: unexpected shapes (n_in %d out %d ws %zu need %zu)\n", n_in, out_size, ws_size, (size_t)WS_END); grid = -1; return; }
        int dev = 0, cus = 0, per_cu = 0;
        if (hipGetDevice(&dev) != hipSuccess || hipDeviceGetAttribute(&cus, hipDeviceAttributeMultiprocessorCount, dev) != hipSuccess) { grid = -1; return; }
        if (hipFuncSetAttribute((const void*)fwd, hipFuncAttributeMaxDynamicSharedMemorySize, LDS_BYTES) != hipSuccess) { fprintf(stderr, "kernel_launch: hipFuncSetAttribute failed\n"); grid = -1; return; }
        if (hipOccupancyMaxActiveBlocksPerMultiprocessor(&per_cu, (const void*)fwd, NT, LDS_BYTES) != hipSuccess || per_cu < 1) { fprintf(stderr, "kernel_launch: occupancy query says %d blocks/CU\n", per_cu); (void)hipGetLastError(); grid = -1; return; }
        grid = cus;
        if (grid != NCHUNK) { fprintf(stderr, "kernel_launch: built for a %d-CU device (one 64-token chunk per workgroup in the mixer phase); this device has %d\n", NCHUNK, cus); grid = -1; return; }
    }
    if (grid < 0) return;
    hipMemsetAsync((char*)d_ws + WS_CTL, 0, 1 * MiB, stream);
    Args a{};
    for (int i = 0; i < 25; ++i) a.in[i] = (const float*)d_in[i];
    a.out = (float*)d_out; a.ws = (unsigned char*)d_ws;
#if MK_PER_PHASE
    for (int s = 0; s < NSTEPS; ++s) { a.ph_lo = s; a.ph_hi = s + 1; hipLaunchKernelGGL(fwd, dim3(grid), dim3(NT), LDS_BYTES, stream, a); }
#else
    a.ph_lo = 0; a.ph_hi = NSTEPS;
    hipLaunchKernelGGL(fwd, dim3(grid), dim3(NT), LDS_BYTES, stream, a);
#endif
}
```

```cpp
#include <hip/hip_runtime.h>
#include <cstdint>
#include <cstdio>

typedef unsigned short bf16;
typedef short bf16x8 __attribute__((ext_vector_type(8)));
typedef float f32x4 __attribute__((ext_vector_type(4)));
typedef unsigned u32x4 __attribute__((ext_vector_type(4)));
typedef unsigned u32x2 __attribute__((ext_vector_type(2)));

constexpr int NTOK = 16384, SEQ = 8192, D = 1024, DIN = 2560, GW = 256, HD = 64, DFF = 2816, DFFE = 3584, NE = 8;
constexpr int CH = 64, NCHUNK = NTOK / CH, CPB = SEQ / CH;
constexpr int NT = 512;
constexpr float W13_SCALE = 64.f, W2_SCALE = 128.f, HID_SCALE = 8.f;
constexpr int MAXTILES = NTOK * 2 / 256 + NE;

constexpr size_t MiB = 1u << 20;
constexpr size_t WS_CTL = 0;
constexpr size_t WS_SMALL = 1 * MiB;
constexpr size_t WS_WIN = 5 * MiB;
constexpr size_t WS_WOUT = 15 * MiB;
constexpr size_t WS_WGU = 19 * MiB;
constexpr size_t WS_WD = 30 * MiB;
constexpr size_t WS_W13 = 36 * MiB;
constexpr size_t WS_W2 = 92 * MiB;
constexpr size_t WS_ACT = 120 * MiB;
constexpr size_t WS_HN = WS_ACT;
constexpr size_t WS_PROJ = WS_ACT + 32 * MiB;
constexpr size_t WS_Y = WS_ACT + 112 * MiB;
constexpr size_t WS_DS = WS_ACT + 144 * MiB;
constexpr size_t WS_HID = WS_PROJ;
constexpr size_t WS_XR = WS_ACT;
constexpr size_t WS_HIDE = WS_ACT + 34 * MiB;
constexpr size_t WS_OUT2 = WS_ACT + 153 * MiB;
constexpr size_t WS_END = WS_ACT + 217 * MiB;
constexpr size_t SM_TOKE = 0;
constexpr size_t SM_TOKG = 128 * 1024;
constexpr size_t SM_TOKR = 256 * 1024;
constexpr size_t SM_BCNT = 384 * 1024;
constexpr size_t SM_ROWTOK = 400 * 1024;
constexpr size_t SM_ROWDST = 544 * 1024;
constexpr size_t SM_ROWG = 688 * 1024;
constexpr size_t SM_TILEE = 832 * 1024;
constexpr size_t SM_CARA = 1024 * 1024;
constexpr size_t SM_CARH = 1280 * 1024;
constexpr size_t SM_CIN = 1536 * 1024;
constexpr size_t SM_DEC = 1792 * 1024;
constexpr size_t SM_RSTD = 2048 * 1024;
constexpr size_t SM_WTA = 2304 * 1024;
constexpr size_t SM_WTX = 2368 * 1024;
constexpr size_t SM_TOKROW = 2560 * 1024;
constexpr size_t SM_WTP = 2432 * 1024;

struct Args {
    const float* in[25];
    float* out;
    unsigned char* ws;
    int ph_lo, ph_hi, pad0, pad1;
};

__device__ __forceinline__ int lane_id_asm() { int l; asm volatile("v_mbcnt_lo_u32_b32 %0, -1, 0\n\tv_mbcnt_hi_u32_b32 %0, -1, %0" : "=v"(l)); return l; }
typedef const float __attribute__((address_space(1)))* gfptr_t;
__device__ __forceinline__ const float* IN(int k) { asm volatile("" : "+s"(k)); const gfptr_t p = ((const gfptr_t __attribute__((address_space(4)))*)__builtin_amdgcn_kernarg_segment_ptr())[k]; return (const float*)p; }
__device__ __forceinline__ float bf2f(unsigned v) { return __uint_as_float(v << 16); }
typedef float f32x2c __attribute__((ext_vector_type(2))); typedef __bf16 bf16x2c __attribute__((ext_vector_type(2)));
__device__ __forceinline__ unsigned pk2(float lo, float hi) { const f32x2c v = {lo, hi}; return __builtin_bit_cast(unsigned, __builtin_convertvector(v, bf16x2c)); }
__device__ __forceinline__ unsigned f2bf(float f) { return pk2(f, 0.f) & 0xffffu; }
__device__ __forceinline__ float fexp(float x) { return __builtin_amdgcn_exp2f(1.44269504089f * x); }
__device__ __forceinline__ float flog(float x) { return 0.69314718056f * __builtin_amdgcn_logf(x); }
__device__ __forceinline__ float sigmoidf_(float x) { return __builtin_amdgcn_rcpf(1.0f + __builtin_amdgcn_exp2f(-1.44269504089f * x)); }
__device__ __forceinline__ float siluf_(float x) { return x * sigmoidf_(x); }
__device__ __forceinline__ float gelu_tanh(float x) { const float u = 1.5957691216057308f * (x + 0.044715f * x * x * x); return x * sigmoidf_(u); }
__device__ __forceinline__ float neg_expm1_small(float x) { return -x * (1.0f + x * (0.5f + x * (0.16666667f + x * (0.041666668f + x * 0.0083333338f)))); }
__device__ __forceinline__ float wave_sum(float v) {
#define WS_DPP(ctrl, rmask) v += __builtin_bit_cast(float, __builtin_amdgcn_update_dpp(0, __builtin_bit_cast(int, v), ctrl, rmask, 0xf, false))
    WS_DPP(0xB1, 0xf); WS_DPP(0x4E, 0xf); WS_DPP(0x141, 0xf); WS_DPP(0x140, 0xf); WS_DPP(0x142, 0xa); WS_DPP(0x143, 0xc);
#undef WS_DPP
    return __builtin_bit_cast(float, __builtin_amdgcn_readlane(__builtin_bit_cast(int, v), 63));
}
#define LDS_WAIT() asm volatile("s_waitcnt lgkmcnt(0)" ::: "memory")

namespace pg8 {
#define PG8_LAS __attribute__((address_space(3)))
typedef unsigned short bf16_t;
typedef short bf16x8 __attribute__((ext_vector_type(8)));
typedef float f32x4 __attribute__((ext_vector_type(4)));
typedef unsigned u32x4 __attribute__((ext_vector_type(4)));
constexpr int BM = 256, BK = 64, HALF = 128, HTB = HALF * BK * 2  , STAGE_BYTES = 8 * HTB, NXCD = 8;

__host__ __device__ __forceinline__ int lds_byte(int r, int c) { const int st = (r >> 4) * 2 + (c >> 5), rr = r & 15, cc = c & 31, ob = rr * 64 + cc * 2; return st * 1024 + (ob ^ (((ob >> 9) & 1) << 5)); }
__host__ __device__ __forceinline__ void stage_rc(int b, int& R, int& C) { const int st = b / 1024, sb = b % 1024, swz = sb ^ (((sb >> 9) & 1) << 5); R = (st >> 1) * 16 + swz / 64; C = (st & 1) * 32 + (swz % 64) / 2; }
__host__ __device__ __forceinline__ int perm32(int rho) { const int n = rho >> 4, i = rho & 15; return 8 * (i >> 2) + 4 * n + (i & 3); }

struct Unit { int pm, pn, pa, pb, ord, koff; };
struct Gemm { const bf16_t* A; const bf16_t* Bt; int M, N, K; int LD; };

struct StaticOrder {
    int nM, nN, nwg, G, c, WGM;
    __host__ __device__ void init(int M, int N, int G_, int c_, int wgm = 4) { nM = M / BM; nN = N / BM; nwg = nM * nN; G = G_; c = c_; WGM = wgm; }
    __host__ __device__ bool next(int i, Unit& u) const {
        const long L = (long)i * G + c; if (L >= nwg) return false;
        int wgid = (int)L; { const int q = nwg / NXCD, r = nwg % NXCD, xcd = wgid % NXCD, off = wgid / NXCD; wgid = (xcd < r ? xcd * (q + 1) : r * (q + 1) + (xcd - r) * q) + off; }
        const int nig = WGM * nN, gid = wgid / nig, fm = gid * WGM, gsz = (nM - fm) < WGM ? (nM - fm) : WGM;
        u.pm = fm + ((wgid % nig) % gsz); u.pn = (wgid % nig) / gsz; u.pa = u.pm; u.pb = u.pn; u.ord = i; u.koff = 0; return true;
    }
    __device__ __forceinline__ void a_ready(const Unit&) const {}
    __device__ __forceinline__ void done(const Unit&) const {}
};

__device__ __forceinline__ unsigned cvt_pk_bf16(float lo, float hi) { unsigned r; asm volatile("v_cvt_pk_bf16_f32 %0, %1, %2" : "=v"(r) : "v"(lo), "v"(hi)); return r; }
typedef float f32x2 __attribute__((ext_vector_type(2)));
typedef int pg8_v8i __attribute__((ext_vector_type(8))); typedef int pg8_v4i __attribute__((ext_vector_type(4)));
__device__ __forceinline__ pg8_v8i pg8_cat(bf16x8 lo, bf16x8 hi) { return __builtin_shufflevector(__builtin_bit_cast(pg8_v4i, lo), __builtin_bit_cast(pg8_v4i, hi), 0, 1, 2, 3, 4, 5, 6, 7); }
__device__ __forceinline__ void pg8_mfma8(f32x4& acc, pg8_v8i a, pg8_v8i b, int sc) { asm volatile("v_mfma_scale_f32_16x16x128_f8f6f4 %0, %1, %2, %0, %3, %3 op_sel_hi:[0,0,0]" : "+v"(acc) : "v"(a), "v"(b), "v"(sc)); }
template <class Epi, class Sched, bool ALIGN_EPI = false, bool SP2 = false, bool F8 = false>
__device__ __forceinline__ void gemm_phase(PG8_LAS unsigned char* lds, const Gemm g, const Sched& S, const Epi& E, int tid_in) {
    int tid = tid_in; asm volatile("" : "+v"(tid));
    const int wid = __builtin_amdgcn_readfirstlane(tid >> 6), lane = tid & 63, wr = wid >> 2, wc = wid & 3, fr = lane & 15, fq = lane >> 4;
    const int K = g.LD ? g.LD : g.K, nt = g.K / BK;
    unsigned voffA[2], voffB[2];
#pragma unroll
    for (int i = 0; i < 2; ++i) { int R, C; stage_rc(tid * 16 + i * 8192, R, C); const int Rb = Epi::PERM ? ((R & ~31) + perm32(R & 31)) : R;
        voffA[i] = (unsigned)(R * K + C) * 2u; voffB[i] = (unsigned)(Rb * K + C) * 2u; }
    const size_t kstep = (size_t)(BK * 2);
    const size_t hstep = (size_t)HALF * K * 2;
    const size_t tstep = 2 * hstep;
    const unsigned ldsw = (unsigned)wid * 1024u;
    int f8one = 0x7f7f7f7f; asm volatile("" : "+v"(f8one));
    constexpr int KOFF = 1024;
    const int aoff = lds_byte(wr * 64 + fr, fq * 8), boff = lds_byte(wc * 32 + fr, fq * 8);
#define PG8_SA(b, h) (((b) * 2 + (h)) * HTB)
#define PG8_SB(b, h) ((4 + (b) * 2 + (h)) * HTB)
#define PG8_STAGE(bufoff, gbase, voff) do { _Pragma("unroll") for (int _i = 0; _i < 2; ++_i) \
        __builtin_amdgcn_global_load_lds((const unsigned*)((const char*)(gbase) + (voff)[_i]), (PG8_LAS unsigned*)(lds + (bufoff) + ldsw + _i * 8192), 16, 0, 0); } while (0)
#define PG8_LDA(dst, b, h) do { _Pragma("unroll") for (int m = 0; m < 4; ++m) _Pragma("unroll") for (int k = 0; k < 2; ++k) dst[m][k] = *(const PG8_LAS bf16x8*)(lds + PG8_SA(b, h) + aoff + m * 2048 + k * KOFF); } while (0)
#define PG8_LDB(dst, b, h) do { _Pragma("unroll") for (int n = 0; n < 2; ++n) _Pragma("unroll") for (int k = 0; k < 2; ++k) dst[n][k] = *(const PG8_LAS bf16x8*)(lds + PG8_SB(b, h) + boff + n * 2048 + k * KOFF); } while (0)
#define PG8_MMA(ai, bj, At, Bt) do { __builtin_amdgcn_s_setprio(1); if constexpr (F8) { _Pragma("unroll") for (int m = 0; m < 4; ++m) _Pragma("unroll") for (int n = 0; n < 2; ++n) \
        pg8_mfma8(acc[ai][bj][m][n], pg8_cat(Bt[n][0], Bt[n][1]), pg8_cat(At[m][0], At[m][1]), f8one); } \
    else { _Pragma("unroll") for (int m = 0; m < 4; ++m) _Pragma("unroll") for (int n = 0; n < 2; ++n) _Pragma("unroll") for (int k = 0; k < 2; ++k) \
        acc[ai][bj][m][n] = __builtin_amdgcn_mfma_f32_16x16x32_bf16(Bt[n][k], At[m][k], acc[ai][bj][m][n], 0, 0, 0); } __builtin_amdgcn_s_setprio(0); } while (0)
#define PG8_WAIT_V(n) asm volatile("s_waitcnt vmcnt(" #n ")" ::: "memory")
#define PG8_WAIT_L(n) asm volatile("s_waitcnt lgkmcnt(" #n ")" ::: "memory")
#define PG8_BAR __builtin_amdgcn_s_barrier()
#define PG8_SCHED __builtin_amdgcn_sched_barrier(0)
    Unit cur, nxt; int ui = 0;
    if (!S.next(0, cur)) return;
    f32x4 acc[2][2][4][2];
    if constexpr (Epi::ACC_INIT) E.init(acc, cur, wr, wc, fr, fq);
    else {
#pragma unroll
    for (int a = 0; a < 2; ++a)
#pragma unroll
        for (int b = 0; b < 2; ++b)
#pragma unroll
            for (int m = 0; m < 4; ++m)
#pragma unroll
                for (int n = 0; n < 2; ++n) acc[a][b][m][n] = (f32x4){0.f, 0.f, 0.f, 0.f};
    }
    bf16x8 At[4][2], B0[2][2], B1[2][2];
    const char* cA = (const char*)g.A + (size_t)cur.pa * tstep + cur.koff; const char* cB = (const char*)g.Bt + (size_t)cur.pb * tstep + cur.koff;
    S.a_ready(cur);
    if constexpr (SP2) {
        PG8_STAGE(PG8_SB(0, 0), cB, voffB); PG8_STAGE(PG8_SB(0, 1), cB + hstep, voffB); PG8_STAGE(PG8_SA(0, 0), cA, voffA); PG8_STAGE(PG8_SA(0, 1), cA + hstep, voffA);
        if (wr == 1) PG8_BAR;
        PG8_WAIT_V(2); PG8_BAR;
        PG8_STAGE(PG8_SB(1, 0), cB + kstep, voffB); PG8_STAGE(PG8_SA(1, 0), cA + kstep, voffA); PG8_STAGE(PG8_SB(1, 1), cB + hstep + kstep, voffB);
        PG8_WAIT_V(6); PG8_BAR;
    } else {
        PG8_STAGE(PG8_SB(0, 0), cB, voffB); PG8_STAGE(PG8_SA(0, 0), cA, voffA); PG8_STAGE(PG8_SB(0, 1), cB + hstep, voffB); PG8_STAGE(PG8_SA(0, 1), cA + hstep, voffA);
        if (wr == 1) PG8_BAR;
        PG8_WAIT_V(4); PG8_BAR;
        PG8_STAGE(PG8_SB(1, 0), cB + kstep, voffB); PG8_STAGE(PG8_SA(1, 0), cA + kstep, voffA); PG8_STAGE(PG8_SB(1, 1), cB + hstep + kstep, voffB);
        PG8_WAIT_V(6); PG8_BAR;
    }
    for (;;) {
        const bool has_next = S.next(ui + 1, nxt);
        const char* nA = has_next ? (const char*)g.A + (size_t)nxt.pa * tstep + nxt.koff : cA; const char* nB = has_next ? (const char*)g.Bt + (size_t)nxt.pb * tstep + nxt.koff : cB;
        for (int t = 0; t < nt; t += 2) {
            const bool last = (t == nt - 2);
            const char* a1 = cA + (size_t)(t + 1) * kstep;
            const char* a2 = last ? nA : cA + (size_t)(t + 2) * kstep; const char* b2 = last ? nB : cB + (size_t)(t + 2) * kstep;
            const char* a3 = a2 + kstep; const char* b3 = b2 + kstep;
            if (last && has_next) S.a_ready(nxt);
            if constexpr (SP2) {
            PG8_LDB(B0, 0, 0); PG8_LDB(B1, 0, 1); PG8_SCHED; PG8_LDA(At, 0, 0); PG8_STAGE(PG8_SA(1, 1), a1 + hstep, voffA);
            PG8_WAIT_V(8); PG8_WAIT_L(0); PG8_BAR; PG8_MMA(0, 0, At, B0); PG8_MMA(0, 1, At, B1); PG8_BAR; PG8_SCHED;
            PG8_LDA(At, 0, 1); PG8_STAGE(PG8_SB(0, 0), b2, voffB); PG8_STAGE(PG8_SB(0, 1), b2 + hstep, voffB); PG8_STAGE(PG8_SA(0, 0), a2, voffA);
            PG8_WAIT_V(8); PG8_WAIT_L(0); PG8_BAR; PG8_MMA(1, 0, At, B0); PG8_MMA(1, 1, At, B1); PG8_BAR; PG8_SCHED;
            PG8_LDB(B0, 1, 0); PG8_LDB(B1, 1, 1); PG8_SCHED; PG8_LDA(At, 1, 0); PG8_STAGE(PG8_SA(0, 1), a2 + hstep, voffA);
            PG8_WAIT_V(8); PG8_WAIT_L(0); PG8_BAR; PG8_MMA(0, 0, At, B0); PG8_MMA(0, 1, At, B1); PG8_BAR; PG8_SCHED;
            PG8_LDA(At, 1, 1); PG8_STAGE(PG8_SB(1, 0), b3, voffB); PG8_STAGE(PG8_SB(1, 1), b3 + hstep, voffB); PG8_STAGE(PG8_SA(1, 0), a3, voffA);
            PG8_WAIT_V(8); PG8_WAIT_L(0); PG8_BAR; PG8_MMA(1, 0, At, B0); PG8_MMA(1, 1, At, B1); PG8_BAR; PG8_SCHED;
            } else {
            PG8_LDB(B0, 0, 0); PG8_SCHED; PG8_LDA(At, 0, 0); PG8_STAGE(PG8_SA(1, 1), a1 + hstep, voffA);
            PG8_WAIT_L(8); PG8_BAR; PG8_WAIT_L(0); PG8_MMA(0, 0, At, B0); PG8_BAR; PG8_SCHED;
            PG8_LDB(B1, 0, 1); PG8_STAGE(PG8_SB(0, 0), b2, voffB);
            PG8_BAR; PG8_WAIT_L(0); PG8_MMA(0, 1, At, B1); PG8_BAR;
            PG8_LDA(At, 0, 1); PG8_STAGE(PG8_SA(0, 0), a2, voffA);
            PG8_BAR; PG8_WAIT_L(0); PG8_MMA(1, 0, At, B0); PG8_BAR; PG8_SCHED;
            PG8_STAGE(PG8_SB(0, 1), b2 + hstep, voffB);
            PG8_WAIT_V(6); PG8_BAR; PG8_MMA(1, 1, At, B1); PG8_BAR;
            PG8_LDB(B0, 1, 0); PG8_SCHED; PG8_LDA(At, 1, 0); PG8_STAGE(PG8_SA(0, 1), a2 + hstep, voffA);
            PG8_WAIT_L(8); PG8_BAR; PG8_WAIT_L(0); PG8_MMA(0, 0, At, B0); PG8_BAR; PG8_SCHED;
            PG8_LDB(B1, 1, 1); PG8_STAGE(PG8_SB(1, 0), b3, voffB);
            PG8_BAR; PG8_WAIT_L(0); PG8_MMA(0, 1, At, B1); PG8_BAR;
            PG8_LDA(At, 1, 1); PG8_STAGE(PG8_SA(1, 0), a3, voffA);
            PG8_BAR; PG8_WAIT_L(0); PG8_MMA(1, 0, At, B0); PG8_BAR; PG8_SCHED;
            PG8_STAGE(PG8_SB(1, 1), b3 + hstep, voffB);
            PG8_WAIT_V(6); PG8_BAR; PG8_MMA(1, 1, At, B1); PG8_BAR;
            }
        }
        if constexpr (F8) asm volatile("s_nop 15\n\ts_nop 15" ::: "memory");
        if constexpr (ALIGN_EPI) { if (wr == 0) PG8_BAR; }
        if constexpr (!Epi::AFTER_DRAIN) { E(acc, cur, wr, wc, fr, fq); S.done(cur); }
        if (!has_next) break;
#pragma unroll
        for (int a = 0; a < 2; ++a)
#pragma unroll
            for (int b = 0; b < 2; ++b)
#pragma unroll
                for (int m = 0; m < 4; ++m)
#pragma unroll
                    for (int n = 0; n < 2; ++n) acc[a][b][m][n] = (f32x4){0.f, 0.f, 0.f, 0.f};
        cur = nxt; cA = nA; cB = nB; ++ui;
        if constexpr (ALIGN_EPI) { if (wr == 1) PG8_BAR; }
    }
    PG8_WAIT_V(0);
    if constexpr (!ALIGN_EPI) { if (wr == 0) PG8_BAR; }
    PG8_BAR;
    if constexpr (Epi::AFTER_DRAIN) { E.fused(acc, cur, wr, wc, fr, fq, lds, wid, lane); S.done(cur); }
#undef PG8_SA
#undef PG8_SB
#undef PG8_STAGE
#undef PG8_LDA
#undef PG8_LDB
#undef PG8_MMA
#undef PG8_WAIT_V
#undef PG8_WAIT_L
#undef PG8_BAR
#undef PG8_SCHED
}

struct EpiStoreBf16 {
    static constexpr bool PERM = true, AFTER_DRAIN = false, ACC_INIT = false;
    bf16_t* O; int ldc;
    __device__ __forceinline__ void operator()(const f32x4 (&acc)[2][2][4][2], const Unit& u, int wr, int wc, int fr, int fq) const {
        const int row0 = u.pm * BM + wr * 64 + fr, col0 = u.pn * BM + wc * 32 + 8 * fq;
#pragma unroll
        for (int ai = 0; ai < 2; ++ai)
#pragma unroll
            for (int m = 0; m < 4; ++m) { bf16_t* rowp = O + (size_t)(row0 + ai * HALF + m * 16) * ldc + col0;
#pragma unroll
                for (int bj = 0; bj < 2; ++bj) { const f32x4 v0 = acc[ai][bj][m][0], v1 = acc[ai][bj][m][1];
                    u32x4 w; w.x = cvt_pk_bf16(v0[0], v0[1]); w.y = cvt_pk_bf16(v0[2], v0[3]); w.z = cvt_pk_bf16(v1[0], v1[1]); w.w = cvt_pk_bf16(v1[2], v1[3]);
                    *(u32x4*)(rowp + bj * HALF) = w; } }
    }
};
struct EpiResidF32 {
    static constexpr bool PERM = false, AFTER_DRAIN = false, ACC_INIT = true;
    const float* base; float* out;
    __device__ __forceinline__ void init(f32x4 (&acc)[2][2][4][2], const Unit& u, int wr, int wc, int fr, int fq) const {
        const int row0 = u.pm * BM + wr * 64 + fr, col0 = u.pn * BM + wc * 32 + 4 * fq;
#pragma unroll
        for (int ai = 0; ai < 2; ++ai)
#pragma unroll
            for (int m = 0; m < 4; ++m) { const size_t off = (size_t)(row0 + ai * HALF + m * 16) * 1024 + col0;
#pragma unroll
                for (int bj = 0; bj < 2; ++bj)
#pragma unroll
                    for (int n = 0; n < 2; ++n) acc[ai][bj][m][n] = *(const f32x4*)(base + off + bj * HALF + n * 16); }
    }
    __device__ __forceinline__ void operator()(const f32x4 (&acc)[2][2][4][2], const Unit& u, int wr, int wc, int fr, int fq) const {
        const int row0 = u.pm * BM + wr * 64 + fr, col0 = u.pn * BM + wc * 32 + 4 * fq;
#pragma unroll
        for (int ai = 0; ai < 2; ++ai)
#pragma unroll
            for (int m = 0; m < 4; ++m) { const size_t off = (size_t)(row0 + ai * HALF + m * 16) * 1024 + col0;
#pragma unroll
                for (int bj = 0; bj < 2; ++bj)
#pragma unroll
                    for (int n = 0; n < 2; ++n) *(f32x4*)(out + off + bj * HALF + n * 16) = acc[ai][bj][m][n]; }
    }
};
__device__ __forceinline__ float silu_f(float x) { return x * __builtin_amdgcn_rcpf(1.0f + __builtin_amdgcn_exp2f(-1.44269504089f * x)); }
struct EpiSwiglu {
    static constexpr bool PERM = true, AFTER_DRAIN = false, ACC_INIT = false;
    bf16_t* C; int ldc; int row_off;
    __device__ __forceinline__ void operator()(const f32x4 (&acc)[2][2][4][2], const Unit& u, int wr, int wc, int fr, int fq) const {
        const int row0 = u.pm * BM + wr * 64 + fr - row_off, col0 = u.pn * HALF + wc * 32 + 8 * fq;
#pragma unroll
        for (int ai = 0; ai < 2; ++ai)
#pragma unroll
            for (int m = 0; m < 4; ++m) { bf16_t* rowp = C + (size_t)(row0 + ai * HALF + m * 16) * ldc + col0;
                const f32x4 g0 = acc[ai][0][m][0], g1 = acc[ai][0][m][1], u0 = acc[ai][1][m][0], u1 = acc[ai][1][m][1];
                u32x4 w; w.x = cvt_pk_bf16(silu_f(g0[0]) * u0[0], silu_f(g0[1]) * u0[1]); w.y = cvt_pk_bf16(silu_f(g0[2]) * u0[2], silu_f(g0[3]) * u0[3]);
                w.z = cvt_pk_bf16(silu_f(g1[0]) * u1[0], silu_f(g1[1]) * u1[1]); w.w = cvt_pk_bf16(silu_f(g1[2]) * u1[2], silu_f(g1[3]) * u1[3]);
                *(u32x4*)rowp = w; }
    }
};
struct EpiMoeDown {
    static constexpr bool PERM = true, AFTER_DRAIN = false, ACC_INIT = false;
    bf16_t* out2; const int* rowdst; const float* rowg; float sc;
    __device__ __forceinline__ void operator()(const f32x4 (&acc)[2][2][4][2], const Unit& u, int wr, int wc, int fr, int fq) const {
        const int row0 = u.pm * BM + wr * 64 + fr, col0 = u.pn * BM + wc * 32 + 8 * fq;
#pragma unroll
        for (int ai = 0; ai < 2; ++ai)
#pragma unroll
            for (int m = 0; m < 4; ++m) { const int gr = row0 + ai * HALF + m * 16; const int d = rowdst[gr]; const float g = rowg[gr] * sc;
                if (d >= 0) { bf16_t* rowp = out2 + (size_t)d * 1024 + col0;
#pragma unroll
                    for (int bj = 0; bj < 2; ++bj) { const f32x4 v0 = acc[ai][bj][m][0] * g, v1 = acc[ai][bj][m][1] * g;
                        u32x4 w; w.x = cvt_pk_bf16(v0[0], v0[1]); w.y = cvt_pk_bf16(v0[2], v0[3]); w.z = cvt_pk_bf16(v1[0], v1[1]); w.w = cvt_pk_bf16(v1[2], v1[3]);
                        *(u32x4*)(rowp + bj * HALF) = w; } } }
    }
};


struct EpiResidStats {
    static constexpr bool PERM = false, AFTER_DRAIN = false, ACC_INIT = true;
    const float* base; float* out; bf16_t* hn; float* ssp;
    __device__ __forceinline__ void init(f32x4 (&acc)[2][2][4][2], const Unit& u, int wr, int wc, int fr, int fq) const {
        const int row0 = u.pm * BM + wr * 64 + fr, col0 = u.pn * BM + wc * 32 + 4 * fq;
#pragma unroll
        for (int ai = 0; ai < 2; ++ai)
#pragma unroll
            for (int m = 0; m < 4; ++m) { const size_t off = (size_t)(row0 + ai * HALF + m * 16) * 1024 + col0;
#pragma unroll
                for (int bj = 0; bj < 2; ++bj)
#pragma unroll
                    for (int n = 0; n < 2; ++n) acc[ai][bj][m][n] = *(const f32x4*)(base + off + bj * HALF + n * 16); }
    }
    __device__ __forceinline__ void operator()(const f32x4 (&acc)[2][2][4][2], const Unit& u, int wr, int wc, int fr, int fq) const {
        const int row0 = u.pm * BM + wr * 64 + fr, col0 = u.pn * BM + wc * 32 + 4 * fq; typedef unsigned u32x2e __attribute__((ext_vector_type(2)));
#pragma unroll
        for (int ai = 0; ai < 2; ++ai)
#pragma unroll
            for (int m = 0; m < 4; ++m) { const int row = row0 + ai * HALF + m * 16; const size_t off = (size_t)row * 1024 + col0; float ss = 0.f;
#pragma unroll
                for (int bj = 0; bj < 2; ++bj)
#pragma unroll
                    for (int n = 0; n < 2; ++n) { const f32x4 v = acc[ai][bj][m][n]; *(f32x4*)(out + off + bj * HALF + n * 16) = v;
                        ss += (v[0] * v[0] + v[1] * v[1]) + (v[2] * v[2] + v[3] * v[3]); u32x2e w; w.x = cvt_pk_bf16(v[0], v[1]); w.y = cvt_pk_bf16(v[2], v[3]); *(u32x2e*)(hn + off + bj * HALF + n * 16) = w; }
                ss += __shfl_xor(ss, 16); ss += __shfl_xor(ss, 32);
                if (fq == 0) ssp[(size_t)row * 16 + u.pn * 4 + wc] = ss; }
    }
};
constexpr int RSTD_TAB_OFF = STAGE_BYTES;
template <class Sched> __device__ __forceinline__ void fill_rstd_table(PG8_LAS unsigned char* lds, const Sched& S, const float* ssp, int tid) {
    PG8_LAS float* tab = (PG8_LAS float*)(lds + RSTD_TAB_OFF); Unit u;
    for (int i = 0; S.next(i, u); ++i)
        if (tid < 256) { const int row = u.pm * BM + tid; const f32x4* p = (const f32x4*)(ssp + (size_t)row * 16); const f32x4 a = p[0], b = p[1], c = p[2], d = p[3];
            const float s = (((a[0] + a[1]) + (a[2] + a[3])) + ((b[0] + b[1]) + (b[2] + b[3]))) + (((c[0] + c[1]) + (c[2] + c[3])) + ((d[0] + d[1]) + (d[2] + d[3])));
            tab[i * 256 + tid] = 1.0f / sqrtf(s * (1.0f / 1024.0f) + 1e-6f); }
    __syncthreads();
}
struct EpiStoreBf16R {
    static constexpr bool PERM = true, AFTER_DRAIN = false, ACC_INIT = false;
    bf16_t* O; int ldc; const PG8_LAS float* tab;
    __device__ __forceinline__ void operator()(const f32x4 (&acc)[2][2][4][2], const Unit& u, int wr, int wc, int fr, int fq) const {
        const int row0 = u.pm * BM + wr * 64 + fr, col0 = u.pn * BM + wc * 32 + 8 * fq;
#pragma unroll
        for (int ai = 0; ai < 2; ++ai)
#pragma unroll
            for (int m = 0; m < 4; ++m) { const int row = row0 + ai * HALF + m * 16; const float r = tab[u.ord * 256 + wr * 64 + fr + ai * HALF + m * 16]; bf16_t* rowp = O + (size_t)row * ldc + col0;
#pragma unroll
                for (int bj = 0; bj < 2; ++bj) { const f32x4 v0 = acc[ai][bj][m][0] * r, v1 = acc[ai][bj][m][1] * r;
                    u32x4 w; w.x = cvt_pk_bf16(v0[0], v0[1]); w.y = cvt_pk_bf16(v0[2], v0[3]); w.z = cvt_pk_bf16(v1[0], v1[1]); w.w = cvt_pk_bf16(v1[2], v1[3]);
                    *(u32x4*)(rowp + bj * HALF) = w; } }
    }
};
struct EpiSwigluR {
    static constexpr bool PERM = true, AFTER_DRAIN = false, ACC_INIT = false;
    bf16_t* C; int ldc; const PG8_LAS float* tab;
    __device__ __forceinline__ void operator()(const f32x4 (&acc)[2][2][4][2], const Unit& u, int wr, int wc, int fr, int fq) const {
        const int row0 = u.pm * BM + wr * 64 + fr, col0 = u.pn * HALF + wc * 32 + 8 * fq;
#pragma unroll
        for (int ai = 0; ai < 2; ++ai)
#pragma unroll
            for (int m = 0; m < 4; ++m) { const int row = row0 + ai * HALF + m * 16; const float r = tab[u.ord * 256 + wr * 64 + fr + ai * HALF + m * 16]; bf16_t* rowp = C + (size_t)row * ldc + col0;
                const f32x4 g0 = acc[ai][0][m][0] * r, g1 = acc[ai][0][m][1] * r, u0 = acc[ai][1][m][0] * r, u1 = acc[ai][1][m][1] * r;
                u32x4 w; w.x = cvt_pk_bf16(silu_f(g0[0]) * u0[0], silu_f(g0[1]) * u0[1]); w.y = cvt_pk_bf16(silu_f(g0[2]) * u0[2], silu_f(g0[3]) * u0[3]);
                w.z = cvt_pk_bf16(silu_f(g1[0]) * u1[0], silu_f(g1[1]) * u1[1]); w.w = cvt_pk_bf16(silu_f(g1[2]) * u1[2], silu_f(g1[3]) * u1[3]);
                *(u32x4*)rowp = w; }
    }
};
__device__ __forceinline__ unsigned pk4_fp8(float a, float b, float c, float d) { int w = __builtin_amdgcn_cvt_pk_fp8_f32(a, b, 0, false); w = __builtin_amdgcn_cvt_pk_fp8_f32(c, d, w, true); return (unsigned)w; }
struct EpiSwiglu8 {
    static constexpr bool PERM = true, AFTER_DRAIN = false, ACC_INIT = false;
    unsigned char* C; int ldc; float isc, osc;
    __device__ __forceinline__ void operator()(const f32x4 (&acc)[2][2][4][2], const Unit& u, int wr, int wc, int fr, int fq) const {
        const int row0 = u.pm * BM + wr * 64 + fr, col0 = u.pn * HALF + wc * 32 + 8 * fq; const float us = isc * osc;
#pragma unroll
        for (int ai = 0; ai < 2; ++ai)
#pragma unroll
            for (int m = 0; m < 4; ++m) { unsigned char* rowp = C + (size_t)(row0 + ai * HALF + m * 16) * ldc + col0;
                const f32x4 g0 = acc[ai][0][m][0] * isc, g1 = acc[ai][0][m][1] * isc, u0 = acc[ai][1][m][0] * us, u1 = acc[ai][1][m][1] * us;
                typedef unsigned u32x2e __attribute__((ext_vector_type(2))); u32x2e w;
                w.x = pk4_fp8(silu_f(g0[0]) * u0[0], silu_f(g0[1]) * u0[1], silu_f(g0[2]) * u0[2], silu_f(g0[3]) * u0[3]);
                w.y = pk4_fp8(silu_f(g1[0]) * u1[0], silu_f(g1[1]) * u1[1], silu_f(g1[2]) * u1[2], silu_f(g1[3]) * u1[3]);
                *(u32x2e*)rowp = w; }
    }
};
struct MoeOrder {
    StaticOrder so; int tlo, nN, a_off; const int* tilee;
    __device__ void init(int nrt, int nN_, int G, int c, int tlo_, int a_off_, const int* tilee_, int wgm = 4) { so.init(nrt * BM, nN_ * BM, G, c, wgm); tlo = tlo_; nN = nN_; a_off = a_off_; tilee = tilee_; }
    __device__ bool next(int i, Unit& u) const { if (!so.next(i, u)) return false; u.pm += tlo; u.pa = u.pm - a_off; const int e = __builtin_amdgcn_readfirstlane(__hip_atomic_load(tilee + u.pm, __ATOMIC_RELAXED, __HIP_MEMORY_SCOPE_AGENT)); u.pb = e * nN + u.pn; return true; }
    __device__ __forceinline__ void a_ready(const Unit&) const {}
    __device__ __forceinline__ void done(const Unit&) const {}
};

struct MoeTailOrder {
    int t0, ntail, nN, S, G, c, kbytes; const int* tilee;
    __device__ bool next(int i, Unit& u) const {
        const int L = i * G + c; if (L >= ntail * nN * S) return false;
        const int piece = L % S, q = L / S, pn = q % nN, tl = q / nN;
        u.pm = t0 + tl; u.pn = pn; u.pa = u.pm; const int e = __builtin_amdgcn_readfirstlane(__hip_atomic_load(tilee + u.pm, __ATOMIC_RELAXED, __HIP_MEMORY_SCOPE_AGENT));
        u.pb = e * nN + pn; u.ord = tl * S + piece; u.koff = piece * kbytes; return true; }
    __device__ __forceinline__ void a_ready(const Unit&) const {}
    __device__ __forceinline__ void done(const Unit&) const {}
};
struct EpiPartF32 {
    static constexpr bool PERM = false, AFTER_DRAIN = false, ACC_INIT = false;
    float* part;
    __device__ __forceinline__ void operator()(const f32x4 (&acc)[2][2][4][2], const Unit& u, int wr, int wc, int fr, int fq) const {
        const int row0 = wr * 64 + fr, col0 = u.pn * BM + wc * 32 + 4 * fq; float* base = part + (size_t)u.ord * 256 * 1024;
#pragma unroll
        for (int ai = 0; ai < 2; ++ai)
#pragma unroll
            for (int m = 0; m < 4; ++m) { const size_t off = (size_t)(row0 + ai * HALF + m * 16) * 1024 + col0;
#pragma unroll
                for (int bj = 0; bj < 2; ++bj)
#pragma unroll
                    for (int n = 0; n < 2; ++n) *(f32x4*)(base + off + bj * HALF + n * 16) = acc[ai][bj][m][n]; }
    }
};
}

__device__ __forceinline__ void cvt_item(const float* W, int K, int N, bf16* WT, int mode, int item, float* scr, int lane, const float* gk = nullptr) {
    const int nblk = N / 32, kb = item / nblk, nb = item % nblk, k0 = 64 * kb, n0 = 32 * nb;
    { f32x4 v[8]; const float* src = W + (size_t)(k0 + (lane >> 3)) * N + n0 + 4 * (lane & 7);
#pragma unroll
      for (int i = 0; i < 8; ++i) v[i] = __builtin_nontemporal_load((const f32x4*)(src + (size_t)(8 * i) * N));
#pragma unroll
      for (int i = 0; i < 8; ++i) { float* d = scr + (8 * i + (lane >> 3)) * 33 + 4 * (lane & 7); const float gg = gk ? gk[k0 + 8 * i + (lane >> 3)] : 1.0f; d[0] = v[i].x * gg; d[1] = v[i].y * gg; d[2] = v[i].z * gg; d[3] = v[i].w * gg; } }
    LDS_WAIT();
    const int c = lane & 7;
#pragma unroll
    for (int j = 0; j < 4; ++j) {
        const int n = (lane >> 3) + 8 * j; const float* s = scr + (8 * c) * 33 + n;
        u32x4 o; o.x = pk2(s[0 * 33], s[1 * 33]); o.y = pk2(s[2 * 33], s[3 * 33]); o.z = pk2(s[4 * 33], s[5 * 33]); o.w = pk2(s[6 * 33], s[7 * 33]);
        const int nn = n0 + n; const int drow = mode == 0 ? nn : ((nn >> 7) * 256 + (nn & 127) + (mode == 2 ? 128 : 0));
        *(u32x4*)(WT + (size_t)drow * K + k0 + 8 * c) = o;
    }
    LDS_WAIT();
}

__device__ __forceinline__ void cvt_item8(const float* W, int K, int N, unsigned char* WT, int mode, int item, float* scr, int lane, float scale) {
    const int nblk = N / 32, kb = item / nblk, nb = item % nblk, k0 = 128 * kb, n0 = 32 * nb;
    { f32x4 v[16]; const float* src = W + (size_t)(k0 + (lane >> 3)) * N + n0 + 4 * (lane & 7);
#pragma unroll
      for (int i = 0; i < 16; ++i) v[i] = __builtin_nontemporal_load((const f32x4*)(src + (size_t)(8 * i) * N));
#pragma unroll
      for (int i = 0; i < 16; ++i) { float* d = scr + (8 * i + (lane >> 3)) * 33 + 4 * (lane & 7); d[0] = v[i].x * scale; d[1] = v[i].y * scale; d[2] = v[i].z * scale; d[3] = v[i].w * scale; } }
    LDS_WAIT();
    const int c = lane & 7;
#pragma unroll
    for (int j = 0; j < 4; ++j) {
        const int n = (lane >> 3) + 8 * j; const float* s = scr + (16 * c) * 33 + n;
        u32x4 o; o.x = pg8::pk4_fp8(s[0 * 33], s[1 * 33], s[2 * 33], s[3 * 33]); o.y = pg8::pk4_fp8(s[4 * 33], s[5 * 33], s[6 * 33], s[7 * 33]);
        o.z = pg8::pk4_fp8(s[8 * 33], s[9 * 33], s[10 * 33], s[11 * 33]); o.w = pg8::pk4_fp8(s[12 * 33], s[13 * 33], s[14 * 33], s[15 * 33]);
        const int nn = n0 + n; const int drow = mode == 0 ? nn : ((nn >> 7) * 256 + (nn & 127) + (mode == 2 ? 128 : 0));
        __builtin_nontemporal_store(o, (u32x4*)(WT + (size_t)drow * K + k0 + 16 * c));
    }
    LDS_WAIT();
}

__device__ __forceinline__ void rms_row_bf16(const float* xrow, const float* g, bf16* orow, int lane) {
    const f32x4* xr = (const f32x4*)xrow; const f32x4* gr = (const f32x4*)g;
    f32x4 v[4]; float s = 0.f;
#pragma unroll
    for (int j = 0; j < 4; ++j) { v[j] = xr[lane + 64 * j]; s += (v[j].x * v[j].x + v[j].y * v[j].y) + (v[j].z * v[j].z + v[j].w * v[j].w); }
    const float r = 1.0f / sqrtf(wave_sum(s) * (1.0f / D) + 1e-6f);
    u32x2* o8 = (u32x2*)orow;
#pragma unroll
    for (int j = 0; j < 4; ++j) { const f32x4 gv = gr[lane + 64 * j]; u32x2 w; w.x = pk2(v[j].x * r * gv.x, v[j].y * r * gv.y); w.y = pk2(v[j].z * r * gv.z, v[j].w * r * gv.w); o8[lane + 64 * j] = w; }
}

#define LAS __attribute__((address_space(3)))
#define XB_TMO      128
#define XB_XCNT(j)  (256  + 64 * (j))
#define XB_XSUB(j)  (1280 + 64 * (j))
#define XB_XGEN(j)  (2304 + 64 * (j))
#define XB_TOP      3328
#define XB_TOPGEN   3392
#define XCD_BAR_WORDS 3456
#define XB_SPIN_CAP (1u << 22)
__device__ __forceinline__ unsigned xb_ld(unsigned* p)              { return __hip_atomic_load(p, __ATOMIC_RELAXED, __HIP_MEMORY_SCOPE_AGENT); }
__device__ __forceinline__ unsigned xb_add(unsigned* p, unsigned v) { return __hip_atomic_fetch_add(p, v, __ATOMIC_RELAXED, __HIP_MEMORY_SCOPE_AGENT); }
__device__ __forceinline__ unsigned xb_xcc_id() { return (unsigned)__builtin_amdgcn_s_getreg((3 << 11) | 20) & 0xFu; }
#define XB_SPIN(cond, bar) do { unsigned _sp = 0; while (cond) { __builtin_amdgcn_s_sleep(1); \
    if ((++_sp & 255u) == 0u) { if (xb_ld(&(bar)[XB_TMO])) break; if (_sp > XB_SPIN_CAP) { atomicAdd(&(bar)[XB_TMO], 1u); break; } } } } while (0)
struct XcdBarrier { unsigned* bar; unsigned x; volatile LAS unsigned* st; };
__device__ __forceinline__ XcdBarrier xcd_barrier_post(unsigned* bar, volatile LAS unsigned* st) {
    XcdBarrier b; b.bar = bar; b.x = xb_xcc_id(); b.st = st;
    if (threadIdx.x == 0) (void)xb_add(&bar[XB_XCNT(b.x)], 1u);
    return b;
}
__device__ __forceinline__ void xcd_barrier_complete(unsigned* bar, unsigned x, unsigned& nloc, unsigned& nx) {
    const unsigned G = gridDim.x * gridDim.y * gridDim.z;
    unsigned sum, cnt, mine, sp = 0u;
    for (;;) {
        sum = 0u; cnt = 0u; mine = 0u;
#pragma unroll
        for (unsigned j = 0; j < 16; ++j) { const unsigned c = xb_ld(&bar[XB_XCNT(j)]); sum += c; cnt += (c > 0u) ? 1u : 0u; mine = (j == x) ? c : mine; }
        if (sum == G) break;
        __builtin_amdgcn_s_sleep(1);
        if ((++sp & 255u) == 0u) { if (xb_ld(&bar[XB_TMO])) break; if (sp > XB_SPIN_CAP) { atomicAdd(&bar[XB_TMO], 1u); break; } }
    }
    nloc = mine > 0u ? mine : 1u; nx = cnt > 0u ? cnt : 1u;
}
__device__ __forceinline__ void xcd_arrive(const XcdBarrier& b, bool leader) {
    asm volatile("s_waitcnt vmcnt(0)" ::: "memory");
    __syncthreads();
    if (leader) {
        unsigned* bar = b.bar;
        __builtin_amdgcn_s_waitcnt(0);
        unsigned nloc = b.st[0], nx = b.st[1];
        if (nloc == 0u) { xcd_barrier_complete(bar, b.x, nloc, nx); b.st[0] = nloc; b.st[1] = nx; }
        const unsigned old = xb_add(&bar[XB_XSUB(b.x)], 1u);
        const unsigned gen = old / nloc;
        b.st[2] = gen; b.st[3] = 0u;
        if (old + 1u == (gen + 1u) * nloc) {
            __builtin_amdgcn_fence(__ATOMIC_RELEASE, "agent");
            asm volatile("s_waitcnt vmcnt(0)" ::: "memory");
            const unsigned og = xb_add(&bar[XB_TOP], 1u);
            const unsigned tg = og / nx;
            b.st[4] = tg; b.st[3] = 1u;
            if (og + 1u == (tg + 1u) * nx) { xb_add(&bar[XB_TOPGEN], 1u); b.st[3] = 2u; }
        }
    }
}
__device__ __forceinline__ void xcd_wait(const XcdBarrier& b, bool leader) {
    if (leader) {
        unsigned* bar = b.bar; const unsigned gen = b.st[2], role = b.st[3], tg = b.st[4];
        if (role >= 1u) {
            if (role == 1u) XB_SPIN(xb_ld(&bar[XB_TOPGEN]) == tg, bar);
            __builtin_amdgcn_fence(__ATOMIC_ACQUIRE, "agent");
            xb_add(&bar[XB_XGEN(b.x)], 1u);
            asm volatile("s_waitcnt vmcnt(0)" ::: "memory");
        } else {
            XB_SPIN(xb_ld(&bar[XB_XGEN(b.x)]) == gen, bar);
            __builtin_amdgcn_fence(__ATOMIC_ACQUIRE, "agent");
            asm volatile("s_waitcnt vmcnt(0)" ::: "memory");
        }
    }
    __syncthreads();
}
__device__ __forceinline__ void xcd_barrier(const XcdBarrier& b, bool leader) { xcd_arrive(b, leader); xcd_wait(b, leader); }
constexpr int LDS_BYTES = 163840, RING_BYTES = LDS_BYTES - 512, MISC_OFF = RING_BYTES + 320;
constexpr int CW_BAR = 4096;

enum Phase { PH_PROLOGUE = 0, PH_INPROJ, PH_MIX1, PH_MIX2, PH_MIX3, PH_OUTPROJ, PH_NORM, PH_FFNUP, PH_FFNDOWN, PH_DISPATCH, PH_MOEUP, PH_MOEDOWN, PH_FINAL };


constexpr int PQ_OFF = 97792;
constexpr int RS = 528;
constexpr int AINB_STRIDE = RS;
constexpr int VTS = 144;
template <int NLD> __device__ __forceinline__ void slab_load(u32x4 (&reg)[NLD], const bf16* src, int nrows, int rvalid0, int tid) {
#pragma unroll
    for (int j = 0; j < NLD; ++j) { const int i = tid + j * NT, r = i >> 5, ch = i & 31; reg[j] = (u32x4){0u, 0u, 0u, 0u}; if (i < nrows * 32 && r >= rvalid0) reg[j] = *(const u32x4*)(src + (ptrdiff_t)r * DIN + ch * 8); }
}
template <int NLD> __device__ __forceinline__ void slab_store(const u32x4 (&reg)[NLD], unsigned char* dst, int nrows, int tid) {
#pragma unroll
    for (int j = 0; j < NLD; ++j) { const int i = tid + j * NT, r = i >> 5, ch = i & 31; if (i < nrows * 32) *(u32x4*)(dst + r * RS + ch * 16) = reg[j]; }
}
__device__ __forceinline__ void ytile_store(const unsigned char* src, bf16* y, int tid) {
    asm volatile("" : "+v"(tid) :: "memory");
#pragma unroll
    for (int j = 0; j < 4; ++j) { const int i = tid + j * NT, r = i >> 5, ch = i & 31; *(u32x4*)(y + (size_t)r * D + ch * 8) = *(const u32x4*)(src + r * RS + ch * 16); }
}
__device__ __forceinline__ int vt_off(int c, int tok) { return c * VTS + ((tok ^ (((c >> 3) & 7) << 3)) << 1); }
__device__ __forceinline__ void vt_store(const u32x4 (&reg)[4], unsigned char* vt, int tid) {
#pragma unroll
    for (int j = 0; j < 4; ++j) { const int i = tid + j * NT, r = i >> 5, ch = i & 31, c0 = ch * 8; const unsigned w[4] = {reg[j].x, reg[j].y, reg[j].z, reg[j].w};
#pragma unroll
        for (int q = 0; q < 8; ++q) *(bf16*)(vt + vt_off(c0 + q, r)) = (bf16)((q & 1) ? (w[q >> 1] >> 16) : (w[q >> 1] & 0xffffu)); }
}
struct LruParams { bf16x8 wa[2], wx[2]; float lam, ba, bx, cb, cw[4]; };
__device__ __forceinline__ void lru_params_load(LruParams& p, const bf16* wta, const bf16* wtx, const float* conv_w, const float* conv_b, const float* b_a, const float* b_x, const float* lam, int h, int nt, int lane) {
    asm volatile("" : "+v"(lane));
    const int fr = lane & 15, fq = lane >> 4, c = 64 * h + 16 * nt + fr;
#pragma unroll
    for (int ks = 0; ks < 2; ++ks) { p.wa[ks] = *(const bf16x8*)(wta + (size_t)(h * 64 + 16 * nt + fr) * 64 + 32 * ks + 8 * fq); p.wx[ks] = *(const bf16x8*)(wtx + (size_t)(h * 64 + 16 * nt + fr) * 64 + 32 * ks + 8 * fq); }
    p.lam = lam[c]; p.ba = b_a[c]; p.bx = b_x[c]; p.cb = conv_b[c];
#pragma unroll
    for (int k = 0; k < 4; ++k) p.cw[k] = conv_w[k * GW + c];
}
__device__ __forceinline__ void lru_ainb(const unsigned char* ax, const float* conv_w, const float* conv_b, unsigned char* ainb, int tid) {
    for (int idx = tid; idx < CH * 128; idx += NT) {
        const int t = idx >> 7, c = (idx & 127) * 2; float a0 = conv_b[c], a1 = conv_b[c + 1];
#pragma unroll
        for (int k = 0; k < 4; ++k) { const unsigned w = *(const unsigned*)(ax + (t + k) * RS + c * 2); a0 += conv_w[k * GW + c] * bf2f(w & 0xffffu); a1 += conv_w[k * GW + c + 1] * bf2f(w >> 16); }
        *(unsigned*)(ainb + t * RS + c * 2) = pk2(a0, a1);
    }
}
__device__ __forceinline__ void lru_gates(const unsigned char* ainb, const unsigned char* ax, const LruParams& p, int h, int nt, int lane, float (&av)[4][4], float (&uv)[4][4]) {
    const int fr = lane & 15, fq = lane >> 4, c = 64 * h + 16 * nt + fr;
    f32x4 aa[4], ax4[4];
#pragma unroll
    for (int mt = 0; mt < 4; ++mt) { aa[mt] = (f32x4){0.f, 0.f, 0.f, 0.f}; ax4[mt] = (f32x4){0.f, 0.f, 0.f, 0.f};
#pragma unroll
        for (int ks = 0; ks < 2; ++ks) { const bf16x8 x = *(const bf16x8*)(ainb + (16 * mt + fr) * RS + (64 * h + 32 * ks + 8 * fq) * 2);
            aa[mt] = __builtin_amdgcn_mfma_f32_16x16x32_bf16(x, p.wa[ks], aa[mt], 0, 0, 0); ax4[mt] = __builtin_amdgcn_mfma_f32_16x16x32_bf16(x, p.wx[ks], ax4[mt], 0, 0, 0); } }
    const float sp = log1pf(fexp(-p.lam));
#pragma unroll
    for (int mt = 0; mt < 4; ++mt)
#pragma unroll
        for (int r = 0; r < 4; ++r) { const int t = 16 * mt + 4 * fq + r; const float rg = sigmoidf_(aa[mt][r] + p.ba), ig = sigmoidf_(ax4[mt][r] + p.bx); const float loga = -8.0f * rg * sp;
            const float x2 = 2.0f * loga; const float m2 = x2 > -0.25f ? neg_expm1_small(x2) : -expm1f(x2);
            float xin = p.cb;
#pragma unroll
            for (int k = 0; k < 4; ++k) xin += p.cw[k] * bf2f(*(const bf16*)(ax + (t + k) * RS + c * 2));
            av[mt][r] = fexp(loga); uv[mt][r] = __builtin_amdgcn_sqrtf(fmaxf(m2, 0.f)) * ig * xin; }
}

constexpr int CW_CVTQ = 2048, CW_DONE = 8192;
constexpr int BG_IE1 = 8 * 112, BG_IE2 = 28 * 32, BG_ITEMS = 2 * NE * BG_IE1 + NE * BG_IE2, BG_BATCHES = BG_ITEMS / 8;
__device__ __forceinline__ void bg_convert(unsigned char* ws, unsigned char* lds_raw, const float* w1, const float* w3, const float* w2, int step, int G, int tid, bool drain) {
    unsigned* ctl = (unsigned*)(ws + WS_CTL); volatile unsigned* shq = (volatile unsigned*)(lds_raw + RING_BYTES);
    const int wid = tid >> 6, lane = tid & 63; float* scr = (float*)lds_raw + wid * (128 * 33);
    __syncthreads();
    if (tid == 0 && !drain) __hip_atomic_fetch_add(ctl + CW_DONE + 64 * step, 1u, __ATOMIC_RELAXED, __HIP_MEMORY_SCOPE_AGENT);
    for (;;) {
        if (tid == 0) { unsigned b = BG_BATCHES;
            if (drain || __hip_atomic_load(ctl + CW_DONE + 64 * step, __ATOMIC_RELAXED, __HIP_MEMORY_SCOPE_AGENT) + 16u < (unsigned)G) b = __hip_atomic_fetch_add(ctl + CW_CVTQ, 1u, __ATOMIC_RELAXED, __HIP_MEMORY_SCOPE_AGENT);
            shq[0] = b; }
        __syncthreads();
        const unsigned b = shq[0];
        __syncthreads();
        if (b >= (unsigned)BG_BATCHES) break;
        const int q = (int)b * 8 + wid;
        if (q < NE * BG_IE1) { const int e = q / BG_IE1, r = q % BG_IE1; cvt_item8(w1 + (size_t)e * D * DFFE, D, DFFE, ws + WS_W13 + (size_t)e * 2 * DFFE * D, 1, r, scr, lane, W13_SCALE); }
        else if (q < 2 * NE * BG_IE1) { const int q2 = q - NE * BG_IE1, e = q2 / BG_IE1, r = q2 % BG_IE1; cvt_item8(w3 + (size_t)e * D * DFFE, D, DFFE, ws + WS_W13 + (size_t)e * 2 * DFFE * D, 2, r, scr, lane, W13_SCALE); }
        else { const int q2 = q - 2 * NE * BG_IE1, e = q2 / BG_IE2, r = q2 % BG_IE2; cvt_item8(w2 + (size_t)e * DFFE * D, DFFE, D, ws + WS_W2 + (size_t)e * D * DFFE, 0, r, scr, lane, W2_SCALE); }
    }
}

__host__ __device__ __forceinline__ int moe_tail_split(int ntail) { return ntail * 4 * 7 <= 256 ? 7 : (ntail * 4 * 2 <= 256 ? 2 : 1); }

#define HN ((bf16*)(ws + WS_HN))
#define PROJ ((bf16*)(ws + WS_PROJ))
#define Y ((bf16*)(ws + WS_Y))
#define DS ((float*)(ws + WS_DS))
#define HID ((bf16*)(ws + WS_HID))
#define HIDE ((unsigned char*)(ws + WS_HIDE))
#define OUT2 ((bf16*)(ws + WS_OUT2))
#define XR ((unsigned char*)(ws + WS_XR))
#define SSP0 ((float*)(ws + WS_END))
#define SSP1 ((float*)(ws + WS_END + MiB))
#define PART ((float*)(ws + WS_END + 3 * MiB))
#define TOKROW SMALLP(int, SM_TOKROW)
#define SMALLP(T, off) ((T*)(ws + WS_SMALL + (off)))
#define RSTD SMALLP(float, SM_RSTD)
#define TOKE SMALLP(int, SM_TOKE)
#define TOKG SMALLP(float, SM_TOKG)
#define TOKR SMALLP(int, SM_TOKR)
#define BCNT SMALLP(int, SM_BCNT)
#define ROWDST SMALLP(int, SM_ROWDST)
#define ROWG SMALLP(float, SM_ROWG)
#define TILEE SMALLP(int, SM_TILEE)
#define CARA SMALLP(float, SM_CARA)
#define CARH SMALLP(float, SM_CARH)
#define CIN SMALLP(float, SM_CIN)
#define DEC SMALLP(float, SM_DEC)
#define WTA SMALLP(bf16, SM_WTA)
#define WTX SMALLP(bf16, SM_WTX)
#define WTP SMALLP(bf16, SM_WTP)
#define PHASE_ENTER int tid = wid_s * 64 + lane_id_asm(); asm volatile("" : "+v"(tid)); const int lane = tid & 63, wid = tid >> 6; __attribute__((address_space(1))) unsigned char* wsg_ = (__attribute__((address_space(1))) unsigned char*)a.ws; asm volatile("" : "+s"(wsg_)); unsigned char* ws = (unsigned char*)wsg_; \
    __attribute__((address_space(1))) float* hresg_ = (__attribute__((address_space(1))) float*)a.out; asm volatile("" : "+s"(hresg_)); float* hres = (float*)hresg_; \
    int bid = blockIdx.x; asm volatile("" : "+s"(bid)); int G = gridDim.x; asm volatile("" : "+s"(G)); (void)lane; (void)wid; (void)hres; (void)bid; (void)G;

__global__ void __launch_bounds__(NT) fwd(Args a) {
    extern __shared__ __attribute__((aligned(16))) unsigned char lds_raw[];
    float* ldsf = (float*)lds_raw;
    const int wid_s = __builtin_amdgcn_readfirstlane(threadIdx.x >> 6);
    { const int tid0 = threadIdx.x; for (int u = tid0; u < (LDS_BYTES - RING_BYTES) / 4; u += NT) ((LAS unsigned*)((LAS unsigned char*)lds_raw + RING_BYTES))[u] = 0u; }
    __syncthreads();
    XcdBarrier bar = xcd_barrier_post((unsigned*)(a.ws + WS_CTL) + CW_BAR, (volatile LAS unsigned*)((LAS unsigned char*)lds_raw + MISC_OFF) + 8);

#ifdef REP_STEP
    int rep_left = REP_N;
#endif
    for (int step = a.ph_lo; step < a.ph_hi; ++step) {
#ifdef REP_STEP
    const bool dry = (step == REP_STEP && rep_left > 0);
#else
    constexpr bool dry = false;
#endif
    int phase, L, pass = 0; (void)pass;
    if (step == 0) { phase = PH_PROLOGUE; L = 0; }
    else if (step < 6) { L = 0; const int s = step - 1; phase = s == 0 ? PH_INPROJ : s == 1 ? PH_MIX1 : s == 2 ? PH_OUTPROJ : s == 3 ? PH_FFNUP : PH_FFNDOWN; }
    else { L = 1; const int s = step - 6; phase = s == 0 ? PH_INPROJ : s == 1 ? PH_MIX1 : s == 2 ? PH_OUTPROJ : s == 3 ? PH_NORM : s == 4 ? PH_MOEUP : s == 5 ? PH_MOEDOWN : PH_FINAL; }
#ifdef REP_NOP
    if (dry) phase = 1000;
#endif
    switch (phase) {
    case PH_PROLOGUE: {
        PHASE_ENTER
        float* scr = ldsf + wid * (128 * 33);
        const int gw = bid * 8 + wid, NGW = G * 8;
        constexpr int I_IN = 16 * 80, I_OUT = 16 * 32, I_G = 16 * 88, I_D = 44 * 32;
        constexpr int T0 = 2 * I_IN, T1 = T0 + 2 * I_OUT, T2 = T1 + I_G, T3 = T2 + I_G, T4 = T3 + I_D;
        for (int it = gw; it < T4; it += NGW) {
            if (it < T0) { const int l = it / I_IN, r = it % I_IN; cvt_item(IN(1) + (size_t)l * D * DIN, D, DIN, (bf16*)(ws + WS_WIN) + (size_t)l * DIN * D, 0, r, scr, lane, l == 1 ? IN(15) + D : nullptr); }
            else if (it < T1) { const int q = it - T0, l = q / I_OUT, r = q % I_OUT; cvt_item(IN(2) + (size_t)l * D * D, D, D, (bf16*)(ws + WS_WOUT) + (size_t)l * D * D, 0, r, scr, lane); }
            else if (it < T2) { cvt_item(IN(17), D, DFF, (bf16*)(ws + WS_WGU), 1, it - T1, scr, lane, IN(16)); }
            else if (it < T3) { cvt_item(IN(18), D, DFF, (bf16*)(ws + WS_WGU), 2, it - T2, scr, lane, IN(16)); }
            else { cvt_item(IN(19), DFF, D, (bf16*)(ws + WS_WD), 0, it - T3, scr, lane); }
        }
        for (int m = gw; m < NTOK; m += NGW) rms_row_bf16(IN(0) + (size_t)m * D, IN(15), HN + (size_t)m * D, lane);
        for (int idx = bid * NT + tid; idx < 3 * 2 * 4 * HD * HD; idx += G * NT) {
            const int mat = idx / (2 * 4 * HD * HD), r = idx % (2 * 4 * HD * HD), lh = r >> 12, j = (r >> 6) & 63, i = r & 63;
            const float* w = mat == 0 ? IN(5) : mat == 1 ? IN(7) : IN(12);
            (mat == 0 ? WTA : mat == 1 ? WTX : WTP)[r] = (bf16)f2bf(w[(lh * 64 + i) * 64 + j]);
        }
    } break;

    case PH_INPROJ: {
        PHASE_ENTER
        pg8::Gemm g{HN, (const bf16*)(ws + WS_WIN) + (size_t)L * DIN * D, NTOK, DIN, D, 0}; pg8::StaticOrder S; S.init(NTOK, DIN, G, bid);
        if (L == 0) { pg8::EpiStoreBf16 E{PROJ, DIN}; pg8::gemm_phase<pg8::EpiStoreBf16, pg8::StaticOrder, true, true>((PG8_LAS unsigned char*)lds_raw, g, S, E, tid); }
        else { pg8::fill_rstd_table((PG8_LAS unsigned char*)lds_raw, S, SSP1, tid); pg8::EpiStoreBf16R E{PROJ, DIN, (const PG8_LAS float*)((PG8_LAS unsigned char*)lds_raw + pg8::RSTD_TAB_OFF)}; pg8::gemm_phase<pg8::EpiStoreBf16R, pg8::StaticOrder, true, true>((PG8_LAS unsigned char*)lds_raw, g, S, E, tid); }
    } break;

    case PH_MIX1: {
        PHASE_ENTER
        {
        const float* conv_w = IN(3) + L * 4 * GW; const float* conv_b = IN(4) + L * GW;
        const float* b_a = IN(6) + L * GW; const float* b_x = IN(8) + L * GW;
        const float* lam = IN(9) + L * GW; const float* lbp = IN(10);
        unsigned char* AX = lds_raw; unsigned char* AINB = lds_raw + 35376;
        unsigned char* FS = lds_raw; unsigned char* KHTl = lds_raw; unsigned char* VTl = lds_raw + 36864; float* TOTl = (float*)(lds_raw + 73728);
        unsigned* PQ = (unsigned*)(lds_raw + PQ_OFF);
        for (int ci = bid; ci < NCHUNK; ci += G) {
            const int t0 = (ci % CPB) * CH, g0 = ci * CH; const bf16* prow = PROJ + (size_t)g0 * DIN;
            LruParams lp[2];
#pragma unroll
            for (int cc = 0; cc < 2; ++cc) lru_params_load(lp[cc], WTA + L * 16384, WTX + L * 16384, conv_w, conv_b, b_a, b_x, lam, wid >> 1, 2 * (wid & 1) + cc, lane);
            int lbi = 64 * (wid >> 1) + lane; asm volatile("" : "+v"(lbi)); const float lbv = L == 0 ? 0.f : sigmoidf_(lbp[GW + lbi] - lbp[lbi]);
            u32x4 rf[4], rv[4];
            {
                u32x4 rax[5];
                int tl1 = tid; asm volatile("" : "+v"(tl1) :: "memory");
                slab_load<5>(rax, prow - 3 * DIN, 67, t0 == 0 ? 3 : 0, tl1);
                slab_store<5>(rax, AX, 67, tid);
            }
            __syncthreads();
            lru_ainb(AX, conv_w, conv_b, AINB, tid);
            __syncthreads();
#pragma unroll
            for (int cc = 0; cc < 2; ++cc) {
                const int h = wid >> 1, nt = 2 * (wid & 1) + cc, fr = lane & 15, fq = lane >> 4, c = 64 * h + 16 * nt + fr; float av[4][4], uv[4][4];
                lru_gates(AINB, AX, lp[cc], h, nt, lane, av, uv);
                float Pin = 1.f, Qin = 0.f;
#pragma unroll
                for (int mt = 0; mt < 4; ++mt) {
                    float Ai[4], Hi[4]; float A_ = 1.f, H_ = 0.f;
#pragma unroll
                    for (int r = 0; r < 4; ++r) { H_ = av[mt][r] * H_ + uv[mt][r]; A_ *= av[mt][r]; Ai[r] = A_; Hi[r] = H_; }
                    const float a1 = __shfl_up(A_, 16), h1 = __shfl_up(H_, 16), a2 = __shfl_up(A_, 32), h2 = __shfl_up(H_, 32), a3 = __shfl_up(A_, 48), h3 = __shfl_up(H_, 48);
                    float EA = 1.f, EH = 0.f;
                    if (fq >= 3) { EA = a3; EH = h3; }
                    if (fq >= 2) { EH = a2 * EH + h2; EA *= a2; }
                    if (fq >= 1) { EH = a1 * EH + h1; EA *= a1; }
                    float Pt[4], Qt[4];
#pragma unroll
                    for (int r = 0; r < 4; ++r) { const float al = Ai[r] * EA, be = Ai[r] * EH + Hi[r]; Pt[r] = al * Pin; Qt[r] = al * Qin + be; PQ[(16 * mt + 4 * fq + r) * 256 + c] = pk2(Pt[r], Qt[r]); }
                    Pin = __shfl(Pt[3], 48 + fr); Qin = __shfl(Qt[3], 48 + fr);
                }
                if (lane < 16) { CARA[ci * GW + c] = Pin; CARH[ci * GW + c] = Qin; }
                if (cc == 0) { int tl2 = tid; asm volatile("" : "+v"(tl2) :: "memory"); slab_load<4>(rf, prow + 768, 64, 0, tl2); slab_load<4>(rv, prow + 1024, 64, 0, tl2); }
            }
            __syncthreads();
            slab_store<4>(rf, FS, 64, tid); vt_store(rv, VTl, tid);
            __syncthreads();
            {
                const int h = wid >> 1, half = wid & 1, c = 64 * h + lane, fr = lane & 15, fq = lane >> 4;
                const float lb = lbv;
                float gl[32], kk[32]; float run = 0.f;
#pragma unroll
                for (int t = 0; t < 32; ++t) { const float sg = sigmoidf_(bf2f(*(const bf16*)(FS + (32 * half + t) * RS + c * 2))); run += flog(lb + (1.f - lb) * sg); gl[t] = run; kk[t] = (1.f - lb) * (1.f - sg); }
                TOTl[(h * 2 + half) * 64 + lane] = run;
                __syncthreads();
                const float tot0 = TOTl[(h * 2) * 64 + lane], glast = tot0 + TOTl[(h * 2 + 1) * 64 + lane], off = half ? tot0 : 0.f;
#pragma unroll
                for (int j = 0; j < 4; ++j) { float e[8];
#pragma unroll
                    for (int q = 0; q < 8; ++q) e[q] = kk[8 * j + q] * fexp(glast - (off + gl[8 * j + q]));
                    u32x4 w; w.x = pk2(e[0], e[1]); w.y = pk2(e[2], e[3]); w.z = pk2(e[4], e[5]); w.w = pk2(e[6], e[7]);
                    *(u32x4*)(KHTl + c * VTS + (32 * half + 8 * j) * 2) = w; }
                if (half) DEC[(ci * 4 + h) * 64 + lane] = fexp(glast);
                __syncthreads();
#pragma unroll
                for (int vvv = 0; vvv < 2; ++vvv) {
                    const int vt = 2 * half + vvv, vrow = 64 * h + 16 * vt + fr; bf16x8 bv[2];
#pragma unroll
                    for (int ks = 0; ks < 2; ++ks) bv[ks] = *(const bf16x8*)(VTl + vt_off(vrow, 32 * ks + 8 * fq));
#pragma unroll
                    for (int kt = 0; kt < 4; ++kt) { f32x4 acc = (f32x4){0.f, 0.f, 0.f, 0.f};
#pragma unroll
                        for (int ks = 0; ks < 2; ++ks) { const bf16x8 ka = *(const bf16x8*)(KHTl + (64 * h + 16 * kt + fr) * VTS + (32 * ks + 8 * fq) * 2); acc = __builtin_amdgcn_mfma_f32_16x16x32_bf16(ka, bv[ks], acc, 0, 0, 0); }
                        *(f32x4*)(DS + ((size_t)(ci * 4 + h) * 64 + 16 * vt + fr) * 64 + 16 * kt + 4 * fq) = acc; }
                }
                __syncthreads();
            }
        }
        }
        xcd_arrive(bar, tid == 0);
        {
        const float* conv_w = IN(3) + L * 4 * GW; const float* conv_b = IN(4) + L * GW; const float* b_a = IN(6) + L * GW; const float* b_x = IN(8) + L * GW; const float* lam = IN(9) + L * GW;
        const float* lbp = IN(10); const float* norm_g = IN(11) + L * HD; const float* pool_s = IN(13) + L * GW; const float* sconv_w = IN(14) + L * 3 * GW;
        unsigned char* AX = lds_raw; unsigned char* AG = lds_raw + 35376; unsigned char* AINB = lds_raw + 69168;
        unsigned char* QT3 = lds_raw; unsigned char* KT3 = lds_raw + 33792; unsigned char* OG3 = lds_raw + 67584; unsigned char* VT3 = lds_raw + 101376; float* TOT3 = (float*)(lds_raw + 138240);
        unsigned char* PS = lds_raw; unsigned char* DIMG = lds_raw + 41712; unsigned char* YST = lds_raw;
        unsigned char* SB = lds_raw; unsigned char* SC = lds_raw + 33792; unsigned char* SX = lds_raw + 68640;
        for (int ci = bid; ci < NCHUNK; ci += G) {
            const int t0 = (ci % CPB) * CH, g0 = ci * CH; const bf16* prow = PROJ + (size_t)g0 * DIN; bf16* yrow = Y + (size_t)g0 * D; (void)t0; (void)yrow;
            { u32x4 rp[5]; int tlc = tid; asm volatile("" : "+v"(tlc) :: "memory"); slab_load<5>(rp, prow - 15 * DIN + 1536, 79, t0 == 0 ? 15 : 0, tlc); slab_store<5>(rp, PS, 79, tid); }
            __syncthreads();
            for (int idx = tid; idx < CH * 128; idx += NT) {
                const int t = idx >> 7, c = (idx & 127) * 2, gi = c >> 6, w = 2 << gi; const int tt = t0 + t; const int cnt = (tt + 1 < w) ? (tt + 1) : w; float s0 = 0.f, s1 = 0.f; unsigned xs[16];
#pragma unroll
                for (int r = 0; r < 16; ++r) xs[r] = *(const unsigned*)(PS + (t + 15 - r) * RS + c * 2);
#pragma unroll
                for (int r = 0; r < 16; ++r) { const float m_ = r < cnt ? 1.0f : 0.0f; s0 += m_ * bf2f(xs[r] & 0xffffu); s1 += m_ * bf2f(xs[r] >> 16); }
                const float inv = __builtin_amdgcn_rcpf((float)cnt);
                *(unsigned*)(DIMG + t * RS + c * 2) = pk2(s0 * inv - bf2f(xs[0] & 0xffffu), s1 * inv - bf2f(xs[0] >> 16));
            }
            __syncthreads();
#pragma unroll 1
            for (int cc = 0; cc < 2; ++cc) {
                const int gi = wid >> 1, nt = 2 * (wid & 1) + cc, fr = lane & 15, fq = lane >> 4, c = 64 * gi + 16 * nt + fr; bf16x8 wp[2];
#pragma unroll
                for (int ks = 0; ks < 2; ++ks) wp[ks] = *(const bf16x8*)(WTP + L * 16384 + (size_t)(gi * 64 + 16 * nt + fr) * 64 + 32 * ks + 8 * fq);
                const float psc = pool_s[c];
#pragma unroll
                for (int mt = 0; mt < 4; ++mt) { f32x4 acc = (f32x4){0.f, 0.f, 0.f, 0.f};
#pragma unroll
                    for (int ks = 0; ks < 2; ++ks) { const bf16x8 x = *(const bf16x8*)(DIMG + (16 * mt + fr) * RS + (64 * gi + 32 * ks + 8 * fq) * 2); acc = __builtin_amdgcn_mfma_f32_16x16x32_bf16(x, wp[ks], acc, 0, 0, 0); }
#pragma unroll
                    for (int r = 0; r < 4; ++r) *(bf16*)(YST + (16 * mt + 4 * fq + r) * RS + c * 2) = (bf16)f2bf(acc[r] * psc); }
            }
            __syncthreads();
            ytile_store(YST, yrow + 512, tid);
            __syncthreads();
        }
        }
        xcd_wait(bar, tid == 0);
        {
        float* xa = ldsf; float* xs = ldsf + 512;
        for (int item = bid; item < 256 + 8; item += G) {
            if (item < 256) {
                const int el = tid & 127, seg = tid >> 7, e = item * 128 + el, b = e >> 14, hh = (e >> 12) & 3, kv = e & 4095, k = kv & 63;
                float dv[32], dc[32];
#pragma unroll
                for (int i = 0; i < 32; ++i) { const int ci = b * CPB + seg * 32 + i; dv[i] = DS[(size_t)(ci * 4 + hh) * 4096 + kv]; dc[i] = DEC[(ci * 4 + hh) * 64 + k]; }
                float S = 0.f, A = 1.f;
#pragma unroll
                for (int i = 0; i < 32; ++i) { const float d = dv[i]; dv[i] = S; S = dc[i] * S + d; const float a0 = dc[i]; dc[i] = A; A *= a0; }
                xa[seg * 128 + el] = A; xs[seg * 128 + el] = S;
                __syncthreads();
                float Sin = 0.f;
                for (int s2 = 0; s2 < seg; ++s2) Sin = xa[s2 * 128 + el] * Sin + xs[s2 * 128 + el];
#pragma unroll
                for (int i = 0; i < 32; ++i) { const int ci = b * CPB + seg * 32 + i; (dry ? DS + 20 * (MiB / 4) * 4 : DS)[(size_t)(ci * 4 + hh) * 4096 + kv] = dv[i] + dc[i] * Sin; }
                __syncthreads();
            } else {
                const int q = item - 256, sq = tid & 63, chg = q * 64 + sq, b = chg >> 8, c = chg & 255, seg = tid >> 6;
                float ca[16], chh[16];
#pragma unroll
                for (int i = 0; i < 16; ++i) { const int ci = b * CPB + seg * 16 + i; ca[i] = CARA[ci * GW + c]; chh[i] = CARH[ci * GW + c]; }
                float A = 1.f, H = 0.f;
#pragma unroll
                for (int i = 0; i < 16; ++i) { const float a0 = ca[i], h0 = chh[i]; ca[i] = A; chh[i] = H; H = a0 * H + h0; A *= a0; }
                xa[seg * 64 + sq] = A; xs[seg * 64 + sq] = H;
                __syncthreads();
                float Hin = 0.f;
                for (int s2 = 0; s2 < seg; ++s2) Hin = xa[s2 * 64 + sq] * Hin + xs[s2 * 64 + sq];
#pragma unroll
                for (int i = 0; i < 16; ++i) { const int ci = b * CPB + seg * 16 + i; CIN[ci * GW + c] = chh[i] + ca[i] * Hin; }
                __syncthreads();
            }
        }
        }
        xcd_arrive(bar, tid == 0);
        {
        const float* conv_w = IN(3) + L * 4 * GW; const float* conv_b = IN(4) + L * GW; const float* b_a = IN(6) + L * GW; const float* b_x = IN(8) + L * GW; const float* lam = IN(9) + L * GW;
        const float* lbp = IN(10); const float* norm_g = IN(11) + L * HD; const float* pool_s = IN(13) + L * GW; const float* sconv_w = IN(14) + L * 3 * GW;
        unsigned char* AX = lds_raw; unsigned char* AG = lds_raw + 35376; unsigned char* AINB = lds_raw + 69168;
        unsigned char* QT3 = lds_raw; unsigned char* KT3 = lds_raw + 33792; unsigned char* OG3 = lds_raw + 67584; unsigned char* VT3 = lds_raw + 101376; float* TOT3 = (float*)(lds_raw + 138240);
        unsigned char* PS = lds_raw; unsigned char* DIMG = lds_raw + 41712; unsigned char* YST = lds_raw;
        unsigned char* SB = lds_raw; unsigned char* SC = lds_raw + 33792; unsigned char* SX = lds_raw + 68640;
        for (int ci = bid; ci < NCHUNK; ci += G) {
            const int t0 = (ci % CPB) * CH, g0 = ci * CH; const bf16* prow = PROJ + (size_t)g0 * DIN; bf16* yrow = Y + (size_t)g0 * D; (void)t0; (void)yrow;
            { u32x4 rsb[4], rsc[5], rsx[5]; int tld = tid; asm volatile("" : "+v"(tld) :: "memory"); slab_load<4>(rsb, prow + 1792, 64, 0, tld); slab_load<5>(rsc, prow - 2 * DIN + 2048, 66, t0 == 0 ? 2 : 0, tld); slab_load<5>(rsx, prow - 2 * DIN + 2304, 66, t0 == 0 ? 2 : 0, tld);
#pragma unroll
              for (int j = 0; j < 5; ++j) {
                  const unsigned a[4] = {rsc[j].x, rsc[j].y, rsc[j].z, rsc[j].w}, b[4] = {rsx[j].x, rsx[j].y, rsx[j].z, rsx[j].w}; unsigned p[4];
#pragma unroll
                  for (int q = 0; q < 4; ++q) p[q] = pk2(bf2f(a[q] & 0xffffu) * bf2f(b[q] & 0xffffu), bf2f(a[q] >> 16) * bf2f(b[q] >> 16));
                  rsc[j] = (u32x4){p[0], p[1], p[2], p[3]}; }
              slab_store<4>(rsb, SB, 64, tid); slab_store<5>(rsc, SC, 66, tid); }
            __syncthreads();
            int tq = tid; asm volatile("" : "+v"(tq));
            for (int idx = tq; idx < CH * 128; idx += NT) {
                const int t = idx >> 7, c = (idx & 127) * 2; float a0 = 0.f, a1 = 0.f;
#pragma unroll
                for (int k = 0; k < 3; ++k) { const unsigned xc = *(const unsigned*)(SC + (t + k) * RS + c * 2); a0 += sconv_w[k * GW + c] * bf2f(xc & 0xffffu); a1 += sconv_w[k * GW + c + 1] * bf2f(xc >> 16); }
                unsigned* pb = (unsigned*)(SB + t * RS + c * 2); const unsigned b = *pb; *pb = pk2(bf2f(b & 0xffffu) * a0, bf2f(b >> 16) * a1);
            }
            __syncthreads();
            ytile_store(SB, yrow + 768, tid);
            __syncthreads();
        }
        }
        xcd_wait(bar, tid == 0);
        {
        const float* conv_w = IN(3) + L * 4 * GW; const float* conv_b = IN(4) + L * GW; const float* b_a = IN(6) + L * GW; const float* b_x = IN(8) + L * GW; const float* lam = IN(9) + L * GW;
        const float* lbp = IN(10); const float* norm_g = IN(11) + L * HD; const float* pool_s = IN(13) + L * GW; const float* sconv_w = IN(14) + L * 3 * GW;
        unsigned char* AX = lds_raw; unsigned char* AG = lds_raw + 35376; unsigned char* AINB = lds_raw + 69168;
        unsigned char* QT3 = lds_raw; unsigned char* KT3 = lds_raw + 33792; unsigned char* OG3 = lds_raw + 67584; unsigned char* VT3 = lds_raw + 101376; float* TOT3 = (float*)(lds_raw + 138240);
        unsigned char* PS = lds_raw; unsigned char* DIMG = lds_raw + 41712; unsigned char* YST = lds_raw;
        unsigned char* SB = lds_raw; unsigned char* SC = lds_raw + 33792; unsigned char* SX = lds_raw + 68640;
        for (int ci = bid; ci < NCHUNK; ci += G) {
            const int t0 = (ci % CPB) * CH, g0 = ci * CH; const bf16* prow = PROJ + (size_t)g0 * DIN; bf16* yrow = Y + (size_t)g0 * D; (void)t0; (void)yrow;
            int lbi = 64 * (wid >> 1) + lane; asm volatile("" : "+v"(lbi)); const float lbv = L == 0 ? 0.f : sigmoidf_(lbp[GW + lbi] - lbp[lbi]);
            { unsigned* PQ = (unsigned*)(lds_raw + PQ_OFF);
              const int c = (tid & 127) * 2; const float hin_a = CIN[ci * GW + c], hin_b = CIN[ci * GW + c + 1];
              unsigned ag[16];
#pragma unroll
              for (int i = 0; i < 16; ++i) ag[i] = *(const unsigned*)(prow + (size_t)(4 * i + (tid >> 7)) * DIN + 256 + c);
#pragma unroll
              for (int i = 0; i < 16; ++i) { const int t = 4 * i + (tid >> 7); const unsigned pa = PQ[t * 256 + c], pb = PQ[t * 256 + c + 1];
                  const float ha = bf2f(pa & 0xffffu) * hin_a + bf2f(pa >> 16), hb = bf2f(pb & 0xffffu) * hin_b + bf2f(pb >> 16);
                  *(unsigned*)(yrow + (size_t)t * D + c) = pk2(ha * gelu_tanh(bf2f(ag[i] & 0xffffu)), hb * gelu_tanh(bf2f(ag[i] >> 16))); }
            }
            __syncthreads();
            { u32x4 rq[4], rf[4], rv[4], rog[4]; int tlb = tid; asm volatile("" : "+v"(tlb) :: "memory"); slab_load<4>(rq, prow + 512, 64, 0, tlb); slab_load<4>(rf, prow + 768, 64, 0, tlb); slab_load<4>(rv, prow + 1024, 64, 0, tlb); slab_load<4>(rog, prow + 1280, 64, 0, tlb);
              slab_store<4>(rq, QT3, 64, tid); slab_store<4>(rf, KT3, 64, tid); slab_store<4>(rog, OG3, 64, tid); vt_store(rv, VT3, tid); }
            __syncthreads();
            {
                const int h = wid >> 1, half = wid & 1, c = 64 * h + lane, fr = lane & 15, fq = lane >> 4;
                const float lb = lbv;
                f32x4 sraw[4][2][2];
#pragma unroll
                for (int vt = 0; vt < 4; ++vt)
#pragma unroll
                    for (int ks = 0; ks < 2; ++ks) { const float* p = DS + ((size_t)(ci * 4 + h) * 64 + 16 * vt + fr) * 64 + 32 * ks + 8 * fq; sraw[vt][ks][0] = *(const f32x4*)p; sraw[vt][ks][1] = *(const f32x4*)(p + 4); }
                float gl[32]; float run = 0.f;
#pragma unroll
                for (int t = 0; t < 32; ++t) { const float sg = sigmoidf_(bf2f(*(const bf16*)(KT3 + (32 * half + t) * RS + c * 2))); run += flog(lb + (1.f - lb) * sg); gl[t] = run; }
                TOT3[(h * 2 + half) * 64 + lane] = run;
                __syncthreads();
                const float tot0 = TOT3[(h * 2) * 64 + lane];
                const float off = half ? 0.f : -tot0;
#pragma unroll
                for (int t = 0; t < 32; ++t) {
                    bf16* pq = (bf16*)(QT3 + (32 * half + t) * RS + c * 2); bf16* pk = (bf16*)(KT3 + (32 * half + t) * RS + c * 2);
                    const float sg = sigmoidf_(bf2f(*pk)), kkv = (1.f - lb) * (1.f - sg), qfv = siluf_(bf2f(*pq)), d = gl[t] + off;
                    *pq = (bf16)f2bf(qfv * fexp(d)); *pk = (bf16)f2bf(kkv * fexp(-d));
                }
                __syncthreads();
                bf16x8 sa[4][2];
#pragma unroll
                for (int vt = 0; vt < 4; ++vt)
#pragma unroll
                    for (int ks = 0; ks < 2; ++ks) {
                        const f32x4 lo = sraw[vt][ks][0], hi = sraw[vt][ks][1];
                        const float* eg = TOT3 + (h * 2) * 64 + 32 * ks + 8 * fq;
                        u32x4 w; w.x = pk2(lo.x * fexp(eg[0]), lo.y * fexp(eg[1])); w.y = pk2(lo.z * fexp(eg[2]), lo.w * fexp(eg[3])); w.z = pk2(hi.x * fexp(eg[4]), hi.y * fexp(eg[5])); w.w = pk2(hi.z * fexp(eg[6]), hi.w * fexp(eg[7]));
                        sa[vt][ks] = __builtin_bit_cast(bf16x8, w);
                    }
#pragma unroll
                for (int tsel = 0; tsel < 2; ++tsel) {
                    const int ti = half == 0 ? (tsel ? 3 : 0) : (tsel ? 2 : 1);
                    bf16x8 qb[2];
#pragma unroll
                    for (int ks = 0; ks < 2; ++ks) qb[ks] = *(const bf16x8*)(QT3 + (16 * ti + fr) * RS + (64 * h + 32 * ks + 8 * fq) * 2);
                    f32x4 st[4];
#pragma unroll
                    for (int si = 0; si < 4; ++si) { st[si] = (f32x4){0.f, 0.f, 0.f, 0.f};
                        if (si <= ti) {
#pragma unroll
                            for (int ks = 0; ks < 2; ++ks) { const bf16x8 ka = *(const bf16x8*)(KT3 + (16 * si + fr) * RS + (64 * h + 32 * ks + 8 * fq) * 2); st[si] = __builtin_amdgcn_mfma_f32_16x16x32_bf16(ka, qb[ks], st[si], 0, 0, 0); }
                            if (si == ti) {
#pragma unroll
                                for (int r = 0; r < 4; ++r) if (4 * fq + r > fr) st[si][r] = 0.f; }
                        } }
                    f32x4 oo[4];
#pragma unroll
                    for (int vt = 0; vt < 4; ++vt) { oo[vt] = (f32x4){0.f, 0.f, 0.f, 0.f};
#pragma unroll
                        for (int ks = 0; ks < 2; ++ks) oo[vt] = __builtin_amdgcn_mfma_f32_16x16x32_bf16(sa[vt][ks], qb[ks], oo[vt], 0, 0, 0); }
#pragma unroll
                    for (int p = 0; p < 2; ++p) if (2 * p <= ti) {
                        u32x4 bw; bw.x = pk2(st[2 * p][0], st[2 * p][1]); bw.y = pk2(st[2 * p][2], st[2 * p][3]); bw.z = pk2(st[2 * p + 1][0], st[2 * p + 1][1]); bw.w = pk2(st[2 * p + 1][2], st[2 * p + 1][3]);
                        const bf16x8 bfr = __builtin_bit_cast(bf16x8, bw);
#pragma unroll
                        for (int vt = 0; vt < 4; ++vt) { const int vrow = 64 * h + 16 * vt + fr; const u32x2 lo8 = *(const u32x2*)(VT3 + vt_off(vrow, 32 * p + 4 * fq)), hi8 = *(const u32x2*)(VT3 + vt_off(vrow, 32 * p + 16 + 4 * fq));
                            u32x4 aw; aw.x = lo8.x; aw.y = lo8.y; aw.z = hi8.x; aw.w = hi8.y;
                            oo[vt] = __builtin_amdgcn_mfma_f32_16x16x32_bf16(__builtin_bit_cast(bf16x8, aw), bfr, oo[vt], 0, 0, 0); }
                    }
                    float ss = 0.f;
#pragma unroll
                    for (int vt = 0; vt < 4; ++vt) ss += (oo[vt][0] * oo[vt][0] + oo[vt][1] * oo[vt][1]) + (oo[vt][2] * oo[vt][2] + oo[vt][3] * oo[vt][3]);
                    ss += __shfl_xor(ss, 16); ss += __shfl_xor(ss, 32);
                    const float rs = __builtin_amdgcn_rsqf(ss * (1.0f / HD) + 1e-5f);
#pragma unroll
                    for (int vt = 0; vt < 4; ++vt) { const int cv = 64 * h + 16 * vt + 4 * fq; u32x2* pog = (u32x2*)(OG3 + (16 * ti + fr) * RS + cv * 2); const u32x2 og = *pog; const f32x4 ng = *(const f32x4*)(norm_g + 16 * vt + 4 * fq);
                        u32x2 w; w.x = pk2(oo[vt][0] * rs * ng.x * siluf_(bf2f(og.x & 0xffffu)), oo[vt][1] * rs * ng.y * siluf_(bf2f(og.x >> 16))); w.y = pk2(oo[vt][2] * rs * ng.z * siluf_(bf2f(og.y & 0xffffu)), oo[vt][3] * rs * ng.w * siluf_(bf2f(og.y >> 16)));
                        *pog = w; }
                }
                __syncthreads();
            }
            ytile_store(OG3, yrow + 256, tid);
            __syncthreads();
        }
        }
    } break;

    case PH_OUTPROJ: {
        PHASE_ENTER
        pg8::Gemm g{Y, (const bf16*)(ws + WS_WOUT) + (size_t)L * D * D, NTOK, D, D, 0}; pg8::StaticOrder S; S.init(NTOK, D, G, bid);
        if (L == 0) { pg8::EpiResidStats E{IN(0), hres, HN, SSP0}; pg8::gemm_phase<pg8::EpiResidStats, pg8::StaticOrder, true, true>((PG8_LAS unsigned char*)lds_raw, g, S, E, tid); }
        else { pg8::EpiResidF32 E{hres, hres}; pg8::gemm_phase<pg8::EpiResidF32, pg8::StaticOrder, true, true>((PG8_LAS unsigned char*)lds_raw, g, S, E, tid); }
    } break;

    case PH_NORM: {
        PHASE_ENTER
        const float* g = IN(16) + D;
        unsigned* XROW = (unsigned*)lds_raw;
        int* sel = (int*)(lds_raw + 65536);
        int* rnk = sel + 128;
        int* sh = rnk + 128;
        int* cnts = sh + 64;
        const int blk = bid;
        {
            float wr[16][8];
            { const float* wr_ = IN(20);
#pragma unroll
              for (int j = 0; j < 4; ++j)
#pragma unroll
                for (int q = 0; q < 4; ++q) { const f32x4 w0 = *(const f32x4*)(wr_ + (size_t)(4 * (lane + 64 * j) + q) * 8), w1 = *(const f32x4*)(wr_ + (size_t)(4 * (lane + 64 * j) + q) * 8 + 4);
                    wr[j * 4 + q][0] = w0.x; wr[j * 4 + q][1] = w0.y; wr[j * 4 + q][2] = w0.z; wr[j * 4 + q][3] = w0.w; wr[j * 4 + q][4] = w1.x; wr[j * 4 + q][5] = w1.y; wr[j * 4 + q][6] = w1.z; wr[j * 4 + q][7] = w1.w; } }
            f32x4 gv[4];
#pragma unroll
            for (int j = 0; j < 4; ++j) gv[j] = ((const f32x4*)g)[lane + 64 * j];
            f32x4 vn[4];
            { const f32x4* xr = (const f32x4*)(hres + (size_t)(blk * 64 + wid * 8) * D);
#pragma unroll
              for (int j = 0; j < 4; ++j) vn[j] = xr[lane + 64 * j]; }
#pragma unroll 1
            for (int r8 = 0; r8 < 8; ++r8) {
                const int tl = wid * 8 + r8, m = blk * 64 + tl;
                f32x4 v[4]; float s = 0.f;
#pragma unroll
                for (int j = 0; j < 4; ++j) { v[j] = vn[j]; s += (v[j].x * v[j].x + v[j].y * v[j].y) + (v[j].z * v[j].z + v[j].w * v[j].w); }
                if (r8 < 7) { const f32x4* xr = (const f32x4*)(hres + (size_t)(m + 1) * D);
#pragma unroll
                    for (int j = 0; j < 4; ++j) vn[j] = xr[lane + 64 * j]; }
                const float r = 1.0f / sqrtf(wave_sum(s) * (1.0f / D) + 1e-6f);
                float lg[8] = {0.f, 0.f, 0.f, 0.f, 0.f, 0.f, 0.f, 0.f};
#pragma unroll
                for (int j = 0; j < 4; ++j) { const float y[4] = {v[j].x * r * gv[j].x, v[j].y * r * gv[j].y, v[j].z * r * gv[j].z, v[j].w * r * gv[j].w};
                    XROW[tl * 256 + lane + 64 * j] = pg8::pk4_fp8(y[0], y[1], y[2], y[3]);
#pragma unroll
                    for (int q = 0; q < 4; ++q)
#pragma unroll
                        for (int e = 0; e < 8; ++e) lg[e] += y[q] * wr[j * 4 + q][e]; }
#pragma unroll
                for (int e = 0; e < 8; ++e) lg[e] = wave_sum(lg[e]);
                if (lane == 0) {
                    int e1 = 0; float l1 = lg[0];
#pragma unroll
                    for (int e = 1; e < 8; ++e) if (lg[e] > l1) { l1 = lg[e]; e1 = e; }
                    int e2 = -1; float l2 = -3.0e38f;
#pragma unroll
                    for (int e = 0; e < 8; ++e) if (e != e1 && lg[e] > l2) { l2 = lg[e]; e2 = e; }
                    const float g1 = 1.0f / (1.0f + fexp(l2 - l1));
                    TOKG[m * 2] = g1; TOKG[m * 2 + 1] = 1.0f - g1;
                    sel[tl * 2] = e1; sel[tl * 2 + 1] = e2;
                }
            }
            __syncthreads();
            if (tid < NE) { int cnt = 0; for (int q = 0; q < 128; ++q) if (sel[q] == tid) { rnk[q] = cnt; ++cnt; } BCNT[blk * NE + tid] = cnt; }
        }
        xcd_barrier(bar, tid == 0);
        {
            for (int i = tid; i < (NTOK / 64) * NE; i += NT) cnts[i] = BCNT[i];
            __syncthreads();
            { const int e = wid; int sall = 0, slt = 0;
#pragma unroll
              for (int i = 0; i < 4; ++i) { const int b2 = 4 * lane + i, c = cnts[b2 * NE + e]; sall += c; slt += (b2 < blk) ? c : 0; }
#pragma unroll
              for (int o = 1; o < 64; o <<= 1) { sall += __shfl_xor(sall, o); slt += __shfl_xor(slt, o); }
              if (lane == 0) { sh[e] = sall; sh[16 + e] = slt; sh[24 + e] = (sall + 255) >> 8; } }
            __syncthreads();
            if (tid == 0) { int acc = 0; for (int e = 0; e < NE; ++e) { sh[8 + e] = acc * 256; acc += sh[24 + e]; } sh[32] = acc; }
            __syncthreads();
            if (tid < 128) { const int m = blk * 64 + (tid >> 1); const int e = sel[tid]; const int r = sh[8 + e] + sh[16 + e] + rnk[tid];
                ROWDST[r] = m * 2 + (tid & 1); ROWG[r] = TOKG[blk * 128 + tid]; TOKROW[blk * 128 + tid] = r; }
#pragma unroll
            for (int r8 = 0; r8 < 8; ++r8) {
                const int tl = wid * 8 + r8; const int e0 = sel[tl * 2], e1 = sel[tl * 2 + 1];
                const int r0 = sh[8 + e0] + sh[16 + e0] + rnk[tl * 2], r1 = sh[8 + e1] + sh[16 + e1] + rnk[tl * 2 + 1];
                const u32x4 w = *(const u32x4*)(XROW + tl * 256 + 4 * lane);
                *(u32x4*)(XR + (size_t)r0 * D + 16 * lane) = w; *(u32x4*)(XR + (size_t)r1 * D + 16 * lane) = w;
            }
            if (blk == 0) {
                for (int e = 0; e < NE; ++e) { const int lo = sh[8 + e] + sh[e], hi = sh[8 + e] + sh[24 + e] * 256; for (int r = lo + tid; r < hi; r += NT) { ROWDST[r] = -1; ROWG[r] = 0.f; } }
                if (tid < MAXTILES) { int e = 0; for (int q = 0; q < NE; ++q) if (tid * 256 >= sh[8 + q]) e = q; TILEE[tid] = e; }
                if (tid == 0) TILEE[MAXTILES] = sh[32];
            }
            __syncthreads();
        }
    } break;

    case PH_FFNUP: {
        PHASE_ENTER
        pg8::Gemm g{HN, (const bf16*)(ws + WS_WGU), NTOK, 2 * DFF, D, 0}; pg8::StaticOrder S; S.init(NTOK, 2 * DFF, G, bid);
        pg8::fill_rstd_table((PG8_LAS unsigned char*)lds_raw, S, SSP0, tid);
        pg8::EpiSwigluR E{HID, DFF, (const PG8_LAS float*)((PG8_LAS unsigned char*)lds_raw + pg8::RSTD_TAB_OFF)};
        pg8::gemm_phase<pg8::EpiSwigluR, pg8::StaticOrder, true, true>((PG8_LAS unsigned char*)lds_raw, g, S, E, tid);
    } break;

    case PH_FFNDOWN: {
        PHASE_ENTER
        pg8::Gemm g{HID, (const bf16*)(ws + WS_WD), NTOK, D, DFF, 0}; pg8::StaticOrder S; S.init(NTOK, D, G, bid);
        pg8::EpiResidStats E{hres, dry ? (float*)(ws + 410 * MiB) : hres, HN, SSP1};
        pg8::gemm_phase<pg8::EpiResidStats, pg8::StaticOrder, true, true>((PG8_LAS unsigned char*)lds_raw, g, S, E, tid);
    } break;

    case PH_MOEUP: {
        PHASE_ENTER
        const int ntiles = __builtin_amdgcn_readfirstlane(__hip_atomic_load(TILEE + MAXTILES, __ATOMIC_RELAXED, __HIP_MEMORY_SCOPE_AGENT));
        pg8::Gemm g{(const bf16*)XR, (const bf16*)(ws + WS_W13), 0, 0, D / 2, 0}; pg8::MoeOrder S; S.init(ntiles, DFFE / 128, G, bid, 0, 0, TILEE);
        pg8::EpiSwiglu8 E{HIDE, DFFE, 1.0f / W13_SCALE, HID_SCALE};
        pg8::gemm_phase<pg8::EpiSwiglu8, pg8::MoeOrder, true, true, true>((PG8_LAS unsigned char*)lds_raw, g, S, E, tid);
    } break;

    case PH_MOEDOWN: {
        PHASE_ENTER
        const int ntiles = __builtin_amdgcn_readfirstlane(__hip_atomic_load(TILEE + MAXTILES, __ATOMIC_RELAXED, __HIP_MEMORY_SCOPE_AGENT));
        const int tfull = (ntiles / 64) * 64, ntail = ntiles - tfull;
        if (tfull > 0) {
            pg8::Gemm g{(const bf16*)HIDE, (const bf16*)(ws + WS_W2), 0, 0, DFFE / 2, 0}; pg8::MoeOrder S; S.init(tfull, D / 256, G, bid, 0, 0, TILEE);
            pg8::EpiMoeDown E{OUT2, ROWDST, ROWG, 1.0f / (W2_SCALE * HID_SCALE)};
            pg8::gemm_phase<pg8::EpiMoeDown, pg8::MoeOrder, true, true, true>((PG8_LAS unsigned char*)lds_raw, g, S, E, tid);
        }
        if (ntail > 0) {
            const int Sp = moe_tail_split(ntail);
            pg8::Gemm g{(const bf16*)HIDE, (const bf16*)(ws + WS_W2), 0, 0, DFFE / 2 / Sp, DFFE / 2};
            pg8::MoeTailOrder S{tfull, ntail, D / 256, Sp, G, bid, DFFE / Sp, TILEE};
            pg8::EpiPartF32 E{PART};
            pg8::gemm_phase<pg8::EpiPartF32, pg8::MoeTailOrder, true, true, true>((PG8_LAS unsigned char*)lds_raw, g, S, E, tid);
        }
    } break;

    case PH_FINAL: {
        PHASE_ENTER
        const float* g = IN(24); const int gw = bid * 8 + wid, NGW = G * 8;
        const int ntiles = __builtin_amdgcn_readfirstlane(__hip_atomic_load(TILEE + MAXTILES, __ATOMIC_RELAXED, __HIP_MEMORY_SCOPE_AGENT));
        const int tfull = (ntiles / 64) * 64, ntail = ntiles - tfull, Sp = ntail > 0 ? moe_tail_split(ntail) : 1, tail_row0 = tfull * 256; const float sc = 1.0f / (W2_SCALE * HID_SCALE);
        for (int mb = gw; mb < NTOK; mb += 8 * NGW) {
        int trow[8][2];
#pragma unroll
        for (int k = 0; k < 8; ++k) { const int m = mb + k * NGW; trow[k][0] = m < NTOK ? TOKROW[2 * m] : 0; trow[k][1] = m < NTOK ? TOKROW[2 * m + 1] : 0; }
#pragma unroll
        for (int k = 0; k < 8; ++k) { const int m = mb + k * NGW; if (m >= NTOK) break;
            f32x4* xr = (f32x4*)(hres + (size_t)m * D); const f32x4* gr = (const f32x4*)g;
            f32x4 v[4]; u32x2 ob[2][4]; float s = 0.f;
#pragma unroll
            for (int j = 0; j < 4; ++j) { v[j] = xr[lane + 64 * j]; ob[0][j] = ((const u32x2*)(OUT2 + (size_t)(2 * m) * D))[lane + 64 * j]; ob[1][j] = ((const u32x2*)(OUT2 + (size_t)(2 * m + 1) * D))[lane + 64 * j]; }
#pragma unroll
            for (int slot = 0; slot < 2; ++slot) {
                const int r = __builtin_amdgcn_readfirstlane(trow[k][slot]);
                if (r < tail_row0) {
#pragma unroll
                    for (int j = 0; j < 4; ++j) { const u32x2 p = ob[slot][j]; v[j].x += bf2f(p.x & 0xffffu); v[j].y += bf2f(p.x >> 16); v[j].z += bf2f(p.y & 0xffffu); v[j].w += bf2f(p.y >> 16); } }
                else { const int tl = (r - tail_row0) >> 8, rl = (r - tail_row0) & 255; const float gt = TOKG[2 * m + slot] * sc;
                    f32x4 q[7][4];
#pragma unroll
                    for (int p = 0; p < 7; ++p) { const f32x4* pr = (const f32x4*)(PART + ((size_t)(tl * Sp + (p < Sp ? p : 0)) * 256 + rl) * 1024);
#pragma unroll
                        for (int j = 0; j < 4; ++j) q[p][j] = pr[lane + 64 * j]; }
#pragma unroll
                    for (int p = 0; p < 7; ++p) { const float gp = p < Sp ? gt : 0.f;
#pragma unroll
                        for (int j = 0; j < 4; ++j) { v[j].x += gp * q[p][j].x; v[j].y += gp * q[p][j].y; v[j].z += gp * q[p][j].z; v[j].w += gp * q[p][j].w; } } }
            }
#pragma unroll
            for (int j = 0; j < 4; ++j) s += (v[j].x * v[j].x + v[j].y * v[j].y) + (v[j].z * v[j].z + v[j].w * v[j].w);
            const float r = 1.0f / sqrtf(wave_sum(s) * (1.0f / D) + 1e-6f);
#pragma unroll
            for (int j = 0; j < 4; ++j) { const f32x4 gv = gr[lane + 64 * j]; (dry ? (f32x4*)((float*)(ws + 410 * MiB) + (size_t)m * D) : xr)[lane + 64 * j] = (f32x4){v[j].x * r * gv.x, v[j].y * r * gv.y, v[j].z * r * gv.z, v[j].w * r * gv.w}; }
        }
        }
    } break;
    }
    if (phase == PH_INPROJ || phase == PH_FFNUP || phase == PH_NORM) {
        int t_ = wid_s * 64 + lane_id_asm(); asm volatile("" : "+v"(t_));
        __attribute__((address_space(1))) unsigned char* wsq_ = (__attribute__((address_space(1))) unsigned char*)a.ws; asm volatile("" : "+s"(wsq_)); unsigned char* ws_ = (unsigned char*)wsq_; int G_ = gridDim.x; asm volatile("" : "+s"(G_));
        bg_convert(ws_, lds_raw, IN(21), IN(22), IN(23), step, G_, t_, phase == PH_NORM);
    }
    if (step + 1 < a.ph_hi) { int t_ = wid_s * 64 + lane_id_asm(); asm volatile("" : "+v"(t_)); xcd_barrier(bar, t_ == 0); }
#ifdef REP_STEP
    if (dry) { --rep_left; --step; }
#endif
    }
}

constexpr int NSTEPS = 13;
#ifndef MK_PER_PHASE
#define MK_PER_PHASE 0
#endif

extern "C" void kernel_launch(void* const* d_in, const int* in_sizes, int n_in, void* d_out, int out_size, void* d_ws, size_t ws_size, hipStream_t stream) {
    static int grid = 0;
    if (grid == 0) {
        if (n_in != 25 || out_size != NTOK * D || ws_size < WS_END + 67 * MiB) { fprintf(stderr, "kernel_launch: unexpected shapes (n_in %d out %d ws %zu need %zu)\n", n_in, out_size, ws_size, (size_t)WS_END); grid = -1; return; }
        int dev = 0, cus = 0, per_cu = 0;
        if (hipGetDevice(&dev) != hipSuccess || hipDeviceGetAttribute(&cus, hipDeviceAttributeMultiprocessorCount, dev) != hipSuccess) { grid = -1; return; }
        if (hipFuncSetAttribute((const void*)fwd, hipFuncAttributeMaxDynamicSharedMemorySize, LDS_BYTES) != hipSuccess) { fprintf(stderr, "kernel_launch: hipFuncSetAttribute failed\n"); grid = -1; return; }
        if (hipOccupancyMaxActiveBlocksPerMultiprocessor(&per_cu, (const void*)fwd, NT, LDS_BYTES) != hipSuccess || per_cu < 1) { fprintf(stderr, "kernel_launch: occupancy query says %d blocks/CU\n", per_cu); (void)hipGetLastError(); grid = -1; return; }
        grid = cus;
        if (grid != NCHUNK) { fprintf(stderr, "kernel_launch: built for a %d-CU device (one 64-token chunk per workgroup in the mixer phase); this device has %d\n", NCHUNK, cus); grid = -1; return; }
    }
    if (grid < 0) return;
    hipMemsetAsync((char*)d_ws + WS_CTL, 0, 1 * MiB, stream);
    Args a{};
    for (int i = 0; i < 25; ++i) a.in[i] = (const float*)d_in[i];
    a.out = (float*)d_out; a.ws = (unsigned char*)d_ws;
#if MK_PER_PHASE
    for (int s = 0; s < NSTEPS; ++s) { a.ph_lo = s; a.ph_hi = s + 1; hipLaunchKernelGGL(fwd, dim3(grid), dim3(NT), LDS_BYTES, stream, a); }
#else
    a.ph_lo = 0; a.ph_hi = NSTEPS;
    hipLaunchKernelGGL(fwd, dim3(grid), dim3(NT), LDS_BYTES, stream, a);
#endif
}
```

```cpp
#include <hip/hip_runtime.h>
#include <cstdint>
#include <cstdio>

typedef unsigned short bf16;
typedef short bf16x8 __attribute__((ext_vector_type(8)));
typedef float f32x4 __attribute__((ext_vector_type(4)));
typedef unsigned u32x4 __attribute__((ext_vector_type(4)));
typedef unsigned u32x2 __attribute__((ext_vector_type(2)));

constexpr int NTOK = 16384, SEQ = 8192, D = 1024, DIN = 2560, GW = 256, HD = 64, DFF = 2816, DFFE = 3584, NE = 8;
constexpr int CH = 64, NCHUNK = NTOK / CH, CPB = SEQ / CH;
constexpr int NT = 512;
constexpr float W13_SCALE = 64.f, W2_SCALE = 128.f, HID_SCALE = 8.f;
constexpr int MAXTILES = NTOK * 2 / 256 + NE;

constexpr size_t MiB = 1u << 20;
constexpr size_t WS_CTL = 0;
constexpr size_t WS_SMALL = 1 * MiB;
constexpr size_t WS_WIN = 5 * MiB;
constexpr size_t WS_WOUT = 15 * MiB;
constexpr size_t WS_WGU = 19 * MiB;
constexpr size_t WS_WD = 30 * MiB;
constexpr size_t WS_W13 = 36 * MiB;
constexpr size_t WS_W2 = 92 * MiB;
constexpr size_t WS_ACT = 120 * MiB;
constexpr size_t WS_HN = WS_ACT;
constexpr size_t WS_PROJ = WS_ACT + 32 * MiB;
constexpr size_t WS_Y = WS_ACT + 112 * MiB;
constexpr size_t WS_DS = WS_ACT + 144 * MiB;
constexpr size_t WS_HID = WS_PROJ;
constexpr size_t WS_XR = WS_ACT;
constexpr size_t WS_HIDE = WS_ACT + 34 * MiB;
constexpr size_t WS_OUT2 = WS_ACT + 153 * MiB;
constexpr size_t WS_END = WS_ACT + 217 * MiB;
constexpr size_t SM_TOKE = 0;
constexpr size_t SM_TOKG = 128 * 1024;
constexpr size_t SM_TOKR = 256 * 1024;
constexpr size_t SM_BCNT = 384 * 1024;
constexpr size_t SM_ROWTOK = 400 * 1024;
constexpr size_t SM_ROWDST = 544 * 1024;
constexpr size_t SM_ROWG = 688 * 1024;
constexpr size_t SM_TILEE = 832 * 1024;
constexpr size_t SM_CARA = 1024 * 1024;
constexpr size_t SM_CARH = 1280 * 1024;
constexpr size_t SM_CIN = 1536 * 1024;
constexpr size_t SM_DEC = 1792 * 1024;
constexpr size_t SM_RSTD = 2048 * 1024;
constexpr size_t SM_WTA = 2304 * 1024;
constexpr size_t SM_WTX = 2368 * 1024;
constexpr size_t SM_TOKROW = 2560 * 1024;
constexpr size_t SM_WTP = 2432 * 1024;

struct Args {
    const float* in[25];
    float* out;
    unsigned char* ws;
    int ph_lo, ph_hi, pad0, pad1;
};

__device__ __forceinline__ int lane_id_asm() { int l; asm volatile("v_mbcnt_lo_u32_b32 %0, -1, 0\n\tv_mbcnt_hi_u32_b32 %0, -1, %0" : "=v"(l)); return l; }
typedef const float __attribute__((address_space(1)))* gfptr_t;
__device__ __forceinline__ const float* IN(int k) { asm volatile("" : "+s"(k)); const gfptr_t p = ((const gfptr_t __attribute__((address_space(4)))*)__builtin_amdgcn_kernarg_segment_ptr())[k]; return (const float*)p; }
__device__ __forceinline__ float bf2f(unsigned v) { return __uint_as_float(v << 16); }
typedef float f32x2c __attribute__((ext_vector_type(2))); typedef __bf16 bf16x2c __attribute__((ext_vector_type(2)));
__device__ __forceinline__ unsigned pk2(float lo, float hi) { const f32x2c v = {lo, hi}; return __builtin_bit_cast(unsigned, __builtin_convertvector(v, bf16x2c)); }
__device__ __forceinline__ unsigned f2bf(float f) { return pk2(f, 0.f) & 0xffffu; }
__device__ __forceinline__ float fexp(float x) { return __builtin_amdgcn_exp2f(1.44269504089f * x); }
__device__ __forceinline__ float flog(float x) { return 0.69314718056f * __builtin_amdgcn_logf(x); }
__device__ __forceinline__ float sigmoidf_(float x) { return __builtin_amdgcn_rcpf(1.0f + __builtin_amdgcn_exp2f(-1.44269504089f * x)); }
__device__ __forceinline__ float siluf_(float x) { return x * sigmoidf_(x); }
__device__ __forceinline__ float gelu_tanh(float x) { const float u = 1.5957691216057308f * (x + 0.044715f * x * x * x); return x * sigmoidf_(u); }
__device__ __forceinline__ float neg_expm1_small(float x) { return -x * (1.0f + x * (0.5f + x * (0.16666667f + x * (0.041666668f + x * 0.0083333338f)))); }
__device__ __forceinline__ float wave_sum(float v) {
#define WS_DPP(ctrl, rmask) v += __builtin_bit_cast(float, __builtin_amdgcn_update_dpp(0, __builtin_bit_cast(int, v), ctrl, rmask, 0xf, false))
    WS_DPP(0xB1, 0xf); WS_DPP(0x4E, 0xf); WS_DPP(0x141, 0xf); WS_DPP(0x140, 0xf); WS_DPP(0x142, 0xa); WS_DPP(0x143, 0xc);
#undef WS_DPP
    return __builtin_bit_cast(float, __builtin_amdgcn_readlane(__builtin_bit_cast(int, v), 63));
}
#define LDS_WAIT() asm volatile("s_waitcnt lgkmcnt(0)" ::: "memory")

namespace pg8 {
#define PG8_LAS __attribute__((address_space(3)))
typedef unsigned short bf16_t;
typedef short bf16x8 __attribute__((ext_vector_type(8)));
typedef float f32x4 __attribute__((ext_vector_type(4)));
typedef unsigned u32x4 __attribute__((ext_vector_type(4)));
constexpr int BM = 256, BK = 64, HALF = 128, HTB = HALF * BK * 2  , STAGE_BYTES = 8 * HTB, NXCD = 8;

__host__ __device__ __forceinline__ int lds_byte(int r, int c) { const int st = (r >> 4) * 2 + (c >> 5), rr = r & 15, cc = c & 31, ob = rr * 64 + cc * 2; return st * 1024 + (ob ^ (((ob >> 9) & 1) << 5)); }
__host__ __device__ __forceinline__ void stage_rc(int b, int& R, int& C) { const int st = b / 1024, sb = b % 1024, swz = sb ^ (((sb >> 9) & 1) << 5); R = (st >> 1) * 16 + swz / 64; C = (st & 1) * 32 + (swz % 64) / 2; }
__host__ __device__ __forceinline__ int perm32(int rho) { const int n = rho >> 4, i = rho & 15; return 8 * (i >> 2) + 4 * n + (i & 3); }

struct Unit { int pm, pn, pa, pb, ord, koff; };
struct Gemm { const bf16_t* A; const bf16_t* Bt; int M, N, K; int LD; };

struct StaticOrder {
    int nM, nN, nwg, G, c, WGM;
    __host__ __device__ void init(int M, int N, int G_, int c_, int wgm = 4) { nM = M / BM; nN = N / BM; nwg = nM * nN; G = G_; c = c_; WGM = wgm; }
    __host__ __device__ bool next(int i, Unit& u) const {
        const long L = (long)i * G + c; if (L >= nwg) return false;
        int wgid = (int)L; { const int q = nwg / NXCD, r = nwg % NXCD, xcd = wgid % NXCD, off = wgid / NXCD; wgid = (xcd < r ? xcd * (q + 1) : r * (q + 1) + (xcd - r) * q) + off; }
        const int nig = WGM * nN, gid = wgid / nig, fm = gid * WGM, gsz = (nM - fm) < WGM ? (nM - fm) : WGM;
        u.pm = fm + ((wgid % nig) % gsz); u.pn = (wgid % nig) / gsz; u.pa = u.pm; u.pb = u.pn; u.ord = i; u.koff = 0; return true;
    }
    __device__ __forceinline__ void a_ready(const Unit&) const {}
    __device__ __forceinline__ void done(const Unit&) const {}
};

__device__ __forceinline__ unsigned cvt_pk_bf16(float lo, float hi) { unsigned r; asm volatile("v_cvt_pk_bf16_f32 %0, %1, %2" : "=v"(r) : "v"(lo), "v"(hi)); return r; }
typedef float f32x2 __attribute__((ext_vector_type(2)));
typedef int pg8_v8i __attribute__((ext_vector_type(8))); typedef int pg8_v4i __attribute__((ext_vector_type(4)));
__device__ __forceinline__ pg8_v8i pg8_cat(bf16x8 lo, bf16x8 hi) { return __builtin_shufflevector(__builtin_bit_cast(pg8_v4i, lo), __builtin_bit_cast(pg8_v4i, hi), 0, 1, 2, 3, 4, 5, 6, 7); }
__device__ __forceinline__ void pg8_mfma8(f32x4& acc, pg8_v8i a, pg8_v8i b, int sc) { asm volatile("v_mfma_scale_f32_16x16x128_f8f6f4 %0, %1, %2, %0, %3, %3 op_sel_hi:[0,0,0]" : "+v"(acc) : "v"(a), "v"(b), "v"(sc)); }
template <class Epi, class Sched, bool ALIGN_EPI = false, bool SP2 = false, bool F8 = false>
__device__ __forceinline__ void gemm_phase(PG8_LAS unsigned char* lds, const Gemm g, const Sched& S, const Epi& E, int tid_in) {
    int tid = tid_in; asm volatile("" : "+v"(tid));
    const int wid = __builtin_amdgcn_readfirstlane(tid >> 6), lane = tid & 63, wr = wid >> 2, wc = wid & 3, fr = lane & 15, fq = lane >> 4;
    const int K = g.LD ? g.LD : g.K, nt = g.K / BK;
    unsigned voffA[2], voffB[2];
#pragma unroll
    for (int i = 0; i < 2; ++i) { int R, C; stage_rc(tid * 16 + i * 8192, R, C); const int Rb = Epi::PERM ? ((R & ~31) + perm32(R & 31)) : R;
        voffA[i] = (unsigned)(R * K + C) * 2u; voffB[i] = (unsigned)(Rb * K + C) * 2u; }
    const size_t kstep = (size_t)(BK * 2);
    const size_t hstep = (size_t)HALF * K * 2;
    const size_t tstep = 2 * hstep;
    const unsigned ldsw = (unsigned)wid * 1024u;
    int f8one = 0x7f7f7f7f; asm volatile("" : "+v"(f8one));
    constexpr int KOFF = 1024;
    const int aoff = lds_byte(wr * 64 + fr, fq * 8), boff = lds_byte(wc * 32 + fr, fq * 8);
#define PG8_SA(b, h) (((b) * 2 + (h)) * HTB)
#define PG8_SB(b, h) ((4 + (b) * 2 + (h)) * HTB)
#define PG8_STAGE(bufoff, gbase, voff) do { _Pragma("unroll") for (int _i = 0; _i < 2; ++_i) \
        __builtin_amdgcn_global_load_lds((const unsigned*)((const char*)(gbase) + (voff)[_i]), (PG8_LAS unsigned*)(lds + (bufoff) + ldsw + _i * 8192), 16, 0, 0); } while (0)
#define PG8_LDA(dst, b, h) do { _Pragma("unroll") for (int m = 0; m < 4; ++m) _Pragma("unroll") for (int k = 0; k < 2; ++k) dst[m][k] = *(const PG8_LAS bf16x8*)(lds + PG8_SA(b, h) + aoff + m * 2048 + k * KOFF); } while (0)
#define PG8_LDB(dst, b, h) do { _Pragma("unroll") for (int n = 0; n < 2; ++n) _Pragma("unroll") for (int k = 0; k < 2; ++k) dst[n][k] = *(const PG8_LAS bf16x8*)(lds + PG8_SB(b, h) + boff + n * 2048 + k * KOFF); } while (0)
#define PG8_MMA(ai, bj, At, Bt) do { __builtin_amdgcn_s_setprio(1); if constexpr (F8) { _Pragma("unroll") for (int m = 0; m < 4; ++m) _Pragma("unroll") for (int n = 0; n < 2; ++n) \
        pg8_mfma8(acc[ai][bj][m][n], pg8_cat(Bt[n][0], Bt[n][1]), pg8_cat(At[m][0], At[m][1]), f8one); } \
    else { _Pragma("unroll") for (int m = 0; m < 4; ++m) _Pragma("unroll") for (int n = 0; n < 2; ++n) _Pragma("unroll") for (int k = 0; k < 2; ++k) \
        acc[ai][bj][m][n] = __builtin_amdgcn_mfma_f32_16x16x32_bf16(Bt[n][k], At[m][k], acc[ai][bj][m][n], 0, 0, 0); } __builtin_amdgcn_s_setprio(0); } while (0)
#define PG8_WAIT_V(n) asm volatile("s_waitcnt vmcnt(" #n ")" ::: "memory")
#define PG8_WAIT_L(n) asm volatile("s_waitcnt lgkmcnt(" #n ")" ::: "memory")
#define PG8_BAR __builtin_amdgcn_s_barrier()
#define PG8_SCHED __builtin_amdgcn_sched_barrier(0)
    Unit cur, nxt; int ui = 0;
    if (!S.next(0, cur)) return;
    f32x4 acc[2][2][4][2];
    if constexpr (Epi::ACC_INIT) E.init(acc, cur, wr, wc, fr, fq);
    else {
#pragma unroll
    for (int a = 0; a < 2; ++a)
#pragma unroll
        for (int b = 0; b < 2; ++b)
#pragma unroll
            for (int m = 0; m < 4; ++m)
#pragma unroll
                for (int n = 0; n < 2; ++n) acc[a][b][m][n] = (f32x4){0.f, 0.f, 0.f, 0.f};
    }
    bf16x8 At[4][2], B0[2][2], B1[2][2];
    const char* cA = (const char*)g.A + (size_t)cur.pa * tstep + cur.koff; const char* cB = (const char*)g.Bt + (size_t)cur.pb * tstep + cur.koff;
    S.a_ready(cur);
    if constexpr (SP2) {
        PG8_STAGE(PG8_SB(0, 0), cB, voffB); PG8_STAGE(PG8_SB(0, 1), cB + hstep, voffB); PG8_STAGE(PG8_SA(0, 0), cA, voffA); PG8_STAGE(PG8_SA(0, 1), cA + hstep, voffA);
        if (wr == 1) PG8_BAR;
        PG8_WAIT_V(2); PG8_BAR;
        PG8_STAGE(PG8_SB(1, 0), cB + kstep, voffB); PG8_STAGE(PG8_SA(1, 0), cA + kstep, voffA); PG8_STAGE(PG8_SB(1, 1), cB + hstep + kstep, voffB);
        PG8_WAIT_V(6); PG8_BAR;
    } else {
        PG8_STAGE(PG8_SB(0, 0), cB, voffB); PG8_STAGE(PG8_SA(0, 0), cA, voffA); PG8_STAGE(PG8_SB(0, 1), cB + hstep, voffB); PG8_STAGE(PG8_SA(0, 1), cA + hstep, voffA);
        if (wr == 1) PG8_BAR;
        PG8_WAIT_V(4); PG8_BAR;
        PG8_STAGE(PG8_SB(1, 0), cB + kstep, voffB); PG8_STAGE(PG8_SA(1, 0), cA + kstep, voffA); PG8_STAGE(PG8_SB(1, 1), cB + hstep + kstep, voffB);
        PG8_WAIT_V(6); PG8_BAR;
    }
    for (;;) {
        const bool has_next = S.next(ui + 1, nxt);
        const char* nA = has_next ? (const char*)g.A + (size_t)nxt.pa * tstep + nxt.koff : cA; const char* nB = has_next ? (const char*)g.Bt + (size_t)nxt.pb * tstep + nxt.koff : cB;
        for (int t = 0; t < nt; t += 2) {
            const bool last = (t == nt - 2);
            const char* a1 = cA + (size_t)(t + 1) * kstep;
            const char* a2 = last ? nA : cA + (size_t)(t + 2) * kstep; const char* b2 = last ? nB : cB + (size_t)(t + 2) * kstep;
            const char* a3 = a2 + kstep; const char* b3 = b2 + kstep;
            if (last && has_next) S.a_ready(nxt);
            if constexpr (SP2) {
            PG8_LDB(B0, 0, 0); PG8_LDB(B1, 0, 1); PG8_SCHED; PG8_LDA(At, 0, 0); PG8_STAGE(PG8_SA(1, 1), a1 + hstep, voffA);
            PG8_WAIT_V(8); PG8_WAIT_L(0); PG8_BAR; PG8_MMA(0, 0, At, B0); PG8_MMA(0, 1, At, B1); PG8_BAR; PG8_SCHED;
            PG8_LDA(At, 0, 1); PG8_STAGE(PG8_SB(0, 0), b2, voffB); PG8_STAGE(PG8_SB(0, 1), b2 + hstep, voffB); PG8_STAGE(PG8_SA(0, 0), a2, voffA);
            PG8_WAIT_V(8); PG8_WAIT_L(0); PG8_BAR; PG8_MMA(1, 0, At, B0); PG8_MMA(1, 1, At, B1); PG8_BAR; PG8_SCHED;
            PG8_LDB(B0, 1, 0); PG8_LDB(B1, 1, 1); PG8_SCHED; PG8_LDA(At, 1, 0); PG8_STAGE(PG8_SA(0, 1), a2 + hstep, voffA);
            PG8_WAIT_V(8); PG8_WAIT_L(0); PG8_BAR; PG8_MMA(0, 0, At, B0); PG8_MMA(0, 1, At, B1); PG8_BAR; PG8_SCHED;
            PG8_LDA(At, 1, 1); PG8_STAGE(PG8_SB(1, 0), b3, voffB); PG8_STAGE(PG8_SB(1, 1), b3 + hstep, voffB); PG8_STAGE(PG8_SA(1, 0), a3, voffA);
            PG8_WAIT_V(8); PG8_WAIT_L(0); PG8_BAR; PG8_MMA(1, 0, At, B0); PG8_MMA(1, 1, At, B1); PG8_BAR; PG8_SCHED;
            } else {
            PG8_LDB(B0, 0, 0); PG8_SCHED; PG8_LDA(At, 0, 0); PG8_STAGE(PG8_SA(1, 1), a1 + hstep, voffA);
            PG8_WAIT_L(8); PG8_BAR; PG8_WAIT_L(0); PG8_MMA(0, 0, At, B0); PG8_BAR; PG8_SCHED;
            PG8_LDB(B1, 0, 1); PG8_STAGE(PG8_SB(0, 0), b2, voffB);
            PG8_BAR; PG8_WAIT_L(0); PG8_MMA(0, 1, At, B1); PG8_BAR;
            PG8_LDA(At, 0, 1); PG8_STAGE(PG8_SA(0, 0), a2, voffA);
            PG8_BAR; PG8_WAIT_L(0); PG8_MMA(1, 0, At, B0); PG8_BAR; PG8_SCHED;
            PG8_STAGE(PG8_SB(0, 1), b2 + hstep, voffB);
            PG8_WAIT_V(6); PG8_BAR; PG8_MMA(1, 1, At, B1); PG8_BAR;
            PG8_LDB(B0, 1, 0); PG8_SCHED; PG8_LDA(At, 1, 0); PG8_STAGE(PG8_SA(0, 1), a2 + hstep, voffA);
            PG8_WAIT_L(8); PG8_BAR; PG8_WAIT_L(0); PG8_MMA(0, 0, At, B0); PG8_BAR; PG8_SCHED;
            PG8_LDB(B1, 1, 1); PG8_STAGE(PG8_SB(1, 0), b3, voffB);
            PG8_BAR; PG8_WAIT_L(0); PG8_MMA(0, 1, At, B1); PG8_BAR;
            PG8_LDA(At, 1, 1); PG8_STAGE(PG8_SA(1, 0), a3, voffA);
            PG8_BAR; PG8_WAIT_L(0); PG8_MMA(1, 0, At, B0); PG8_BAR; PG8_SCHED;
            PG8_STAGE(PG8_SB(1, 1), b3 + hstep, voffB);
            PG8_WAIT_V(6); PG8_BAR; PG8_MMA(1, 1, At, B1); PG8_BAR;
            }
        }
        if constexpr (F8) asm volatile("s_nop 15\n\ts_nop 15" ::: "memory");
        if constexpr (ALIGN_EPI) { if (wr == 0) PG8_BAR; }
        if constexpr (!Epi::AFTER_DRAIN) { E(acc, cur, wr, wc, fr, fq); S.done(cur); }
        if (!has_next) break;
#pragma unroll
        for (int a = 0; a < 2; ++a)
#pragma unroll
            for (int b = 0; b < 2; ++b)
#pragma unroll
                for (int m = 0; m < 4; ++m)
#pragma unroll
                    for (int n = 0; n < 2; ++n) acc[a][b][m][n] = (f32x4){0.f, 0.f, 0.f, 0.f};
        cur = nxt; cA = nA; cB = nB; ++ui;
        if constexpr (ALIGN_EPI) { if (wr == 1) PG8_BAR; }
    }
    PG8_WAIT_V(0);
    if constexpr (!ALIGN_EPI) { if (wr == 0) PG8_BAR; }
    PG8_BAR;
    if constexpr (Epi::AFTER_DRAIN) { E.fused(acc, cur, wr, wc, fr, fq, lds, wid, lane); S.done(cur); }
#undef PG8_SA
#undef PG8_SB
#undef PG8_STAGE
#undef PG8_LDA
#undef PG8_LDB
#undef PG8_MMA
#undef PG8_WAIT_V
#undef PG8_WAIT_L
#undef PG8_BAR
#undef PG8_SCHED
}

struct EpiStoreBf16 {
    static constexpr bool PERM = true, AFTER_DRAIN = false, ACC_INIT = false;
    bf16_t* O; int ldc;
    __device__ __forceinline__ void operator()(const f32x4 (&acc)[2][2][4][2], const Unit& u, int wr, int wc, int fr, int fq) const {
        const int row0 = u.pm * BM + wr * 64 + fr, col0 = u.pn * BM + wc * 32 + 8 * fq;
#pragma unroll
        for (int ai = 0; ai < 2; ++ai)
#pragma unroll
            for (int m = 0; m < 4; ++m) { bf16_t* rowp = O + (size_t)(row0 + ai * HALF + m * 16) * ldc + col0;
#pragma unroll
                for (int bj = 0; bj < 2; ++bj) { const f32x4 v0 = acc[ai][bj][m][0], v1 = acc[ai][bj][m][1];
                    u32x4 w; w.x = cvt_pk_bf16(v0[0], v0[1]); w.y = cvt_pk_bf16(v0[2], v0[3]); w.z = cvt_pk_bf16(v1[0], v1[1]); w.w = cvt_pk_bf16(v1[2], v1[3]);
                    *(u32x4*)(rowp + bj * HALF) = w; } }
    }
};
struct EpiResidF32 {
    static constexpr bool PERM = false, AFTER_DRAIN = false, ACC_INIT = true;
    const float* base; float* out;
    __device__ __forceinline__ void init(f32x4 (&acc)[2][2][4][2], const Unit& u, int wr, int wc, int fr, int fq) const {
        const int row0 = u.pm * BM + wr * 64 + fr, col0 = u.pn * BM + wc * 32 + 4 * fq;
#pragma unroll
        for (int ai = 0; ai < 2; ++ai)
#pragma unroll
            for (int m = 0; m < 4; ++m) { const size_t off = (size_t)(row0 + ai * HALF + m * 16) * 1024 + col0;
#pragma unroll
                for (int bj = 0; bj < 2; ++bj)
#pragma unroll
                    for (int n = 0; n < 2; ++n) acc[ai][bj][m][n] = *(const f32x4*)(base + off + bj * HALF + n * 16); }
    }
    __device__ __forceinline__ void operator()(const f32x4 (&acc)[2][2][4][2], const Unit& u, int wr, int wc, int fr, int fq) const {
        const int row0 = u.pm * BM + wr * 64 + fr, col0 = u.pn * BM + wc * 32 + 4 * fq;
#pragma unroll
        for (int ai = 0; ai < 2; ++ai)
#pragma unroll
            for (int m = 0; m < 4; ++m) { const size_t off = (size_t)(row0 + ai * HALF + m * 16) * 1024 + col0;
#pragma unroll
                for (int bj = 0; bj < 2; ++bj)
#pragma unroll
                    for (int n = 0; n < 2; ++n) *(f32x4*)(out + off + bj * HALF + n * 16) = acc[ai][bj][m][n]; }
    }
};
__device__ __forceinline__ float silu_f(float x) { return x * __builtin_amdgcn_rcpf(1.0f + __builtin_amdgcn_exp2f(-1.44269504089f * x)); }
struct EpiSwiglu {
    static constexpr bool PERM = true, AFTER_DRAIN = false, ACC_INIT = false;
    bf16_t* C; int ldc; int row_off;
    __device__ __forceinline__ void operator()(const f32x4 (&acc)[2][2][4][2], const Unit& u, int wr, int wc, int fr, int fq) const {
        const int row0 = u.pm * BM + wr * 64 + fr - row_off, col0 = u.pn * HALF + wc * 32 + 8 * fq;
#pragma unroll
        for (int ai = 0; ai < 2; ++ai)
#pragma unroll
            for (int m = 0; m < 4; ++m) { bf16_t* rowp = C + (size_t)(row0 + ai * HALF + m * 16) * ldc + col0;
                const f32x4 g0 = acc[ai][0][m][0], g1 = acc[ai][0][m][1], u0 = acc[ai][1][m][0], u1 = acc[ai][1][m][1];
                u32x4 w; w.x = cvt_pk_bf16(silu_f(g0[0]) * u0[0], silu_f(g0[1]) * u0[1]); w.y = cvt_pk_bf16(silu_f(g0[2]) * u0[2], silu_f(g0[3]) * u0[3]);
                w.z = cvt_pk_bf16(silu_f(g1[0]) * u1[0], silu_f(g1[1]) * u1[1]); w.w = cvt_pk_bf16(silu_f(g1[2]) * u1[2], silu_f(g1[3]) * u1[3]);
                *(u32x4*)rowp = w; }
    }
};
struct EpiMoeDown {
    static constexpr bool PERM = true, AFTER_DRAIN = false, ACC_INIT = false;
    bf16_t* out2; const int* rowdst; const float* rowg; float sc;
    __device__ __forceinline__ void operator()(const f32x4 (&acc)[2][2][4][2], const Unit& u, int wr, int wc, int fr, int fq) const {
        const int row0 = u.pm * BM + wr * 64 + fr, col0 = u.pn * BM + wc * 32 + 8 * fq;
#pragma unroll
        for (int ai = 0; ai < 2; ++ai)
#pragma unroll
            for (int m = 0; m < 4; ++m) { const int gr = row0 + ai * HALF + m * 16; const int d = rowdst[gr]; const float g = rowg[gr] * sc;
                if (d >= 0) { bf16_t* rowp = out2 + (size_t)d * 1024 + col0;
#pragma unroll
                    for (int bj = 0; bj < 2; ++bj) { const f32x4 v0 = acc[ai][bj][m][0] * g, v1 = acc[ai][bj][m][1] * g;
                        u32x4 w; w.x = cvt_pk_bf16(v0[0], v0[1]); w.y = cvt_pk_bf16(v0[2], v0[3]); w.z = cvt_pk_bf16(v1[0], v1[1]); w.w = cvt_pk_bf16(v1[2], v1[3]);
                        *(u32x4*)(rowp + bj * HALF) = w; } } }
    }
};


struct EpiResidStats {
    static constexpr bool PERM = false, AFTER_DRAIN = false, ACC_INIT = true;
    const float* base; float* out; bf16_t* hn; float* ssp;
    __device__ __forceinline__ void init(f32x4 (&acc)[2][2][4][2], const Unit& u, int wr, int wc, int fr, int fq) const {
        const int row0 = u.pm * BM + wr * 64 + fr, col0 = u.pn * BM + wc * 32 + 4 * fq;
#pragma unroll
        for (int ai = 0; ai < 2; ++ai)
#pragma unroll
            for (int m = 0; m < 4; ++m) { const size_t off = (size_t)(row0 + ai * HALF + m * 16) * 1024 + col0;
#pragma unroll
                for (int bj = 0; bj < 2; ++bj)
#pragma unroll
                    for (int n = 0; n < 2; ++n) acc[ai][bj][m][n] = *(const f32x4*)(base + off + bj * HALF + n * 16); }
    }
    __device__ __forceinline__ void operator()(const f32x4 (&acc)[2][2][4][2], const Unit& u, int wr, int wc, int fr, int fq) const {
        const int row0 = u.pm * BM + wr * 64 + fr, col0 = u.pn * BM + wc * 32 + 4 * fq; typedef unsigned u32x2e __attribute__((ext_vector_type(2)));
#pragma unroll
        for (int ai = 0; ai < 2; ++ai)
#pragma unroll
            for (int m = 0; m < 4; ++m) { const int row = row0 + ai * HALF + m * 16; const size_t off = (size_t)row * 1024 + col0; float ss = 0.f;
#pragma unroll
                for (int bj = 0; bj < 2; ++bj)
#pragma unroll
                    for (int n = 0; n < 2; ++n) { const f32x4 v = acc[ai][bj][m][n]; *(f32x4*)(out + off + bj * HALF + n * 16) = v;
                        ss += (v[0] * v[0] + v[1] * v[1]) + (v[2] * v[2] + v[3] * v[3]); u32x2e w; w.x = cvt_pk_bf16(v[0], v[1]); w.y = cvt_pk_bf16(v[2], v[3]); *(u32x2e*)(hn + off + bj * HALF + n * 16) = w; }
                ss += __shfl_xor(ss, 16); ss += __shfl_xor(ss, 32);
                if (fq == 0) ssp[(size_t)row * 16 + u.pn * 4 + wc] = ss; }
    }
};
constexpr int RSTD_TAB_OFF = STAGE_BYTES;
template <class Sched> __device__ __forceinline__ void fill_rstd_table(PG8_LAS unsigned char* lds, const Sched& S, const float* ssp, int tid) {
    PG8_LAS float* tab = (PG8_LAS float*)(lds + RSTD_TAB_OFF); Unit u;
    for (int i = 0; S.next(i, u); ++i)
        if (tid < 256) { const int row = u.pm * BM + tid; const f32x4* p = (const f32x4*)(ssp + (size_t)row * 16); const f32x4 a = p[0], b = p[1], c = p[2], d = p[3];
            const float s = (((a[0] + a[1]) + (a[2] + a[3])) + ((b[0] + b[1]) + (b[2] + b[3]))) + (((c[0] + c[1]) + (c[2] + c[3])) + ((d[0] + d[1]) + (d[2] + d[3])));
            tab[i * 256 + tid] = 1.0f / sqrtf(s * (1.0f / 1024.0f) + 1e-6f); }
    __syncthreads();
}
struct EpiStoreBf16R {
    static constexpr bool PERM = true, AFTER_DRAIN = false, ACC_INIT = false;
    bf16_t* O; int ldc; const PG8_LAS float* tab;
    __device__ __forceinline__ void operator()(const f32x4 (&acc)[2][2][4][2], const Unit& u, int wr, int wc, int fr, int fq) const {
        const int row0 = u.pm * BM + wr * 64 + fr, col0 = u.pn * BM + wc * 32 + 8 * fq;
#pragma unroll
        for (int ai = 0; ai < 2; ++ai)
#pragma unroll
            for (int m = 0; m < 4; ++m) { const int row = row0 + ai * HALF + m * 16; const float r = tab[u.ord * 256 + wr * 64 + fr + ai * HALF + m * 16]; bf16_t* rowp = O + (size_t)row * ldc + col0;
#pragma unroll
                for (int bj = 0; bj < 2; ++bj) { const f32x4 v0 = acc[ai][bj][m][0] * r, v1 = acc[ai][bj][m][1] * r;
                    u32x4 w; w.x = cvt_pk_bf16(v0[0], v0[1]); w.y = cvt_pk_bf16(v0[2], v0[3]); w.z = cvt_pk_bf16(v1[0], v1[1]); w.w = cvt_pk_bf16(v1[2], v1[3]);
                    *(u32x4*)(rowp + bj * HALF) = w; } }
    }
};
struct EpiSwigluR {
    static constexpr bool PERM = true, AFTER_DRAIN = false, ACC_INIT = false;
    bf16_t* C; int ldc; const PG8_LAS float* tab;
    __device__ __forceinline__ void operator()(const f32x4 (&acc)[2][2][4][2], const Unit& u, int wr, int wc, int fr, int fq) const {
        const int row0 = u.pm * BM + wr * 64 + fr, col0 = u.pn * HALF + wc * 32 + 8 * fq;
#pragma unroll
        for (int ai = 0; ai < 2; ++ai)
#pragma unroll
            for (int m = 0; m < 4; ++m) { const int row = row0 + ai * HALF + m * 16; const float r = tab[u.ord * 256 + wr * 64 + fr + ai * HALF + m * 16]; bf16_t* rowp = C + (size_t)row * ldc + col0;
                const f32x4 g0 = acc[ai][0][m][0] * r, g1 = acc[ai][0][m][1] * r, u0 = acc[ai][1][m][0] * r, u1 = acc[ai][1][m][1] * r;
                u32x4 w; w.x = cvt_pk_bf16(silu_f(g0[0]) * u0[0], silu_f(g0[1]) * u0[1]); w.y = cvt_pk_bf16(silu_f(g0[2]) * u0[2], silu_f(g0[3]) * u0[3]);
                w.z = cvt_pk_bf16(silu_f(g1[0]) * u1[0], silu_f(g1[1]) * u1[1]); w.w = cvt_pk_bf16(silu_f(g1[2]) * u1[2], silu_f(g1[3]) * u1[3]);
                *(u32x4*)rowp = w; }
    }
};
__device__ __forceinline__ unsigned pk4_fp8(float a, float b, float c, float d) { int w = __builtin_amdgcn_cvt_pk_fp8_f32(a, b, 0, false); w = __builtin_amdgcn_cvt_pk_fp8_f32(c, d, w, true); return (unsigned)w; }
struct EpiSwiglu8 {
    static constexpr bool PERM = true, AFTER_DRAIN = false, ACC_INIT = false;
    unsigned char* C; int ldc; float isc, osc;
    __device__ __forceinline__ void operator()(const f32x4 (&acc)[2][2][4][2], const Unit& u, int wr, int wc, int fr, int fq) const {
        const int row0 = u.pm * BM + wr * 64 + fr, col0 = u.pn * HALF + wc * 32 + 8 * fq; const float us = isc * osc;
#pragma unroll
        for (int ai = 0; ai < 2; ++ai)
#pragma unroll
            for (int m = 0; m < 4; ++m) { unsigned char* rowp = C + (size_t)(row0 + ai * HALF + m * 16) * ldc + col0;
                const f32x4 g0 = acc[ai][0][m][0] * isc, g1 = acc[ai][0][m][1] * isc, u0 = acc[ai][1][m][0] * us, u1 = acc[ai][1][m][1] * us;
                typedef unsigned u32x2e __attribute__((ext_vector_type(2))); u32x2e w;
                w.x = pk4_fp8(silu_f(g0[0]) * u0[0], silu_f(g0[1]) * u0[1], silu_f(g0[2]) * u0[2], silu_f(g0[3]) * u0[3]);
                w.y = pk4_fp8(silu_f(g1[0]) * u1[0], silu_f(g1[1]) * u1[1], silu_f(g1[2]) * u1[2], silu_f(g1[3]) * u1[3]);
                *(u32x2e*)rowp = w; }
    }
};
struct MoeOrder {
    StaticOrder so; int tlo, nN, a_off; const int* tilee;
    __device__ void init(int nrt, int nN_, int G, int c, int tlo_, int a_off_, const int* tilee_, int wgm = 4) { so.init(nrt * BM, nN_ * BM, G, c, wgm); tlo = tlo_; nN = nN_; a_off = a_off_; tilee = tilee_; }
    __device__ bool next(int i, Unit& u) const { if (!so.next(i, u)) return false; u.pm += tlo; u.pa = u.pm - a_off; const int e = __builtin_amdgcn_readfirstlane(__hip_atomic_load(tilee + u.pm, __ATOMIC_RELAXED, __HIP_MEMORY_SCOPE_AGENT)); u.pb = e * nN + u.pn; return true; }
    __device__ __forceinline__ void a_ready(const Unit&) const {}
    __device__ __forceinline__ void done(const Unit&) const {}
};

struct MoeTailOrder {
    int t0, ntail, nN, S, G, c, kbytes; const int* tilee;
    __device__ bool next(int i, Unit& u) const {
        const int L = i * G + c; if (L >= ntail * nN * S) return false;
        const int piece = L % S, q = L / S, pn = q % nN, tl = q / nN;
        u.pm = t0 + tl; u.pn = pn; u.pa = u.pm; const int e = __builtin_amdgcn_readfirstlane(__hip_atomic_load(tilee + u.pm, __ATOMIC_RELAXED, __HIP_MEMORY_SCOPE_AGENT));
        u.pb = e * nN + pn; u.ord = tl * S + piece; u.koff = piece * kbytes; return true; }
    __device__ __forceinline__ void a_ready(const Unit&) const {}
    __device__ __forceinline__ void done(const Unit&) const {}
};
struct EpiPartF32 {
    static constexpr bool PERM = false, AFTER_DRAIN = false, ACC_INIT = false;
    float* part;
    __device__ __forceinline__ void operator()(const f32x4 (&acc)[2][2][4][2], const Unit& u, int wr, int wc, int fr, int fq) const {
        const int row0 = wr * 64 + fr, col0 = u.pn * BM + wc * 32 + 4 * fq; float* base = part + (size_t)u.ord * 256 * 1024;
#pragma unroll
        for (int ai = 0; ai < 2; ++ai)
#pragma unroll
            for (int m = 0; m < 4; ++m) { const size_t off = (size_t)(row0 + ai * HALF + m * 16) * 1024 + col0;
#pragma unroll
                for (int bj = 0; bj < 2; ++bj)
#pragma unroll
                    for (int n = 0; n < 2; ++n) *(f32x4*)(base + off + bj * HALF + n * 16) = acc[ai][bj][m][n]; }
    }
};
}

__device__ __forceinline__ void cvt_item(const float* W, int K, int N, bf16* WT, int mode, int item, float* scr, int lane, const float* gk = nullptr) {
    const int nblk = N / 32, kb = item / nblk, nb = item % nblk, k0 = 64 * kb, n0 = 32 * nb;
    { f32x4 v[8]; const float* src = W + (size_t)(k0 + (lane >> 3)) * N + n0 + 4 * (lane & 7);
#pragma unroll
      for (int i = 0; i < 8; ++i) v[i] = __builtin_nontemporal_load((const f32x4*)(src + (size_t)(8 * i) * N));
#pragma unroll
      for (int i = 0; i < 8; ++i) { float* d = scr + (8 * i + (lane >> 3)) * 33 + 4 * (lane & 7); const float gg = gk ? gk[k0 + 8 * i + (lane >> 3)] : 1.0f; d[0] = v[i].x * gg; d[1] = v[i].y * gg; d[2] = v[i].z * gg; d[3] = v[i].w * gg; } }
    LDS_WAIT();
    const int c = lane & 7;
#pragma unroll
    for (int j = 0; j < 4; ++j) {
        const int n = (lane >> 3) + 8 * j; const float* s = scr + (8 * c) * 33 + n;
        u32x4 o; o.x = pk2(s[0 * 33], s[1 * 33]); o.y = pk2(s[2 * 33], s[3 * 33]); o.z = pk2(s[4 * 33], s[5 * 33]); o.w = pk2(s[6 * 33], s[7 * 33]);
        const int nn = n0 + n; const int drow = mode == 0 ? nn : ((nn >> 7) * 256 + (nn & 127) + (mode == 2 ? 128 : 0));
        *(u32x4*)(WT + (size_t)drow * K + k0 + 8 * c) = o;
    }
    LDS_WAIT();
}

__device__ __forceinline__ void cvt_item8(const float* W, int K, int N, unsigned char* WT, int mode, int item, float* scr, int lane, float scale) {
    const int nblk = N / 32, kb = item / nblk, nb = item % nblk, k0 = 128 * kb, n0 = 32 * nb;
    { f32x4 v[16]; const float* src = W + (size_t)(k0 + (lane >> 3)) * N + n0 + 4 * (lane & 7);
#pragma unroll
      for (int i = 0; i < 16; ++i) v[i] = __builtin_nontemporal_load((const f32x4*)(src + (size_t)(8 * i) * N));
#pragma unroll
      for (int i = 0; i < 16; ++i) { float* d = scr + (8 * i + (lane >> 3)) * 33 + 4 * (lane & 7); d[0] = v[i].x * scale; d[1] = v[i].y * scale; d[2] = v[i].z * scale; d[3] = v[i].w * scale; } }
    LDS_WAIT();
    const int c = lane & 7;
#pragma unroll
    for (int j = 0; j < 4; ++j) {
        const int n = (lane >> 3) + 8 * j; const float* s = scr + (16 * c) * 33 + n;
        u32x4 o; o.x = pg8::pk4_fp8(s[0 * 33], s[1 * 33], s[2 * 33], s[3 * 33]); o.y = pg8::pk4_fp8(s[4 * 33], s[5 * 33], s[6 * 33], s[7 * 33]);
        o.z = pg8::pk4_fp8(s[8 * 33], s[9 * 33], s[10 * 33], s[11 * 33]); o.w = pg8::pk4_fp8(s[12 * 33], s[13 * 33], s[14 * 33], s[15 * 33]);
        const int nn = n0 + n; const int drow = mode == 0 ? nn : ((nn >> 7) * 256 + (nn & 127) + (mode == 2 ? 128 : 0));
        __builtin_nontemporal_store(o, (u32x4*)(WT + (size_t)drow * K + k0 + 16 * c));
    }
    LDS_WAIT();
}

__device__ __forceinline__ void rms_row_bf16(const float* xrow, const float* g, bf16* orow, int lane) {
    const f32x4* xr = (const f32x4*)xrow; const f32x4* gr = (const f32x4*)g;
    f32x4 v[4]; float s = 0.f;
#pragma unroll
    for (int j = 0; j < 4; ++j) { v[j] = xr[lane + 64 * j]; s += (v[j].x * v[j].x + v[j].y * v[j].y) + (v[j].z * v[j].z + v[j].w * v[j].w); }
    const float r = 1.0f / sqrtf(wave_sum(s) * (1.0f / D) + 1e-6f);
    u32x2* o8 = (u32x2*)orow;
#pragma unroll
    for (int j = 0; j < 4; ++j) { const f32x4 gv = gr[lane + 64 * j]; u32x2 w; w.x = pk2(v[j].x * r * gv.x, v[j].y * r * gv.y); w.y = pk2(v[j].z * r * gv.z, v[j].w * r * gv.w); o8[lane + 64 * j] = w; }
}

#define LAS __attribute__((address_space(3)))
#define XB_TMO      128
#define XB_XCNT(j)  (256  + 64 * (j))
#define XB_XSUB(j)  (1280 + 64 * (j))
#define XB_XGEN(j)  (2304 + 64 * (j))
#define XB_TOP      3328
#define XB_TOPGEN   3392
#define XCD_BAR_WORDS 3456
#define XB_SPIN_CAP (1u << 22)
__device__ __forceinline__ unsigned xb_ld(unsigned* p)              { return __hip_atomic_load(p, __ATOMIC_RELAXED, __HIP_MEMORY_SCOPE_AGENT); }
__device__ __forceinline__ unsigned xb_add(unsigned* p, unsigned v) { return __hip_atomic_fetch_add(p, v, __ATOMIC_RELAXED, __HIP_MEMORY_SCOPE_AGENT); }
__device__ __forceinline__ unsigned xb_xcc_id() { return (unsigned)__builtin_amdgcn_s_getreg((3 << 11) | 20) & 0xFu; }
#define XB_SPIN(cond, bar) do { unsigned _sp = 0; while (cond) { __builtin_amdgcn_s_sleep(1); \
    if ((++_sp & 255u) == 0u) { if (xb_ld(&(bar)[XB_TMO])) break; if (_sp > XB_SPIN_CAP) { atomicAdd(&(bar)[XB_TMO], 1u); break; } } } } while (0)
struct XcdBarrier { unsigned* bar; unsigned x; volatile LAS unsigned* st; };
__device__ __forceinline__ XcdBarrier xcd_barrier_post(unsigned* bar, volatile LAS unsigned* st) {
    XcdBarrier b; b.bar = bar; b.x = xb_xcc_id(); b.st = st;
    if (threadIdx.x == 0) (void)xb_add(&bar[XB_XCNT(b.x)], 1u);
    return b;
}
__device__ __forceinline__ void xcd_barrier_complete(unsigned* bar, unsigned x, unsigned& nloc, unsigned& nx) {
    const unsigned G = gridDim.x * gridDim.y * gridDim.z;
    unsigned sum, cnt, mine, sp = 0u;
    for (;;) {
        sum = 0u; cnt = 0u; mine = 0u;
#pragma unroll
        for (unsigned j = 0; j < 16; ++j) { const unsigned c = xb_ld(&bar[XB_XCNT(j)]); sum += c; cnt += (c > 0u) ? 1u : 0u; mine = (j == x) ? c : mine; }
        if (sum == G) break;
        __builtin_amdgcn_s_sleep(1);
        if ((++sp & 255u) == 0u) { if (xb_ld(&bar[XB_TMO])) break; if (sp > XB_SPIN_CAP) { atomicAdd(&bar[XB_TMO], 1u); break; } }
    }
    nloc = mine > 0u ? mine : 1u; nx = cnt > 0u ? cnt : 1u;
}
__device__ __forceinline__ void xcd_arrive(const XcdBarrier& b, bool leader) {
    asm volatile("s_waitcnt vmcnt(0)" ::: "memory");
    __syncthreads();
    if (leader) {
        unsigned* bar = b.bar;
        __builtin_amdgcn_s_waitcnt(0);
        unsigned nloc = b.st[0], nx = b.st[1];
        if (nloc == 0u) { xcd_barrier_complete(bar, b.x, nloc, nx); b.st[0] = nloc; b.st[1] = nx; }
        const unsigned old = xb_add(&bar[XB_XSUB(b.x)], 1u);
        const unsigned gen = old / nloc;
        b.st[2] = gen; b.st[3] = 0u;
        if (old + 1u == (gen + 1u) * nloc) {
            __builtin_amdgcn_fence(__ATOMIC_RELEASE, "agent");
            asm volatile("s_waitcnt vmcnt(0)" ::: "memory");
            const unsigned og = xb_add(&bar[XB_TOP], 1u);
            const unsigned tg = og / nx;
            b.st[4] = tg; b.st[3] = 1u;
            if (og + 1u == (tg + 1u) * nx) { xb_add(&bar[XB_TOPGEN], 1u); b.st[3] = 2u; }
        }
    }
}
__device__ __forceinline__ void xcd_wait(const XcdBarrier& b, bool leader) {
    if (leader) {
        unsigned* bar = b.bar; const unsigned gen = b.st[2], role = b.st[3], tg = b.st[4];
        if (role >= 1u) {
            if (role == 1u) XB_SPIN(xb_ld(&bar[XB_TOPGEN]) == tg, bar);
            __builtin_amdgcn_fence(__ATOMIC_ACQUIRE, "agent");
            xb_add(&bar[XB_XGEN(b.x)], 1u);
            asm volatile("s_waitcnt vmcnt(0)" ::: "memory");
        } else {
            XB_SPIN(xb_ld(&bar[XB_XGEN(b.x)]) == gen, bar);
            __builtin_amdgcn_fence(__ATOMIC_ACQUIRE, "agent");
            asm volatile("s_waitcnt vmcnt(0)" ::: "memory");
        }
    }
    __syncthreads();
}
__device__ __forceinline__ void xcd_barrier(const XcdBarrier& b, bool leader) { xcd_arrive(b, leader); xcd_wait(b, leader); }
constexpr int LDS_BYTES = 163840, RING_BYTES = LDS_BYTES - 512, MISC_OFF = RING_BYTES + 320;
constexpr int CW_BAR = 4096;

enum Phase { PH_PROLOGUE = 0, PH_INPROJ, PH_MIX1, PH_MIX2, PH_MIX3, PH_OUTPROJ, PH_NORM, PH_FFNUP, PH_FFNDOWN, PH_DISPATCH, PH_MOEUP, PH_MOEDOWN, PH_FINAL };


constexpr int PQ_OFF = 97792;
constexpr int RS = 528;
constexpr int AINB_STRIDE = RS;
constexpr int VTS = 144;
template <int NLD> __device__ __forceinline__ void slab_load(u32x4 (&reg)[NLD], const bf16* src, int nrows, int rvalid0, int tid) {
#pragma unroll
    for (int j = 0; j < NLD; ++j) { const int i = tid + j * NT, r = i >> 5, ch = i & 31; reg[j] = (u32x4){0u, 0u, 0u, 0u}; if (i < nrows * 32 && r >= rvalid0) reg[j] = *(const u32x4*)(src + (ptrdiff_t)r * DIN + ch * 8); }
}
template <int NLD> __device__ __forceinline__ void slab_store(const u32x4 (&reg)[NLD], unsigned char* dst, int nrows, int tid) {
#pragma unroll
    for (int j = 0; j < NLD; ++j) { const int i = tid + j * NT, r = i >> 5, ch = i & 31; if (i < nrows * 32) *(u32x4*)(dst + r * RS + ch * 16) = reg[j]; }
}
__device__ __forceinline__ void ytile_store(const unsigned char* src, bf16* y, int tid) {
    asm volatile("" : "+v"(tid) :: "memory");
#pragma unroll
    for (int j = 0; j < 4; ++j) { const int i = tid + j * NT, r = i >> 5, ch = i & 31; *(u32x4*)(y + (size_t)r * D + ch * 8) = *(const u32x4*)(src + r * RS + ch * 16); }
}
__device__ __forceinline__ int vt_off(int c, int tok) { return c * VTS + ((tok ^ (((c >> 3) & 7) << 3)) << 1); }
__device__ __forceinline__ void vt_store(const u32x4 (&reg)[4], unsigned char* vt, int tid) {
#pragma unroll
    for (int j = 0; j < 4; ++j) { const int i = tid + j * NT, r = i >> 5, ch = i & 31, c0 = ch * 8; const unsigned w[4] = {reg[j].x, reg[j].y, reg[j].z, reg[j].w};
#pragma unroll
        for (int q = 0; q < 8; ++q) *(bf16*)(vt + vt_off(c0 + q, r)) = (bf16)((q & 1) ? (w[q >> 1] >> 16) : (w[q >> 1] & 0xffffu)); }
}
struct LruParams { bf16x8 wa[2], wx[2]; float lam, ba, bx, cb, cw[4]; };
__device__ __forceinline__ void lru_params_load(LruParams& p, const bf16* wta, const bf16* wtx, const float* conv_w, const float* conv_b, const float* b_a, const float* b_x, const float* lam, int h, int nt, int lane) {
    asm volatile("" : "+v"(lane));
    const int fr = lane & 15, fq = lane >> 4, c = 64 * h + 16 * nt + fr;
#pragma unroll
    for (int ks = 0; ks < 2; ++ks) { p.wa[ks] = *(const bf16x8*)(wta + (size_t)(h * 64 + 16 * nt + fr) * 64 + 32 * ks + 8 * fq); p.wx[ks] = *(const bf16x8*)(wtx + (size_t)(h * 64 + 16 * nt + fr) * 64 + 32 * ks + 8 * fq); }
    p.lam = lam[c]; p.ba = b_a[c]; p.bx = b_x[c]; p.cb = conv_b[c];
#pragma unroll
    for (int k = 0; k < 4; ++k) p.cw[k] = conv_w[k * GW + c];
}
__device__ __forceinline__ void lru_ainb(const unsigned char* ax, const float* conv_w, const float* conv_b, unsigned char* ainb, int tid) {
    for (int idx = tid; idx < CH * 128; idx += NT) {
        const int t = idx >> 7, c = (idx & 127) * 2; float a0 = conv_b[c], a1 = conv_b[c + 1];
#pragma unroll
        for (int k = 0; k < 4; ++k) { const unsigned w = *(const unsigned*)(ax + (t + k) * RS + c * 2); a0 += conv_w[k * GW + c] * bf2f(w & 0xffffu); a1 += conv_w[k * GW + c + 1] * bf2f(w >> 16); }
        *(unsigned*)(ainb + t * RS + c * 2) = pk2(a0, a1);
    }
}
__device__ __forceinline__ void lru_gates(const unsigned char* ainb, const unsigned char* ax, const LruParams& p, int h, int nt, int lane, float (&av)[4][4], float (&uv)[4][4]) {
    const int fr = lane & 15, fq = lane >> 4, c = 64 * h + 16 * nt + fr;
    f32x4 aa[4], ax4[4];
#pragma unroll
    for (int mt = 0; mt < 4; ++mt) { aa[mt] = (f32x4){0.f, 0.f, 0.f, 0.f}; ax4[mt] = (f32x4){0.f, 0.f, 0.f, 0.f};
#pragma unroll
        for (int ks = 0; ks < 2; ++ks) { const bf16x8 x = *(const bf16x8*)(ainb + (16 * mt + fr) * RS + (64 * h + 32 * ks + 8 * fq) * 2);
            aa[mt] = __builtin_amdgcn_mfma_f32_16x16x32_bf16(x, p.wa[ks], aa[mt], 0, 0, 0); ax4[mt] = __builtin_amdgcn_mfma_f32_16x16x32_bf16(x, p.wx[ks], ax4[mt], 0, 0, 0); } }
    const float sp = log1pf(fexp(-p.lam));
#pragma unroll
    for (int mt = 0; mt < 4; ++mt)
#pragma unroll
        for (int r = 0; r < 4; ++r) { const int t = 16 * mt + 4 * fq + r; const float rg = sigmoidf_(aa[mt][r] + p.ba), ig = sigmoidf_(ax4[mt][r] + p.bx); const float loga = -8.0f * rg * sp;
            const float x2 = 2.0f * loga; const float m2 = x2 > -0.25f ? neg_expm1_small(x2) : -expm1f(x2);
            float xin = p.cb;
#pragma unroll
            for (int k = 0; k < 4; ++k) xin += p.cw[k] * bf2f(*(const bf16*)(ax + (t + k) * RS + c * 2));
            av[mt][r] = fexp(loga); uv[mt][r] = __builtin_amdgcn_sqrtf(fmaxf(m2, 0.f)) * ig * xin; }
}

constexpr int CW_CVTQ = 2048, CW_DONE = 8192;
constexpr int BG_IE1 = 8 * 112, BG_IE2 = 28 * 32, BG_ITEMS = 2 * NE * BG_IE1 + NE * BG_IE2, BG_BATCHES = BG_ITEMS / 8;
__device__ __forceinline__ void bg_convert(unsigned char* ws, unsigned char* lds_raw, const float* w1, const float* w3, const float* w2, int step, int G, int tid, bool drain) {
    unsigned* ctl = (unsigned*)(ws + WS_CTL); volatile unsigned* shq = (volatile unsigned*)(lds_raw + RING_BYTES);
    const int wid = tid >> 6, lane = tid & 63; float* scr = (float*)lds_raw + wid * (128 * 33);
    __syncthreads();
    if (tid == 0 && !drain) __hip_atomic_fetch_add(ctl + CW_DONE + 64 * step, 1u, __ATOMIC_RELAXED, __HIP_MEMORY_SCOPE_AGENT);
    for (;;) {
        if (tid == 0) { unsigned b = BG_BATCHES;
            if (drain || __hip_atomic_load(ctl + CW_DONE + 64 * step, __ATOMIC_RELAXED, __HIP_MEMORY_SCOPE_AGENT) + 16u < (unsigned)G) b = __hip_atomic_fetch_add(ctl + CW_CVTQ, 1u, __ATOMIC_RELAXED, __HIP_MEMORY_SCOPE_AGENT);
            shq[0] = b; }
        __syncthreads();
        const unsigned b = shq[0];
        __syncthreads();
        if (b >= (unsigned)BG_BATCHES) break;
        const int q = (int)b * 8 + wid;
        if (q < NE * BG_IE1) { const int e = q / BG_IE1, r = q % BG_IE1; cvt_item8(w1 + (size_t)e * D * DFFE, D, DFFE, ws + WS_W13 + (size_t)e * 2 * DFFE * D, 1, r, scr, lane, W13_SCALE); }
        else if (q < 2 * NE * BG_IE1) { const int q2 = q - NE * BG_IE1, e = q2 / BG_IE1, r = q2 % BG_IE1; cvt_item8(w3 + (size_t)e * D * DFFE, D, DFFE, ws + WS_W13 + (size_t)e * 2 * DFFE * D, 2, r, scr, lane, W13_SCALE); }
        else { const int q2 = q - 2 * NE * BG_IE1, e = q2 / BG_IE2, r = q2 % BG_IE2; cvt_item8(w2 + (size_t)e * DFFE * D, DFFE, D, ws + WS_W2 + (size_t)e * D * DFFE, 0, r, scr, lane, W2_SCALE); }
    }
}

__host__ __device__ __forceinline__ int moe_tail_split(int ntail) { return ntail * 4 * 7 <= 256 ? 7 : (ntail * 4 * 2 <= 256 ? 2 : 1); }

#define HN ((bf16*)(ws + WS_HN))
#define PROJ ((bf16*)(ws + WS_PROJ))
#define Y ((bf16*)(ws + WS_Y))
#define DS ((float*)(ws + WS_DS))
#define HID ((bf16*)(ws + WS_HID))
#define HIDE ((unsigned char*)(ws + WS_HIDE))
#define OUT2 ((bf16*)(ws + WS_OUT2))
#define XR ((unsigned char*)(ws + WS_XR))
#define SSP0 ((float*)(ws + WS_END))
#define SSP1 ((float*)(ws + WS_END + MiB))
#define PART ((float*)(ws + WS_END + 3 * MiB))
#define TOKROW SMALLP(int, SM_TOKROW)
#define SMALLP(T, off) ((T*)(ws + WS_SMALL + (off)))
#define RSTD SMALLP(float, SM_RSTD)
#define TOKE SMALLP(int, SM_TOKE)
#define TOKG SMALLP(float, SM_TOKG)
#define TOKR SMALLP(int, SM_TOKR)
#define BCNT SMALLP(int, SM_BCNT)
#define ROWDST SMALLP(int, SM_ROWDST)
#define ROWG SMALLP(float, SM_ROWG)
#define TILEE SMALLP(int, SM_TILEE)
#define CARA SMALLP(float, SM_CARA)
#define CARH SMALLP(float, SM_CARH)
#define CIN SMALLP(float, SM_CIN)
#define DEC SMALLP(float, SM_DEC)
#define WTA SMALLP(bf16, SM_WTA)
#define WTX SMALLP(bf16, SM_WTX)
#define WTP SMALLP(bf16, SM_WTP)
#define PHASE_ENTER int tid = wid_s * 64 + lane_id_asm(); asm volatile("" : "+v"(tid)); const int lane = tid & 63, wid = tid >> 6; __attribute__((address_space(1))) unsigned char* wsg_ = (__attribute__((address_space(1))) unsigned char*)a.ws; asm volatile("" : "+s"(wsg_)); unsigned char* ws = (unsigned char*)wsg_; \
    __attribute__((address_space(1))) float* hresg_ = (__attribute__((address_space(1))) float*)a.out; asm volatile("" : "+s"(hresg_)); float* hres = (float*)hresg_; \
    int bid = blockIdx.x; asm volatile("" : "+s"(bid)); int G = gridDim.x; asm volatile("" : "+s"(G)); (void)lane; (void)wid; (void)hres; (void)bid; (void)G;

__global__ void __launch_bounds__(NT) fwd(Args a) {
    extern __shared__ __attribute__((aligned(16))) unsigned char lds_raw[];
    float* ldsf = (float*)lds_raw;
    const int wid_s = __builtin_amdgcn_readfirstlane(threadIdx.x >> 6);
    { const int tid0 = threadIdx.x; for (int u = tid0; u < (LDS_BYTES - RING_BYTES) / 4; u += NT) ((LAS unsigned*)((LAS unsigned char*)lds_raw + RING_BYTES))[u] = 0u; }
    __syncthreads();
    XcdBarrier bar = xcd_barrier_post((unsigned*)(a.ws + WS_CTL) + CW_BAR, (volatile LAS unsigned*)((LAS unsigned char*)lds_raw + MISC_OFF) + 8);

#ifdef REP_STEP
    int rep_left = REP_N;
#endif
    for (int step = a.ph_lo; step < a.ph_hi; ++step) {
#ifdef REP_STEP
    const bool dry = (step == REP_STEP && rep_left > 0);
#else
    constexpr bool dry = false;
#endif
    int phase, L, pass = 0; (void)pass;
    if (step == 0) { phase = PH_PROLOGUE; L = 0; }
    else if (step < 6) { L = 0; const int s = step - 1; phase = s == 0 ? PH_INPROJ : s == 1 ? PH_MIX1 : s == 2 ? PH_OUTPROJ : s == 3 ? PH_FFNUP : PH_FFNDOWN; }
    else { L = 1; const int s = step - 6; phase = s == 0 ? PH_INPROJ : s == 1 ? PH_MIX1 : s == 2 ? PH_OUTPROJ : s == 3 ? PH_NORM : s == 4 ? PH_MOEUP : s == 5 ? PH_MOEDOWN : PH_FINAL; }
#ifdef REP_NOP
    if (dry) phase = 1000;
#endif
    switch (phase) {
    case PH_PROLOGUE: {
        PHASE_ENTER
        float* scr = ldsf + wid * (128 * 33);
        const int gw = bid * 8 + wid, NGW = G * 8;
        constexpr int I_IN = 16 * 80, I_OUT = 16 * 32, I_G = 16 * 88, I_D = 44 * 32;
        constexpr int T0 = 2 * I_IN, T1 = T0 + 2 * I_OUT, T2 = T1 + I_G, T3 = T2 + I_G, T4 = T3 + I_D;
        for (int it = gw; it < T4; it += NGW) {
            if (it < T0) { const int l = it / I_IN, r = it % I_IN; cvt_item(IN(1) + (size_t)l * D * DIN, D, DIN, (bf16*)(ws + WS_WIN) + (size_t)l * DIN * D, 0, r, scr, lane, l == 1 ? IN(15) + D : nullptr); }
            else if (it < T1) { const int q = it - T0, l = q / I_OUT, r = q % I_OUT; cvt_item(IN(2) + (size_t)l * D * D, D, D, (bf16*)(ws + WS_WOUT) + (size_t)l * D * D, 0, r, scr, lane); }
            else if (it < T2) { cvt_item(IN(17), D, DFF, (bf16*)(ws + WS_WGU), 1, it - T1, scr, lane, IN(16)); }
            else if (it < T3) { cvt_item(IN(18), D, DFF, (bf16*)(ws + WS_WGU), 2, it - T2, scr, lane, IN(16)); }
            else { cvt_item(IN(19), DFF, D, (bf16*)(ws + WS_WD), 0, it - T3, scr, lane); }
        }
        for (int m = gw; m < NTOK; m += NGW) rms_row_bf16(IN(0) + (size_t)m * D, IN(15), HN + (size_t)m * D, lane);
        for (int idx = bid * NT + tid; idx < 3 * 2 * 4 * HD * HD; idx += G * NT) {
            const int mat = idx / (2 * 4 * HD * HD), r = idx % (2 * 4 * HD * HD), lh = r >> 12, j = (r >> 6) & 63, i = r & 63;
            const float* w = mat == 0 ? IN(5) : mat == 1 ? IN(7) : IN(12);
            (mat == 0 ? WTA : mat == 1 ? WTX : WTP)[r] = (bf16)f2bf(w[(lh * 64 + i) * 64 + j]);
        }
    } break;

    case PH_INPROJ: {
        PHASE_ENTER
        pg8::Gemm g{HN, (const bf16*)(ws + WS_WIN) + (size_t)L * DIN * D, NTOK, DIN, D, 0}; pg8::StaticOrder S; S.init(NTOK, DIN, G, bid);
        if (L == 0) { pg8::EpiStoreBf16 E{PROJ, DIN}; pg8::gemm_phase<pg8::EpiStoreBf16, pg8::StaticOrder, true, true>((PG8_LAS unsigned char*)lds_raw, g, S, E, tid); }
        else { pg8::fill_rstd_table((PG8_LAS unsigned char*)lds_raw, S, SSP1, tid); pg8::EpiStoreBf16R E{PROJ, DIN, (const PG8_LAS float*)((PG8_LAS unsigned char*)lds_raw + pg8::RSTD_TAB_OFF)}; pg8::gemm_phase<pg8::EpiStoreBf16R, pg8::StaticOrder, true, true>((PG8_LAS unsigned char*)lds_raw, g, S, E, tid); }
    } break;

    case PH_MIX1: {
        PHASE_ENTER
        {
        const float* conv_w = IN(3) + L * 4 * GW; const float* conv_b = IN(4) + L * GW;
        const float* b_a = IN(6) + L * GW; const float* b_x = IN(8) + L * GW;
        const float* lam = IN(9) + L * GW; const float* lbp = IN(10);
        unsigned char* AX = lds_raw; unsigned char* AINB = lds_raw + 35376;
        unsigned char* FS = lds_raw; unsigned char* KHTl = lds_raw; unsigned char* VTl = lds_raw + 36864; float* TOTl = (float*)(lds_raw + 73728);
        unsigned* PQ = (unsigned*)(lds_raw + PQ_OFF);
        for (int ci = bid; ci < NCHUNK; ci += G) {
            const int t0 = (ci % CPB) * CH, g0 = ci * CH; const bf16* prow = PROJ + (size_t)g0 * DIN;
            LruParams lp[2];
#pragma unroll
            for (int cc = 0; cc < 2; ++cc) lru_params_load(lp[cc], WTA + L * 16384, WTX + L * 16384, conv_w, conv_b, b_a, b_x, lam, wid >> 1, 2 * (wid & 1) + cc, lane);
            int lbi = 64 * (wid >> 1) + lane; asm volatile("" : "+v"(lbi)); const float lbv = L == 0 ? 0.f : sigmoidf_(lbp[GW + lbi] - lbp[lbi]);
            u32x4 rf[4], rv[4];
            {
                u32x4 rax[5];
                int tl1 = tid; asm volatile("" : "+v"(tl1) :: "memory");
                slab_load<5>(rax, prow - 3 * DIN, 67, t0 == 0 ? 3 : 0, tl1);
                slab_store<5>(rax, AX, 67, tid);
            }
            __syncthreads();
            lru_ainb(AX, conv_w, conv_b, AINB, tid);
            __syncthreads();
#pragma unroll
            for (int cc = 0; cc < 2; ++cc) {
                const int h = wid >> 1, nt = 2 * (wid & 1) + cc, fr = lane & 15, fq = lane >> 4, c = 64 * h + 16 * nt + fr; float av[4][4], uv[4][4];
                lru_gates(AINB, AX, lp[cc], h, nt, lane, av, uv);
                float Pin = 1.f, Qin = 0.f;
#pragma unroll
                for (int mt = 0; mt < 4; ++mt) {
                    float Ai[4], Hi[4]; float A_ = 1.f, H_ = 0.f;
#pragma unroll
                    for (int r = 0; r < 4; ++r) { H_ = av[mt][r] * H_ + uv[mt][r]; A_ *= av[mt][r]; Ai[r] = A_; Hi[r] = H_; }
                    const float a1 = __shfl_up(A_, 16), h1 = __shfl_up(H_, 16), a2 = __shfl_up(A_, 32), h2 = __shfl_up(H_, 32), a3 = __shfl_up(A_, 48), h3 = __shfl_up(H_, 48);
                    float EA = 1.f, EH = 0.f;
                    if (fq >= 3) { EA = a3; EH = h3; }
                    if (fq >= 2) { EH = a2 * EH + h2; EA *= a2; }
                    if (fq >= 1) { EH = a1 * EH + h1; EA *= a1; }
                    float Pt[4], Qt[4];
#pragma unroll
                    for (int r = 0; r < 4; ++r) { const float al = Ai[r] * EA, be = Ai[r] * EH + Hi[r]; Pt[r] = al * Pin; Qt[r] = al * Qin + be; PQ[(16 * mt + 4 * fq + r) * 256 + c] = pk2(Pt[r], Qt[r]); }
                    Pin = __shfl(Pt[3], 48 + fr); Qin = __shfl(Qt[3], 48 + fr);
                }
                if (lane < 16) { CARA[ci * GW + c] = Pin; CARH[ci * GW + c] = Qin; }
                if (cc == 0) { int tl2 = tid; asm volatile("" : "+v"(tl2) :: "memory"); slab_load<4>(rf, prow + 768, 64, 0, tl2); slab_load<4>(rv, prow + 1024, 64, 0, tl2); }
            }
            __syncthreads();
            slab_store<4>(rf, FS, 64, tid); vt_store(rv, VTl, tid);
            __syncthreads();
            {
                const int h = wid >> 1, half = wid & 1, c = 64 * h + lane, fr = lane & 15, fq = lane >> 4;
                const float lb = lbv;
                float gl[32], kk[32]; float run = 0.f;
#pragma unroll
                for (int t = 0; t < 32; ++t) { const float sg = sigmoidf_(bf2f(*(const bf16*)(FS + (32 * half + t) * RS + c * 2))); run += flog(lb + (1.f - lb) * sg); gl[t] = run; kk[t] = (1.f - lb) * (1.f - sg); }
                TOTl[(h * 2 + half) * 64 + lane] = run;
                __syncthreads();
                const float tot0 = TOTl[(h * 2) * 64 + lane], glast = tot0 + TOTl[(h * 2 + 1) * 64 + lane], off = half ? tot0 : 0.f;
#pragma unroll
                for (int j = 0; j < 4; ++j) { float e[8];
#pragma unroll
                    for (int q = 0; q < 8; ++q) e[q] = kk[8 * j + q] * fexp(glast - (off + gl[8 * j + q]));
                    u32x4 w; w.x = pk2(e[0], e[1]); w.y = pk2(e[2], e[3]); w.z = pk2(e[4], e[5]); w.w = pk2(e[6], e[7]);
                    *(u32x4*)(KHTl + c * VTS + (32 * half + 8 * j) * 2) = w; }
                if (half) DEC[(ci * 4 + h) * 64 + lane] = fexp(glast);
                __syncthreads();
#pragma unroll
                for (int vvv = 0; vvv < 2; ++vvv) {
                    const int vt = 2 * half + vvv, vrow = 64 * h + 16 * vt + fr; bf16x8 bv[2];
#pragma unroll
                    for (int ks = 0; ks < 2; ++ks) bv[ks] = *(const bf16x8*)(VTl + vt_off(vrow, 32 * ks + 8 * fq));
#pragma unroll
                    for (int kt = 0; kt < 4; ++kt) { f32x4 acc = (f32x4){0.f, 0.f, 0.f, 0.f};
#pragma unroll
                        for (int ks = 0; ks < 2; ++ks) { const bf16x8 ka = *(const bf16x8*)(KHTl + (64 * h + 16 * kt + fr) * VTS + (32 * ks + 8 * fq) * 2); acc = __builtin_amdgcn_mfma_f32_16x16x32_bf16(ka, bv[ks], acc, 0, 0, 0); }
                        *(f32x4*)(DS + ((size_t)(ci * 4 + h) * 64 + 16 * vt + fr) * 64 + 16 * kt + 4 * fq) = acc; }
                }
                __syncthreads();
            }
        }
        }
        xcd_arrive(bar, tid == 0);
        {
        const float* conv_w = IN(3) + L * 4 * GW; const float* conv_b = IN(4) + L * GW; const float* b_a = IN(6) + L * GW; const float* b_x = IN(8) + L * GW; const float* lam = IN(9) + L * GW;
        const float* lbp = IN(10); const float* norm_g = IN(11) + L * HD; const float* pool_s = IN(13) + L * GW; const float* sconv_w = IN(14) + L * 3 * GW;
        unsigned char* AX = lds_raw; unsigned char* AG = lds_raw + 35376; unsigned char* AINB = lds_raw + 69168;
        unsigned char* QT3 = lds_raw; unsigned char* KT3 = lds_raw + 33792; unsigned char* OG3 = lds_raw + 67584; unsigned char* VT3 = lds_raw + 101376; float* TOT3 = (float*)(lds_raw + 138240);
        unsigned char* PS = lds_raw; unsigned char* DIMG = lds_raw + 41712; unsigned char* YST = lds_raw;
        unsigned char* SB = lds_raw; unsigned char* SC = lds_raw + 33792; unsigned char* SX = lds_raw + 68640;
        for (int ci = bid; ci < NCHUNK; ci += G) {
            const int t0 = (ci % CPB) * CH, g0 = ci * CH; const bf16* prow = PROJ + (size_t)g0 * DIN; bf16* yrow = Y + (size_t)g0 * D; (void)t0; (void)yrow;
            { u32x4 rp[5]; int tlc = tid; asm volatile("" : "+v"(tlc) :: "memory"); slab_load<5>(rp, prow - 15 * DIN + 1536, 79, t0 == 0 ? 15 : 0, tlc); slab_store<5>(rp, PS, 79, tid); }
            __syncthreads();
            for (int idx = tid; idx < CH * 128; idx += NT) {
                const int t = idx >> 7, c = (idx & 127) * 2, gi = c >> 6, w = 2 << gi; const int tt = t0 + t; const int cnt = (tt + 1 < w) ? (tt + 1) : w; float s0 = 0.f, s1 = 0.f; unsigned xs[16];
#pragma unroll
                for (int r = 0; r < 16; ++r) xs[r] = *(const unsigned*)(PS + (t + 15 - r) * RS + c * 2);
#pragma unroll
                for (int r = 0; r < 16; ++r) { const float m_ = r < cnt ? 1.0f : 0.0f; s0 += m_ * bf2f(xs[r] & 0xffffu); s1 += m_ * bf2f(xs[r] >> 16); }
                const float inv = __builtin_amdgcn_rcpf((float)cnt);
                *(unsigned*)(DIMG + t * RS + c * 2) = pk2(s0 * inv - bf2f(xs[0] & 0xffffu), s1 * inv - bf2f(xs[0] >> 16));
            }
            __syncthreads();
#pragma unroll 1
            for (int cc = 0; cc < 2; ++cc) {
                const int gi = wid >> 1, nt = 2 * (wid & 1) + cc, fr = lane & 15, fq = lane >> 4, c = 64 * gi + 16 * nt + fr; bf16x8 wp[2];
#pragma unroll
                for (int ks = 0; ks < 2; ++ks) wp[ks] = *(const bf16x8*)(WTP + L * 16384 + (size_t)(gi * 64 + 16 * nt + fr) * 64 + 32 * ks + 8 * fq);
                const float psc = pool_s[c];
#pragma unroll
                for (int mt = 0; mt < 4; ++mt) { f32x4 acc = (f32x4){0.f, 0.f, 0.f, 0.f};
#pragma unroll
                    for (int ks = 0; ks < 2; ++ks) { const bf16x8 x = *(const bf16x8*)(DIMG + (16 * mt + fr) * RS + (64 * gi + 32 * ks + 8 * fq) * 2); acc = __builtin_amdgcn_mfma_f32_16x16x32_bf16(x, wp[ks], acc, 0, 0, 0); }
#pragma unroll
                    for (int r = 0; r < 4; ++r) *(bf16*)(YST + (16 * mt + 4 * fq + r) * RS + c * 2) = (bf16)f2bf(acc[r] * psc); }
            }
            __syncthreads();
            ytile_store(YST, yrow + 512, tid);
            __syncthreads();
        }
        }
        xcd_wait(bar, tid == 0);
        {
        float* xa = ldsf; float* xs = ldsf + 512;
        for (int item = bid; item < 256 + 8; item += G) {
            if (item < 256) {
                const int el = tid & 127, seg = tid >> 7, e = item * 128 + el, b = e >> 14, hh = (e >> 12) & 3, kv = e & 4095, k = kv & 63;
                float dv[32], dc[32];
#pragma unroll
                for (int i = 0; i < 32; ++i) { const int ci = b * CPB + seg * 32 + i; dv[i] = DS[(size_t)(ci * 4 + hh) * 4096 + kv]; dc[i] = DEC[(ci * 4 + hh) * 64 + k]; }
                float S = 0.f, A = 1.f;
#pragma unroll
                for (int i = 0; i < 32; ++i) { const float d = dv[i]; dv[i] = S; S = dc[i] * S + d; const float a0 = dc[i]; dc[i] = A; A *= a0; }
                xa[seg * 128 + el] = A; xs[seg * 128 + el] = S;
                __syncthreads();
                float Sin = 0.f;
                for (int s2 = 0; s2 < seg; ++s2) Sin = xa[s2 * 128 + el] * Sin + xs[s2 * 128 + el];
#pragma unroll
                for (int i = 0; i < 32; ++i) { const int ci = b * CPB + seg * 32 + i; (dry ? DS + 20 * (MiB / 4) * 4 : DS)[(size_t)(ci * 4 + hh) * 4096 + kv] = dv[i] + dc[i] * Sin; }
                __syncthreads();
            } else {
                const int q = item - 256, sq = tid & 63, chg = q * 64 + sq, b = chg >> 8, c = chg & 255, seg = tid >> 6;
                float ca[16], chh[16];
#pragma unroll
                for (int i = 0; i < 16; ++i) { const int ci = b * CPB + seg * 16 + i; ca[i] = CARA[ci * GW + c]; chh[i] = CARH[ci * GW + c]; }
                float A = 1.f, H = 0.f;
#pragma unroll
                for (int i = 0; i < 16; ++i) { const float a0 = ca[i], h0 = chh[i]; ca[i] = A; chh[i] = H; H = a0 * H + h0; A *= a0; }
                xa[seg * 64 + sq] = A; xs[seg * 64 + sq] = H;
                __syncthreads();
                float Hin = 0.f;
                for (int s2 = 0; s2 < seg; ++s2) Hin = xa[s2 * 64 + sq] * Hin + xs[s2 * 64 + sq];
#pragma unroll
                for (int i = 0; i < 16; ++i) { const int ci = b * CPB + seg * 16 + i; CIN[ci * GW + c] = chh[i] + ca[i] * Hin; }
                __syncthreads();
            }
        }
        }
        xcd_arrive(bar, tid == 0);
        {
        const float* conv_w = IN(3) + L * 4 * GW; const float* conv_b = IN(4) + L * GW; const float* b_a = IN(6) + L * GW; const float* b_x = IN(8) + L * GW; const float* lam = IN(9) + L * GW;
        const float* lbp = IN(10); const float* norm_g = IN(11) + L * HD; const float* pool_s = IN(13) + L * GW; const float* sconv_w = IN(14) + L * 3 * GW;
        unsigned char* AX = lds_raw; unsigned char* AG = lds_raw + 35376; unsigned char* AINB = lds_raw + 69168;
        unsigned char* QT3 = lds_raw; unsigned char* KT3 = lds_raw + 33792; unsigned char* OG3 = lds_raw + 67584; unsigned char* VT3 = lds_raw + 101376; float* TOT3 = (float*)(lds_raw + 138240);
        unsigned char* PS = lds_raw; unsigned char* DIMG = lds_raw + 41712; unsigned char* YST = lds_raw;
        unsigned char* SB = lds_raw; unsigned char* SC = lds_raw + 33792; unsigned char* SX = lds_raw + 68640;
        for (int ci = bid; ci < NCHUNK; ci += G) {
            const int t0 = (ci % CPB) * CH, g0 = ci * CH; const bf16* prow = PROJ + (size_t)g0 * DIN; bf16* yrow = Y + (size_t)g0 * D; (void)t0; (void)yrow;
            { u32x4 rsb[4], rsc[5], rsx[5]; int tld = tid; asm volatile("" : "+v"(tld) :: "memory"); slab_load<4>(rsb, prow + 1792, 64, 0, tld); slab_load<5>(rsc, prow - 2 * DIN + 2048, 66, t0 == 0 ? 2 : 0, tld); slab_load<5>(rsx, prow - 2 * DIN + 2304, 66, t0 == 0 ? 2 : 0, tld);
#pragma unroll
              for (int j = 0; j < 5; ++j) {
                  const unsigned a[4] = {rsc[j].x, rsc[j].y, rsc[j].z, rsc[j].w}, b[4] = {rsx[j].x, rsx[j].y, rsx[j].z, rsx[j].w}; unsigned p[4];
#pragma unroll
                  for (int q = 0; q < 4; ++q) p[q] = pk2(bf2f(a[q] & 0xffffu) * bf2f(b[q] & 0xffffu), bf2f(a[q] >> 16) * bf2f(b[q] >> 16));
                  rsc[j] = (u32x4){p[0], p[1], p[2], p[3]}; }
              slab_store<4>(rsb, SB, 64, tid); slab_store<5>(rsc, SC, 66, tid); }
            __syncthreads();
            int tq = tid; asm volatile("" : "+v"(tq));
            for (int idx = tq; idx < CH * 128; idx += NT) {
                const int t = idx >> 7, c = (idx & 127) * 2; float a0 = 0.f, a1 = 0.f;
#pragma unroll
                for (int k = 0; k < 3; ++k) { const unsigned xc = *(const unsigned*)(SC + (t + k) * RS + c * 2); a0 += sconv_w[k * GW + c] * bf2f(xc & 0xffffu); a1 += sconv_w[k * GW + c + 1] * bf2f(xc >> 16); }
                unsigned* pb = (unsigned*)(SB + t * RS + c * 2); const unsigned b = *pb; *pb = pk2(bf2f(b & 0xffffu) * a0, bf2f(b >> 16) * a1);
            }
            __syncthreads();
            ytile_store(SB, yrow + 768, tid);
            __syncthreads();
        }
        }
        xcd_wait(bar, tid == 0);
        {
        const float* conv_w = IN(3) + L * 4 * GW; const float* conv_b = IN(4) + L * GW; const float* b_a = IN(6) + L * GW; const float* b_x = IN(8) + L * GW; const float* lam = IN(9) + L * GW;
        const float* lbp = IN(10); const float* norm_g = IN(11) + L * HD; const float* pool_s = IN(13) + L * GW; const float* sconv_w = IN(14) + L * 3 * GW;
        unsigned char* AX = lds_raw; unsigned char* AG = lds_raw + 35376; unsigned char* AINB = lds_raw + 69168;
        unsigned char* QT3 = lds_raw; unsigned char* KT3 = lds_raw + 33792; unsigned char* OG3 = lds_raw + 67584; unsigned char* VT3 = lds_raw + 101376; float* TOT3 = (float*)(lds_raw + 138240);
        unsigned char* PS = lds_raw; unsigned char* DIMG = lds_raw + 41712; unsigned char* YST = lds_raw;
        unsigned char* SB = lds_raw; unsigned char* SC = lds_raw + 33792; unsigned char* SX = lds_raw + 68640;
        for (int ci = bid; ci < NCHUNK; ci += G) {
            const int t0 = (ci % CPB) * CH, g0 = ci * CH; const bf16* prow = PROJ + (size_t)g0 * DIN; bf16* yrow = Y + (size_t)g0 * D; (void)t0; (void)yrow;
            int lbi = 64 * (wid >> 1) + lane; asm volatile("" : "+v"(lbi)); const float lbv = L == 0 ? 0.f : sigmoidf_(lbp[GW + lbi] - lbp[lbi]);
            { unsigned* PQ = (unsigned*)(lds_raw + PQ_OFF);
              const int c = (tid & 127) * 2; const float hin_a = CIN[ci * GW + c], hin_b = CIN[ci * GW + c + 1];
              unsigned ag[16];
#pragma unroll
              for (int i = 0; i < 16; ++i) ag[i] = *(const unsigned*)(prow + (size_t)(4 * i + (tid >> 7)) * DIN + 256 + c);
#pragma unroll
              for (int i = 0; i < 16; ++i) { const int t = 4 * i + (tid >> 7); const unsigned pa = PQ[t * 256 + c], pb = PQ[t * 256 + c + 1];
                  const float ha = bf2f(pa & 0xffffu) * hin_a + bf2f(pa >> 16), hb = bf2f(pb & 0xffffu) * hin_b + bf2f(pb >> 16);
                  *(unsigned*)(yrow + (size_t)t * D + c) = pk2(ha * gelu_tanh(bf2f(ag[i] & 0xffffu)), hb * gelu_tanh(bf2f(ag[i] >> 16))); }
            }
            __syncthreads();
            { u32x4 rq[4], rf[4], rv[4], rog[4]; int tlb = tid; asm volatile("" : "+v"(tlb) :: "memory"); slab_load<4>(rq, prow + 512, 64, 0, tlb); slab_load<4>(rf, prow + 768, 64, 0, tlb); slab_load<4>(rv, prow + 1024, 64, 0, tlb); slab_load<4>(rog, prow + 1280, 64, 0, tlb);
              slab_store<4>(rq, QT3, 64, tid); slab_store<4>(rf, KT3, 64, tid); slab_store<4>(rog, OG3, 64, tid); vt_store(rv, VT3, tid); }
            __syncthreads();
            {
                const int h = wid >> 1, half = wid & 1, c = 64 * h + lane, fr = lane & 15, fq = lane >> 4;
                const float lb = lbv;
                f32x4 sraw[4][2][2];
#pragma unroll
                for (int vt = 0; vt < 4; ++vt)
#pragma unroll
                    for (int ks = 0; ks < 2; ++ks) { const float* p = DS + ((size_t)(ci * 4 + h) * 64 + 16 * vt + fr) * 64 + 32 * ks + 8 * fq; sraw[vt][ks][0] = *(const f32x4*)p; sraw[vt][ks][1] = *(const f32x4*)(p + 4); }
                float gl[32]; float run = 0.f;
#pragma unroll
                for (int t = 0; t < 32; ++t) { const float sg = sigmoidf_(bf2f(*(const bf16*)(KT3 + (32 * half + t) * RS + c * 2))); run += flog(lb + (1.f - lb) * sg); gl[t] = run; }
                TOT3[(h * 2 + half) * 64 + lane] = run;
                __syncthreads();
                const float tot0 = TOT3[(h * 2) * 64 + lane];
                const float off = half ? 0.f : -tot0;
#pragma unroll
                for (int t = 0; t < 32; ++t) {
                    bf16* pq = (bf16*)(QT3 + (32 * half + t) * RS + c * 2); bf16* pk = (bf16*)(KT3 + (32 * half + t) * RS + c * 2);
                    const float sg = sigmoidf_(bf2f(*pk)), kkv = (1.f - lb) * (1.f - sg), qfv = siluf_(bf2f(*pq)), d = gl[t] + off;
                    *pq = (bf16)f2bf(qfv * fexp(d)); *pk = (bf16)f2bf(kkv * fexp(-d));
                }
                __syncthreads();
                bf16x8 sa[4][2];
#pragma unroll
                for (int vt = 0; vt < 4; ++vt)
#pragma unroll
                    for (int ks = 0; ks < 2; ++ks) {
                        const f32x4 lo = sraw[vt][ks][0], hi = sraw[vt][ks][1];
                        const float* eg = TOT3 + (h * 2) * 64 + 32 * ks + 8 * fq;
                        u32x4 w; w.x = pk2(lo.x * fexp(eg[0]), lo.y * fexp(eg[1])); w.y = pk2(lo.z * fexp(eg[2]), lo.w * fexp(eg[3])); w.z = pk2(hi.x * fexp(eg[4]), hi.y * fexp(eg[5])); w.w = pk2(hi.z * fexp(eg[6]), hi.w * fexp(eg[7]));
                        sa[vt][ks] = __builtin_bit_cast(bf16x8, w);
                    }
#pragma unroll
                for (int tsel = 0; tsel < 2; ++tsel) {
                    const int ti = half == 0 ? (tsel ? 3 : 0) : (tsel ? 2 : 1);
                    bf16x8 qb[2];
#pragma unroll
                    for (int ks = 0; ks < 2; ++ks) qb[ks] = *(const bf16x8*)(QT3 + (16 * ti + fr) * RS + (64 * h + 32 * ks + 8 * fq) * 2);
                    f32x4 st[4];
#pragma unroll
                    for (int si = 0; si < 4; ++si) { st[si] = (f32x4){0.f, 0.f, 0.f, 0.f};
                        if (si <= ti) {
#pragma unroll
                            for (int ks = 0; ks < 2; ++ks) { const bf16x8 ka = *(const bf16x8*)(KT3 + (16 * si + fr) * RS + (64 * h + 32 * ks + 8 * fq) * 2); st[si] = __builtin_amdgcn_mfma_f32_16x16x32_bf16(ka, qb[ks], st[si], 0, 0, 0); }
                            if (si == ti) {
#pragma unroll
                                for (int r = 0; r < 4; ++r) if (4 * fq + r > fr) st[si][r] = 0.f; }
                        } }
                    f32x4 oo[4];
#pragma unroll
                    for (int vt = 0; vt < 4; ++vt) { oo[vt] = (f32x4){0.f, 0.f, 0.f, 0.f};
#pragma unroll
                        for (int ks = 0; ks < 2; ++ks) oo[vt] = __builtin_amdgcn_mfma_f32_16x16x32_bf16(sa[vt][ks], qb[ks], oo[vt], 0, 0, 0); }
#pragma unroll
                    for (int p = 0; p < 2; ++p) if (2 * p <= ti) {
                        u32x4 bw; bw.x = pk2(st[2 * p][0], st[2 * p][1]); bw.y = pk2(st[2 * p][2], st[2 * p][3]); bw.z = pk2(st[2 * p + 1][0], st[2 * p + 1][1]); bw.w = pk2(st[2 * p + 1][2], st[2 * p + 1][3]);
                        const bf16x8 bfr = __builtin_bit_cast(bf16x8, bw);
#pragma unroll
                        for (int vt = 0; vt < 4; ++vt) { const int vrow = 64 * h + 16 * vt + fr; const u32x2 lo8 = *(const u32x2*)(VT3 + vt_off(vrow, 32 * p + 4 * fq)), hi8 = *(const u32x2*)(VT3 + vt_off(vrow, 32 * p + 16 + 4 * fq));
                            u32x4 aw; aw.x = lo8.x; aw.y = lo8.y; aw.z = hi8.x; aw.w = hi8.y;
                            oo[vt] = __builtin_amdgcn_mfma_f32_16x16x32_bf16(__builtin_bit_cast(bf16x8, aw), bfr, oo[vt], 0, 0, 0); }
                    }
                    float ss = 0.f;
#pragma unroll
                    for (int vt = 0; vt < 4; ++vt) ss += (oo[vt][0] * oo[vt][0] + oo[vt][1] * oo[vt][1]) + (oo[vt][2] * oo[vt][2] + oo[vt][3] * oo[vt][3]);
                    ss += __shfl_xor(ss, 16); ss += __shfl_xor(ss, 32);
                    const float rs = __builtin_amdgcn_rsqf(ss * (1.0f / HD) + 1e-5f);
#pragma unroll
                    for (int vt = 0; vt < 4; ++vt) { const int cv = 64 * h + 16 * vt + 4 * fq; u32x2* pog = (u32x2*)(OG3 + (16 * ti + fr) * RS + cv * 2); const u32x2 og = *pog; const f32x4 ng = *(const f32x4*)(norm_g + 16 * vt + 4 * fq);
                        u32x2 w; w.x = pk2(oo[vt][0] * rs * ng.x * siluf_(bf2f(og.x & 0xffffu)), oo[vt][1] * rs * ng.y * siluf_(bf2f(og.x >> 16))); w.y = pk2(oo[vt][2] * rs * ng.z * siluf_(bf2f(og.y & 0xffffu)), oo[vt][3] * rs * ng.w * siluf_(bf2f(og.y >> 16)));
                        *pog = w; }
                }
                __syncthreads();
            }
            ytile_store(OG3, yrow + 256, tid);
            __syncthreads();
        }
        }
    } break;

    case PH_OUTPROJ: {
        PHASE_ENTER
        pg8::Gemm g{Y, (const bf16*)(ws + WS_WOUT) + (size_t)L * D * D, NTOK, D, D, 0}; pg8::StaticOrder S; S.init(NTOK, D, G, bid);
        if (L == 0) { pg8::EpiResidStats E{IN(0), hres, HN, SSP0}; pg8::gemm_phase<pg8::EpiResidStats, pg8::StaticOrder, true, true>((PG8_LAS unsigned char*)lds_raw, g, S, E, tid); }
        else { pg8::EpiResidF32 E{hres, hres}; pg8::gemm_phase<pg8::EpiResidF32, pg8::StaticOrder, true, true>((PG8_LAS unsigned char*)lds_raw, g, S, E, tid); }
    } break;

    case PH_NORM: {
        PHASE_ENTER
        const float* g = IN(16) + D;
        unsigned* XROW = (unsigned*)lds_raw;
        int* sel = (int*)(lds_raw + 65536);
        int* rnk = sel + 128;
        int* sh = rnk + 128;
        int* cnts = sh + 64;
        const int blk = bid;
        {
            float wr[16][8];
            { const float* wr_ = IN(20);
#pragma unroll
              for (int j = 0; j < 4; ++j)
#pragma unroll
                for (int q = 0; q < 4; ++q) { const f32x4 w0 = *(const f32x4*)(wr_ + (size_t)(4 * (lane + 64 * j) + q) * 8), w1 = *(const f32x4*)(wr_ + (size_t)(4 * (lane + 64 * j) + q) * 8 + 4);
                    wr[j * 4 + q][0] = w0.x; wr[j * 4 + q][1] = w0.y; wr[j * 4 + q][2] = w0.z; wr[j * 4 + q][3] = w0.w; wr[j * 4 + q][4] = w1.x; wr[j * 4 + q][5] = w1.y; wr[j * 4 + q][6] = w1.z; wr[j * 4 + q][7] = w1.w; } }
            f32x4 gv[4];
#pragma unroll
            for (int j = 0; j < 4; ++j) gv[j] = ((const f32x4*)g)[lane + 64 * j];
            f32x4 vn[4];
            { const f32x4* xr = (const f32x4*)(hres + (size_t)(blk * 64 + wid * 8) * D);
#pragma unroll
              for (int j = 0; j < 4; ++j) vn[j] = xr[lane + 64 * j]; }
#pragma unroll 1
            for (int r8 = 0; r8 < 8; ++r8) {
                const int tl = wid * 8 + r8, m = blk * 64 + tl;
                f32x4 v[4]; float s = 0.f;
#pragma unroll
                for (int j = 0; j < 4; ++j) { v[j] = vn[j]; s += (v[j].x * v[j].x + v[j].y * v[j].y) + (v[j].z * v[j].z + v[j].w * v[j].w); }
                if (r8 < 7) { const f32x4* xr = (const f32x4*)(hres + (size_t)(m + 1) * D);
#pragma unroll
                    for (int j = 0; j < 4; ++j) vn[j] = xr[lane + 64 * j]; }
                const float r = 1.0f / sqrtf(wave_sum(s) * (1.0f / D) + 1e-6f);
                float lg[8] = {0.f, 0.f, 0.f, 0.f, 0.f, 0.f, 0.f, 0.f};
#pragma unroll
                for (int j = 0; j < 4; ++j) { const float y[4] = {v[j].x * r * gv[j].x, v[j].y * r * gv[j].y, v[j].z * r * gv[j].z, v[j].w * r * gv[j].w};
                    XROW[tl * 256 + lane + 64 * j] = pg8::pk4_fp8(y[0], y[1], y[2], y[3]);
#pragma unroll
                    for (int q = 0; q < 4; ++q)
#pragma unroll
                        for (int e = 0; e < 8; ++e) lg[e] += y[q] * wr[j * 4 + q][e]; }
#pragma unroll
                for (int e = 0; e < 8; ++e) lg[e] = wave_sum(lg[e]);
                if (lane == 0) {
                    int e1 = 0; float l1 = lg[0];
#pragma unroll
                    for (int e = 1; e < 8; ++e) if (lg[e] > l1) { l1 = lg[e]; e1 = e; }
                    int e2 = -1; float l2 = -3.0e38f;
#pragma unroll
                    for (int e = 0; e < 8; ++e) if (e != e1 && lg[e] > l2) { l2 = lg[e]; e2 = e; }
                    const float g1 = 1.0f / (1.0f + fexp(l2 - l1));
                    TOKG[m * 2] = g1; TOKG[m * 2 + 1] = 1.0f - g1;
                    sel[tl * 2] = e1; sel[tl * 2 + 1] = e2;
                }
            }
            __syncthreads();
            { const int e = wid;
              const bool m0 = sel[lane] == e, m1 = sel[lane + 64] == e; const unsigned long long b0 = __ballot(m0), b1 = __ballot(m1), low = (1ull << lane) - 1ull;
              const int c0 = __popcll(b0);
              if (m0) rnk[lane] = __popcll(b0 & low);
              if (m1) rnk[lane + 64] = c0 + __popcll(b1 & low);
              if (lane == 0) BCNT[blk * NE + e] = c0 + __popcll(b1); }
        }
        xcd_barrier(bar, tid == 0);
        {
            for (int i = tid; i < (NTOK / 64) * NE; i += NT) cnts[i] = BCNT[i];
            __syncthreads();
            { const int e = wid; int sall = 0, slt = 0;
#pragma unroll
              for (int i = 0; i < 4; ++i) { const int b2 = 4 * lane + i, c = cnts[b2 * NE + e]; sall += c; slt += (b2 < blk) ? c : 0; }
#pragma unroll
              for (int o = 1; o < 64; o <<= 1) { sall += __shfl_xor(sall, o); slt += __shfl_xor(slt, o); }
              if (lane == 0) { sh[e] = sall; sh[16 + e] = slt; sh[24 + e] = (sall + 255) >> 8; } }
            __syncthreads();
            if (tid == 0) { int acc = 0; for (int e = 0; e < NE; ++e) { sh[8 + e] = acc * 256; acc += sh[24 + e]; } sh[32] = acc; }
            __syncthreads();
            if (tid < 128) { const int m = blk * 64 + (tid >> 1); const int e = sel[tid]; const int r = sh[8 + e] + sh[16 + e] + rnk[tid];
                ROWDST[r] = m * 2 + (tid & 1); ROWG[r] = TOKG[blk * 128 + tid]; TOKROW[blk * 128 + tid] = r; }
#pragma unroll
            for (int r8 = 0; r8 < 8; ++r8) {
                const int tl = wid * 8 + r8; const int e0 = sel[tl * 2], e1 = sel[tl * 2 + 1];
                const int r0 = sh[8 + e0] + sh[16 + e0] + rnk[tl * 2], r1 = sh[8 + e1] + sh[16 + e1] + rnk[tl * 2 + 1];
                const u32x4 w = *(const u32x4*)(XROW + tl * 256 + 4 * lane);
                *(u32x4*)(XR + (size_t)r0 * D + 16 * lane) = w; *(u32x4*)(XR + (size_t)r1 * D + 16 * lane) = w;
            }
            if (blk == 0) {
                for (int e = 0; e < NE; ++e) { const int lo = sh[8 + e] + sh[e], hi = sh[8 + e] + sh[24 + e] * 256; for (int r = lo + tid; r < hi; r += NT) { ROWDST[r] = -1; ROWG[r] = 0.f; } }
                if (tid < MAXTILES) { int e = 0; for (int q = 0; q < NE; ++q) if (tid * 256 >= sh[8 + q]) e = q; TILEE[tid] = e; }
                if (tid == 0) TILEE[MAXTILES] = sh[32];
            }
            __syncthreads();
        }
    } break;

    case PH_FFNUP: {
        PHASE_ENTER
        pg8::Gemm g{HN, (const bf16*)(ws + WS_WGU), NTOK, 2 * DFF, D, 0}; pg8::StaticOrder S; S.init(NTOK, 2 * DFF, G, bid);
        pg8::fill_rstd_table((PG8_LAS unsigned char*)lds_raw, S, SSP0, tid);
        pg8::EpiSwigluR E{HID, DFF, (const PG8_LAS float*)((PG8_LAS unsigned char*)lds_raw + pg8::RSTD_TAB_OFF)};
        pg8::gemm_phase<pg8::EpiSwigluR, pg8::StaticOrder, true, true>((PG8_LAS unsigned char*)lds_raw, g, S, E, tid);
    } break;

    case PH_FFNDOWN: {
        PHASE_ENTER
        pg8::Gemm g{HID, (const bf16*)(ws + WS_WD), NTOK, D, DFF, 0}; pg8::StaticOrder S; S.init(NTOK, D, G, bid);
        pg8::EpiResidStats E{hres, dry ? (float*)(ws + 410 * MiB) : hres, HN, SSP1};
        pg8::gemm_phase<pg8::EpiResidStats, pg8::StaticOrder, true, true>((PG8_LAS unsigned char*)lds_raw, g, S, E, tid);
    } break;

    case PH_MOEUP: {
        PHASE_ENTER
        const int ntiles = __builtin_amdgcn_readfirstlane(__hip_atomic_load(TILEE + MAXTILES, __ATOMIC_RELAXED, __HIP_MEMORY_SCOPE_AGENT));
        pg8::Gemm g{(const bf16*)XR, (const bf16*)(ws + WS_W13), 0, 0, D / 2, 0}; pg8::MoeOrder S; S.init(ntiles, DFFE / 128, G, bid, 0, 0, TILEE);
        pg8::EpiSwiglu8 E{HIDE, DFFE, 1.0f / W13_SCALE, HID_SCALE};
        pg8::gemm_phase<pg8::EpiSwiglu8, pg8::MoeOrder, true, true, true>((PG8_LAS unsigned char*)lds_raw, g, S, E, tid);
    } break;

    case PH_MOEDOWN: {
        PHASE_ENTER
        const int ntiles = __builtin_amdgcn_readfirstlane(__hip_atomic_load(TILEE + MAXTILES, __ATOMIC_RELAXED, __HIP_MEMORY_SCOPE_AGENT));
        const int tfull = (ntiles / 64) * 64, ntail = ntiles - tfull;
        if (tfull > 0) {
            pg8::Gemm g{(const bf16*)HIDE, (const bf16*)(ws + WS_W2), 0, 0, DFFE / 2, 0}; pg8::MoeOrder S; S.init(tfull, D / 256, G, bid, 0, 0, TILEE);
            pg8::EpiMoeDown E{OUT2, ROWDST, ROWG, 1.0f / (W2_SCALE * HID_SCALE)};
            pg8::gemm_phase<pg8::EpiMoeDown, pg8::MoeOrder, true, true, true>((PG8_LAS unsigned char*)lds_raw, g, S, E, tid);
        }
        if (ntail > 0) {
            const int Sp = moe_tail_split(ntail);
            pg8::Gemm g{(const bf16*)HIDE, (const bf16*)(ws + WS_W2), 0, 0, DFFE / 2 / Sp, DFFE / 2};
            pg8::MoeTailOrder S{tfull, ntail, D / 256, Sp, G, bid, DFFE / Sp, TILEE};
            pg8::EpiPartF32 E{PART};
            pg8::gemm_phase<pg8::EpiPartF32, pg8::MoeTailOrder, true, true, true>((PG8_LAS unsigned char*)lds_raw, g, S, E, tid);
        }
    } break;

    case PH_FINAL: {
        PHASE_ENTER
        const float* g = IN(24); const int gw = bid * 8 + wid, NGW = G * 8;
        const int ntiles = __builtin_amdgcn_readfirstlane(__hip_atomic_load(TILEE + MAXTILES, __ATOMIC_RELAXED, __HIP_MEMORY_SCOPE_AGENT));
        const int tfull = (ntiles / 64) * 64, ntail = ntiles - tfull, Sp = ntail > 0 ? moe_tail_split(ntail) : 1, tail_row0 = tfull * 256; const float sc = 1.0f / (W2_SCALE * HID_SCALE);
        for (int mb = gw; mb < NTOK; mb += 8 * NGW) {
        int trow[8][2];
#pragma unroll
        for (int k = 0; k < 8; ++k) { const int m = mb + k * NGW; trow[k][0] = m < NTOK ? TOKROW[2 * m] : 0; trow[k][1] = m < NTOK ? TOKROW[2 * m + 1] : 0; }
#pragma unroll
        for (int k = 0; k < 8; ++k) { const int m = mb + k * NGW; if (m >= NTOK) break;
            f32x4* xr = (f32x4*)(hres + (size_t)m * D); const f32x4* gr = (const f32x4*)g;
            f32x4 v[4]; u32x2 ob[2][4]; float s = 0.f;
#pragma unroll
            for (int j = 0; j < 4; ++j) { v[j] = xr[lane + 64 * j]; ob[0][j] = ((const u32x2*)(OUT2 + (size_t)(2 * m) * D))[lane + 64 * j]; ob[1][j] = ((const u32x2*)(OUT2 + (size_t)(2 * m + 1) * D))[lane + 64 * j]; }
#pragma unroll
            for (int slot = 0; slot < 2; ++slot) {
                const int r = __builtin_amdgcn_readfirstlane(trow[k][slot]);
                if (r < tail_row0) {
#pragma unroll
                    for (int j = 0; j < 4; ++j) { const u32x2 p = ob[slot][j]; v[j].x += bf2f(p.x & 0xffffu); v[j].y += bf2f(p.x >> 16); v[j].z += bf2f(p.y & 0xffffu); v[j].w += bf2f(p.y >> 16); } }
                else { const int tl = (r - tail_row0) >> 8, rl = (r - tail_row0) & 255; const float gt = TOKG[2 * m + slot] * sc;
                    f32x4 q[7][4];
#pragma unroll
                    for (int p = 0; p < 7; ++p) { const f32x4* pr = (const f32x4*)(PART + ((size_t)(tl * Sp + (p < Sp ? p : 0)) * 256 + rl) * 1024);
#pragma unroll
                        for (int j = 0; j < 4; ++j) q[p][j] = pr[lane + 64 * j]; }
#pragma unroll
                    for (int p = 0; p < 7; ++p) { const float gp = p < Sp ? gt : 0.f;
#pragma unroll
                        for (int j = 0; j < 4; ++j) { v[j].x += gp * q[p][j].x; v[j].y += gp * q[p][j].y; v[j].z += gp * q[p][j].z; v[j].w += gp * q[p][j].w; } } }
            }
#pragma unroll
            for (int j = 0; j < 4; ++j) s += (v[j].x * v[j].x + v[j].y * v[j].y) + (v[j].z * v[j].z + v[j].w * v[j].w);
            const float r = 1.0f / sqrtf(wave_sum(s) * (1.0f / D) + 1e-6f);
#pragma unroll
            for (int j = 0; j < 4; ++j) { const f32x4 gv = gr[lane + 64 * j]; (dry ? (f32x4*)((float*)(ws + 410 * MiB) + (size_t)m * D) : xr)[lane + 64 * j] = (f32x4){v[j].x * r * gv.x, v[j].y * r * gv.y, v[j].z * r * gv.z, v[j].w * r * gv.w}; }
        }
        }
    } break;
    }
    if (phase == PH_INPROJ || phase == PH_FFNUP || phase == PH_NORM) {
        int t_ = wid_s * 64 + lane_id_asm(); asm volatile("" : "+v"(t_));
        __attribute__((address_space(1))) unsigned char* wsq_ = (__attribute__((address_space(1))) unsigned char*)a.ws; asm volatile("" : "+s"(wsq_)); unsigned char* ws_ = (unsigned char*)wsq_; int G_ = gridDim.x; asm volatile("" : "+s"(G_));
        bg_convert(ws_, lds_raw, IN(21), IN(22), IN(23), step, G_, t_, phase == PH_NORM);
    }
    if (step + 1 < a.ph_hi) { int t_ = wid_s * 64 + lane_id_asm(); asm volatile("" : "+v"(t_)); xcd_barrier(bar, t_ == 0); }
#ifdef REP_STEP
    if (dry) { --rep_left; --step; }
#endif
    }
}

constexpr int NSTEPS = 13;
#ifndef MK_PER_PHASE
#define MK_PER_PHASE 0
#endif

extern "C" void kernel_launch(void* const* d_in, const int* in_sizes, int n_in, void* d_out, int out_size, void* d_ws, size_t ws_size, hipStream_t stream) {
    static int grid = 0;
    if (grid == 0) {
        if (n_in != 25 || out_size != NTOK * D || ws_size < WS_END + 67 * MiB) { fprintf(stderr, "kernel_launch: unexpected shapes (n_in %d out %d ws %zu need %zu)\n", n_in, out_size, ws_size, (size_t)WS_END); grid = -1; return; }
        int dev = 0, cus = 0, per_cu = 0;
        if (hipGetDevice(&dev) != hipSuccess || hipDeviceGetAttribute(&cus, hipDeviceAttributeMultiprocessorCount, dev) != hipSuccess) { grid = -1; return; }
        if (hipFuncSetAttribute((const void*)fwd, hipFuncAttributeMaxDynamicSharedMemorySize, LDS_BYTES) != hipSuccess) { fprintf(stderr, "kernel_launch: hipFuncSetAttribute failed\n"); grid = -1; return; }
        if (hipOccupancyMaxActiveBlocksPerMultiprocessor(&per_cu, (const void*)fwd, NT, LDS_BYTES) != hipSuccess || per_cu < 1) { fprintf(stderr, "kernel_launch: occupancy query says %d blocks/CU\n", per_cu); (void)hipGetLastError(); grid = -1; return; }
        grid = cus;
        if (grid != NCHUNK) { fprintf(stderr, "kernel_launch: built for a %d-CU device (one 64-token chunk per workgroup in the mixer phase); this device has %d\n", NCHUNK, cus); grid = -1; return; }
    }
    if (grid < 0) return;
    hipMemsetAsync((char*)d_ws + WS_CTL, 0, 1 * MiB, stream);
    Args a{};
    for (int i = 0; i < 25; ++i) a.in[i] = (const float*)d_in[i];
    a.out = (float*)d_out; a.ws = (unsigned char*)d_ws;
#if MK_PER_PHASE
    for (int s = 0; s < NSTEPS; ++s) { a.ph_lo = s; a.ph_hi = s + 1; hipLaunchKernelGGL(fwd, dim3(grid), dim3(NT), LDS_BYTES, stream, a); }
#else
    a.ph_lo = 0; a.ph_hi = NSTEPS;
    hipLaunchKernelGGL(fwd, dim3(grid), dim3(NT), LDS_BYTES, stream, a);
#endif
}
```

```cpp
#include <hip/hip_runtime.h>
#include <cstdint>
#include <cstdio>

typedef unsigned short bf16;
typedef short bf16x8 __attribute__((ext_vector_type(8)));
typedef float f32x4 __attribute__((ext_vector_type(4)));
typedef unsigned u32x4 __attribute__((ext_vector_type(4)));
typedef unsigned u32x2 __attribute__((ext_vector_type(2)));

constexpr int NTOK = 16384, SEQ = 8192, D = 1024, DIN = 2560, GW = 256, HD = 64, DFF = 2816, DFFE = 3584, NE = 8;
constexpr int CH = 64, NCHUNK = NTOK / CH, CPB = SEQ / CH;
constexpr int NT = 512;
constexpr float W13_SCALE = 64.f, W2_SCALE = 128.f, HID_SCALE = 8.f, OUT2_SCALE = 16.f;
constexpr int MAXTILES = NTOK * 2 / 256 + NE;

constexpr size_t MiB = 1u << 20;
constexpr size_t WS_CTL = 0;
constexpr size_t WS_SMALL = 1 * MiB;
constexpr size_t WS_WIN = 5 * MiB;
constexpr size_t WS_WOUT = 15 * MiB;
constexpr size_t WS_WGU = 19 * MiB;
constexpr size_t WS_WD = 30 * MiB;
constexpr size_t WS_W13 = 36 * MiB;
constexpr size_t WS_W2 = 92 * MiB;
constexpr size_t WS_ACT = 120 * MiB;
constexpr size_t WS_HN = WS_ACT;
constexpr size_t WS_PROJ = WS_ACT + 32 * MiB;
constexpr size_t WS_Y = WS_ACT + 112 * MiB;
constexpr size_t WS_DS = WS_ACT + 144 * MiB;
constexpr size_t WS_HID = WS_PROJ;
constexpr size_t WS_XR = WS_ACT;
constexpr size_t WS_HIDE = WS_ACT + 34 * MiB;
constexpr size_t WS_OUT2 = WS_ACT + 153 * MiB;
constexpr size_t WS_END = WS_ACT + 217 * MiB;
constexpr size_t SM_TOKE = 0;
constexpr size_t SM_TOKG = 128 * 1024;
constexpr size_t SM_TOKR = 256 * 1024;
constexpr size_t SM_BCNT = 384 * 1024;
constexpr size_t SM_ROWTOK = 400 * 1024;
constexpr size_t SM_ROWDST = 544 * 1024;
constexpr size_t SM_ROWG = 688 * 1024;
constexpr size_t SM_TILEE = 832 * 1024;
constexpr size_t SM_CARA = 1024 * 1024;
constexpr size_t SM_CARH = 1280 * 1024;
constexpr size_t SM_CIN = 1536 * 1024;
constexpr size_t SM_DEC = 1792 * 1024;
constexpr size_t SM_RSTD = 2048 * 1024;
constexpr size_t SM_WTA = 2304 * 1024;
constexpr size_t SM_WTX = 2368 * 1024;
constexpr size_t SM_TOKROW = 2560 * 1024;
constexpr size_t SM_WTP = 2432 * 1024;

struct Args {
    const float* in[25];
    float* out;
    unsigned char* ws;
    int ph_lo, ph_hi, pad0, pad1;
};

__device__ __forceinline__ int lane_id_asm() { int l; asm volatile("v_mbcnt_lo_u32_b32 %0, -1, 0\n\tv_mbcnt_hi_u32_b32 %0, -1, %0" : "=v"(l)); return l; }
typedef const float __attribute__((address_space(1)))* gfptr_t;
__device__ __forceinline__ const float* IN(int k) { asm volatile("" : "+s"(k)); const gfptr_t p = ((const gfptr_t __attribute__((address_space(4)))*)__builtin_amdgcn_kernarg_segment_ptr())[k]; return (const float*)p; }
__device__ __forceinline__ float bf2f(unsigned v) { return __uint_as_float(v << 16); }
typedef float f32x2c __attribute__((ext_vector_type(2))); typedef __bf16 bf16x2c __attribute__((ext_vector_type(2)));
__device__ __forceinline__ unsigned pk2(float lo, float hi) { const f32x2c v = {lo, hi}; return __builtin_bit_cast(unsigned, __builtin_convertvector(v, bf16x2c)); }
__device__ __forceinline__ unsigned f2bf(float f) { return pk2(f, 0.f) & 0xffffu; }
__device__ __forceinline__ float fexp(float x) { return __builtin_amdgcn_exp2f(1.44269504089f * x); }
__device__ __forceinline__ float flog(float x) { return 0.69314718056f * __builtin_amdgcn_logf(x); }
__device__ __forceinline__ float sigmoidf_(float x) { return __builtin_amdgcn_rcpf(1.0f + __builtin_amdgcn_exp2f(-1.44269504089f * x)); }
__device__ __forceinline__ float siluf_(float x) { return x * sigmoidf_(x); }
__device__ __forceinline__ float gelu_tanh(float x) { const float u = 1.5957691216057308f * (x + 0.044715f * x * x * x); return x * sigmoidf_(u); }
__device__ __forceinline__ float neg_expm1_small(float x) { return -x * (1.0f + x * (0.5f + x * (0.16666667f + x * (0.041666668f + x * 0.0083333338f)))); }
__device__ __forceinline__ float wave_sum(float v) {
#define WS_DPP(ctrl, rmask) v += __builtin_bit_cast(float, __builtin_amdgcn_update_dpp(0, __builtin_bit_cast(int, v), ctrl, rmask, 0xf, false))
    WS_DPP(0xB1, 0xf); WS_DPP(0x4E, 0xf); WS_DPP(0x141, 0xf); WS_DPP(0x140, 0xf); WS_DPP(0x142, 0xa); WS_DPP(0x143, 0xc);
#undef WS_DPP
    return __builtin_bit_cast(float, __builtin_amdgcn_readlane(__builtin_bit_cast(int, v), 63));
}
#define LDS_WAIT() asm volatile("s_waitcnt lgkmcnt(0)" ::: "memory")

namespace pg8 {
#define PG8_LAS __attribute__((address_space(3)))
typedef unsigned short bf16_t;
typedef short bf16x8 __attribute__((ext_vector_type(8)));
typedef float f32x4 __attribute__((ext_vector_type(4)));
typedef unsigned u32x4 __attribute__((ext_vector_type(4)));
constexpr int BM = 256, BK = 64, HALF = 128, HTB = HALF * BK * 2  , STAGE_BYTES = 8 * HTB, NXCD = 8;

__host__ __device__ __forceinline__ int lds_byte(int r, int c) { const int st = (r >> 4) * 2 + (c >> 5), rr = r & 15, cc = c & 31, ob = rr * 64 + cc * 2; return st * 1024 + (ob ^ (((ob >> 9) & 1) << 5)); }
__host__ __device__ __forceinline__ void stage_rc(int b, int& R, int& C) { const int st = b / 1024, sb = b % 1024, swz = sb ^ (((sb >> 9) & 1) << 5); R = (st >> 1) * 16 + swz / 64; C = (st & 1) * 32 + (swz % 64) / 2; }
__host__ __device__ __forceinline__ int perm32(int rho) { const int n = rho >> 4, i = rho & 15; return 8 * (i >> 2) + 4 * n + (i & 3); }

struct Unit { int pm, pn, pa, pb, ord, koff; };
struct Gemm { const bf16_t* A; const bf16_t* Bt; int M, N, K; int LD; };

struct StaticOrder {
    int nM, nN, nwg, G, c, WGM;
    __host__ __device__ void init(int M, int N, int G_, int c_, int wgm = 4) { nM = M / BM; nN = N / BM; nwg = nM * nN; G = G_; c = c_; WGM = wgm; }
    __host__ __device__ bool next(int i, Unit& u) const {
        const long L = (long)i * G + c; if (L >= nwg) return false;
        int wgid = (int)L; { const int q = nwg / NXCD, r = nwg % NXCD, xcd = wgid % NXCD, off = wgid / NXCD; wgid = (xcd < r ? xcd * (q + 1) : r * (q + 1) + (xcd - r) * q) + off; }
        const int nig = WGM * nN, gid = wgid / nig, fm = gid * WGM, gsz = (nM - fm) < WGM ? (nM - fm) : WGM;
        u.pm = fm + ((wgid % nig) % gsz); u.pn = (wgid % nig) / gsz; u.pa = u.pm; u.pb = u.pn; u.ord = i; u.koff = 0; return true;
    }
    __device__ __forceinline__ void a_ready(const Unit&) const {}
    __device__ __forceinline__ void done(const Unit&) const {}
};

__device__ __forceinline__ unsigned cvt_pk_bf16(float lo, float hi) { unsigned r; asm volatile("v_cvt_pk_bf16_f32 %0, %1, %2" : "=v"(r) : "v"(lo), "v"(hi)); return r; }
typedef float f32x2 __attribute__((ext_vector_type(2)));
typedef int pg8_v8i __attribute__((ext_vector_type(8))); typedef int pg8_v4i __attribute__((ext_vector_type(4)));
__device__ __forceinline__ pg8_v8i pg8_cat(bf16x8 lo, bf16x8 hi) { return __builtin_shufflevector(__builtin_bit_cast(pg8_v4i, lo), __builtin_bit_cast(pg8_v4i, hi), 0, 1, 2, 3, 4, 5, 6, 7); }
__device__ __forceinline__ void pg8_mfma8(f32x4& acc, pg8_v8i a, pg8_v8i b, int sc) { asm volatile("v_mfma_scale_f32_16x16x128_f8f6f4 %0, %1, %2, %0, %3, %3 op_sel_hi:[0,0,0]" : "+v"(acc) : "v"(a), "v"(b), "v"(sc)); }
template <class Epi, class Sched, bool ALIGN_EPI = false, bool SP2 = false, bool F8 = false>
__device__ __forceinline__ void gemm_phase(PG8_LAS unsigned char* lds, const Gemm g, const Sched& S, const Epi& E, int tid_in) {
    int tid = tid_in; asm volatile("" : "+v"(tid));
    const int wid = __builtin_amdgcn_readfirstlane(tid >> 6), lane = tid & 63, wr = wid >> 2, wc = wid & 3, fr = lane & 15, fq = lane >> 4;
    const int K = g.LD ? g.LD : g.K, nt = g.K / BK;
    unsigned voffA[2], voffB[2];
#pragma unroll
    for (int i = 0; i < 2; ++i) { int R, C; stage_rc(tid * 16 + i * 8192, R, C); const int Rb = Epi::PERM ? ((R & ~31) + perm32(R & 31)) : R;
        voffA[i] = (unsigned)(R * K + C) * 2u; voffB[i] = (unsigned)(Rb * K + C) * 2u; }
    const size_t kstep = (size_t)(BK * 2);
    const size_t hstep = (size_t)HALF * K * 2;
    const size_t tstep = 2 * hstep;
    const unsigned ldsw = (unsigned)wid * 1024u;
    int f8one = 0x7f7f7f7f; asm volatile("" : "+v"(f8one));
    constexpr int KOFF = 1024;
    const int aoff = lds_byte(wr * 64 + fr, fq * 8), boff = lds_byte(wc * 32 + fr, fq * 8);
#define PG8_SA(b, h) (((b) * 2 + (h)) * HTB)
#define PG8_SB(b, h) ((4 + (b) * 2 + (h)) * HTB)
#define PG8_STAGE(bufoff, gbase, voff) do { _Pragma("unroll") for (int _i = 0; _i < 2; ++_i) \
        __builtin_amdgcn_global_load_lds((const unsigned*)((const char*)(gbase) + (voff)[_i]), (PG8_LAS unsigned*)(lds + (bufoff) + ldsw + _i * 8192), 16, 0, 0); } while (0)
#define PG8_LDA(dst, b, h) do { _Pragma("unroll") for (int m = 0; m < 4; ++m) _Pragma("unroll") for (int k = 0; k < 2; ++k) dst[m][k] = *(const PG8_LAS bf16x8*)(lds + PG8_SA(b, h) + aoff + m * 2048 + k * KOFF); } while (0)
#define PG8_LDB(dst, b, h) do { _Pragma("unroll") for (int n = 0; n < 2; ++n) _Pragma("unroll") for (int k = 0; k < 2; ++k) dst[n][k] = *(const PG8_LAS bf16x8*)(lds + PG8_SB(b, h) + boff + n * 2048 + k * KOFF); } while (0)
#define PG8_MMA(ai, bj, At, Bt) do { __builtin_amdgcn_s_setprio(1); if constexpr (F8) { _Pragma("unroll") for (int m = 0; m < 4; ++m) _Pragma("unroll") for (int n = 0; n < 2; ++n) \
        pg8_mfma8(acc[ai][bj][m][n], pg8_cat(Bt[n][0], Bt[n][1]), pg8_cat(At[m][0], At[m][1]), f8one); } \
    else { _Pragma("unroll") for (int m = 0; m < 4; ++m) _Pragma("unroll") for (int n = 0; n < 2; ++n) _Pragma("unroll") for (int k = 0; k < 2; ++k) \
        acc[ai][bj][m][n] = __builtin_amdgcn_mfma_f32_16x16x32_bf16(Bt[n][k], At[m][k], acc[ai][bj][m][n], 0, 0, 0); } __builtin_amdgcn_s_setprio(0); } while (0)
#define PG8_WAIT_V(n) asm volatile("s_waitcnt vmcnt(" #n ")" ::: "memory")
#define PG8_WAIT_L(n) asm volatile("s_waitcnt lgkmcnt(" #n ")" ::: "memory")
#define PG8_BAR __builtin_amdgcn_s_barrier()
#define PG8_SCHED __builtin_amdgcn_sched_barrier(0)
    Unit cur, nxt; int ui = 0;
    if (!S.next(0, cur)) return;
    f32x4 acc[2][2][4][2];
    if constexpr (Epi::ACC_INIT) E.init(acc, cur, wr, wc, fr, fq);
    else {
#pragma unroll
    for (int a = 0; a < 2; ++a)
#pragma unroll
        for (int b = 0; b < 2; ++b)
#pragma unroll
            for (int m = 0; m < 4; ++m)
#pragma unroll
                for (int n = 0; n < 2; ++n) acc[a][b][m][n] = (f32x4){0.f, 0.f, 0.f, 0.f};
    }
    bf16x8 At[4][2], B0[2][2], B1[2][2];
    const char* cA = (const char*)g.A + (size_t)cur.pa * tstep + cur.koff; const char* cB = (const char*)g.Bt + (size_t)cur.pb * tstep + cur.koff;
    S.a_ready(cur);
    if constexpr (SP2) {
        PG8_STAGE(PG8_SB(0, 0), cB, voffB); PG8_STAGE(PG8_SB(0, 1), cB + hstep, voffB); PG8_STAGE(PG8_SA(0, 0), cA, voffA); PG8_STAGE(PG8_SA(0, 1), cA + hstep, voffA);
        if (wr == 1) PG8_BAR;
        PG8_WAIT_V(2); PG8_BAR;
        PG8_STAGE(PG8_SB(1, 0), cB + kstep, voffB); PG8_STAGE(PG8_SA(1, 0), cA + kstep, voffA); PG8_STAGE(PG8_SB(1, 1), cB + hstep + kstep, voffB);
        PG8_WAIT_V(6); PG8_BAR;
    } else {
        PG8_STAGE(PG8_SB(0, 0), cB, voffB); PG8_STAGE(PG8_SA(0, 0), cA, voffA); PG8_STAGE(PG8_SB(0, 1), cB + hstep, voffB); PG8_STAGE(PG8_SA(0, 1), cA + hstep, voffA);
        if (wr == 1) PG8_BAR;
        PG8_WAIT_V(4); PG8_BAR;
        PG8_STAGE(PG8_SB(1, 0), cB + kstep, voffB); PG8_STAGE(PG8_SA(1, 0), cA + kstep, voffA); PG8_STAGE(PG8_SB(1, 1), cB + hstep + kstep, voffB);
        PG8_WAIT_V(6); PG8_BAR;
    }
    for (;;) {
        const bool has_next = S.next(ui + 1, nxt);
        const char* nA = has_next ? (const char*)g.A + (size_t)nxt.pa * tstep + nxt.koff : cA; const char* nB = has_next ? (const char*)g.Bt + (size_t)nxt.pb * tstep + nxt.koff : cB;
        for (int t = 0; t < nt; t += 2) {
            const bool last = (t == nt - 2);
            const char* a1 = cA + (size_t)(t + 1) * kstep;
            const char* a2 = last ? nA : cA + (size_t)(t + 2) * kstep; const char* b2 = last ? nB : cB + (size_t)(t + 2) * kstep;
            const char* a3 = a2 + kstep; const char* b3 = b2 + kstep;
            if (last && has_next) S.a_ready(nxt);
            if constexpr (SP2) {
            PG8_LDB(B0, 0, 0); PG8_LDB(B1, 0, 1); PG8_SCHED; PG8_LDA(At, 0, 0); PG8_STAGE(PG8_SA(1, 1), a1 + hstep, voffA);
            PG8_WAIT_V(8); PG8_WAIT_L(0); PG8_BAR; PG8_MMA(0, 0, At, B0); PG8_MMA(0, 1, At, B1); PG8_BAR; PG8_SCHED;
            PG8_LDA(At, 0, 1); PG8_STAGE(PG8_SB(0, 0), b2, voffB); PG8_STAGE(PG8_SB(0, 1), b2 + hstep, voffB); PG8_STAGE(PG8_SA(0, 0), a2, voffA);
            PG8_WAIT_V(8); PG8_WAIT_L(0); PG8_BAR; PG8_MMA(1, 0, At, B0); PG8_MMA(1, 1, At, B1); PG8_BAR; PG8_SCHED;
            PG8_LDB(B0, 1, 0); PG8_LDB(B1, 1, 1); PG8_SCHED; PG8_LDA(At, 1, 0); PG8_STAGE(PG8_SA(0, 1), a2 + hstep, voffA);
            PG8_WAIT_V(8); PG8_WAIT_L(0); PG8_BAR; PG8_MMA(0, 0, At, B0); PG8_MMA(0, 1, At, B1); PG8_BAR; PG8_SCHED;
            PG8_LDA(At, 1, 1); PG8_STAGE(PG8_SB(1, 0), b3, voffB); PG8_STAGE(PG8_SB(1, 1), b3 + hstep, voffB); PG8_STAGE(PG8_SA(1, 0), a3, voffA);
            PG8_WAIT_V(8); PG8_WAIT_L(0); PG8_BAR; PG8_MMA(1, 0, At, B0); PG8_MMA(1, 1, At, B1); PG8_BAR; PG8_SCHED;
            } else {
            PG8_LDB(B0, 0, 0); PG8_SCHED; PG8_LDA(At, 0, 0); PG8_STAGE(PG8_SA(1, 1), a1 + hstep, voffA);
            PG8_WAIT_L(8); PG8_BAR; PG8_WAIT_L(0); PG8_MMA(0, 0, At, B0); PG8_BAR; PG8_SCHED;
            PG8_LDB(B1, 0, 1); PG8_STAGE(PG8_SB(0, 0), b2, voffB);
            PG8_BAR; PG8_WAIT_L(0); PG8_MMA(0, 1, At, B1); PG8_BAR;
            PG8_LDA(At, 0, 1); PG8_STAGE(PG8_SA(0, 0), a2, voffA);
            PG8_BAR; PG8_WAIT_L(0); PG8_MMA(1, 0, At, B0); PG8_BAR; PG8_SCHED;
            PG8_STAGE(PG8_SB(0, 1), b2 + hstep, voffB);
            PG8_WAIT_V(6); PG8_BAR; PG8_MMA(1, 1, At, B1); PG8_BAR;
            PG8_LDB(B0, 1, 0); PG8_SCHED; PG8_LDA(At, 1, 0); PG8_STAGE(PG8_SA(0, 1), a2 + hstep, voffA);
            PG8_WAIT_L(8); PG8_BAR; PG8_WAIT_L(0); PG8_MMA(0, 0, At, B0); PG8_BAR; PG8_SCHED;
            PG8_LDB(B1, 1, 1); PG8_STAGE(PG8_SB(1, 0), b3, voffB);
            PG8_BAR; PG8_WAIT_L(0); PG8_MMA(0, 1, At, B1); PG8_BAR;
            PG8_LDA(At, 1, 1); PG8_STAGE(PG8_SA(1, 0), a3, voffA);
            PG8_BAR; PG8_WAIT_L(0); PG8_MMA(1, 0, At, B0); PG8_BAR; PG8_SCHED;
            PG8_STAGE(PG8_SB(1, 1), b3 + hstep, voffB);
            PG8_WAIT_V(6); PG8_BAR; PG8_MMA(1, 1, At, B1); PG8_BAR;
            }
        }
        if constexpr (F8) asm volatile("s_nop 15\n\ts_nop 15" ::: "memory");
        if constexpr (ALIGN_EPI) { if (wr == 0) PG8_BAR; }
        if constexpr (!Epi::AFTER_DRAIN) { E(acc, cur, wr, wc, fr, fq); S.done(cur); }
        if (!has_next) break;
#pragma unroll
        for (int a = 0; a < 2; ++a)
#pragma unroll
            for (int b = 0; b < 2; ++b)
#pragma unroll
                for (int m = 0; m < 4; ++m)
#pragma unroll
                    for (int n = 0; n < 2; ++n) acc[a][b][m][n] = (f32x4){0.f, 0.f, 0.f, 0.f};
        cur = nxt; cA = nA; cB = nB; ++ui;
        if constexpr (ALIGN_EPI) { if (wr == 1) PG8_BAR; }
    }
    PG8_WAIT_V(0);
    if constexpr (!ALIGN_EPI) { if (wr == 0) PG8_BAR; }
    PG8_BAR;
    if constexpr (Epi::AFTER_DRAIN) { E.fused(acc, cur, wr, wc, fr, fq, lds, wid, lane); S.done(cur); }
#undef PG8_SA
#undef PG8_SB
#undef PG8_STAGE
#undef PG8_LDA
#undef PG8_LDB
#undef PG8_MMA
#undef PG8_WAIT_V
#undef PG8_WAIT_L
#undef PG8_BAR
#undef PG8_SCHED
}

struct EpiStoreBf16 {
    static constexpr bool PERM = true, AFTER_DRAIN = false, ACC_INIT = false;
    bf16_t* O; int ldc;
    __device__ __forceinline__ void operator()(const f32x4 (&acc)[2][2][4][2], const Unit& u, int wr, int wc, int fr, int fq) const {
        const int row0 = u.pm * BM + wr * 64 + fr, col0 = u.pn * BM + wc * 32 + 8 * fq;
#pragma unroll
        for (int ai = 0; ai < 2; ++ai)
#pragma unroll
            for (int m = 0; m < 4; ++m) { bf16_t* rowp = O + (size_t)(row0 + ai * HALF + m * 16) * ldc + col0;
#pragma unroll
                for (int bj = 0; bj < 2; ++bj) { const f32x4 v0 = acc[ai][bj][m][0], v1 = acc[ai][bj][m][1];
                    u32x4 w; w.x = cvt_pk_bf16(v0[0], v0[1]); w.y = cvt_pk_bf16(v0[2], v0[3]); w.z = cvt_pk_bf16(v1[0], v1[1]); w.w = cvt_pk_bf16(v1[2], v1[3]);
                    *(u32x4*)(rowp + bj * HALF) = w; } }
    }
};
struct EpiResidF32 {
    static constexpr bool PERM = false, AFTER_DRAIN = false, ACC_INIT = true;
    const float* base; float* out;
    __device__ __forceinline__ void init(f32x4 (&acc)[2][2][4][2], const Unit& u, int wr, int wc, int fr, int fq) const {
        const int row0 = u.pm * BM + wr * 64 + fr, col0 = u.pn * BM + wc * 32 + 4 * fq;
#pragma unroll
        for (int ai = 0; ai < 2; ++ai)
#pragma unroll
            for (int m = 0; m < 4; ++m) { const size_t off = (size_t)(row0 + ai * HALF + m * 16) * 1024 + col0;
#pragma unroll
                for (int bj = 0; bj < 2; ++bj)
#pragma unroll
                    for (int n = 0; n < 2; ++n) acc[ai][bj][m][n] = *(const f32x4*)(base + off + bj * HALF + n * 16); }
    }
    __device__ __forceinline__ void operator()(const f32x4 (&acc)[2][2][4][2], const Unit& u, int wr, int wc, int fr, int fq) const {
        const int row0 = u.pm * BM + wr * 64 + fr, col0 = u.pn * BM + wc * 32 + 4 * fq;
#pragma unroll
        for (int ai = 0; ai < 2; ++ai)
#pragma unroll
            for (int m = 0; m < 4; ++m) { const size_t off = (size_t)(row0 + ai * HALF + m * 16) * 1024 + col0;
#pragma unroll
                for (int bj = 0; bj < 2; ++bj)
#pragma unroll
                    for (int n = 0; n < 2; ++n) *(f32x4*)(out + off + bj * HALF + n * 16) = acc[ai][bj][m][n]; }
    }
};
__device__ __forceinline__ float silu_f(float x) { return x * __builtin_amdgcn_rcpf(1.0f + __builtin_amdgcn_exp2f(-1.44269504089f * x)); }
struct EpiSwiglu {
    static constexpr bool PERM = true, AFTER_DRAIN = false, ACC_INIT = false;
    bf16_t* C; int ldc; int row_off;
    __device__ __forceinline__ void operator()(const f32x4 (&acc)[2][2][4][2], const Unit& u, int wr, int wc, int fr, int fq) const {
        const int row0 = u.pm * BM + wr * 64 + fr - row_off, col0 = u.pn * HALF + wc * 32 + 8 * fq;
#pragma unroll
        for (int ai = 0; ai < 2; ++ai)
#pragma unroll
            for (int m = 0; m < 4; ++m) { bf16_t* rowp = C + (size_t)(row0 + ai * HALF + m * 16) * ldc + col0;
                const f32x4 g0 = acc[ai][0][m][0], g1 = acc[ai][0][m][1], u0 = acc[ai][1][m][0], u1 = acc[ai][1][m][1];
                u32x4 w; w.x = cvt_pk_bf16(silu_f(g0[0]) * u0[0], silu_f(g0[1]) * u0[1]); w.y = cvt_pk_bf16(silu_f(g0[2]) * u0[2], silu_f(g0[3]) * u0[3]);
                w.z = cvt_pk_bf16(silu_f(g1[0]) * u1[0], silu_f(g1[1]) * u1[1]); w.w = cvt_pk_bf16(silu_f(g1[2]) * u1[2], silu_f(g1[3]) * u1[3]);
                *(u32x4*)rowp = w; }
    }
};
__device__ __forceinline__ unsigned pk4_fp8(float a, float b, float c, float d) { int w = __builtin_amdgcn_cvt_pk_fp8_f32(a, b, 0, false); w = __builtin_amdgcn_cvt_pk_fp8_f32(c, d, w, true); return (unsigned)w; }
struct EpiMoeDown {
    static constexpr bool PERM = true, AFTER_DRAIN = false, ACC_INIT = false;
    unsigned char* out2; const int* rowdst; const float* rowg; float sc;
    __device__ __forceinline__ void operator()(const f32x4 (&acc)[2][2][4][2], const Unit& u, int wr, int wc, int fr, int fq) const {
        const int row0 = u.pm * BM + wr * 64 + fr, col0 = u.pn * BM + wc * 32 + 8 * fq; typedef unsigned u32x2e __attribute__((ext_vector_type(2)));
#pragma unroll
        for (int ai = 0; ai < 2; ++ai)
#pragma unroll
            for (int m = 0; m < 4; ++m) { const int gr = row0 + ai * HALF + m * 16; const int d = rowdst[gr]; const float g = rowg[gr] * sc;
                if (d >= 0) { unsigned char* rowp = out2 + (size_t)d * 1024 + col0;
#pragma unroll
                    for (int bj = 0; bj < 2; ++bj) { const f32x4 v0 = acc[ai][bj][m][0] * g, v1 = acc[ai][bj][m][1] * g;
                        u32x2e w; w.x = pk4_fp8(v0[0], v0[1], v0[2], v0[3]); w.y = pk4_fp8(v1[0], v1[1], v1[2], v1[3]);
                        *(u32x2e*)(rowp + bj * HALF) = w; } } }
    }
};


struct EpiResidStats {
    static constexpr bool PERM = false, AFTER_DRAIN = false, ACC_INIT = true;
    const float* base; float* out; bf16_t* hn; float* ssp;
    __device__ __forceinline__ void init(f32x4 (&acc)[2][2][4][2], const Unit& u, int wr, int wc, int fr, int fq) const {
        const int row0 = u.pm * BM + wr * 64 + fr, col0 = u.pn * BM + wc * 32 + 4 * fq;
#pragma unroll
        for (int ai = 0; ai < 2; ++ai)
#pragma unroll
            for (int m = 0; m < 4; ++m) { const size_t off = (size_t)(row0 + ai * HALF + m * 16) * 1024 + col0;
#pragma unroll
                for (int bj = 0; bj < 2; ++bj)
#pragma unroll
                    for (int n = 0; n < 2; ++n) acc[ai][bj][m][n] = *(const f32x4*)(base + off + bj * HALF + n * 16); }
    }
    __device__ __forceinline__ void operator()(const f32x4 (&acc)[2][2][4][2], const Unit& u, int wr, int wc, int fr, int fq) const {
        const int row0 = u.pm * BM + wr * 64 + fr, col0 = u.pn * BM + wc * 32 + 4 * fq; typedef unsigned u32x2e __attribute__((ext_vector_type(2)));
#pragma unroll
        for (int ai = 0; ai < 2; ++ai)
#pragma unroll
            for (int m = 0; m < 4; ++m) { const int row = row0 + ai * HALF + m * 16; const size_t off = (size_t)row * 1024 + col0; float ss = 0.f;
#pragma unroll
                for (int bj = 0; bj < 2; ++bj)
#pragma unroll
                    for (int n = 0; n < 2; ++n) { const f32x4 v = acc[ai][bj][m][n]; *(f32x4*)(out + off + bj * HALF + n * 16) = v;
                        ss += (v[0] * v[0] + v[1] * v[1]) + (v[2] * v[2] + v[3] * v[3]); u32x2e w; w.x = cvt_pk_bf16(v[0], v[1]); w.y = cvt_pk_bf16(v[2], v[3]); *(u32x2e*)(hn + off + bj * HALF + n * 16) = w; }
                ss += __shfl_xor(ss, 16); ss += __shfl_xor(ss, 32);
                if (fq == 0) ssp[(size_t)row * 16 + u.pn * 4 + wc] = ss; }
    }
};
constexpr int RSTD_TAB_OFF = STAGE_BYTES;
template <class Sched> __device__ __forceinline__ void fill_rstd_table(PG8_LAS unsigned char* lds, const Sched& S, const float* ssp, int tid) {
    PG8_LAS float* tab = (PG8_LAS float*)(lds + RSTD_TAB_OFF); Unit u;
    for (int i = 0; S.next(i, u); ++i)
        if (tid < 256) { const int row = u.pm * BM + tid; const f32x4* p = (const f32x4*)(ssp + (size_t)row * 16); const f32x4 a = p[0], b = p[1], c = p[2], d = p[3];
            const float s = (((a[0] + a[1]) + (a[2] + a[3])) + ((b[0] + b[1]) + (b[2] + b[3]))) + (((c[0] + c[1]) + (c[2] + c[3])) + ((d[0] + d[1]) + (d[2] + d[3])));
            tab[i * 256 + tid] = 1.0f / sqrtf(s * (1.0f / 1024.0f) + 1e-6f); }
    __syncthreads();
}
struct EpiStoreBf16R {
    static constexpr bool PERM = true, AFTER_DRAIN = false, ACC_INIT = false;
    bf16_t* O; int ldc; const PG8_LAS float* tab;
    __device__ __forceinline__ void operator()(const f32x4 (&acc)[2][2][4][2], const Unit& u, int wr, int wc, int fr, int fq) const {
        const int row0 = u.pm * BM + wr * 64 + fr, col0 = u.pn * BM + wc * 32 + 8 * fq;
#pragma unroll
        for (int ai = 0; ai < 2; ++ai)
#pragma unroll
            for (int m = 0; m < 4; ++m) { const int row = row0 + ai * HALF + m * 16; const float r = tab[u.ord * 256 + wr * 64 + fr + ai * HALF + m * 16]; bf16_t* rowp = O + (size_t)row * ldc + col0;
#pragma unroll
                for (int bj = 0; bj < 2; ++bj) { const f32x4 v0 = acc[ai][bj][m][0] * r, v1 = acc[ai][bj][m][1] * r;
                    u32x4 w; w.x = cvt_pk_bf16(v0[0], v0[1]); w.y = cvt_pk_bf16(v0[2], v0[3]); w.z = cvt_pk_bf16(v1[0], v1[1]); w.w = cvt_pk_bf16(v1[2], v1[3]);
                    *(u32x4*)(rowp + bj * HALF) = w; } }
    }
};
struct EpiSwigluR {
    static constexpr bool PERM = true, AFTER_DRAIN = false, ACC_INIT = false;
    bf16_t* C; int ldc; const PG8_LAS float* tab;
    __device__ __forceinline__ void operator()(const f32x4 (&acc)[2][2][4][2], const Unit& u, int wr, int wc, int fr, int fq) const {
        const int row0 = u.pm * BM + wr * 64 + fr, col0 = u.pn * HALF + wc * 32 + 8 * fq;
#pragma unroll
        for (int ai = 0; ai < 2; ++ai)
#pragma unroll
            for (int m = 0; m < 4; ++m) { const int row = row0 + ai * HALF + m * 16; const float r = tab[u.ord * 256 + wr * 64 + fr + ai * HALF + m * 16]; bf16_t* rowp = C + (size_t)row * ldc + col0;
                const f32x4 g0 = acc[ai][0][m][0] * r, g1 = acc[ai][0][m][1] * r, u0 = acc[ai][1][m][0] * r, u1 = acc[ai][1][m][1] * r;
                u32x4 w; w.x = cvt_pk_bf16(silu_f(g0[0]) * u0[0], silu_f(g0[1]) * u0[1]); w.y = cvt_pk_bf16(silu_f(g0[2]) * u0[2], silu_f(g0[3]) * u0[3]);
                w.z = cvt_pk_bf16(silu_f(g1[0]) * u1[0], silu_f(g1[1]) * u1[1]); w.w = cvt_pk_bf16(silu_f(g1[2]) * u1[2], silu_f(g1[3]) * u1[3]);
                *(u32x4*)rowp = w; }
    }
};
struct EpiSwiglu8 {
    static constexpr bool PERM = true, AFTER_DRAIN = false, ACC_INIT = false;
    unsigned char* C; int ldc; float isc, osc;
    __device__ __forceinline__ void operator()(const f32x4 (&acc)[2][2][4][2], const Unit& u, int wr, int wc, int fr, int fq) const {
        const int row0 = u.pm * BM + wr * 64 + fr, col0 = u.pn * HALF + wc * 32 + 8 * fq; const float us = isc * osc;
#pragma unroll
        for (int ai = 0; ai < 2; ++ai)
#pragma unroll
            for (int m = 0; m < 4; ++m) { unsigned char* rowp = C + (size_t)(row0 + ai * HALF + m * 16) * ldc + col0;
                const f32x4 g0 = acc[ai][0][m][0] * isc, g1 = acc[ai][0][m][1] * isc, u0 = acc[ai][1][m][0] * us, u1 = acc[ai][1][m][1] * us;
                typedef unsigned u32x2e __attribute__((ext_vector_type(2))); u32x2e w;
                w.x = pk4_fp8(silu_f(g0[0]) * u0[0], silu_f(g0[1]) * u0[1], silu_f(g0[2]) * u0[2], silu_f(g0[3]) * u0[3]);
                w.y = pk4_fp8(silu_f(g1[0]) * u1[0], silu_f(g1[1]) * u1[1], silu_f(g1[2]) * u1[2], silu_f(g1[3]) * u1[3]);
                *(u32x2e*)rowp = w; }
    }
};
struct MoeOrder {
    StaticOrder so; int tlo, nN, a_off; const int* tilee;
    __device__ void init(int nrt, int nN_, int G, int c, int tlo_, int a_off_, const int* tilee_, int wgm = 4) { so.init(nrt * BM, nN_ * BM, G, c, wgm); tlo = tlo_; nN = nN_; a_off = a_off_; tilee = tilee_; }
    __device__ bool next(int i, Unit& u) const { if (!so.next(i, u)) return false; u.pm += tlo; u.pa = u.pm - a_off; const int e = __builtin_amdgcn_readfirstlane(__hip_atomic_load(tilee + u.pm, __ATOMIC_RELAXED, __HIP_MEMORY_SCOPE_AGENT)); u.pb = e * nN + u.pn; return true; }
    __device__ __forceinline__ void a_ready(const Unit&) const {}
    __device__ __forceinline__ void done(const Unit&) const {}
};

struct MoeTailOrder {
    int t0, ntail, nN, S, G, c, kbytes; const int* tilee;
    __device__ bool next(int i, Unit& u) const {
        const int L = i * G + c; if (L >= ntail * nN * S) return false;
        const int piece = L % S, q = L / S, pn = q % nN, tl = q / nN;
        u.pm = t0 + tl; u.pn = pn; u.pa = u.pm; const int e = __builtin_amdgcn_readfirstlane(__hip_atomic_load(tilee + u.pm, __ATOMIC_RELAXED, __HIP_MEMORY_SCOPE_AGENT));
        u.pb = e * nN + pn; u.ord = tl * S + piece; u.koff = piece * kbytes; return true; }
    __device__ __forceinline__ void a_ready(const Unit&) const {}
    __device__ __forceinline__ void done(const Unit&) const {}
};
struct EpiPartF32 {
    static constexpr bool PERM = false, AFTER_DRAIN = false, ACC_INIT = false;
    float* part;
    __device__ __forceinline__ void operator()(const f32x4 (&acc)[2][2][4][2], const Unit& u, int wr, int wc, int fr, int fq) const {
        const int row0 = wr * 64 + fr, col0 = u.pn * BM + wc * 32 + 4 * fq; float* base = part + (size_t)u.ord * 256 * 1024;
#pragma unroll
        for (int ai = 0; ai < 2; ++ai)
#pragma unroll
            for (int m = 0; m < 4; ++m) { const size_t off = (size_t)(row0 + ai * HALF + m * 16) * 1024 + col0;
#pragma unroll
                for (int bj = 0; bj < 2; ++bj)
#pragma unroll
                    for (int n = 0; n < 2; ++n) *(f32x4*)(base + off + bj * HALF + n * 16) = acc[ai][bj][m][n]; }
    }
};
}

__device__ __forceinline__ void cvt_item(const float* W, int K, int N, bf16* WT, int mode, int item, float* scr, int lane, const float* gk = nullptr) {
    const int nblk = N / 32, kb = item / nblk, nb = item % nblk, k0 = 64 * kb, n0 = 32 * nb;
    { f32x4 v[8]; const float* src = W + (size_t)(k0 + (lane >> 3)) * N + n0 + 4 * (lane & 7);
#pragma unroll
      for (int i = 0; i < 8; ++i) v[i] = __builtin_nontemporal_load((const f32x4*)(src + (size_t)(8 * i) * N));
#pragma unroll
      for (int i = 0; i < 8; ++i) { float* d = scr + (8 * i + (lane >> 3)) * 33 + 4 * (lane & 7); const float gg = gk ? gk[k0 + 8 * i + (lane >> 3)] : 1.0f; d[0] = v[i].x * gg; d[1] = v[i].y * gg; d[2] = v[i].z * gg; d[3] = v[i].w * gg; } }
    LDS_WAIT();
    const int c = lane & 7;
#pragma unroll
    for (int j = 0; j < 4; ++j) {
        const int n = (lane >> 3) + 8 * j; const float* s = scr + (8 * c) * 33 + n;
        u32x4 o; o.x = pk2(s[0 * 33], s[1 * 33]); o.y = pk2(s[2 * 33], s[3 * 33]); o.z = pk2(s[4 * 33], s[5 * 33]); o.w = pk2(s[6 * 33], s[7 * 33]);
        const int nn = n0 + n; const int drow = mode == 0 ? nn : ((nn >> 7) * 256 + (nn & 127) + (mode == 2 ? 128 : 0));
        *(u32x4*)(WT + (size_t)drow * K + k0 + 8 * c) = o;
    }
    LDS_WAIT();
}

__device__ __forceinline__ void cvt_item8(const float* W, int K, int N, unsigned char* WT, int mode, int item, float* scr, int lane, float scale) {
    const int nblk = N / 32, kb = item / nblk, nb = item % nblk, k0 = 128 * kb, n0 = 32 * nb;
    { f32x4 v[16]; const float* src = W + (size_t)(k0 + (lane >> 3)) * N + n0 + 4 * (lane & 7);
#pragma unroll
      for (int i = 0; i < 16; ++i) v[i] = __builtin_nontemporal_load((const f32x4*)(src + (size_t)(8 * i) * N));
#pragma unroll
      for (int i = 0; i < 16; ++i) { float* d = scr + (8 * i + (lane >> 3)) * 33 + 4 * (lane & 7); d[0] = v[i].x * scale; d[1] = v[i].y * scale; d[2] = v[i].z * scale; d[3] = v[i].w * scale; } }
    LDS_WAIT();
    const int c = lane & 7;
#pragma unroll
    for (int j = 0; j < 4; ++j) {
        const int n = (lane >> 3) + 8 * j; const float* s = scr + (16 * c) * 33 + n;
        u32x4 o; o.x = pg8::pk4_fp8(s[0 * 33], s[1 * 33], s[2 * 33], s[3 * 33]); o.y = pg8::pk4_fp8(s[4 * 33], s[5 * 33], s[6 * 33], s[7 * 33]);
        o.z = pg8::pk4_fp8(s[8 * 33], s[9 * 33], s[10 * 33], s[11 * 33]); o.w = pg8::pk4_fp8(s[12 * 33], s[13 * 33], s[14 * 33], s[15 * 33]);
        const int nn = n0 + n; const int drow = mode == 0 ? nn : ((nn >> 7) * 256 + (nn & 127) + (mode == 2 ? 128 : 0));
        __builtin_nontemporal_store(o, (u32x4*)(WT + (size_t)drow * K + k0 + 16 * c));
    }
    LDS_WAIT();
}

__device__ __forceinline__ void rms_row_bf16(const float* xrow, const float* g, bf16* orow, int lane) {
    const f32x4* xr = (const f32x4*)xrow; const f32x4* gr = (const f32x4*)g;
    f32x4 v[4]; float s = 0.f;
#pragma unroll
    for (int j = 0; j < 4; ++j) { v[j] = xr[lane + 64 * j]; s += (v[j].x * v[j].x + v[j].y * v[j].y) + (v[j].z * v[j].z + v[j].w * v[j].w); }
    const float r = 1.0f / sqrtf(wave_sum(s) * (1.0f / D) + 1e-6f);
    u32x2* o8 = (u32x2*)orow;
#pragma unroll
    for (int j = 0; j < 4; ++j) { const f32x4 gv = gr[lane + 64 * j]; u32x2 w; w.x = pk2(v[j].x * r * gv.x, v[j].y * r * gv.y); w.y = pk2(v[j].z * r * gv.z, v[j].w * r * gv.w); o8[lane + 64 * j] = w; }
}

#define LAS __attribute__((address_space(3)))
#define XB_TMO      128
#define XB_XCNT(j)  (256  + 64 * (j))
#define XB_XSUB(j)  (1280 + 64 * (j))
#define XB_XGEN(j)  (2304 + 64 * (j))
#define XB_TOP      3328
#define XB_TOPGEN   3392
#define XCD_BAR_WORDS 3456
#define XB_SPIN_CAP (1u << 22)
__device__ __forceinline__ unsigned xb_ld(unsigned* p)              { return __hip_atomic_load(p, __ATOMIC_RELAXED, __HIP_MEMORY_SCOPE_AGENT); }
__device__ __forceinline__ unsigned xb_add(unsigned* p, unsigned v) { return __hip_atomic_fetch_add(p, v, __ATOMIC_RELAXED, __HIP_MEMORY_SCOPE_AGENT); }
__device__ __forceinline__ unsigned xb_xcc_id() { return (unsigned)__builtin_amdgcn_s_getreg((3 << 11) | 20) & 0xFu; }
#define XB_SPIN(cond, bar) do { unsigned _sp = 0; while (cond) { __builtin_amdgcn_s_sleep(1); \
    if ((++_sp & 255u) == 0u) { if (xb_ld(&(bar)[XB_TMO])) break; if (_sp > XB_SPIN_CAP) { atomicAdd(&(bar)[XB_TMO], 1u); break; } } } } while (0)
struct XcdBarrier { unsigned* bar; unsigned x; volatile LAS unsigned* st; };
__device__ __forceinline__ XcdBarrier xcd_barrier_post(unsigned* bar, volatile LAS unsigned* st) {
    XcdBarrier b; b.bar = bar; b.x = xb_xcc_id(); b.st = st;
    if (threadIdx.x == 0) (void)xb_add(&bar[XB_XCNT(b.x)], 1u);
    return b;
}
__device__ __forceinline__ void xcd_barrier_complete(unsigned* bar, unsigned x, unsigned& nloc, unsigned& nx) {
    const unsigned G = gridDim.x * gridDim.y * gridDim.z;
    unsigned sum, cnt, mine, sp = 0u;
    for (;;) {
        sum = 0u; cnt = 0u; mine = 0u;
#pragma unroll
        for (unsigned j = 0; j < 16; ++j) { const unsigned c = xb_ld(&bar[XB_XCNT(j)]); sum += c; cnt += (c > 0u) ? 1u : 0u; mine = (j == x) ? c : mine; }
        if (sum == G) break;
        __builtin_amdgcn_s_sleep(1);
        if ((++sp & 255u) == 0u) { if (xb_ld(&bar[XB_TMO])) break; if (sp > XB_SPIN_CAP) { atomicAdd(&bar[XB_TMO], 1u); break; } }
    }
    nloc = mine > 0u ? mine : 1u; nx = cnt > 0u ? cnt : 1u;
}
__device__ __forceinline__ void xcd_arrive(const XcdBarrier& b, bool leader) {
    asm volatile("s_waitcnt vmcnt(0)" ::: "memory");
    __syncthreads();
    if (leader) {
        unsigned* bar = b.bar;
        __builtin_amdgcn_s_waitcnt(0);
        unsigned nloc = b.st[0], nx = b.st[1];
        if (nloc == 0u) { xcd_barrier_complete(bar, b.x, nloc, nx); b.st[0] = nloc; b.st[1] = nx; }
        const unsigned old = xb_add(&bar[XB_XSUB(b.x)], 1u);
        const unsigned gen = old / nloc;
        b.st[2] = gen; b.st[3] = 0u;
        if (old + 1u == (gen + 1u) * nloc) {
            __builtin_amdgcn_fence(__ATOMIC_RELEASE, "agent");
            asm volatile("s_waitcnt vmcnt(0)" ::: "memory");
            const unsigned og = xb_add(&bar[XB_TOP], 1u);
            const unsigned tg = og / nx;
            b.st[4] = tg; b.st[3] = 1u;
            if (og + 1u == (tg + 1u) * nx) { xb_add(&bar[XB_TOPGEN], 1u); b.st[3] = 2u; }
        }
    }
}
__device__ __forceinline__ void xcd_wait(const XcdBarrier& b, bool leader) {
    if (leader) {
        unsigned* bar = b.bar; const unsigned gen = b.st[2], role = b.st[3], tg = b.st[4];
        if (role >= 1u) {
            if (role == 1u) XB_SPIN(xb_ld(&bar[XB_TOPGEN]) == tg, bar);
            __builtin_amdgcn_fence(__ATOMIC_ACQUIRE, "agent");
            xb_add(&bar[XB_XGEN(b.x)], 1u);
            asm volatile("s_waitcnt vmcnt(0)" ::: "memory");
        } else {
            XB_SPIN(xb_ld(&bar[XB_XGEN(b.x)]) == gen, bar);
            __builtin_amdgcn_fence(__ATOMIC_ACQUIRE, "agent");
            asm volatile("s_waitcnt vmcnt(0)" ::: "memory");
        }
    }
    __syncthreads();
}
__device__ __forceinline__ void xcd_barrier(const XcdBarrier& b, bool leader) { xcd_arrive(b, leader); xcd_wait(b, leader); }
constexpr int LDS_BYTES = 163840, RING_BYTES = LDS_BYTES - 512, MISC_OFF = RING_BYTES + 320;
constexpr int CW_BAR = 4096;

enum Phase { PH_PROLOGUE = 0, PH_INPROJ, PH_MIX1, PH_MIX2, PH_MIX3, PH_OUTPROJ, PH_NORM, PH_FFNUP, PH_FFNDOWN, PH_DISPATCH, PH_MOEUP, PH_MOEDOWN, PH_FINAL };


constexpr int PQ_OFF = 97792;
constexpr int RS = 528;
constexpr int AINB_STRIDE = RS;
constexpr int VTS = 144;
template <int NLD> __device__ __forceinline__ void slab_load(u32x4 (&reg)[NLD], const bf16* src, int nrows, int rvalid0, int tid) {
#pragma unroll
    for (int j = 0; j < NLD; ++j) { const int i = tid + j * NT, r = i >> 5, ch = i & 31; reg[j] = (u32x4){0u, 0u, 0u, 0u}; if (i < nrows * 32 && r >= rvalid0) reg[j] = *(const u32x4*)(src + (ptrdiff_t)r * DIN + ch * 8); }
}
template <int NLD> __device__ __forceinline__ void slab_store(const u32x4 (&reg)[NLD], unsigned char* dst, int nrows, int tid) {
#pragma unroll
    for (int j = 0; j < NLD; ++j) { const int i = tid + j * NT, r = i >> 5, ch = i & 31; if (i < nrows * 32) *(u32x4*)(dst + r * RS + ch * 16) = reg[j]; }
}
__device__ __forceinline__ void ytile_store(const unsigned char* src, bf16* y, int tid) {
    asm volatile("" : "+v"(tid) :: "memory");
#pragma unroll
    for (int j = 0; j < 4; ++j) { const int i = tid + j * NT, r = i >> 5, ch = i & 31; *(u32x4*)(y + (size_t)r * D + ch * 8) = *(const u32x4*)(src + r * RS + ch * 16); }
}
__device__ __forceinline__ int vt_off(int c, int tok) { return c * VTS + ((tok ^ (((c >> 3) & 7) << 3)) << 1); }
__device__ __forceinline__ void vt_store(const u32x4 (&reg)[4], unsigned char* vt, int tid) {
#pragma unroll
    for (int j = 0; j < 4; ++j) { const int i = tid + j * NT, r = i >> 5, ch = i & 31, c0 = ch * 8; const unsigned w[4] = {reg[j].x, reg[j].y, reg[j].z, reg[j].w};
#pragma unroll
        for (int q = 0; q < 8; ++q) *(bf16*)(vt + vt_off(c0 + q, r)) = (bf16)((q & 1) ? (w[q >> 1] >> 16) : (w[q >> 1] & 0xffffu)); }
}
struct LruParams { bf16x8 wa[2], wx[2]; float lam, ba, bx, cb, cw[4]; };
__device__ __forceinline__ void lru_params_load(LruParams& p, const bf16* wta, const bf16* wtx, const float* conv_w, const float* conv_b, const float* b_a, const float* b_x, const float* lam, int h, int nt, int lane) {
    asm volatile("" : "+v"(lane));
    const int fr = lane & 15, fq = lane >> 4, c = 64 * h + 16 * nt + fr;
#pragma unroll
    for (int ks = 0; ks < 2; ++ks) { p.wa[ks] = *(const bf16x8*)(wta + (size_t)(h * 64 + 16 * nt + fr) * 64 + 32 * ks + 8 * fq); p.wx[ks] = *(const bf16x8*)(wtx + (size_t)(h * 64 + 16 * nt + fr) * 64 + 32 * ks + 8 * fq); }
    p.lam = lam[c]; p.ba = b_a[c]; p.bx = b_x[c]; p.cb = conv_b[c];
#pragma unroll
    for (int k = 0; k < 4; ++k) p.cw[k] = conv_w[k * GW + c];
}
__device__ __forceinline__ void lru_ainb(const unsigned char* ax, const float* conv_w, const float* conv_b, unsigned char* ainb, int tid) {
    for (int idx = tid; idx < CH * 128; idx += NT) {
        const int t = idx >> 7, c = (idx & 127) * 2; float a0 = conv_b[c], a1 = conv_b[c + 1];
#pragma unroll
        for (int k = 0; k < 4; ++k) { const unsigned w = *(const unsigned*)(ax + (t + k) * RS + c * 2); a0 += conv_w[k * GW + c] * bf2f(w & 0xffffu); a1 += conv_w[k * GW + c + 1] * bf2f(w >> 16); }
        *(unsigned*)(ainb + t * RS + c * 2) = pk2(a0, a1);
    }
}
__device__ __forceinline__ void lru_gates(const unsigned char* ainb, const unsigned char* ax, const LruParams& p, int h, int nt, int lane, float (&av)[4][4], float (&uv)[4][4]) {
    const int fr = lane & 15, fq = lane >> 4, c = 64 * h + 16 * nt + fr;
    f32x4 aa[4], ax4[4];
#pragma unroll
    for (int mt = 0; mt < 4; ++mt) { aa[mt] = (f32x4){0.f, 0.f, 0.f, 0.f}; ax4[mt] = (f32x4){0.f, 0.f, 0.f, 0.f};
#pragma unroll
        for (int ks = 0; ks < 2; ++ks) { const bf16x8 x = *(const bf16x8*)(ainb + (16 * mt + fr) * RS + (64 * h + 32 * ks + 8 * fq) * 2);
            aa[mt] = __builtin_amdgcn_mfma_f32_16x16x32_bf16(x, p.wa[ks], aa[mt], 0, 0, 0); ax4[mt] = __builtin_amdgcn_mfma_f32_16x16x32_bf16(x, p.wx[ks], ax4[mt], 0, 0, 0); } }
    const float sp = log1pf(fexp(-p.lam));
#pragma unroll
    for (int mt = 0; mt < 4; ++mt)
#pragma unroll
        for (int r = 0; r < 4; ++r) { const int t = 16 * mt + 4 * fq + r; const float rg = sigmoidf_(aa[mt][r] + p.ba), ig = sigmoidf_(ax4[mt][r] + p.bx); const float loga = -8.0f * rg * sp;
            const float x2 = 2.0f * loga; const float m2 = x2 > -0.25f ? neg_expm1_small(x2) : -expm1f(x2);
            float xin = p.cb;
#pragma unroll
            for (int k = 0; k < 4; ++k) xin += p.cw[k] * bf2f(*(const bf16*)(ax + (t + k) * RS + c * 2));
            av[mt][r] = fexp(loga); uv[mt][r] = __builtin_amdgcn_sqrtf(fmaxf(m2, 0.f)) * ig * xin; }
}

constexpr int CW_CVTQ = 2048, CW_DONE = 8192;
constexpr int BG_IE1 = 8 * 112, BG_IE2 = 28 * 32, BG_ITEMS = 2 * NE * BG_IE1 + NE * BG_IE2, BG_BATCHES = BG_ITEMS / 8;
__device__ __forceinline__ void bg_convert(unsigned char* ws, unsigned char* lds_raw, const float* w1, const float* w3, const float* w2, int step, int G, int tid, bool drain) {
    unsigned* ctl = (unsigned*)(ws + WS_CTL); volatile unsigned* shq = (volatile unsigned*)(lds_raw + RING_BYTES);
    const int wid = tid >> 6, lane = tid & 63; float* scr = (float*)lds_raw + wid * (128 * 33);
    __syncthreads();
    if (tid == 0 && !drain) __hip_atomic_fetch_add(ctl + CW_DONE + 64 * step, 1u, __ATOMIC_RELAXED, __HIP_MEMORY_SCOPE_AGENT);
    for (;;) {
        if (tid == 0) { unsigned b = BG_BATCHES;
            if (drain || __hip_atomic_load(ctl + CW_DONE + 64 * step, __ATOMIC_RELAXED, __HIP_MEMORY_SCOPE_AGENT) + 16u < (unsigned)G) b = __hip_atomic_fetch_add(ctl + CW_CVTQ, 1u, __ATOMIC_RELAXED, __HIP_MEMORY_SCOPE_AGENT);
            shq[0] = b; }
        __syncthreads();
        const unsigned b = shq[0];
        __syncthreads();
        if (b >= (unsigned)BG_BATCHES) break;
        const int q = (int)b * 8 + wid;
        if (q < NE * BG_IE1) { const int e = q / BG_IE1, r = q % BG_IE1; cvt_item8(w1 + (size_t)e * D * DFFE, D, DFFE, ws + WS_W13 + (size_t)e * 2 * DFFE * D, 1, r, scr, lane, W13_SCALE); }
        else if (q < 2 * NE * BG_IE1) { const int q2 = q - NE * BG_IE1, e = q2 / BG_IE1, r = q2 % BG_IE1; cvt_item8(w3 + (size_t)e * D * DFFE, D, DFFE, ws + WS_W13 + (size_t)e * 2 * DFFE * D, 2, r, scr, lane, W13_SCALE); }
        else { const int q2 = q - 2 * NE * BG_IE1, e = q2 / BG_IE2, r = q2 % BG_IE2; cvt_item8(w2 + (size_t)e * DFFE * D, DFFE, D, ws + WS_W2 + (size_t)e * D * DFFE, 0, r, scr, lane, W2_SCALE); }
    }
}

__host__ __device__ __forceinline__ int moe_tail_split(int ntail) { return ntail * 4 * 7 <= 256 ? 7 : (ntail * 4 * 2 <= 256 ? 2 : 1); }

#define HN ((bf16*)(ws + WS_HN))
#define PROJ ((bf16*)(ws + WS_PROJ))
#define Y ((bf16*)(ws + WS_Y))
#define DS ((float*)(ws + WS_DS))
#define HID ((bf16*)(ws + WS_HID))
#define HIDE ((unsigned char*)(ws + WS_HIDE))
#define OUT2 ((unsigned char*)(ws + WS_OUT2))
#define XR ((unsigned char*)(ws + WS_XR))
#define SSP0 ((float*)(ws + WS_END))
#define SSP1 ((float*)(ws + WS_END + MiB))
#define PART ((float*)(ws + WS_END + 3 * MiB))
#define TOKROW SMALLP(int, SM_TOKROW)
#define SMALLP(T, off) ((T*)(ws + WS_SMALL + (off)))
#define RSTD SMALLP(float, SM_RSTD)
#define TOKE SMALLP(int, SM_TOKE)
#define TOKG SMALLP(float, SM_TOKG)
#define TOKR SMALLP(int, SM_TOKR)
#define BCNT SMALLP(int, SM_BCNT)
#define ROWDST SMALLP(int, SM_ROWDST)
#define ROWG SMALLP(float, SM_ROWG)
#define TILEE SMALLP(int, SM_TILEE)
#define CARA SMALLP(float, SM_CARA)
#define CARH SMALLP(float, SM_CARH)
#define CIN SMALLP(float, SM_CIN)
#define DEC SMALLP(float, SM_DEC)
#define WTA SMALLP(bf16, SM_WTA)
#define WTX SMALLP(bf16, SM_WTX)
#define WTP SMALLP(bf16, SM_WTP)
#define PHASE_ENTER int tid = wid_s * 64 + lane_id_asm(); asm volatile("" : "+v"(tid)); const int lane = tid & 63, wid = tid >> 6; __attribute__((address_space(1))) unsigned char* wsg_ = (__attribute__((address_space(1))) unsigned char*)a.ws; asm volatile("" : "+s"(wsg_)); unsigned char* ws = (unsigned char*)wsg_; \
    __attribute__((address_space(1))) float* hresg_ = (__attribute__((address_space(1))) float*)a.out; asm volatile("" : "+s"(hresg_)); float* hres = (float*)hresg_; \
    int bid = blockIdx.x; asm volatile("" : "+s"(bid)); int G = gridDim.x; asm volatile("" : "+s"(G)); (void)lane; (void)wid; (void)hres; (void)bid; (void)G;

__global__ void __launch_bounds__(NT) fwd(Args a) {
    extern __shared__ __attribute__((aligned(16))) unsigned char lds_raw[];
    float* ldsf = (float*)lds_raw;
    const int wid_s = __builtin_amdgcn_readfirstlane(threadIdx.x >> 6);
    { const int tid0 = threadIdx.x; for (int u = tid0; u < (LDS_BYTES - RING_BYTES) / 4; u += NT) ((LAS unsigned*)((LAS unsigned char*)lds_raw + RING_BYTES))[u] = 0u; }
    __syncthreads();
    XcdBarrier bar = xcd_barrier_post((unsigned*)(a.ws + WS_CTL) + CW_BAR, (volatile LAS unsigned*)((LAS unsigned char*)lds_raw + MISC_OFF) + 8);

#ifdef REP_STEP
    int rep_left = REP_N;
#endif
    for (int step = a.ph_lo; step < a.ph_hi; ++step) {
#ifdef REP_STEP
    const bool dry = (step == REP_STEP && rep_left > 0);
#else
    constexpr bool dry = false;
#endif
    int phase, L, pass = 0; (void)pass;
    if (step == 0) { phase = PH_PROLOGUE; L = 0; }
    else if (step < 6) { L = 0; const int s = step - 1; phase = s == 0 ? PH_INPROJ : s == 1 ? PH_MIX1 : s == 2 ? PH_OUTPROJ : s == 3 ? PH_FFNUP : PH_FFNDOWN; }
    else { L = 1; const int s = step - 6; phase = s == 0 ? PH_INPROJ : s == 1 ? PH_MIX1 : s == 2 ? PH_OUTPROJ : s == 3 ? PH_NORM : s == 4 ? PH_MOEUP : s == 5 ? PH_MOEDOWN : PH_FINAL; }
#ifdef REP_NOP
    if (dry) phase = 1000;
#endif
    switch (phase) {
    case PH_PROLOGUE: {
        PHASE_ENTER
        float* scr = ldsf + wid * (128 * 33);
        const int gw = bid * 8 + wid, NGW = G * 8;
        constexpr int I_IN = 16 * 80, I_OUT = 16 * 32, I_G = 16 * 88, I_D = 44 * 32;
        constexpr int T0 = 2 * I_IN, T1 = T0 + 2 * I_OUT, T2 = T1 + I_G, T3 = T2 + I_G, T4 = T3 + I_D;
        for (int it = gw; it < T4; it += NGW) {
            if (it < T0) { const int l = it / I_IN, r = it % I_IN; cvt_item(IN(1) + (size_t)l * D * DIN, D, DIN, (bf16*)(ws + WS_WIN) + (size_t)l * DIN * D, 0, r, scr, lane, l == 1 ? IN(15) + D : nullptr); }
            else if (it < T1) { const int q = it - T0, l = q / I_OUT, r = q % I_OUT; cvt_item(IN(2) + (size_t)l * D * D, D, D, (bf16*)(ws + WS_WOUT) + (size_t)l * D * D, 0, r, scr, lane); }
            else if (it < T2) { cvt_item(IN(17), D, DFF, (bf16*)(ws + WS_WGU), 1, it - T1, scr, lane, IN(16)); }
            else if (it < T3) { cvt_item(IN(18), D, DFF, (bf16*)(ws + WS_WGU), 2, it - T2, scr, lane, IN(16)); }
            else { cvt_item(IN(19), DFF, D, (bf16*)(ws + WS_WD), 0, it - T3, scr, lane); }
        }
        for (int m = gw; m < NTOK; m += NGW) rms_row_bf16(IN(0) + (size_t)m * D, IN(15), HN + (size_t)m * D, lane);
        for (int idx = bid * NT + tid; idx < 3 * 2 * 4 * HD * HD; idx += G * NT) {
            const int mat = idx / (2 * 4 * HD * HD), r = idx % (2 * 4 * HD * HD), lh = r >> 12, j = (r >> 6) & 63, i = r & 63;
            const float* w = mat == 0 ? IN(5) : mat == 1 ? IN(7) : IN(12);
            (mat == 0 ? WTA : mat == 1 ? WTX : WTP)[r] = (bf16)f2bf(w[(lh * 64 + i) * 64 + j]);
        }
    } break;

    case PH_INPROJ: {
        PHASE_ENTER
        pg8::Gemm g{HN, (const bf16*)(ws + WS_WIN) + (size_t)L * DIN * D, NTOK, DIN, D, 0}; pg8::StaticOrder S; S.init(NTOK, DIN, G, bid);
        if (L == 0) { pg8::EpiStoreBf16 E{PROJ, DIN}; pg8::gemm_phase<pg8::EpiStoreBf16, pg8::StaticOrder, true, true>((PG8_LAS unsigned char*)lds_raw, g, S, E, tid); }
        else { pg8::fill_rstd_table((PG8_LAS unsigned char*)lds_raw, S, SSP1, tid); pg8::EpiStoreBf16R E{PROJ, DIN, (const PG8_LAS float*)((PG8_LAS unsigned char*)lds_raw + pg8::RSTD_TAB_OFF)}; pg8::gemm_phase<pg8::EpiStoreBf16R, pg8::StaticOrder, true, true>((PG8_LAS unsigned char*)lds_raw, g, S, E, tid); }
    } break;

    case PH_MIX1: {
        PHASE_ENTER
        {
        const float* conv_w = IN(3) + L * 4 * GW; const float* conv_b = IN(4) + L * GW;
        const float* b_a = IN(6) + L * GW; const float* b_x = IN(8) + L * GW;
        const float* lam = IN(9) + L * GW; const float* lbp = IN(10);
        unsigned char* AX = lds_raw; unsigned char* AINB = lds_raw + 35376;
        unsigned char* FS = lds_raw; unsigned char* KHTl = lds_raw; unsigned char* VTl = lds_raw + 36864; float* TOTl = (float*)(lds_raw + 73728);
        unsigned* PQ = (unsigned*)(lds_raw + PQ_OFF);
        for (int ci = bid; ci < NCHUNK; ci += G) {
            const int t0 = (ci % CPB) * CH, g0 = ci * CH; const bf16* prow = PROJ + (size_t)g0 * DIN;
            LruParams lp[2];
#pragma unroll
            for (int cc = 0; cc < 2; ++cc) lru_params_load(lp[cc], WTA + L * 16384, WTX + L * 16384, conv_w, conv_b, b_a, b_x, lam, wid >> 1, 2 * (wid & 1) + cc, lane);
            int lbi = 64 * (wid >> 1) + lane; asm volatile("" : "+v"(lbi)); const float lbv = L == 0 ? 0.f : sigmoidf_(lbp[GW + lbi] - lbp[lbi]);
            u32x4 rf[4], rv[4];
            {
                u32x4 rax[5];
                int tl1 = tid; asm volatile("" : "+v"(tl1) :: "memory");
                slab_load<5>(rax, prow - 3 * DIN, 67, t0 == 0 ? 3 : 0, tl1);
                slab_store<5>(rax, AX, 67, tid);
            }
            __syncthreads();
            lru_ainb(AX, conv_w, conv_b, AINB, tid);
            __syncthreads();
#pragma unroll
            for (int cc = 0; cc < 2; ++cc) {
                const int h = wid >> 1, nt = 2 * (wid & 1) + cc, fr = lane & 15, fq = lane >> 4, c = 64 * h + 16 * nt + fr; float av[4][4], uv[4][4];
                lru_gates(AINB, AX, lp[cc], h, nt, lane, av, uv);
                float Pin = 1.f, Qin = 0.f;
#pragma unroll
                for (int mt = 0; mt < 4; ++mt) {
                    float Ai[4], Hi[4]; float A_ = 1.f, H_ = 0.f;
#pragma unroll
                    for (int r = 0; r < 4; ++r) { H_ = av[mt][r] * H_ + uv[mt][r]; A_ *= av[mt][r]; Ai[r] = A_; Hi[r] = H_; }
                    const float a1 = __shfl_up(A_, 16), h1 = __shfl_up(H_, 16), a2 = __shfl_up(A_, 32), h2 = __shfl_up(H_, 32), a3 = __shfl_up(A_, 48), h3 = __shfl_up(H_, 48);
                    float EA = 1.f, EH = 0.f;
                    if (fq >= 3) { EA = a3; EH = h3; }
                    if (fq >= 2) { EH = a2 * EH + h2; EA *= a2; }
                    if (fq >= 1) { EH = a1 * EH + h1; EA *= a1; }
                    float Pt[4], Qt[4];
#pragma unroll
                    for (int r = 0; r < 4; ++r) { const float al = Ai[r] * EA, be = Ai[r] * EH + Hi[r]; Pt[r] = al * Pin; Qt[r] = al * Qin + be; PQ[(16 * mt + 4 * fq + r) * 256 + c] = pk2(Pt[r], Qt[r]); }
                    Pin = __shfl(Pt[3], 48 + fr); Qin = __shfl(Qt[3], 48 + fr);
                }
                if (lane < 16) { CARA[ci * GW + c] = Pin; CARH[ci * GW + c] = Qin; }
                if (cc == 0) { int tl2 = tid; asm volatile("" : "+v"(tl2) :: "memory"); slab_load<4>(rf, prow + 768, 64, 0, tl2); slab_load<4>(rv, prow + 1024, 64, 0, tl2); }
            }
            __syncthreads();
            slab_store<4>(rf, FS, 64, tid); vt_store(rv, VTl, tid);
            __syncthreads();
            {
                const int h = wid >> 1, half = wid & 1, c = 64 * h + lane, fr = lane & 15, fq = lane >> 4;
                const float lb = lbv;
                float gl[32], kk[32]; float run = 0.f;
#pragma unroll
                for (int t = 0; t < 32; ++t) { const float sg = sigmoidf_(bf2f(*(const bf16*)(FS + (32 * half + t) * RS + c * 2))); run += flog(lb + (1.f - lb) * sg); gl[t] = run; kk[t] = (1.f - lb) * (1.f - sg); }
                TOTl[(h * 2 + half) * 64 + lane] = run;
                __syncthreads();
                const float tot0 = TOTl[(h * 2) * 64 + lane], glast = tot0 + TOTl[(h * 2 + 1) * 64 + lane], off = half ? tot0 : 0.f;
#pragma unroll
                for (int j = 0; j < 4; ++j) { float e[8];
#pragma unroll
                    for (int q = 0; q < 8; ++q) e[q] = kk[8 * j + q] * fexp(glast - (off + gl[8 * j + q]));
                    u32x4 w; w.x = pk2(e[0], e[1]); w.y = pk2(e[2], e[3]); w.z = pk2(e[4], e[5]); w.w = pk2(e[6], e[7]);
                    *(u32x4*)(KHTl + c * VTS + (32 * half + 8 * j) * 2) = w; }
                if (half) DEC[(ci * 4 + h) * 64 + lane] = fexp(glast);
                __syncthreads();
#pragma unroll
                for (int vvv = 0; vvv < 2; ++vvv) {
                    const int vt = 2 * half + vvv, vrow = 64 * h + 16 * vt + fr; bf16x8 bv[2];
#pragma unroll
                    for (int ks = 0; ks < 2; ++ks) bv[ks] = *(const bf16x8*)(VTl + vt_off(vrow, 32 * ks + 8 * fq));
#pragma unroll
                    for (int kt = 0; kt < 4; ++kt) { f32x4 acc = (f32x4){0.f, 0.f, 0.f, 0.f};
#pragma unroll
                        for (int ks = 0; ks < 2; ++ks) { const bf16x8 ka = *(const bf16x8*)(KHTl + (64 * h + 16 * kt + fr) * VTS + (32 * ks + 8 * fq) * 2); acc = __builtin_amdgcn_mfma_f32_16x16x32_bf16(ka, bv[ks], acc, 0, 0, 0); }
                        *(f32x4*)(DS + ((size_t)(ci * 4 + h) * 64 + 16 * vt + fr) * 64 + 16 * kt + 4 * fq) = acc; }
                }
                __syncthreads();
            }
        }
        }
        xcd_arrive(bar, tid == 0);
        {
        const float* conv_w = IN(3) + L * 4 * GW; const float* conv_b = IN(4) + L * GW; const float* b_a = IN(6) + L * GW; const float* b_x = IN(8) + L * GW; const float* lam = IN(9) + L * GW;
        const float* lbp = IN(10); const float* norm_g = IN(11) + L * HD; const float* pool_s = IN(13) + L * GW; const float* sconv_w = IN(14) + L * 3 * GW;
        unsigned char* AX = lds_raw; unsigned char* AG = lds_raw + 35376; unsigned char* AINB = lds_raw + 69168;
        unsigned char* QT3 = lds_raw; unsigned char* KT3 = lds_raw + 33792; unsigned char* OG3 = lds_raw + 67584; unsigned char* VT3 = lds_raw + 101376; float* TOT3 = (float*)(lds_raw + 138240);
        unsigned char* PS = lds_raw; unsigned char* DIMG = lds_raw + 41712; unsigned char* YST = lds_raw;
        unsigned char* SB = lds_raw; unsigned char* SC = lds_raw + 33792; unsigned char* SX = lds_raw + 68640;
        for (int ci = bid; ci < NCHUNK; ci += G) {
            const int t0 = (ci % CPB) * CH, g0 = ci * CH; const bf16* prow = PROJ + (size_t)g0 * DIN; bf16* yrow = Y + (size_t)g0 * D; (void)t0; (void)yrow;
            { u32x4 rp[5]; int tlc = tid; asm volatile("" : "+v"(tlc) :: "memory"); slab_load<5>(rp, prow - 15 * DIN + 1536, 79, t0 == 0 ? 15 : 0, tlc); slab_store<5>(rp, PS, 79, tid); }
            __syncthreads();
            for (int idx = tid; idx < CH * 128; idx += NT) {
                const int t = idx >> 7, c = (idx & 127) * 2, gi = c >> 6, w = 2 << gi; const int tt = t0 + t; const int cnt = (tt + 1 < w) ? (tt + 1) : w; float s0 = 0.f, s1 = 0.f; unsigned xs[16];
#pragma unroll
                for (int r = 0; r < 16; ++r) xs[r] = *(const unsigned*)(PS + (t + 15 - r) * RS + c * 2);
#pragma unroll
                for (int r = 0; r < 16; ++r) { const float m_ = r < cnt ? 1.0f : 0.0f; s0 += m_ * bf2f(xs[r] & 0xffffu); s1 += m_ * bf2f(xs[r] >> 16); }
                const float inv = __builtin_amdgcn_rcpf((float)cnt);
                *(unsigned*)(DIMG + t * RS + c * 2) = pk2(s0 * inv - bf2f(xs[0] & 0xffffu), s1 * inv - bf2f(xs[0] >> 16));
            }
            __syncthreads();
#pragma unroll 1
            for (int cc = 0; cc < 2; ++cc) {
                const int gi = wid >> 1, nt = 2 * (wid & 1) + cc, fr = lane & 15, fq = lane >> 4, c = 64 * gi + 16 * nt + fr; bf16x8 wp[2];
#pragma unroll
                for (int ks = 0; ks < 2; ++ks) wp[ks] = *(const bf16x8*)(WTP + L * 16384 + (size_t)(gi * 64 + 16 * nt + fr) * 64 + 32 * ks + 8 * fq);
                const float psc = pool_s[c];
#pragma unroll
                for (int mt = 0; mt < 4; ++mt) { f32x4 acc = (f32x4){0.f, 0.f, 0.f, 0.f};
#pragma unroll
                    for (int ks = 0; ks < 2; ++ks) { const bf16x8 x = *(const bf16x8*)(DIMG + (16 * mt + fr) * RS + (64 * gi + 32 * ks + 8 * fq) * 2); acc = __builtin_amdgcn_mfma_f32_16x16x32_bf16(x, wp[ks], acc, 0, 0, 0); }
#pragma unroll
                    for (int r = 0; r < 4; ++r) *(bf16*)(YST + (16 * mt + 4 * fq + r) * RS + c * 2) = (bf16)f2bf(acc[r] * psc); }
            }
            __syncthreads();
            ytile_store(YST, yrow + 512, tid);
            __syncthreads();
        }
        }
        xcd_wait(bar, tid == 0);
        {
        float* xa = ldsf; float* xs = ldsf + 512;
        for (int item = bid; item < 256 + 8; item += G) {
            if (item < 256) {
                const int el = tid & 127, seg = tid >> 7, e = item * 128 + el, b = e >> 14, hh = (e >> 12) & 3, kv = e & 4095, k = kv & 63;
                float dv[32], dc[32];
#pragma unroll
                for (int i = 0; i < 32; ++i) { const int ci = b * CPB + seg * 32 + i; dv[i] = DS[(size_t)(ci * 4 + hh) * 4096 + kv]; dc[i] = DEC[(ci * 4 + hh) * 64 + k]; }
                float S = 0.f, A = 1.f;
#pragma unroll
                for (int i = 0; i < 32; ++i) { const float d = dv[i]; dv[i] = S; S = dc[i] * S + d; const float a0 = dc[i]; dc[i] = A; A *= a0; }
                xa[seg * 128 + el] = A; xs[seg * 128 + el] = S;
                __syncthreads();
                float Sin = 0.f;
                for (int s2 = 0; s2 < seg; ++s2) Sin = xa[s2 * 128 + el] * Sin + xs[s2 * 128 + el];
#pragma unroll
                for (int i = 0; i < 32; ++i) { const int ci = b * CPB + seg * 32 + i; (dry ? DS + 20 * (MiB / 4) * 4 : DS)[(size_t)(ci * 4 + hh) * 4096 + kv] = dv[i] + dc[i] * Sin; }
                __syncthreads();
            } else {
                const int q = item - 256, sq = tid & 63, chg = q * 64 + sq, b = chg >> 8, c = chg & 255, seg = tid >> 6;
                float ca[16], chh[16];
#pragma unroll
                for (int i = 0; i < 16; ++i) { const int ci = b * CPB + seg * 16 + i; ca[i] = CARA[ci * GW + c]; chh[i] = CARH[ci * GW + c]; }
                float A = 1.f, H = 0.f;
#pragma unroll
                for (int i = 0; i < 16; ++i) { const float a0 = ca[i], h0 = chh[i]; ca[i] = A; chh[i] = H; H = a0 * H + h0; A *= a0; }
                xa[seg * 64 + sq] = A; xs[seg * 64 + sq] = H;
                __syncthreads();
                float Hin = 0.f;
                for (int s2 = 0; s2 < seg; ++s2) Hin = xa[s2 * 64 + sq] * Hin + xs[s2 * 64 + sq];
#pragma unroll
                for (int i = 0; i < 16; ++i) { const int ci = b * CPB + seg * 16 + i; CIN[ci * GW + c] = chh[i] + ca[i] * Hin; }
                __syncthreads();
            }
        }
        }
        xcd_arrive(bar, tid == 0);
        {
        const float* conv_w = IN(3) + L * 4 * GW; const float* conv_b = IN(4) + L * GW; const float* b_a = IN(6) + L * GW; const float* b_x = IN(8) + L * GW; const float* lam = IN(9) + L * GW;
        const float* lbp = IN(10); const float* norm_g = IN(11) + L * HD; const float* pool_s = IN(13) + L * GW; const float* sconv_w = IN(14) + L * 3 * GW;
        unsigned char* AX = lds_raw; unsigned char* AG = lds_raw + 35376; unsigned char* AINB = lds_raw + 69168;
        unsigned char* QT3 = lds_raw; unsigned char* KT3 = lds_raw + 33792; unsigned char* OG3 = lds_raw + 67584; unsigned char* VT3 = lds_raw + 101376; float* TOT3 = (float*)(lds_raw + 138240);
        unsigned char* PS = lds_raw; unsigned char* DIMG = lds_raw + 41712; unsigned char* YST = lds_raw;
        unsigned char* SB = lds_raw; unsigned char* SC = lds_raw + 33792; unsigned char* SX = lds_raw + 68640;
        for (int ci = bid; ci < NCHUNK; ci += G) {
            const int t0 = (ci % CPB) * CH, g0 = ci * CH; const bf16* prow = PROJ + (size_t)g0 * DIN; bf16* yrow = Y + (size_t)g0 * D; (void)t0; (void)yrow;
            { u32x4 rsb[4], rsc[5], rsx[5]; int tld = tid; asm volatile("" : "+v"(tld) :: "memory"); slab_load<4>(rsb, prow + 1792, 64, 0, tld); slab_load<5>(rsc, prow - 2 * DIN + 2048, 66, t0 == 0 ? 2 : 0, tld); slab_load<5>(rsx, prow - 2 * DIN + 2304, 66, t0 == 0 ? 2 : 0, tld);
#pragma unroll
              for (int j = 0; j < 5; ++j) {
                  const unsigned a[4] = {rsc[j].x, rsc[j].y, rsc[j].z, rsc[j].w}, b[4] = {rsx[j].x, rsx[j].y, rsx[j].z, rsx[j].w}; unsigned p[4];
#pragma unroll
                  for (int q = 0; q < 4; ++q) p[q] = pk2(bf2f(a[q] & 0xffffu) * bf2f(b[q] & 0xffffu), bf2f(a[q] >> 16) * bf2f(b[q] >> 16));
                  rsc[j] = (u32x4){p[0], p[1], p[2], p[3]}; }
              slab_store<4>(rsb, SB, 64, tid); slab_store<5>(rsc, SC, 66, tid); }
            __syncthreads();
            int tq = tid; asm volatile("" : "+v"(tq));
            for (int idx = tq; idx < CH * 128; idx += NT) {
                const int t = idx >> 7, c = (idx & 127) * 2; float a0 = 0.f, a1 = 0.f;
#pragma unroll
                for (int k = 0; k < 3; ++k) { const unsigned xc = *(const unsigned*)(SC + (t + k) * RS + c * 2); a0 += sconv_w[k * GW + c] * bf2f(xc & 0xffffu); a1 += sconv_w[k * GW + c + 1] * bf2f(xc >> 16); }
                unsigned* pb = (unsigned*)(SB + t * RS + c * 2); const unsigned b = *pb; *pb = pk2(bf2f(b & 0xffffu) * a0, bf2f(b >> 16) * a1);
            }
            __syncthreads();
            ytile_store(SB, yrow + 768, tid);
            __syncthreads();
        }
        }
        xcd_wait(bar, tid == 0);
        {
        const float* conv_w = IN(3) + L * 4 * GW; const float* conv_b = IN(4) + L * GW; const float* b_a = IN(6) + L * GW; const float* b_x = IN(8) + L * GW; const float* lam = IN(9) + L * GW;
        const float* lbp = IN(10); const float* norm_g = IN(11) + L * HD; const float* pool_s = IN(13) + L * GW; const float* sconv_w = IN(14) + L * 3 * GW;
        unsigned char* AX = lds_raw; unsigned char* AG = lds_raw + 35376; unsigned char* AINB = lds_raw + 69168;
        unsigned char* QT3 = lds_raw; unsigned char* KT3 = lds_raw + 33792; unsigned char* OG3 = lds_raw + 67584; unsigned char* VT3 = lds_raw + 101376; float* TOT3 = (float*)(lds_raw + 138240);
        unsigned char* PS = lds_raw; unsigned char* DIMG = lds_raw + 41712; unsigned char* YST = lds_raw;
        unsigned char* SB = lds_raw; unsigned char* SC = lds_raw + 33792; unsigned char* SX = lds_raw + 68640;
        for (int ci = bid; ci < NCHUNK; ci += G) {
            const int t0 = (ci % CPB) * CH, g0 = ci * CH; const bf16* prow = PROJ + (size_t)g0 * DIN; bf16* yrow = Y + (size_t)g0 * D; (void)t0; (void)yrow;
            int lbi = 64 * (wid >> 1) + lane; asm volatile("" : "+v"(lbi)); const float lbv = L == 0 ? 0.f : sigmoidf_(lbp[GW + lbi] - lbp[lbi]);
            { unsigned* PQ = (unsigned*)(lds_raw + PQ_OFF);
              const int c = (tid & 127) * 2; const float hin_a = CIN[ci * GW + c], hin_b = CIN[ci * GW + c + 1];
              unsigned ag[16];
#pragma unroll
              for (int i = 0; i < 16; ++i) ag[i] = *(const unsigned*)(prow + (size_t)(4 * i + (tid >> 7)) * DIN + 256 + c);
#pragma unroll
              for (int i = 0; i < 16; ++i) { const int t = 4 * i + (tid >> 7); const unsigned pa = PQ[t * 256 + c], pb = PQ[t * 256 + c + 1];
                  const float ha = bf2f(pa & 0xffffu) * hin_a + bf2f(pa >> 16), hb = bf2f(pb & 0xffffu) * hin_b + bf2f(pb >> 16);
                  *(unsigned*)(yrow + (size_t)t * D + c) = pk2(ha * gelu_tanh(bf2f(ag[i] & 0xffffu)), hb * gelu_tanh(bf2f(ag[i] >> 16))); }
            }
            __syncthreads();
            { u32x4 rq[4], rf[4], rv[4], rog[4]; int tlb = tid; asm volatile("" : "+v"(tlb) :: "memory"); slab_load<4>(rq, prow + 512, 64, 0, tlb); slab_load<4>(rf, prow + 768, 64, 0, tlb); slab_load<4>(rv, prow + 1024, 64, 0, tlb); slab_load<4>(rog, prow + 1280, 64, 0, tlb);
              slab_store<4>(rq, QT3, 64, tid); slab_store<4>(rf, KT3, 64, tid); slab_store<4>(rog, OG3, 64, tid); vt_store(rv, VT3, tid); }
            __syncthreads();
            {
                const int h = wid >> 1, half = wid & 1, c = 64 * h + lane, fr = lane & 15, fq = lane >> 4;
                const float lb = lbv;
                f32x4 sraw[4][2][2];
#pragma unroll
                for (int vt = 0; vt < 4; ++vt)
#pragma unroll
                    for (int ks = 0; ks < 2; ++ks) { const float* p = DS + ((size_t)(ci * 4 + h) * 64 + 16 * vt + fr) * 64 + 32 * ks + 8 * fq; sraw[vt][ks][0] = *(const f32x4*)p; sraw[vt][ks][1] = *(const f32x4*)(p + 4); }
                float gl[32]; float run = 0.f;
#pragma unroll
                for (int t = 0; t < 32; ++t) { const float sg = sigmoidf_(bf2f(*(const bf16*)(KT3 + (32 * half + t) * RS + c * 2))); run += flog(lb + (1.f - lb) * sg); gl[t] = run; }
                TOT3[(h * 2 + half) * 64 + lane] = run;
                __syncthreads();
                const float tot0 = TOT3[(h * 2) * 64 + lane];
                const float off = half ? 0.f : -tot0;
#pragma unroll
                for (int t = 0; t < 32; ++t) {
                    bf16* pq = (bf16*)(QT3 + (32 * half + t) * RS + c * 2); bf16* pk = (bf16*)(KT3 + (32 * half + t) * RS + c * 2);
                    const float sg = sigmoidf_(bf2f(*pk)), kkv = (1.f - lb) * (1.f - sg), qfv = siluf_(bf2f(*pq)), d = gl[t] + off;
                    *pq = (bf16)f2bf(qfv * fexp(d)); *pk = (bf16)f2bf(kkv * fexp(-d));
                }
                __syncthreads();
                bf16x8 sa[4][2];
#pragma unroll
                for (int vt = 0; vt < 4; ++vt)
#pragma unroll
                    for (int ks = 0; ks < 2; ++ks) {
                        const f32x4 lo = sraw[vt][ks][0], hi = sraw[vt][ks][1];
                        const float* eg = TOT3 + (h * 2) * 64 + 32 * ks + 8 * fq;
                        u32x4 w; w.x = pk2(lo.x * fexp(eg[0]), lo.y * fexp(eg[1])); w.y = pk2(lo.z * fexp(eg[2]), lo.w * fexp(eg[3])); w.z = pk2(hi.x * fexp(eg[4]), hi.y * fexp(eg[5])); w.w = pk2(hi.z * fexp(eg[6]), hi.w * fexp(eg[7]));
                        sa[vt][ks] = __builtin_bit_cast(bf16x8, w);
                    }
#pragma unroll
                for (int tsel = 0; tsel < 2; ++tsel) {
                    const int ti = half == 0 ? (tsel ? 3 : 0) : (tsel ? 2 : 1);
                    bf16x8 qb[2];
#pragma unroll
                    for (int ks = 0; ks < 2; ++ks) qb[ks] = *(const bf16x8*)(QT3 + (16 * ti + fr) * RS + (64 * h + 32 * ks + 8 * fq) * 2);
                    f32x4 st[4];
#pragma unroll
                    for (int si = 0; si < 4; ++si) { st[si] = (f32x4){0.f, 0.f, 0.f, 0.f};
                        if (si <= ti) {
#pragma unroll
                            for (int ks = 0; ks < 2; ++ks) { const bf16x8 ka = *(const bf16x8*)(KT3 + (16 * si + fr) * RS + (64 * h + 32 * ks + 8 * fq) * 2); st[si] = __builtin_amdgcn_mfma_f32_16x16x32_bf16(ka, qb[ks], st[si], 0, 0, 0); }
                            if (si == ti) {
#pragma unroll
                                for (int r = 0; r < 4; ++r) if (4 * fq + r > fr) st[si][r] = 0.f; }
                        } }
                    f32x4 oo[4];
#pragma unroll
                    for (int vt = 0; vt < 4; ++vt) { oo[vt] = (f32x4){0.f, 0.f, 0.f, 0.f};
#pragma unroll
                        for (int ks = 0; ks < 2; ++ks) oo[vt] = __builtin_amdgcn_mfma_f32_16x16x32_bf16(sa[vt][ks], qb[ks], oo[vt], 0, 0, 0); }
#pragma unroll
                    for (int p = 0; p < 2; ++p) if (2 * p <= ti) {
                        u32x4 bw; bw.x = pk2(st[2 * p][0], st[2 * p][1]); bw.y = pk2(st[2 * p][2], st[2 * p][3]); bw.z = pk2(st[2 * p + 1][0], st[2 * p + 1][1]); bw.w = pk2(st[2 * p + 1][2], st[2 * p + 1][3]);
                        const bf16x8 bfr = __builtin_bit_cast(bf16x8, bw);
#pragma unroll
                        for (int vt = 0; vt < 4; ++vt) { const int vrow = 64 * h + 16 * vt + fr; const u32x2 lo8 = *(const u32x2*)(VT3 + vt_off(vrow, 32 * p + 4 * fq)), hi8 = *(const u32x2*)(VT3 + vt_off(vrow, 32 * p + 16 + 4 * fq));
                            u32x4 aw; aw.x = lo8.x; aw.y = lo8.y; aw.z = hi8.x; aw.w = hi8.y;
                            oo[vt] = __builtin_amdgcn_mfma_f32_16x16x32_bf16(__builtin_bit_cast(bf16x8, aw), bfr, oo[vt], 0, 0, 0); }
                    }
                    float ss = 0.f;
#pragma unroll
                    for (int vt = 0; vt < 4; ++vt) ss += (oo[vt][0] * oo[vt][0] + oo[vt][1] * oo[vt][1]) + (oo[vt][2] * oo[vt][2] + oo[vt][3] * oo[vt][3]);
                    ss += __shfl_xor(ss, 16); ss += __shfl_xor(ss, 32);
                    const float rs = __builtin_amdgcn_rsqf(ss * (1.0f / HD) + 1e-5f);
#pragma unroll
                    for (int vt = 0; vt < 4; ++vt) { const int cv = 64 * h + 16 * vt + 4 * fq; u32x2* pog = (u32x2*)(OG3 + (16 * ti + fr) * RS + cv * 2); const u32x2 og = *pog; const f32x4 ng = *(const f32x4*)(norm_g + 16 * vt + 4 * fq);
                        u32x2 w; w.x = pk2(oo[vt][0] * rs * ng.x * siluf_(bf2f(og.x & 0xffffu)), oo[vt][1] * rs * ng.y * siluf_(bf2f(og.x >> 16))); w.y = pk2(oo[vt][2] * rs * ng.z * siluf_(bf2f(og.y & 0xffffu)), oo[vt][3] * rs * ng.w * siluf_(bf2f(og.y >> 16)));
                        *pog = w; }
                }
                __syncthreads();
            }
            ytile_store(OG3, yrow + 256, tid);
            __syncthreads();
        }
        }
    } break;

    case PH_OUTPROJ: {
        PHASE_ENTER
        pg8::Gemm g{Y, (const bf16*)(ws + WS_WOUT) + (size_t)L * D * D, NTOK, D, D, 0}; pg8::StaticOrder S; S.init(NTOK, D, G, bid);
        if (L == 0) { pg8::EpiResidStats E{IN(0), hres, HN, SSP0}; pg8::gemm_phase<pg8::EpiResidStats, pg8::StaticOrder, true, true>((PG8_LAS unsigned char*)lds_raw, g, S, E, tid); }
        else { pg8::EpiResidF32 E{hres, hres}; pg8::gemm_phase<pg8::EpiResidF32, pg8::StaticOrder, true, true>((PG8_LAS unsigned char*)lds_raw, g, S, E, tid); }
    } break;

    case PH_NORM: {
        PHASE_ENTER
        const float* g = IN(16) + D;
        unsigned* XROW = (unsigned*)lds_raw;
        int* sel = (int*)(lds_raw + 65536);
        int* rnk = sel + 128;
        int* sh = rnk + 128;
        int* cnts = sh + 64;
        const int blk = bid;
        {
            float wr[16][8];
            { const float* wr_ = IN(20);
#pragma unroll
              for (int j = 0; j < 4; ++j)
#pragma unroll
                for (int q = 0; q < 4; ++q) { const f32x4 w0 = *(const f32x4*)(wr_ + (size_t)(4 * (lane + 64 * j) + q) * 8), w1 = *(const f32x4*)(wr_ + (size_t)(4 * (lane + 64 * j) + q) * 8 + 4);
                    wr[j * 4 + q][0] = w0.x; wr[j * 4 + q][1] = w0.y; wr[j * 4 + q][2] = w0.z; wr[j * 4 + q][3] = w0.w; wr[j * 4 + q][4] = w1.x; wr[j * 4 + q][5] = w1.y; wr[j * 4 + q][6] = w1.z; wr[j * 4 + q][7] = w1.w; } }
            f32x4 gv[4];
#pragma unroll
            for (int j = 0; j < 4; ++j) gv[j] = ((const f32x4*)g)[lane + 64 * j];
            f32x4 vn[4];
            { const f32x4* xr = (const f32x4*)(hres + (size_t)(blk * 64 + wid * 8) * D);
#pragma unroll
              for (int j = 0; j < 4; ++j) vn[j] = xr[lane + 64 * j]; }
#pragma unroll 1
            for (int r8 = 0; r8 < 8; ++r8) {
                const int tl = wid * 8 + r8, m = blk * 64 + tl;
                f32x4 v[4]; float s = 0.f;
#pragma unroll
                for (int j = 0; j < 4; ++j) { v[j] = vn[j]; s += (v[j].x * v[j].x + v[j].y * v[j].y) + (v[j].z * v[j].z + v[j].w * v[j].w); }
                if (r8 < 7) { const f32x4* xr = (const f32x4*)(hres + (size_t)(m + 1) * D);
#pragma unroll
                    for (int j = 0; j < 4; ++j) vn[j] = xr[lane + 64 * j]; }
                const float r = 1.0f / sqrtf(wave_sum(s) * (1.0f / D) + 1e-6f);
                float lg[8] = {0.f, 0.f, 0.f, 0.f, 0.f, 0.f, 0.f, 0.f};
#pragma unroll
                for (int j = 0; j < 4; ++j) { const float y[4] = {v[j].x * r * gv[j].x, v[j].y * r * gv[j].y, v[j].z * r * gv[j].z, v[j].w * r * gv[j].w};
                    XROW[tl * 256 + lane + 64 * j] = pg8::pk4_fp8(y[0], y[1], y[2], y[3]);
#pragma unroll
                    for (int q = 0; q < 4; ++q)
#pragma unroll
                        for (int e = 0; e < 8; ++e) lg[e] += y[q] * wr[j * 4 + q][e]; }
#pragma unroll
                for (int e = 0; e < 8; ++e) lg[e] = wave_sum(lg[e]);
                if (lane == 0) {
                    int e1 = 0; float l1 = lg[0];
#pragma unroll
                    for (int e = 1; e < 8; ++e) if (lg[e] > l1) { l1 = lg[e]; e1 = e; }
                    int e2 = -1; float l2 = -3.0e38f;
#pragma unroll
                    for (int e = 0; e < 8; ++e) if (e != e1 && lg[e] > l2) { l2 = lg[e]; e2 = e; }
                    const float g1 = 1.0f / (1.0f + fexp(l2 - l1));
                    TOKG[m * 2] = g1; TOKG[m * 2 + 1] = 1.0f - g1;
                    sel[tl * 2] = e1; sel[tl * 2 + 1] = e2;
                }
            }
            __syncthreads();
            { const int e = wid;
              const bool m0 = sel[lane] == e, m1 = sel[lane + 64] == e; const unsigned long long b0 = __ballot(m0), b1 = __ballot(m1), low = (1ull << lane) - 1ull;
              const int c0 = __popcll(b0);
              if (m0) rnk[lane] = __popcll(b0 & low);
              if (m1) rnk[lane + 64] = c0 + __popcll(b1 & low);
              if (lane == 0) BCNT[blk * NE + e] = c0 + __popcll(b1); }
        }
        xcd_barrier(bar, tid == 0);
        {
            for (int i = tid; i < (NTOK / 64) * NE; i += NT) cnts[i] = BCNT[i];
            __syncthreads();
            { const int e = wid; int sall = 0, slt = 0;
#pragma unroll
              for (int i = 0; i < 4; ++i) { const int b2 = 4 * lane + i, c = cnts[b2 * NE + e]; sall += c; slt += (b2 < blk) ? c : 0; }
#pragma unroll
              for (int o = 1; o < 64; o <<= 1) { sall += __shfl_xor(sall, o); slt += __shfl_xor(slt, o); }
              if (lane == 0) { sh[e] = sall; sh[16 + e] = slt; sh[24 + e] = (sall + 255) >> 8; } }
            __syncthreads();
            if (tid == 0) { int acc = 0; for (int e = 0; e < NE; ++e) { sh[8 + e] = acc * 256; acc += sh[24 + e]; } sh[32] = acc; }
            __syncthreads();
            if (tid < 128) { const int m = blk * 64 + (tid >> 1); const int e = sel[tid]; const int r = sh[8 + e] + sh[16 + e] + rnk[tid];
                ROWDST[r] = m * 2 + (tid & 1); ROWG[r] = TOKG[blk * 128 + tid]; TOKROW[blk * 128 + tid] = r; }
#pragma unroll
            for (int r8 = 0; r8 < 8; ++r8) {
                const int tl = wid * 8 + r8; const int e0 = sel[tl * 2], e1 = sel[tl * 2 + 1];
                const int r0 = sh[8 + e0] + sh[16 + e0] + rnk[tl * 2], r1 = sh[8 + e1] + sh[16 + e1] + rnk[tl * 2 + 1];
                const u32x4 w = *(const u32x4*)(XROW + tl * 256 + 4 * lane);
                *(u32x4*)(XR + (size_t)r0 * D + 16 * lane) = w; *(u32x4*)(XR + (size_t)r1 * D + 16 * lane) = w;
            }
            if (blk == 0) {
                for (int e = 0; e < NE; ++e) { const int lo = sh[8 + e] + sh[e], hi = sh[8 + e] + sh[24 + e] * 256; for (int r = lo + tid; r < hi; r += NT) { ROWDST[r] = -1; ROWG[r] = 0.f; } }
                if (tid < MAXTILES) { int e = 0; for (int q = 0; q < NE; ++q) if (tid * 256 >= sh[8 + q]) e = q; TILEE[tid] = e; }
                if (tid == 0) TILEE[MAXTILES] = sh[32];
            }
            __syncthreads();
        }
    } break;

    case PH_FFNUP: {
        PHASE_ENTER
        pg8::Gemm g{HN, (const bf16*)(ws + WS_WGU), NTOK, 2 * DFF, D, 0}; pg8::StaticOrder S; S.init(NTOK, 2 * DFF, G, bid);
        pg8::fill_rstd_table((PG8_LAS unsigned char*)lds_raw, S, SSP0, tid);
        pg8::EpiSwigluR E{HID, DFF, (const PG8_LAS float*)((PG8_LAS unsigned char*)lds_raw + pg8::RSTD_TAB_OFF)};
        pg8::gemm_phase<pg8::EpiSwigluR, pg8::StaticOrder, true, true>((PG8_LAS unsigned char*)lds_raw, g, S, E, tid);
    } break;

    case PH_FFNDOWN: {
        PHASE_ENTER
        pg8::Gemm g{HID, (const bf16*)(ws + WS_WD), NTOK, D, DFF, 0}; pg8::StaticOrder S; S.init(NTOK, D, G, bid);
        pg8::EpiResidStats E{hres, dry ? (float*)(ws + 410 * MiB) : hres, HN, SSP1};
        pg8::gemm_phase<pg8::EpiResidStats, pg8::StaticOrder, true, true>((PG8_LAS unsigned char*)lds_raw, g, S, E, tid);
    } break;

    case PH_MOEUP: {
        PHASE_ENTER
        const int ntiles = __builtin_amdgcn_readfirstlane(__hip_atomic_load(TILEE + MAXTILES, __ATOMIC_RELAXED, __HIP_MEMORY_SCOPE_AGENT));
        pg8::Gemm g{(const bf16*)XR, (const bf16*)(ws + WS_W13), 0, 0, D / 2, 0}; pg8::MoeOrder S; S.init(ntiles, DFFE / 128, G, bid, 0, 0, TILEE);
        pg8::EpiSwiglu8 E{HIDE, DFFE, 1.0f / W13_SCALE, HID_SCALE};
        pg8::gemm_phase<pg8::EpiSwiglu8, pg8::MoeOrder, true, true, true>((PG8_LAS unsigned char*)lds_raw, g, S, E, tid);
    } break;

    case PH_MOEDOWN: {
        PHASE_ENTER
        const int ntiles = __builtin_amdgcn_readfirstlane(__hip_atomic_load(TILEE + MAXTILES, __ATOMIC_RELAXED, __HIP_MEMORY_SCOPE_AGENT));
        const int tfull = (ntiles / 64) * 64, ntail = ntiles - tfull;
        if (tfull > 0) {
            pg8::Gemm g{(const bf16*)HIDE, (const bf16*)(ws + WS_W2), 0, 0, DFFE / 2, 0}; pg8::MoeOrder S; S.init(tfull, D / 256, G, bid, 0, 0, TILEE);
            pg8::EpiMoeDown E{OUT2, ROWDST, ROWG, OUT2_SCALE / (W2_SCALE * HID_SCALE)};
            pg8::gemm_phase<pg8::EpiMoeDown, pg8::MoeOrder, true, true, true>((PG8_LAS unsigned char*)lds_raw, g, S, E, tid);
        }
        if (ntail > 0) {
            const int Sp = moe_tail_split(ntail);
            pg8::Gemm g{(const bf16*)HIDE, (const bf16*)(ws + WS_W2), 0, 0, DFFE / 2 / Sp, DFFE / 2};
            pg8::MoeTailOrder S{tfull, ntail, D / 256, Sp, G, bid, DFFE / Sp, TILEE};
            pg8::EpiPartF32 E{PART};
            pg8::gemm_phase<pg8::EpiPartF32, pg8::MoeTailOrder, true, true, true>((PG8_LAS unsigned char*)lds_raw, g, S, E, tid);
        }
    } break;

    case PH_FINAL: {
        PHASE_ENTER
        const float* g = IN(24); const int gw = bid * 8 + wid, NGW = G * 8;
        const int ntiles = __builtin_amdgcn_readfirstlane(__hip_atomic_load(TILEE + MAXTILES, __ATOMIC_RELAXED, __HIP_MEMORY_SCOPE_AGENT));
        const int tfull = (ntiles / 64) * 64, ntail = ntiles - tfull, Sp = ntail > 0 ? moe_tail_split(ntail) : 1, tail_row0 = tfull * 256; const float sc = 1.0f / (W2_SCALE * HID_SCALE);
        for (int mb = gw; mb < NTOK; mb += 8 * NGW) {
        int trow[8][2];
#pragma unroll
        for (int k = 0; k < 8; ++k) { const int m = mb + k * NGW; trow[k][0] = m < NTOK ? TOKROW[2 * m] : 0; trow[k][1] = m < NTOK ? TOKROW[2 * m + 1] : 0; }
#pragma unroll
        for (int k = 0; k < 8; ++k) { const int m = mb + k * NGW; if (m >= NTOK) break;
            f32x4* xr = (f32x4*)(hres + (size_t)m * D); const f32x4* gr = (const f32x4*)g;
            f32x4 v[4]; unsigned ob[2][4]; float s = 0.f;
#pragma unroll
            for (int j = 0; j < 4; ++j) { v[j] = xr[lane + 64 * j]; ob[0][j] = ((const unsigned*)(OUT2 + (size_t)(2 * m) * D))[lane + 64 * j]; ob[1][j] = ((const unsigned*)(OUT2 + (size_t)(2 * m + 1) * D))[lane + 64 * j]; }
#pragma unroll
            for (int slot = 0; slot < 2; ++slot) {
                const int r = __builtin_amdgcn_readfirstlane(trow[k][slot]);
                if (r < tail_row0) {
#pragma unroll
                    for (int j = 0; j < 4; ++j) { const int p = (int)ob[slot][j]; const float i16 = 1.0f / OUT2_SCALE; v[j].x += i16 * __builtin_amdgcn_cvt_f32_fp8(p, 0); v[j].y += i16 * __builtin_amdgcn_cvt_f32_fp8(p, 1); v[j].z += i16 * __builtin_amdgcn_cvt_f32_fp8(p, 2); v[j].w += i16 * __builtin_amdgcn_cvt_f32_fp8(p, 3); } }
                else { const int tl = (r - tail_row0) >> 8, rl = (r - tail_row0) & 255; const float gt = TOKG[2 * m + slot] * sc;
                    f32x4 q[7][4];
#pragma unroll
                    for (int p = 0; p < 7; ++p) { const f32x4* pr = (const f32x4*)(PART + ((size_t)(tl * Sp + (p < Sp ? p : 0)) * 256 + rl) * 1024);
#pragma unroll
                        for (int j = 0; j < 4; ++j) q[p][j] = pr[lane + 64 * j]; }
#pragma unroll
                    for (int p = 0; p < 7; ++p) { const float gp = p < Sp ? gt : 0.f;
#pragma unroll
                        for (int j = 0; j < 4; ++j) { v[j].x += gp * q[p][j].x; v[j].y += gp * q[p][j].y; v[j].z += gp * q[p][j].z; v[j].w += gp * q[p][j].w; } } }
            }
#pragma unroll
            for (int j = 0; j < 4; ++j) s += (v[j].x * v[j].x + v[j].y * v[j].y) + (v[j].z * v[j].z + v[j].w * v[j].w);
            const float r = 1.0f / sqrtf(wave_sum(s) * (1.0f / D) + 1e-6f);
#pragma unroll
            for (int j = 0; j < 4; ++j) { const f32x4 gv = gr[lane + 64 * j]; (dry ? (f32x4*)((float*)(ws + 410 * MiB) + (size_t)m * D) : xr)[lane + 64 * j] = (f32x4){v[j].x * r * gv.x, v[j].y * r * gv.y, v[j].z * r * gv.z, v[j].w * r * gv.w}; }
        }
        }
    } break;
    }
    if (phase == PH_INPROJ || phase == PH_FFNUP || phase == PH_NORM) {
        int t_ = wid_s * 64 + lane_id_asm(); asm volatile("" : "+v"(t_));
        __attribute__((address_space(1))) unsigned char* wsq_ = (__attribute__((address_space(1))) unsigned char*)a.ws; asm volatile("" : "+s"(wsq_)); unsigned char* ws_ = (unsigned char*)wsq_; int G_ = gridDim.x; asm volatile("" : "+s"(G_));
        bg_convert(ws_, lds_raw, IN(21), IN(22), IN(23), step, G_, t_, phase == PH_NORM);
    }
    if (step + 1 < a.ph_hi) { int t_ = wid_s * 64 + lane_id_asm(); asm volatile("" : "+v"(t_)); xcd_barrier(bar, t_ == 0); }
#ifdef REP_STEP
    if (dry) { --rep_left; --step; }
#endif
    }
}

constexpr int NSTEPS = 13;
#ifndef MK_PER_PHASE
#define MK_PER_PHASE 0
#endif

extern "C" void kernel_launch(void* const* d_in, const int* in_sizes, int n_in, void* d_out, int out_size, void* d_ws, size_t ws_size, hipStream_t stream) {
    static int grid = 0;
    if (grid == 0) {
        if (n_in != 25 || out_size != NTOK * D || ws_size < WS_END + 67 * MiB) { fprintf(stderr, "kernel_launch: unexpected shapes (n_in %d out %d ws %zu need %zu)\n", n_in, out_size, ws_size, (size_t)WS_END); grid = -1; return; }
        int dev = 0, cus = 0, per_cu = 0;
        if (hipGetDevice(&dev) != hipSuccess || hipDeviceGetAttribute(&cus, hipDeviceAttributeMultiprocessorCount, dev) != hipSuccess) { grid = -1; return; }
        if (hipFuncSetAttribute((const void*)fwd, hipFuncAttributeMaxDynamicSharedMemorySize, LDS_BYTES) != hipSuccess) { fprintf(stderr, "kernel_launch: hipFuncSetAttribute failed\n"); grid = -1; return; }
        if (hipOccupancyMaxActiveBlocksPerMultiprocessor(&per_cu, (const void*)fwd, NT, LDS_BYTES) != hipSuccess || per_cu < 1) { fprintf(stderr, "kernel_launch: occupancy query says %d blocks/CU\n", per_cu); (void)hipGetLastError(); grid = -1; return; }
        grid = cus;
        if (grid != NCHUNK) { fprintf(stderr, "kernel_launch: built for a %d-CU device (one 64-token chunk per workgroup in the mixer phase); this device has %d\n", NCHUNK, cus); grid = -1; return; }
    }
    if (grid < 0) return;
    hipMemsetAsync((char*)d_ws + WS_CTL, 0, 1 * MiB, stream);
    Args a{};
    for (int i = 0; i < 25; ++i) a.in[i] = (const float*)d_in[i];
    a.out = (float*)d_out; a.ws = (unsigned char*)d_ws;
#if MK_PER_PHASE
    for (int s = 0; s < NSTEPS; ++s) { a.ph_lo = s; a.ph_hi = s + 1; hipLaunchKernelGGL(fwd, dim3(grid), dim3(NT), LDS_BYTES, stream, a); }
#else
    a.ph_lo = 0; a.ph_hi = NSTEPS;
    hipLaunchKernelGGL(fwd, dim3(grid), dim3(NT), LDS_BYTES, stream, a);
#endif
}
```
